# Optimizing an MI355X kernel written in HIP

```python
import math
import jax, jax.numpy as jnp
from jax import lax
import numpy as np


D_MODEL = 1024
BATCH = 32
SEQ = 2048
DEPTH = 4

D_MIX = D_MODEL
DN_HEADS = 4
DN_HEAD_DIM = 128
DN_WIDTH = DN_HEADS * DN_HEAD_DIM
LRU_WIDTH = D_MIX - DN_WIDTH
LRU_BLOCKS = 8
LRU_BLOCK = LRU_WIDTH // LRU_BLOCKS
LRU_C = 8.0
SHORT_CONV = 4
SHORT_CONV_LEFT = 2
FFN_CONV = 3
FFN_CONV_LEFT = 1
D_FF = 2816
PLE_DIM = 256
CHUNK = 64
EPS = 1e-6

Q_OFF = 0
K_OFF = DN_WIDTH
V_OFF = 2 * DN_WIDTH
Z_OFF = 3 * DN_WIDTH
BETA_OFF = 4 * DN_WIDTH
ALPHA_OFF = BETA_OFF + 2 * DN_HEADS
LX_OFF = ALPHA_OFF + 2 * DN_HEADS
LG_OFF = LX_OFF + LRU_WIDTH
IN_COLS = LG_OFF + LRU_WIDTH

kernel_name = 'hymba_gdn_rglru_convglu_ple_encoder'


def rmsnorm(x, g):
    x32 = x.astype(jnp.float32)
    y = x32 * lax.rsqrt(jnp.mean(x32 * x32, axis=-1, keepdims=True) + EPS)
    return (y * g.astype(jnp.float32)).astype(x.dtype)


def l2norm(x):
    x32 = x.astype(jnp.float32)
    return (x32 * lax.rsqrt(jnp.sum(x32 * x32, axis=-1, keepdims=True) + EPS)).astype(x.dtype)


def dwconv(x, w, left):
    k = w.shape[0]
    s = x.shape[1]
    xp = jnp.pad(x, ((0, 0), (left, k - 1 - left), (0, 0)))
    out = xp[:, 0:s] * w[0]
    for j in range(1, k):
        out = out + xp[:, j:j + s] * w[j]
    return out


def flip(t):
    return jnp.flip(t, axis=1)


def gated_delta_chunked(q, k, v, g, beta):
    B, S, H, Dk = q.shape
    Dv = v.shape[-1]
    N = S // CHUNK
    f32 = jnp.float32

    def chunks(t):
        t = t.astype(f32).reshape((B, N, CHUNK) + t.shape[2:])
        return jnp.moveaxis(t, 3, 1)

    qc = chunks(q) * (Dk ** -0.5)
    kc, vc, gc, bc = chunks(k), chunks(v), chunks(g), chunks(beta)
    gcum = jnp.cumsum(gc, axis=-1)
    idx = jnp.arange(CHUNK)
    incl = idx[:, None] >= idx[None, :]
    strict = idx[:, None] > idx[None, :]
    decay = jnp.exp(jnp.where(incl, gcum[..., :, None] - gcum[..., None, :], -jnp.inf))
    kb = kc * bc[..., None]
    a_mat = jnp.where(strict, jnp.einsum('bhnid,bhnjd->bhnij', kb, kc) * decay, 0.0)
    rhs = jnp.concatenate([vc * bc[..., None], kb * jnp.exp(gcum)[..., None]], axis=-1)
    sol = lax.linalg.triangular_solve(a_mat, rhs, left_side=True, lower=True, unit_diagonal=True)
    u, w = sol[..., :Dv], sol[..., Dv:]
    attn = jnp.einsum('bhnid,bhnjd->bhnij', qc, kc) * decay
    glast = gcum[..., -1:]
    q_dec = qc * jnp.exp(gcum)[..., None]
    k_dec = kc * jnp.exp(glast - gcum)[..., None]
    cdec = jnp.exp(glast[..., 0])
    xs = tuple(jnp.moveaxis(t, 2, 0) for t in (q_dec, k_dec, w, u, attn, cdec))

    def step(state, inp):
        qd, kd, wi, ui, ai, cd = inp
        v_new = ui - jnp.einsum('bhcd,bhde->bhce', wi, state)
        o = jnp.einsum('bhcd,bhde->bhce', qd, state) + jnp.einsum('bhij,bhje->bhie', ai, v_new)
        state = state * cd[..., None, None] + jnp.einsum('bhcd,bhce->bhde', kd, v_new)
        return state, o

    state0 = jnp.zeros((B, H, Dk, Dv), f32)
    _, o = lax.scan(step, state0, xs)
    o = jnp.transpose(o, (1, 0, 3, 2, 4)).reshape(B, S, H, Dv)
    return o.astype(v.dtype)


def rglru(x, wa, ba, wx, bx, lam):
    B, S, W = x.shape
    xr = x.reshape(B, S, LRU_BLOCKS, LRU_BLOCK)
    r = jax.nn.sigmoid(jnp.einsum('bsnc,ncd->bsnd', xr, wa).reshape(B, S, W) + ba)
    ig = jax.nn.sigmoid(jnp.einsum('bsnc,ncd->bsnd', xr, wx).reshape(B, S, W) + bx)
    log_a = -LRU_C * r.astype(jnp.float32) * jax.nn.softplus(-lam.astype(jnp.float32))
    a = jnp.exp(log_a)
    b = jnp.sqrt(-jnp.expm1(2.0 * log_a)) * (ig * x).astype(jnp.float32)

    def combine(e1, e2):
        a1, b1 = e1
        a2, b2 = e2
        return a1 * a2, a2 * b1 + b2

    _, h = lax.associative_scan(combine, (a, b), axis=1)
    return h.astype(x.dtype)


def setup_inputs(seed: int = 0) -> dict:
    key = jax.random.key(seed)
    ks = iter(jax.random.split(key, 32))
    f32 = jnp.float32

    def nrm(shape, scale):
        return scale * jax.random.normal(next(ks), shape, f32)

    def gain(shape):
        return 1.0 + nrm(shape, 0.02)

    L, H = DEPTH, DN_HEADS
    x = nrm((BATCH, SEQ, D_MODEL), 1.0)
    p = nrm((DEPTH, BATCH, SEQ, PLE_DIM), 1.0)
    norm1_g = gain((L, D_MODEL))
    w_in = nrm((L, D_MODEL, IN_COLS), D_MODEL ** -0.5)
    dn_conv_w = nrm((L, SHORT_CONV, 3 * DN_WIDTH), SHORT_CONV ** -0.5)
    dn_a_log = jnp.log(jax.random.uniform(next(ks), (L, 2, H), f32, 1.0, 16.0))
    dt = jnp.exp(jax.random.uniform(next(ks), (L, 2, H), f32, math.log(1e-3), math.log(1e-1)))
    dn_dt_bias = dt + jnp.log(-jnp.expm1(-dt))
    dn_norm_g = gain((L, DN_HEAD_DIM))
    lru_conv_w = nrm((L, SHORT_CONV, LRU_WIDTH), SHORT_CONV ** -0.5)
    lru_conv_b = nrm((L, LRU_WIDTH), 0.02)
    lru_wa = nrm((L, 2, LRU_BLOCKS, LRU_BLOCK, LRU_BLOCK), LRU_BLOCK ** -0.5)
    lru_ba = nrm((L, 2, LRU_WIDTH), 0.02)
    lru_wx = nrm((L, 2, LRU_BLOCKS, LRU_BLOCK, LRU_BLOCK), LRU_BLOCK ** -0.5)
    lru_bx = nrm((L, 2, LRU_WIDTH), 0.02)
    a0 = jax.random.uniform(next(ks), (L, 2, LRU_WIDTH), f32, 0.9, 0.999) ** (1.0 / LRU_C)
    lru_lambda = jnp.log(a0) - jnp.log1p(-a0)
    lru_norm_g = gain((L, LRU_WIDTH))
    w_out = nrm((L, D_MIX, D_MODEL), D_MIX ** -0.5)
    norm2_g = gain((L, D_MODEL))
    ffn_wg = nrm((L, D_MODEL, D_FF), D_MODEL ** -0.5)
    ffn_wu = nrm((L, D_MODEL, D_FF), D_MODEL ** -0.5)
    ffn_conv_w = nrm((L, FFN_CONV, D_FF), FFN_CONV ** -0.5)
    ffn_conv_b = nrm((L, D_FF), 0.02)
    ffn_wd = nrm((L, D_FF, D_MODEL), D_FF ** -0.5)
    ple_norm_g = gain((L, D_MODEL))
    ple_wg = nrm((L, D_MODEL, D_MODEL), D_MODEL ** -0.5)
    ple_bg = nrm((L, D_MODEL), 0.02)
    ple_wp = nrm((L, PLE_DIM, D_MODEL), PLE_DIM ** -0.5)
    final_g = gain((D_MODEL,))
    return {'x': x, 'p': p, 'norm1_g': norm1_g, 'w_in': w_in, 'dn_conv_w': dn_conv_w,
            'dn_a_log': dn_a_log, 'dn_dt_bias': dn_dt_bias, 'dn_norm_g': dn_norm_g,
            'lru_conv_w': lru_conv_w, 'lru_conv_b': lru_conv_b, 'lru_wa': lru_wa, 'lru_ba': lru_ba,
            'lru_wx': lru_wx, 'lru_bx': lru_bx, 'lru_lambda': lru_lambda, 'lru_norm_g': lru_norm_g,
            'w_out': w_out, 'norm2_g': norm2_g, 'ffn_wg': ffn_wg, 'ffn_wu': ffn_wu,
            'ffn_conv_w': ffn_conv_w, 'ffn_conv_b': ffn_conv_b, 'ffn_wd': ffn_wd,
            'ple_norm_g': ple_norm_g, 'ple_wg': ple_wg, 'ple_bg': ple_bg, 'ple_wp': ple_wp,
            'final_g': final_g}


def reference(x, p, norm1_g, w_in, dn_conv_w, dn_a_log, dn_dt_bias, dn_norm_g,
              lru_conv_w, lru_conv_b, lru_wa, lru_ba, lru_wx, lru_bx, lru_lambda, lru_norm_g,
              w_out, norm2_g, ffn_wg, ffn_wu, ffn_conv_w, ffn_conv_b, ffn_wd,
              ple_norm_g, ple_wg, ple_bg, ple_wp, final_g):
    B, S, _ = x.shape
    H, Dh = DN_HEADS, DN_HEAD_DIM
    r = x
    for i in range(DEPTH):
        h = rmsnorm(r, norm1_g[i])
        proj = h @ w_in[i]
        qkv = jax.nn.silu(dwconv(proj[..., Q_OFF:Z_OFF], dn_conv_w[i], SHORT_CONV_LEFT))
        q = l2norm(qkv[..., Q_OFF:K_OFF].reshape(B, S, H, Dh))
        k = l2norm(qkv[..., K_OFF:V_OFF].reshape(B, S, H, Dh))
        v = qkv[..., V_OFF:Z_OFF].reshape(B, S, H, Dh)
        z = proj[..., Z_OFF:BETA_OFF].reshape(B, S, H, Dh)
        beta = jax.nn.sigmoid(proj[..., BETA_OFF:ALPHA_OFF].reshape(B, S, 2, H))
        alpha = proj[..., ALPHA_OFF:LX_OFF].reshape(B, S, 2, H).astype(jnp.float32)
        g = -jnp.exp(dn_a_log[i].astype(jnp.float32)) * jax.nn.softplus(alpha + dn_dt_bias[i].astype(jnp.float32))
        o_f = gated_delta_chunked(q, k, v, g[:, :, 0], beta[:, :, 0])
        o_b = flip(gated_delta_chunked(flip(q), flip(k), flip(v), flip(g[:, :, 1]), flip(beta[:, :, 1])))
        dn_out = (rmsnorm(o_f + o_b, dn_norm_g[i]) * jax.nn.silu(z)).reshape(B, S, DN_WIDTH)
        xc = dwconv(proj[..., LX_OFF:LG_OFF], lru_conv_w[i], SHORT_CONV_LEFT) + lru_conv_b[i]
        h_f = rglru(xc, lru_wa[i, 0], lru_ba[i, 0], lru_wx[i, 0], lru_bx[i, 0], lru_lambda[i, 0])
        h_b = flip(rglru(flip(xc), lru_wa[i, 1], lru_ba[i, 1], lru_wx[i, 1], lru_bx[i, 1], lru_lambda[i, 1]))
        lru_out = rmsnorm(jax.nn.gelu(proj[..., LG_OFF:IN_COLS]) * (h_f + h_b), lru_norm_g[i])
        r = r + jnp.concatenate([dn_out, lru_out], axis=-1) @ w_out[i]
        h2 = rmsnorm(r, norm2_g[i])
        gate = dwconv(h2 @ ffn_wg[i], ffn_conv_w[i], FFN_CONV_LEFT) + ffn_conv_b[i]
        r = r + (jax.nn.gelu(gate) * (h2 @ ffn_wu[i])) @ ffn_wd[i]
        pg = jax.nn.sigmoid(rmsnorm(r, ple_norm_g[i]) @ ple_wg[i] + ple_bg[i])
        r = r + pg * (p[i] @ ple_wp[i])
    return rmsnorm(r, final_g)
```

```cpp
#include <hip/hip_runtime.h>
#include <hip/hip_cooperative_groups.h>
#include <cstdio>
#include <cstdint>
namespace cg = cooperative_groups;

#define LAS __attribute__((address_space(3)))
typedef unsigned short bf16_t;
typedef short bf16x8 __attribute__((ext_vector_type(8)));
typedef short s16x4 __attribute__((ext_vector_type(4)));
typedef float f32x2 __attribute__((ext_vector_type(2)));
typedef float f32x4 __attribute__((ext_vector_type(4)));
typedef float f32x16 __attribute__((ext_vector_type(16)));
typedef unsigned u32x4 __attribute__((ext_vector_type(4)));
typedef unsigned u32x2 __attribute__((ext_vector_type(2)));
typedef __bf16 bfx2_t __attribute__((ext_vector_type(2)));

constexpr int M_TOK = 65536, DM = 1024, SEQ = 2048, NB = 32, NL = 4;
constexpr int FF = 2816, PLE = 256, INC = 3088;
constexpr float EPS = 1e-6f;

constexpr size_t MiB = 1u << 20;
constexpr size_t WS_SS = 0;
constexpr size_t WS_WIN = 4 * MiB;
constexpr size_t WS_WOUT = WS_WIN + 26 * MiB;
constexpr size_t WS_WG = WS_WOUT + 8 * MiB;
constexpr size_t WS_WU = WS_WG + 22 * MiB;
constexpr size_t WS_WD = WS_WU + 22 * MiB;
constexpr size_t WS_WPG = WS_WD + 22 * MiB;
constexpr size_t WS_WP = WS_WPG + 8 * MiB;
constexpr size_t WS_WAT = WS_WP + 2 * MiB;
constexpr size_t WS_GATES = WS_WAT + 1 * MiB;
constexpr size_t WS_VEC = WS_GATES + 4 * MiB;
constexpr size_t WS_PB = WS_VEC + 8 * MiB;
constexpr size_t WS_RB = WS_PB + 32 * MiB;
constexpr size_t WS_BIG = WS_RB + 128 * MiB;
constexpr size_t WS_PQKV = WS_BIG;
constexpr size_t WS_OF = WS_BIG, WS_OB = WS_BIG + 64 * MiB, WS_PZ = WS_BIG + 128 * MiB;
constexpr size_t WS_PLX = WS_BIG + 192 * MiB, WS_PLG = WS_BIG + 192 * MiB;
constexpr size_t WS_QH = WS_BIG + 256 * MiB, WS_KH = WS_BIG + 320 * MiB, WS_VT = WS_BIG + 384 * MiB;
constexpr size_t WS_TM = WS_BIG + 448 * MiB, WS_AT = WS_BIG + 512 * MiB;
constexpr size_t WS_HF = WS_BIG + 576 * MiB, WS_HB = WS_BIG + 640 * MiB;
constexpr size_t WS_AMIX = WS_BIG + 256 * MiB;
constexpr size_t WS_G = WS_BIG, WS_ACT = WS_BIG + 352 * MiB, WS_PP = WS_BIG;
constexpr size_t WS_SSP = WS_BIG + 704 * MiB;
constexpr size_t WS_END = WS_SSP + 12 * MiB;
constexpr int LDS_BYTES = 153600;

__device__ __forceinline__ unsigned pk2(float lo, float hi) { f32x2 v = {lo, hi}; bfx2_t b = __builtin_convertvector(v, bfx2_t); return __builtin_bit_cast(unsigned, b); }
__device__ __forceinline__ u32x2 pk4(f32x4 v) { u32x2 r; r.x = pk2(v[0], v[1]); r.y = pk2(v[2], v[3]); return r; }
__device__ __forceinline__ float bflo(unsigned w) { return __uint_as_float(w << 16); }
__device__ __forceinline__ float bfhi(unsigned w) { return __uint_as_float(w & 0xffff0000u); }
__device__ __forceinline__ float bf2f(unsigned short b) { return __uint_as_float((unsigned)b << 16); }
__device__ __forceinline__ float fexp(float x) { return __builtin_amdgcn_exp2f(x * 1.4426950408889634f); }
__device__ __forceinline__ float sigm(float x) { return __builtin_amdgcn_rcpf(1.0f + fexp(-x)); }
__device__ __forceinline__ float gelu_t(float x) { const float u = 1.5957691216057308f * (x + 0.044715f * x * x * x); return x * __builtin_amdgcn_rcpf(1.0f + fexp(-u)); }
__device__ __forceinline__ float softplus_f(float x) { return x > 20.f ? x : log1pf(expf(x)); }
__device__ __forceinline__ int swz128(int row, int col) { return row * 256 + ((((col >> 3) ^ (row & 15)) << 4) | ((col & 7) << 1)); }
__device__ __forceinline__ int swz64(int row, int col) { return row * 128 + ((((col >> 3) ^ (row & 7)) << 4) | ((col & 7) << 1)); }
__device__ __forceinline__ int crow(int r, int hi) { return (r & 3) + 8 * (r >> 2) + 4 * hi; }
#define MFMA16(a, b, c) __builtin_amdgcn_mfma_f32_16x16x32_bf16((a), (b), (c), 0, 0, 0)
#define MFMA32(a, b, c) __builtin_amdgcn_mfma_f32_32x32x16_bf16((a), (b), (c), 0, 0, 0)
__device__ __forceinline__ float rs_of(const float* ssp, int row) { const f32x4* p = (const f32x4*)(ssp + (size_t)row * 16); const f32x4 a = p[0], b = p[1], c = p[2], d = p[3];
    const float s = (((a[0] + a[1]) + (a[2] + a[3])) + ((b[0] + b[1]) + (b[2] + b[3]))) + (((c[0] + c[1]) + (c[2] + c[3])) + ((d[0] + d[1]) + (d[2] + d[3]))); return rsqrtf(s * (1.0f / 1024.0f) + EPS); }
#define LDS_FENCE() asm volatile("s_waitcnt lgkmcnt(0)" ::: "memory")

namespace pg8 {
#define PG8_LAS __attribute__((address_space(3)))
typedef unsigned short bf16_t;
typedef short bf16x8 __attribute__((ext_vector_type(8)));
typedef float f32x4 __attribute__((ext_vector_type(4)));
typedef unsigned u32x4 __attribute__((ext_vector_type(4)));
constexpr int BM = 256, BK = 64, HALF = 128, HTB = HALF * BK * 2  , STAGE_BYTES = 8 * HTB, NXCD = 8, WGM = 8;

__host__ __device__ __forceinline__ int lds_byte(int r, int c) { const int st = (r >> 4) * 2 + (c >> 5), rr = r & 15, cc = c & 31, ob = rr * 64 + cc * 2; return st * 1024 + (ob ^ (((ob >> 9) & 1) << 5)); }
__host__ __device__ __forceinline__ void stage_rc(int b, int& R, int& C) { const int st = b / 1024, sb = b % 1024, swz = sb ^ (((sb >> 9) & 1) << 5); R = (st >> 1) * 16 + swz / 64; C = (st & 1) * 32 + (swz % 64) / 2; }
__host__ __device__ __forceinline__ int perm32(int rho) { const int n = rho >> 4, i = rho & 15; return 8 * (i >> 2) + 4 * n + (i & 3); }

struct Unit { int pm, pn; };
struct Gemm { const bf16_t* A; const bf16_t* Bt; int M, N, K; };

struct StaticOrder {
    int nM, nN, nwg, G, c;
    __host__ __device__ void init(int M, int N, int G_, int c_) { nM = M / BM; nN = N / BM; nwg = nM * nN; G = G_; c = c_; }
    __host__ __device__ bool next(int i, Unit& u) const {
        const long L = (long)i * G + c; if (L >= nwg) return false;
        int wgid = (int)L; { const int q = nwg / NXCD, r = nwg % NXCD, xcd = wgid % NXCD, off = wgid / NXCD; wgid = (xcd < r ? xcd * (q + 1) : r * (q + 1) + (xcd - r) * q) + off; }
        const int nig = WGM * nN, gid = wgid / nig, fm = gid * WGM, gsz = (nM - fm) < WGM ? (nM - fm) : WGM;
        u.pm = fm + ((wgid % nig) % gsz); u.pn = (wgid % nig) / gsz; return true;
    }
    __device__ __forceinline__ void a_ready(const Unit&) const {}
    __device__ __forceinline__ void done(const Unit&) const {}
};

template <class Epi, class Sched, bool ALIGN_EPI = false, bool SP2 = false>
__device__ __forceinline__ void gemm_phase(PG8_LAS unsigned char* lds, const Gemm g, const Sched& S, const Epi& E) {
    int tid_ = threadIdx.x; asm volatile("" : "+v"(tid_));
    const int tid = tid_, wid = __builtin_amdgcn_readfirstlane(tid >> 6), lane = tid & 63, wr = wid >> 2, wc = wid & 3, fr = lane & 15, fq = lane >> 4;
    const int K = g.K, nt = K / BK;
    unsigned voffA[2], voffB[2];
#pragma unroll
    for (int i = 0; i < 2; ++i) { int R, C; stage_rc(tid * 16 + i * 8192, R, C); const int Rb = Epi::PERM ? ((R & ~31) + perm32(R & 31)) : R;
        voffA[i] = (unsigned)(R * K + C) * 2u; voffB[i] = (unsigned)(Rb * K + C) * 2u; }
    const size_t kstep = (size_t)(BK * 2);
    const size_t hstep = (size_t)HALF * K * 2;
    const size_t tstep = 2 * hstep;
    const unsigned ldsw = (unsigned)wid * 1024u;
    const int aoff = lds_byte(wr * 64 + fr, fq * 8), boff = lds_byte(wc * 32 + fr, fq * 8);
#define PG8_SA(b, h) (((b) * 2 + (h)) * HTB)
#define PG8_SB(b, h) ((4 + (b) * 2 + (h)) * HTB)
#define PG8_STAGE(bufoff, gbase, voff) do { _Pragma("unroll") for (int _i = 0; _i < 2; ++_i) \
        __builtin_amdgcn_global_load_lds((const unsigned*)((const char*)(gbase) + (voff)[_i]), (PG8_LAS unsigned*)(lds + (bufoff) + ldsw + _i * 8192), 16, 0, 0); } while (0)
#define PG8_LDA(dst, b, h) do { _Pragma("unroll") for (int m = 0; m < 4; ++m) _Pragma("unroll") for (int k = 0; k < 2; ++k) dst[m][k] = *(const PG8_LAS bf16x8*)(lds + PG8_SA(b, h) + aoff + m * 2048 + k * 1024); } while (0)
#define PG8_LDB(dst, b, h) do { _Pragma("unroll") for (int n = 0; n < 2; ++n) _Pragma("unroll") for (int k = 0; k < 2; ++k) dst[n][k] = *(const PG8_LAS bf16x8*)(lds + PG8_SB(b, h) + boff + n * 2048 + k * 1024); } while (0)
#define PG8_MMA(ai, bj, At, Bt) do { __builtin_amdgcn_s_setprio(1); _Pragma("unroll") for (int m = 0; m < 4; ++m) _Pragma("unroll") for (int n = 0; n < 2; ++n) _Pragma("unroll") for (int k = 0; k < 2; ++k) \
        acc[ai][bj][m][n] = __builtin_amdgcn_mfma_f32_16x16x32_bf16(Bt[n][k], At[m][k], acc[ai][bj][m][n], 0, 0, 0); __builtin_amdgcn_s_setprio(0); } while (0)
#define PG8_WAIT_V(n) asm volatile("s_waitcnt vmcnt(" #n ")" ::: "memory")
#define PG8_WAIT_L(n) asm volatile("s_waitcnt lgkmcnt(" #n ")" ::: "memory")
#define PG8_BAR __builtin_amdgcn_s_barrier()
#define PG8_SCHED __builtin_amdgcn_sched_barrier(0)
    Unit cur, nxt; int ui = 0;
    if (!S.next(0, cur)) return;
    f32x4 acc[2][2][4][2];
#pragma unroll
    for (int a = 0; a < 2; ++a)
#pragma unroll
        for (int b = 0; b < 2; ++b)
#pragma unroll
            for (int m = 0; m < 4; ++m)
#pragma unroll
                for (int n = 0; n < 2; ++n) acc[a][b][m][n] = (f32x4){0.f, 0.f, 0.f, 0.f};
    bf16x8 At[4][2], B0[2][2], B1[2][2];
    const char* cA = (const char*)g.A + (size_t)cur.pm * tstep; const char* cB = (const char*)g.Bt + (size_t)cur.pn * tstep;
    S.a_ready(cur);
    if constexpr (SP2) {
        PG8_STAGE(PG8_SB(0, 0), cB, voffB); PG8_STAGE(PG8_SB(0, 1), cB + hstep, voffB); PG8_STAGE(PG8_SA(0, 0), cA, voffA); PG8_STAGE(PG8_SA(0, 1), cA + hstep, voffA);
        if (wr == 1) PG8_BAR;
        PG8_WAIT_V(2); PG8_BAR;
        PG8_STAGE(PG8_SB(1, 0), cB + kstep, voffB); PG8_STAGE(PG8_SA(1, 0), cA + kstep, voffA); PG8_STAGE(PG8_SB(1, 1), cB + hstep + kstep, voffB);
        PG8_WAIT_V(6); PG8_BAR;
    } else {
        PG8_STAGE(PG8_SB(0, 0), cB, voffB); PG8_STAGE(PG8_SA(0, 0), cA, voffA); PG8_STAGE(PG8_SB(0, 1), cB + hstep, voffB); PG8_STAGE(PG8_SA(0, 1), cA + hstep, voffA);
        if (wr == 1) PG8_BAR;
        PG8_WAIT_V(4); PG8_BAR;
        PG8_STAGE(PG8_SB(1, 0), cB + kstep, voffB); PG8_STAGE(PG8_SA(1, 0), cA + kstep, voffA); PG8_STAGE(PG8_SB(1, 1), cB + hstep + kstep, voffB);
        PG8_WAIT_V(6); PG8_BAR;
    }
    for (;;) {
        const bool has_next = S.next(ui + 1, nxt);
        const char* nA = has_next ? (const char*)g.A + (size_t)nxt.pm * tstep : cA; const char* nB = has_next ? (const char*)g.Bt + (size_t)nxt.pn * tstep : cB;
        for (int t = 0; t < nt; t += 2) {
            const bool last = (t == nt - 2);
            const char* a1 = cA + (size_t)(t + 1) * kstep;
            const char* a2 = last ? nA : cA + (size_t)(t + 2) * kstep; const char* b2 = last ? nB : cB + (size_t)(t + 2) * kstep;
            const char* a3 = a2 + kstep; const char* b3 = b2 + kstep;
            if (last && has_next) S.a_ready(nxt);
            if constexpr (SP2) {
            PG8_LDB(B0, 0, 0); PG8_LDB(B1, 0, 1); PG8_SCHED; PG8_LDA(At, 0, 0); PG8_STAGE(PG8_SA(1, 1), a1 + hstep, voffA);
            PG8_WAIT_V(8); PG8_WAIT_L(0); PG8_BAR; PG8_MMA(0, 0, At, B0); PG8_MMA(0, 1, At, B1); PG8_BAR; PG8_SCHED;
            PG8_LDA(At, 0, 1); PG8_STAGE(PG8_SB(0, 0), b2, voffB); PG8_STAGE(PG8_SB(0, 1), b2 + hstep, voffB); PG8_STAGE(PG8_SA(0, 0), a2, voffA);
            PG8_WAIT_V(8); PG8_WAIT_L(0); PG8_BAR; PG8_MMA(1, 0, At, B0); PG8_MMA(1, 1, At, B1); PG8_BAR; PG8_SCHED;
            PG8_LDB(B0, 1, 0); PG8_LDB(B1, 1, 1); PG8_SCHED; PG8_LDA(At, 1, 0); PG8_STAGE(PG8_SA(0, 1), a2 + hstep, voffA);
            PG8_WAIT_V(8); PG8_WAIT_L(0); PG8_BAR; PG8_MMA(0, 0, At, B0); PG8_MMA(0, 1, At, B1); PG8_BAR; PG8_SCHED;
            PG8_LDA(At, 1, 1); PG8_STAGE(PG8_SB(1, 0), b3, voffB); PG8_STAGE(PG8_SB(1, 1), b3 + hstep, voffB); PG8_STAGE(PG8_SA(1, 0), a3, voffA);
            PG8_WAIT_V(8); PG8_WAIT_L(0); PG8_BAR; PG8_MMA(1, 0, At, B0); PG8_MMA(1, 1, At, B1); PG8_BAR; PG8_SCHED;
            } else {
            PG8_LDB(B0, 0, 0); PG8_SCHED; PG8_LDA(At, 0, 0); PG8_STAGE(PG8_SA(1, 1), a1 + hstep, voffA);
            PG8_WAIT_L(8); PG8_BAR; PG8_WAIT_L(0); PG8_MMA(0, 0, At, B0); PG8_BAR; PG8_SCHED;
            PG8_LDB(B1, 0, 1); PG8_STAGE(PG8_SB(0, 0), b2, voffB);
            PG8_BAR; PG8_WAIT_L(0); PG8_MMA(0, 1, At, B1); PG8_BAR;
            PG8_LDA(At, 0, 1); PG8_STAGE(PG8_SA(0, 0), a2, voffA);
            PG8_BAR; PG8_WAIT_L(0); PG8_MMA(1, 0, At, B0); PG8_BAR; PG8_SCHED;
            PG8_STAGE(PG8_SB(0, 1), b2 + hstep, voffB);
            PG8_WAIT_V(6); PG8_BAR; PG8_MMA(1, 1, At, B1); PG8_BAR;
            PG8_LDB(B0, 1, 0); PG8_SCHED; PG8_LDA(At, 1, 0); PG8_STAGE(PG8_SA(0, 1), a2 + hstep, voffA);
            PG8_WAIT_L(8); PG8_BAR; PG8_WAIT_L(0); PG8_MMA(0, 0, At, B0); PG8_BAR; PG8_SCHED;
            PG8_LDB(B1, 1, 1); PG8_STAGE(PG8_SB(1, 0), b3, voffB);
            PG8_BAR; PG8_WAIT_L(0); PG8_MMA(0, 1, At, B1); PG8_BAR;
            PG8_LDA(At, 1, 1); PG8_STAGE(PG8_SA(1, 0), a3, voffA);
            PG8_BAR; PG8_WAIT_L(0); PG8_MMA(1, 0, At, B0); PG8_BAR; PG8_SCHED;
            PG8_STAGE(PG8_SB(1, 1), b3 + hstep, voffB);
            PG8_WAIT_V(6); PG8_BAR; PG8_MMA(1, 1, At, B1); PG8_BAR;
            }
        }
        if constexpr (ALIGN_EPI) { if (wr == 0) PG8_BAR; }
        if constexpr (!Epi::AFTER_DRAIN) { E(acc, cur, wr, wc, fr, fq); S.done(cur); }
        if (!has_next) break;
#pragma unroll
        for (int a = 0; a < 2; ++a)
#pragma unroll
            for (int b = 0; b < 2; ++b)
#pragma unroll
                for (int m = 0; m < 4; ++m)
#pragma unroll
                    for (int n = 0; n < 2; ++n) acc[a][b][m][n] = (f32x4){0.f, 0.f, 0.f, 0.f};
        cur = nxt; cA = nA; cB = nB; ++ui;
        if constexpr (ALIGN_EPI) { if (wr == 1) PG8_BAR; }
    }
    PG8_WAIT_V(0);
    if constexpr (!ALIGN_EPI) { if (wr == 0) PG8_BAR; }
    PG8_BAR;
    if constexpr (Epi::AFTER_DRAIN) { E.fused(acc, cur, wr, wc, fr, fq, lds, wid, lane); S.done(cur); }
#undef PG8_SA
#undef PG8_SB
#undef PG8_STAGE
#undef PG8_LDA
#undef PG8_LDB
#undef PG8_MMA
#undef PG8_WAIT_V
#undef PG8_WAIT_L
#undef PG8_BAR
#undef PG8_SCHED
}
}

using pg8::Unit;
struct EpiStore {
    static constexpr bool PERM = true, AFTER_DRAIN = false;
    const float* ss; bf16_t* base0; int ld0; bf16_t* base1; int ld1; int t1; float* gates; int t2;
    __device__ __forceinline__ void operator()(const f32x4 (&acc)[2][2][4][2], const Unit& u, int wr, int wc, int fr, int fq) const {
        const int row0 = u.pm * 256 + wr * 64 + fr; const int pn = u.pn;
        if (pn >= t2) {
            if (wc == 0 && fq < 2) {
#pragma unroll
                for (int ai = 0; ai < 2; ++ai)
#pragma unroll
                    for (int m = 0; m < 4; ++m) { const int row = row0 + ai * 128 + m * 16; const float s = ss ? rs_of(ss, row) : 1.f;
                        float* gp = gates + (size_t)row * 16 + 8 * fq; *(f32x4*)gp = acc[ai][0][m][0] * s; *(f32x4*)(gp + 4) = acc[ai][0][m][1] * s; }
            }
            return;
        }
        bf16_t* base; int ld, colt;
        if (pn >= t1) { base = base1; ld = ld1; colt = (pn - t1) * 256; } else { base = base0; ld = ld0; colt = pn * 256; }
        const int col0 = colt + wc * 32 + 8 * fq;
#pragma unroll
        for (int ai = 0; ai < 2; ++ai)
#pragma unroll
            for (int m = 0; m < 4; ++m) { const int row = row0 + ai * 128 + m * 16; const float s = ss ? rs_of(ss, row) : 1.f;
                bf16_t* rowp = base + (size_t)row * ld + col0;
#pragma unroll
                for (int bj = 0; bj < 2; ++bj) { const f32x4 v0 = acc[ai][bj][m][0] * s, v1 = acc[ai][bj][m][1] * s;
                    u32x4 w; w.x = pk2(v0[0], v0[1]); w.y = pk2(v0[2], v0[3]); w.z = pk2(v1[0], v1[1]); w.w = pk2(v1[2], v1[3]);
                    *(u32x4*)(rowp + bj * 128) = w; } }
    }
};

template <int MODE> struct EpiResid {
    static constexpr bool PERM = true, AFTER_DRAIN = false;
    const float* rin; float* rout; bf16_t* rb; float* ss_out; const float* ss_in; const float* bias; const bf16_t* pp;
    __device__ __forceinline__ void operator()(const f32x4 (&acc)[2][2][4][2], const Unit& u, int wr, int wc, int fr, int fq) const {
        const int row0 = u.pm * 256 + wr * 64 + fr; const int col0 = u.pn * 256 + wc * 32 + 8 * fq;
#pragma unroll
        for (int ai = 0; ai < 2; ++ai)
#pragma unroll
            for (int m = 0; m < 4; ++m) { const int row = row0 + ai * 128 + m * 16; float sq = 0.f;
                float sin_ = 1.f; if (MODE == 1) sin_ = rs_of(ss_in, row);
#pragma unroll
                for (int bj = 0; bj < 2; ++bj) { const size_t off = (size_t)row * 1024 + col0 + bj * 128;
                    f32x4 r0 = *(const f32x4*)(rin + off), r1 = *(const f32x4*)(rin + off + 4);
                    f32x4 a0 = acc[ai][bj][m][0], a1 = acc[ai][bj][m][1];
                    if (MODE == 1) { const f32x4 b0 = *(const f32x4*)(bias + col0 + bj * 128), b1 = *(const f32x4*)(bias + col0 + bj * 128 + 4);
                        const u32x4 pw = *(const u32x4*)(pp + off);
                        a0[0] = sigm(a0[0] * sin_ + b0[0]) * bflo(pw.x); a0[1] = sigm(a0[1] * sin_ + b0[1]) * bfhi(pw.x);
                        a0[2] = sigm(a0[2] * sin_ + b0[2]) * bflo(pw.y); a0[3] = sigm(a0[3] * sin_ + b0[3]) * bfhi(pw.y);
                        a1[0] = sigm(a1[0] * sin_ + b1[0]) * bflo(pw.z); a1[1] = sigm(a1[1] * sin_ + b1[1]) * bfhi(pw.z);
                        a1[2] = sigm(a1[2] * sin_ + b1[2]) * bflo(pw.w); a1[3] = sigm(a1[3] * sin_ + b1[3]) * bfhi(pw.w); }
                    r0 += a0; r1 += a1;
                    *(f32x4*)(rout + off) = r0; *(f32x4*)(rout + off + 4) = r1;
                    u32x4 w; w.x = pk2(r0[0], r0[1]); w.y = pk2(r0[2], r0[3]); w.z = pk2(r1[0], r1[1]); w.w = pk2(r1[2], r1[3]);
                    *(u32x4*)(rb + off) = w;
                    sq += (r0[0] * r0[0] + r0[1] * r0[1]) + (r0[2] * r0[2] + r0[3] * r0[3]) + (r1[0] * r1[0] + r1[1] * r1[1]) + (r1[2] * r1[2] + r1[3] * r1[3]); }
                sq += __shfl_xor(sq, 16); sq += __shfl_xor(sq, 32);
                if (fq == 0) ss_out[(size_t)row * 16 + u.pn * 4 + wc] = sq; }
    }
};

struct EpiGlu {
    static constexpr bool PERM = true, AFTER_DRAIN = false;
    const float* ss; const bf16_t* G; const float* cw; const float* cb; bf16_t* act;
    __device__ __forceinline__ void operator()(const f32x4 (&acc)[2][2][4][2], const Unit& u, int wr, int wc, int fr, int fq) const {
        const int row0 = u.pm * 256 + wr * 64 + fr; const int col0 = u.pn * 256 + wc * 32 + 8 * fq;
#pragma unroll
        for (int bj = 0; bj < 2; ++bj) { const int c = col0 + bj * 128;
            const f32x4 w0a = *(const f32x4*)(cw + c), w0b = *(const f32x4*)(cw + c + 4), w1a = *(const f32x4*)(cw + FF + c), w1b = *(const f32x4*)(cw + FF + c + 4);
            const f32x4 w2a = *(const f32x4*)(cw + 2 * FF + c), w2b = *(const f32x4*)(cw + 2 * FF + c + 4), bba = *(const f32x4*)(cb + c), bbb = *(const f32x4*)(cb + c + 4);
#pragma unroll
            for (int ai = 0; ai < 2; ++ai)
#pragma unroll
                for (int m = 0; m < 4; ++m) { const int row = row0 + ai * 128 + m * 16; const int t = row & (SEQ - 1);
                    const float s = rs_of(ss, row);
                    const bf16_t* gp = G + (size_t)row * FF + c;
                    const u32x4 gm = *(const u32x4*)gp; u32x4 gl = {0u, 0u, 0u, 0u}, gn = {0u, 0u, 0u, 0u};
                    if (t > 0) gl = *(const u32x4*)(gp - FF);
                    if (t < SEQ - 1) gn = *(const u32x4*)(gp + FF);
                    f32x4 ga, gb;
                    ga[0] = w0a[0] * bflo(gl.x) + w1a[0] * bflo(gm.x) + w2a[0] * bflo(gn.x) + bba[0];
                    ga[1] = w0a[1] * bfhi(gl.x) + w1a[1] * bfhi(gm.x) + w2a[1] * bfhi(gn.x) + bba[1];
                    ga[2] = w0a[2] * bflo(gl.y) + w1a[2] * bflo(gm.y) + w2a[2] * bflo(gn.y) + bba[2];
                    ga[3] = w0a[3] * bfhi(gl.y) + w1a[3] * bfhi(gm.y) + w2a[3] * bfhi(gn.y) + bba[3];
                    gb[0] = w0b[0] * bflo(gl.z) + w1b[0] * bflo(gm.z) + w2b[0] * bflo(gn.z) + bbb[0];
                    gb[1] = w0b[1] * bfhi(gl.z) + w1b[1] * bfhi(gm.z) + w2b[1] * bfhi(gn.z) + bbb[1];
                    gb[2] = w0b[2] * bflo(gl.w) + w1b[2] * bflo(gm.w) + w2b[2] * bflo(gn.w) + bbb[2];
                    gb[3] = w0b[3] * bfhi(gl.w) + w1b[3] * bfhi(gm.w) + w2b[3] * bfhi(gn.w) + bbb[3];
                    const f32x4 a0 = acc[ai][bj][m][0] * s, a1 = acc[ai][bj][m][1] * s;
                    u32x4 w; w.x = pk2(gelu_t(ga[0]) * a0[0], gelu_t(ga[1]) * a0[1]); w.y = pk2(gelu_t(ga[2]) * a0[2], gelu_t(ga[3]) * a0[3]);
                    w.z = pk2(gelu_t(gb[0]) * a1[0], gelu_t(gb[1]) * a1[1]); w.w = pk2(gelu_t(gb[2]) * a1[2], gelu_t(gb[3]) * a1[3]);
                    *(u32x4*)(act + (size_t)row * FF + c) = w; } }
    }
};

struct Params { const float* in[28]; float* out; unsigned char* ws; };
typedef LAS unsigned* PT;
__device__ __forceinline__ const float* pin(PT t, int k) { const unsigned lo = __builtin_amdgcn_readfirstlane(t[2 * k]), hi = __builtin_amdgcn_readfirstlane(t[2 * k + 1]); return (const float*)(((unsigned long long)hi << 32) | lo); }
__device__ __forceinline__ float* pout(PT t) { return (float*)pin(t, 28); }
__device__ __forceinline__ unsigned char* pws(PT t) { return (unsigned char*)pin(t, 29); }
enum { I_X = 0, I_P, I_N1G, I_WIN, I_DNCW, I_ALOG, I_DTB, I_DNG, I_LCW, I_LCB, I_LWA, I_LBA, I_LWX, I_LBX, I_LAM, I_LNG, I_WOUT, I_N2G, I_FWG, I_FWU, I_FCW, I_FCB, I_FWD, I_PNG, I_PWG, I_PBG, I_PWP, I_FING };

template <class RM>
__device__ __forceinline__ void tr_item(const float* W, int K, int N, bf16_t* WT, int ldt, const float* gk, const RM& rm, LAS float* scr, int item, int lane) {
    const int nblk = (N + 31) >> 5, kb = item / nblk, nb = item % nblk, k0 = 64 * kb, n0 = 32 * nb;
#pragma unroll 8
    for (int i = 0; i < 32; ++i) { const int kk = 2 * i + (lane >> 5), n = n0 + (lane & 31);
        float v = (n < N) ? W[(size_t)(k0 + kk) * N + n] : 0.f; if (gk) v *= gk[k0 + kk];
        scr[kk * 33 + (lane & 31)] = v; }
    LDS_FENCE();
    const int c = lane & 7;
#pragma unroll
    for (int j = 0; j < 4; ++j) { const int nl = (lane >> 3) + 8 * j, n = n0 + nl; const LAS float* s = scr + (8 * c) * 33 + nl;
        u32x4 o; o.x = pk2(s[0 * 33], s[1 * 33]); o.y = pk2(s[2 * 33], s[3 * 33]); o.z = pk2(s[4 * 33], s[5 * 33]); o.w = pk2(s[6 * 33], s[7 * 33]);
        const int dst = (n < N) ? rm(n) : -1;
        if (dst >= 0) *(u32x4*)(WT + (size_t)dst * ldt + k0 + 8 * c) = o; }
    LDS_FENCE();
}
struct RmId { __device__ __forceinline__ int operator()(int n) const { return n; } };
struct RmIn { __device__ __forceinline__ int operator()(int n) const {
    if (n < 1536) return n;
    if (n < 2048) return 2304 + (n - 1536);
    if (n < 2064) return 2048 + (n - 2048);
    if (n < 2576) return 1536 + (n - 2064);
    return 2816 + (n - 2576);
} };

__device__ __forceinline__ void prologue(PT pt, LAS unsigned char* lds, int gw, int NGW, int lane, int wave) {
    asm volatile("" : "+v"(lane));
    unsigned char* ws = pws(pt);
    for (int l = 0; l < NL; ++l) { u32x4* z = (u32x4*)((bf16_t*)(ws + WS_WIN) + ((size_t)l * 3328 + 2064) * 1024); const int n4 = 240 * 1024 / 8;
        for (int i = gw * 64 + lane; i < n4; i += NGW * 64) z[i] = (u32x4){0u, 0u, 0u, 0u}; }
    LAS float* scr = (LAS float*)(lds + wave * 16384);
    constexpr int I_IN = 16 * 97, I_OUT = 16 * 32, I_G = 16 * 88, I_D = 44 * 32, I_PG = 16 * 32, I_PP = 4 * 32, I_LA = 32;
    constexpr int PER_L = I_IN + I_OUT + 2 * I_G + I_D + I_PG + I_PP + 2 * I_LA;
    for (int it = gw; it < NL * PER_L; it += NGW) {
        const int l = it / PER_L; int r = it % PER_L;
        if (r < I_IN) { tr_item(pin(pt, I_WIN) + (size_t)l * DM * INC, DM, INC, (bf16_t*)(ws + WS_WIN) + (size_t)l * 3328 * 1024, 1024, pin(pt, I_N1G) + l * DM, RmIn(), scr, r, lane); continue; } r -= I_IN;
        if (r < I_OUT) { tr_item(pin(pt, I_WOUT) + (size_t)l * DM * DM, DM, DM, (bf16_t*)(ws + WS_WOUT) + (size_t)l * DM * DM, 1024, nullptr, RmId(), scr, r, lane); continue; } r -= I_OUT;
        if (r < I_G) { tr_item(pin(pt, I_FWG) + (size_t)l * DM * FF, DM, FF, (bf16_t*)(ws + WS_WG) + (size_t)l * FF * DM, 1024, pin(pt, I_N2G) + l * DM, RmId(), scr, r, lane); continue; } r -= I_G;
        if (r < I_G) { tr_item(pin(pt, I_FWU) + (size_t)l * DM * FF, DM, FF, (bf16_t*)(ws + WS_WU) + (size_t)l * FF * DM, 1024, pin(pt, I_N2G) + l * DM, RmId(), scr, r, lane); continue; } r -= I_G;
        if (r < I_D) { tr_item(pin(pt, I_FWD) + (size_t)l * FF * DM, FF, DM, (bf16_t*)(ws + WS_WD) + (size_t)l * DM * FF, FF, nullptr, RmId(), scr, r, lane); continue; } r -= I_D;
        if (r < I_PG) { tr_item(pin(pt, I_PWG) + (size_t)l * DM * DM, DM, DM, (bf16_t*)(ws + WS_WPG) + (size_t)l * DM * DM, 1024, pin(pt, I_PNG) + l * DM, RmId(), scr, r, lane); continue; } r -= I_PG;
        if (r < I_PP) { tr_item(pin(pt, I_PWP) + (size_t)l * PLE * DM, PLE, DM, (bf16_t*)(ws + WS_WP) + (size_t)l * DM * PLE, PLE, nullptr, RmId(), scr, r, lane); continue; } r -= I_PP;
        { const int gate = r / I_LA; r %= I_LA; const int mat = r >> 1, sub = r & 1;
          const float* src = pin(pt, gate ? I_LWX : I_LWA) + ((size_t)l * 16 + mat) * 4096;
          bf16_t* dst = (bf16_t*)(ws + WS_WAT) + (((size_t)l * 16 + mat) * 2 + gate) * 4096;
          tr_item(src, 64, 64, dst, 64, nullptr, RmId(), scr, sub, lane); }
    }
    const float* x = pin(pt, I_X); bf16_t* rb = (bf16_t*)(ws + WS_RB); float* ss0 = (float*)(ws + WS_SSP);
    for (int m = gw; m < M_TOK; m += NGW) { const f32x4* xr = (const f32x4*)(x + (size_t)m * DM) + lane; u32x2* o = (u32x2*)(rb + (size_t)m * DM) + lane; float s = 0.f;
#pragma unroll
        for (int j = 0; j < 4; ++j) { const f32x4 v = xr[64 * j]; s += (v[0] * v[0] + v[1] * v[1]) + (v[2] * v[2] + v[3] * v[3]); o[64 * j] = pk4(v); }
#pragma unroll
        for (int o2 = 1; o2 < 64; o2 <<= 1) s += __shfl_xor(s, o2);
        if (lane < 16) ss0[(size_t)m * 16 + lane] = lane == 0 ? s : 0.f; }
}

__device__ __forceinline__ void lru_wave(PT pt, LAS unsigned char* wl, int wi, int layer, int lane) {
    asm volatile("" : "+v"(lane));
    unsigned char* ws = pws(pt);
    const int dq = wi & 3, n = (wi >> 2) & 7, dir = (wi >> 5) & 1, b = wi >> 6;
    const int fr = lane & 15, fq = lane >> 4;
    LAS unsigned char* XC = wl; LAS float* CW = (LAS float*)(wl + 2048);
#pragma unroll
    for (int tap = 0; tap < 4; ++tap) CW[tap * 64 + lane] = pin(pt, I_LCW)[((size_t)layer * 4 + tap) * 512 + 64 * n + lane];
    CW[256 + lane] = pin(pt, I_LCB)[(size_t)layer * 512 + 64 * n + lane];
    const bf16_t* wbase = (const bf16_t*)(ws + WS_WAT) + ((((size_t)layer * 2 + dir) * 8 + n) * 2) * 4096;
    bf16x8 Ba[2], Bx[2];
#pragma unroll
    for (int ks = 0; ks < 2; ++ks) { Ba[ks] = *(const bf16x8*)(wbase + (16 * dq + fr) * 64 + 32 * ks + 8 * fq); Bx[ks] = *(const bf16x8*)(wbase + 4096 + (16 * dq + fr) * 64 + 32 * ks + 8 * fq); }
    const int dch = 64 * n + 16 * dq + fr; const size_t pidx = ((size_t)layer * 2 + dir) * 512 + dch;
    const float ba = pin(pt, I_LBA)[pidx], bx = pin(pt, I_LBX)[pidx], sp8 = 8.0f * softplus_f(-pin(pt, I_LAM)[pidx]);
    const bf16_t* plx = (const bf16_t*)(ws + WS_PLX) + (size_t)b * SEQ * 512 + 64 * n;
    bf16_t* hout = (bf16_t*)(ws + (dir ? WS_HB : WS_HF)) + (size_t)b * SEQ * 512 + dch;
    const int ti = lane >> 2, cq = lane & 3;
    LDS_FENCE();
    float hprev = 0.f;
    for (int sc = 0; sc < 128; ++sc) {
        { const int tt = dir ? (SEQ - 1 - (16 * sc + ti)) : (16 * sc + ti);
          f32x4 xa[4];
#pragma unroll
          for (int q = 0; q < 4; ++q) xa[q] = *(const LAS f32x4*)(CW + 256 + 16 * cq + 4 * q);
#pragma unroll
          for (int tap = 0; tap < 4; ++tap) { const int t2 = tt + tap - 2;
              if (t2 >= 0 && t2 < SEQ) { const u32x4 x0 = *(const u32x4*)(plx + (size_t)t2 * 512 + 16 * cq), x1 = *(const u32x4*)(plx + (size_t)t2 * 512 + 16 * cq + 8);
                  const f32x4 w0 = *(const LAS f32x4*)(CW + tap * 64 + 16 * cq), w1 = *(const LAS f32x4*)(CW + tap * 64 + 16 * cq + 4), w2 = *(const LAS f32x4*)(CW + tap * 64 + 16 * cq + 8), w3 = *(const LAS f32x4*)(CW + tap * 64 + 16 * cq + 12);
                  xa[0][0] += w0[0] * bflo(x0.x); xa[0][1] += w0[1] * bfhi(x0.x); xa[0][2] += w0[2] * bflo(x0.y); xa[0][3] += w0[3] * bfhi(x0.y);
                  xa[1][0] += w1[0] * bflo(x0.z); xa[1][1] += w1[1] * bfhi(x0.z); xa[1][2] += w1[2] * bflo(x0.w); xa[1][3] += w1[3] * bfhi(x0.w);
                  xa[2][0] += w2[0] * bflo(x1.x); xa[2][1] += w2[1] * bfhi(x1.x); xa[2][2] += w2[2] * bflo(x1.y); xa[2][3] += w2[3] * bfhi(x1.y);
                  xa[3][0] += w3[0] * bflo(x1.z); xa[3][1] += w3[1] * bfhi(x1.z); xa[3][2] += w3[2] * bflo(x1.w); xa[3][3] += w3[3] * bfhi(x1.w); } }
          u32x4 o0, o1; o0.x = pk2(xa[0][0], xa[0][1]); o0.y = pk2(xa[0][2], xa[0][3]); o0.z = pk2(xa[1][0], xa[1][1]); o0.w = pk2(xa[1][2], xa[1][3]);
          o1.x = pk2(xa[2][0], xa[2][1]); o1.y = pk2(xa[2][2], xa[2][3]); o1.z = pk2(xa[3][0], xa[3][1]); o1.w = pk2(xa[3][2], xa[3][3]);
          *(LAS u32x4*)(XC + swz64(ti, 16 * cq)) = o0; *(LAS u32x4*)(XC + swz64(ti, 16 * cq + 8)) = o1; }
        LDS_FENCE();
        const bf16x8 A0 = *(const LAS bf16x8*)(XC + swz64(fr, 8 * fq)), A1 = *(const LAS bf16x8*)(XC + swz64(fr, 32 + 8 * fq));
        f32x4 ca = {0.f, 0.f, 0.f, 0.f}, cx = {0.f, 0.f, 0.f, 0.f};
        ca = MFMA16(A0, Ba[0], ca); ca = MFMA16(A1, Ba[1], ca); cx = MFMA16(A0, Bx[0], cx); cx = MFMA16(A1, Bx[1], cx);
        float Ac[4], Hc[4];
#pragma unroll
        for (int jj = 0; jj < 4; ++jj) { const float xv = bf2f(*(const LAS unsigned short*)(XC + swz64(4 * fq + jj, 16 * dq + fr)));
            const float r = sigm(ca[jj] + ba), ig = sigm(cx[jj] + bx), a = fexp(-r * sp8);
            const float bt = sqrtf(fmaxf(1.0f - a * a, 0.f)) * ig * xv;
            Hc[jj] = jj ? (a * Hc[jj - 1] + bt) : bt; Ac[jj] = jj ? (a * Ac[jj - 1]) : a; }
        LDS_FENCE();
        float A = Ac[3], Bv = Hc[3];
        { const float A1s = __shfl_up(A, 16), B1s = __shfl_up(Bv, 16); if (fq >= 1) { Bv = A * B1s + Bv; A = A * A1s; } }
        { const float A2s = __shfl_up(A, 32), B2s = __shfl_up(Bv, 32); if (fq >= 2) { Bv = A * B2s + Bv; A = A * A2s; } }
        float Ae = __shfl_up(A, 16), Be = __shfl_up(Bv, 16); if (fq == 0) { Ae = 1.f; Be = 0.f; }
        const float hin = Ae * hprev + Be;
        float hv[4];
#pragma unroll
        for (int jj = 0; jj < 4; ++jj) hv[jj] = Ac[jj] * hin + Hc[jj];
        hprev = __shfl(hv[3], 48 + fr);
#pragma unroll
        for (int jj = 0; jj < 4; ++jj) { const int i = 4 * fq + jj; const int t2 = dir ? (SEQ - 1 - (16 * sc + i)) : (16 * sc + i);
            hout[(size_t)t2 * 512] = (bf16_t)(pk2(hv[jj], 0.f) & 0xffffu); }
    }
}

constexpr int DP_BUF0 = 0, DP_BUF1 = 49152, DP_KL = 49152, DP_QL = 49152 + 16384, DP_VL = 49152 + 32768, DP_VEC = 98304;
__device__ __forceinline__ void dp_item(PT pt, LAS unsigned char* lds, int item, int layer, int tid, int lane, int w) {
    asm volatile("" : "+v"(tid)); lane = tid & 63; asm volatile("" : "+s"(w));
    unsigned char* ws = pws(pt);
    const int b = item >> 7, h = (item >> 5) & 3, n = item & 31;
    const size_t rowbase = (size_t)b * SEQ + 64 * n;
    LAS float* VEC = (LAS float*)(lds + DP_VEC);
    __syncthreads();
    { const int i = tid >> 3, c = tid & 7; const int t = 64 * n + i; const size_t R = rowbase + i;
      const bf16_t* pq = (const bf16_t*)(ws + WS_PQKV);
#pragma unroll 1
      for (int mat = 0; mat < 3; ++mat) { const int colb = mat * 512 + h * 128 + 16 * c;
          f32x4 a[4] = {{0.f, 0.f, 0.f, 0.f}, {0.f, 0.f, 0.f, 0.f}, {0.f, 0.f, 0.f, 0.f}, {0.f, 0.f, 0.f, 0.f}};
#pragma unroll
          for (int tap = 0; tap < 4; ++tap) { const int t2 = t + tap - 2;
              if (t2 >= 0 && t2 < SEQ) { const bf16_t* xp = pq + (R + tap - 2) * 1536 + colb; const u32x4 x0 = *(const u32x4*)xp, x1 = *(const u32x4*)(xp + 8);
                  const float* wp = pin(pt, I_DNCW) + ((size_t)layer * 4 + tap) * 1536 + colb; const f32x4 w0 = *(const f32x4*)wp, w1 = *(const f32x4*)(wp + 4), w2 = *(const f32x4*)(wp + 8), w3 = *(const f32x4*)(wp + 12);
                  a[0][0] += w0[0] * bflo(x0.x); a[0][1] += w0[1] * bfhi(x0.x); a[0][2] += w0[2] * bflo(x0.y); a[0][3] += w0[3] * bfhi(x0.y);
                  a[1][0] += w1[0] * bflo(x0.z); a[1][1] += w1[1] * bfhi(x0.z); a[1][2] += w1[2] * bflo(x0.w); a[1][3] += w1[3] * bfhi(x0.w);
                  a[2][0] += w2[0] * bflo(x1.x); a[2][1] += w2[1] * bfhi(x1.x); a[2][2] += w2[2] * bflo(x1.y); a[2][3] += w2[3] * bfhi(x1.y);
                  a[3][0] += w3[0] * bflo(x1.z); a[3][1] += w3[1] * bfhi(x1.z); a[3][2] += w3[2] * bflo(x1.w); a[3][3] += w3[3] * bfhi(x1.w); } }
          float ssq = 0.f;
#pragma unroll
          for (int q = 0; q < 4; ++q)
#pragma unroll
              for (int e = 0; e < 4; ++e) { const float v = a[q][e]; const float s = v * sigm(v); a[q][e] = s; ssq += s * s; }
          float scale = 1.f;
          if (mat < 2) { ssq += __shfl_xor(ssq, 1); ssq += __shfl_xor(ssq, 2); ssq += __shfl_xor(ssq, 4); scale = rsqrtf(ssq + EPS); if (mat == 0) scale *= 0.08838834764831845f; }
          u32x4 o0, o1; o0.x = pk2(a[0][0] * scale, a[0][1] * scale); o0.y = pk2(a[0][2] * scale, a[0][3] * scale); o0.z = pk2(a[1][0] * scale, a[1][1] * scale); o0.w = pk2(a[1][2] * scale, a[1][3] * scale);
          o1.x = pk2(a[2][0] * scale, a[2][1] * scale); o1.y = pk2(a[2][2] * scale, a[2][3] * scale); o1.z = pk2(a[3][0] * scale, a[3][1] * scale); o1.w = pk2(a[3][2] * scale, a[3][3] * scale);
          const int lbase = (mat == 0) ? DP_QL : (mat == 1 ? DP_KL : DP_VL);
          *(LAS u32x4*)(lds + lbase + swz128(i, 16 * c)) = o0; *(LAS u32x4*)(lds + lbase + swz128(i, 16 * c + 8)) = o1;
          if (mat < 2) { bf16_t* gp = (bf16_t*)(ws + (mat == 0 ? WS_QH : WS_KH)) + R * 512 + h * 128 + 16 * c; *(u32x4*)gp = o0; *(u32x4*)(gp + 8) = o1; } }
    }
    if (w == 0) {
        const float* gp = (const float*)(ws + WS_GATES) + (rowbase + lane) * 16;
        const float bF = sigm(gp[h]), bB = sigm(gp[4 + h]);
        float gF = -expf(pin(pt, I_ALOG)[layer * 8 + h]) * softplus_f(gp[8 + h] + pin(pt, I_DTB)[layer * 8 + h]);
        float gB = -expf(pin(pt, I_ALOG)[layer * 8 + 4 + h]) * softplus_f(gp[12 + h] + pin(pt, I_DTB)[layer * 8 + 4 + h]);
#pragma unroll
        for (int off = 1; off < 64; off <<= 1) { const float v = __shfl_up(gF, off); if (lane >= off) gF += v; const float u = __shfl_down(gB, off); if (lane + off < 64) gB += u; }
        const float glF = __shfl(gF, 63), glB = __shfl(gB, 0);
        VEC[lane] = bF; VEC[64 + lane] = gF; VEC[128 + lane] = bB; VEC[192 + lane] = gB;
        float* v0 = (float*)(ws + WS_VEC) + (size_t)item * 256; float* v1 = v0 + (size_t)4096 * 256;
        v0[lane] = bF; v0[64 + lane] = fexp(gF); v0[128 + lane] = fexp(glF - gF); if (lane == 0) v0[192] = fexp(glF);
        v1[lane] = bB; v1[64 + lane] = fexp(gB); v1[128 + lane] = fexp(glB - gB); if (lane == 0) v1[192] = fexp(glB);
    }
    __syncthreads();
    { const int e = tid >> 2, jq = tid & 3; unsigned vv[8];
#pragma unroll
      for (int p = 0; p < 8; ++p) { const unsigned lo = *(const LAS unsigned short*)(lds + DP_VL + swz128(16 * jq + 2 * p, e)), hi = *(const LAS unsigned short*)(lds + DP_VL + swz128(16 * jq + 2 * p + 1, e)); vv[p] = lo | (hi << 16); }
      bf16_t* gp = (bf16_t*)(ws + WS_VT) + (size_t)item * 8192 + e * 64 + 16 * jq;
      *(u32x4*)gp = (u32x4){vv[0], vv[1], vv[2], vv[3]}; *(u32x4*)(gp + 8) = (u32x4){vv[4], vv[5], vv[6], vv[7]}; }
    const int r32 = lane & 31, hi = lane >> 5;
    { const int kind = w >> 2, q = w & 3, ta = q >> 1, tb = q & 1;
      f32x16 acc; for (int r = 0; r < 16; ++r) acc[r] = 0.f;
      const int bbase = kind ? DP_QL : DP_KL;
#pragma unroll
      for (int ks = 0; ks < 8; ++ks) { const bf16x8 av = *(const LAS bf16x8*)(lds + DP_KL + swz128(32 * ta + r32, 16 * ks + 8 * hi)), bv = *(const LAS bf16x8*)(lds + bbase + swz128(32 * tb + r32, 16 * ks + 8 * hi)); acc = MFMA32(av, bv, acc); }
      const int gb = 32 * tb + r32;
#pragma unroll
      for (int dir = 0; dir < 2; ++dir) { const LAS float* bet = VEC + dir * 128; const LAS float* gc = VEC + dir * 128 + 64;
          const float gcl = gc[gb], betl = bet[gb];
#pragma unroll
          for (int g = 0; g < 4; ++g) { const int ga0 = 32 * ta + 8 * g + 4 * hi; const f32x4 gca = *(const LAS f32x4*)(gc + ga0), bea = *(const LAS f32x4*)(bet + ga0);
              if (kind == 0) { f32x4 xv, yv, pv;
#pragma unroll
                  for (int jj = 0; jj < 4; ++jj) { const int ga = ga0 + jj; const float kk = acc[4 * g + jj];
                      const bool mx = dir ? (gb < ga) : (gb > ga), my = dir ? (ga < gb) : (ga > gb);
                      xv[jj] = mx ? (-betl * kk * fexp(gcl - gca[jj])) : 0.f; yv[jj] = my ? (-bea[jj] * kk * fexp(gca[jj] - gcl)) : 0.f; pv[jj] = (ga == gb) ? 1.f : 0.f; }
                  LAS unsigned char* bb = lds + DP_BUF0 + dir * 24576 + swz64(gb, ga0);
                  *(LAS u32x2*)bb = pk4(xv); *(LAS u32x2*)(bb + 8192) = pk4(yv); *(LAS u32x2*)(bb + 16384) = pk4(pv);
              } else { f32x4 av4;
#pragma unroll
                  for (int jj = 0; jj < 4; ++jj) { const int ga = ga0 + jj; const bool ma = dir ? (gb <= ga) : (gb >= ga); av4[jj] = ma ? (acc[4 * g + jj] * fexp(gcl - gca[jj])) : 0.f; }
                  *(u32x2*)((bf16_t*)(ws + WS_AT) + ((size_t)dir * 4096 + item) * 4096 + gb * 64 + ga0) = pk4(av4); } } }
    }
    __syncthreads();
    { const int dir = w >> 2, q = w & 3, ti = q >> 1, tj = q & 1;
      f32x16 pacc; for (int r = 0; r < 16; ++r) pacc[r] = (32 * tj + crow(r, hi) == 32 * ti + r32) ? 1.f : 0.f;
#pragma unroll 1
      for (int rd = 0; rd < 6; ++rd) { LAS unsigned char* cur = lds + ((rd & 1) ? DP_BUF1 : DP_BUF0) + dir * 24576; LAS unsigned char* nxt = lds + ((rd & 1) ? DP_BUF0 : DP_BUF1) + dir * 24576;
          bf16x8 xf[4], yf[4], pf[4];
#pragma unroll
          for (int ks = 0; ks < 4; ++ks) { xf[ks] = *(const LAS bf16x8*)(cur + swz64(32 * ti + r32, 16 * ks + 8 * hi)); yf[ks] = *(const LAS bf16x8*)(cur + 8192 + swz64(32 * tj + r32, 16 * ks + 8 * hi)); pf[ks] = *(const LAS bf16x8*)(cur + 16384 + swz64(32 * ti + r32, 16 * ks + 8 * hi)); }
#pragma unroll
          for (int ks = 0; ks < 4; ++ks) pacc = MFMA32(yf[ks], pf[ks], pacc);
          if (rd < 5) { f32x16 xa, ya; for (int r = 0; r < 16; ++r) { xa[r] = 0.f; ya[r] = 0.f; }
#pragma unroll
              for (int ks = 0; ks < 4; ++ks) { xa = MFMA32(yf[ks], xf[ks], xa); ya = MFMA32(xf[ks], yf[ks], ya); }
#pragma unroll
              for (int g = 0; g < 4; ++g) { const int c0 = 8 * g + 4 * hi;
                  *(LAS u32x2*)(nxt + swz64(32 * ti + r32, 32 * tj + c0)) = pk4((f32x4){xa[4 * g], xa[4 * g + 1], xa[4 * g + 2], xa[4 * g + 3]});
                  *(LAS u32x2*)(nxt + 8192 + swz64(32 * tj + r32, 32 * ti + c0)) = pk4((f32x4){ya[4 * g], ya[4 * g + 1], ya[4 * g + 2], ya[4 * g + 3]});
                  *(LAS u32x2*)(nxt + 16384 + swz64(32 * ti + r32, 32 * tj + c0)) = pk4((f32x4){pacc[4 * g], pacc[4 * g + 1], pacc[4 * g + 2], pacc[4 * g + 3]}); }
              __syncthreads(); } }
      bf16_t* tg = (bf16_t*)(ws + WS_TM) + ((size_t)dir * 4096 + item) * 4096 + (32 * ti + r32) * 64 + 32 * tj + 4 * hi;
#pragma unroll
      for (int g = 0; g < 4; ++g) *(u32x2*)(tg + 8 * g) = pk4((f32x4){pacc[4 * g], pacc[4 * g + 1], pacc[4 * g + 2], pacc[4 * g + 3]});
    }
}

constexpr int DR_K = 0, DR_Q = 16384, DR_KT = 32768, DR_VT = 49152, DR_T = 65536, DR_A = 73728, DR_VEC = 81920, DR_PRIV = 83968;
__device__ __forceinline__ void dr_item(PT pt, LAS unsigned char* lds, int item, int tid, int lane, int w) {
    asm volatile("" : "+v"(tid)); lane = tid & 63; asm volatile("" : "+s"(w));
    unsigned char* ws = pws(pt);
    const int dir = item & 1, h = (item >> 1) & 3, b = item >> 3;
    const int fr = lane & 15, fq = lane >> 4, es = 16 * w;
    LAS unsigned char* ST = lds + DR_PRIV + w * 8192; LAS unsigned char* RV = ST + 4096; LAS unsigned char* VN2 = ST + 6144;
    const LAS float* VEC = (const LAS float*)(lds + DR_VEC);
    const bf16_t* kh = (const bf16_t*)(ws + WS_KH) + (size_t)b * SEQ * 512 + h * 128;
    const bf16_t* qh = (const bf16_t*)(ws + WS_QH) + (size_t)b * SEQ * 512 + h * 128;
    const int ibase = (b * 4 + h) * 32;
    const bf16_t* vt = (const bf16_t*)(ws + WS_VT) + (size_t)ibase * 8192;
    const bf16_t* tm = (const bf16_t*)(ws + WS_TM) + ((size_t)dir * 4096 + ibase) * 4096;
    const bf16_t* at = (const bf16_t*)(ws + WS_AT) + ((size_t)dir * 4096 + ibase) * 4096;
    const float* vecs = (const float*)(ws + WS_VEC) + ((size_t)dir * 4096 + ibase) * 256;
    bf16_t* og = (bf16_t*)(ws + (dir ? WS_OB : WS_OF)) + (size_t)b * SEQ * 512 + h * 128 + es + fr;
    u32x4 pk[2], pq[2], pv[2], ptm, pa; f32x4 pvec = {0.f, 0.f, 0.f, 0.f};
#define DR_LOAD(nn) do { _Pragma("unroll") for (int u_ = 0; u_ < 2; ++u_) { const int p_ = tid + 512 * u_; \
        pk[u_] = *(const u32x4*)(kh + (size_t)(64 * (nn) + (p_ >> 4)) * 512 + 8 * (p_ & 15)); pq[u_] = *(const u32x4*)(qh + (size_t)(64 * (nn) + (p_ >> 4)) * 512 + 8 * (p_ & 15)); \
        pv[u_] = *(const u32x4*)(vt + (size_t)(nn) * 8192 + p_ * 8); } \
        ptm = *(const u32x4*)(tm + (size_t)(nn) * 4096 + tid * 8); pa = *(const u32x4*)(at + (size_t)(nn) * 4096 + tid * 8); \
        if (tid < 64) pvec = *(const f32x4*)(vecs + (size_t)(nn) * 256 + 4 * tid); } while (0)
#define DR_STORE() do { _Pragma("unroll") for (int u_ = 0; u_ < 2; ++u_) { const int p_ = tid + 512 * u_; const int j_ = p_ >> 4, q_ = p_ & 15; \
        *(LAS u32x4*)(lds + DR_K + swz128(j_, 8 * q_)) = pk[u_]; *(LAS u32x4*)(lds + DR_Q + swz128(j_, 8 * q_)) = pq[u_]; \
        *(LAS unsigned short*)(lds + DR_KT + swz64(8 * q_ + 0, j_)) = (unsigned short)(pk[u_].x & 0xffffu); *(LAS unsigned short*)(lds + DR_KT + swz64(8 * q_ + 1, j_)) = (unsigned short)(pk[u_].x >> 16); \
        *(LAS unsigned short*)(lds + DR_KT + swz64(8 * q_ + 2, j_)) = (unsigned short)(pk[u_].y & 0xffffu); *(LAS unsigned short*)(lds + DR_KT + swz64(8 * q_ + 3, j_)) = (unsigned short)(pk[u_].y >> 16); \
        *(LAS unsigned short*)(lds + DR_KT + swz64(8 * q_ + 4, j_)) = (unsigned short)(pk[u_].z & 0xffffu); *(LAS unsigned short*)(lds + DR_KT + swz64(8 * q_ + 5, j_)) = (unsigned short)(pk[u_].z >> 16); \
        *(LAS unsigned short*)(lds + DR_KT + swz64(8 * q_ + 6, j_)) = (unsigned short)(pk[u_].w & 0xffffu); *(LAS unsigned short*)(lds + DR_KT + swz64(8 * q_ + 7, j_)) = (unsigned short)(pk[u_].w >> 16); \
        *(LAS u32x4*)(lds + DR_VT + swz64(p_ >> 3, 8 * (p_ & 7))) = pv[u_]; } \
        *(LAS u32x4*)(lds + DR_T + swz64(tid >> 3, 8 * (tid & 7))) = ptm; *(LAS u32x4*)(lds + DR_A + swz64(tid >> 3, 8 * (tid & 7))) = pa; \
        if (tid < 64) *(LAS f32x4*)(lds + DR_VEC + 16 * tid) = pvec; } while (0)
    __syncthreads();
    DR_LOAD(dir ? 31 : 0);
    DR_STORE();
#pragma unroll
    for (int q = 0; q < 4; ++q) *(LAS u32x4*)(ST + lane * 64 + q * 16) = (u32x4){0u, 0u, 0u, 0u};
    f32x4 Sacc[8];
#pragma unroll
    for (int d = 0; d < 8; ++d) Sacc[d] = (f32x4){0.f, 0.f, 0.f, 0.f};
    __syncthreads();
#pragma unroll 1
    for (int cc = 0; cc < 32; ++cc) { const int n = dir ? (31 - cc) : cc;
        if (cc + 1 < 32) DR_LOAD(dir ? (30 - cc) : (cc + 1));
        bf16x8 sb[4];
#pragma unroll
        for (int ks = 0; ks < 4; ++ks) sb[ks] = *(const LAS bf16x8*)(ST + swz128(fr, 32 * ks + 8 * fq));
        f32x4 oacc[4];
#pragma unroll
        for (int it = 0; it < 4; ++it) { f32x4 ka = {0.f, 0.f, 0.f, 0.f}, qa = {0.f, 0.f, 0.f, 0.f};
#pragma unroll
            for (int ks = 0; ks < 4; ++ks) { const bf16x8 a1 = *(const LAS bf16x8*)(lds + DR_K + swz128(16 * it + fr, 32 * ks + 8 * fq)), a2 = *(const LAS bf16x8*)(lds + DR_Q + swz128(16 * it + fr, 32 * ks + 8 * fq));
                ka = MFMA16(a1, sb[ks], ka); qa = MFMA16(a2, sb[ks], qa); }
            const int i0 = 16 * it + 4 * fq; const f32x4 be = *(const LAS f32x4*)(VEC + i0), eg = *(const LAS f32x4*)(VEC + 64 + i0);
            const u32x2 vv = *(const LAS u32x2*)(lds + DR_VT + swz64(es + fr, i0));
            f32x4 rh; rh[0] = be[0] * (bflo(vv.x) - eg[0] * ka[0]); rh[1] = be[1] * (bfhi(vv.x) - eg[1] * ka[1]); rh[2] = be[2] * (bflo(vv.y) - eg[2] * ka[2]); rh[3] = be[3] * (bfhi(vv.y) - eg[3] * ka[3]);
            *(LAS u32x2*)(RV + swz64(fr, i0)) = pk4(rh);
            oacc[it] = qa * eg; }
        bf16x8 rb2[2];
#pragma unroll
        for (int ks = 0; ks < 2; ++ks) rb2[ks] = *(const LAS bf16x8*)(RV + swz64(fr, 32 * ks + 8 * fq));
        f32x4 vn[4];
#pragma unroll
        for (int it = 0; it < 4; ++it) { vn[it] = (f32x4){0.f, 0.f, 0.f, 0.f};
#pragma unroll
            for (int ks = 0; ks < 2; ++ks) { const bf16x8 a1 = *(const LAS bf16x8*)(lds + DR_T + swz64(16 * it + fr, 32 * ks + 8 * fq)); vn[it] = MFMA16(a1, rb2[ks], vn[it]); } }
#pragma unroll
        for (int it = 0; it < 4; ++it) { const int i0 = 16 * it + 4 * fq; const f32x4 ed = *(const LAS f32x4*)(VEC + 128 + i0);
            *(LAS u32x2*)(RV + swz64(fr, i0)) = pk4(vn[it]); *(LAS u32x2*)(VN2 + swz64(fr, i0)) = pk4(vn[it] * ed); }
        bf16x8 vb[2], vb2[2];
#pragma unroll
        for (int ks = 0; ks < 2; ++ks) { vb[ks] = *(const LAS bf16x8*)(RV + swz64(fr, 32 * ks + 8 * fq)); vb2[ks] = *(const LAS bf16x8*)(VN2 + swz64(fr, 32 * ks + 8 * fq)); }
#pragma unroll
        for (int it = 0; it < 4; ++it)
#pragma unroll
            for (int ks = 0; ks < 2; ++ks) { const bf16x8 a1 = *(const LAS bf16x8*)(lds + DR_A + swz64(16 * it + fr, 32 * ks + 8 * fq)); oacc[it] = MFMA16(a1, vb[ks], oacc[it]); }
        const float cdec = VEC[192];
#pragma unroll
        for (int dt = 0; dt < 8; ++dt) { Sacc[dt] = Sacc[dt] * cdec;
#pragma unroll
            for (int ks = 0; ks < 2; ++ks) { const bf16x8 a1 = *(const LAS bf16x8*)(lds + DR_KT + swz64(16 * dt + fr, 32 * ks + 8 * fq)); Sacc[dt] = MFMA16(a1, vb2[ks], Sacc[dt]); }
            *(LAS u32x2*)(ST + swz128(fr, 16 * dt + 4 * fq)) = pk4(Sacc[dt]); }
#pragma unroll
        for (int it = 0; it < 4; ++it)
#pragma unroll
            for (int jj = 0; jj < 4; ++jj) og[(size_t)(64 * n + 16 * it + 4 * fq + jj) * 512] = (bf16_t)(pk2(oacc[it][jj], 0.f) & 0xffffu);
        __syncthreads();
        if (cc + 1 < 32) DR_STORE();
        __syncthreads();
    }
#undef DR_LOAD
#undef DR_STORE
}

__device__ __forceinline__ void m2_rows(PT pt, int layer, int gw, int NGW, int lane) {
    asm volatile("" : "+v"(lane));
    unsigned char* ws = pws(pt);
    const bf16_t* of = (const bf16_t*)(ws + WS_OF); const bf16_t* ob = (const bf16_t*)(ws + WS_OB); const bf16_t* pz = (const bf16_t*)(ws + WS_PZ);
    const bf16_t* hf = (const bf16_t*)(ws + WS_HF); const bf16_t* hb = (const bf16_t*)(ws + WS_HB); const bf16_t* plg = (const bf16_t*)(ws + WS_PLG);
    bf16_t* amix = (bf16_t*)(ws + WS_AMIX);
    const float* dng = pin(pt, I_DNG) + layer * 128 + 8 * (lane & 15); const float* lng = pin(pt, I_LNG) + layer * 512 + 8 * lane;
    const f32x4 dg0 = *(const f32x4*)dng, dg1 = *(const f32x4*)(dng + 4), lg0 = *(const f32x4*)lng, lg1 = *(const f32x4*)(lng + 4);
    for (int m = gw; m < M_TOK; m += NGW) { const size_t o = (size_t)m * 512 + 8 * lane;
        const u32x4 a = *(const u32x4*)(of + o), b2 = *(const u32x4*)(ob + o), z = *(const u32x4*)(pz + o);
        const u32x4 c = *(const u32x4*)(hf + o), d = *(const u32x4*)(hb + o), g = *(const u32x4*)(plg + o);
        float v[8], y[8];
        v[0] = bflo(a.x) + bflo(b2.x); v[1] = bfhi(a.x) + bfhi(b2.x); v[2] = bflo(a.y) + bflo(b2.y); v[3] = bfhi(a.y) + bfhi(b2.y);
        v[4] = bflo(a.z) + bflo(b2.z); v[5] = bfhi(a.z) + bfhi(b2.z); v[6] = bflo(a.w) + bflo(b2.w); v[7] = bfhi(a.w) + bfhi(b2.w);
        float s1 = 0.f;
#pragma unroll
        for (int e = 0; e < 8; ++e) s1 += v[e] * v[e];
        s1 += __shfl_xor(s1, 1); s1 += __shfl_xor(s1, 2); s1 += __shfl_xor(s1, 4); s1 += __shfl_xor(s1, 8);
        const float r1 = rsqrtf(s1 * (1.0f / 128.0f) + EPS);
        float zz[8] = {bflo(z.x), bfhi(z.x), bflo(z.y), bfhi(z.y), bflo(z.z), bfhi(z.z), bflo(z.w), bfhi(z.w)};
        float gg[8] = {bflo(g.x), bfhi(g.x), bflo(g.y), bfhi(g.y), bflo(g.z), bfhi(g.z), bflo(g.w), bfhi(g.w)};
        float hh[8] = {bflo(c.x) + bflo(d.x), bfhi(c.x) + bfhi(d.x), bflo(c.y) + bflo(d.y), bfhi(c.y) + bfhi(d.y), bflo(c.z) + bflo(d.z), bfhi(c.z) + bfhi(d.z), bflo(c.w) + bflo(d.w), bfhi(c.w) + bfhi(d.w)};
        float s2 = 0.f;
#pragma unroll
        for (int e = 0; e < 8; ++e) { const float dgv = e < 4 ? dg0[e & 3] : dg1[e & 3]; v[e] = v[e] * r1 * dgv * (zz[e] * sigm(zz[e])); y[e] = gelu_t(gg[e]) * hh[e]; s2 += y[e] * y[e]; }
#pragma unroll
        for (int o2 = 1; o2 < 64; o2 <<= 1) s2 += __shfl_xor(s2, o2);
        const float r2 = rsqrtf(s2 * (1.0f / 512.0f) + EPS);
#pragma unroll
        for (int e = 0; e < 8; ++e) { const float lgv = e < 4 ? lg0[e & 3] : lg1[e & 3]; y[e] = y[e] * r2 * lgv; }
        u32x4 w1, w2; w1.x = pk2(v[0], v[1]); w1.y = pk2(v[2], v[3]); w1.z = pk2(v[4], v[5]); w1.w = pk2(v[6], v[7]);
        w2.x = pk2(y[0], y[1]); w2.y = pk2(y[2], y[3]); w2.z = pk2(y[4], y[5]); w2.w = pk2(y[6], y[7]);
        *(u32x4*)(amix + (size_t)m * 1024 + 8 * lane) = w1; *(u32x4*)(amix + (size_t)m * 1024 + 512 + 8 * lane) = w2; }
}

#ifndef PHMASK
#define PHMASK 0xFFFF
#endif
#define PH(k) if ((PHMASK >> (k)) & 1)
#define RB_ ((bf16_t*)(pws(pt) + WS_RB))
#define RBN_ ((bf16_t*)(pws(pt) + WS_ACT))
#define SS_(k) ((float*)(pws(pt) + WS_SSP) + (size_t)((k) % 3) * M_TOK * 16)
__global__ void __launch_bounds__(512, 2) fwd_kernel(Params P) {
    extern __shared__ __attribute__((aligned(16))) unsigned char lds_raw[];
    LAS unsigned char* lds = (LAS unsigned char*)lds_raw;
    cg::grid_group grid = cg::this_grid();
    const int tid = threadIdx.x, lane = tid & 63, wave = __builtin_amdgcn_readfirstlane(tid >> 6);
    const int G = gridDim.x, bx = blockIdx.x; const int gw = bx * 8 + wave, NGW = G * 8;
    PT pt = (PT)(lds + LDS_BYTES - 256);
    if (tid == 0) {
#pragma unroll
        for (int i = 0; i < 28; ++i) { const unsigned long long v = (unsigned long long)P.in[i]; pt[2 * i] = (unsigned)v; pt[2 * i + 1] = (unsigned)(v >> 32); }
        { const unsigned long long v = (unsigned long long)P.out; pt[56] = (unsigned)v; pt[57] = (unsigned)(v >> 32); }
        { const unsigned long long v = (unsigned long long)P.ws; pt[58] = (unsigned)v; pt[59] = (unsigned)(v >> 32); }
    }
    __syncthreads();

    PH(0) prologue(pt, lds, gw, NGW, lane, wave);
    __syncthreads();
    grid.sync();

#pragma unroll 1
    for (int layer = 0; layer < NL; ++layer) {
        PH(1) { pg8::Gemm g{layer == 0 ? RB_ : RBN_, (const bf16_t*)(pws(pt) + WS_WIN) + (size_t)layer * 3328 * 1024, M_TOK, 2304, 1024}; pg8::StaticOrder S; S.init(M_TOK, 2304, G, bx);
          EpiStore E{SS_(0), (bf16_t*)(pws(pt) + WS_PQKV), 1536, (bf16_t*)(pws(pt) + WS_PLX), 512, 6, (float*)(pws(pt) + WS_GATES), 8};
          pg8::gemm_phase<EpiStore, pg8::StaticOrder, true, true>(lds, g, S, E);
          const f32x4* ps = (const f32x4*)(pin(pt, I_P) + (size_t)layer * M_TOK * PLE); u32x2* pd = (u32x2*)(pws(pt) + WS_PB);
          for (size_t i = (size_t)bx * 512 + tid; i < (size_t)M_TOK * PLE / 4; i += (size_t)G * 512) pd[i] = pk4(ps[i]);
          if (layer > 0) { const u32x4* cs = (const u32x4*)RBN_; u32x4* cd = (u32x4*)RB_;
              for (size_t i = (size_t)bx * 512 + tid; i < (size_t)M_TOK * DM / 8; i += (size_t)G * 512) cd[i] = cs[i]; } }
        __syncthreads(); grid.sync();
        PH(2) for (int wi = gw; wi < 2048; wi += NGW) lru_wave(pt, lds + wave * 16384, wi, layer, lane);
        PH(3) for (int it = bx; it < 4096; it += G) dp_item(pt, lds, it, layer, tid, lane, wave);
        __syncthreads(); grid.sync();
        PH(4) for (int it = bx; it < 256; it += G) dr_item(pt, lds, it, tid, lane, wave);
        __syncthreads();
        PH(5) { pg8::Gemm g{RB_, (const bf16_t*)(pws(pt) + WS_WIN) + ((size_t)layer * 3328 + 2304) * 1024, M_TOK, 1024, 1024}; pg8::StaticOrder S; S.init(M_TOK, 1024, G, bx);
          EpiStore E{SS_(0), (bf16_t*)(pws(pt) + WS_PZ), 512, (bf16_t*)(pws(pt) + WS_PLG), 512, 2, nullptr, 99};
          pg8::gemm_phase<EpiStore, pg8::StaticOrder, true, true>(lds, g, S, E); }
        __syncthreads(); grid.sync();
        PH(6) m2_rows(pt, layer, gw, NGW, lane);
        __syncthreads(); grid.sync();
        PH(7) { pg8::Gemm g{(const bf16_t*)(pws(pt) + WS_AMIX), (const bf16_t*)(pws(pt) + WS_WOUT) + (size_t)layer * DM * DM, M_TOK, 1024, 1024}; pg8::StaticOrder S; S.init(M_TOK, 1024, G, bx);
          EpiResid<0> E{layer == 0 ? pin(pt, I_X) : pout(pt), pout(pt), RB_, SS_(1), nullptr, nullptr, nullptr};
          pg8::gemm_phase<EpiResid<0>, pg8::StaticOrder, true, true>(lds, g, S, E); }
        __syncthreads(); grid.sync();
        PH(8) { pg8::Gemm g{RB_, (const bf16_t*)(pws(pt) + WS_WG) + (size_t)layer * FF * DM, M_TOK, FF, 1024}; pg8::StaticOrder S; S.init(M_TOK, FF, G, bx);
          EpiStore E{SS_(1), (bf16_t*)(pws(pt) + WS_G), FF, nullptr, 0, 99, nullptr, 99};
          pg8::gemm_phase<EpiStore, pg8::StaticOrder, true, true>(lds, g, S, E); }
        __syncthreads(); grid.sync();
        PH(9) { pg8::Gemm g{RB_, (const bf16_t*)(pws(pt) + WS_WU) + (size_t)layer * FF * DM, M_TOK, FF, 1024}; pg8::StaticOrder S; S.init(M_TOK, FF, G, bx);
          EpiGlu E{SS_(1), (const bf16_t*)(pws(pt) + WS_G), pin(pt, I_FCW) + (size_t)layer * 3 * FF, pin(pt, I_FCB) + (size_t)layer * FF, (bf16_t*)(pws(pt) + WS_ACT)};
          pg8::gemm_phase<EpiGlu, pg8::StaticOrder, true, true>(lds, g, S, E); }
        __syncthreads(); grid.sync();
        PH(10) { pg8::Gemm g{(const bf16_t*)(pws(pt) + WS_ACT), (const bf16_t*)(pws(pt) + WS_WD) + (size_t)layer * DM * FF, M_TOK, 1024, FF}; pg8::StaticOrder S; S.init(M_TOK, 1024, G, bx);
          EpiResid<0> E{pout(pt), pout(pt), RB_, SS_(2), nullptr, nullptr, nullptr};
          pg8::gemm_phase<EpiResid<0>, pg8::StaticOrder, true, true>(lds, g, S, E); }
        __syncthreads();
        PH(11) { pg8::Gemm g{(const bf16_t*)(pws(pt) + WS_PB), (const bf16_t*)(pws(pt) + WS_WP) + (size_t)layer * DM * PLE, M_TOK, 1024, PLE}; pg8::StaticOrder S; S.init(M_TOK, 1024, G, bx);
          EpiStore E{nullptr, (bf16_t*)(pws(pt) + WS_PP), 1024, nullptr, 0, 99, nullptr, 99};
          pg8::gemm_phase<EpiStore, pg8::StaticOrder, true, true>(lds, g, S, E); }
        __syncthreads(); grid.sync();
        PH(12) { pg8::Gemm g{RB_, (const bf16_t*)(pws(pt) + WS_WPG) + (size_t)layer * DM * DM, M_TOK, 1024, 1024}; pg8::StaticOrder S; S.init(M_TOK, 1024, G, bx);
          EpiResid<1> E{pout(pt), pout(pt), RBN_, SS_(0), SS_(2), pin(pt, I_PBG) + (size_t)layer * DM, (const bf16_t*)(pws(pt) + WS_PP)};
          pg8::gemm_phase<EpiResid<1>, pg8::StaticOrder, true, true>(lds, g, S, E); }
        __syncthreads(); grid.sync();
    }
    { const float* ssF = SS_(0); const f32x4* fg = (const f32x4*)pin(pt, I_FING) + lane;
      for (int m = gw; m < M_TOK; m += NGW) { const float s = rs_of(ssF, m); f32x4* xr = (f32x4*)(pout(pt) + (size_t)m * DM) + lane;
#pragma unroll
          for (int j = 0; j < 4; ++j) xr[64 * j] = xr[64 * j] * s * fg[64 * j]; } }
}

extern "C" void kernel_launch(void* const* d_in, const int* in_sizes, int n_in, void* d_out, int out_size, void* d_ws, size_t ws_size, hipStream_t stream) {
    static int grid = 0;
    if (grid == 0) {
        if (n_in != 28 || ws_size < WS_END) { fprintf(stderr, "kernel_launch: unexpected n_in %d or workspace %zu < %zu\n", n_in, ws_size, (size_t)WS_END); grid = -1; return; }
        int dev = 0, cus = 0, per_cu = 0;
        hipGetDevice(&dev); hipDeviceGetAttribute(&cus, hipDeviceAttributeMultiprocessorCount, dev);
        if (hipFuncSetAttribute((const void*)fwd_kernel, hipFuncAttributeMaxDynamicSharedMemorySize, LDS_BYTES) != hipSuccess) fprintf(stderr, "kernel_launch: hipFuncSetAttribute failed\n");
        if (hipOccupancyMaxActiveBlocksPerMultiprocessor(&per_cu, (const void*)fwd_kernel, 512, LDS_BYTES) != hipSuccess || per_cu < 1) { fprintf(stderr, "kernel_launch: occupancy query says %d\n", per_cu); per_cu = 1; }
        (void)hipGetLastError();
        grid = cus * per_cu; if (grid > 256) grid = 256;
    }
    if (grid < 0) return;
    Params p{};
    for (int i = 0; i < 28; ++i) p.in[i] = (const float*)d_in[i];
    p.out = (float*)d_out; p.ws = (unsigned char*)d_ws;
    void* args[] = {&p};
    hipError_t e = hipLaunchCooperativeKernel((const void*)fwd_kernel, dim3(grid), dim3(512), args, LDS_BYTES, stream);
    if (e != hipSuccess) fprintf(stderr, "cooperative launch failed: %s (grid %d)\n", hipGetErrorString(e), grid);
}
```

```cpp
#include <hip/hip_runtime.h>
#include <hip/hip_cooperative_groups.h>
#include <cstdio>
#include <cstdint>
namespace cg = cooperative_groups;

#define LAS __attribute__((address_space(3)))
typedef unsigned short bf16_t;
typedef short bf16x8 __attribute__((ext_vector_type(8)));
typedef short s16x4 __attribute__((ext_vector_type(4)));
typedef float f32x2 __attribute__((ext_vector_type(2)));
typedef float f32x4 __attribute__((ext_vector_type(4)));
typedef float f32x16 __attribute__((ext_vector_type(16)));
typedef unsigned u32x4 __attribute__((ext_vector_type(4)));
typedef unsigned u32x2 __attribute__((ext_vector_type(2)));
typedef __bf16 bfx2_t __attribute__((ext_vector_type(2)));

constexpr int M_TOK = 65536, DM = 1024, SEQ = 2048, NB = 32, NL = 4;
constexpr int FF = 2816, PLE = 256, INC = 3088;
constexpr float EPS = 1e-6f;

constexpr size_t MiB = 1u << 20;
constexpr size_t WS_SS = 0;
constexpr size_t WS_WIN = 4 * MiB;
constexpr size_t WS_WOUT = WS_WIN + 26 * MiB;
constexpr size_t WS_WG = WS_WOUT + 8 * MiB;
constexpr size_t WS_WU = WS_WG + 22 * MiB;
constexpr size_t WS_WD = WS_WU + 22 * MiB;
constexpr size_t WS_WPG = WS_WD + 22 * MiB;
constexpr size_t WS_WP = WS_WPG + 8 * MiB;
constexpr size_t WS_WAT = WS_WP + 2 * MiB;
constexpr size_t WS_GATES = WS_WAT + 1 * MiB;
constexpr size_t WS_VEC = WS_GATES + 4 * MiB;
constexpr size_t WS_PB = WS_VEC + 8 * MiB;
constexpr size_t WS_RB = WS_PB + 32 * MiB;
constexpr size_t WS_BIG = WS_RB + 128 * MiB;
constexpr size_t WS_PQKV = WS_BIG;
constexpr size_t WS_OF = WS_BIG, WS_OB = WS_BIG + 64 * MiB, WS_PZ = WS_BIG + 128 * MiB;
constexpr size_t WS_PLX = WS_BIG + 192 * MiB, WS_PLG = WS_BIG + 192 * MiB;
constexpr size_t WS_QH = WS_BIG + 256 * MiB, WS_KH = WS_BIG + 320 * MiB, WS_VT = WS_BIG + 384 * MiB;
constexpr size_t WS_TM = WS_BIG + 448 * MiB, WS_AT = WS_BIG + 512 * MiB;
constexpr size_t WS_HF = WS_BIG + 576 * MiB, WS_HB = WS_BIG + 640 * MiB;
constexpr size_t WS_AMIX = WS_BIG + 256 * MiB;
constexpr size_t WS_G = WS_BIG, WS_ACT = WS_BIG + 352 * MiB, WS_PP = WS_BIG;
constexpr size_t WS_SSP = WS_BIG + 704 * MiB;
constexpr size_t WS_END = WS_SSP + 12 * MiB;
constexpr int LDS_BYTES = 153600;

__device__ __forceinline__ unsigned pk2(float lo, float hi) { f32x2 v = {lo, hi}; bfx2_t b = __builtin_convertvector(v, bfx2_t); return __builtin_bit_cast(unsigned, b); }
__device__ __forceinline__ u32x2 pk4(f32x4 v) { u32x2 r; r.x = pk2(v[0], v[1]); r.y = pk2(v[2], v[3]); return r; }
__device__ __forceinline__ float bflo(unsigned w) { return __uint_as_float(w << 16); }
__device__ __forceinline__ float bfhi(unsigned w) { return __uint_as_float(w & 0xffff0000u); }
__device__ __forceinline__ float bf2f(unsigned short b) { return __uint_as_float((unsigned)b << 16); }
__device__ __forceinline__ float fexp(float x) { return __builtin_amdgcn_exp2f(x * 1.4426950408889634f); }
__device__ __forceinline__ float sigm(float x) { return __builtin_amdgcn_rcpf(1.0f + fexp(-x)); }
__device__ __forceinline__ float gelu_t(float x) { const float u = 1.5957691216057308f * (x + 0.044715f * x * x * x); return x * __builtin_amdgcn_rcpf(1.0f + fexp(-u)); }
__device__ __forceinline__ float softplus_f(float x) { return x > 20.f ? x : log1pf(expf(x)); }
__device__ __forceinline__ int swz128(int row, int col) { return row * 256 + ((((col >> 3) ^ (row & 15)) << 4) | ((col & 7) << 1)); }
__device__ __forceinline__ int swz64(int row, int col) { return row * 128 + ((((col >> 3) ^ (row & 7)) << 4) | ((col & 7) << 1)); }
__device__ __forceinline__ int crow(int r, int hi) { return (r & 3) + 8 * (r >> 2) + 4 * hi; }
#define MFMA16(a, b, c) __builtin_amdgcn_mfma_f32_16x16x32_bf16((a), (b), (c), 0, 0, 0)
#define MFMA32(a, b, c) __builtin_amdgcn_mfma_f32_32x32x16_bf16((a), (b), (c), 0, 0, 0)
typedef unsigned long long u64;
__device__ __forceinline__ u64 ss_fix(float s) { return (u64)(s * 1048576.0f + 0.5f); }
__device__ __forceinline__ float rs_of(const u64* ss, int row) { return rsqrtf((float)ss[row] * (1.0f / (1048576.0f * 1024.0f)) + EPS); }
#define LDS_FENCE() asm volatile("s_waitcnt lgkmcnt(0)" ::: "memory")

namespace pg8 {
#define PG8_LAS __attribute__((address_space(3)))
typedef unsigned short bf16_t;
typedef short bf16x8 __attribute__((ext_vector_type(8)));
typedef float f32x4 __attribute__((ext_vector_type(4)));
typedef unsigned u32x4 __attribute__((ext_vector_type(4)));
constexpr int BM = 256, BK = 64, HALF = 128, HTB = HALF * BK * 2  , STAGE_BYTES = 8 * HTB, NXCD = 8, WGM = 8;

__host__ __device__ __forceinline__ int lds_byte(int r, int c) { const int st = (r >> 4) * 2 + (c >> 5), rr = r & 15, cc = c & 31, ob = rr * 64 + cc * 2; return st * 1024 + (ob ^ (((ob >> 9) & 1) << 5)); }
__host__ __device__ __forceinline__ void stage_rc(int b, int& R, int& C) { const int st = b / 1024, sb = b % 1024, swz = sb ^ (((sb >> 9) & 1) << 5); R = (st >> 1) * 16 + swz / 64; C = (st & 1) * 32 + (swz % 64) / 2; }
__host__ __device__ __forceinline__ int perm32(int rho) { const int n = rho >> 4, i = rho & 15; return 8 * (i >> 2) + 4 * n + (i & 3); }

struct Unit { int pm, pn; };
struct Gemm { const bf16_t* A; const bf16_t* Bt; int M, N, K; };

struct StaticOrder {
    int nM, nN, nwg, G, c;
    __host__ __device__ void init(int M, int N, int G_, int c_) { nM = M / BM; nN = N / BM; nwg = nM * nN; G = G_; c = c_; }
    __host__ __device__ bool next(int i, Unit& u) const {
        const long L = (long)i * G + c; if (L >= nwg) return false;
        int wgid = (int)L; { const int q = nwg / NXCD, r = nwg % NXCD, xcd = wgid % NXCD, off = wgid / NXCD; wgid = (xcd < r ? xcd * (q + 1) : r * (q + 1) + (xcd - r) * q) + off; }
        const int nig = WGM * nN, gid = wgid / nig, fm = gid * WGM, gsz = (nM - fm) < WGM ? (nM - fm) : WGM;
        u.pm = fm + ((wgid % nig) % gsz); u.pn = (wgid % nig) / gsz; return true;
    }
    __device__ __forceinline__ void a_ready(const Unit&) const {}
    __device__ __forceinline__ void done(const Unit&) const {}
};

template <class Epi, class Sched, bool ALIGN_EPI = false, bool SP2 = false>
__device__ __forceinline__ void gemm_phase(PG8_LAS unsigned char* lds, const Gemm g, const Sched& S, const Epi& E) {
    int tid_ = threadIdx.x; asm volatile("" : "+v"(tid_));
    const int tid = tid_, wid = __builtin_amdgcn_readfirstlane(tid >> 6), lane = tid & 63, wr = wid >> 2, wc = wid & 3, fr = lane & 15, fq = lane >> 4;
    const int K = g.K, nt = K / BK;
    unsigned voffA[2], voffB[2];
#pragma unroll
    for (int i = 0; i < 2; ++i) { int R, C; stage_rc(tid * 16 + i * 8192, R, C); const int Rb = Epi::PERM ? ((R & ~31) + perm32(R & 31)) : R;
        voffA[i] = (unsigned)(R * K + C) * 2u; voffB[i] = (unsigned)(Rb * K + C) * 2u; }
    const size_t kstep = (size_t)(BK * 2);
    const size_t hstep = (size_t)HALF * K * 2;
    const size_t tstep = 2 * hstep;
    const unsigned ldsw = (unsigned)wid * 1024u;
    const int aoff = lds_byte(wr * 64 + fr, fq * 8), boff = lds_byte(wc * 32 + fr, fq * 8);
#define PG8_SA(b, h) (((b) * 2 + (h)) * HTB)
#define PG8_SB(b, h) ((4 + (b) * 2 + (h)) * HTB)
#define PG8_STAGE(bufoff, gbase, voff) do { _Pragma("unroll") for (int _i = 0; _i < 2; ++_i) \
        __builtin_amdgcn_global_load_lds((const unsigned*)((const char*)(gbase) + (voff)[_i]), (PG8_LAS unsigned*)(lds + (bufoff) + ldsw + _i * 8192), 16, 0, 0); } while (0)
#define PG8_LDA(dst, b, h) do { _Pragma("unroll") for (int m = 0; m < 4; ++m) _Pragma("unroll") for (int k = 0; k < 2; ++k) dst[m][k] = *(const PG8_LAS bf16x8*)(lds + PG8_SA(b, h) + aoff + m * 2048 + k * 1024); } while (0)
#define PG8_LDB(dst, b, h) do { _Pragma("unroll") for (int n = 0; n < 2; ++n) _Pragma("unroll") for (int k = 0; k < 2; ++k) dst[n][k] = *(const PG8_LAS bf16x8*)(lds + PG8_SB(b, h) + boff + n * 2048 + k * 1024); } while (0)
#define PG8_MMA(ai, bj, At, Bt) do { __builtin_amdgcn_s_setprio(1); _Pragma("unroll") for (int m = 0; m < 4; ++m) _Pragma("unroll") for (int n = 0; n < 2; ++n) _Pragma("unroll") for (int k = 0; k < 2; ++k) \
        acc[ai][bj][m][n] = __builtin_amdgcn_mfma_f32_16x16x32_bf16(Bt[n][k], At[m][k], acc[ai][bj][m][n], 0, 0, 0); __builtin_amdgcn_s_setprio(0); } while (0)
#define PG8_WAIT_V(n) asm volatile("s_waitcnt vmcnt(" #n ")" ::: "memory")
#define PG8_WAIT_L(n) asm volatile("s_waitcnt lgkmcnt(" #n ")" ::: "memory")
#define PG8_BAR __builtin_amdgcn_s_barrier()
#define PG8_SCHED __builtin_amdgcn_sched_barrier(0)
    Unit cur, nxt; int ui = 0;
    if (!S.next(0, cur)) return;
    f32x4 acc[2][2][4][2];
#pragma unroll
    for (int a = 0; a < 2; ++a)
#pragma unroll
        for (int b = 0; b < 2; ++b)
#pragma unroll
            for (int m = 0; m < 4; ++m)
#pragma unroll
                for (int n = 0; n < 2; ++n) acc[a][b][m][n] = (f32x4){0.f, 0.f, 0.f, 0.f};
    bf16x8 At[4][2], B0[2][2], B1[2][2];
    const char* cA = (const char*)g.A + (size_t)cur.pm * tstep; const char* cB = (const char*)g.Bt + (size_t)cur.pn * tstep;
    S.a_ready(cur);
    if constexpr (SP2) {
        PG8_STAGE(PG8_SB(0, 0), cB, voffB); PG8_STAGE(PG8_SB(0, 1), cB + hstep, voffB); PG8_STAGE(PG8_SA(0, 0), cA, voffA); PG8_STAGE(PG8_SA(0, 1), cA + hstep, voffA);
        if (wr == 1) PG8_BAR;
        PG8_WAIT_V(2); PG8_BAR;
        PG8_STAGE(PG8_SB(1, 0), cB + kstep, voffB); PG8_STAGE(PG8_SA(1, 0), cA + kstep, voffA); PG8_STAGE(PG8_SB(1, 1), cB + hstep + kstep, voffB);
        PG8_WAIT_V(6); PG8_BAR;
    } else {
        PG8_STAGE(PG8_SB(0, 0), cB, voffB); PG8_STAGE(PG8_SA(0, 0), cA, voffA); PG8_STAGE(PG8_SB(0, 1), cB + hstep, voffB); PG8_STAGE(PG8_SA(0, 1), cA + hstep, voffA);
        if (wr == 1) PG8_BAR;
        PG8_WAIT_V(4); PG8_BAR;
        PG8_STAGE(PG8_SB(1, 0), cB + kstep, voffB); PG8_STAGE(PG8_SA(1, 0), cA + kstep, voffA); PG8_STAGE(PG8_SB(1, 1), cB + hstep + kstep, voffB);
        PG8_WAIT_V(6); PG8_BAR;
    }
    for (;;) {
        const bool has_next = S.next(ui + 1, nxt);
        const char* nA = has_next ? (const char*)g.A + (size_t)nxt.pm * tstep : cA; const char* nB = has_next ? (const char*)g.Bt + (size_t)nxt.pn * tstep : cB;
        for (int t = 0; t < nt; t += 2) {
            const bool last = (t == nt - 2);
            const char* a1 = cA + (size_t)(t + 1) * kstep;
            const char* a2 = last ? nA : cA + (size_t)(t + 2) * kstep; const char* b2 = last ? nB : cB + (size_t)(t + 2) * kstep;
            const char* a3 = a2 + kstep; const char* b3 = b2 + kstep;
            if (last && has_next) S.a_ready(nxt);
            if constexpr (SP2) {
            PG8_LDB(B0, 0, 0); PG8_LDB(B1, 0, 1); PG8_SCHED; PG8_LDA(At, 0, 0); PG8_STAGE(PG8_SA(1, 1), a1 + hstep, voffA);
            PG8_WAIT_V(8); PG8_WAIT_L(0); PG8_BAR; PG8_MMA(0, 0, At, B0); PG8_MMA(0, 1, At, B1); PG8_BAR; PG8_SCHED;
            PG8_LDA(At, 0, 1); PG8_STAGE(PG8_SB(0, 0), b2, voffB); PG8_STAGE(PG8_SB(0, 1), b2 + hstep, voffB); PG8_STAGE(PG8_SA(0, 0), a2, voffA);
            PG8_WAIT_V(8); PG8_WAIT_L(0); PG8_BAR; PG8_MMA(1, 0, At, B0); PG8_MMA(1, 1, At, B1); PG8_BAR; PG8_SCHED;
            PG8_LDB(B0, 1, 0); PG8_LDB(B1, 1, 1); PG8_SCHED; PG8_LDA(At, 1, 0); PG8_STAGE(PG8_SA(0, 1), a2 + hstep, voffA);
            PG8_WAIT_V(8); PG8_WAIT_L(0); PG8_BAR; PG8_MMA(0, 0, At, B0); PG8_MMA(0, 1, At, B1); PG8_BAR; PG8_SCHED;
            PG8_LDA(At, 1, 1); PG8_STAGE(PG8_SB(1, 0), b3, voffB); PG8_STAGE(PG8_SB(1, 1), b3 + hstep, voffB); PG8_STAGE(PG8_SA(1, 0), a3, voffA);
            PG8_WAIT_V(8); PG8_WAIT_L(0); PG8_BAR; PG8_MMA(1, 0, At, B0); PG8_MMA(1, 1, At, B1); PG8_BAR; PG8_SCHED;
            } else {
            PG8_LDB(B0, 0, 0); PG8_SCHED; PG8_LDA(At, 0, 0); PG8_STAGE(PG8_SA(1, 1), a1 + hstep, voffA);
            PG8_WAIT_L(8); PG8_BAR; PG8_WAIT_L(0); PG8_MMA(0, 0, At, B0); PG8_BAR; PG8_SCHED;
            PG8_LDB(B1, 0, 1); PG8_STAGE(PG8_SB(0, 0), b2, voffB);
            PG8_BAR; PG8_WAIT_L(0); PG8_MMA(0, 1, At, B1); PG8_BAR;
            PG8_LDA(At, 0, 1); PG8_STAGE(PG8_SA(0, 0), a2, voffA);
            PG8_BAR; PG8_WAIT_L(0); PG8_MMA(1, 0, At, B0); PG8_BAR; PG8_SCHED;
            PG8_STAGE(PG8_SB(0, 1), b2 + hstep, voffB);
            PG8_WAIT_V(6); PG8_BAR; PG8_MMA(1, 1, At, B1); PG8_BAR;
            PG8_LDB(B0, 1, 0); PG8_SCHED; PG8_LDA(At, 1, 0); PG8_STAGE(PG8_SA(0, 1), a2 + hstep, voffA);
            PG8_WAIT_L(8); PG8_BAR; PG8_WAIT_L(0); PG8_MMA(0, 0, At, B0); PG8_BAR; PG8_SCHED;
            PG8_LDB(B1, 1, 1); PG8_STAGE(PG8_SB(1, 0), b3, voffB);
            PG8_BAR; PG8_WAIT_L(0); PG8_MMA(0, 1, At, B1); PG8_BAR;
            PG8_LDA(At, 1, 1); PG8_STAGE(PG8_SA(1, 0), a3, voffA);
            PG8_BAR; PG8_WAIT_L(0); PG8_MMA(1, 0, At, B0); PG8_BAR; PG8_SCHED;
            PG8_STAGE(PG8_SB(1, 1), b3 + hstep, voffB);
            PG8_WAIT_V(6); PG8_BAR; PG8_MMA(1, 1, At, B1); PG8_BAR;
            }
        }
        if constexpr (ALIGN_EPI) { if (wr == 0) PG8_BAR; }
        if constexpr (!Epi::AFTER_DRAIN) { E(acc, cur, wr, wc, fr, fq); S.done(cur); }
        if (!has_next) break;
#pragma unroll
        for (int a = 0; a < 2; ++a)
#pragma unroll
            for (int b = 0; b < 2; ++b)
#pragma unroll
                for (int m = 0; m < 4; ++m)
#pragma unroll
                    for (int n = 0; n < 2; ++n) acc[a][b][m][n] = (f32x4){0.f, 0.f, 0.f, 0.f};
        cur = nxt; cA = nA; cB = nB; ++ui;
        if constexpr (ALIGN_EPI) { if (wr == 1) PG8_BAR; }
    }
    PG8_WAIT_V(0);
    if constexpr (!ALIGN_EPI) { if (wr == 0) PG8_BAR; }
    PG8_BAR;
    if constexpr (Epi::AFTER_DRAIN) { E.fused(acc, cur, wr, wc, fr, fq, lds, wid, lane); S.done(cur); }
#undef PG8_SA
#undef PG8_SB
#undef PG8_STAGE
#undef PG8_LDA
#undef PG8_LDB
#undef PG8_MMA
#undef PG8_WAIT_V
#undef PG8_WAIT_L
#undef PG8_BAR
#undef PG8_SCHED
}
}

using pg8::Unit;
struct EpiStore {
    static constexpr bool PERM = true, AFTER_DRAIN = false;
    const u64* ss; bf16_t* base0; int ld0; bf16_t* base1; int ld1; int t1; float* gates; int t2;
    __device__ __forceinline__ void operator()(const f32x4 (&acc)[2][2][4][2], const Unit& u, int wr, int wc, int fr, int fq) const {
        const int row0 = u.pm * 256 + wr * 64 + fr; const int pn = u.pn;
        if (pn >= t2) {
            if (wc == 0 && fq < 2) {
#pragma unroll
                for (int ai = 0; ai < 2; ++ai)
#pragma unroll
                    for (int m = 0; m < 4; ++m) { const int row = row0 + ai * 128 + m * 16; const float s = ss ? rs_of(ss, row) : 1.f;
                        float* gp = gates + (size_t)row * 16 + 8 * fq; *(f32x4*)gp = acc[ai][0][m][0] * s; *(f32x4*)(gp + 4) = acc[ai][0][m][1] * s; }
            }
            return;
        }
        bf16_t* base; int ld, colt;
        if (pn >= t1) { base = base1; ld = ld1; colt = (pn - t1) * 256; } else { base = base0; ld = ld0; colt = pn * 256; }
        const int col0 = colt + wc * 32 + 8 * fq;
#pragma unroll
        for (int ai = 0; ai < 2; ++ai)
#pragma unroll
            for (int m = 0; m < 4; ++m) { const int row = row0 + ai * 128 + m * 16; const float s = ss ? rs_of(ss, row) : 1.f;
                bf16_t* rowp = base + (size_t)row * ld + col0;
#pragma unroll
                for (int bj = 0; bj < 2; ++bj) { const f32x4 v0 = acc[ai][bj][m][0] * s, v1 = acc[ai][bj][m][1] * s;
                    u32x4 w; w.x = pk2(v0[0], v0[1]); w.y = pk2(v0[2], v0[3]); w.z = pk2(v1[0], v1[1]); w.w = pk2(v1[2], v1[3]);
                    *(u32x4*)(rowp + bj * 128) = w; } }
    }
};

#ifndef RES_BM
#define RES_BM 4
#endif
#ifndef RES1_BM
#define RES1_BM 2
#endif
template <int MODE> struct EpiResid {
    static constexpr bool PERM = true, AFTER_DRAIN = false;
    const float* rin; float* rout; bf16_t* rb; u64* ss_out; const u64* ss_in; const float* bias; const bf16_t* pp;
    __device__ __forceinline__ void operator()(const f32x4 (&acc)[2][2][4][2], const Unit& u, int wr, int wc, int fr, int fq) const {
        const int row0 = u.pm * 256 + wr * 64 + fr; const int col0 = u.pn * 256 + wc * 32 + 8 * fq;
#pragma unroll
        for (int ai = 0; ai < 2; ++ai) {
            float sq[4] = {0.f, 0.f, 0.f, 0.f};
            if (MODE == 0) {
#pragma unroll
                for (int mh = 0; mh < 4; mh += RES_BM) {
                f32x4 pre[RES_BM][2][2];
#pragma unroll
                for (int m = 0; m < RES_BM; ++m)
#pragma unroll
                    for (int bj = 0; bj < 2; ++bj) { const size_t off = (size_t)(row0 + ai * 128 + (mh + m) * 16) * 1024 + col0 + bj * 128; pre[m][bj][0] = *(const f32x4*)(rin + off); pre[m][bj][1] = *(const f32x4*)(rin + off + 4); }
#pragma unroll
                for (int m = 0; m < RES_BM; ++m)
#pragma unroll
                    for (int bj = 0; bj < 2; ++bj) { const size_t off = (size_t)(row0 + ai * 128 + (mh + m) * 16) * 1024 + col0 + bj * 128;
                        const f32x4 r0 = pre[m][bj][0] + acc[ai][bj][mh + m][0], r1 = pre[m][bj][1] + acc[ai][bj][mh + m][1];
                        *(f32x4*)(rout + off) = r0; *(f32x4*)(rout + off + 4) = r1;
                        u32x4 w; w.x = pk2(r0[0], r0[1]); w.y = pk2(r0[2], r0[3]); w.z = pk2(r1[0], r1[1]); w.w = pk2(r1[2], r1[3]);
                        *(u32x4*)(rb + off) = w;
                        sq[mh + m] += (r0[0] * r0[0] + r0[1] * r0[1]) + (r0[2] * r0[2] + r0[3] * r0[3]) + (r1[0] * r1[0] + r1[1] * r1[1]) + (r1[2] * r1[2] + r1[3] * r1[3]); }
                }
            } else {
                float sin_[4];
#pragma unroll
                for (int m = 0; m < 4; ++m) sin_[m] = rs_of(ss_in, row0 + ai * 128 + m * 16);
#pragma unroll
                for (int bj = 0; bj < 2; ++bj) { const f32x4 b0 = *(const f32x4*)(bias + col0 + bj * 128), b1 = *(const f32x4*)(bias + col0 + bj * 128 + 4);
#pragma unroll
                    for (int mh = 0; mh < 4; mh += RES1_BM) {
                    f32x4 pre[RES1_BM][2]; u32x4 pw[RES1_BM];
#pragma unroll
                    for (int m = 0; m < RES1_BM; ++m) { const size_t off = (size_t)(row0 + ai * 128 + (mh + m) * 16) * 1024 + col0 + bj * 128; pre[m][0] = *(const f32x4*)(rin + off); pre[m][1] = *(const f32x4*)(rin + off + 4); pw[m] = *(const u32x4*)(pp + off); }
#pragma unroll
                    for (int m = 0; m < RES1_BM; ++m) { const size_t off = (size_t)(row0 + ai * 128 + (mh + m) * 16) * 1024 + col0 + bj * 128; const float si = sin_[mh + m];
                        f32x4 a0 = acc[ai][bj][mh + m][0], a1 = acc[ai][bj][mh + m][1];
                        a0[0] = sigm(a0[0] * si + b0[0]) * bflo(pw[m].x); a0[1] = sigm(a0[1] * si + b0[1]) * bfhi(pw[m].x);
                        a0[2] = sigm(a0[2] * si + b0[2]) * bflo(pw[m].y); a0[3] = sigm(a0[3] * si + b0[3]) * bfhi(pw[m].y);
                        a1[0] = sigm(a1[0] * si + b1[0]) * bflo(pw[m].z); a1[1] = sigm(a1[1] * si + b1[1]) * bfhi(pw[m].z);
                        a1[2] = sigm(a1[2] * si + b1[2]) * bflo(pw[m].w); a1[3] = sigm(a1[3] * si + b1[3]) * bfhi(pw[m].w);
                        const f32x4 r0 = pre[m][0] + a0, r1 = pre[m][1] + a1;
                        *(f32x4*)(rout + off) = r0; *(f32x4*)(rout + off + 4) = r1;
                        u32x4 w; w.x = pk2(r0[0], r0[1]); w.y = pk2(r0[2], r0[3]); w.z = pk2(r1[0], r1[1]); w.w = pk2(r1[2], r1[3]);
                        *(u32x4*)(rb + off) = w;
                        sq[mh + m] += (r0[0] * r0[0] + r0[1] * r0[1]) + (r0[2] * r0[2] + r0[3] * r0[3]) + (r1[0] * r1[0] + r1[1] * r1[1]) + (r1[2] * r1[2] + r1[3] * r1[3]); } } }
            }
#pragma unroll
            for (int m = 0; m < 4; ++m) { float q = sq[m]; q += __shfl_xor(q, 16); q += __shfl_xor(q, 32);
                if (fq == 0) atomicAdd(ss_out + (row0 + ai * 128 + m * 16), ss_fix(q)); }
        }
    }
};

#ifndef GLU_BM
#define GLU_BM 2
#endif
struct EpiGlu {
    static constexpr bool PERM = true, AFTER_DRAIN = false;
    const u64* ss; const bf16_t* G; const float* cw; const float* cb; bf16_t* act;
    __device__ __forceinline__ void operator()(const f32x4 (&acc)[2][2][4][2], const Unit& u, int wr, int wc, int fr, int fq) const {
        const int row0 = u.pm * 256 + wr * 64 + fr; const int col0 = u.pn * 256 + wc * 32 + 8 * fq;
#pragma unroll
        for (int bj = 0; bj < 2; ++bj) { const int c = col0 + bj * 128;
            const f32x4 w0a = *(const f32x4*)(cw + c), w0b = *(const f32x4*)(cw + c + 4), w1a = *(const f32x4*)(cw + FF + c), w1b = *(const f32x4*)(cw + FF + c + 4);
            const f32x4 w2a = *(const f32x4*)(cw + 2 * FF + c), w2b = *(const f32x4*)(cw + 2 * FF + c + 4), bba = *(const f32x4*)(cb + c), bbb = *(const f32x4*)(cb + c + 4);
#pragma unroll
            for (int ai = 0; ai < 2; ++ai)
#pragma unroll
            for (int mh = 0; mh < 4; mh += GLU_BM) {
                u32x4 gmv[GLU_BM], glv[GLU_BM], gnv[GLU_BM]; float sv[GLU_BM];
#pragma unroll
                for (int m = 0; m < GLU_BM; ++m) { const int row = row0 + ai * 128 + (mh + m) * 16; const int t = row & (SEQ - 1); const bf16_t* gp = G + (size_t)row * FF + c;
                    gmv[m] = *(const u32x4*)gp; glv[m] = (u32x4){0u, 0u, 0u, 0u}; gnv[m] = (u32x4){0u, 0u, 0u, 0u};
                    if (t > 0) glv[m] = *(const u32x4*)(gp - FF);
                    if (t < SEQ - 1) gnv[m] = *(const u32x4*)(gp + FF);
                    sv[m] = rs_of(ss, row); }
#pragma unroll
                for (int m = 0; m < GLU_BM; ++m) { const int row = row0 + ai * 128 + (mh + m) * 16; const float s = sv[m]; const u32x4 gm = gmv[m], gl = glv[m], gn = gnv[m];
                    f32x4 ga, gb;
                    ga[0] = w0a[0] * bflo(gl.x) + w1a[0] * bflo(gm.x) + w2a[0] * bflo(gn.x) + bba[0];
                    ga[1] = w0a[1] * bfhi(gl.x) + w1a[1] * bfhi(gm.x) + w2a[1] * bfhi(gn.x) + bba[1];
                    ga[2] = w0a[2] * bflo(gl.y) + w1a[2] * bflo(gm.y) + w2a[2] * bflo(gn.y) + bba[2];
                    ga[3] = w0a[3] * bfhi(gl.y) + w1a[3] * bfhi(gm.y) + w2a[3] * bfhi(gn.y) + bba[3];
                    gb[0] = w0b[0] * bflo(gl.z) + w1b[0] * bflo(gm.z) + w2b[0] * bflo(gn.z) + bbb[0];
                    gb[1] = w0b[1] * bfhi(gl.z) + w1b[1] * bfhi(gm.z) + w2b[1] * bfhi(gn.z) + bbb[1];
                    gb[2] = w0b[2] * bflo(gl.w) + w1b[2] * bflo(gm.w) + w2b[2] * bflo(gn.w) + bbb[2];
                    gb[3] = w0b[3] * bfhi(gl.w) + w1b[3] * bfhi(gm.w) + w2b[3] * bfhi(gn.w) + bbb[3];
                    const f32x4 a0 = acc[ai][bj][mh + m][0] * s, a1 = acc[ai][bj][mh + m][1] * s;
                    u32x4 w; w.x = pk2(gelu_t(ga[0]) * a0[0], gelu_t(ga[1]) * a0[1]); w.y = pk2(gelu_t(ga[2]) * a0[2], gelu_t(ga[3]) * a0[3]);
                    w.z = pk2(gelu_t(gb[0]) * a1[0], gelu_t(gb[1]) * a1[1]); w.w = pk2(gelu_t(gb[2]) * a1[2], gelu_t(gb[3]) * a1[3]);
                    *(u32x4*)(act + (size_t)row * FF + c) = w; } } }
    }
};

struct Params { const float* in[28]; float* out; unsigned char* ws; };
typedef LAS unsigned* PT;
__device__ __forceinline__ const float* pin(PT t, int k) { const unsigned lo = __builtin_amdgcn_readfirstlane(t[2 * k]), hi = __builtin_amdgcn_readfirstlane(t[2 * k + 1]); return (const float*)(((unsigned long long)hi << 32) | lo); }
__device__ __forceinline__ float* pout(PT t) { return (float*)pin(t, 28); }
__device__ __forceinline__ unsigned char* pws(PT t) { return (unsigned char*)pin(t, 29); }
enum { I_X = 0, I_P, I_N1G, I_WIN, I_DNCW, I_ALOG, I_DTB, I_DNG, I_LCW, I_LCB, I_LWA, I_LBA, I_LWX, I_LBX, I_LAM, I_LNG, I_WOUT, I_N2G, I_FWG, I_FWU, I_FCW, I_FCB, I_FWD, I_PNG, I_PWG, I_PBG, I_PWP, I_FING };

template <class RM>
__device__ __forceinline__ void tr_item(const float* W, int K, int N, bf16_t* WT, int ldt, const float* gk, const RM& rm, LAS float* scr, int item, int lane) {
    const int nblk = (N + 31) >> 5, kb = item / nblk, nb = item % nblk, k0 = 64 * kb, n0 = 32 * nb;
#pragma unroll 8
    for (int i = 0; i < 32; ++i) { const int kk = 2 * i + (lane >> 5), n = n0 + (lane & 31);
        float v = (n < N) ? W[(size_t)(k0 + kk) * N + n] : 0.f; if (gk) v *= gk[k0 + kk];
        scr[kk * 33 + (lane & 31)] = v; }
    LDS_FENCE();
    const int c = lane & 7;
#pragma unroll
    for (int j = 0; j < 4; ++j) { const int nl = (lane >> 3) + 8 * j, n = n0 + nl; const LAS float* s = scr + (8 * c) * 33 + nl;
        u32x4 o; o.x = pk2(s[0 * 33], s[1 * 33]); o.y = pk2(s[2 * 33], s[3 * 33]); o.z = pk2(s[4 * 33], s[5 * 33]); o.w = pk2(s[6 * 33], s[7 * 33]);
        const int dst = (n < N) ? rm(n) : -1;
        if (dst >= 0) *(u32x4*)(WT + (size_t)dst * ldt + k0 + 8 * c) = o; }
    LDS_FENCE();
}
struct RmId { __device__ __forceinline__ int operator()(int n) const { return n; } };
struct RmIn { __device__ __forceinline__ int operator()(int n) const {
    if (n < 1536) return n;
    if (n < 2048) return 2304 + (n - 1536);
    if (n < 2064) return 2048 + (n - 2048);
    if (n < 2576) return 1536 + (n - 2064);
    return 2816 + (n - 2576);
} };

__device__ __forceinline__ void prologue(PT pt, LAS unsigned char* lds, int gw, int NGW, int lane, int wave) {
    asm volatile("" : "+v"(lane));
    unsigned char* ws = pws(pt);
    { u32x4* z = (u32x4*)((u64*)(ws + WS_SSP) + M_TOK); const size_t n4 = (size_t)12 * M_TOK / 2;
      for (size_t i = (size_t)gw * 64 + lane; i < n4; i += (size_t)NGW * 64) z[i] = (u32x4){0u, 0u, 0u, 0u}; }
    for (int l = 0; l < NL; ++l) { u32x4* z = (u32x4*)((bf16_t*)(ws + WS_WIN) + ((size_t)l * 3328 + 2064) * 1024); const int n4 = 240 * 1024 / 8;
        for (int i = gw * 64 + lane; i < n4; i += NGW * 64) z[i] = (u32x4){0u, 0u, 0u, 0u}; }
    LAS float* scr = (LAS float*)(lds + wave * 16384);
    constexpr int I_IN = 16 * 97, I_OUT = 16 * 32, I_G = 16 * 88, I_D = 44 * 32, I_PG = 16 * 32, I_PP = 4 * 32, I_LA = 32;
    constexpr int PER_L = I_IN + I_OUT + 2 * I_G + I_D + I_PG + I_PP + 2 * I_LA;
    for (int it = gw; it < NL * PER_L; it += NGW) {
        const int l = it / PER_L; int r = it % PER_L;
        if (r < I_IN) { tr_item(pin(pt, I_WIN) + (size_t)l * DM * INC, DM, INC, (bf16_t*)(ws + WS_WIN) + (size_t)l * 3328 * 1024, 1024, pin(pt, I_N1G) + l * DM, RmIn(), scr, r, lane); continue; } r -= I_IN;
        if (r < I_OUT) { tr_item(pin(pt, I_WOUT) + (size_t)l * DM * DM, DM, DM, (bf16_t*)(ws + WS_WOUT) + (size_t)l * DM * DM, 1024, nullptr, RmId(), scr, r, lane); continue; } r -= I_OUT;
        if (r < I_G) { tr_item(pin(pt, I_FWG) + (size_t)l * DM * FF, DM, FF, (bf16_t*)(ws + WS_WG) + (size_t)l * FF * DM, 1024, pin(pt, I_N2G) + l * DM, RmId(), scr, r, lane); continue; } r -= I_G;
        if (r < I_G) { tr_item(pin(pt, I_FWU) + (size_t)l * DM * FF, DM, FF, (bf16_t*)(ws + WS_WU) + (size_t)l * FF * DM, 1024, pin(pt, I_N2G) + l * DM, RmId(), scr, r, lane); continue; } r -= I_G;
        if (r < I_D) { tr_item(pin(pt, I_FWD) + (size_t)l * FF * DM, FF, DM, (bf16_t*)(ws + WS_WD) + (size_t)l * DM * FF, FF, nullptr, RmId(), scr, r, lane); continue; } r -= I_D;
        if (r < I_PG) { tr_item(pin(pt, I_PWG) + (size_t)l * DM * DM, DM, DM, (bf16_t*)(ws + WS_WPG) + (size_t)l * DM * DM, 1024, pin(pt, I_PNG) + l * DM, RmId(), scr, r, lane); continue; } r -= I_PG;
        if (r < I_PP) { tr_item(pin(pt, I_PWP) + (size_t)l * PLE * DM, PLE, DM, (bf16_t*)(ws + WS_WP) + (size_t)l * DM * PLE, PLE, nullptr, RmId(), scr, r, lane); continue; } r -= I_PP;
        { const int gate = r / I_LA; r %= I_LA; const int mat = r >> 1, sub = r & 1;
          const float* src = pin(pt, gate ? I_LWX : I_LWA) + ((size_t)l * 16 + mat) * 4096;
          bf16_t* dst = (bf16_t*)(ws + WS_WAT) + (((size_t)l * 16 + mat) * 2 + gate) * 4096;
          tr_item(src, 64, 64, dst, 64, nullptr, RmId(), scr, sub, lane); }
    }
    const float* x = pin(pt, I_X); bf16_t* rb = (bf16_t*)(ws + WS_RB); u64* ss0 = (u64*)(ws + WS_SSP);
    for (int m = gw; m < M_TOK; m += NGW) { const f32x4* xr = (const f32x4*)(x + (size_t)m * DM) + lane; u32x2* o = (u32x2*)(rb + (size_t)m * DM) + lane; float s = 0.f;
#pragma unroll
        for (int j = 0; j < 4; ++j) { const f32x4 v = xr[64 * j]; s += (v[0] * v[0] + v[1] * v[1]) + (v[2] * v[2] + v[3] * v[3]); o[64 * j] = pk4(v); }
#pragma unroll
        for (int o2 = 1; o2 < 64; o2 <<= 1) s += __shfl_xor(s, o2);
        if (lane == 0) ss0[m] = ss_fix(s); }
}

__device__ __forceinline__ void lru_wave(PT pt, LAS unsigned char* wl, int wi, int layer, int lane) {
    asm volatile("" : "+v"(lane));
    unsigned char* ws = pws(pt);
    const int dq = wi & 3, n = (wi >> 2) & 7, dir = (wi >> 5) & 1, b = wi >> 6;
    const int fr = lane & 15, fq = lane >> 4;
    LAS unsigned char* XC = wl; LAS float* CW = (LAS float*)(wl + 2048);
#pragma unroll
    for (int tap = 0; tap < 4; ++tap) CW[tap * 64 + lane] = pin(pt, I_LCW)[((size_t)layer * 4 + tap) * 512 + 64 * n + lane];
    CW[256 + lane] = pin(pt, I_LCB)[(size_t)layer * 512 + 64 * n + lane];
    const bf16_t* wbase = (const bf16_t*)(ws + WS_WAT) + ((((size_t)layer * 2 + dir) * 8 + n) * 2) * 4096;
    bf16x8 Ba[2], Bx[2];
#pragma unroll
    for (int ks = 0; ks < 2; ++ks) { Ba[ks] = *(const bf16x8*)(wbase + (16 * dq + fr) * 64 + 32 * ks + 8 * fq); Bx[ks] = *(const bf16x8*)(wbase + 4096 + (16 * dq + fr) * 64 + 32 * ks + 8 * fq); }
    const int dch = 64 * n + 16 * dq + fr; const size_t pidx = ((size_t)layer * 2 + dir) * 512 + dch;
    const float ba = pin(pt, I_LBA)[pidx], bx = pin(pt, I_LBX)[pidx], sp8 = 8.0f * softplus_f(-pin(pt, I_LAM)[pidx]);
    const bf16_t* plx = (const bf16_t*)(ws + WS_PLX) + (size_t)b * SEQ * 512 + 64 * n;
    bf16_t* hout = (bf16_t*)(ws + (dir ? WS_HB : WS_HF)) + (size_t)b * SEQ * 512 + dch;
    const int ti = lane >> 2, cq = lane & 3;
    LDS_FENCE();
    float hprev = 0.f;
    for (int sc = 0; sc < 128; ++sc) {
        { const int tt = dir ? (SEQ - 1 - (16 * sc + ti)) : (16 * sc + ti);
          f32x4 xa[4];
#pragma unroll
          for (int q = 0; q < 4; ++q) xa[q] = *(const LAS f32x4*)(CW + 256 + 16 * cq + 4 * q);
#pragma unroll
          for (int tap = 0; tap < 4; ++tap) { const int t2 = tt + tap - 2;
              if (t2 >= 0 && t2 < SEQ) { const u32x4 x0 = *(const u32x4*)(plx + (size_t)t2 * 512 + 16 * cq), x1 = *(const u32x4*)(plx + (size_t)t2 * 512 + 16 * cq + 8);
                  const f32x4 w0 = *(const LAS f32x4*)(CW + tap * 64 + 16 * cq), w1 = *(const LAS f32x4*)(CW + tap * 64 + 16 * cq + 4), w2 = *(const LAS f32x4*)(CW + tap * 64 + 16 * cq + 8), w3 = *(const LAS f32x4*)(CW + tap * 64 + 16 * cq + 12);
                  xa[0][0] += w0[0] * bflo(x0.x); xa[0][1] += w0[1] * bfhi(x0.x); xa[0][2] += w0[2] * bflo(x0.y); xa[0][3] += w0[3] * bfhi(x0.y);
                  xa[1][0] += w1[0] * bflo(x0.z); xa[1][1] += w1[1] * bfhi(x0.z); xa[1][2] += w1[2] * bflo(x0.w); xa[1][3] += w1[3] * bfhi(x0.w);
                  xa[2][0] += w2[0] * bflo(x1.x); xa[2][1] += w2[1] * bfhi(x1.x); xa[2][2] += w2[2] * bflo(x1.y); xa[2][3] += w2[3] * bfhi(x1.y);
                  xa[3][0] += w3[0] * bflo(x1.z); xa[3][1] += w3[1] * bfhi(x1.z); xa[3][2] += w3[2] * bflo(x1.w); xa[3][3] += w3[3] * bfhi(x1.w); } }
          u32x4 o0, o1; o0.x = pk2(xa[0][0], xa[0][1]); o0.y = pk2(xa[0][2], xa[0][3]); o0.z = pk2(xa[1][0], xa[1][1]); o0.w = pk2(xa[1][2], xa[1][3]);
          o1.x = pk2(xa[2][0], xa[2][1]); o1.y = pk2(xa[2][2], xa[2][3]); o1.z = pk2(xa[3][0], xa[3][1]); o1.w = pk2(xa[3][2], xa[3][3]);
          *(LAS u32x4*)(XC + swz64(ti, 16 * cq)) = o0; *(LAS u32x4*)(XC + swz64(ti, 16 * cq + 8)) = o1; }
        LDS_FENCE();
        const bf16x8 A0 = *(const LAS bf16x8*)(XC + swz64(fr, 8 * fq)), A1 = *(const LAS bf16x8*)(XC + swz64(fr, 32 + 8 * fq));
        f32x4 ca = {0.f, 0.f, 0.f, 0.f}, cx = {0.f, 0.f, 0.f, 0.f};
        ca = MFMA16(A0, Ba[0], ca); ca = MFMA16(A1, Ba[1], ca); cx = MFMA16(A0, Bx[0], cx); cx = MFMA16(A1, Bx[1], cx);
        float Ac[4], Hc[4];
#pragma unroll
        for (int jj = 0; jj < 4; ++jj) { const float xv = bf2f(*(const LAS unsigned short*)(XC + swz64(4 * fq + jj, 16 * dq + fr)));
            const float r = sigm(ca[jj] + ba), ig = sigm(cx[jj] + bx), a = fexp(-r * sp8);
            const float bt = sqrtf(fmaxf(1.0f - a * a, 0.f)) * ig * xv;
            Hc[jj] = jj ? (a * Hc[jj - 1] + bt) : bt; Ac[jj] = jj ? (a * Ac[jj - 1]) : a; }
        LDS_FENCE();
        float A = Ac[3], Bv = Hc[3];
        { const float A1s = __shfl_up(A, 16), B1s = __shfl_up(Bv, 16); if (fq >= 1) { Bv = A * B1s + Bv; A = A * A1s; } }
        { const float A2s = __shfl_up(A, 32), B2s = __shfl_up(Bv, 32); if (fq >= 2) { Bv = A * B2s + Bv; A = A * A2s; } }
        float Ae = __shfl_up(A, 16), Be = __shfl_up(Bv, 16); if (fq == 0) { Ae = 1.f; Be = 0.f; }
        const float hin = Ae * hprev + Be;
        float hv[4];
#pragma unroll
        for (int jj = 0; jj < 4; ++jj) hv[jj] = Ac[jj] * hin + Hc[jj];
        hprev = __shfl(hv[3], 48 + fr);
#pragma unroll
        for (int jj = 0; jj < 4; ++jj) { const int i = 4 * fq + jj; const int t2 = dir ? (SEQ - 1 - (16 * sc + i)) : (16 * sc + i);
            hout[(size_t)t2 * 512] = (bf16_t)(pk2(hv[jj], 0.f) & 0xffffu); }
    }
}

constexpr int DP_BUF0 = 0, DP_BUF1 = 49152, DP_KL = 49152, DP_QL = 49152 + 16384, DP_VL = 49152 + 32768, DP_VEC = 98304;
__device__ __forceinline__ void dp_item(PT pt, LAS unsigned char* lds, int item, int layer, int tid, int lane, int w) {
    asm volatile("" : "+v"(tid)); lane = tid & 63; asm volatile("" : "+s"(w));
    unsigned char* ws = pws(pt);
    const int b = item >> 7, h = (item >> 5) & 3, n = item & 31;
    const size_t rowbase = (size_t)b * SEQ + 64 * n;
    LAS float* VEC = (LAS float*)(lds + DP_VEC);
    __syncthreads();
    { const int i = tid >> 3, c = tid & 7; const int t = 64 * n + i; const size_t R = rowbase + i;
      const bf16_t* pq = (const bf16_t*)(ws + WS_PQKV);
#pragma unroll 1
      for (int mat = 0; mat < 3; ++mat) { const int colb = mat * 512 + h * 128 + 16 * c;
          f32x4 a[4] = {{0.f, 0.f, 0.f, 0.f}, {0.f, 0.f, 0.f, 0.f}, {0.f, 0.f, 0.f, 0.f}, {0.f, 0.f, 0.f, 0.f}};
#pragma unroll
          for (int tap = 0; tap < 4; ++tap) { const int t2 = t + tap - 2;
              if (t2 >= 0 && t2 < SEQ) { const bf16_t* xp = pq + (R + tap - 2) * 1536 + colb; const u32x4 x0 = *(const u32x4*)xp, x1 = *(const u32x4*)(xp + 8);
                  const float* wp = pin(pt, I_DNCW) + ((size_t)layer * 4 + tap) * 1536 + colb; const f32x4 w0 = *(const f32x4*)wp, w1 = *(const f32x4*)(wp + 4), w2 = *(const f32x4*)(wp + 8), w3 = *(const f32x4*)(wp + 12);
                  a[0][0] += w0[0] * bflo(x0.x); a[0][1] += w0[1] * bfhi(x0.x); a[0][2] += w0[2] * bflo(x0.y); a[0][3] += w0[3] * bfhi(x0.y);
                  a[1][0] += w1[0] * bflo(x0.z); a[1][1] += w1[1] * bfhi(x0.z); a[1][2] += w1[2] * bflo(x0.w); a[1][3] += w1[3] * bfhi(x0.w);
                  a[2][0] += w2[0] * bflo(x1.x); a[2][1] += w2[1] * bfhi(x1.x); a[2][2] += w2[2] * bflo(x1.y); a[2][3] += w2[3] * bfhi(x1.y);
                  a[3][0] += w3[0] * bflo(x1.z); a[3][1] += w3[1] * bfhi(x1.z); a[3][2] += w3[2] * bflo(x1.w); a[3][3] += w3[3] * bfhi(x1.w); } }
          float ssq = 0.f;
#pragma unroll
          for (int q = 0; q < 4; ++q)
#pragma unroll
              for (int e = 0; e < 4; ++e) { const float v = a[q][e]; const float s = v * sigm(v); a[q][e] = s; ssq += s * s; }
          float scale = 1.f;
          if (mat < 2) { ssq += __shfl_xor(ssq, 1); ssq += __shfl_xor(ssq, 2); ssq += __shfl_xor(ssq, 4); scale = rsqrtf(ssq + EPS); if (mat == 0) scale *= 0.08838834764831845f; }
          u32x4 o0, o1; o0.x = pk2(a[0][0] * scale, a[0][1] * scale); o0.y = pk2(a[0][2] * scale, a[0][3] * scale); o0.z = pk2(a[1][0] * scale, a[1][1] * scale); o0.w = pk2(a[1][2] * scale, a[1][3] * scale);
          o1.x = pk2(a[2][0] * scale, a[2][1] * scale); o1.y = pk2(a[2][2] * scale, a[2][3] * scale); o1.z = pk2(a[3][0] * scale, a[3][1] * scale); o1.w = pk2(a[3][2] * scale, a[3][3] * scale);
          const int lbase = (mat == 0) ? DP_QL : (mat == 1 ? DP_KL : DP_VL);
          *(LAS u32x4*)(lds + lbase + swz128(i, 16 * c)) = o0; *(LAS u32x4*)(lds + lbase + swz128(i, 16 * c + 8)) = o1;
          if (mat < 2) { bf16_t* gp = (bf16_t*)(ws + (mat == 0 ? WS_QH : WS_KH)) + R * 512 + h * 128 + 16 * c; *(u32x4*)gp = o0; *(u32x4*)(gp + 8) = o1; } }
    }
    if (w == 0) {
        const float* gp = (const float*)(ws + WS_GATES) + (rowbase + lane) * 16;
        const float bF = sigm(gp[h]), bB = sigm(gp[4 + h]);
        float gF = -expf(pin(pt, I_ALOG)[layer * 8 + h]) * softplus_f(gp[8 + h] + pin(pt, I_DTB)[layer * 8 + h]);
        float gB = -expf(pin(pt, I_ALOG)[layer * 8 + 4 + h]) * softplus_f(gp[12 + h] + pin(pt, I_DTB)[layer * 8 + 4 + h]);
#pragma unroll
        for (int off = 1; off < 64; off <<= 1) { const float v = __shfl_up(gF, off); if (lane >= off) gF += v; const float u = __shfl_down(gB, off); if (lane + off < 64) gB += u; }
        const float glF = __shfl(gF, 63), glB = __shfl(gB, 0);
        VEC[lane] = bF; VEC[64 + lane] = gF; VEC[128 + lane] = bB; VEC[192 + lane] = gB;
        float* v0 = (float*)(ws + WS_VEC) + (size_t)item * 256; float* v1 = v0 + (size_t)4096 * 256;
        v0[lane] = bF; v0[64 + lane] = fexp(gF); v0[128 + lane] = fexp(glF - gF); if (lane == 0) v0[192] = fexp(glF);
        v1[lane] = bB; v1[64 + lane] = fexp(gB); v1[128 + lane] = fexp(glB - gB); if (lane == 0) v1[192] = fexp(glB);
    }
    __syncthreads();
    { const int e = tid >> 2, jq = tid & 3; unsigned vv[8];
#pragma unroll
      for (int p = 0; p < 8; ++p) { const unsigned lo = *(const LAS unsigned short*)(lds + DP_VL + swz128(16 * jq + 2 * p, e)), hi = *(const LAS unsigned short*)(lds + DP_VL + swz128(16 * jq + 2 * p + 1, e)); vv[p] = lo | (hi << 16); }
      bf16_t* gp = (bf16_t*)(ws + WS_VT) + (size_t)item * 8192 + e * 64 + 16 * jq;
      *(u32x4*)gp = (u32x4){vv[0], vv[1], vv[2], vv[3]}; *(u32x4*)(gp + 8) = (u32x4){vv[4], vv[5], vv[6], vv[7]}; }
    const int r32 = lane & 31, hi = lane >> 5;
    { const int kind = w >> 2, q = w & 3, ta = q >> 1, tb = q & 1;
      f32x16 acc; for (int r = 0; r < 16; ++r) acc[r] = 0.f;
      const int bbase = kind ? DP_QL : DP_KL;
#pragma unroll
      for (int ks = 0; ks < 8; ++ks) { const bf16x8 av = *(const LAS bf16x8*)(lds + DP_KL + swz128(32 * ta + r32, 16 * ks + 8 * hi)), bv = *(const LAS bf16x8*)(lds + bbase + swz128(32 * tb + r32, 16 * ks + 8 * hi)); acc = MFMA32(av, bv, acc); }
      const int gb = 32 * tb + r32;
#pragma unroll
      for (int dir = 0; dir < 2; ++dir) { const LAS float* bet = VEC + dir * 128; const LAS float* gc = VEC + dir * 128 + 64;
          const float gcl = gc[gb], betl = bet[gb];
#pragma unroll
          for (int g = 0; g < 4; ++g) { const int ga0 = 32 * ta + 8 * g + 4 * hi; const f32x4 gca = *(const LAS f32x4*)(gc + ga0), bea = *(const LAS f32x4*)(bet + ga0);
              if (kind == 0) { f32x4 xv, yv, pv;
#pragma unroll
                  for (int jj = 0; jj < 4; ++jj) { const int ga = ga0 + jj; const float kk = acc[4 * g + jj];
                      const bool mx = dir ? (gb < ga) : (gb > ga), my = dir ? (ga < gb) : (ga > gb);
                      xv[jj] = mx ? (-betl * kk * fexp(gcl - gca[jj])) : 0.f; yv[jj] = my ? (-bea[jj] * kk * fexp(gca[jj] - gcl)) : 0.f; pv[jj] = (ga == gb) ? 1.f : 0.f; }
                  LAS unsigned char* bb = lds + DP_BUF0 + dir * 24576 + swz64(gb, ga0);
                  *(LAS u32x2*)bb = pk4(xv); *(LAS u32x2*)(bb + 8192) = pk4(yv); *(LAS u32x2*)(bb + 16384) = pk4(pv);
              } else { f32x4 av4;
#pragma unroll
                  for (int jj = 0; jj < 4; ++jj) { const int ga = ga0 + jj; const bool ma = dir ? (gb <= ga) : (gb >= ga); av4[jj] = ma ? (acc[4 * g + jj] * fexp(gcl - gca[jj])) : 0.f; }
                  *(u32x2*)((bf16_t*)(ws + WS_AT) + ((size_t)dir * 4096 + item) * 4096 + gb * 64 + ga0) = pk4(av4); } } }
    }
    __syncthreads();
    { const int dir = w >> 2, q = w & 3, ti = q >> 1, tj = q & 1;
      f32x16 pacc; for (int r = 0; r < 16; ++r) pacc[r] = (32 * tj + crow(r, hi) == 32 * ti + r32) ? 1.f : 0.f;
#pragma unroll 1
      for (int rd = 0; rd < 6; ++rd) { LAS unsigned char* cur = lds + ((rd & 1) ? DP_BUF1 : DP_BUF0) + dir * 24576; LAS unsigned char* nxt = lds + ((rd & 1) ? DP_BUF0 : DP_BUF1) + dir * 24576;
          bf16x8 xf[4], yf[4], pf[4];
#pragma unroll
          for (int ks = 0; ks < 4; ++ks) { xf[ks] = *(const LAS bf16x8*)(cur + swz64(32 * ti + r32, 16 * ks + 8 * hi)); yf[ks] = *(const LAS bf16x8*)(cur + 8192 + swz64(32 * tj + r32, 16 * ks + 8 * hi)); pf[ks] = *(const LAS bf16x8*)(cur + 16384 + swz64(32 * ti + r32, 16 * ks + 8 * hi)); }
#pragma unroll
          for (int ks = 0; ks < 4; ++ks) pacc = MFMA32(yf[ks], pf[ks], pacc);
          if (rd < 5) { f32x16 xa, ya; for (int r = 0; r < 16; ++r) { xa[r] = 0.f; ya[r] = 0.f; }
#pragma unroll
              for (int ks = 0; ks < 4; ++ks) { xa = MFMA32(yf[ks], xf[ks], xa); ya = MFMA32(xf[ks], yf[ks], ya); }
#pragma unroll
              for (int g = 0; g < 4; ++g) { const int c0 = 8 * g + 4 * hi;
                  *(LAS u32x2*)(nxt + swz64(32 * ti + r32, 32 * tj + c0)) = pk4((f32x4){xa[4 * g], xa[4 * g + 1], xa[4 * g + 2], xa[4 * g + 3]});
                  *(LAS u32x2*)(nxt + 8192 + swz64(32 * tj + r32, 32 * ti + c0)) = pk4((f32x4){ya[4 * g], ya[4 * g + 1], ya[4 * g + 2], ya[4 * g + 3]});
                  *(LAS u32x2*)(nxt + 16384 + swz64(32 * ti + r32, 32 * tj + c0)) = pk4((f32x4){pacc[4 * g], pacc[4 * g + 1], pacc[4 * g + 2], pacc[4 * g + 3]}); }
              __syncthreads(); } }
      bf16_t* tg = (bf16_t*)(ws + WS_TM) + ((size_t)dir * 4096 + item) * 4096 + (32 * ti + r32) * 64 + 32 * tj + 4 * hi;
#pragma unroll
      for (int g = 0; g < 4; ++g) *(u32x2*)(tg + 8 * g) = pk4((f32x4){pacc[4 * g], pacc[4 * g + 1], pacc[4 * g + 2], pacc[4 * g + 3]});
    }
}

constexpr int DR_K = 0, DR_Q = 16384, DR_KT = 32768, DR_VT = 49152, DR_T = 65536, DR_A = 73728, DR_VEC = 81920, DR_PRIV = 83968;
__device__ __forceinline__ void dr_item(PT pt, LAS unsigned char* lds, int item, int tid, int lane, int w) {
    asm volatile("" : "+v"(tid)); lane = tid & 63; asm volatile("" : "+s"(w));
    unsigned char* ws = pws(pt);
    const int dir = item & 1, h = (item >> 1) & 3, b = item >> 3;
    const int fr = lane & 15, fq = lane >> 4, es = 16 * w;
    LAS unsigned char* ST = lds + DR_PRIV + w * 8192; LAS unsigned char* RV = ST + 4096; LAS unsigned char* VN2 = ST + 6144;
    const LAS float* VEC = (const LAS float*)(lds + DR_VEC);
    const bf16_t* kh = (const bf16_t*)(ws + WS_KH) + (size_t)b * SEQ * 512 + h * 128;
    const bf16_t* qh = (const bf16_t*)(ws + WS_QH) + (size_t)b * SEQ * 512 + h * 128;
    const int ibase = (b * 4 + h) * 32;
    const bf16_t* vt = (const bf16_t*)(ws + WS_VT) + (size_t)ibase * 8192;
    const bf16_t* tm = (const bf16_t*)(ws + WS_TM) + ((size_t)dir * 4096 + ibase) * 4096;
    const bf16_t* at = (const bf16_t*)(ws + WS_AT) + ((size_t)dir * 4096 + ibase) * 4096;
    const float* vecs = (const float*)(ws + WS_VEC) + ((size_t)dir * 4096 + ibase) * 256;
    bf16_t* og = (bf16_t*)(ws + (dir ? WS_OB : WS_OF)) + (size_t)b * SEQ * 512 + h * 128 + es + fr;
    u32x4 pk[2], pq[2], pv[2], ptm, pa; f32x4 pvec = {0.f, 0.f, 0.f, 0.f};
#define DR_LOAD(nn) do { _Pragma("unroll") for (int u_ = 0; u_ < 2; ++u_) { const int p_ = tid + 512 * u_; \
        pk[u_] = *(const u32x4*)(kh + (size_t)(64 * (nn) + (p_ >> 4)) * 512 + 8 * (p_ & 15)); pq[u_] = *(const u32x4*)(qh + (size_t)(64 * (nn) + (p_ >> 4)) * 512 + 8 * (p_ & 15)); \
        pv[u_] = *(const u32x4*)(vt + (size_t)(nn) * 8192 + p_ * 8); } \
        ptm = *(const u32x4*)(tm + (size_t)(nn) * 4096 + tid * 8); pa = *(const u32x4*)(at + (size_t)(nn) * 4096 + tid * 8); \
        if (tid < 64) pvec = *(const f32x4*)(vecs + (size_t)(nn) * 256 + 4 * tid); } while (0)
#define DR_STORE() do { _Pragma("unroll") for (int u_ = 0; u_ < 2; ++u_) { const int p_ = tid + 512 * u_; const int j_ = p_ >> 4, q_ = p_ & 15; \
        *(LAS u32x4*)(lds + DR_K + swz128(j_, 8 * q_)) = pk[u_]; *(LAS u32x4*)(lds + DR_Q + swz128(j_, 8 * q_)) = pq[u_]; \
        *(LAS unsigned short*)(lds + DR_KT + swz64(8 * q_ + 0, j_)) = (unsigned short)(pk[u_].x & 0xffffu); *(LAS unsigned short*)(lds + DR_KT + swz64(8 * q_ + 1, j_)) = (unsigned short)(pk[u_].x >> 16); \
        *(LAS unsigned short*)(lds + DR_KT + swz64(8 * q_ + 2, j_)) = (unsigned short)(pk[u_].y & 0xffffu); *(LAS unsigned short*)(lds + DR_KT + swz64(8 * q_ + 3, j_)) = (unsigned short)(pk[u_].y >> 16); \
        *(LAS unsigned short*)(lds + DR_KT + swz64(8 * q_ + 4, j_)) = (unsigned short)(pk[u_].z & 0xffffu); *(LAS unsigned short*)(lds + DR_KT + swz64(8 * q_ + 5, j_)) = (unsigned short)(pk[u_].z >> 16); \
        *(LAS unsigned short*)(lds + DR_KT + swz64(8 * q_ + 6, j_)) = (unsigned short)(pk[u_].w & 0xffffu); *(LAS unsigned short*)(lds + DR_KT + swz64(8 * q_ + 7, j_)) = (unsigned short)(pk[u_].w >> 16); \
        *(LAS u32x4*)(lds + DR_VT + swz64(p_ >> 3, 8 * (p_ & 7))) = pv[u_]; } \
        *(LAS u32x4*)(lds + DR_T + swz64(tid >> 3, 8 * (tid & 7))) = ptm; *(LAS u32x4*)(lds + DR_A + swz64(tid >> 3, 8 * (tid & 7))) = pa; \
        if (tid < 64) *(LAS f32x4*)(lds + DR_VEC + 16 * tid) = pvec; } while (0)
    __syncthreads();
    DR_LOAD(dir ? 31 : 0);
    DR_STORE();
#pragma unroll
    for (int q = 0; q < 4; ++q) *(LAS u32x4*)(ST + lane * 64 + q * 16) = (u32x4){0u, 0u, 0u, 0u};
    f32x4 Sacc[8];
#pragma unroll
    for (int d = 0; d < 8; ++d) Sacc[d] = (f32x4){0.f, 0.f, 0.f, 0.f};
    __syncthreads();
#pragma unroll 1
    for (int cc = 0; cc < 32; ++cc) { const int n = dir ? (31 - cc) : cc;
        if (cc + 1 < 32) DR_LOAD(dir ? (30 - cc) : (cc + 1));
        bf16x8 sb[4];
#pragma unroll
        for (int ks = 0; ks < 4; ++ks) sb[ks] = *(const LAS bf16x8*)(ST + swz128(fr, 32 * ks + 8 * fq));
        f32x4 oacc[4];
#pragma unroll
        for (int it = 0; it < 4; ++it) { f32x4 ka = {0.f, 0.f, 0.f, 0.f}, qa = {0.f, 0.f, 0.f, 0.f};
#pragma unroll
            for (int ks = 0; ks < 4; ++ks) { const bf16x8 a1 = *(const LAS bf16x8*)(lds + DR_K + swz128(16 * it + fr, 32 * ks + 8 * fq)), a2 = *(const LAS bf16x8*)(lds + DR_Q + swz128(16 * it + fr, 32 * ks + 8 * fq));
                ka = MFMA16(a1, sb[ks], ka); qa = MFMA16(a2, sb[ks], qa); }
            const int i0 = 16 * it + 4 * fq; const f32x4 be = *(const LAS f32x4*)(VEC + i0), eg = *(const LAS f32x4*)(VEC + 64 + i0);
            const u32x2 vv = *(const LAS u32x2*)(lds + DR_VT + swz64(es + fr, i0));
            f32x4 rh; rh[0] = be[0] * (bflo(vv.x) - eg[0] * ka[0]); rh[1] = be[1] * (bfhi(vv.x) - eg[1] * ka[1]); rh[2] = be[2] * (bflo(vv.y) - eg[2] * ka[2]); rh[3] = be[3] * (bfhi(vv.y) - eg[3] * ka[3]);
            *(LAS u32x2*)(RV + swz64(fr, i0)) = pk4(rh);
            oacc[it] = qa * eg; }
        bf16x8 rb2[2];
#pragma unroll
        for (int ks = 0; ks < 2; ++ks) rb2[ks] = *(const LAS bf16x8*)(RV + swz64(fr, 32 * ks + 8 * fq));
        f32x4 vn[4];
#pragma unroll
        for (int it = 0; it < 4; ++it) { vn[it] = (f32x4){0.f, 0.f, 0.f, 0.f};
#pragma unroll
            for (int ks = 0; ks < 2; ++ks) { const bf16x8 a1 = *(const LAS bf16x8*)(lds + DR_T + swz64(16 * it + fr, 32 * ks + 8 * fq)); vn[it] = MFMA16(a1, rb2[ks], vn[it]); } }
#pragma unroll
        for (int it = 0; it < 4; ++it) { const int i0 = 16 * it + 4 * fq; const f32x4 ed = *(const LAS f32x4*)(VEC + 128 + i0);
            *(LAS u32x2*)(RV + swz64(fr, i0)) = pk4(vn[it]); *(LAS u32x2*)(VN2 + swz64(fr, i0)) = pk4(vn[it] * ed); }
        bf16x8 vb[2], vb2[2];
#pragma unroll
        for (int ks = 0; ks < 2; ++ks) { vb[ks] = *(const LAS bf16x8*)(RV + swz64(fr, 32 * ks + 8 * fq)); vb2[ks] = *(const LAS bf16x8*)(VN2 + swz64(fr, 32 * ks + 8 * fq)); }
#pragma unroll
        for (int it = 0; it < 4; ++it)
#pragma unroll
            for (int ks = 0; ks < 2; ++ks) { const bf16x8 a1 = *(const LAS bf16x8*)(lds + DR_A + swz64(16 * it + fr, 32 * ks + 8 * fq)); oacc[it] = MFMA16(a1, vb[ks], oacc[it]); }
        const float cdec = VEC[192];
#pragma unroll
        for (int dt = 0; dt < 8; ++dt) { Sacc[dt] = Sacc[dt] * cdec;
#pragma unroll
            for (int ks = 0; ks < 2; ++ks) { const bf16x8 a1 = *(const LAS bf16x8*)(lds + DR_KT + swz64(16 * dt + fr, 32 * ks + 8 * fq)); Sacc[dt] = MFMA16(a1, vb2[ks], Sacc[dt]); }
            *(LAS u32x2*)(ST + swz128(fr, 16 * dt + 4 * fq)) = pk4(Sacc[dt]); }
#pragma unroll
        for (int it = 0; it < 4; ++it)
#pragma unroll
            for (int jj = 0; jj < 4; ++jj) og[(size_t)(64 * n + 16 * it + 4 * fq + jj) * 512] = (bf16_t)(pk2(oacc[it][jj], 0.f) & 0xffffu);
        __syncthreads();
        if (cc + 1 < 32) DR_STORE();
        __syncthreads();
    }
#undef DR_LOAD
#undef DR_STORE
}

__device__ __forceinline__ void m2_rows(PT pt, int layer, int gw, int NGW, int lane) {
    asm volatile("" : "+v"(lane));
    unsigned char* ws = pws(pt);
    const bf16_t* of = (const bf16_t*)(ws + WS_OF); const bf16_t* ob = (const bf16_t*)(ws + WS_OB); const bf16_t* pz = (const bf16_t*)(ws + WS_PZ);
    const bf16_t* hf = (const bf16_t*)(ws + WS_HF); const bf16_t* hb = (const bf16_t*)(ws + WS_HB); const bf16_t* plg = (const bf16_t*)(ws + WS_PLG);
    bf16_t* amix = (bf16_t*)(ws + WS_AMIX);
    const float* dng = pin(pt, I_DNG) + layer * 128 + 8 * (lane & 15); const float* lng = pin(pt, I_LNG) + layer * 512 + 8 * lane;
    const f32x4 dg0 = *(const f32x4*)dng, dg1 = *(const f32x4*)(dng + 4), lg0 = *(const f32x4*)lng, lg1 = *(const f32x4*)(lng + 4);
    for (int m = gw; m < M_TOK; m += NGW) { const size_t o = (size_t)m * 512 + 8 * lane;
        const u32x4 a = *(const u32x4*)(of + o), b2 = *(const u32x4*)(ob + o), z = *(const u32x4*)(pz + o);
        const u32x4 c = *(const u32x4*)(hf + o), d = *(const u32x4*)(hb + o), g = *(const u32x4*)(plg + o);
        float v[8], y[8];
        v[0] = bflo(a.x) + bflo(b2.x); v[1] = bfhi(a.x) + bfhi(b2.x); v[2] = bflo(a.y) + bflo(b2.y); v[3] = bfhi(a.y) + bfhi(b2.y);
        v[4] = bflo(a.z) + bflo(b2.z); v[5] = bfhi(a.z) + bfhi(b2.z); v[6] = bflo(a.w) + bflo(b2.w); v[7] = bfhi(a.w) + bfhi(b2.w);
        float s1 = 0.f;
#pragma unroll
        for (int e = 0; e < 8; ++e) s1 += v[e] * v[e];
        s1 += __shfl_xor(s1, 1); s1 += __shfl_xor(s1, 2); s1 += __shfl_xor(s1, 4); s1 += __shfl_xor(s1, 8);
        const float r1 = rsqrtf(s1 * (1.0f / 128.0f) + EPS);
        float zz[8] = {bflo(z.x), bfhi(z.x), bflo(z.y), bfhi(z.y), bflo(z.z), bfhi(z.z), bflo(z.w), bfhi(z.w)};
        float gg[8] = {bflo(g.x), bfhi(g.x), bflo(g.y), bfhi(g.y), bflo(g.z), bfhi(g.z), bflo(g.w), bfhi(g.w)};
        float hh[8] = {bflo(c.x) + bflo(d.x), bfhi(c.x) + bfhi(d.x), bflo(c.y) + bflo(d.y), bfhi(c.y) + bfhi(d.y), bflo(c.z) + bflo(d.z), bfhi(c.z) + bfhi(d.z), bflo(c.w) + bflo(d.w), bfhi(c.w) + bfhi(d.w)};
        float s2 = 0.f;
#pragma unroll
        for (int e = 0; e < 8; ++e) { const float dgv = e < 4 ? dg0[e & 3] : dg1[e & 3]; v[e] = v[e] * r1 * dgv * (zz[e] * sigm(zz[e])); y[e] = gelu_t(gg[e]) * hh[e]; s2 += y[e] * y[e]; }
#pragma unroll
        for (int o2 = 1; o2 < 64; o2 <<= 1) s2 += __shfl_xor(s2, o2);
        const float r2 = rsqrtf(s2 * (1.0f / 512.0f) + EPS);
#pragma unroll
        for (int e = 0; e < 8; ++e) { const float lgv = e < 4 ? lg0[e & 3] : lg1[e & 3]; y[e] = y[e] * r2 * lgv; }
        u32x4 w1, w2; w1.x = pk2(v[0], v[1]); w1.y = pk2(v[2], v[3]); w1.z = pk2(v[4], v[5]); w1.w = pk2(v[6], v[7]);
        w2.x = pk2(y[0], y[1]); w2.y = pk2(y[2], y[3]); w2.z = pk2(y[4], y[5]); w2.w = pk2(y[6], y[7]);
        *(u32x4*)(amix + (size_t)m * 1024 + 8 * lane) = w1; *(u32x4*)(amix + (size_t)m * 1024 + 512 + 8 * lane) = w2; }
}

#ifndef PHMASK
#define PHMASK 0xFFFF
#endif
#ifndef DUPMASK
#define DUPMASK 0
#endif
#define PH(k) _Pragma("unroll 1") for (int rep_ = 0; rep_ < ((((PHMASK >> (k)) & 1) ? 1 : 0) + (((DUPMASK >> (k)) & 1) ? 1 : 0)); ++rep_)
#define RB_ ((bf16_t*)(pws(pt) + WS_RB))
#define RBN_ ((bf16_t*)(pws(pt) + WS_ACT))
#define SS_(k) ((u64*)(pws(pt) + WS_SSP) + (size_t)(k) * M_TOK)
__global__ void __launch_bounds__(512, 2) fwd_kernel(Params P) {
    extern __shared__ __attribute__((aligned(16))) unsigned char lds_raw[];
    LAS unsigned char* lds = (LAS unsigned char*)lds_raw;
    cg::grid_group grid = cg::this_grid();
    const int tid = threadIdx.x, lane = tid & 63, wave = __builtin_amdgcn_readfirstlane(tid >> 6);
    const int G = gridDim.x, bx = blockIdx.x; const int gw = bx * 8 + wave, NGW = G * 8;
    PT pt = (PT)(lds + LDS_BYTES - 256);
    if (tid == 0) {
#pragma unroll
        for (int i = 0; i < 28; ++i) { const unsigned long long v = (unsigned long long)P.in[i]; pt[2 * i] = (unsigned)v; pt[2 * i + 1] = (unsigned)(v >> 32); }
        { const unsigned long long v = (unsigned long long)P.out; pt[56] = (unsigned)v; pt[57] = (unsigned)(v >> 32); }
        { const unsigned long long v = (unsigned long long)P.ws; pt[58] = (unsigned)v; pt[59] = (unsigned)(v >> 32); }
    }
    __syncthreads();

    PH(0) prologue(pt, lds, gw, NGW, lane, wave);
    __syncthreads();
    grid.sync();

#pragma unroll 1
    for (int layer = 0; layer < NL; ++layer) {
        PH(1) { pg8::Gemm g{layer == 0 ? RB_ : RBN_, (const bf16_t*)(pws(pt) + WS_WIN) + (size_t)layer * 3328 * 1024, M_TOK, 2304, 1024}; pg8::StaticOrder S; S.init(M_TOK, 2304, G, bx);
          EpiStore E{SS_(3 * layer), (bf16_t*)(pws(pt) + WS_PQKV), 1536, (bf16_t*)(pws(pt) + WS_PLX), 512, 6, (float*)(pws(pt) + WS_GATES), 8};
          pg8::gemm_phase<EpiStore, pg8::StaticOrder, true, true>(lds, g, S, E);
          int tl = tid; asm volatile("" : "+v"(tl));
          const f32x4* ps = (const f32x4*)(pin(pt, I_P) + (size_t)layer * M_TOK * PLE); u32x2* pd = (u32x2*)(pws(pt) + WS_PB);
          for (size_t i = (size_t)bx * 512 + tl; i < (size_t)M_TOK * PLE / 4; i += (size_t)G * 512) pd[i] = pk4(ps[i]);
          if (layer > 0) { const u32x4* cs = (const u32x4*)RBN_; u32x4* cd = (u32x4*)RB_;
              for (size_t i = (size_t)bx * 512 + tl; i < (size_t)M_TOK * DM / 8; i += (size_t)G * 512) cd[i] = cs[i]; } }
        __syncthreads(); grid.sync();
        PH(2) for (int wi = gw; wi < 2048; wi += NGW) lru_wave(pt, lds + wave * 16384, wi, layer, lane);
        PH(3) for (int it = bx; it < 4096; it += G) dp_item(pt, lds, it, layer, tid, lane, wave);
        __syncthreads(); grid.sync();
        PH(4) for (int it = bx; it < 256; it += G) dr_item(pt, lds, it, tid, lane, wave);
        __syncthreads();
        PH(5) { pg8::Gemm g{RB_, (const bf16_t*)(pws(pt) + WS_WIN) + ((size_t)layer * 3328 + 2304) * 1024, M_TOK, 1024, 1024}; pg8::StaticOrder S; S.init(M_TOK, 1024, G, bx);
          EpiStore E{SS_(3 * layer), (bf16_t*)(pws(pt) + WS_PZ), 512, (bf16_t*)(pws(pt) + WS_PLG), 512, 2, nullptr, 99};
          pg8::gemm_phase<EpiStore, pg8::StaticOrder, true, true>(lds, g, S, E); }
        __syncthreads(); grid.sync();
        PH(6) m2_rows(pt, layer, gw, NGW, lane);
        __syncthreads(); grid.sync();
        PH(7) { pg8::Gemm g{(const bf16_t*)(pws(pt) + WS_AMIX), (const bf16_t*)(pws(pt) + WS_WOUT) + (size_t)layer * DM * DM, M_TOK, 1024, 1024}; pg8::StaticOrder S; S.init(M_TOK, 1024, G, bx);
          EpiResid<0> E{layer == 0 ? pin(pt, I_X) : pout(pt), pout(pt), RB_, SS_(3 * layer + 1), nullptr, nullptr, nullptr};
          pg8::gemm_phase<EpiResid<0>, pg8::StaticOrder, true, true>(lds, g, S, E); }
        __syncthreads(); grid.sync();
        PH(8) { pg8::Gemm g{RB_, (const bf16_t*)(pws(pt) + WS_WG) + (size_t)layer * FF * DM, M_TOK, FF, 1024}; pg8::StaticOrder S; S.init(M_TOK, FF, G, bx);
          EpiStore E{SS_(3 * layer + 1), (bf16_t*)(pws(pt) + WS_G), FF, nullptr, 0, 99, nullptr, 99};
          pg8::gemm_phase<EpiStore, pg8::StaticOrder, true, true>(lds, g, S, E); }
        __syncthreads(); grid.sync();
        PH(9) { pg8::Gemm g{RB_, (const bf16_t*)(pws(pt) + WS_WU) + (size_t)layer * FF * DM, M_TOK, FF, 1024}; pg8::StaticOrder S; S.init(M_TOK, FF, G, bx);
          EpiGlu E{SS_(3 * layer + 1), (const bf16_t*)(pws(pt) + WS_G), pin(pt, I_FCW) + (size_t)layer * 3 * FF, pin(pt, I_FCB) + (size_t)layer * FF, (bf16_t*)(pws(pt) + WS_ACT)};
          pg8::gemm_phase<EpiGlu, pg8::StaticOrder, true, true>(lds, g, S, E); }
        __syncthreads(); grid.sync();
        PH(10) { pg8::Gemm g{(const bf16_t*)(pws(pt) + WS_ACT), (const bf16_t*)(pws(pt) + WS_WD) + (size_t)layer * DM * FF, M_TOK, 1024, FF}; pg8::StaticOrder S; S.init(M_TOK, 1024, G, bx);
          EpiResid<0> E{pout(pt), pout(pt), RB_, SS_(3 * layer + 2), nullptr, nullptr, nullptr};
          pg8::gemm_phase<EpiResid<0>, pg8::StaticOrder, true, true>(lds, g, S, E); }
        __syncthreads();
        PH(11) { pg8::Gemm g{(const bf16_t*)(pws(pt) + WS_PB), (const bf16_t*)(pws(pt) + WS_WP) + (size_t)layer * DM * PLE, M_TOK, 1024, PLE}; pg8::StaticOrder S; S.init(M_TOK, 1024, G, bx);
          EpiStore E{nullptr, (bf16_t*)(pws(pt) + WS_PP), 1024, nullptr, 0, 99, nullptr, 99};
          pg8::gemm_phase<EpiStore, pg8::StaticOrder, true, true>(lds, g, S, E); }
        __syncthreads(); grid.sync();
        PH(12) { pg8::Gemm g{RB_, (const bf16_t*)(pws(pt) + WS_WPG) + (size_t)layer * DM * DM, M_TOK, 1024, 1024}; pg8::StaticOrder S; S.init(M_TOK, 1024, G, bx);
          EpiResid<1> E{pout(pt), pout(pt), RBN_, SS_(3 * layer + 3), SS_(3 * layer + 2), pin(pt, I_PBG) + (size_t)layer * DM, (const bf16_t*)(pws(pt) + WS_PP)};
          pg8::gemm_phase<EpiResid<1>, pg8::StaticOrder, true, true>(lds, g, S, E); }
        __syncthreads(); grid.sync();
    }
    { const u64* ssF = SS_(12); const f32x4* fg = (const f32x4*)pin(pt, I_FING) + lane;
      for (int m = gw; m < M_TOK; m += NGW) { const float s = rs_of(ssF, m); f32x4* xr = (f32x4*)(pout(pt) + (size_t)m * DM) + lane;
#pragma unroll
          for (int j = 0; j < 4; ++j) xr[64 * j] = xr[64 * j] * s * fg[64 * j]; } }
}

extern "C" void kernel_launch(void* const* d_in, const int* in_sizes, int n_in, void* d_out, int out_size, void* d_ws, size_t ws_size, hipStream_t stream) {
    static int grid = 0;
    if (grid == 0) {
        if (n_in != 28 || ws_size < WS_END) { fprintf(stderr, "kernel_launch: unexpected n_in %d or workspace %zu < %zu\n", n_in, ws_size, (size_t)WS_END); grid = -1; return; }
        int dev = 0, cus = 0, per_cu = 0;
        hipGetDevice(&dev); hipDeviceGetAttribute(&cus, hipDeviceAttributeMultiprocessorCount, dev);
        if (hipFuncSetAttribute((const void*)fwd_kernel, hipFuncAttributeMaxDynamicSharedMemorySize, LDS_BYTES) != hipSuccess) fprintf(stderr, "kernel_launch: hipFuncSetAttribute failed\n");
        if (hipOccupancyMaxActiveBlocksPerMultiprocessor(&per_cu, (const void*)fwd_kernel, 512, LDS_BYTES) != hipSuccess || per_cu < 1) { fprintf(stderr, "kernel_launch: occupancy query says %d\n", per_cu); per_cu = 1; }
        (void)hipGetLastError();
        grid = cus * per_cu; if (grid > 256) grid = 256;
    }
    if (grid < 0) return;
    Params p{};
    for (int i = 0; i < 28; ++i) p.in[i] = (const float*)d_in[i];
    p.out = (float*)d_out; p.ws = (unsigned char*)d_ws;
    void* args[] = {&p};
    hipError_t e = hipLaunchCooperativeKernel((const void*)fwd_kernel, dim3(grid), dim3(512), args, LDS_BYTES, stream);
    if (e != hipSuccess) fprintf(stderr, "cooperative launch failed: %s (grid %d)\n", hipGetErrorString(e), grid);
}
```

```cpp
#include <hip/hip_runtime.h>
#include <hip/hip_cooperative_groups.h>
#include <cstdio>
#include <cstdint>
namespace cg = cooperative_groups;

#define LAS __attribute__((address_space(3)))
typedef unsigned short bf16_t;
typedef short bf16x8 __attribute__((ext_vector_type(8)));
typedef short s16x4 __attribute__((ext_vector_type(4)));
typedef float f32x2 __attribute__((ext_vector_type(2)));
typedef float f32x4 __attribute__((ext_vector_type(4)));
typedef float f32x16 __attribute__((ext_vector_type(16)));
typedef unsigned u32x4 __attribute__((ext_vector_type(4)));
typedef unsigned u32x2 __attribute__((ext_vector_type(2)));
typedef __bf16 bfx2_t __attribute__((ext_vector_type(2)));

constexpr int M_TOK = 65536, DM = 1024, SEQ = 2048, NB = 32, NL = 4;
constexpr int FF = 2816, PLE = 256, INC = 3088;
constexpr float EPS = 1e-6f;

constexpr size_t MiB = 1u << 20;
constexpr size_t WS_SS = 0;
constexpr size_t WS_WIN = 4 * MiB;
constexpr size_t WS_WOUT = WS_WIN + 26 * MiB;
constexpr size_t WS_WG = WS_WOUT + 8 * MiB;
constexpr size_t WS_WU = WS_WG + 22 * MiB;
constexpr size_t WS_WD = WS_WU + 22 * MiB;
constexpr size_t WS_WPG = WS_WD + 22 * MiB;
constexpr size_t WS_WP = WS_WPG + 8 * MiB;
constexpr size_t WS_WAT = WS_WP + 2 * MiB;
constexpr size_t WS_GATES = WS_WAT + 1 * MiB;
constexpr size_t WS_VEC = WS_GATES + 4 * MiB;
constexpr size_t WS_PB = WS_VEC + 8 * MiB;
constexpr size_t WS_RB = WS_PB + 32 * MiB;
constexpr size_t WS_BIG = WS_RB + 128 * MiB;
constexpr size_t WS_PQKV = WS_BIG;
constexpr size_t WS_OF = WS_BIG, WS_OB = WS_BIG + 64 * MiB, WS_PZ = WS_BIG + 128 * MiB;
constexpr size_t WS_PLX = WS_BIG + 192 * MiB, WS_PLG = WS_BIG + 192 * MiB;
constexpr size_t WS_QH = WS_BIG + 256 * MiB, WS_KH = WS_BIG + 320 * MiB, WS_VT = WS_BIG + 384 * MiB;
constexpr size_t WS_TM = WS_BIG + 448 * MiB, WS_AT = WS_BIG + 512 * MiB;
constexpr size_t WS_HF = WS_BIG + 576 * MiB, WS_HB = WS_BIG + 640 * MiB;
constexpr size_t WS_AMIX = WS_BIG + 256 * MiB;
constexpr size_t WS_G = WS_BIG, WS_ACT = WS_BIG + 352 * MiB, WS_PP = WS_BIG;
constexpr size_t WS_SSP = WS_BIG + 704 * MiB;
constexpr size_t WS_END = WS_SSP + 12 * MiB;
constexpr int LDS_BYTES = 153600;

__device__ __forceinline__ unsigned pk2(float lo, float hi) { f32x2 v = {lo, hi}; bfx2_t b = __builtin_convertvector(v, bfx2_t); return __builtin_bit_cast(unsigned, b); }
__device__ __forceinline__ u32x2 pk4(f32x4 v) { u32x2 r; r.x = pk2(v[0], v[1]); r.y = pk2(v[2], v[3]); return r; }
__device__ __forceinline__ float bflo(unsigned w) { return __uint_as_float(w << 16); }
__device__ __forceinline__ float bfhi(unsigned w) { return __uint_as_float(w & 0xffff0000u); }
__device__ __forceinline__ float bf2f(unsigned short b) { return __uint_as_float((unsigned)b << 16); }
__device__ __forceinline__ float fexp(float x) { return __builtin_amdgcn_exp2f(x * 1.4426950408889634f); }
__device__ __forceinline__ float sigm(float x) { return __builtin_amdgcn_rcpf(1.0f + fexp(-x)); }
__device__ __forceinline__ float gelu_t(float x) { const float u = 1.5957691216057308f * (x + 0.044715f * x * x * x); return x * __builtin_amdgcn_rcpf(1.0f + fexp(-u)); }
__device__ __forceinline__ float softplus_f(float x) { return x > 20.f ? x : log1pf(expf(x)); }
__device__ __forceinline__ int swz128(int row, int col) { return row * 256 + ((((col >> 3) ^ (row & 15)) << 4) | ((col & 7) << 1)); }
__device__ __forceinline__ int swz64(int row, int col) { return row * 128 + ((((col >> 3) ^ (row & 7)) << 4) | ((col & 7) << 1)); }
__device__ __forceinline__ int crow(int r, int hi) { return (r & 3) + 8 * (r >> 2) + 4 * hi; }
#define MFMA16(a, b, c) __builtin_amdgcn_mfma_f32_16x16x32_bf16((a), (b), (c), 0, 0, 0)
#define MFMA32(a, b, c) __builtin_amdgcn_mfma_f32_32x32x16_bf16((a), (b), (c), 0, 0, 0)
typedef unsigned long long u64;
__device__ __forceinline__ u64 ss_fix(float s) { return (u64)(s * 1048576.0f + 0.5f); }
__device__ __forceinline__ float rs_of(const u64* ss, int row) { return rsqrtf((float)ss[row] * (1.0f / (1048576.0f * 1024.0f)) + EPS); }
#define LDS_FENCE() asm volatile("s_waitcnt lgkmcnt(0)" ::: "memory")

namespace pg8 {
#define PG8_LAS __attribute__((address_space(3)))
typedef unsigned short bf16_t;
typedef short bf16x8 __attribute__((ext_vector_type(8)));
typedef float f32x4 __attribute__((ext_vector_type(4)));
typedef unsigned u32x4 __attribute__((ext_vector_type(4)));
constexpr int BM = 256, BK = 64, HALF = 128, HTB = HALF * BK * 2  , STAGE_BYTES = 8 * HTB, NXCD = 8, WGM = 8;

__host__ __device__ __forceinline__ int lds_byte(int r, int c) { const int st = (r >> 4) * 2 + (c >> 5), rr = r & 15, cc = c & 31, ob = rr * 64 + cc * 2; return st * 1024 + (ob ^ (((ob >> 9) & 1) << 5)); }
__host__ __device__ __forceinline__ void stage_rc(int b, int& R, int& C) { const int st = b / 1024, sb = b % 1024, swz = sb ^ (((sb >> 9) & 1) << 5); R = (st >> 1) * 16 + swz / 64; C = (st & 1) * 32 + (swz % 64) / 2; }
__host__ __device__ __forceinline__ int perm32(int rho) { const int n = rho >> 4, i = rho & 15; return 8 * (i >> 2) + 4 * n + (i & 3); }

struct Unit { int pm, pn; };
struct Gemm { const bf16_t* A; const bf16_t* Bt; int M, N, K; };

struct StaticOrder {
    int nM, nN, nwg, G, c;
    __host__ __device__ void init(int M, int N, int G_, int c_) { nM = M / BM; nN = N / BM; nwg = nM * nN; G = G_; c = c_; }
    __host__ __device__ bool next(int i, Unit& u) const {
        const long L = (long)i * G + c; if (L >= nwg) return false;
        int wgid = (int)L; { const int q = nwg / NXCD, r = nwg % NXCD, xcd = wgid % NXCD, off = wgid / NXCD; wgid = (xcd < r ? xcd * (q + 1) : r * (q + 1) + (xcd - r) * q) + off; }
        const int nig = WGM * nN, gid = wgid / nig, fm = gid * WGM, gsz = (nM - fm) < WGM ? (nM - fm) : WGM;
        u.pm = fm + ((wgid % nig) % gsz); u.pn = (wgid % nig) / gsz; return true;
    }
    __device__ __forceinline__ void a_ready(const Unit&) const {}
    __device__ __forceinline__ void done(const Unit&) const {}
};

template <class Epi, class Sched, bool ALIGN_EPI = false, bool SP2 = false>
__device__ __forceinline__ void gemm_phase(PG8_LAS unsigned char* lds, const Gemm g, const Sched& S, const Epi& E) {
    int tid_ = threadIdx.x; asm volatile("" : "+v"(tid_));
    const int tid = tid_, wid = __builtin_amdgcn_readfirstlane(tid >> 6), lane = tid & 63, wr = wid >> 2, wc = wid & 3, fr = lane & 15, fq = lane >> 4;
    const int K = g.K, nt = K / BK;
    unsigned voffA[2], voffB[2];
#pragma unroll
    for (int i = 0; i < 2; ++i) { int R, C; stage_rc(tid * 16 + i * 8192, R, C); const int Rb = Epi::PERM ? ((R & ~31) + perm32(R & 31)) : R;
        voffA[i] = (unsigned)(R * K + C) * 2u; voffB[i] = (unsigned)(Rb * K + C) * 2u; }
    const size_t kstep = (size_t)(BK * 2);
    const size_t hstep = (size_t)HALF * K * 2;
    const size_t tstep = 2 * hstep;
    const unsigned ldsw = (unsigned)wid * 1024u;
    const int aoff = lds_byte(wr * 64 + fr, fq * 8), boff = lds_byte(wc * 32 + fr, fq * 8);
#define PG8_SA(b, h) (((b) * 2 + (h)) * HTB)
#define PG8_SB(b, h) ((4 + (b) * 2 + (h)) * HTB)
#define PG8_STAGE(bufoff, gbase, voff) do { _Pragma("unroll") for (int _i = 0; _i < 2; ++_i) \
        __builtin_amdgcn_global_load_lds((const unsigned*)((const char*)(gbase) + (voff)[_i]), (PG8_LAS unsigned*)(lds + (bufoff) + ldsw + _i * 8192), 16, 0, 0); } while (0)
#define PG8_LDA(dst, b, h) do { _Pragma("unroll") for (int m = 0; m < 4; ++m) _Pragma("unroll") for (int k = 0; k < 2; ++k) dst[m][k] = *(const PG8_LAS bf16x8*)(lds + PG8_SA(b, h) + aoff + m * 2048 + k * 1024); } while (0)
#define PG8_LDB(dst, b, h) do { _Pragma("unroll") for (int n = 0; n < 2; ++n) _Pragma("unroll") for (int k = 0; k < 2; ++k) dst[n][k] = *(const PG8_LAS bf16x8*)(lds + PG8_SB(b, h) + boff + n * 2048 + k * 1024); } while (0)
#define PG8_MMA(ai, bj, At, Bt) do { __builtin_amdgcn_s_setprio(1); _Pragma("unroll") for (int m = 0; m < 4; ++m) _Pragma("unroll") for (int n = 0; n < 2; ++n) _Pragma("unroll") for (int k = 0; k < 2; ++k) \
        acc[ai][bj][m][n] = __builtin_amdgcn_mfma_f32_16x16x32_bf16(Bt[n][k], At[m][k], acc[ai][bj][m][n], 0, 0, 0); __builtin_amdgcn_s_setprio(0); } while (0)
#define PG8_WAIT_V(n) asm volatile("s_waitcnt vmcnt(" #n ")" ::: "memory")
#define PG8_WAIT_L(n) asm volatile("s_waitcnt lgkmcnt(" #n ")" ::: "memory")
#define PG8_BAR __builtin_amdgcn_s_barrier()
#define PG8_SCHED __builtin_amdgcn_sched_barrier(0)
    Unit cur, nxt; int ui = 0;
    if (!S.next(0, cur)) return;
    f32x4 acc[2][2][4][2];
#pragma unroll
    for (int a = 0; a < 2; ++a)
#pragma unroll
        for (int b = 0; b < 2; ++b)
#pragma unroll
            for (int m = 0; m < 4; ++m)
#pragma unroll
                for (int n = 0; n < 2; ++n) acc[a][b][m][n] = (f32x4){0.f, 0.f, 0.f, 0.f};
    bf16x8 At[4][2], B0[2][2], B1[2][2];
    const char* cA = (const char*)g.A + (size_t)cur.pm * tstep; const char* cB = (const char*)g.Bt + (size_t)cur.pn * tstep;
    S.a_ready(cur);
    if constexpr (SP2) {
        PG8_STAGE(PG8_SB(0, 0), cB, voffB); PG8_STAGE(PG8_SB(0, 1), cB + hstep, voffB); PG8_STAGE(PG8_SA(0, 0), cA, voffA); PG8_STAGE(PG8_SA(0, 1), cA + hstep, voffA);
        if (wr == 1) PG8_BAR;
        PG8_WAIT_V(2); PG8_BAR;
        PG8_STAGE(PG8_SB(1, 0), cB + kstep, voffB); PG8_STAGE(PG8_SA(1, 0), cA + kstep, voffA); PG8_STAGE(PG8_SB(1, 1), cB + hstep + kstep, voffB);
        PG8_WAIT_V(6); PG8_BAR;
    } else {
        PG8_STAGE(PG8_SB(0, 0), cB, voffB); PG8_STAGE(PG8_SA(0, 0), cA, voffA); PG8_STAGE(PG8_SB(0, 1), cB + hstep, voffB); PG8_STAGE(PG8_SA(0, 1), cA + hstep, voffA);
        if (wr == 1) PG8_BAR;
        PG8_WAIT_V(4); PG8_BAR;
        PG8_STAGE(PG8_SB(1, 0), cB + kstep, voffB); PG8_STAGE(PG8_SA(1, 0), cA + kstep, voffA); PG8_STAGE(PG8_SB(1, 1), cB + hstep + kstep, voffB);
        PG8_WAIT_V(6); PG8_BAR;
    }
    for (;;) {
        const bool has_next = S.next(ui + 1, nxt);
        const char* nA = has_next ? (const char*)g.A + (size_t)nxt.pm * tstep : cA; const char* nB = has_next ? (const char*)g.Bt + (size_t)nxt.pn * tstep : cB;
        for (int t = 0; t < nt; t += 2) {
            const bool last = (t == nt - 2);
            const char* a1 = cA + (size_t)(t + 1) * kstep;
            const char* a2 = last ? nA : cA + (size_t)(t + 2) * kstep; const char* b2 = last ? nB : cB + (size_t)(t + 2) * kstep;
            const char* a3 = a2 + kstep; const char* b3 = b2 + kstep;
            if (last && has_next) S.a_ready(nxt);
            if constexpr (SP2) {
            PG8_LDB(B0, 0, 0); PG8_LDB(B1, 0, 1); PG8_SCHED; PG8_LDA(At, 0, 0); PG8_STAGE(PG8_SA(1, 1), a1 + hstep, voffA);
            PG8_WAIT_V(8); PG8_WAIT_L(0); PG8_BAR; PG8_MMA(0, 0, At, B0); PG8_MMA(0, 1, At, B1); PG8_BAR; PG8_SCHED;
            PG8_LDA(At, 0, 1); PG8_STAGE(PG8_SB(0, 0), b2, voffB); PG8_STAGE(PG8_SB(0, 1), b2 + hstep, voffB); PG8_STAGE(PG8_SA(0, 0), a2, voffA);
            PG8_WAIT_V(8); PG8_WAIT_L(0); PG8_BAR; PG8_MMA(1, 0, At, B0); PG8_MMA(1, 1, At, B1); PG8_BAR; PG8_SCHED;
            PG8_LDB(B0, 1, 0); PG8_LDB(B1, 1, 1); PG8_SCHED; PG8_LDA(At, 1, 0); PG8_STAGE(PG8_SA(0, 1), a2 + hstep, voffA);
            PG8_WAIT_V(8); PG8_WAIT_L(0); PG8_BAR; PG8_MMA(0, 0, At, B0); PG8_MMA(0, 1, At, B1); PG8_BAR; PG8_SCHED;
            PG8_LDA(At, 1, 1); PG8_STAGE(PG8_SB(1, 0), b3, voffB); PG8_STAGE(PG8_SB(1, 1), b3 + hstep, voffB); PG8_STAGE(PG8_SA(1, 0), a3, voffA);
            PG8_WAIT_V(8); PG8_WAIT_L(0); PG8_BAR; PG8_MMA(1, 0, At, B0); PG8_MMA(1, 1, At, B1); PG8_BAR; PG8_SCHED;
            } else {
            PG8_LDB(B0, 0, 0); PG8_SCHED; PG8_LDA(At, 0, 0); PG8_STAGE(PG8_SA(1, 1), a1 + hstep, voffA);
            PG8_WAIT_L(8); PG8_BAR; PG8_WAIT_L(0); PG8_MMA(0, 0, At, B0); PG8_BAR; PG8_SCHED;
            PG8_LDB(B1, 0, 1); PG8_STAGE(PG8_SB(0, 0), b2, voffB);
            PG8_BAR; PG8_WAIT_L(0); PG8_MMA(0, 1, At, B1); PG8_BAR;
            PG8_LDA(At, 0, 1); PG8_STAGE(PG8_SA(0, 0), a2, voffA);
            PG8_BAR; PG8_WAIT_L(0); PG8_MMA(1, 0, At, B0); PG8_BAR; PG8_SCHED;
            PG8_STAGE(PG8_SB(0, 1), b2 + hstep, voffB);
            PG8_WAIT_V(6); PG8_BAR; PG8_MMA(1, 1, At, B1); PG8_BAR;
            PG8_LDB(B0, 1, 0); PG8_SCHED; PG8_LDA(At, 1, 0); PG8_STAGE(PG8_SA(0, 1), a2 + hstep, voffA);
            PG8_WAIT_L(8); PG8_BAR; PG8_WAIT_L(0); PG8_MMA(0, 0, At, B0); PG8_BAR; PG8_SCHED;
            PG8_LDB(B1, 1, 1); PG8_STAGE(PG8_SB(1, 0), b3, voffB);
            PG8_BAR; PG8_WAIT_L(0); PG8_MMA(0, 1, At, B1); PG8_BAR;
            PG8_LDA(At, 1, 1); PG8_STAGE(PG8_SA(1, 0), a3, voffA);
            PG8_BAR; PG8_WAIT_L(0); PG8_MMA(1, 0, At, B0); PG8_BAR; PG8_SCHED;
            PG8_STAGE(PG8_SB(1, 1), b3 + hstep, voffB);
            PG8_WAIT_V(6); PG8_BAR; PG8_MMA(1, 1, At, B1); PG8_BAR;
            }
        }
        if constexpr (ALIGN_EPI) { if (wr == 0) PG8_BAR; }
        if constexpr (!Epi::AFTER_DRAIN) { E(acc, cur, wr, wc, fr, fq); S.done(cur); }
        if (!has_next) break;
#pragma unroll
        for (int a = 0; a < 2; ++a)
#pragma unroll
            for (int b = 0; b < 2; ++b)
#pragma unroll
                for (int m = 0; m < 4; ++m)
#pragma unroll
                    for (int n = 0; n < 2; ++n) acc[a][b][m][n] = (f32x4){0.f, 0.f, 0.f, 0.f};
        cur = nxt; cA = nA; cB = nB; ++ui;
        if constexpr (ALIGN_EPI) { if (wr == 1) PG8_BAR; }
    }
    PG8_WAIT_V(0);
    if constexpr (!ALIGN_EPI) { if (wr == 0) PG8_BAR; }
    PG8_BAR;
    if constexpr (Epi::AFTER_DRAIN) { E.fused(acc, cur, wr, wc, fr, fq, lds, wid, lane); S.done(cur); }
#undef PG8_SA
#undef PG8_SB
#undef PG8_STAGE
#undef PG8_LDA
#undef PG8_LDB
#undef PG8_MMA
#undef PG8_WAIT_V
#undef PG8_WAIT_L
#undef PG8_BAR
#undef PG8_SCHED
}
}

using pg8::Unit;
struct EpiStore {
    static constexpr bool PERM = true, AFTER_DRAIN = false;
    const u64* ss; bf16_t* base0; int ld0; bf16_t* base1; int ld1; int t1; float* gates; int t2;
    __device__ __forceinline__ void operator()(const f32x4 (&acc)[2][2][4][2], const Unit& u, int wr, int wc, int fr, int fq) const {
        const int row0 = u.pm * 256 + wr * 64 + fr; const int pn = u.pn;
        if (pn >= t2) {
            if (wc == 0 && fq < 2) {
#pragma unroll
                for (int ai = 0; ai < 2; ++ai)
#pragma unroll
                    for (int m = 0; m < 4; ++m) { const int row = row0 + ai * 128 + m * 16; const float s = ss ? rs_of(ss, row) : 1.f;
                        float* gp = gates + (size_t)row * 16 + 8 * fq; *(f32x4*)gp = acc[ai][0][m][0] * s; *(f32x4*)(gp + 4) = acc[ai][0][m][1] * s; }
            }
            return;
        }
        bf16_t* base; int ld, colt;
        if (pn >= t1) { base = base1; ld = ld1; colt = (pn - t1) * 256; } else { base = base0; ld = ld0; colt = pn * 256; }
        const int col0 = colt + wc * 32 + 8 * fq;
#pragma unroll
        for (int ai = 0; ai < 2; ++ai)
#pragma unroll
            for (int m = 0; m < 4; ++m) { const int row = row0 + ai * 128 + m * 16; const float s = ss ? rs_of(ss, row) : 1.f;
                bf16_t* rowp = base + (size_t)row * ld + col0;
#pragma unroll
                for (int bj = 0; bj < 2; ++bj) { const f32x4 v0 = acc[ai][bj][m][0] * s, v1 = acc[ai][bj][m][1] * s;
                    u32x4 w; w.x = pk2(v0[0], v0[1]); w.y = pk2(v0[2], v0[3]); w.z = pk2(v1[0], v1[1]); w.w = pk2(v1[2], v1[3]);
                    *(u32x4*)(rowp + bj * 128) = w; } }
    }
};

#ifndef RES_BM
#define RES_BM 4
#endif
#ifndef RES1_BM
#define RES1_BM 2
#endif
template <int MODE> struct EpiResid {
    static constexpr bool PERM = true, AFTER_DRAIN = false;
    const float* rin; float* rout; bf16_t* rb; u64* ss_out; const u64* ss_in; const float* bias; const bf16_t* pp;
    __device__ __forceinline__ void operator()(const f32x4 (&acc)[2][2][4][2], const Unit& u, int wr, int wc, int fr, int fq) const {
        const int row0 = u.pm * 256 + wr * 64 + fr; const int col0 = u.pn * 256 + wc * 32 + 8 * fq;
#pragma unroll
        for (int ai = 0; ai < 2; ++ai) {
            float sq[4] = {0.f, 0.f, 0.f, 0.f};
            if (MODE == 0) {
#pragma unroll
                for (int mh = 0; mh < 4; mh += RES_BM) {
                f32x4 pre[RES_BM][2][2];
#pragma unroll
                for (int m = 0; m < RES_BM; ++m)
#pragma unroll
                    for (int bj = 0; bj < 2; ++bj) { const size_t off = (size_t)(row0 + ai * 128 + (mh + m) * 16) * 1024 + col0 + bj * 128; pre[m][bj][0] = *(const f32x4*)(rin + off); pre[m][bj][1] = *(const f32x4*)(rin + off + 4); }
#pragma unroll
                for (int m = 0; m < RES_BM; ++m)
#pragma unroll
                    for (int bj = 0; bj < 2; ++bj) { const size_t off = (size_t)(row0 + ai * 128 + (mh + m) * 16) * 1024 + col0 + bj * 128;
                        const f32x4 r0 = pre[m][bj][0] + acc[ai][bj][mh + m][0], r1 = pre[m][bj][1] + acc[ai][bj][mh + m][1];
                        *(f32x4*)(rout + off) = r0; *(f32x4*)(rout + off + 4) = r1;
                        u32x4 w; w.x = pk2(r0[0], r0[1]); w.y = pk2(r0[2], r0[3]); w.z = pk2(r1[0], r1[1]); w.w = pk2(r1[2], r1[3]);
                        *(u32x4*)(rb + off) = w;
                        sq[mh + m] += (r0[0] * r0[0] + r0[1] * r0[1]) + (r0[2] * r0[2] + r0[3] * r0[3]) + (r1[0] * r1[0] + r1[1] * r1[1]) + (r1[2] * r1[2] + r1[3] * r1[3]); }
                }
            } else {
                float sin_[4];
#pragma unroll
                for (int m = 0; m < 4; ++m) sin_[m] = rs_of(ss_in, row0 + ai * 128 + m * 16);
#pragma unroll
                for (int bj = 0; bj < 2; ++bj) { const f32x4 b0 = *(const f32x4*)(bias + col0 + bj * 128), b1 = *(const f32x4*)(bias + col0 + bj * 128 + 4);
#pragma unroll
                    for (int mh = 0; mh < 4; mh += RES1_BM) {
                    f32x4 pre[RES1_BM][2]; u32x4 pw[RES1_BM];
#pragma unroll
                    for (int m = 0; m < RES1_BM; ++m) { const size_t off = (size_t)(row0 + ai * 128 + (mh + m) * 16) * 1024 + col0 + bj * 128; pre[m][0] = *(const f32x4*)(rin + off); pre[m][1] = *(const f32x4*)(rin + off + 4); pw[m] = *(const u32x4*)(pp + off); }
#pragma unroll
                    for (int m = 0; m < RES1_BM; ++m) { const size_t off = (size_t)(row0 + ai * 128 + (mh + m) * 16) * 1024 + col0 + bj * 128; const float si = sin_[mh + m];
                        f32x4 a0 = acc[ai][bj][mh + m][0], a1 = acc[ai][bj][mh + m][1];
                        a0[0] = sigm(a0[0] * si + b0[0]) * bflo(pw[m].x); a0[1] = sigm(a0[1] * si + b0[1]) * bfhi(pw[m].x);
                        a0[2] = sigm(a0[2] * si + b0[2]) * bflo(pw[m].y); a0[3] = sigm(a0[3] * si + b0[3]) * bfhi(pw[m].y);
                        a1[0] = sigm(a1[0] * si + b1[0]) * bflo(pw[m].z); a1[1] = sigm(a1[1] * si + b1[1]) * bfhi(pw[m].z);
                        a1[2] = sigm(a1[2] * si + b1[2]) * bflo(pw[m].w); a1[3] = sigm(a1[3] * si + b1[3]) * bfhi(pw[m].w);
                        const f32x4 r0 = pre[m][0] + a0, r1 = pre[m][1] + a1;
                        *(f32x4*)(rout + off) = r0; *(f32x4*)(rout + off + 4) = r1;
                        u32x4 w; w.x = pk2(r0[0], r0[1]); w.y = pk2(r0[2], r0[3]); w.z = pk2(r1[0], r1[1]); w.w = pk2(r1[2], r1[3]);
                        *(u32x4*)(rb + off) = w;
                        sq[mh + m] += (r0[0] * r0[0] + r0[1] * r0[1]) + (r0[2] * r0[2] + r0[3] * r0[3]) + (r1[0] * r1[0] + r1[1] * r1[1]) + (r1[2] * r1[2] + r1[3] * r1[3]); } } }
            }
#pragma unroll
            for (int m = 0; m < 4; ++m) { float q = sq[m]; q += __shfl_xor(q, 16); q += __shfl_xor(q, 32);
                if (fq == 0) atomicAdd(ss_out + (row0 + ai * 128 + m * 16), ss_fix(q)); }
        }
    }
};

#ifndef GLU_BM
#define GLU_BM 2
#endif
struct EpiGlu {
    static constexpr bool PERM = true, AFTER_DRAIN = false;
    const u64* ss; const bf16_t* G; const float* cw; const float* cb; bf16_t* act;
    __device__ __forceinline__ void operator()(const f32x4 (&acc)[2][2][4][2], const Unit& u, int wr, int wc, int fr, int fq) const {
        const int row0 = u.pm * 256 + wr * 64 + fr; const int col0 = u.pn * 256 + wc * 32 + 8 * fq;
#pragma unroll
        for (int bj = 0; bj < 2; ++bj) { const int c = col0 + bj * 128;
            const f32x4 w0a = *(const f32x4*)(cw + c), w0b = *(const f32x4*)(cw + c + 4), w1a = *(const f32x4*)(cw + FF + c), w1b = *(const f32x4*)(cw + FF + c + 4);
            const f32x4 w2a = *(const f32x4*)(cw + 2 * FF + c), w2b = *(const f32x4*)(cw + 2 * FF + c + 4), bba = *(const f32x4*)(cb + c), bbb = *(const f32x4*)(cb + c + 4);
#pragma unroll
            for (int ai = 0; ai < 2; ++ai)
#pragma unroll
            for (int mh = 0; mh < 4; mh += GLU_BM) {
                u32x4 gmv[GLU_BM], glv[GLU_BM], gnv[GLU_BM]; float sv[GLU_BM];
#pragma unroll
                for (int m = 0; m < GLU_BM; ++m) { const int row = row0 + ai * 128 + (mh + m) * 16; const int t = row & (SEQ - 1); const bf16_t* gp = G + (size_t)row * FF + c;
                    gmv[m] = *(const u32x4*)gp; glv[m] = (u32x4){0u, 0u, 0u, 0u}; gnv[m] = (u32x4){0u, 0u, 0u, 0u};
                    if (t > 0) glv[m] = *(const u32x4*)(gp - FF);
                    if (t < SEQ - 1) gnv[m] = *(const u32x4*)(gp + FF);
                    sv[m] = rs_of(ss, row); }
#pragma unroll
                for (int m = 0; m < GLU_BM; ++m) { const int row = row0 + ai * 128 + (mh + m) * 16; const float s = sv[m]; const u32x4 gm = gmv[m], gl = glv[m], gn = gnv[m];
                    f32x4 ga, gb;
                    ga[0] = w0a[0] * bflo(gl.x) + w1a[0] * bflo(gm.x) + w2a[0] * bflo(gn.x) + bba[0];
                    ga[1] = w0a[1] * bfhi(gl.x) + w1a[1] * bfhi(gm.x) + w2a[1] * bfhi(gn.x) + bba[1];
                    ga[2] = w0a[2] * bflo(gl.y) + w1a[2] * bflo(gm.y) + w2a[2] * bflo(gn.y) + bba[2];
                    ga[3] = w0a[3] * bfhi(gl.y) + w1a[3] * bfhi(gm.y) + w2a[3] * bfhi(gn.y) + bba[3];
                    gb[0] = w0b[0] * bflo(gl.z) + w1b[0] * bflo(gm.z) + w2b[0] * bflo(gn.z) + bbb[0];
                    gb[1] = w0b[1] * bfhi(gl.z) + w1b[1] * bfhi(gm.z) + w2b[1] * bfhi(gn.z) + bbb[1];
                    gb[2] = w0b[2] * bflo(gl.w) + w1b[2] * bflo(gm.w) + w2b[2] * bflo(gn.w) + bbb[2];
                    gb[3] = w0b[3] * bfhi(gl.w) + w1b[3] * bfhi(gm.w) + w2b[3] * bfhi(gn.w) + bbb[3];
                    const f32x4 a0 = acc[ai][bj][mh + m][0] * s, a1 = acc[ai][bj][mh + m][1] * s;
                    u32x4 w; w.x = pk2(gelu_t(ga[0]) * a0[0], gelu_t(ga[1]) * a0[1]); w.y = pk2(gelu_t(ga[2]) * a0[2], gelu_t(ga[3]) * a0[3]);
                    w.z = pk2(gelu_t(gb[0]) * a1[0], gelu_t(gb[1]) * a1[1]); w.w = pk2(gelu_t(gb[2]) * a1[2], gelu_t(gb[3]) * a1[3]);
                    *(u32x4*)(act + (size_t)row * FF + c) = w; } } }
    }
};

struct Params { const float* in[28]; float* out; unsigned char* ws; };
typedef LAS unsigned* PT;
__device__ __forceinline__ const float* pin(PT t, int k) { const unsigned lo = __builtin_amdgcn_readfirstlane(t[2 * k]), hi = __builtin_amdgcn_readfirstlane(t[2 * k + 1]); return (const float*)(((unsigned long long)hi << 32) | lo); }
__device__ __forceinline__ float* pout(PT t) { return (float*)pin(t, 28); }
__device__ __forceinline__ unsigned char* pws(PT t) { return (unsigned char*)pin(t, 29); }
enum { I_X = 0, I_P, I_N1G, I_WIN, I_DNCW, I_ALOG, I_DTB, I_DNG, I_LCW, I_LCB, I_LWA, I_LBA, I_LWX, I_LBX, I_LAM, I_LNG, I_WOUT, I_N2G, I_FWG, I_FWU, I_FCW, I_FCB, I_FWD, I_PNG, I_PWG, I_PBG, I_PWP, I_FING };

template <class RM>
__device__ __forceinline__ void tr_item(const float* W, int K, int N, bf16_t* WT, int ldt, const float* gk, const RM& rm, LAS float* scr, int item, int lane) {
    const int nblk = (N + 31) >> 5, kb = item / nblk, nb = item % nblk, k0 = 64 * kb, n0 = 32 * nb;
#pragma unroll 8
    for (int i = 0; i < 32; ++i) { const int kk = 2 * i + (lane >> 5), n = n0 + (lane & 31);
        float v = (n < N) ? W[(size_t)(k0 + kk) * N + n] : 0.f; if (gk) v *= gk[k0 + kk];
        scr[kk * 33 + (lane & 31)] = v; }
    LDS_FENCE();
    const int c = lane & 7;
#pragma unroll
    for (int j = 0; j < 4; ++j) { const int nl = (lane >> 3) + 8 * j, n = n0 + nl; const LAS float* s = scr + (8 * c) * 33 + nl;
        u32x4 o; o.x = pk2(s[0 * 33], s[1 * 33]); o.y = pk2(s[2 * 33], s[3 * 33]); o.z = pk2(s[4 * 33], s[5 * 33]); o.w = pk2(s[6 * 33], s[7 * 33]);
        const int dst = (n < N) ? rm(n) : -1;
        if (dst >= 0) *(u32x4*)(WT + (size_t)dst * ldt + k0 + 8 * c) = o; }
    LDS_FENCE();
}
struct RmId { __device__ __forceinline__ int operator()(int n) const { return n; } };
struct RmIn { __device__ __forceinline__ int operator()(int n) const {
    if (n < 1536) return n;
    if (n < 2048) return 2304 + (n - 1536);
    if (n < 2064) return 2048 + (n - 2048);
    if (n < 2576) return 1536 + (n - 2064);
    return 2816 + (n - 2576);
} };

__device__ __forceinline__ void prologue(PT pt, LAS unsigned char* lds, int gw, int NGW, int lane, int wave) {
    asm volatile("" : "+v"(lane));
    unsigned char* ws = pws(pt);
    { u32x4* z = (u32x4*)((u64*)(ws + WS_SSP) + M_TOK); const size_t n4 = (size_t)12 * M_TOK / 2;
      for (size_t i = (size_t)gw * 64 + lane; i < n4; i += (size_t)NGW * 64) z[i] = (u32x4){0u, 0u, 0u, 0u}; }
    for (int l = 0; l < NL; ++l) { u32x4* z = (u32x4*)((bf16_t*)(ws + WS_WIN) + ((size_t)l * 3328 + 2064) * 1024); const int n4 = 240 * 1024 / 8;
        for (int i = gw * 64 + lane; i < n4; i += NGW * 64) z[i] = (u32x4){0u, 0u, 0u, 0u}; }
    LAS float* scr = (LAS float*)(lds + wave * 16384);
    constexpr int I_IN = 16 * 97, I_OUT = 16 * 32, I_G = 16 * 88, I_D = 44 * 32, I_PG = 16 * 32, I_PP = 4 * 32, I_LA = 32;
    constexpr int PER_L = I_IN + I_OUT + 2 * I_G + I_D + I_PG + I_PP + 2 * I_LA;
    for (int it = gw; it < NL * PER_L; it += NGW) {
        const int l = it / PER_L; int r = it % PER_L;
        if (r < I_IN) { tr_item(pin(pt, I_WIN) + (size_t)l * DM * INC, DM, INC, (bf16_t*)(ws + WS_WIN) + (size_t)l * 3328 * 1024, 1024, pin(pt, I_N1G) + l * DM, RmIn(), scr, r, lane); continue; } r -= I_IN;
        if (r < I_OUT) { tr_item(pin(pt, I_WOUT) + (size_t)l * DM * DM, DM, DM, (bf16_t*)(ws + WS_WOUT) + (size_t)l * DM * DM, 1024, nullptr, RmId(), scr, r, lane); continue; } r -= I_OUT;
        if (r < I_G) { tr_item(pin(pt, I_FWG) + (size_t)l * DM * FF, DM, FF, (bf16_t*)(ws + WS_WG) + (size_t)l * FF * DM, 1024, pin(pt, I_N2G) + l * DM, RmId(), scr, r, lane); continue; } r -= I_G;
        if (r < I_G) { tr_item(pin(pt, I_FWU) + (size_t)l * DM * FF, DM, FF, (bf16_t*)(ws + WS_WU) + (size_t)l * FF * DM, 1024, pin(pt, I_N2G) + l * DM, RmId(), scr, r, lane); continue; } r -= I_G;
        if (r < I_D) { tr_item(pin(pt, I_FWD) + (size_t)l * FF * DM, FF, DM, (bf16_t*)(ws + WS_WD) + (size_t)l * DM * FF, FF, nullptr, RmId(), scr, r, lane); continue; } r -= I_D;
        if (r < I_PG) { tr_item(pin(pt, I_PWG) + (size_t)l * DM * DM, DM, DM, (bf16_t*)(ws + WS_WPG) + (size_t)l * DM * DM, 1024, pin(pt, I_PNG) + l * DM, RmId(), scr, r, lane); continue; } r -= I_PG;
        if (r < I_PP) { tr_item(pin(pt, I_PWP) + (size_t)l * PLE * DM, PLE, DM, (bf16_t*)(ws + WS_WP) + (size_t)l * DM * PLE, PLE, nullptr, RmId(), scr, r, lane); continue; } r -= I_PP;
        { const int gate = r / I_LA; r %= I_LA; const int mat = r >> 1, sub = r & 1;
          const float* src = pin(pt, gate ? I_LWX : I_LWA) + ((size_t)l * 16 + mat) * 4096;
          bf16_t* dst = (bf16_t*)(ws + WS_WAT) + (((size_t)l * 16 + mat) * 2 + gate) * 4096;
          tr_item(src, 64, 64, dst, 64, nullptr, RmId(), scr, sub, lane); }
    }
    const float* x = pin(pt, I_X); bf16_t* rb = (bf16_t*)(ws + WS_RB); u64* ss0 = (u64*)(ws + WS_SSP);
    for (int m = gw; m < M_TOK; m += NGW) { const f32x4* xr = (const f32x4*)(x + (size_t)m * DM) + lane; u32x2* o = (u32x2*)(rb + (size_t)m * DM) + lane; float s = 0.f;
#pragma unroll
        for (int j = 0; j < 4; ++j) { const f32x4 v = xr[64 * j]; s += (v[0] * v[0] + v[1] * v[1]) + (v[2] * v[2] + v[3] * v[3]); o[64 * j] = pk4(v); }
#pragma unroll
        for (int o2 = 1; o2 < 64; o2 <<= 1) s += __shfl_xor(s, o2);
        if (lane == 0) ss0[m] = ss_fix(s); }
}

__device__ __forceinline__ void lru_wave(PT pt, LAS unsigned char* wl, int wi, int layer, int lane) {
    asm volatile("" : "+v"(lane));
    unsigned char* ws = pws(pt);
    const int dq = wi & 3, n = (wi >> 2) & 7, dir = (wi >> 5) & 1, b = wi >> 6;
    const int fr = lane & 15, fq = lane >> 4;
    LAS unsigned char* XC = wl; LAS float* CW = (LAS float*)(wl + 2048);
#pragma unroll
    for (int tap = 0; tap < 4; ++tap) CW[tap * 64 + lane] = pin(pt, I_LCW)[((size_t)layer * 4 + tap) * 512 + 64 * n + lane];
    CW[256 + lane] = pin(pt, I_LCB)[(size_t)layer * 512 + 64 * n + lane];
    const bf16_t* wbase = (const bf16_t*)(ws + WS_WAT) + ((((size_t)layer * 2 + dir) * 8 + n) * 2) * 4096;
    bf16x8 Ba[2], Bx[2];
#pragma unroll
    for (int ks = 0; ks < 2; ++ks) { Ba[ks] = *(const bf16x8*)(wbase + (16 * dq + fr) * 64 + 32 * ks + 8 * fq); Bx[ks] = *(const bf16x8*)(wbase + 4096 + (16 * dq + fr) * 64 + 32 * ks + 8 * fq); }
    const int dch = 64 * n + 16 * dq + fr; const size_t pidx = ((size_t)layer * 2 + dir) * 512 + dch;
    const float ba = pin(pt, I_LBA)[pidx], bx = pin(pt, I_LBX)[pidx], sp8 = 8.0f * softplus_f(-pin(pt, I_LAM)[pidx]);
    const bf16_t* plx = (const bf16_t*)(ws + WS_PLX) + (size_t)b * SEQ * 512 + 64 * n;
    bf16_t* hout = (bf16_t*)(ws + (dir ? WS_HB : WS_HF)) + (size_t)b * SEQ * 512 + dch;
    const int ti = lane >> 2, cq = lane & 3;
    LDS_FENCE();
    float hprev = 0.f;
    for (int sc = 0; sc < 128; ++sc) {
        { const int tt = dir ? (SEQ - 1 - (16 * sc + ti)) : (16 * sc + ti);
          f32x4 xa[4];
#pragma unroll
          for (int q = 0; q < 4; ++q) xa[q] = *(const LAS f32x4*)(CW + 256 + 16 * cq + 4 * q);
#pragma unroll
          for (int tap = 0; tap < 4; ++tap) { const int t2 = tt + tap - 2;
              if (t2 >= 0 && t2 < SEQ) { const u32x4 x0 = *(const u32x4*)(plx + (size_t)t2 * 512 + 16 * cq), x1 = *(const u32x4*)(plx + (size_t)t2 * 512 + 16 * cq + 8);
                  const f32x4 w0 = *(const LAS f32x4*)(CW + tap * 64 + 16 * cq), w1 = *(const LAS f32x4*)(CW + tap * 64 + 16 * cq + 4), w2 = *(const LAS f32x4*)(CW + tap * 64 + 16 * cq + 8), w3 = *(const LAS f32x4*)(CW + tap * 64 + 16 * cq + 12);
                  xa[0][0] += w0[0] * bflo(x0.x); xa[0][1] += w0[1] * bfhi(x0.x); xa[0][2] += w0[2] * bflo(x0.y); xa[0][3] += w0[3] * bfhi(x0.y);
                  xa[1][0] += w1[0] * bflo(x0.z); xa[1][1] += w1[1] * bfhi(x0.z); xa[1][2] += w1[2] * bflo(x0.w); xa[1][3] += w1[3] * bfhi(x0.w);
                  xa[2][0] += w2[0] * bflo(x1.x); xa[2][1] += w2[1] * bfhi(x1.x); xa[2][2] += w2[2] * bflo(x1.y); xa[2][3] += w2[3] * bfhi(x1.y);
                  xa[3][0] += w3[0] * bflo(x1.z); xa[3][1] += w3[1] * bfhi(x1.z); xa[3][2] += w3[2] * bflo(x1.w); xa[3][3] += w3[3] * bfhi(x1.w); } }
          u32x4 o0, o1; o0.x = pk2(xa[0][0], xa[0][1]); o0.y = pk2(xa[0][2], xa[0][3]); o0.z = pk2(xa[1][0], xa[1][1]); o0.w = pk2(xa[1][2], xa[1][3]);
          o1.x = pk2(xa[2][0], xa[2][1]); o1.y = pk2(xa[2][2], xa[2][3]); o1.z = pk2(xa[3][0], xa[3][1]); o1.w = pk2(xa[3][2], xa[3][3]);
          *(LAS u32x4*)(XC + swz64(ti, 16 * cq)) = o0; *(LAS u32x4*)(XC + swz64(ti, 16 * cq + 8)) = o1; }
        LDS_FENCE();
        const bf16x8 A0 = *(const LAS bf16x8*)(XC + swz64(fr, 8 * fq)), A1 = *(const LAS bf16x8*)(XC + swz64(fr, 32 + 8 * fq));
        f32x4 ca = {0.f, 0.f, 0.f, 0.f}, cx = {0.f, 0.f, 0.f, 0.f};
        ca = MFMA16(A0, Ba[0], ca); ca = MFMA16(A1, Ba[1], ca); cx = MFMA16(A0, Bx[0], cx); cx = MFMA16(A1, Bx[1], cx);
        float Ac[4], Hc[4];
#pragma unroll
        for (int jj = 0; jj < 4; ++jj) { const float xv = bf2f(*(const LAS unsigned short*)(XC + swz64(4 * fq + jj, 16 * dq + fr)));
            const float r = sigm(ca[jj] + ba), ig = sigm(cx[jj] + bx), a = fexp(-r * sp8);
            const float bt = sqrtf(fmaxf(1.0f - a * a, 0.f)) * ig * xv;
            Hc[jj] = jj ? (a * Hc[jj - 1] + bt) : bt; Ac[jj] = jj ? (a * Ac[jj - 1]) : a; }
        LDS_FENCE();
        float A = Ac[3], Bv = Hc[3];
        { const float A1s = __shfl_up(A, 16), B1s = __shfl_up(Bv, 16); if (fq >= 1) { Bv = A * B1s + Bv; A = A * A1s; } }
        { const float A2s = __shfl_up(A, 32), B2s = __shfl_up(Bv, 32); if (fq >= 2) { Bv = A * B2s + Bv; A = A * A2s; } }
        float Ae = __shfl_up(A, 16), Be = __shfl_up(Bv, 16); if (fq == 0) { Ae = 1.f; Be = 0.f; }
        const float hin = Ae * hprev + Be;
        float hv[4];
#pragma unroll
        for (int jj = 0; jj < 4; ++jj) hv[jj] = Ac[jj] * hin + Hc[jj];
        hprev = __shfl(hv[3], 48 + fr);
#pragma unroll
        for (int jj = 0; jj < 4; ++jj) { const int i = 4 * fq + jj; const int t2 = dir ? (SEQ - 1 - (16 * sc + i)) : (16 * sc + i);
            hout[(size_t)t2 * 512] = (bf16_t)(pk2(hv[jj], 0.f) & 0xffffu); }
    }
}

constexpr int DP_BUF0 = 0, DP_BUF1 = 49152, DP_KL = 49152, DP_QL = 49152 + 16384, DP_VL = 49152 + 32768, DP_VEC = 98304;
__device__ __forceinline__ void dp_item(PT pt, LAS unsigned char* lds, int item, int layer, int tid, int lane, int w) {
    asm volatile("" : "+v"(tid)); lane = tid & 63; asm volatile("" : "+s"(w));
    unsigned char* ws = pws(pt);
    const int b = item >> 7, h = (item >> 5) & 3, n = item & 31;
    const size_t rowbase = (size_t)b * SEQ + 64 * n;
    LAS float* VEC = (LAS float*)(lds + DP_VEC);
    __syncthreads();
    { const int i = tid >> 3, c = tid & 7; const int t = 64 * n + i; const size_t R = rowbase + i;
      const bf16_t* pq = (const bf16_t*)(ws + WS_PQKV);
#pragma unroll 1
      for (int mat = 0; mat < 3; ++mat) { const int colb = mat * 512 + h * 128 + 16 * c;
          f32x4 a[4] = {{0.f, 0.f, 0.f, 0.f}, {0.f, 0.f, 0.f, 0.f}, {0.f, 0.f, 0.f, 0.f}, {0.f, 0.f, 0.f, 0.f}};
#pragma unroll
          for (int tap = 0; tap < 4; ++tap) { const int t2 = t + tap - 2;
              if (t2 >= 0 && t2 < SEQ) { const bf16_t* xp = pq + (R + tap - 2) * 1536 + colb; const u32x4 x0 = *(const u32x4*)xp, x1 = *(const u32x4*)(xp + 8);
                  const float* wp = pin(pt, I_DNCW) + ((size_t)layer * 4 + tap) * 1536 + colb; const f32x4 w0 = *(const f32x4*)wp, w1 = *(const f32x4*)(wp + 4), w2 = *(const f32x4*)(wp + 8), w3 = *(const f32x4*)(wp + 12);
                  a[0][0] += w0[0] * bflo(x0.x); a[0][1] += w0[1] * bfhi(x0.x); a[0][2] += w0[2] * bflo(x0.y); a[0][3] += w0[3] * bfhi(x0.y);
                  a[1][0] += w1[0] * bflo(x0.z); a[1][1] += w1[1] * bfhi(x0.z); a[1][2] += w1[2] * bflo(x0.w); a[1][3] += w1[3] * bfhi(x0.w);
                  a[2][0] += w2[0] * bflo(x1.x); a[2][1] += w2[1] * bfhi(x1.x); a[2][2] += w2[2] * bflo(x1.y); a[2][3] += w2[3] * bfhi(x1.y);
                  a[3][0] += w3[0] * bflo(x1.z); a[3][1] += w3[1] * bfhi(x1.z); a[3][2] += w3[2] * bflo(x1.w); a[3][3] += w3[3] * bfhi(x1.w); } }
          float ssq = 0.f;
#pragma unroll
          for (int q = 0; q < 4; ++q)
#pragma unroll
              for (int e = 0; e < 4; ++e) { const float v = a[q][e]; const float s = v * sigm(v); a[q][e] = s; ssq += s * s; }
          float scale = 1.f;
          if (mat < 2) { ssq += __shfl_xor(ssq, 1); ssq += __shfl_xor(ssq, 2); ssq += __shfl_xor(ssq, 4); scale = rsqrtf(ssq + EPS); if (mat == 0) scale *= 0.08838834764831845f; }
          u32x4 o0, o1; o0.x = pk2(a[0][0] * scale, a[0][1] * scale); o0.y = pk2(a[0][2] * scale, a[0][3] * scale); o0.z = pk2(a[1][0] * scale, a[1][1] * scale); o0.w = pk2(a[1][2] * scale, a[1][3] * scale);
          o1.x = pk2(a[2][0] * scale, a[2][1] * scale); o1.y = pk2(a[2][2] * scale, a[2][3] * scale); o1.z = pk2(a[3][0] * scale, a[3][1] * scale); o1.w = pk2(a[3][2] * scale, a[3][3] * scale);
          const int lbase = (mat == 0) ? DP_QL : (mat == 1 ? DP_KL : DP_VL);
          *(LAS u32x4*)(lds + lbase + swz128(i, 16 * c)) = o0; *(LAS u32x4*)(lds + lbase + swz128(i, 16 * c + 8)) = o1;
          if (mat < 2) { bf16_t* gp = (bf16_t*)(ws + (mat == 0 ? WS_QH : WS_KH)) + R * 512 + h * 128 + 16 * c; *(u32x4*)gp = o0; *(u32x4*)(gp + 8) = o1; } }
    }
    if (w == 0) {
        const float* gp = (const float*)(ws + WS_GATES) + (rowbase + lane) * 16;
        const float bF = sigm(gp[h]), bB = sigm(gp[4 + h]);
        float gF = -expf(pin(pt, I_ALOG)[layer * 8 + h]) * softplus_f(gp[8 + h] + pin(pt, I_DTB)[layer * 8 + h]);
        float gB = -expf(pin(pt, I_ALOG)[layer * 8 + 4 + h]) * softplus_f(gp[12 + h] + pin(pt, I_DTB)[layer * 8 + 4 + h]);
#pragma unroll
        for (int off = 1; off < 64; off <<= 1) { const float v = __shfl_up(gF, off); if (lane >= off) gF += v; const float u = __shfl_down(gB, off); if (lane + off < 64) gB += u; }
        const float glF = __shfl(gF, 63), glB = __shfl(gB, 0);
        VEC[lane] = bF; VEC[64 + lane] = gF; VEC[128 + lane] = bB; VEC[192 + lane] = gB;
        float* v0 = (float*)(ws + WS_VEC) + (size_t)item * 256; float* v1 = v0 + (size_t)4096 * 256;
        v0[lane] = bF; v0[64 + lane] = fexp(gF); v0[128 + lane] = fexp(glF - gF); if (lane == 0) v0[192] = fexp(glF);
        v1[lane] = bB; v1[64 + lane] = fexp(gB); v1[128 + lane] = fexp(glB - gB); if (lane == 0) v1[192] = fexp(glB);
    }
    __syncthreads();
    { const int e = tid >> 2, jq = tid & 3; unsigned vv[8];
#pragma unroll
      for (int p = 0; p < 8; ++p) { const unsigned lo = *(const LAS unsigned short*)(lds + DP_VL + swz128(16 * jq + 2 * p, e)), hi = *(const LAS unsigned short*)(lds + DP_VL + swz128(16 * jq + 2 * p + 1, e)); vv[p] = lo | (hi << 16); }
      bf16_t* gp = (bf16_t*)(ws + WS_VT) + (size_t)item * 8192 + e * 64 + 16 * jq;
      *(u32x4*)gp = (u32x4){vv[0], vv[1], vv[2], vv[3]}; *(u32x4*)(gp + 8) = (u32x4){vv[4], vv[5], vv[6], vv[7]}; }
    const int r32 = lane & 31, hi = lane >> 5;
    { const int kind = w >> 2, q = w & 3, ta = q >> 1, tb = q & 1;
      f32x16 acc; for (int r = 0; r < 16; ++r) acc[r] = 0.f;
      const int bbase = kind ? DP_QL : DP_KL;
#pragma unroll
      for (int ks = 0; ks < 8; ++ks) { const bf16x8 av = *(const LAS bf16x8*)(lds + DP_KL + swz128(32 * ta + r32, 16 * ks + 8 * hi)), bv = *(const LAS bf16x8*)(lds + bbase + swz128(32 * tb + r32, 16 * ks + 8 * hi)); acc = MFMA32(av, bv, acc); }
      const int gb = 32 * tb + r32;
#pragma unroll
      for (int dir = 0; dir < 2; ++dir) { const LAS float* bet = VEC + dir * 128; const LAS float* gc = VEC + dir * 128 + 64;
          const float gcl = gc[gb], betl = bet[gb];
#pragma unroll
          for (int g = 0; g < 4; ++g) { const int ga0 = 32 * ta + 8 * g + 4 * hi; const f32x4 gca = *(const LAS f32x4*)(gc + ga0), bea = *(const LAS f32x4*)(bet + ga0);
              if (kind == 0) { f32x4 xv, yv, pv;
#pragma unroll
                  for (int jj = 0; jj < 4; ++jj) { const int ga = ga0 + jj; const float kk = acc[4 * g + jj];
                      const bool mx = dir ? (gb < ga) : (gb > ga), my = dir ? (ga < gb) : (ga > gb);
                      xv[jj] = mx ? (-betl * kk * fexp(gcl - gca[jj])) : 0.f; yv[jj] = my ? (-bea[jj] * kk * fexp(gca[jj] - gcl)) : 0.f; pv[jj] = (ga == gb) ? 1.f : 0.f; }
                  LAS unsigned char* bb = lds + DP_BUF0 + dir * 24576 + swz64(gb, ga0);
                  *(LAS u32x2*)bb = pk4(xv); *(LAS u32x2*)(bb + 8192) = pk4(yv); *(LAS u32x2*)(bb + 16384) = pk4(pv);
              } else { f32x4 av4;
#pragma unroll
                  for (int jj = 0; jj < 4; ++jj) { const int ga = ga0 + jj; const bool ma = dir ? (gb <= ga) : (gb >= ga); av4[jj] = ma ? (acc[4 * g + jj] * fexp(gcl - gca[jj])) : 0.f; }
                  *(u32x2*)((bf16_t*)(ws + WS_AT) + ((size_t)dir * 4096 + item) * 4096 + gb * 64 + ga0) = pk4(av4); } } }
    }
    __syncthreads();
    { const int dir = w >> 2, q = w & 3, ti = q >> 1, tj = q & 1;
      f32x16 pacc; for (int r = 0; r < 16; ++r) pacc[r] = (32 * tj + crow(r, hi) == 32 * ti + r32) ? 1.f : 0.f;
#pragma unroll 1
      for (int rd = 0; rd < 6; ++rd) { LAS unsigned char* cur = lds + ((rd & 1) ? DP_BUF1 : DP_BUF0) + dir * 24576; LAS unsigned char* nxt = lds + ((rd & 1) ? DP_BUF0 : DP_BUF1) + dir * 24576;
          bf16x8 xf[4], yf[4], pf[4];
#pragma unroll
          for (int ks = 0; ks < 4; ++ks) { xf[ks] = *(const LAS bf16x8*)(cur + swz64(32 * ti + r32, 16 * ks + 8 * hi)); yf[ks] = *(const LAS bf16x8*)(cur + 8192 + swz64(32 * tj + r32, 16 * ks + 8 * hi)); pf[ks] = *(const LAS bf16x8*)(cur + 16384 + swz64(32 * ti + r32, 16 * ks + 8 * hi)); }
#pragma unroll
          for (int ks = 0; ks < 4; ++ks) pacc = MFMA32(yf[ks], pf[ks], pacc);
          if (rd < 5) { f32x16 xa, ya; for (int r = 0; r < 16; ++r) { xa[r] = 0.f; ya[r] = 0.f; }
#pragma unroll
              for (int ks = 0; ks < 4; ++ks) { xa = MFMA32(yf[ks], xf[ks], xa); ya = MFMA32(xf[ks], yf[ks], ya); }
#pragma unroll
              for (int g = 0; g < 4; ++g) { const int c0 = 8 * g + 4 * hi;
                  *(LAS u32x2*)(nxt + swz64(32 * ti + r32, 32 * tj + c0)) = pk4((f32x4){xa[4 * g], xa[4 * g + 1], xa[4 * g + 2], xa[4 * g + 3]});
                  *(LAS u32x2*)(nxt + 8192 + swz64(32 * tj + r32, 32 * ti + c0)) = pk4((f32x4){ya[4 * g], ya[4 * g + 1], ya[4 * g + 2], ya[4 * g + 3]});
                  *(LAS u32x2*)(nxt + 16384 + swz64(32 * ti + r32, 32 * tj + c0)) = pk4((f32x4){pacc[4 * g], pacc[4 * g + 1], pacc[4 * g + 2], pacc[4 * g + 3]}); }
              __syncthreads(); } }
      bf16_t* tg = (bf16_t*)(ws + WS_TM) + ((size_t)dir * 4096 + item) * 4096 + (32 * ti + r32) * 64 + 32 * tj + 4 * hi;
#pragma unroll
      for (int g = 0; g < 4; ++g) *(u32x2*)(tg + 8 * g) = pk4((f32x4){pacc[4 * g], pacc[4 * g + 1], pacc[4 * g + 2], pacc[4 * g + 3]});
    }
}

constexpr int DR_K = 0, DR_Q = 16384, DR_KT = 32768, DR_VT = 49152, DR_T = 65536, DR_A = 73728, DR_VEC = 81920, DR_PRIV = 83968;
__device__ __forceinline__ void dr_item(PT pt, LAS unsigned char* lds, int item, int tid, int lane, int w) {
    asm volatile("" : "+v"(tid)); lane = tid & 63; asm volatile("" : "+s"(w));
    unsigned char* ws = pws(pt);
    const int dir = item & 1, h = (item >> 1) & 3, b = item >> 3;
    const int fr = lane & 15, fq = lane >> 4, es = 16 * w;
    LAS unsigned char* ST = lds + DR_PRIV + w * 8192; LAS unsigned char* RV = ST + 4096; LAS unsigned char* VN2 = ST + 6144;
    const LAS float* VEC = (const LAS float*)(lds + DR_VEC);
    const bf16_t* kh = (const bf16_t*)(ws + WS_KH) + (size_t)b * SEQ * 512 + h * 128;
    const bf16_t* qh = (const bf16_t*)(ws + WS_QH) + (size_t)b * SEQ * 512 + h * 128;
    const int ibase = (b * 4 + h) * 32;
    const bf16_t* vt = (const bf16_t*)(ws + WS_VT) + (size_t)ibase * 8192;
    const bf16_t* tm = (const bf16_t*)(ws + WS_TM) + ((size_t)dir * 4096 + ibase) * 4096;
    const bf16_t* at = (const bf16_t*)(ws + WS_AT) + ((size_t)dir * 4096 + ibase) * 4096;
    const float* vecs = (const float*)(ws + WS_VEC) + ((size_t)dir * 4096 + ibase) * 256;
    bf16_t* og = (bf16_t*)(ws + (dir ? WS_OB : WS_OF)) + (size_t)b * SEQ * 512 + h * 128 + es + fr;
    u32x4 pk[2], pq[2], pv[2], ptm, pa; f32x4 pvec = {0.f, 0.f, 0.f, 0.f};
#define DR_LOAD(nn) do { _Pragma("unroll") for (int u_ = 0; u_ < 2; ++u_) { const int p_ = tid + 512 * u_; \
        pk[u_] = *(const u32x4*)(kh + (size_t)(64 * (nn) + (p_ >> 4)) * 512 + 8 * (p_ & 15)); pq[u_] = *(const u32x4*)(qh + (size_t)(64 * (nn) + (p_ >> 4)) * 512 + 8 * (p_ & 15)); \
        pv[u_] = *(const u32x4*)(vt + (size_t)(nn) * 8192 + p_ * 8); } \
        ptm = *(const u32x4*)(tm + (size_t)(nn) * 4096 + tid * 8); pa = *(const u32x4*)(at + (size_t)(nn) * 4096 + tid * 8); \
        if (tid < 64) pvec = *(const f32x4*)(vecs + (size_t)(nn) * 256 + 4 * tid); } while (0)
#define DR_STORE() do { _Pragma("unroll") for (int u_ = 0; u_ < 2; ++u_) { const int p_ = tid + 512 * u_; const int j_ = p_ >> 4, q_ = p_ & 15; \
        *(LAS u32x4*)(lds + DR_K + swz128(j_, 8 * q_)) = pk[u_]; *(LAS u32x4*)(lds + DR_Q + swz128(j_, 8 * q_)) = pq[u_]; \
        *(LAS unsigned short*)(lds + DR_KT + swz64(8 * q_ + 0, j_)) = (unsigned short)(pk[u_].x & 0xffffu); *(LAS unsigned short*)(lds + DR_KT + swz64(8 * q_ + 1, j_)) = (unsigned short)(pk[u_].x >> 16); \
        *(LAS unsigned short*)(lds + DR_KT + swz64(8 * q_ + 2, j_)) = (unsigned short)(pk[u_].y & 0xffffu); *(LAS unsigned short*)(lds + DR_KT + swz64(8 * q_ + 3, j_)) = (unsigned short)(pk[u_].y >> 16); \
        *(LAS unsigned short*)(lds + DR_KT + swz64(8 * q_ + 4, j_)) = (unsigned short)(pk[u_].z & 0xffffu); *(LAS unsigned short*)(lds + DR_KT + swz64(8 * q_ + 5, j_)) = (unsigned short)(pk[u_].z >> 16); \
        *(LAS unsigned short*)(lds + DR_KT + swz64(8 * q_ + 6, j_)) = (unsigned short)(pk[u_].w & 0xffffu); *(LAS unsigned short*)(lds + DR_KT + swz64(8 * q_ + 7, j_)) = (unsigned short)(pk[u_].w >> 16); \
        *(LAS u32x4*)(lds + DR_VT + swz64(p_ >> 3, 8 * (p_ & 7))) = pv[u_]; } \
        *(LAS u32x4*)(lds + DR_T + swz64(tid >> 3, 8 * (tid & 7))) = ptm; *(LAS u32x4*)(lds + DR_A + swz64(tid >> 3, 8 * (tid & 7))) = pa; \
        if (tid < 64) *(LAS f32x4*)(lds + DR_VEC + 16 * tid) = pvec; } while (0)
    __syncthreads();
    DR_LOAD(dir ? 31 : 0);
    DR_STORE();
#pragma unroll
    for (int q = 0; q < 4; ++q) *(LAS u32x4*)(ST + lane * 64 + q * 16) = (u32x4){0u, 0u, 0u, 0u};
    f32x4 Sacc[8];
#pragma unroll
    for (int d = 0; d < 8; ++d) Sacc[d] = (f32x4){0.f, 0.f, 0.f, 0.f};
    __syncthreads();
#pragma unroll 1
    for (int cc = 0; cc < 32; ++cc) { const int n = dir ? (31 - cc) : cc;
        if (cc + 1 < 32) DR_LOAD(dir ? (30 - cc) : (cc + 1));
        bf16x8 sb[4];
#pragma unroll
        for (int ks = 0; ks < 4; ++ks) sb[ks] = *(const LAS bf16x8*)(ST + swz128(fr, 32 * ks + 8 * fq));
        f32x4 oacc[4];
#pragma unroll
        for (int it = 0; it < 4; ++it) { f32x4 ka = {0.f, 0.f, 0.f, 0.f}, qa = {0.f, 0.f, 0.f, 0.f};
#pragma unroll
            for (int ks = 0; ks < 4; ++ks) { const bf16x8 a1 = *(const LAS bf16x8*)(lds + DR_K + swz128(16 * it + fr, 32 * ks + 8 * fq)), a2 = *(const LAS bf16x8*)(lds + DR_Q + swz128(16 * it + fr, 32 * ks + 8 * fq));
                ka = MFMA16(a1, sb[ks], ka); qa = MFMA16(a2, sb[ks], qa); }
            const int i0 = 16 * it + 4 * fq; const f32x4 be = *(const LAS f32x4*)(VEC + i0), eg = *(const LAS f32x4*)(VEC + 64 + i0);
            const u32x2 vv = *(const LAS u32x2*)(lds + DR_VT + swz64(es + fr, i0));
            f32x4 rh; rh[0] = be[0] * (bflo(vv.x) - eg[0] * ka[0]); rh[1] = be[1] * (bfhi(vv.x) - eg[1] * ka[1]); rh[2] = be[2] * (bflo(vv.y) - eg[2] * ka[2]); rh[3] = be[3] * (bfhi(vv.y) - eg[3] * ka[3]);
            *(LAS u32x2*)(RV + swz64(fr, i0)) = pk4(rh);
            oacc[it] = qa * eg; }
        bf16x8 rb2[2];
#pragma unroll
        for (int ks = 0; ks < 2; ++ks) rb2[ks] = *(const LAS bf16x8*)(RV + swz64(fr, 32 * ks + 8 * fq));
        f32x4 vn[4];
#pragma unroll
        for (int it = 0; it < 4; ++it) { vn[it] = (f32x4){0.f, 0.f, 0.f, 0.f};
#pragma unroll
            for (int ks = 0; ks < 2; ++ks) { const bf16x8 a1 = *(const LAS bf16x8*)(lds + DR_T + swz64(16 * it + fr, 32 * ks + 8 * fq)); vn[it] = MFMA16(a1, rb2[ks], vn[it]); } }
#pragma unroll
        for (int it = 0; it < 4; ++it) { const int i0 = 16 * it + 4 * fq; const f32x4 ed = *(const LAS f32x4*)(VEC + 128 + i0);
            *(LAS u32x2*)(RV + swz64(fr, i0)) = pk4(vn[it]); *(LAS u32x2*)(VN2 + swz64(fr, i0)) = pk4(vn[it] * ed); }
        bf16x8 vb[2], vb2[2];
#pragma unroll
        for (int ks = 0; ks < 2; ++ks) { vb[ks] = *(const LAS bf16x8*)(RV + swz64(fr, 32 * ks + 8 * fq)); vb2[ks] = *(const LAS bf16x8*)(VN2 + swz64(fr, 32 * ks + 8 * fq)); }
#pragma unroll
        for (int it = 0; it < 4; ++it)
#pragma unroll
            for (int ks = 0; ks < 2; ++ks) { const bf16x8 a1 = *(const LAS bf16x8*)(lds + DR_A + swz64(16 * it + fr, 32 * ks + 8 * fq)); oacc[it] = MFMA16(a1, vb[ks], oacc[it]); }
        const float cdec = VEC[192];
#pragma unroll
        for (int dt = 0; dt < 8; ++dt) { Sacc[dt] = Sacc[dt] * cdec;
#pragma unroll
            for (int ks = 0; ks < 2; ++ks) { const bf16x8 a1 = *(const LAS bf16x8*)(lds + DR_KT + swz64(16 * dt + fr, 32 * ks + 8 * fq)); Sacc[dt] = MFMA16(a1, vb2[ks], Sacc[dt]); }
            *(LAS u32x2*)(ST + swz128(fr, 16 * dt + 4 * fq)) = pk4(Sacc[dt]); }
#pragma unroll
        for (int it = 0; it < 4; ++it)
#pragma unroll
            for (int jj = 0; jj < 4; ++jj) og[(size_t)(64 * n + 16 * it + 4 * fq + jj) * 512] = (bf16_t)(pk2(oacc[it][jj], 0.f) & 0xffffu);
        __syncthreads();
        if (cc + 1 < 32) DR_STORE();
        __syncthreads();
    }
#undef DR_LOAD
#undef DR_STORE
}

__device__ __forceinline__ void m2_rows(PT pt, int layer, int gw, int NGW, int lane) {
    asm volatile("" : "+v"(lane));
    unsigned char* ws = pws(pt);
    const bf16_t* of = (const bf16_t*)(ws + WS_OF); const bf16_t* ob = (const bf16_t*)(ws + WS_OB); const bf16_t* pz = (const bf16_t*)(ws + WS_PZ);
    const bf16_t* hf = (const bf16_t*)(ws + WS_HF); const bf16_t* hb = (const bf16_t*)(ws + WS_HB); const bf16_t* plg = (const bf16_t*)(ws + WS_PLG);
    bf16_t* amix = (bf16_t*)(ws + WS_AMIX);
    const float* dng = pin(pt, I_DNG) + layer * 128 + 8 * (lane & 15); const float* lng = pin(pt, I_LNG) + layer * 512 + 8 * lane;
    const f32x4 dg0 = *(const f32x4*)dng, dg1 = *(const f32x4*)(dng + 4), lg0 = *(const f32x4*)lng, lg1 = *(const f32x4*)(lng + 4);
    for (int m = gw; m < M_TOK; m += NGW) { const size_t o = (size_t)m * 512 + 8 * lane;
        const u32x4 a = *(const u32x4*)(of + o), b2 = *(const u32x4*)(ob + o), z = *(const u32x4*)(pz + o);
        const u32x4 c = *(const u32x4*)(hf + o), d = *(const u32x4*)(hb + o), g = *(const u32x4*)(plg + o);
        float v[8], y[8];
        v[0] = bflo(a.x) + bflo(b2.x); v[1] = bfhi(a.x) + bfhi(b2.x); v[2] = bflo(a.y) + bflo(b2.y); v[3] = bfhi(a.y) + bfhi(b2.y);
        v[4] = bflo(a.z) + bflo(b2.z); v[5] = bfhi(a.z) + bfhi(b2.z); v[6] = bflo(a.w) + bflo(b2.w); v[7] = bfhi(a.w) + bfhi(b2.w);
        float s1 = 0.f;
#pragma unroll
        for (int e = 0; e < 8; ++e) s1 += v[e] * v[e];
        s1 += __shfl_xor(s1, 1); s1 += __shfl_xor(s1, 2); s1 += __shfl_xor(s1, 4); s1 += __shfl_xor(s1, 8);
        const float r1 = rsqrtf(s1 * (1.0f / 128.0f) + EPS);
        float zz[8] = {bflo(z.x), bfhi(z.x), bflo(z.y), bfhi(z.y), bflo(z.z), bfhi(z.z), bflo(z.w), bfhi(z.w)};
        float gg[8] = {bflo(g.x), bfhi(g.x), bflo(g.y), bfhi(g.y), bflo(g.z), bfhi(g.z), bflo(g.w), bfhi(g.w)};
        float hh[8] = {bflo(c.x) + bflo(d.x), bfhi(c.x) + bfhi(d.x), bflo(c.y) + bflo(d.y), bfhi(c.y) + bfhi(d.y), bflo(c.z) + bflo(d.z), bfhi(c.z) + bfhi(d.z), bflo(c.w) + bflo(d.w), bfhi(c.w) + bfhi(d.w)};
        float s2 = 0.f;
#pragma unroll
        for (int e = 0; e < 8; ++e) { const float dgv = e < 4 ? dg0[e & 3] : dg1[e & 3]; v[e] = v[e] * r1 * dgv * (zz[e] * sigm(zz[e])); y[e] = gelu_t(gg[e]) * hh[e]; s2 += y[e] * y[e]; }
#pragma unroll
        for (int o2 = 1; o2 < 64; o2 <<= 1) s2 += __shfl_xor(s2, o2);
        const float r2 = rsqrtf(s2 * (1.0f / 512.0f) + EPS);
#pragma unroll
        for (int e = 0; e < 8; ++e) { const float lgv = e < 4 ? lg0[e & 3] : lg1[e & 3]; y[e] = y[e] * r2 * lgv; }
        u32x4 w1, w2; w1.x = pk2(v[0], v[1]); w1.y = pk2(v[2], v[3]); w1.z = pk2(v[4], v[5]); w1.w = pk2(v[6], v[7]);
        w2.x = pk2(y[0], y[1]); w2.y = pk2(y[2], y[3]); w2.z = pk2(y[4], y[5]); w2.w = pk2(y[6], y[7]);
        *(u32x4*)(amix + (size_t)m * 1024 + 8 * lane) = w1; *(u32x4*)(amix + (size_t)m * 1024 + 512 + 8 * lane) = w2; }
}

#define XB_TMO      128
#define XB_XCNT(j)  (256  + 64 * (j))
#define XB_XSUB(j)  (1280 + 64 * (j))
#define XB_XGEN(j)  (2304 + 64 * (j))
#define XB_TOP      3328
#define XB_TOPGEN   3392
#define XCD_BAR_WORDS 3456
#define XB_SPIN_CAP (1u << 18)

__device__ __forceinline__ unsigned xb_ld(unsigned* p)              { return __hip_atomic_load(p, __ATOMIC_RELAXED, __HIP_MEMORY_SCOPE_AGENT); }
__device__ __forceinline__ unsigned xb_add(unsigned* p, unsigned v) { return __hip_atomic_fetch_add(p, v, __ATOMIC_RELAXED, __HIP_MEMORY_SCOPE_AGENT); }
__device__ __forceinline__ unsigned xb_xcc_id() { return (unsigned)__builtin_amdgcn_s_getreg((3 << 11) | 20) & 0xFu; }
#define XB_SPIN(cond, bar) do { unsigned _sp = 0; while (cond) { __builtin_amdgcn_s_sleep(1); \
    if ((++_sp & 255u) == 0u) { if (xb_ld(&(bar)[XB_TMO])) break; if (_sp > XB_SPIN_CAP) { atomicAdd(&(bar)[XB_TMO], 1u); break; } } } } while (0)

struct XcdBarrier {
    unsigned* bar; unsigned x;
    volatile LAS unsigned* st;
};

__device__ __forceinline__ XcdBarrier xcd_barrier_post(unsigned* bar, volatile LAS unsigned* st) {
    XcdBarrier b; b.bar = bar; b.x = xb_xcc_id(); b.st = st;
    if (threadIdx.x == 0) (void)xb_add(&bar[XB_XCNT(b.x)], 1u);
    return b;
}
__device__ __forceinline__ void xcd_barrier_complete(unsigned* bar, unsigned x, unsigned& nloc, unsigned& nx) {
    const unsigned G = gridDim.x * gridDim.y * gridDim.z;
    unsigned sum, cnt, mine, sp = 0u;
    for (;;) {
        sum = 0u; cnt = 0u; mine = 0u;
#pragma unroll
        for (unsigned j = 0; j < 16; ++j) { const unsigned c = xb_ld(&bar[XB_XCNT(j)]); sum += c; cnt += (c > 0u) ? 1u : 0u; mine = (j == x) ? c : mine; }
        if (sum == G) break;
        __builtin_amdgcn_s_sleep(1);
        if ((++sp & 255u) == 0u) { if (xb_ld(&bar[XB_TMO])) break; if (sp > XB_SPIN_CAP) { atomicAdd(&bar[XB_TMO], 1u); break; } }
    }
    nloc = mine > 0u ? mine : 1u; nx = cnt > 0u ? cnt : 1u;
}

__device__ __forceinline__ void xcd_barrier(const XcdBarrier& b) {
    asm volatile("s_waitcnt vmcnt(0)" ::: "memory");
    __syncthreads();
    if (threadIdx.x == 0) {
        unsigned* bar = b.bar;
        __builtin_amdgcn_s_waitcnt(0);
        unsigned nloc = b.st[0], nx = b.st[1];
        if (nloc == 0u) { xcd_barrier_complete(bar, b.x, nloc, nx); b.st[0] = nloc; b.st[1] = nx; }
        const unsigned old = xb_add(&bar[XB_XSUB(b.x)], 1u);
        const unsigned gen = old / nloc;
        if (old + 1u == (gen + 1u) * nloc) {
            __builtin_amdgcn_fence(__ATOMIC_RELEASE, "agent");
            asm volatile("s_waitcnt vmcnt(0)" ::: "memory");
            const unsigned og = xb_add(&bar[XB_TOP], 1u);
            const unsigned tg = og / nx;
            if (og + 1u == (tg + 1u) * nx) xb_add(&bar[XB_TOPGEN], 1u);
            else XB_SPIN(xb_ld(&bar[XB_TOPGEN]) == tg, bar);
            __builtin_amdgcn_fence(__ATOMIC_ACQUIRE, "agent");
            xb_add(&bar[XB_XGEN(b.x)], 1u);
            asm volatile("s_waitcnt vmcnt(0)" ::: "memory");
        } else {
            XB_SPIN(xb_ld(&bar[XB_XGEN(b.x)]) == gen, bar);
            __builtin_amdgcn_fence(__ATOMIC_ACQUIRE, "agent");
            asm volatile("s_waitcnt vmcnt(0)" ::: "memory");
        }
    }
    __syncthreads();
}

#ifndef PHMASK
#define PHMASK 0xFFFF
#endif
#ifndef DUPMASK
#define DUPMASK 0
#endif
#define PH(k) _Pragma("unroll 1") for (int rep_ = 0; rep_ < ((((PHMASK >> (k)) & 1) ? 1 : 0) + (((DUPMASK >> (k)) & 1) ? 1 : 0)); ++rep_)
#define GRID_BAR() do { XcdBarrier b_; b_.bar = (unsigned*)pws(pt); b_.x = xb_xcc_id(); b_.st = (volatile LAS unsigned*)(lds + LDS_BYTES - 512); xcd_barrier(b_); } while (0)
#define RB_ ((bf16_t*)(pws(pt) + WS_RB))
#define RBN_ ((bf16_t*)(pws(pt) + WS_ACT))
#define SS_(k) ((u64*)(pws(pt) + WS_SSP) + (size_t)(k) * M_TOK)
__global__ void __launch_bounds__(512, 2) fwd_kernel(Params P) {
    extern __shared__ __attribute__((aligned(16))) unsigned char lds_raw[];
    LAS unsigned char* lds = (LAS unsigned char*)lds_raw;
    cg::grid_group grid = cg::this_grid();
    const int tid = threadIdx.x, lane = tid & 63, wave = __builtin_amdgcn_readfirstlane(tid >> 6);
    const int G = gridDim.x, bx = blockIdx.x; const int gw = bx * 8 + wave, NGW = G * 8;
    PT pt = (PT)(lds + LDS_BYTES - 256);
    volatile LAS unsigned* xst = (volatile LAS unsigned*)(lds + LDS_BYTES - 512);
    if (tid == 0) { xst[0] = 0u; xst[1] = 0u;
#pragma unroll
        for (int i = 0; i < 28; ++i) { const unsigned long long v = (unsigned long long)P.in[i]; pt[2 * i] = (unsigned)v; pt[2 * i + 1] = (unsigned)(v >> 32); }
        { const unsigned long long v = (unsigned long long)P.out; pt[56] = (unsigned)v; pt[57] = (unsigned)(v >> 32); }
        { const unsigned long long v = (unsigned long long)P.ws; pt[58] = (unsigned)v; pt[59] = (unsigned)(v >> 32); }
    }
    __syncthreads();
    (void)xcd_barrier_post((unsigned*)P.ws, xst);

    PH(0) prologue(pt, lds, gw, NGW, lane, wave);
    __syncthreads();
    grid.sync();

#pragma unroll 1
    for (int layer = 0; layer < NL; ++layer) {
        PH(1) { pg8::Gemm g{layer == 0 ? RB_ : RBN_, (const bf16_t*)(pws(pt) + WS_WIN) + (size_t)layer * 3328 * 1024, M_TOK, 2304, 1024}; pg8::StaticOrder S; S.init(M_TOK, 2304, G, bx);
          EpiStore E{SS_(3 * layer), (bf16_t*)(pws(pt) + WS_PQKV), 1536, (bf16_t*)(pws(pt) + WS_PLX), 512, 6, (float*)(pws(pt) + WS_GATES), 8};
          pg8::gemm_phase<EpiStore, pg8::StaticOrder, true, true>(lds, g, S, E);
          int tl = tid; asm volatile("" : "+v"(tl));
          const f32x4* ps = (const f32x4*)(pin(pt, I_P) + (size_t)layer * M_TOK * PLE); u32x2* pd = (u32x2*)(pws(pt) + WS_PB);
          for (size_t i = (size_t)bx * 512 + tl; i < (size_t)M_TOK * PLE / 4; i += (size_t)G * 512) pd[i] = pk4(ps[i]);
          if (layer > 0) { const u32x4* cs = (const u32x4*)RBN_; u32x4* cd = (u32x4*)RB_;
              for (size_t i = (size_t)bx * 512 + tl; i < (size_t)M_TOK * DM / 8; i += (size_t)G * 512) cd[i] = cs[i]; } }
        GRID_BAR();
        PH(2) for (int wi = gw; wi < 2048; wi += NGW) lru_wave(pt, lds + wave * 16384, wi, layer, lane);
        PH(3) for (int it = bx; it < 4096; it += G) dp_item(pt, lds, it, layer, tid, lane, wave);
        GRID_BAR();
        PH(4) for (int it = bx; it < 256; it += G) dr_item(pt, lds, it, tid, lane, wave);
        __syncthreads();
        PH(5) { pg8::Gemm g{RB_, (const bf16_t*)(pws(pt) + WS_WIN) + ((size_t)layer * 3328 + 2304) * 1024, M_TOK, 1024, 1024}; pg8::StaticOrder S; S.init(M_TOK, 1024, G, bx);
          EpiStore E{SS_(3 * layer), (bf16_t*)(pws(pt) + WS_PZ), 512, (bf16_t*)(pws(pt) + WS_PLG), 512, 2, nullptr, 99};
          pg8::gemm_phase<EpiStore, pg8::StaticOrder, true, true>(lds, g, S, E); }
        GRID_BAR();
        PH(6) m2_rows(pt, layer, gw, NGW, lane);
        GRID_BAR();
        PH(7) { pg8::Gemm g{(const bf16_t*)(pws(pt) + WS_AMIX), (const bf16_t*)(pws(pt) + WS_WOUT) + (size_t)layer * DM * DM, M_TOK, 1024, 1024}; pg8::StaticOrder S; S.init(M_TOK, 1024, G, bx);
          EpiResid<0> E{layer == 0 ? pin(pt, I_X) : pout(pt), pout(pt), RB_, SS_(3 * layer + 1), nullptr, nullptr, nullptr};
          pg8::gemm_phase<EpiResid<0>, pg8::StaticOrder, true, true>(lds, g, S, E); }
        GRID_BAR();
        PH(8) { pg8::Gemm g{RB_, (const bf16_t*)(pws(pt) + WS_WG) + (size_t)layer * FF * DM, M_TOK, FF, 1024}; pg8::StaticOrder S; S.init(M_TOK, FF, G, bx);
          EpiStore E{SS_(3 * layer + 1), (bf16_t*)(pws(pt) + WS_G), FF, nullptr, 0, 99, nullptr, 99};
          pg8::gemm_phase<EpiStore, pg8::StaticOrder, true, true>(lds, g, S, E); }
        GRID_BAR();
        PH(9) { pg8::Gemm g{RB_, (const bf16_t*)(pws(pt) + WS_WU) + (size_t)layer * FF * DM, M_TOK, FF, 1024}; pg8::StaticOrder S; S.init(M_TOK, FF, G, bx);
          EpiGlu E{SS_(3 * layer + 1), (const bf16_t*)(pws(pt) + WS_G), pin(pt, I_FCW) + (size_t)layer * 3 * FF, pin(pt, I_FCB) + (size_t)layer * FF, (bf16_t*)(pws(pt) + WS_ACT)};
          pg8::gemm_phase<EpiGlu, pg8::StaticOrder, true, true>(lds, g, S, E); }
        GRID_BAR();
        PH(10) { pg8::Gemm g{(const bf16_t*)(pws(pt) + WS_ACT), (const bf16_t*)(pws(pt) + WS_WD) + (size_t)layer * DM * FF, M_TOK, 1024, FF}; pg8::StaticOrder S; S.init(M_TOK, 1024, G, bx);
          EpiResid<0> E{pout(pt), pout(pt), RB_, SS_(3 * layer + 2), nullptr, nullptr, nullptr};
          pg8::gemm_phase<EpiResid<0>, pg8::StaticOrder, true, true>(lds, g, S, E); }
        __syncthreads();
        PH(11) { pg8::Gemm g{(const bf16_t*)(pws(pt) + WS_PB), (const bf16_t*)(pws(pt) + WS_WP) + (size_t)layer * DM * PLE, M_TOK, 1024, PLE}; pg8::StaticOrder S; S.init(M_TOK, 1024, G, bx);
          EpiStore E{nullptr, (bf16_t*)(pws(pt) + WS_PP), 1024, nullptr, 0, 99, nullptr, 99};
          pg8::gemm_phase<EpiStore, pg8::StaticOrder, true, true>(lds, g, S, E); }
        GRID_BAR();
        PH(12) { pg8::Gemm g{RB_, (const bf16_t*)(pws(pt) + WS_WPG) + (size_t)layer * DM * DM, M_TOK, 1024, 1024}; pg8::StaticOrder S; S.init(M_TOK, 1024, G, bx);
          EpiResid<1> E{pout(pt), pout(pt), RBN_, SS_(3 * layer + 3), SS_(3 * layer + 2), pin(pt, I_PBG) + (size_t)layer * DM, (const bf16_t*)(pws(pt) + WS_PP)};
          pg8::gemm_phase<EpiResid<1>, pg8::StaticOrder, true, true>(lds, g, S, E); }
        GRID_BAR();
    }
    { const u64* ssF = SS_(12); const f32x4* fg = (const f32x4*)pin(pt, I_FING) + lane;
      for (int m = gw; m < M_TOK; m += NGW) { const float s = rs_of(ssF, m); f32x4* xr = (f32x4*)(pout(pt) + (size_t)m * DM) + lane;
#pragma unroll
          for (int j = 0; j < 4; ++j) xr[64 * j] = xr[64 * j] * s * fg[64 * j]; } }
}

extern "C" void kernel_launch(void* const* d_in, const int* in_sizes, int n_in, void* d_out, int out_size, void* d_ws, size_t ws_size, hipStream_t stream) {
    static int grid = 0;
    if (grid == 0) {
        if (n_in != 28 || ws_size < WS_END) { fprintf(stderr, "kernel_launch: unexpected n_in %d or workspace %zu < %zu\n", n_in, ws_size, (size_t)WS_END); grid = -1; return; }
        int dev = 0, cus = 0, per_cu = 0;
        hipGetDevice(&dev); hipDeviceGetAttribute(&cus, hipDeviceAttributeMultiprocessorCount, dev);
        if (hipFuncSetAttribute((const void*)fwd_kernel, hipFuncAttributeMaxDynamicSharedMemorySize, LDS_BYTES) != hipSuccess) fprintf(stderr, "kernel_launch: hipFuncSetAttribute failed\n");
        if (hipOccupancyMaxActiveBlocksPerMultiprocessor(&per_cu, (const void*)fwd_kernel, 512, LDS_BYTES) != hipSuccess || per_cu < 1) { fprintf(stderr, "kernel_launch: occupancy query says %d\n", per_cu); per_cu = 1; }
        (void)hipGetLastError();
        grid = cus * per_cu; if (grid > 256) grid = 256;
    }
    if (grid < 0) return;
    if (hipMemsetAsync(d_ws, 0, 16384, stream) != hipSuccess) { fprintf(stderr, "kernel_launch: memset of the barrier words failed\n"); return; }
    Params p{};
    for (int i = 0; i < 28; ++i) p.in[i] = (const float*)d_in[i];
    p.out = (float*)d_out; p.ws = (unsigned char*)d_ws;
    void* args[] = {&p};
    hipError_t e = hipLaunchCooperativeKernel((const void*)fwd_kernel, dim3(grid), dim3(512), args, LDS_BYTES, stream);
    if (e != hipSuccess) fprintf(stderr, "cooperative launch failed: %s (grid %d)\n", hipGetErrorString(e), grid);
}
```

```cpp
#include <hip/hip_runtime.h>
#include <hip/hip_cooperative_groups.h>
#include <cstdio>
#include <cstdint>
namespace cg = cooperative_groups;

#define LAS __attribute__((address_space(3)))
typedef unsigned short bf16_t;
typedef short bf16x8 __attribute__((ext_vector_type(8)));
typedef short s16x4 __attribute__((ext_vector_type(4)));
typedef float f32x2 __attribute__((ext_vector_type(2)));
typedef float f32x4 __attribute__((ext_vector_type(4)));
typedef float f32x16 __attribute__((ext_vector_type(16)));
typedef unsigned u32x4 __attribute__((ext_vector_type(4)));
typedef unsigned u32x2 __attribute__((ext_vector_type(2)));
typedef __bf16 bfx2_t __attribute__((ext_vector_type(2)));

constexpr int M_TOK = 65536, DM = 1024, SEQ = 2048, NB = 32, NL = 4;
constexpr int FF = 2816, PLE = 256, INC = 3088;
constexpr float EPS = 1e-6f;

constexpr size_t MiB = 1u << 20;
constexpr size_t WS_SS = 0;
constexpr size_t WS_WIN = 4 * MiB;
constexpr size_t WS_WOUT = WS_WIN + 26 * MiB;
constexpr size_t WS_WG = WS_WOUT + 8 * MiB;
constexpr size_t WS_WU = WS_WG + 22 * MiB;
constexpr size_t WS_WD = WS_WU + 22 * MiB;
constexpr size_t WS_WPG = WS_WD + 22 * MiB;
constexpr size_t WS_WP = WS_WPG + 8 * MiB;
constexpr size_t WS_WAT = WS_WP + 2 * MiB;
constexpr size_t WS_GATES = WS_WAT + 1 * MiB;
constexpr size_t WS_VEC = WS_GATES + 4 * MiB;
constexpr size_t WS_PB = WS_VEC + 8 * MiB;
constexpr size_t WS_RB = WS_PB + 32 * MiB;
constexpr size_t WS_BIG = WS_RB + 128 * MiB;
constexpr size_t WS_PQKV = WS_BIG;
constexpr size_t WS_OF = WS_BIG, WS_OB = WS_BIG + 64 * MiB, WS_PZ = WS_BIG + 128 * MiB;
constexpr size_t WS_PLX = WS_BIG + 192 * MiB, WS_PLG = WS_BIG + 192 * MiB;
constexpr size_t WS_QH = WS_BIG + 256 * MiB, WS_KH = WS_BIG + 320 * MiB, WS_VT = WS_BIG + 384 * MiB;
constexpr size_t WS_TM = WS_BIG + 448 * MiB, WS_AT = WS_BIG + 512 * MiB;
constexpr size_t WS_HF = WS_BIG + 576 * MiB, WS_HB = WS_BIG + 640 * MiB;
constexpr size_t WS_AMIX = WS_BIG + 256 * MiB;
constexpr size_t WS_G = WS_BIG, WS_ACT = WS_BIG + 352 * MiB, WS_PP = WS_BIG;
constexpr size_t WS_SSP = WS_BIG + 704 * MiB;
constexpr size_t WS_END = WS_SSP + 12 * MiB;
constexpr int LDS_BYTES = 153600;

__device__ __forceinline__ unsigned pk2(float lo, float hi) { f32x2 v = {lo, hi}; bfx2_t b = __builtin_convertvector(v, bfx2_t); return __builtin_bit_cast(unsigned, b); }
__device__ __forceinline__ u32x2 pk4(f32x4 v) { u32x2 r; r.x = pk2(v[0], v[1]); r.y = pk2(v[2], v[3]); return r; }
__device__ __forceinline__ float bflo(unsigned w) { return __uint_as_float(w << 16); }
__device__ __forceinline__ float bfhi(unsigned w) { return __uint_as_float(w & 0xffff0000u); }
__device__ __forceinline__ float bf2f(unsigned short b) { return __uint_as_float((unsigned)b << 16); }
__device__ __forceinline__ float fexp(float x) { return __builtin_amdgcn_exp2f(x * 1.4426950408889634f); }
__device__ __forceinline__ float sigm(float x) { return __builtin_amdgcn_rcpf(1.0f + fexp(-x)); }
__device__ __forceinline__ float gelu_t(float x) { const float u = 1.5957691216057308f * (x + 0.044715f * x * x * x); return x * __builtin_amdgcn_rcpf(1.0f + fexp(-u)); }
__device__ __forceinline__ float softplus_f(float x) { return x > 20.f ? x : log1pf(expf(x)); }
__device__ __forceinline__ int swz128(int row, int col) { return row * 256 + ((((col >> 3) ^ (row & 15)) << 4) | ((col & 7) << 1)); }
__device__ __forceinline__ int swz64(int row, int col) { return row * 128 + ((((col >> 3) ^ (row & 7)) << 4) | ((col & 7) << 1)); }
__device__ __forceinline__ int crow(int r, int hi) { return (r & 3) + 8 * (r >> 2) + 4 * hi; }
#define MFMA16(a, b, c) __builtin_amdgcn_mfma_f32_16x16x32_bf16((a), (b), (c), 0, 0, 0)
#define MFMA32(a, b, c) __builtin_amdgcn_mfma_f32_32x32x16_bf16((a), (b), (c), 0, 0, 0)
typedef unsigned long long u64;
__device__ __forceinline__ u64 ss_fix(float s) { return (u64)(s * 1048576.0f + 0.5f); }
__device__ __forceinline__ float rs_of(const u64* ss, int row) { return rsqrtf((float)ss[row] * (1.0f / (1048576.0f * 1024.0f)) + EPS); }
#define LDS_FENCE() asm volatile("s_waitcnt lgkmcnt(0)" ::: "memory")

namespace pg8 {
#define PG8_LAS __attribute__((address_space(3)))
typedef unsigned short bf16_t;
typedef short bf16x8 __attribute__((ext_vector_type(8)));
typedef float f32x4 __attribute__((ext_vector_type(4)));
typedef unsigned u32x4 __attribute__((ext_vector_type(4)));
constexpr int BM = 256, BK = 64, HALF = 128, HTB = HALF * BK * 2  , STAGE_BYTES = 8 * HTB, NXCD = 8, WGM = 8;

__host__ __device__ __forceinline__ int lds_byte(int r, int c) { const int st = (r >> 4) * 2 + (c >> 5), rr = r & 15, cc = c & 31, ob = rr * 64 + cc * 2; return st * 1024 + (ob ^ (((ob >> 9) & 1) << 5)); }
__host__ __device__ __forceinline__ void stage_rc(int b, int& R, int& C) { const int st = b / 1024, sb = b % 1024, swz = sb ^ (((sb >> 9) & 1) << 5); R = (st >> 1) * 16 + swz / 64; C = (st & 1) * 32 + (swz % 64) / 2; }
__host__ __device__ __forceinline__ int perm32(int rho) { const int n = rho >> 4, i = rho & 15; return 8 * (i >> 2) + 4 * n + (i & 3); }

struct Unit { int pm, pn; };
struct Gemm { const bf16_t* A; const bf16_t* Bt; int M, N, K; };

struct StaticOrder {
    int nM, nN, nwg, G, c;
    __host__ __device__ void init(int M, int N, int G_, int c_) { nM = M / BM; nN = N / BM; nwg = nM * nN; G = G_; c = c_; }
    __host__ __device__ bool next(int i, Unit& u) const {
        const long L = (long)i * G + c; if (L >= nwg) return false;
        int wgid = (int)L; { const int q = nwg / NXCD, r = nwg % NXCD, xcd = wgid % NXCD, off = wgid / NXCD; wgid = (xcd < r ? xcd * (q + 1) : r * (q + 1) + (xcd - r) * q) + off; }
        const int nig = WGM * nN, gid = wgid / nig, fm = gid * WGM, gsz = (nM - fm) < WGM ? (nM - fm) : WGM;
        u.pm = fm + ((wgid % nig) % gsz); u.pn = (wgid % nig) / gsz; return true;
    }
    __device__ __forceinline__ void a_ready(const Unit&) const {}
    __device__ __forceinline__ void done(const Unit&) const {}
};

template <class Epi, class Sched, bool ALIGN_EPI = false, bool SP2 = false>
__device__ __forceinline__ void gemm_phase(PG8_LAS unsigned char* lds, const Gemm g, const Sched& S, const Epi& E) {
    int tid_ = threadIdx.x; asm volatile("" : "+v"(tid_));
    const int tid = tid_, wid = __builtin_amdgcn_readfirstlane(tid >> 6), lane = tid & 63, wr = wid >> 2, wc = wid & 3, fr = lane & 15, fq = lane >> 4;
    const int K = g.K, nt = K / BK;
    unsigned voffA[2], voffB[2];
#pragma unroll
    for (int i = 0; i < 2; ++i) { int R, C; stage_rc(tid * 16 + i * 8192, R, C); const int Rb = Epi::PERM ? ((R & ~31) + perm32(R & 31)) : R;
        voffA[i] = (unsigned)(R * K + C) * 2u; voffB[i] = (unsigned)(Rb * K + C) * 2u; }
    const size_t kstep = (size_t)(BK * 2);
    const size_t hstep = (size_t)HALF * K * 2;
    const size_t tstep = 2 * hstep;
    const unsigned ldsw = (unsigned)wid * 1024u;
    const int aoff = lds_byte(wr * 64 + fr, fq * 8), boff = lds_byte(wc * 32 + fr, fq * 8);
#define PG8_SA(b, h) (((b) * 2 + (h)) * HTB)
#define PG8_SB(b, h) ((4 + (b) * 2 + (h)) * HTB)
#define PG8_STAGE(bufoff, gbase, voff) do { _Pragma("unroll") for (int _i = 0; _i < 2; ++_i) \
        __builtin_amdgcn_global_load_lds((const unsigned*)((const char*)(gbase) + (voff)[_i]), (PG8_LAS unsigned*)(lds + (bufoff) + ldsw + _i * 8192), 16, 0, 0); } while (0)
#define PG8_LDA(dst, b, h) do { _Pragma("unroll") for (int m = 0; m < 4; ++m) _Pragma("unroll") for (int k = 0; k < 2; ++k) dst[m][k] = *(const PG8_LAS bf16x8*)(lds + PG8_SA(b, h) + aoff + m * 2048 + k * 1024); } while (0)
#define PG8_LDB(dst, b, h) do { _Pragma("unroll") for (int n = 0; n < 2; ++n) _Pragma("unroll") for (int k = 0; k < 2; ++k) dst[n][k] = *(const PG8_LAS bf16x8*)(lds + PG8_SB(b, h) + boff + n * 2048 + k * 1024); } while (0)
#define PG8_MMA(ai, bj, At, Bt) do { __builtin_amdgcn_s_setprio(1); _Pragma("unroll") for (int m = 0; m < 4; ++m) _Pragma("unroll") for (int n = 0; n < 2; ++n) _Pragma("unroll") for (int k = 0; k < 2; ++k) \
        acc[ai][bj][m][n] = __builtin_amdgcn_mfma_f32_16x16x32_bf16(Bt[n][k], At[m][k], acc[ai][bj][m][n], 0, 0, 0); __builtin_amdgcn_s_setprio(0); } while (0)
#define PG8_WAIT_V(n) asm volatile("s_waitcnt vmcnt(" #n ")" ::: "memory")
#define PG8_WAIT_L(n) asm volatile("s_waitcnt lgkmcnt(" #n ")" ::: "memory")
#define PG8_BAR __builtin_amdgcn_s_barrier()
#define PG8_SCHED __builtin_amdgcn_sched_barrier(0)
    Unit cur, nxt; int ui = 0;
    if (!S.next(0, cur)) return;
    f32x4 acc[2][2][4][2];
#pragma unroll
    for (int a = 0; a < 2; ++a)
#pragma unroll
        for (int b = 0; b < 2; ++b)
#pragma unroll
            for (int m = 0; m < 4; ++m)
#pragma unroll
                for (int n = 0; n < 2; ++n) acc[a][b][m][n] = (f32x4){0.f, 0.f, 0.f, 0.f};
    bf16x8 At[4][2], B0[2][2], B1[2][2];
    const char* cA = (const char*)g.A + (size_t)cur.pm * tstep; const char* cB = (const char*)g.Bt + (size_t)cur.pn * tstep;
    S.a_ready(cur);
    if constexpr (SP2) {
        PG8_STAGE(PG8_SB(0, 0), cB, voffB); PG8_STAGE(PG8_SB(0, 1), cB + hstep, voffB); PG8_STAGE(PG8_SA(0, 0), cA, voffA); PG8_STAGE(PG8_SA(0, 1), cA + hstep, voffA);
        if (wr == 1) PG8_BAR;
        PG8_WAIT_V(2); PG8_BAR;
        PG8_STAGE(PG8_SB(1, 0), cB + kstep, voffB); PG8_STAGE(PG8_SA(1, 0), cA + kstep, voffA); PG8_STAGE(PG8_SB(1, 1), cB + hstep + kstep, voffB);
        PG8_WAIT_V(6); PG8_BAR;
    } else {
        PG8_STAGE(PG8_SB(0, 0), cB, voffB); PG8_STAGE(PG8_SA(0, 0), cA, voffA); PG8_STAGE(PG8_SB(0, 1), cB + hstep, voffB); PG8_STAGE(PG8_SA(0, 1), cA + hstep, voffA);
        if (wr == 1) PG8_BAR;
        PG8_WAIT_V(4); PG8_BAR;
        PG8_STAGE(PG8_SB(1, 0), cB + kstep, voffB); PG8_STAGE(PG8_SA(1, 0), cA + kstep, voffA); PG8_STAGE(PG8_SB(1, 1), cB + hstep + kstep, voffB);
        PG8_WAIT_V(6); PG8_BAR;
    }
    for (;;) {
        const bool has_next = S.next(ui + 1, nxt);
        const char* nA = has_next ? (const char*)g.A + (size_t)nxt.pm * tstep : cA; const char* nB = has_next ? (const char*)g.Bt + (size_t)nxt.pn * tstep : cB;
        for (int t = 0; t < nt; t += 2) {
            const bool last = (t == nt - 2);
            const char* a1 = cA + (size_t)(t + 1) * kstep;
            const char* a2 = last ? nA : cA + (size_t)(t + 2) * kstep; const char* b2 = last ? nB : cB + (size_t)(t + 2) * kstep;
            const char* a3 = a2 + kstep; const char* b3 = b2 + kstep;
            if (last && has_next) S.a_ready(nxt);
            if constexpr (SP2) {
            PG8_LDB(B0, 0, 0); PG8_LDB(B1, 0, 1); PG8_SCHED; PG8_LDA(At, 0, 0); PG8_STAGE(PG8_SA(1, 1), a1 + hstep, voffA);
            PG8_WAIT_V(8); PG8_WAIT_L(0); PG8_BAR; PG8_MMA(0, 0, At, B0); PG8_MMA(0, 1, At, B1); PG8_BAR; PG8_SCHED;
            PG8_LDA(At, 0, 1); PG8_STAGE(PG8_SB(0, 0), b2, voffB); PG8_STAGE(PG8_SB(0, 1), b2 + hstep, voffB); PG8_STAGE(PG8_SA(0, 0), a2, voffA);
            PG8_WAIT_V(8); PG8_WAIT_L(0); PG8_BAR; PG8_MMA(1, 0, At, B0); PG8_MMA(1, 1, At, B1); PG8_BAR; PG8_SCHED;
            PG8_LDB(B0, 1, 0); PG8_LDB(B1, 1, 1); PG8_SCHED; PG8_LDA(At, 1, 0); PG8_STAGE(PG8_SA(0, 1), a2 + hstep, voffA);
            PG8_WAIT_V(8); PG8_WAIT_L(0); PG8_BAR; PG8_MMA(0, 0, At, B0); PG8_MMA(0, 1, At, B1); PG8_BAR; PG8_SCHED;
            PG8_LDA(At, 1, 1); PG8_STAGE(PG8_SB(1, 0), b3, voffB); PG8_STAGE(PG8_SB(1, 1), b3 + hstep, voffB); PG8_STAGE(PG8_SA(1, 0), a3, voffA);
            PG8_WAIT_V(8); PG8_WAIT_L(0); PG8_BAR; PG8_MMA(1, 0, At, B0); PG8_MMA(1, 1, At, B1); PG8_BAR; PG8_SCHED;
            } else {
            PG8_LDB(B0, 0, 0); PG8_SCHED; PG8_LDA(At, 0, 0); PG8_STAGE(PG8_SA(1, 1), a1 + hstep, voffA);
            PG8_WAIT_L(8); PG8_BAR; PG8_WAIT_L(0); PG8_MMA(0, 0, At, B0); PG8_BAR; PG8_SCHED;
            PG8_LDB(B1, 0, 1); PG8_STAGE(PG8_SB(0, 0), b2, voffB);
            PG8_BAR; PG8_WAIT_L(0); PG8_MMA(0, 1, At, B1); PG8_BAR;
            PG8_LDA(At, 0, 1); PG8_STAGE(PG8_SA(0, 0), a2, voffA);
            PG8_BAR; PG8_WAIT_L(0); PG8_MMA(1, 0, At, B0); PG8_BAR; PG8_SCHED;
            PG8_STAGE(PG8_SB(0, 1), b2 + hstep, voffB);
            PG8_WAIT_V(6); PG8_BAR; PG8_MMA(1, 1, At, B1); PG8_BAR;
            PG8_LDB(B0, 1, 0); PG8_SCHED; PG8_LDA(At, 1, 0); PG8_STAGE(PG8_SA(0, 1), a2 + hstep, voffA);
            PG8_WAIT_L(8); PG8_BAR; PG8_WAIT_L(0); PG8_MMA(0, 0, At, B0); PG8_BAR; PG8_SCHED;
            PG8_LDB(B1, 1, 1); PG8_STAGE(PG8_SB(1, 0), b3, voffB);
            PG8_BAR; PG8_WAIT_L(0); PG8_MMA(0, 1, At, B1); PG8_BAR;
            PG8_LDA(At, 1, 1); PG8_STAGE(PG8_SA(1, 0), a3, voffA);
            PG8_BAR; PG8_WAIT_L(0); PG8_MMA(1, 0, At, B0); PG8_BAR; PG8_SCHED;
            PG8_STAGE(PG8_SB(1, 1), b3 + hstep, voffB);
            PG8_WAIT_V(6); PG8_BAR; PG8_MMA(1, 1, At, B1); PG8_BAR;
            }
        }
        if constexpr (ALIGN_EPI) { if (wr == 0) PG8_BAR; }
        if constexpr (!Epi::AFTER_DRAIN) { E(acc, cur, wr, wc, fr, fq); S.done(cur); }
        if (!has_next) break;
#pragma unroll
        for (int a = 0; a < 2; ++a)
#pragma unroll
            for (int b = 0; b < 2; ++b)
#pragma unroll
                for (int m = 0; m < 4; ++m)
#pragma unroll
                    for (int n = 0; n < 2; ++n) acc[a][b][m][n] = (f32x4){0.f, 0.f, 0.f, 0.f};
        cur = nxt; cA = nA; cB = nB; ++ui;
        if constexpr (ALIGN_EPI) { if (wr == 1) PG8_BAR; }
    }
    PG8_WAIT_V(0);
    if constexpr (!ALIGN_EPI) { if (wr == 0) PG8_BAR; }
    PG8_BAR;
    if constexpr (Epi::AFTER_DRAIN) { E.fused(acc, cur, wr, wc, fr, fq, lds, wid, lane); S.done(cur); }
#undef PG8_SA
#undef PG8_SB
#undef PG8_STAGE
#undef PG8_LDA
#undef PG8_LDB
#undef PG8_MMA
#undef PG8_WAIT_V
#undef PG8_WAIT_L
#undef PG8_BAR
#undef PG8_SCHED
}
}

using pg8::Unit;
struct EpiStore {
    static constexpr bool PERM = true, AFTER_DRAIN = false;
    const u64* ss; bf16_t* base0; int ld0; bf16_t* base1; int ld1; int t1; float* gates; int t2;
    __device__ __forceinline__ void operator()(const f32x4 (&acc)[2][2][4][2], const Unit& u, int wr, int wc, int fr, int fq) const {
        const int row0 = u.pm * 256 + wr * 64 + fr; const int pn = u.pn;
        if (pn >= t2) {
            if (wc == 0 && fq < 2) {
#pragma unroll
                for (int ai = 0; ai < 2; ++ai)
#pragma unroll
                    for (int m = 0; m < 4; ++m) { const int row = row0 + ai * 128 + m * 16; const float s = ss ? rs_of(ss, row) : 1.f;
                        float* gp = gates + (size_t)row * 16 + 8 * fq; *(f32x4*)gp = acc[ai][0][m][0] * s; *(f32x4*)(gp + 4) = acc[ai][0][m][1] * s; }
            }
            return;
        }
        bf16_t* base; int ld, colt;
        if (pn >= t1) { base = base1; ld = ld1; colt = (pn - t1) * 256; } else { base = base0; ld = ld0; colt = pn * 256; }
        const int col0 = colt + wc * 32 + 8 * fq;
#pragma unroll
        for (int ai = 0; ai < 2; ++ai)
#pragma unroll
            for (int m = 0; m < 4; ++m) { const int row = row0 + ai * 128 + m * 16; const float s = ss ? rs_of(ss, row) : 1.f;
                bf16_t* rowp = base + (size_t)row * ld + col0;
#pragma unroll
                for (int bj = 0; bj < 2; ++bj) { const f32x4 v0 = acc[ai][bj][m][0] * s, v1 = acc[ai][bj][m][1] * s;
                    u32x4 w; w.x = pk2(v0[0], v0[1]); w.y = pk2(v0[2], v0[3]); w.z = pk2(v1[0], v1[1]); w.w = pk2(v1[2], v1[3]);
                    *(u32x4*)(rowp + bj * 128) = w; } }
    }
};

#ifndef RES_BM
#define RES_BM 4
#endif
#ifndef RES1_BM
#define RES1_BM 2
#endif
template <int MODE> struct EpiResid {
    static constexpr bool PERM = true, AFTER_DRAIN = false;
    const float* rin; float* rout; bf16_t* rb; u64* ss_out; const u64* ss_in; const float* bias; const bf16_t* pp;
    __device__ __forceinline__ void operator()(const f32x4 (&acc)[2][2][4][2], const Unit& u, int wr, int wc, int fr, int fq) const {
        const int row0 = u.pm * 256 + wr * 64 + fr; const int col0 = u.pn * 256 + wc * 32 + 8 * fq;
#pragma unroll
        for (int ai = 0; ai < 2; ++ai) {
            float sq[4] = {0.f, 0.f, 0.f, 0.f};
            if (MODE == 0) {
#pragma unroll
                for (int mh = 0; mh < 4; mh += RES_BM) {
                f32x4 pre[RES_BM][2][2];
#pragma unroll
                for (int m = 0; m < RES_BM; ++m)
#pragma unroll
                    for (int bj = 0; bj < 2; ++bj) { const size_t off = (size_t)(row0 + ai * 128 + (mh + m) * 16) * 1024 + col0 + bj * 128; pre[m][bj][0] = *(const f32x4*)(rin + off); pre[m][bj][1] = *(const f32x4*)(rin + off + 4); }
#pragma unroll
                for (int m = 0; m < RES_BM; ++m)
#pragma unroll
                    for (int bj = 0; bj < 2; ++bj) { const size_t off = (size_t)(row0 + ai * 128 + (mh + m) * 16) * 1024 + col0 + bj * 128;
                        const f32x4 r0 = pre[m][bj][0] + acc[ai][bj][mh + m][0], r1 = pre[m][bj][1] + acc[ai][bj][mh + m][1];
                        *(f32x4*)(rout + off) = r0; *(f32x4*)(rout + off + 4) = r1;
                        u32x4 w; w.x = pk2(r0[0], r0[1]); w.y = pk2(r0[2], r0[3]); w.z = pk2(r1[0], r1[1]); w.w = pk2(r1[2], r1[3]);
                        *(u32x4*)(rb + off) = w;
                        sq[mh + m] += (r0[0] * r0[0] + r0[1] * r0[1]) + (r0[2] * r0[2] + r0[3] * r0[3]) + (r1[0] * r1[0] + r1[1] * r1[1]) + (r1[2] * r1[2] + r1[3] * r1[3]); }
                }
            } else {
                float sin_[4];
#pragma unroll
                for (int m = 0; m < 4; ++m) sin_[m] = rs_of(ss_in, row0 + ai * 128 + m * 16);
#pragma unroll
                for (int bj = 0; bj < 2; ++bj) { const f32x4 b0 = *(const f32x4*)(bias + col0 + bj * 128), b1 = *(const f32x4*)(bias + col0 + bj * 128 + 4);
#pragma unroll
                    for (int mh = 0; mh < 4; mh += RES1_BM) {
                    f32x4 pre[RES1_BM][2]; u32x4 pw[RES1_BM];
#pragma unroll
                    for (int m = 0; m < RES1_BM; ++m) { const size_t off = (size_t)(row0 + ai * 128 + (mh + m) * 16) * 1024 + col0 + bj * 128; pre[m][0] = *(const f32x4*)(rin + off); pre[m][1] = *(const f32x4*)(rin + off + 4); pw[m] = *(const u32x4*)(pp + off); }
#pragma unroll
                    for (int m = 0; m < RES1_BM; ++m) { const size_t off = (size_t)(row0 + ai * 128 + (mh + m) * 16) * 1024 + col0 + bj * 128; const float si = sin_[mh + m];
                        f32x4 a0 = acc[ai][bj][mh + m][0], a1 = acc[ai][bj][mh + m][1];
                        a0[0] = sigm(a0[0] * si + b0[0]) * bflo(pw[m].x); a0[1] = sigm(a0[1] * si + b0[1]) * bfhi(pw[m].x);
                        a0[2] = sigm(a0[2] * si + b0[2]) * bflo(pw[m].y); a0[3] = sigm(a0[3] * si + b0[3]) * bfhi(pw[m].y);
                        a1[0] = sigm(a1[0] * si + b1[0]) * bflo(pw[m].z); a1[1] = sigm(a1[1] * si + b1[1]) * bfhi(pw[m].z);
                        a1[2] = sigm(a1[2] * si + b1[2]) * bflo(pw[m].w); a1[3] = sigm(a1[3] * si + b1[3]) * bfhi(pw[m].w);
                        const f32x4 r0 = pre[m][0] + a0, r1 = pre[m][1] + a1;
                        *(f32x4*)(rout + off) = r0; *(f32x4*)(rout + off + 4) = r1;
                        u32x4 w; w.x = pk2(r0[0], r0[1]); w.y = pk2(r0[2], r0[3]); w.z = pk2(r1[0], r1[1]); w.w = pk2(r1[2], r1[3]);
                        *(u32x4*)(rb + off) = w;
                        sq[mh + m] += (r0[0] * r0[0] + r0[1] * r0[1]) + (r0[2] * r0[2] + r0[3] * r0[3]) + (r1[0] * r1[0] + r1[1] * r1[1]) + (r1[2] * r1[2] + r1[3] * r1[3]); } } }
            }
#pragma unroll
            for (int m = 0; m < 4; ++m) { float q = sq[m]; q += __shfl_xor(q, 16); q += __shfl_xor(q, 32);
                if (fq == 0) atomicAdd(ss_out + (row0 + ai * 128 + m * 16), ss_fix(q)); }
        }
    }
};

#ifndef GLU_BM
#define GLU_BM 2
#endif
struct EpiGlu {
    static constexpr bool PERM = true, AFTER_DRAIN = false;
    const u64* ss; const bf16_t* G; const float* cw; const float* cb; bf16_t* act;
    __device__ __forceinline__ void operator()(const f32x4 (&acc)[2][2][4][2], const Unit& u, int wr, int wc, int fr, int fq) const {
        const int row0 = u.pm * 256 + wr * 64 + fr; const int col0 = u.pn * 256 + wc * 32 + 8 * fq;
#pragma unroll
        for (int bj = 0; bj < 2; ++bj) { const int c = col0 + bj * 128;
            const f32x4 w0a = *(const f32x4*)(cw + c), w0b = *(const f32x4*)(cw + c + 4), w1a = *(const f32x4*)(cw + FF + c), w1b = *(const f32x4*)(cw + FF + c + 4);
            const f32x4 w2a = *(const f32x4*)(cw + 2 * FF + c), w2b = *(const f32x4*)(cw + 2 * FF + c + 4), bba = *(const f32x4*)(cb + c), bbb = *(const f32x4*)(cb + c + 4);
#pragma unroll
            for (int ai = 0; ai < 2; ++ai)
#pragma unroll
            for (int mh = 0; mh < 4; mh += GLU_BM) {
                u32x4 gmv[GLU_BM], glv[GLU_BM], gnv[GLU_BM]; float sv[GLU_BM];
#pragma unroll
                for (int m = 0; m < GLU_BM; ++m) { const int row = row0 + ai * 128 + (mh + m) * 16; const int t = row & (SEQ - 1); const bf16_t* gp = G + (size_t)row * FF + c;
                    gmv[m] = *(const u32x4*)gp; glv[m] = (u32x4){0u, 0u, 0u, 0u}; gnv[m] = (u32x4){0u, 0u, 0u, 0u};
                    if (t > 0) glv[m] = *(const u32x4*)(gp - FF);
                    if (t < SEQ - 1) gnv[m] = *(const u32x4*)(gp + FF);
                    sv[m] = rs_of(ss, row); }
#pragma unroll
                for (int m = 0; m < GLU_BM; ++m) { const int row = row0 + ai * 128 + (mh + m) * 16; const float s = sv[m]; const u32x4 gm = gmv[m], gl = glv[m], gn = gnv[m];
                    f32x4 ga, gb;
                    ga[0] = w0a[0] * bflo(gl.x) + w1a[0] * bflo(gm.x) + w2a[0] * bflo(gn.x) + bba[0];
                    ga[1] = w0a[1] * bfhi(gl.x) + w1a[1] * bfhi(gm.x) + w2a[1] * bfhi(gn.x) + bba[1];
                    ga[2] = w0a[2] * bflo(gl.y) + w1a[2] * bflo(gm.y) + w2a[2] * bflo(gn.y) + bba[2];
                    ga[3] = w0a[3] * bfhi(gl.y) + w1a[3] * bfhi(gm.y) + w2a[3] * bfhi(gn.y) + bba[3];
                    gb[0] = w0b[0] * bflo(gl.z) + w1b[0] * bflo(gm.z) + w2b[0] * bflo(gn.z) + bbb[0];
                    gb[1] = w0b[1] * bfhi(gl.z) + w1b[1] * bfhi(gm.z) + w2b[1] * bfhi(gn.z) + bbb[1];
                    gb[2] = w0b[2] * bflo(gl.w) + w1b[2] * bflo(gm.w) + w2b[2] * bflo(gn.w) + bbb[2];
                    gb[3] = w0b[3] * bfhi(gl.w) + w1b[3] * bfhi(gm.w) + w2b[3] * bfhi(gn.w) + bbb[3];
                    const f32x4 a0 = acc[ai][bj][mh + m][0] * s, a1 = acc[ai][bj][mh + m][1] * s;
                    u32x4 w; w.x = pk2(gelu_t(ga[0]) * a0[0], gelu_t(ga[1]) * a0[1]); w.y = pk2(gelu_t(ga[2]) * a0[2], gelu_t(ga[3]) * a0[3]);
                    w.z = pk2(gelu_t(gb[0]) * a1[0], gelu_t(gb[1]) * a1[1]); w.w = pk2(gelu_t(gb[2]) * a1[2], gelu_t(gb[3]) * a1[3]);
                    *(u32x4*)(act + (size_t)row * FF + c) = w; } } }
    }
};

struct Params { const float* in[28]; float* out; unsigned char* ws; };
typedef LAS unsigned* PT;
__device__ __forceinline__ const float* pin(PT t, int k) { const unsigned lo = __builtin_amdgcn_readfirstlane(t[2 * k]), hi = __builtin_amdgcn_readfirstlane(t[2 * k + 1]); return (const float*)(((unsigned long long)hi << 32) | lo); }
__device__ __forceinline__ float* pout(PT t) { return (float*)pin(t, 28); }
__device__ __forceinline__ unsigned char* pws(PT t) { return (unsigned char*)pin(t, 29); }
enum { I_X = 0, I_P, I_N1G, I_WIN, I_DNCW, I_ALOG, I_DTB, I_DNG, I_LCW, I_LCB, I_LWA, I_LBA, I_LWX, I_LBX, I_LAM, I_LNG, I_WOUT, I_N2G, I_FWG, I_FWU, I_FCW, I_FCB, I_FWD, I_PNG, I_PWG, I_PBG, I_PWP, I_FING };

template <class RM>
__device__ __forceinline__ void tr_item(const float* W, int K, int N, bf16_t* WT, int ldt, const float* gk, const RM& rm, LAS float* scr, int item, int lane) {
    const int nblk = (N + 31) >> 5, kb = item / nblk, nb = item % nblk, k0 = 64 * kb, n0 = 32 * nb;
#pragma unroll 8
    for (int i = 0; i < 32; ++i) { const int kk = 2 * i + (lane >> 5), n = n0 + (lane & 31);
        float v = (n < N) ? W[(size_t)(k0 + kk) * N + n] : 0.f; if (gk) v *= gk[k0 + kk];
        scr[kk * 33 + (lane & 31)] = v; }
    LDS_FENCE();
    const int c = lane & 7;
#pragma unroll
    for (int j = 0; j < 4; ++j) { const int nl = (lane >> 3) + 8 * j, n = n0 + nl; const LAS float* s = scr + (8 * c) * 33 + nl;
        u32x4 o; o.x = pk2(s[0 * 33], s[1 * 33]); o.y = pk2(s[2 * 33], s[3 * 33]); o.z = pk2(s[4 * 33], s[5 * 33]); o.w = pk2(s[6 * 33], s[7 * 33]);
        const int dst = (n < N) ? rm(n) : -1;
        if (dst >= 0) *(u32x4*)(WT + (size_t)dst * ldt + k0 + 8 * c) = o; }
    LDS_FENCE();
}
struct RmId { __device__ __forceinline__ int operator()(int n) const { return n; } };
struct RmIn { __device__ __forceinline__ int operator()(int n) const {
    if (n < 1536) return n;
    if (n < 2048) return 2304 + (n - 1536);
    if (n < 2064) return 2048 + (n - 2048);
    if (n < 2576) return 1536 + (n - 2064);
    return 2816 + (n - 2576);
} };

__device__ __forceinline__ void prologue(PT pt, LAS unsigned char* lds, int gw, int NGW, int lane, int wave) {
    asm volatile("" : "+v"(lane));
    unsigned char* ws = pws(pt);
    { u32x4* z = (u32x4*)((u64*)(ws + WS_SSP) + M_TOK); const size_t n4 = (size_t)12 * M_TOK / 2;
      for (size_t i = (size_t)gw * 64 + lane; i < n4; i += (size_t)NGW * 64) z[i] = (u32x4){0u, 0u, 0u, 0u}; }
    for (int l = 0; l < NL; ++l) { u32x4* z = (u32x4*)((bf16_t*)(ws + WS_WIN) + ((size_t)l * 3328 + 2064) * 1024); const int n4 = 240 * 1024 / 8;
        for (int i = gw * 64 + lane; i < n4; i += NGW * 64) z[i] = (u32x4){0u, 0u, 0u, 0u}; }
    LAS float* scr = (LAS float*)(lds + wave * 16384);
    constexpr int I_IN = 16 * 97, I_OUT = 16 * 32, I_G = 16 * 88, I_D = 44 * 32, I_PG = 16 * 32, I_PP = 4 * 32, I_LA = 32;
    constexpr int PER_L = I_IN + I_OUT + 2 * I_G + I_D + I_PG + I_PP + 2 * I_LA;
    for (int it = gw; it < NL * PER_L; it += NGW) {
        const int l = it / PER_L; int r = it % PER_L;
        if (r < I_IN) { tr_item(pin(pt, I_WIN) + (size_t)l * DM * INC, DM, INC, (bf16_t*)(ws + WS_WIN) + (size_t)l * 3328 * 1024, 1024, pin(pt, I_N1G) + l * DM, RmIn(), scr, r, lane); continue; } r -= I_IN;
        if (r < I_OUT) { tr_item(pin(pt, I_WOUT) + (size_t)l * DM * DM, DM, DM, (bf16_t*)(ws + WS_WOUT) + (size_t)l * DM * DM, 1024, nullptr, RmId(), scr, r, lane); continue; } r -= I_OUT;
        if (r < I_G) { tr_item(pin(pt, I_FWG) + (size_t)l * DM * FF, DM, FF, (bf16_t*)(ws + WS_WG) + (size_t)l * FF * DM, 1024, pin(pt, I_N2G) + l * DM, RmId(), scr, r, lane); continue; } r -= I_G;
        if (r < I_G) { tr_item(pin(pt, I_FWU) + (size_t)l * DM * FF, DM, FF, (bf16_t*)(ws + WS_WU) + (size_t)l * FF * DM, 1024, pin(pt, I_N2G) + l * DM, RmId(), scr, r, lane); continue; } r -= I_G;
        if (r < I_D) { tr_item(pin(pt, I_FWD) + (size_t)l * FF * DM, FF, DM, (bf16_t*)(ws + WS_WD) + (size_t)l * DM * FF, FF, nullptr, RmId(), scr, r, lane); continue; } r -= I_D;
        if (r < I_PG) { tr_item(pin(pt, I_PWG) + (size_t)l * DM * DM, DM, DM, (bf16_t*)(ws + WS_WPG) + (size_t)l * DM * DM, 1024, pin(pt, I_PNG) + l * DM, RmId(), scr, r, lane); continue; } r -= I_PG;
        if (r < I_PP) { tr_item(pin(pt, I_PWP) + (size_t)l * PLE * DM, PLE, DM, (bf16_t*)(ws + WS_WP) + (size_t)l * DM * PLE, PLE, nullptr, RmId(), scr, r, lane); continue; } r -= I_PP;
        { const int gate = r / I_LA; r %= I_LA; const int mat = r >> 1, sub = r & 1;
          const float* src = pin(pt, gate ? I_LWX : I_LWA) + ((size_t)l * 16 + mat) * 4096;
          bf16_t* dst = (bf16_t*)(ws + WS_WAT) + (((size_t)l * 16 + mat) * 2 + gate) * 4096;
          tr_item(src, 64, 64, dst, 64, nullptr, RmId(), scr, sub, lane); }
    }
    const float* x = pin(pt, I_X); bf16_t* rb = (bf16_t*)(ws + WS_RB); u64* ss0 = (u64*)(ws + WS_SSP);
    for (int m = gw; m < M_TOK; m += NGW) { const f32x4* xr = (const f32x4*)(x + (size_t)m * DM) + lane; u32x2* o = (u32x2*)(rb + (size_t)m * DM) + lane; float s = 0.f;
#pragma unroll
        for (int j = 0; j < 4; ++j) { const f32x4 v = xr[64 * j]; s += (v[0] * v[0] + v[1] * v[1]) + (v[2] * v[2] + v[3] * v[3]); o[64 * j] = pk4(v); }
#pragma unroll
        for (int o2 = 1; o2 < 64; o2 <<= 1) s += __shfl_xor(s, o2);
        if (lane == 0) ss0[m] = ss_fix(s); }
}

__device__ __forceinline__ void lru_block(PT pt, LAS unsigned char* lds, int bi, int layer, int tid) {
    asm volatile("" : "+v"(tid));
    const int lane = tid & 63, w = tid >> 6;
    unsigned char* ws = pws(pt);
    const int wi = bi * 8 + w;
    const int dq = wi & 3, n = (wi >> 2) & 7, dir = (wi >> 5) & 1, b = wi >> 6;
    const int fr = lane & 15, fq = lane >> 4;
    LAS unsigned char* XCB = lds + (w >> 2) * 4096;
    const int ti = lane >> 2, cq = lane & 3;
    const int cch = 64 * n + 16 * dq + 4 * cq;
    f32x4 cw4[4];
#pragma unroll
    for (int tap = 0; tap < 4; ++tap) cw4[tap] = *(const f32x4*)(pin(pt, I_LCW) + ((size_t)layer * 4 + tap) * 512 + cch);
    const f32x4 cb4 = *(const f32x4*)(pin(pt, I_LCB) + (size_t)layer * 512 + cch);
    const bf16_t* wbase = (const bf16_t*)(ws + WS_WAT) + ((((size_t)layer * 2 + dir) * 8 + n) * 2) * 4096;
    bf16x8 Ba[2], Bx[2];
#pragma unroll
    for (int ks = 0; ks < 2; ++ks) { Ba[ks] = *(const bf16x8*)(wbase + (16 * dq + fr) * 64 + 32 * ks + 8 * fq); Bx[ks] = *(const bf16x8*)(wbase + 4096 + (16 * dq + fr) * 64 + 32 * ks + 8 * fq); }
    const int dch = 64 * n + 16 * dq + fr; const size_t pidx = ((size_t)layer * 2 + dir) * 512 + dch;
    const float ba = pin(pt, I_LBA)[pidx], bx = pin(pt, I_LBX)[pidx], sp8 = 8.0f * 1.4426950408889634f * softplus_f(-pin(pt, I_LAM)[pidx]);
    const bf16_t* plx = (const bf16_t*)(ws + WS_PLX) + (size_t)b * SEQ * 512 + cch;
    bf16_t* hout = (bf16_t*)(ws + (dir ? WS_HB : WS_HF)) + (size_t)b * SEQ * 512 + dch;
    u32x2 xr[4];
#define LRU_LOAD(scn) do { const int tt_ = dir ? (SEQ - 1 - (16 * (scn) + ti)) : (16 * (scn) + ti); _Pragma("unroll") for (int tap = 0; tap < 4; ++tap) { const int t2_ = tt_ + tap - 2; \
        xr[tap] = (u32x2){0u, 0u}; if (t2_ >= 0 && t2_ < SEQ) xr[tap] = *(const u32x2*)(plx + (size_t)t2_ * 512); } } while (0)
    LRU_LOAD(0);
    float hprev = 0.f;
    __syncthreads();
#pragma unroll 1
    for (int sc = 0; sc < 128; ++sc) {
        LAS unsigned char* XC = XCB + (sc & 1) * 2048;
        { f32x4 xa = cb4;
#pragma unroll
          for (int tap = 0; tap < 4; ++tap) { xa[0] += cw4[tap][0] * bflo(xr[tap].x); xa[1] += cw4[tap][1] * bfhi(xr[tap].x); xa[2] += cw4[tap][2] * bflo(xr[tap].y); xa[3] += cw4[tap][3] * bfhi(xr[tap].y); }
          *(LAS u32x2*)(XC + swz64(ti, 16 * dq + 4 * cq)) = pk4(xa); }
        if (sc + 1 < 128) LRU_LOAD(sc + 1);
        __syncthreads();
        const bf16x8 A0 = *(const LAS bf16x8*)(XC + swz64(fr, 8 * fq)), A1 = *(const LAS bf16x8*)(XC + swz64(fr, 32 + 8 * fq));
        f32x4 ca = {0.f, 0.f, 0.f, 0.f}, cx = {0.f, 0.f, 0.f, 0.f};
        ca = MFMA16(A0, Ba[0], ca); ca = MFMA16(A1, Ba[1], ca); cx = MFMA16(A0, Bx[0], cx); cx = MFMA16(A1, Bx[1], cx);
        float Ac[4], Hc[4];
#pragma unroll
        for (int jj = 0; jj < 4; ++jj) { const float xv = bf2f(*(const LAS unsigned short*)(XC + swz64(4 * fq + jj, 16 * dq + fr)));
            const float r = sigm(ca[jj] + ba), ig = sigm(cx[jj] + bx), a = __builtin_amdgcn_exp2f(-r * sp8);
            const float bt = __builtin_amdgcn_sqrtf(fmaxf(1.0f - a * a, 0.f)) * ig * xv;
            Hc[jj] = jj ? (a * Hc[jj - 1] + bt) : bt; Ac[jj] = jj ? (a * Ac[jj - 1]) : a; }
        float A = Ac[3], Bv = Hc[3];
        { const float A1s = __shfl_up(A, 16), B1s = __shfl_up(Bv, 16); if (fq >= 1) { Bv = A * B1s + Bv; A = A * A1s; } }
        { const float A2s = __shfl_up(A, 32), B2s = __shfl_up(Bv, 32); if (fq >= 2) { Bv = A * B2s + Bv; A = A * A2s; } }
        float Ae = __shfl_up(A, 16), Be = __shfl_up(Bv, 16); if (fq == 0) { Ae = 1.f; Be = 0.f; }
        const float hin = Ae * hprev + Be;
        float hv[4];
#pragma unroll
        for (int jj = 0; jj < 4; ++jj) hv[jj] = Ac[jj] * hin + Hc[jj];
        hprev = __shfl(hv[3], 48 + fr);
#pragma unroll
        for (int jj = 0; jj < 4; ++jj) { const int i = 4 * fq + jj; const int t2 = dir ? (SEQ - 1 - (16 * sc + i)) : (16 * sc + i);
            hout[(size_t)t2 * 512] = (bf16_t)(pk2(hv[jj], 0.f) & 0xffffu); }
    }
#undef LRU_LOAD
}

constexpr int DP_BUF0 = 0, DP_BUF1 = 49152, DP_KL = 49152, DP_QL = 49152 + 16384, DP_VL = 49152 + 32768, DP_VEC = 98304, DP_CWL = 99328;
__device__ __forceinline__ void dp_item(PT pt, LAS unsigned char* lds, int item, int layer, int tid, int lane, int w) {
    asm volatile("" : "+v"(tid)); lane = tid & 63; asm volatile("" : "+s"(w));
    unsigned char* ws = pws(pt);
    const int b = item >> 7, h = (item >> 5) & 3, n = item & 31;
    const size_t rowbase = (size_t)b * SEQ + 64 * n;
    LAS float* VEC = (LAS float*)(lds + DP_VEC);
    __syncthreads();
    f32x4 gpre = {0.f, 0.f, 0.f, 0.f};
    if (w == 0) { const float* gp = (const float*)(ws + WS_GATES) + (rowbase + lane) * 16 + h; gpre[0] = gp[0]; gpre[1] = gp[4]; gpre[2] = gp[8]; gpre[3] = gp[12]; }
    { const int i = tid >> 3, c = tid & 7; const int t = 64 * n + i; const size_t R = rowbase + i;
      const bf16_t* pq = (const bf16_t*)(ws + WS_PQKV);
      u32x4 xin[3][4][2];
#pragma unroll
      for (int mat = 0; mat < 3; ++mat)
#pragma unroll
          for (int tap = 0; tap < 4; ++tap) { const int t2 = t + tap - 2; xin[mat][tap][0] = (u32x4){0u, 0u, 0u, 0u}; xin[mat][tap][1] = (u32x4){0u, 0u, 0u, 0u};
              if (t2 >= 0 && t2 < SEQ) { const bf16_t* xp = pq + (R + tap - 2) * 1536 + mat * 512 + h * 128 + 16 * c; xin[mat][tap][0] = *(const u32x4*)xp; xin[mat][tap][1] = *(const u32x4*)(xp + 8); } }
#pragma unroll
      for (int mat = 0; mat < 3; ++mat) {
          f32x4 a[4] = {{0.f, 0.f, 0.f, 0.f}, {0.f, 0.f, 0.f, 0.f}, {0.f, 0.f, 0.f, 0.f}, {0.f, 0.f, 0.f, 0.f}};
#pragma unroll
          for (int tap = 0; tap < 4; ++tap) { const u32x4 x0 = xin[mat][tap][0], x1 = xin[mat][tap][1];
              const LAS float* wp = (const LAS float*)(lds + DP_CWL) + (mat * 4 + tap) * 128 + 16 * c; const f32x4 w0 = *(const LAS f32x4*)wp, w1 = *(const LAS f32x4*)(wp + 4), w2 = *(const LAS f32x4*)(wp + 8), w3 = *(const LAS f32x4*)(wp + 12);
              a[0][0] += w0[0] * bflo(x0.x); a[0][1] += w0[1] * bfhi(x0.x); a[0][2] += w0[2] * bflo(x0.y); a[0][3] += w0[3] * bfhi(x0.y);
              a[1][0] += w1[0] * bflo(x0.z); a[1][1] += w1[1] * bfhi(x0.z); a[1][2] += w1[2] * bflo(x0.w); a[1][3] += w1[3] * bfhi(x0.w);
              a[2][0] += w2[0] * bflo(x1.x); a[2][1] += w2[1] * bfhi(x1.x); a[2][2] += w2[2] * bflo(x1.y); a[2][3] += w2[3] * bfhi(x1.y);
              a[3][0] += w3[0] * bflo(x1.z); a[3][1] += w3[1] * bfhi(x1.z); a[3][2] += w3[2] * bflo(x1.w); a[3][3] += w3[3] * bfhi(x1.w); }
          float ssq = 0.f;
#pragma unroll
          for (int q = 0; q < 4; ++q)
#pragma unroll
              for (int e = 0; e < 4; ++e) { const float v = a[q][e]; const float sv = v * sigm(v); a[q][e] = sv; ssq += sv * sv; }
          float scale = 1.f;
          if (mat < 2) { ssq += __shfl_xor(ssq, 1); ssq += __shfl_xor(ssq, 2); ssq += __shfl_xor(ssq, 4); scale = rsqrtf(ssq + EPS); if (mat == 0) scale *= 0.08838834764831845f; }
          u32x4 o0, o1; o0.x = pk2(a[0][0] * scale, a[0][1] * scale); o0.y = pk2(a[0][2] * scale, a[0][3] * scale); o0.z = pk2(a[1][0] * scale, a[1][1] * scale); o0.w = pk2(a[1][2] * scale, a[1][3] * scale);
          o1.x = pk2(a[2][0] * scale, a[2][1] * scale); o1.y = pk2(a[2][2] * scale, a[2][3] * scale); o1.z = pk2(a[3][0] * scale, a[3][1] * scale); o1.w = pk2(a[3][2] * scale, a[3][3] * scale);
          const int lbase = (mat == 0) ? DP_QL : (mat == 1 ? DP_KL : DP_VL);
          *(LAS u32x4*)(lds + lbase + swz128(i, 16 * c)) = o0; *(LAS u32x4*)(lds + lbase + swz128(i, 16 * c + 8)) = o1;
          if (mat < 2) { bf16_t* gp = (bf16_t*)(ws + (mat == 0 ? WS_QH : WS_KH)) + R * 512 + h * 128 + 16 * c; *(u32x4*)gp = o0; *(u32x4*)(gp + 8) = o1; } }
    }
    if (w == 0) {
        const float bF = sigm(gpre[0]), bB = sigm(gpre[1]);
        float gF = -expf(pin(pt, I_ALOG)[layer * 8 + h]) * softplus_f(gpre[2] + pin(pt, I_DTB)[layer * 8 + h]);
        float gB = -expf(pin(pt, I_ALOG)[layer * 8 + 4 + h]) * softplus_f(gpre[3] + pin(pt, I_DTB)[layer * 8 + 4 + h]);
#pragma unroll
        for (int off = 1; off < 64; off <<= 1) { const float v = __shfl_up(gF, off); if (lane >= off) gF += v; const float u = __shfl_down(gB, off); if (lane + off < 64) gB += u; }
        const float glF = __shfl(gF, 63), glB = __shfl(gB, 0);
        VEC[lane] = bF; VEC[64 + lane] = gF; VEC[128 + lane] = bB; VEC[192 + lane] = gB;
        float* v0 = (float*)(ws + WS_VEC) + (size_t)item * 256; float* v1 = v0 + (size_t)4096 * 256;
        v0[lane] = bF; v0[64 + lane] = fexp(gF); v0[128 + lane] = fexp(glF - gF); if (lane == 0) v0[192] = fexp(glF);
        v1[lane] = bB; v1[64 + lane] = fexp(gB); v1[128 + lane] = fexp(glB - gB); if (lane == 0) v1[192] = fexp(glB);
    }
    __syncthreads();
    { const int e = tid >> 2, jq = tid & 3; unsigned vv[8];
#pragma unroll
      for (int p = 0; p < 8; ++p) { const unsigned lo = *(const LAS unsigned short*)(lds + DP_VL + swz128(16 * jq + 2 * p, e)), hi = *(const LAS unsigned short*)(lds + DP_VL + swz128(16 * jq + 2 * p + 1, e)); vv[p] = lo | (hi << 16); }
      bf16_t* gp = (bf16_t*)(ws + WS_VT) + (size_t)item * 8192 + e * 64 + 16 * jq;
      *(u32x4*)gp = (u32x4){vv[0], vv[1], vv[2], vv[3]}; *(u32x4*)(gp + 8) = (u32x4){vv[4], vv[5], vv[6], vv[7]}; }
    const int r32 = lane & 31, hi = lane >> 5;
    { const int kind = w >> 2, q = w & 3, ta = q >> 1, tb = q & 1;
      f32x16 acc; for (int r = 0; r < 16; ++r) acc[r] = 0.f;
      const int bbase = kind ? DP_QL : DP_KL;
#pragma unroll
      for (int ks = 0; ks < 8; ++ks) { const bf16x8 av = *(const LAS bf16x8*)(lds + DP_KL + swz128(32 * ta + r32, 16 * ks + 8 * hi)), bv = *(const LAS bf16x8*)(lds + bbase + swz128(32 * tb + r32, 16 * ks + 8 * hi)); acc = MFMA32(av, bv, acc); }
      const int gb = 32 * tb + r32;
#pragma unroll
      for (int dir = 0; dir < 2; ++dir) { const LAS float* bet = VEC + dir * 128; const LAS float* gc = VEC + dir * 128 + 64;
          const float gcl = gc[gb], betl = bet[gb];
#pragma unroll
          for (int g = 0; g < 4; ++g) { const int ga0 = 32 * ta + 8 * g + 4 * hi; const f32x4 gca = *(const LAS f32x4*)(gc + ga0), bea = *(const LAS f32x4*)(bet + ga0);
              if (kind == 0) { f32x4 xv, yv, pv;
#pragma unroll
                  for (int jj = 0; jj < 4; ++jj) { const int ga = ga0 + jj; const float kk = acc[4 * g + jj];
                      const bool mx = dir ? (gb < ga) : (gb > ga), my = dir ? (ga < gb) : (ga > gb);
                      const float ed = kk * fexp(-fabsf(gcl - gca[jj]));
                      xv[jj] = mx ? (-betl * ed) : 0.f; yv[jj] = my ? (-bea[jj] * ed) : 0.f; pv[jj] = (ga == gb) ? 1.f : 0.f; }
                  LAS unsigned char* bb = lds + DP_BUF0 + dir * 24576 + swz64(gb, ga0);
                  *(LAS u32x2*)bb = pk4(xv); *(LAS u32x2*)(bb + 8192) = pk4(yv); *(LAS u32x2*)(bb + 16384) = pk4(pv);
              } else { f32x4 av4;
#pragma unroll
                  for (int jj = 0; jj < 4; ++jj) { const int ga = ga0 + jj; const bool ma = dir ? (gb <= ga) : (gb >= ga); av4[jj] = ma ? (acc[4 * g + jj] * fexp(-fabsf(gcl - gca[jj]))) : 0.f; }
                  *(u32x2*)((bf16_t*)(ws + WS_AT) + ((size_t)dir * 4096 + item) * 4096 + gb * 64 + ga0) = pk4(av4); } } }
    }
    __syncthreads();
    { const int dir = w >> 2, q = w & 3, ti = q >> 1, tj = q & 1;
      f32x16 pacc; for (int r = 0; r < 16; ++r) pacc[r] = (32 * tj + crow(r, hi) == 32 * ti + r32) ? 1.f : 0.f;
#pragma unroll 1
      for (int rd = 0; rd < 6; ++rd) { LAS unsigned char* cur = lds + ((rd & 1) ? DP_BUF1 : DP_BUF0) + dir * 24576; LAS unsigned char* nxt = lds + ((rd & 1) ? DP_BUF0 : DP_BUF1) + dir * 24576;
          bf16x8 xf[4], yf[4], pf[4];
#pragma unroll
          for (int ks = 0; ks < 4; ++ks) { xf[ks] = *(const LAS bf16x8*)(cur + swz64(32 * ti + r32, 16 * ks + 8 * hi)); yf[ks] = *(const LAS bf16x8*)(cur + 8192 + swz64(32 * tj + r32, 16 * ks + 8 * hi)); pf[ks] = *(const LAS bf16x8*)(cur + 16384 + swz64(32 * ti + r32, 16 * ks + 8 * hi)); }
#pragma unroll
          for (int ks = 0; ks < 4; ++ks) pacc = MFMA32(yf[ks], pf[ks], pacc);
          if (rd < 5) { f32x16 xa, ya; for (int r = 0; r < 16; ++r) { xa[r] = 0.f; ya[r] = 0.f; }
#pragma unroll
              for (int ks = 0; ks < 4; ++ks) { xa = MFMA32(yf[ks], xf[ks], xa); ya = MFMA32(xf[ks], yf[ks], ya); }
#pragma unroll
              for (int g = 0; g < 4; ++g) { const int c0 = 8 * g + 4 * hi;
                  *(LAS u32x2*)(nxt + swz64(32 * ti + r32, 32 * tj + c0)) = pk4((f32x4){xa[4 * g], xa[4 * g + 1], xa[4 * g + 2], xa[4 * g + 3]});
                  *(LAS u32x2*)(nxt + 8192 + swz64(32 * tj + r32, 32 * ti + c0)) = pk4((f32x4){ya[4 * g], ya[4 * g + 1], ya[4 * g + 2], ya[4 * g + 3]});
                  *(LAS u32x2*)(nxt + 16384 + swz64(32 * ti + r32, 32 * tj + c0)) = pk4((f32x4){pacc[4 * g], pacc[4 * g + 1], pacc[4 * g + 2], pacc[4 * g + 3]}); }
              __syncthreads(); } }
      bf16_t* tg = (bf16_t*)(ws + WS_TM) + ((size_t)dir * 4096 + item) * 4096 + (32 * ti + r32) * 64 + 32 * tj + 4 * hi;
#pragma unroll
      for (int g = 0; g < 4; ++g) *(u32x2*)(tg + 8 * g) = pk4((f32x4){pacc[4 * g], pacc[4 * g + 1], pacc[4 * g + 2], pacc[4 * g + 3]});
    }
}

constexpr int DR_K = 0, DR_Q = 16384, DR_KT = 32768, DR_VT = 49152, DR_T = 65536, DR_A = 73728, DR_VEC = 81920, DR_PRIV = 83968;
__device__ __forceinline__ void dr_item(PT pt, LAS unsigned char* lds, int item, int tid, int lane, int w) {
    asm volatile("" : "+v"(tid)); lane = tid & 63; asm volatile("" : "+s"(w));
    unsigned char* ws = pws(pt);
    const int dir = item & 1, h = (item >> 1) & 3, b = item >> 3;
    const int fr = lane & 15, fq = lane >> 4, es = 16 * w;
    LAS unsigned char* ST = lds + DR_PRIV + w * 8192; LAS unsigned char* RV = ST + 4096; LAS unsigned char* VN2 = ST + 6144;
    const LAS float* VEC = (const LAS float*)(lds + DR_VEC);
    const bf16_t* kh = (const bf16_t*)(ws + WS_KH) + (size_t)b * SEQ * 512 + h * 128;
    const bf16_t* qh = (const bf16_t*)(ws + WS_QH) + (size_t)b * SEQ * 512 + h * 128;
    const int ibase = (b * 4 + h) * 32;
    const bf16_t* vt = (const bf16_t*)(ws + WS_VT) + (size_t)ibase * 8192;
    const bf16_t* tm = (const bf16_t*)(ws + WS_TM) + ((size_t)dir * 4096 + ibase) * 4096;
    const bf16_t* at = (const bf16_t*)(ws + WS_AT) + ((size_t)dir * 4096 + ibase) * 4096;
    const float* vecs = (const float*)(ws + WS_VEC) + ((size_t)dir * 4096 + ibase) * 256;
    bf16_t* og = (bf16_t*)(ws + (dir ? WS_OB : WS_OF)) + (size_t)b * SEQ * 512 + h * 128 + es + fr;
    u32x4 pk[2], pq[2], pv[2], ptm, pa; f32x4 pvec = {0.f, 0.f, 0.f, 0.f};
#define DR_LOAD(nn) do { _Pragma("unroll") for (int u_ = 0; u_ < 2; ++u_) { const int p_ = tid + 512 * u_; \
        pk[u_] = *(const u32x4*)(kh + (size_t)(64 * (nn) + (p_ >> 4)) * 512 + 8 * (p_ & 15)); pq[u_] = *(const u32x4*)(qh + (size_t)(64 * (nn) + (p_ >> 4)) * 512 + 8 * (p_ & 15)); \
        pv[u_] = *(const u32x4*)(vt + (size_t)(nn) * 8192 + p_ * 8); } \
        ptm = *(const u32x4*)(tm + (size_t)(nn) * 4096 + tid * 8); pa = *(const u32x4*)(at + (size_t)(nn) * 4096 + tid * 8); \
        if (tid < 64) pvec = *(const f32x4*)(vecs + (size_t)(nn) * 256 + 4 * tid); } while (0)
#define DR_STORE() do { _Pragma("unroll") for (int u_ = 0; u_ < 2; ++u_) { const int p_ = tid + 512 * u_; const int j_ = p_ >> 4, q_ = p_ & 15; \
        *(LAS u32x4*)(lds + DR_K + swz128(j_, 8 * q_)) = pk[u_]; *(LAS u32x4*)(lds + DR_Q + swz128(j_, 8 * q_)) = pq[u_]; \
        *(LAS unsigned short*)(lds + DR_KT + swz64(8 * q_ + 0, j_)) = (unsigned short)(pk[u_].x & 0xffffu); *(LAS unsigned short*)(lds + DR_KT + swz64(8 * q_ + 1, j_)) = (unsigned short)(pk[u_].x >> 16); \
        *(LAS unsigned short*)(lds + DR_KT + swz64(8 * q_ + 2, j_)) = (unsigned short)(pk[u_].y & 0xffffu); *(LAS unsigned short*)(lds + DR_KT + swz64(8 * q_ + 3, j_)) = (unsigned short)(pk[u_].y >> 16); \
        *(LAS unsigned short*)(lds + DR_KT + swz64(8 * q_ + 4, j_)) = (unsigned short)(pk[u_].z & 0xffffu); *(LAS unsigned short*)(lds + DR_KT + swz64(8 * q_ + 5, j_)) = (unsigned short)(pk[u_].z >> 16); \
        *(LAS unsigned short*)(lds + DR_KT + swz64(8 * q_ + 6, j_)) = (unsigned short)(pk[u_].w & 0xffffu); *(LAS unsigned short*)(lds + DR_KT + swz64(8 * q_ + 7, j_)) = (unsigned short)(pk[u_].w >> 16); \
        *(LAS u32x4*)(lds + DR_VT + swz64(p_ >> 3, 8 * (p_ & 7))) = pv[u_]; } \
        *(LAS u32x4*)(lds + DR_T + swz64(tid >> 3, 8 * (tid & 7))) = ptm; *(LAS u32x4*)(lds + DR_A + swz64(tid >> 3, 8 * (tid & 7))) = pa; \
        if (tid < 64) *(LAS f32x4*)(lds + DR_VEC + 16 * tid) = pvec; } while (0)
    __syncthreads();
    DR_LOAD(dir ? 31 : 0);
    DR_STORE();
#pragma unroll
    for (int q = 0; q < 4; ++q) *(LAS u32x4*)(ST + lane * 64 + q * 16) = (u32x4){0u, 0u, 0u, 0u};
    f32x4 Sacc[8];
#pragma unroll
    for (int d = 0; d < 8; ++d) Sacc[d] = (f32x4){0.f, 0.f, 0.f, 0.f};
    __syncthreads();
#pragma unroll 1
    for (int cc = 0; cc < 32; ++cc) { const int n = dir ? (31 - cc) : cc;
        if (cc + 1 < 32) DR_LOAD(dir ? (30 - cc) : (cc + 1));
        bf16x8 sb[4];
#pragma unroll
        for (int ks = 0; ks < 4; ++ks) sb[ks] = *(const LAS bf16x8*)(ST + swz128(fr, 32 * ks + 8 * fq));
        f32x4 oacc[4];
#pragma unroll
        for (int it = 0; it < 4; ++it) { f32x4 ka = {0.f, 0.f, 0.f, 0.f}, qa = {0.f, 0.f, 0.f, 0.f};
#pragma unroll
            for (int ks = 0; ks < 4; ++ks) { const bf16x8 a1 = *(const LAS bf16x8*)(lds + DR_K + swz128(16 * it + fr, 32 * ks + 8 * fq)), a2 = *(const LAS bf16x8*)(lds + DR_Q + swz128(16 * it + fr, 32 * ks + 8 * fq));
                ka = MFMA16(a1, sb[ks], ka); qa = MFMA16(a2, sb[ks], qa); }
            const int i0 = 16 * it + 4 * fq; const f32x4 be = *(const LAS f32x4*)(VEC + i0), eg = *(const LAS f32x4*)(VEC + 64 + i0);
            const u32x2 vv = *(const LAS u32x2*)(lds + DR_VT + swz64(es + fr, i0));
            f32x4 rh; rh[0] = be[0] * (bflo(vv.x) - eg[0] * ka[0]); rh[1] = be[1] * (bfhi(vv.x) - eg[1] * ka[1]); rh[2] = be[2] * (bflo(vv.y) - eg[2] * ka[2]); rh[3] = be[3] * (bfhi(vv.y) - eg[3] * ka[3]);
            *(LAS u32x2*)(RV + swz64(fr, i0)) = pk4(rh);
            oacc[it] = qa * eg; }
        bf16x8 rb2[2];
#pragma unroll
        for (int ks = 0; ks < 2; ++ks) rb2[ks] = *(const LAS bf16x8*)(RV + swz64(fr, 32 * ks + 8 * fq));
        f32x4 vn[4];
#pragma unroll
        for (int it = 0; it < 4; ++it) { vn[it] = (f32x4){0.f, 0.f, 0.f, 0.f};
#pragma unroll
            for (int ks = 0; ks < 2; ++ks) { const bf16x8 a1 = *(const LAS bf16x8*)(lds + DR_T + swz64(16 * it + fr, 32 * ks + 8 * fq)); vn[it] = MFMA16(a1, rb2[ks], vn[it]); } }
#pragma unroll
        for (int it = 0; it < 4; ++it) { const int i0 = 16 * it + 4 * fq; const f32x4 ed = *(const LAS f32x4*)(VEC + 128 + i0);
            *(LAS u32x2*)(RV + swz64(fr, i0)) = pk4(vn[it]); *(LAS u32x2*)(VN2 + swz64(fr, i0)) = pk4(vn[it] * ed); }
        bf16x8 vb[2], vb2[2];
#pragma unroll
        for (int ks = 0; ks < 2; ++ks) { vb[ks] = *(const LAS bf16x8*)(RV + swz64(fr, 32 * ks + 8 * fq)); vb2[ks] = *(const LAS bf16x8*)(VN2 + swz64(fr, 32 * ks + 8 * fq)); }
#pragma unroll
        for (int it = 0; it < 4; ++it)
#pragma unroll
            for (int ks = 0; ks < 2; ++ks) { const bf16x8 a1 = *(const LAS bf16x8*)(lds + DR_A + swz64(16 * it + fr, 32 * ks + 8 * fq)); oacc[it] = MFMA16(a1, vb[ks], oacc[it]); }
        const float cdec = VEC[192];
#pragma unroll
        for (int dt = 0; dt < 8; ++dt) { Sacc[dt] = Sacc[dt] * cdec;
#pragma unroll
            for (int ks = 0; ks < 2; ++ks) { const bf16x8 a1 = *(const LAS bf16x8*)(lds + DR_KT + swz64(16 * dt + fr, 32 * ks + 8 * fq)); Sacc[dt] = MFMA16(a1, vb2[ks], Sacc[dt]); }
            *(LAS u32x2*)(ST + swz128(fr, 16 * dt + 4 * fq)) = pk4(Sacc[dt]); }
#pragma unroll
        for (int it = 0; it < 4; ++it)
#pragma unroll
            for (int jj = 0; jj < 4; ++jj) og[(size_t)(64 * n + 16 * it + 4 * fq + jj) * 512] = (bf16_t)(pk2(oacc[it][jj], 0.f) & 0xffffu);
        __syncthreads();
        if (cc + 1 < 32) DR_STORE();
        __syncthreads();
    }
#undef DR_LOAD
#undef DR_STORE
}

__device__ __forceinline__ void m2_rows(PT pt, int layer, int gw, int NGW, int lane) {
    asm volatile("" : "+v"(lane));
    unsigned char* ws = pws(pt);
    const bf16_t* of = (const bf16_t*)(ws + WS_OF); const bf16_t* ob = (const bf16_t*)(ws + WS_OB); const bf16_t* pz = (const bf16_t*)(ws + WS_PZ);
    const bf16_t* hf = (const bf16_t*)(ws + WS_HF); const bf16_t* hb = (const bf16_t*)(ws + WS_HB); const bf16_t* plg = (const bf16_t*)(ws + WS_PLG);
    bf16_t* amix = (bf16_t*)(ws + WS_AMIX);
    const float* dng = pin(pt, I_DNG) + layer * 128 + 8 * (lane & 15); const float* lng = pin(pt, I_LNG) + layer * 512 + 8 * lane;
    const f32x4 dg0 = *(const f32x4*)dng, dg1 = *(const f32x4*)(dng + 4), lg0 = *(const f32x4*)lng, lg1 = *(const f32x4*)(lng + 4);
    for (int m = gw; m < M_TOK; m += NGW) { const size_t o = (size_t)m * 512 + 8 * lane;
        const u32x4 a = *(const u32x4*)(of + o), b2 = *(const u32x4*)(ob + o), z = *(const u32x4*)(pz + o);
        const u32x4 c = *(const u32x4*)(hf + o), d = *(const u32x4*)(hb + o), g = *(const u32x4*)(plg + o);
        float v[8], y[8];
        v[0] = bflo(a.x) + bflo(b2.x); v[1] = bfhi(a.x) + bfhi(b2.x); v[2] = bflo(a.y) + bflo(b2.y); v[3] = bfhi(a.y) + bfhi(b2.y);
        v[4] = bflo(a.z) + bflo(b2.z); v[5] = bfhi(a.z) + bfhi(b2.z); v[6] = bflo(a.w) + bflo(b2.w); v[7] = bfhi(a.w) + bfhi(b2.w);
        float s1 = 0.f;
#pragma unroll
        for (int e = 0; e < 8; ++e) s1 += v[e] * v[e];
        s1 += __shfl_xor(s1, 1); s1 += __shfl_xor(s1, 2); s1 += __shfl_xor(s1, 4); s1 += __shfl_xor(s1, 8);
        const float r1 = rsqrtf(s1 * (1.0f / 128.0f) + EPS);
        float zz[8] = {bflo(z.x), bfhi(z.x), bflo(z.y), bfhi(z.y), bflo(z.z), bfhi(z.z), bflo(z.w), bfhi(z.w)};
        float gg[8] = {bflo(g.x), bfhi(g.x), bflo(g.y), bfhi(g.y), bflo(g.z), bfhi(g.z), bflo(g.w), bfhi(g.w)};
        float hh[8] = {bflo(c.x) + bflo(d.x), bfhi(c.x) + bfhi(d.x), bflo(c.y) + bflo(d.y), bfhi(c.y) + bfhi(d.y), bflo(c.z) + bflo(d.z), bfhi(c.z) + bfhi(d.z), bflo(c.w) + bflo(d.w), bfhi(c.w) + bfhi(d.w)};
        float s2 = 0.f;
#pragma unroll
        for (int e = 0; e < 8; ++e) { const float dgv = e < 4 ? dg0[e & 3] : dg1[e & 3]; v[e] = v[e] * r1 * dgv * (zz[e] * sigm(zz[e])); y[e] = gelu_t(gg[e]) * hh[e]; s2 += y[e] * y[e]; }
#pragma unroll
        for (int o2 = 1; o2 < 64; o2 <<= 1) s2 += __shfl_xor(s2, o2);
        const float r2 = rsqrtf(s2 * (1.0f / 512.0f) + EPS);
#pragma unroll
        for (int e = 0; e < 8; ++e) { const float lgv = e < 4 ? lg0[e & 3] : lg1[e & 3]; y[e] = y[e] * r2 * lgv; }
        u32x4 w1, w2; w1.x = pk2(v[0], v[1]); w1.y = pk2(v[2], v[3]); w1.z = pk2(v[4], v[5]); w1.w = pk2(v[6], v[7]);
        w2.x = pk2(y[0], y[1]); w2.y = pk2(y[2], y[3]); w2.z = pk2(y[4], y[5]); w2.w = pk2(y[6], y[7]);
        *(u32x4*)(amix + (size_t)m * 1024 + 8 * lane) = w1; *(u32x4*)(amix + (size_t)m * 1024 + 512 + 8 * lane) = w2; }
}

#define XB_TMO      128
#define XB_XCNT(j)  (256  + 64 * (j))
#define XB_XSUB(j)  (1280 + 64 * (j))
#define XB_XGEN(j)  (2304 + 64 * (j))
#define XB_TOP      3328
#define XB_TOPGEN   3392
#define XCD_BAR_WORDS 3456
#define XB_SPIN_CAP (1u << 18)

__device__ __forceinline__ unsigned xb_ld(unsigned* p)              { return __hip_atomic_load(p, __ATOMIC_RELAXED, __HIP_MEMORY_SCOPE_AGENT); }
__device__ __forceinline__ unsigned xb_add(unsigned* p, unsigned v) { return __hip_atomic_fetch_add(p, v, __ATOMIC_RELAXED, __HIP_MEMORY_SCOPE_AGENT); }
__device__ __forceinline__ unsigned xb_xcc_id() { return (unsigned)__builtin_amdgcn_s_getreg((3 << 11) | 20) & 0xFu; }
#define XB_SPIN(cond, bar) do { unsigned _sp = 0; while (cond) { __builtin_amdgcn_s_sleep(1); \
    if ((++_sp & 255u) == 0u) { if (xb_ld(&(bar)[XB_TMO])) break; if (_sp > XB_SPIN_CAP) { atomicAdd(&(bar)[XB_TMO], 1u); break; } } } } while (0)

struct XcdBarrier {
    unsigned* bar; unsigned x;
    volatile LAS unsigned* st;
};

__device__ __forceinline__ XcdBarrier xcd_barrier_post(unsigned* bar, volatile LAS unsigned* st) {
    XcdBarrier b; b.bar = bar; b.x = xb_xcc_id(); b.st = st;
    if (threadIdx.x == 0) (void)xb_add(&bar[XB_XCNT(b.x)], 1u);
    return b;
}
__device__ __forceinline__ void xcd_barrier_complete(unsigned* bar, unsigned x, unsigned& nloc, unsigned& nx) {
    const unsigned G = gridDim.x * gridDim.y * gridDim.z;
    unsigned sum, cnt, mine, sp = 0u;
    for (;;) {
        sum = 0u; cnt = 0u; mine = 0u;
#pragma unroll
        for (unsigned j = 0; j < 16; ++j) { const unsigned c = xb_ld(&bar[XB_XCNT(j)]); sum += c; cnt += (c > 0u) ? 1u : 0u; mine = (j == x) ? c : mine; }
        if (sum == G) break;
        __builtin_amdgcn_s_sleep(1);
        if ((++sp & 255u) == 0u) { if (xb_ld(&bar[XB_TMO])) break; if (sp > XB_SPIN_CAP) { atomicAdd(&bar[XB_TMO], 1u); break; } }
    }
    nloc = mine > 0u ? mine : 1u; nx = cnt > 0u ? cnt : 1u;
}

__device__ __forceinline__ void xcd_barrier(const XcdBarrier& b) {
    asm volatile("s_waitcnt vmcnt(0)" ::: "memory");
    __syncthreads();
    if (threadIdx.x == 0) {
        unsigned* bar = b.bar;
        __builtin_amdgcn_s_waitcnt(0);
        unsigned nloc = b.st[0], nx = b.st[1];
        if (nloc == 0u) { xcd_barrier_complete(bar, b.x, nloc, nx); b.st[0] = nloc; b.st[1] = nx; }
        const unsigned old = xb_add(&bar[XB_XSUB(b.x)], 1u);
        const unsigned gen = old / nloc;
        if (old + 1u == (gen + 1u) * nloc) {
            __builtin_amdgcn_fence(__ATOMIC_RELEASE, "agent");
            asm volatile("s_waitcnt vmcnt(0)" ::: "memory");
            const unsigned og = xb_add(&bar[XB_TOP], 1u);
            const unsigned tg = og / nx;
            if (og + 1u == (tg + 1u) * nx) xb_add(&bar[XB_TOPGEN], 1u);
            else XB_SPIN(xb_ld(&bar[XB_TOPGEN]) == tg, bar);
            __builtin_amdgcn_fence(__ATOMIC_ACQUIRE, "agent");
            xb_add(&bar[XB_XGEN(b.x)], 1u);
            asm volatile("s_waitcnt vmcnt(0)" ::: "memory");
        } else {
            XB_SPIN(xb_ld(&bar[XB_XGEN(b.x)]) == gen, bar);
            __builtin_amdgcn_fence(__ATOMIC_ACQUIRE, "agent");
            asm volatile("s_waitcnt vmcnt(0)" ::: "memory");
        }
    }
    __syncthreads();
}

#ifndef PHMASK
#define PHMASK 0xFFFF
#endif
#ifndef DUPMASK
#define DUPMASK 0
#endif
#define PH(k) _Pragma("unroll 1") for (int rep_ = 0; rep_ < ((((PHMASK >> (k)) & 1) ? 1 : 0) + (((DUPMASK >> (k)) & 1) ? 1 : 0)); ++rep_)
#define GRID_BAR() do { XcdBarrier b_; b_.bar = (unsigned*)pws(pt); b_.x = xb_xcc_id(); b_.st = (volatile LAS unsigned*)(lds + LDS_BYTES - 512); xcd_barrier(b_); } while (0)
#define RB_ ((bf16_t*)(pws(pt) + WS_RB))
#define RBN_ ((bf16_t*)(pws(pt) + WS_ACT))
#define SS_(k) ((u64*)(pws(pt) + WS_SSP) + (size_t)(k) * M_TOK)
__global__ void __launch_bounds__(512, 2) fwd_kernel(Params P) {
    extern __shared__ __attribute__((aligned(16))) unsigned char lds_raw[];
    LAS unsigned char* lds = (LAS unsigned char*)lds_raw;
    cg::grid_group grid = cg::this_grid();
    const int tid = threadIdx.x, lane = tid & 63, wave = __builtin_amdgcn_readfirstlane(tid >> 6);
    const int G = gridDim.x, bx = blockIdx.x; const int gw = bx * 8 + wave, NGW = G * 8;
    PT pt = (PT)(lds + LDS_BYTES - 256);
    volatile LAS unsigned* xst = (volatile LAS unsigned*)(lds + LDS_BYTES - 512);
    if (tid == 0) { xst[0] = 0u; xst[1] = 0u;
#pragma unroll
        for (int i = 0; i < 28; ++i) { const unsigned long long v = (unsigned long long)P.in[i]; pt[2 * i] = (unsigned)v; pt[2 * i + 1] = (unsigned)(v >> 32); }
        { const unsigned long long v = (unsigned long long)P.out; pt[56] = (unsigned)v; pt[57] = (unsigned)(v >> 32); }
        { const unsigned long long v = (unsigned long long)P.ws; pt[58] = (unsigned)v; pt[59] = (unsigned)(v >> 32); }
    }
    __syncthreads();
    (void)xcd_barrier_post((unsigned*)P.ws, xst);

    PH(0) prologue(pt, lds, gw, NGW, lane, wave);
    __syncthreads();
    grid.sync();

#pragma unroll 1
    for (int layer = 0; layer < NL; ++layer) {
        PH(1) { pg8::Gemm g{layer == 0 ? RB_ : RBN_, (const bf16_t*)(pws(pt) + WS_WIN) + (size_t)layer * 3328 * 1024, M_TOK, 2304, 1024}; pg8::StaticOrder S; S.init(M_TOK, 2304, G, bx);
          EpiStore E{SS_(3 * layer), (bf16_t*)(pws(pt) + WS_PQKV), 1536, (bf16_t*)(pws(pt) + WS_PLX), 512, 6, (float*)(pws(pt) + WS_GATES), 8};
          pg8::gemm_phase<EpiStore, pg8::StaticOrder, true, true>(lds, g, S, E);
          int tl = tid; asm volatile("" : "+v"(tl));
          const f32x4* ps = (const f32x4*)(pin(pt, I_P) + (size_t)layer * M_TOK * PLE); u32x2* pd = (u32x2*)(pws(pt) + WS_PB);
          for (size_t i = (size_t)bx * 512 + tl; i < (size_t)M_TOK * PLE / 4; i += (size_t)G * 512) pd[i] = pk4(ps[i]);
          if (layer > 0) { const u32x4* cs = (const u32x4*)RBN_; u32x4* cd = (u32x4*)RB_;
              for (size_t i = (size_t)bx * 512 + tl; i < (size_t)M_TOK * DM / 8; i += (size_t)G * 512) cd[i] = cs[i]; } }
        GRID_BAR();
        PH(2) for (int bi = bx; bi < 256; bi += G) lru_block(pt, lds, bi, layer, tid);
        PH(3) { __syncthreads();
          { int tl = tid; asm volatile("" : "+v"(tl)); const int hh = (bx >> 5) & 3; const float* cwg = pin(pt, I_DNCW) + (size_t)layer * 4 * 1536;
            for (int e = tl; e < 1536; e += 512) { const int mat = e >> 9, tap = (e >> 7) & 3, ch = e & 127; ((LAS float*)(lds + DP_CWL))[e] = cwg[tap * 1536 + mat * 512 + hh * 128 + ch]; } }
          for (int it = bx; it < 4096; it += G) dp_item(pt, lds, it, layer, tid, lane, wave); }
        GRID_BAR();
        PH(4) for (int it = bx; it < 256; it += G) dr_item(pt, lds, it, tid, lane, wave);
        __syncthreads();
        PH(5) { pg8::Gemm g{RB_, (const bf16_t*)(pws(pt) + WS_WIN) + ((size_t)layer * 3328 + 2304) * 1024, M_TOK, 1024, 1024}; pg8::StaticOrder S; S.init(M_TOK, 1024, G, bx);
          EpiStore E{SS_(3 * layer), (bf16_t*)(pws(pt) + WS_PZ), 512, (bf16_t*)(pws(pt) + WS_PLG), 512, 2, nullptr, 99};
          pg8::gemm_phase<EpiStore, pg8::StaticOrder, true, true>(lds, g, S, E); }
        GRID_BAR();
        PH(6) m2_rows(pt, layer, gw, NGW, lane);
        GRID_BAR();
        PH(7) { pg8::Gemm g{(const bf16_t*)(pws(pt) + WS_AMIX), (const bf16_t*)(pws(pt) + WS_WOUT) + (size_t)layer * DM * DM, M_TOK, 1024, 1024}; pg8::StaticOrder S; S.init(M_TOK, 1024, G, bx);
          EpiResid<0> E{layer == 0 ? pin(pt, I_X) : pout(pt), pout(pt), RB_, SS_(3 * layer + 1), nullptr, nullptr, nullptr};
          pg8::gemm_phase<EpiResid<0>, pg8::StaticOrder, true, true>(lds, g, S, E); }
        GRID_BAR();
        PH(8) { pg8::Gemm g{RB_, (const bf16_t*)(pws(pt) + WS_WG) + (size_t)layer * FF * DM, M_TOK, FF, 1024}; pg8::StaticOrder S; S.init(M_TOK, FF, G, bx);
          EpiStore E{SS_(3 * layer + 1), (bf16_t*)(pws(pt) + WS_G), FF, nullptr, 0, 99, nullptr, 99};
          pg8::gemm_phase<EpiStore, pg8::StaticOrder, true, true>(lds, g, S, E); }
        GRID_BAR();
        PH(9) { pg8::Gemm g{RB_, (const bf16_t*)(pws(pt) + WS_WU) + (size_t)layer * FF * DM, M_TOK, FF, 1024}; pg8::StaticOrder S; S.init(M_TOK, FF, G, bx);
          EpiGlu E{SS_(3 * layer + 1), (const bf16_t*)(pws(pt) + WS_G), pin(pt, I_FCW) + (size_t)layer * 3 * FF, pin(pt, I_FCB) + (size_t)layer * FF, (bf16_t*)(pws(pt) + WS_ACT)};
          pg8::gemm_phase<EpiGlu, pg8::StaticOrder, true, true>(lds, g, S, E); }
        GRID_BAR();
        PH(10) { pg8::Gemm g{(const bf16_t*)(pws(pt) + WS_ACT), (const bf16_t*)(pws(pt) + WS_WD) + (size_t)layer * DM * FF, M_TOK, 1024, FF}; pg8::StaticOrder S; S.init(M_TOK, 1024, G, bx);
          EpiResid<0> E{pout(pt), pout(pt), RB_, SS_(3 * layer + 2), nullptr, nullptr, nullptr};
          pg8::gemm_phase<EpiResid<0>, pg8::StaticOrder, true, true>(lds, g, S, E); }
        __syncthreads();
        PH(11) { pg8::Gemm g{(const bf16_t*)(pws(pt) + WS_PB), (const bf16_t*)(pws(pt) + WS_WP) + (size_t)layer * DM * PLE, M_TOK, 1024, PLE}; pg8::StaticOrder S; S.init(M_TOK, 1024, G, bx);
          EpiStore E{nullptr, (bf16_t*)(pws(pt) + WS_PP), 1024, nullptr, 0, 99, nullptr, 99};
          pg8::gemm_phase<EpiStore, pg8::StaticOrder, true, true>(lds, g, S, E); }
        GRID_BAR();
        PH(12) { pg8::Gemm g{RB_, (const bf16_t*)(pws(pt) + WS_WPG) + (size_t)layer * DM * DM, M_TOK, 1024, 1024}; pg8::StaticOrder S; S.init(M_TOK, 1024, G, bx);
          EpiResid<1> E{pout(pt), pout(pt), RBN_, SS_(3 * layer + 3), SS_(3 * layer + 2), pin(pt, I_PBG) + (size_t)layer * DM, (const bf16_t*)(pws(pt) + WS_PP)};
          pg8::gemm_phase<EpiResid<1>, pg8::StaticOrder, true, true>(lds, g, S, E); }
        GRID_BAR();
    }
    { const u64* ssF = SS_(12); const f32x4* fg = (const f32x4*)pin(pt, I_FING) + lane;
      for (int m = gw; m < M_TOK; m += NGW) { const float s = rs_of(ssF, m); f32x4* xr = (f32x4*)(pout(pt) + (size_t)m * DM) + lane;
#pragma unroll
          for (int j = 0; j < 4; ++j) xr[64 * j] = xr[64 * j] * s * fg[64 * j]; } }
}

extern "C" void kernel_launch(void* const* d_in, const int* in_sizes, int n_in, void* d_out, int out_size, void* d_ws, size_t ws_size, hipStream_t stream) {
    static int grid = 0;
    if (grid == 0) {
        if (n_in != 28 || ws_size < WS_END) { fprintf(stderr, "kernel_launch: unexpected n_in %d or workspace %zu < %zu\n", n_in, ws_size, (size_t)WS_END); grid = -1; return; }
        int dev = 0, cus = 0, per_cu = 0;
        hipGetDevice(&dev); hipDeviceGetAttribute(&cus, hipDeviceAttributeMultiprocessorCount, dev);
        if (hipFuncSetAttribute((const void*)fwd_kernel, hipFuncAttributeMaxDynamicSharedMemorySize, LDS_BYTES) != hipSuccess) fprintf(stderr, "kernel_launch: hipFuncSetAttribute failed\n");
        if (hipOccupancyMaxActiveBlocksPerMultiprocessor(&per_cu, (const void*)fwd_kernel, 512, LDS_BYTES) != hipSuccess || per_cu < 1) { fprintf(stderr, "kernel_launch: occupancy query says %d\n", per_cu); per_cu = 1; }
        (void)hipGetLastError();
        grid = cus * per_cu; if (grid > 256) grid = 256;
    }
    if (grid < 0) return;
    if (hipMemsetAsync(d_ws, 0, 16384, stream) != hipSuccess) { fprintf(stderr, "kernel_launch: memset of the barrier words failed\n"); return; }
    Params p{};
    for (int i = 0; i < 28; ++i) p.in[i] = (const float*)d_in[i];
    p.out = (float*)d_out; p.ws = (unsigned char*)d_ws;
    void* args[] = {&p};
    hipError_t e = hipLaunchCooperativeKernel((const void*)fwd_kernel, dim3(grid), dim3(512), args, LDS_BYTES, stream);
    if (e != hipSuccess) fprintf(stderr, "cooperative launch failed: %s (grid %d)\n", hipGetErrorString(e), grid);
}
```

```cpp
#include <hip/hip_runtime.h>
#include <hip/hip_cooperative_groups.h>
#include <cstdio>
#include <cstdint>
namespace cg = cooperative_groups;

#define LAS __attribute__((address_space(3)))
typedef unsigned short bf16_t;
typedef short bf16x8 __attribute__((ext_vector_type(8)));
typedef short s16x4 __attribute__((ext_vector_type(4)));
typedef float f32x2 __attribute__((ext_vector_type(2)));
typedef float f32x4 __attribute__((ext_vector_type(4)));
typedef float f32x16 __attribute__((ext_vector_type(16)));
typedef unsigned u32x4 __attribute__((ext_vector_type(4)));
typedef unsigned u32x2 __attribute__((ext_vector_type(2)));
typedef __bf16 bfx2_t __attribute__((ext_vector_type(2)));

constexpr int M_TOK = 65536, DM = 1024, SEQ = 2048, NB = 32, NL = 4;
constexpr int FF = 2816, PLE = 256, INC = 3088;
constexpr float EPS = 1e-6f;

constexpr size_t MiB = 1u << 20;
constexpr size_t WS_SS = 0;
constexpr size_t WS_WIN = 4 * MiB;
constexpr size_t WS_WOUT = WS_WIN + 26 * MiB;
constexpr size_t WS_WG = WS_WOUT + 8 * MiB;
constexpr size_t WS_WU = WS_WG + 22 * MiB;
constexpr size_t WS_WD = WS_WU + 22 * MiB;
constexpr size_t WS_WPG = WS_WD + 22 * MiB;
constexpr size_t WS_WP = WS_WPG + 8 * MiB;
constexpr size_t WS_WAT = WS_WP + 2 * MiB;
constexpr size_t WS_GATES = WS_WAT + 1 * MiB;
constexpr size_t WS_VEC = WS_GATES + 4 * MiB;
constexpr size_t WS_PB = WS_VEC + 8 * MiB;
constexpr size_t WS_RB = WS_PB + 32 * MiB;
constexpr size_t WS_BIG = WS_RB + 128 * MiB;
constexpr size_t WS_PQKV = WS_BIG;
constexpr size_t WS_OF = WS_BIG, WS_OB = WS_BIG + 64 * MiB, WS_PZ = WS_BIG + 576 * MiB;
constexpr size_t WS_PLX = WS_BIG + 192 * MiB, WS_PLG = WS_BIG + 640 * MiB;
constexpr size_t WS_QH = WS_BIG + 256 * MiB, WS_KH = WS_BIG + 320 * MiB, WS_VT = WS_BIG + 384 * MiB;
constexpr size_t WS_TM = WS_BIG + 448 * MiB, WS_AT = WS_BIG + 512 * MiB;
constexpr size_t WS_RLO = WS_BIG + 576 * MiB;
constexpr size_t WS_AMIX = WS_BIG + 256 * MiB;
constexpr size_t WS_G = WS_BIG, WS_ACT = WS_BIG + 352 * MiB, WS_PP = WS_BIG;
constexpr size_t WS_SSP = WS_BIG + 704 * MiB;
constexpr size_t WS_END = WS_SSP + 13 * MiB;
constexpr int LDS_BYTES = 153600;

__device__ __forceinline__ unsigned pk2(float lo, float hi) { f32x2 v = {lo, hi}; bfx2_t b = __builtin_convertvector(v, bfx2_t); return __builtin_bit_cast(unsigned, b); }
__device__ __forceinline__ u32x2 pk4(f32x4 v) { u32x2 r; r.x = pk2(v[0], v[1]); r.y = pk2(v[2], v[3]); return r; }
__device__ __forceinline__ float bflo(unsigned w) { return __uint_as_float(w << 16); }
__device__ __forceinline__ float bfhi(unsigned w) { return __uint_as_float(w & 0xffff0000u); }
__device__ __forceinline__ float bf2f(unsigned short b) { return __uint_as_float((unsigned)b << 16); }
__device__ __forceinline__ float fexp(float x) { return __builtin_amdgcn_exp2f(x * 1.4426950408889634f); }
__device__ __forceinline__ float sigm(float x) { return __builtin_amdgcn_rcpf(1.0f + fexp(-x)); }
__device__ __forceinline__ float gelu_t(float x) { const float u = 1.5957691216057308f * (x + 0.044715f * x * x * x); return x * __builtin_amdgcn_rcpf(1.0f + fexp(-u)); }
__device__ __forceinline__ float softplus_f(float x) { return x > 20.f ? x : log1pf(expf(x)); }
__device__ __forceinline__ int swz128(int row, int col) { return row * 256 + ((((col >> 3) ^ (row & 15)) << 4) | ((col & 7) << 1)); }
__device__ __forceinline__ int swz64(int row, int col) { return row * 128 + ((((col >> 3) ^ (row & 7)) << 4) | ((col & 7) << 1)); }
__device__ __forceinline__ int crow(int r, int hi) { return (r & 3) + 8 * (r >> 2) + 4 * hi; }
#define MFMA16(a, b, c) __builtin_amdgcn_mfma_f32_16x16x32_bf16((a), (b), (c), 0, 0, 0)
#define MFMA32(a, b, c) __builtin_amdgcn_mfma_f32_32x32x16_bf16((a), (b), (c), 0, 0, 0)
typedef unsigned long long u64;
__device__ __forceinline__ float rs_of(const float* ss4, int row) { const f32x4 p = *(const f32x4*)(ss4 + (size_t)row * 4); return rsqrtf(((p[0] + p[1]) + (p[2] + p[3])) * (1.0f / 1024.0f) + EPS); }
#define LDS_FENCE() asm volatile("s_waitcnt lgkmcnt(0)" ::: "memory")

#define LBAR() do { asm volatile("s_waitcnt lgkmcnt(0)" ::: "memory"); __builtin_amdgcn_s_barrier(); asm volatile("" ::: "memory"); } while (0)

namespace pg8 {
#define PG8_LAS __attribute__((address_space(3)))
typedef unsigned short bf16_t;
typedef short bf16x8 __attribute__((ext_vector_type(8)));
typedef float f32x4 __attribute__((ext_vector_type(4)));
typedef unsigned u32x4 __attribute__((ext_vector_type(4)));
constexpr int BM = 256, BK = 64, HALF = 128, HTB = HALF * BK * 2  , STAGE_BYTES = 8 * HTB, NXCD = 8, WGM = 8;

__host__ __device__ __forceinline__ int lds_byte(int r, int c) { const int st = (r >> 4) * 2 + (c >> 5), rr = r & 15, cc = c & 31, ob = rr * 64 + cc * 2; return st * 1024 + (ob ^ (((ob >> 9) & 1) << 5)); }
__host__ __device__ __forceinline__ void stage_rc(int b, int& R, int& C) { const int st = b / 1024, sb = b % 1024, swz = sb ^ (((sb >> 9) & 1) << 5); R = (st >> 1) * 16 + swz / 64; C = (st & 1) * 32 + (swz % 64) / 2; }
__host__ __device__ __forceinline__ int perm32(int rho) { const int n = rho >> 4, i = rho & 15; return 8 * (i >> 2) + 4 * n + (i & 3); }

struct Unit { int pm, pn; };
struct Gemm { const bf16_t* A; const bf16_t* Bt; int M, N, K; };

struct StaticOrder {
    int nM, nN, nwg, G, c;
    __host__ __device__ void init(int M, int N, int G_, int c_) { nM = M / BM; nN = N / BM; nwg = nM * nN; G = G_; c = c_; }
    __host__ __device__ bool next(int i, Unit& u) const {
        const long L = (long)i * G + c; if (L >= nwg) return false;
        int wgid = (int)L; { const int q = nwg / NXCD, r = nwg % NXCD, xcd = wgid % NXCD, off = wgid / NXCD; wgid = (xcd < r ? xcd * (q + 1) : r * (q + 1) + (xcd - r) * q) + off; }
        const int nig = WGM * nN, gid = wgid / nig, fm = gid * WGM, gsz = (nM - fm) < WGM ? (nM - fm) : WGM;
        u.pm = fm + ((wgid % nig) % gsz); u.pn = (wgid % nig) / gsz; return true;
    }
    __device__ __forceinline__ void a_ready(const Unit&) const {}
    __device__ __forceinline__ void done(const Unit&) const {}
};

template <class Epi, class Sched, bool ALIGN_EPI = false, bool SP2 = false>
__device__ __forceinline__ void gemm_phase(PG8_LAS unsigned char* lds, const Gemm g, const Sched& S, const Epi& E) {
    int tid_ = threadIdx.x; asm volatile("" : "+v"(tid_));
    const int tid = tid_, wid = __builtin_amdgcn_readfirstlane(tid >> 6), lane = tid & 63, wr = wid >> 2, wc = wid & 3, fr = lane & 15, fq = lane >> 4;
    const int K = g.K, nt = K / BK;
    unsigned voffA[2], voffB[2];
#pragma unroll
    for (int i = 0; i < 2; ++i) { int R, C; stage_rc(tid * 16 + i * 8192, R, C); const int Rb = Epi::PERM ? ((R & ~31) + perm32(R & 31)) : R;
        voffA[i] = (unsigned)(R * K + C) * 2u; voffB[i] = (unsigned)(Rb * K + C) * 2u; }
    const size_t kstep = (size_t)(BK * 2);
    const size_t hstep = (size_t)HALF * K * 2;
    const size_t tstep = 2 * hstep;
    const unsigned ldsw = (unsigned)wid * 1024u;
    const int aoff = lds_byte(wr * 64 + fr, fq * 8), boff = lds_byte(wc * 32 + fr, fq * 8);
#define PG8_SA(b, h) (((b) * 2 + (h)) * HTB)
#define PG8_SB(b, h) ((4 + (b) * 2 + (h)) * HTB)
#define PG8_STAGE(bufoff, gbase, voff) do { _Pragma("unroll") for (int _i = 0; _i < 2; ++_i) \
        __builtin_amdgcn_global_load_lds((const unsigned*)((const char*)(gbase) + (voff)[_i]), (PG8_LAS unsigned*)(lds + (bufoff) + ldsw + _i * 8192), 16, 0, 0); } while (0)
#define PG8_LDA(dst, b, h) do { _Pragma("unroll") for (int m = 0; m < 4; ++m) _Pragma("unroll") for (int k = 0; k < 2; ++k) dst[m][k] = *(const PG8_LAS bf16x8*)(lds + PG8_SA(b, h) + aoff + m * 2048 + k * 1024); } while (0)
#define PG8_LDB(dst, b, h) do { _Pragma("unroll") for (int n = 0; n < 2; ++n) _Pragma("unroll") for (int k = 0; k < 2; ++k) dst[n][k] = *(const PG8_LAS bf16x8*)(lds + PG8_SB(b, h) + boff + n * 2048 + k * 1024); } while (0)
#define PG8_MMA(ai, bj, At, Bt) do { __builtin_amdgcn_s_setprio(1); _Pragma("unroll") for (int m = 0; m < 4; ++m) _Pragma("unroll") for (int n = 0; n < 2; ++n) _Pragma("unroll") for (int k = 0; k < 2; ++k) \
        acc[ai][bj][m][n] = __builtin_amdgcn_mfma_f32_16x16x32_bf16(Bt[n][k], At[m][k], acc[ai][bj][m][n], 0, 0, 0); __builtin_amdgcn_s_setprio(0); } while (0)
#define PG8_WAIT_V(n) asm volatile("s_waitcnt vmcnt(" #n ")" ::: "memory")
#define PG8_WAIT_L(n) asm volatile("s_waitcnt lgkmcnt(" #n ")" ::: "memory")
#define PG8_BAR __builtin_amdgcn_s_barrier()
#define PG8_SCHED __builtin_amdgcn_sched_barrier(0)
    Unit cur, nxt; int ui = 0;
    if (!S.next(0, cur)) return;
    f32x4 acc[2][2][4][2];
#pragma unroll
    for (int a = 0; a < 2; ++a)
#pragma unroll
        for (int b = 0; b < 2; ++b)
#pragma unroll
            for (int m = 0; m < 4; ++m)
#pragma unroll
                for (int n = 0; n < 2; ++n) acc[a][b][m][n] = (f32x4){0.f, 0.f, 0.f, 0.f};
    bf16x8 At[4][2], B0[2][2], B1[2][2];
    const char* cA = (const char*)g.A + (size_t)cur.pm * tstep; const char* cB = (const char*)g.Bt + (size_t)cur.pn * tstep;
    S.a_ready(cur);
    if constexpr (SP2) {
        PG8_STAGE(PG8_SB(0, 0), cB, voffB); PG8_STAGE(PG8_SB(0, 1), cB + hstep, voffB); PG8_STAGE(PG8_SA(0, 0), cA, voffA); PG8_STAGE(PG8_SA(0, 1), cA + hstep, voffA);
        if (wr == 1) PG8_BAR;
        PG8_WAIT_V(2); PG8_BAR;
        PG8_STAGE(PG8_SB(1, 0), cB + kstep, voffB); PG8_STAGE(PG8_SA(1, 0), cA + kstep, voffA); PG8_STAGE(PG8_SB(1, 1), cB + hstep + kstep, voffB);
        PG8_WAIT_V(6); PG8_BAR;
    } else {
        PG8_STAGE(PG8_SB(0, 0), cB, voffB); PG8_STAGE(PG8_SA(0, 0), cA, voffA); PG8_STAGE(PG8_SB(0, 1), cB + hstep, voffB); PG8_STAGE(PG8_SA(0, 1), cA + hstep, voffA);
        if (wr == 1) PG8_BAR;
        PG8_WAIT_V(4); PG8_BAR;
        PG8_STAGE(PG8_SB(1, 0), cB + kstep, voffB); PG8_STAGE(PG8_SA(1, 0), cA + kstep, voffA); PG8_STAGE(PG8_SB(1, 1), cB + hstep + kstep, voffB);
        PG8_WAIT_V(6); PG8_BAR;
    }
    for (;;) {
        const bool has_next = S.next(ui + 1, nxt);
        const char* nA = has_next ? (const char*)g.A + (size_t)nxt.pm * tstep : cA; const char* nB = has_next ? (const char*)g.Bt + (size_t)nxt.pn * tstep : cB;
        for (int t = 0; t < nt; t += 2) {
            const bool last = (t == nt - 2);
            const char* a1 = cA + (size_t)(t + 1) * kstep;
            const char* a2 = last ? nA : cA + (size_t)(t + 2) * kstep; const char* b2 = last ? nB : cB + (size_t)(t + 2) * kstep;
            const char* a3 = a2 + kstep; const char* b3 = b2 + kstep;
            if (last && has_next) S.a_ready(nxt);
            if constexpr (SP2) {
            PG8_LDB(B0, 0, 0); PG8_LDB(B1, 0, 1); PG8_SCHED; PG8_LDA(At, 0, 0); PG8_STAGE(PG8_SA(1, 1), a1 + hstep, voffA);
            PG8_WAIT_V(8); PG8_WAIT_L(0); PG8_BAR; PG8_MMA(0, 0, At, B0); PG8_MMA(0, 1, At, B1); PG8_BAR; PG8_SCHED;
            PG8_LDA(At, 0, 1); PG8_STAGE(PG8_SB(0, 0), b2, voffB); PG8_STAGE(PG8_SB(0, 1), b2 + hstep, voffB); PG8_STAGE(PG8_SA(0, 0), a2, voffA);
            PG8_WAIT_V(8); PG8_WAIT_L(0); PG8_BAR; PG8_MMA(1, 0, At, B0); PG8_MMA(1, 1, At, B1); PG8_BAR; PG8_SCHED;
            PG8_LDB(B0, 1, 0); PG8_LDB(B1, 1, 1); PG8_SCHED; PG8_LDA(At, 1, 0); PG8_STAGE(PG8_SA(0, 1), a2 + hstep, voffA);
            PG8_WAIT_V(8); PG8_WAIT_L(0); PG8_BAR; PG8_MMA(0, 0, At, B0); PG8_MMA(0, 1, At, B1); PG8_BAR; PG8_SCHED;
            PG8_LDA(At, 1, 1); PG8_STAGE(PG8_SB(1, 0), b3, voffB); PG8_STAGE(PG8_SB(1, 1), b3 + hstep, voffB); PG8_STAGE(PG8_SA(1, 0), a3, voffA);
            PG8_WAIT_V(8); PG8_WAIT_L(0); PG8_BAR; PG8_MMA(1, 0, At, B0); PG8_MMA(1, 1, At, B1); PG8_BAR; PG8_SCHED;
            } else {
            PG8_LDB(B0, 0, 0); PG8_SCHED; PG8_LDA(At, 0, 0); PG8_STAGE(PG8_SA(1, 1), a1 + hstep, voffA);
            PG8_WAIT_L(8); PG8_BAR; PG8_WAIT_L(0); PG8_MMA(0, 0, At, B0); PG8_BAR; PG8_SCHED;
            PG8_LDB(B1, 0, 1); PG8_STAGE(PG8_SB(0, 0), b2, voffB);
            PG8_BAR; PG8_WAIT_L(0); PG8_MMA(0, 1, At, B1); PG8_BAR;
            PG8_LDA(At, 0, 1); PG8_STAGE(PG8_SA(0, 0), a2, voffA);
            PG8_BAR; PG8_WAIT_L(0); PG8_MMA(1, 0, At, B0); PG8_BAR; PG8_SCHED;
            PG8_STAGE(PG8_SB(0, 1), b2 + hstep, voffB);
            PG8_WAIT_V(6); PG8_BAR; PG8_MMA(1, 1, At, B1); PG8_BAR;
            PG8_LDB(B0, 1, 0); PG8_SCHED; PG8_LDA(At, 1, 0); PG8_STAGE(PG8_SA(0, 1), a2 + hstep, voffA);
            PG8_WAIT_L(8); PG8_BAR; PG8_WAIT_L(0); PG8_MMA(0, 0, At, B0); PG8_BAR; PG8_SCHED;
            PG8_LDB(B1, 1, 1); PG8_STAGE(PG8_SB(1, 0), b3, voffB);
            PG8_BAR; PG8_WAIT_L(0); PG8_MMA(0, 1, At, B1); PG8_BAR;
            PG8_LDA(At, 1, 1); PG8_STAGE(PG8_SA(1, 0), a3, voffA);
            PG8_BAR; PG8_WAIT_L(0); PG8_MMA(1, 0, At, B0); PG8_BAR; PG8_SCHED;
            PG8_STAGE(PG8_SB(1, 1), b3 + hstep, voffB);
            PG8_WAIT_V(6); PG8_BAR; PG8_MMA(1, 1, At, B1); PG8_BAR;
            }
        }
        if constexpr (ALIGN_EPI) { if (wr == 0) PG8_BAR; }
        if constexpr (!Epi::AFTER_DRAIN) { E(acc, cur, wr, wc, fr, fq); S.done(cur); }
        if (!has_next) break;
#pragma unroll
        for (int a = 0; a < 2; ++a)
#pragma unroll
            for (int b = 0; b < 2; ++b)
#pragma unroll
                for (int m = 0; m < 4; ++m)
#pragma unroll
                    for (int n = 0; n < 2; ++n) acc[a][b][m][n] = (f32x4){0.f, 0.f, 0.f, 0.f};
        cur = nxt; cA = nA; cB = nB; ++ui;
        if constexpr (ALIGN_EPI) { if (wr == 1) PG8_BAR; }
    }
    PG8_WAIT_V(0);
    if constexpr (!ALIGN_EPI) { if (wr == 0) PG8_BAR; }
    PG8_BAR;
    if constexpr (Epi::AFTER_DRAIN) { E.fused(acc, cur, wr, wc, fr, fq, lds, wid, lane); S.done(cur); }
#undef PG8_SA
#undef PG8_SB
#undef PG8_STAGE
#undef PG8_LDA
#undef PG8_LDB
#undef PG8_MMA
#undef PG8_WAIT_V
#undef PG8_WAIT_L
#undef PG8_BAR
#undef PG8_SCHED
}
}

using pg8::Unit;
struct EpiStore {
    static constexpr bool PERM = true, AFTER_DRAIN = false;
    const float* ss; bf16_t* base[4]; int ld[4]; int ts[4]; float* gates; int t2;
    __device__ __forceinline__ void operator()(const f32x4 (&acc)[2][2][4][2], const Unit& u, int wr, int wc, int fr, int fq) const {
        const int row0 = u.pm * 256 + wr * 64 + fr; const int pn = u.pn;
        if (pn >= t2) {
            if (wc == 0 && fq < 2) {
#pragma unroll
                for (int ai = 0; ai < 2; ++ai)
#pragma unroll
                    for (int m = 0; m < 4; ++m) { const int row = row0 + ai * 128 + m * 16; const float s = ss ? rs_of(ss, row) : 1.f;
                        float* gp = gates + (size_t)row * 16 + 8 * fq; *(f32x4*)gp = acc[ai][0][m][0] * s; *(f32x4*)(gp + 4) = acc[ai][0][m][1] * s; }
            }
            return;
        }
        int k = 0; if (pn >= ts[1]) k = 1; if (pn >= ts[2]) k = 2; if (pn >= ts[3]) k = 3;
        bf16_t* bsel = base[0]; int ldsel = ld[0], t0 = ts[0];
        if (k == 1) { bsel = base[1]; ldsel = ld[1]; t0 = ts[1]; } else if (k == 2) { bsel = base[2]; ldsel = ld[2]; t0 = ts[2]; } else if (k == 3) { bsel = base[3]; ldsel = ld[3]; t0 = ts[3]; }
        const int col0 = (pn - t0) * 256 + wc * 32 + 8 * fq;
#pragma unroll
        for (int ai = 0; ai < 2; ++ai)
#pragma unroll
            for (int m = 0; m < 4; ++m) { const int row = row0 + ai * 128 + m * 16; const float s = ss ? rs_of(ss, row) : 1.f;
                bf16_t* rowp = bsel + (size_t)row * ldsel + col0;
#pragma unroll
                for (int bj = 0; bj < 2; ++bj) { const f32x4 v0 = acc[ai][bj][m][0] * s, v1 = acc[ai][bj][m][1] * s;
                    u32x4 w; w.x = pk2(v0[0], v0[1]); w.y = pk2(v0[2], v0[3]); w.z = pk2(v1[0], v1[1]); w.w = pk2(v1[2], v1[3]);
                    *(u32x4*)(rowp + bj * 128) = w; } }
    }
};

#ifndef RES_BM
#define RES_BM 4
#endif
#ifndef RES1_BM
#define RES1_BM 2
#endif
template <int MODE> struct EpiResid {
    static constexpr bool PERM = true, AFTER_DRAIN = false;
    const float* rin32; bf16_t* rb; const bf16_t* rlo; bf16_t* rlo_w; float* ss_out; const float* ss_in; const float* bias; const bf16_t* pp; bf16_t* rb2; LAS float* sl;
    __device__ __forceinline__ void ld_r(size_t off, f32x4& r0, f32x4& r1) const {
        if (rin32) { r0 = *(const f32x4*)(rin32 + off); r1 = *(const f32x4*)(rin32 + off + 4); }
        else { const u32x4 h = *(const u32x4*)(rb + off), l = *(const u32x4*)(rlo + off);
            r0[0] = bflo(h.x) + bflo(l.x); r0[1] = bfhi(h.x) + bfhi(l.x); r0[2] = bflo(h.y) + bflo(l.y); r0[3] = bfhi(h.y) + bfhi(l.y);
            r1[0] = bflo(h.z) + bflo(l.z); r1[1] = bfhi(h.z) + bfhi(l.z); r1[2] = bflo(h.w) + bflo(l.w); r1[3] = bfhi(h.w) + bfhi(l.w); }
    }
    __device__ __forceinline__ float st_r(size_t off, const f32x4& r0, const f32x4& r1) const {
        u32x4 w; w.x = pk2(r0[0], r0[1]); w.y = pk2(r0[2], r0[3]); w.z = pk2(r1[0], r1[1]); w.w = pk2(r1[2], r1[3]);
        u32x4 l; l.x = pk2(r0[0] - bflo(w.x), r0[1] - bfhi(w.x)); l.y = pk2(r0[2] - bflo(w.y), r0[3] - bfhi(w.y)); l.z = pk2(r1[0] - bflo(w.z), r1[1] - bfhi(w.z)); l.w = pk2(r1[2] - bflo(w.w), r1[3] - bfhi(w.w));
        *(u32x4*)(rb + off) = w; *(u32x4*)(rlo_w + off) = l; if (rb2) *(u32x4*)(rb2 + off) = w;
        return (r0[0] * r0[0] + r0[1] * r0[1]) + (r0[2] * r0[2] + r0[3] * r0[3]) + (r1[0] * r1[0] + r1[1] * r1[1]) + (r1[2] * r1[2] + r1[3] * r1[3]);
    }
    __device__ __forceinline__ void operator()(const f32x4 (&acc)[2][2][4][2], const Unit& u, int wr, int wc, int fr, int fq) const {
        run<false>(acc, u, wr, wc, fr, fq);
    }
    template <bool F32IN> __device__ __forceinline__ void run(const f32x4 (&acc)[2][2][4][2], const Unit& u, int wr, int wc, int fr, int fq) const {
        const int row0 = u.pm * 256 + wr * 64 + fr; const int col0 = u.pn * 256 + wc * 32 + 8 * fq;
        float sqa[2][4] = {{0.f, 0.f, 0.f, 0.f}, {0.f, 0.f, 0.f, 0.f}}; float sina[2][4]; f32x4 bia[2][2];
#pragma unroll
        for (int ai = 0; ai < 2; ++ai)
#pragma unroll
            for (int m = 0; m < 4; ++m) sina[ai][m] = (MODE == 1) ? rs_of(ss_in, row0 + ai * 128 + m * 16) : 1.f;
#pragma unroll
        for (int bj = 0; bj < 2; ++bj) { bia[bj][0] = (f32x4){0.f, 0.f, 0.f, 0.f}; bia[bj][1] = (f32x4){0.f, 0.f, 0.f, 0.f};
            if (MODE == 1) { bia[bj][0] = *(const f32x4*)(bias + col0 + bj * 128); bia[bj][1] = *(const f32x4*)(bias + col0 + bj * 128 + 4); } }
        constexpr int RPB = (MODE == 1) ? 1 : 2;
        constexpr int NBAT = 16 / RPB;
        u32x4 ph[2][RPB], pl[2][RPB], pw[2][RPB];
#define RES_AI(b_) ((b_) / (8 / RPB))
#define RES_BJ(b_) (((b_) / (4 / RPB)) & 1)
#define RES_MH(b_) (((b_) % (4 / RPB)) * RPB)
#define RES_OFF(b_, m_) ((size_t)(row0 + RES_AI(b_) * 128 + (RES_MH(b_) + (m_)) * 16) * 1024 + col0 + RES_BJ(b_) * 128)
#define RES_LOAD(b_, buf_) do { _Pragma("unroll") for (int m_ = 0; m_ < RPB; ++m_) { const size_t off_ = RES_OFF(b_, m_); ph[buf_][m_] = *(const u32x4*)(rb + off_); pl[buf_][m_] = *(const u32x4*)(rlo + off_); \
            if (MODE == 1) pw[buf_][m_] = *(const u32x4*)(pp + off_); } } while (0)
        __builtin_amdgcn_sched_barrier(0);
        RES_LOAD(0, 0);
        __builtin_amdgcn_sched_barrier(0);
#pragma unroll
        for (int b = 0; b < NBAT; ++b) { const int buf = b & 1; const int ai = RES_AI(b), bj = RES_BJ(b), mh = RES_MH(b);
            if (b + 1 < NBAT) { RES_LOAD(b + 1, buf ^ 1); }
            __builtin_amdgcn_sched_barrier(0);
            const f32x4 b0 = bia[bj][0], b1 = bia[bj][1];
#pragma unroll
            for (int m = 0; m < RPB; ++m) { const size_t off = RES_OFF(b, m); const float si = sina[ai][mh + m]; const u32x4 h = ph[buf][m], l = pl[buf][m];
                f32x4 p0, p1;
                p0[0] = bflo(h.x) + bflo(l.x); p0[1] = bfhi(h.x) + bfhi(l.x); p0[2] = bflo(h.y) + bflo(l.y); p0[3] = bfhi(h.y) + bfhi(l.y);
                p1[0] = bflo(h.z) + bflo(l.z); p1[1] = bfhi(h.z) + bfhi(l.z); p1[2] = bflo(h.w) + bflo(l.w); p1[3] = bfhi(h.w) + bfhi(l.w);
                f32x4 a0 = acc[ai][bj][mh + m][0], a1 = acc[ai][bj][mh + m][1];
                if (MODE == 1) { const u32x4 w = pw[buf][m];
                    a0[0] = sigm(a0[0] * si + b0[0]) * bflo(w.x); a0[1] = sigm(a0[1] * si + b0[1]) * bfhi(w.x);
                    a0[2] = sigm(a0[2] * si + b0[2]) * bflo(w.y); a0[3] = sigm(a0[3] * si + b0[3]) * bfhi(w.y);
                    a1[0] = sigm(a1[0] * si + b1[0]) * bflo(w.z); a1[1] = sigm(a1[1] * si + b1[1]) * bfhi(w.z);
                    a1[2] = sigm(a1[2] * si + b1[2]) * bflo(w.w); a1[3] = sigm(a1[3] * si + b1[3]) * bfhi(w.w); }
                const f32x4 r0 = p0 + a0, r1 = p1 + a1;
                sqa[ai][mh + m] += st_r(off, r0, r1); }
            __builtin_amdgcn_sched_barrier(0);
        }
#undef RES_AI
#undef RES_BJ
#undef RES_MH
#undef RES_LOAD
#undef RES_OFF
#pragma unroll
        for (int ai = 0; ai < 2; ++ai)
#pragma unroll
            for (int m = 0; m < 4; ++m) { float q = sqa[ai][m]; q += __shfl_xor(q, 16); q += __shfl_xor(q, 32);
                if (fq == 0) sl[(ai * 128 + wr * 64 + m * 16 + fr) * 4 + wc] = q; }
        asm volatile("s_waitcnt lgkmcnt(0)" ::: "memory"); __builtin_amdgcn_s_barrier(); asm volatile("" ::: "memory");
        if (fq == 0) {
#pragma unroll
            for (int ai = 0; ai < 2; ++ai) { const int r = ai * 128 + wr * 64 + wc * 16 + fr; const f32x4 p = *(const LAS f32x4*)(sl + r * 4);
                ss_out[(size_t)(u.pm * 256 + r) * 4 + u.pn] = (p[0] + p[1]) + (p[2] + p[3]); } }
    }
};

#ifndef GLU_BM
#define GLU_BM 2
#endif
struct EpiGlu {
    static constexpr bool PERM = true, AFTER_DRAIN = false;
    const float* ss; const bf16_t* G; const float* cw; const float* cb; bf16_t* act;
    __device__ __forceinline__ void operator()(const f32x4 (&acc)[2][2][4][2], const Unit& u, int wr, int wc, int fr, int fq) const {
        const int row0 = u.pm * 256 + wr * 64 + fr; const int col0 = u.pn * 256 + wc * 32 + 8 * fq;
#pragma unroll
        for (int bj = 0; bj < 2; ++bj) { const int c = col0 + bj * 128;
            const f32x4 w0a = *(const f32x4*)(cw + c), w0b = *(const f32x4*)(cw + c + 4), w1a = *(const f32x4*)(cw + FF + c), w1b = *(const f32x4*)(cw + FF + c + 4);
            const f32x4 w2a = *(const f32x4*)(cw + 2 * FF + c), w2b = *(const f32x4*)(cw + 2 * FF + c + 4), bba = *(const f32x4*)(cb + c), bbb = *(const f32x4*)(cb + c + 4);
#pragma unroll
            for (int ai = 0; ai < 2; ++ai)
#pragma unroll
            for (int mh = 0; mh < 4; mh += GLU_BM) {
                u32x4 gmv[GLU_BM], glv[GLU_BM], gnv[GLU_BM]; float sv[GLU_BM];
#pragma unroll
                for (int m = 0; m < GLU_BM; ++m) { const int row = row0 + ai * 128 + (mh + m) * 16; const int t = row & (SEQ - 1); const bf16_t* gp = G + (size_t)row * FF + c;
                    gmv[m] = *(const u32x4*)gp; glv[m] = (u32x4){0u, 0u, 0u, 0u}; gnv[m] = (u32x4){0u, 0u, 0u, 0u};
                    if (t > 0) glv[m] = *(const u32x4*)(gp - FF);
                    if (t < SEQ - 1) gnv[m] = *(const u32x4*)(gp + FF);
                    sv[m] = rs_of(ss, row); }
#pragma unroll
                for (int m = 0; m < GLU_BM; ++m) { const int row = row0 + ai * 128 + (mh + m) * 16; const float s = sv[m]; const u32x4 gm = gmv[m], gl = glv[m], gn = gnv[m];
                    f32x4 ga, gb;
                    ga[0] = w0a[0] * bflo(gl.x) + w1a[0] * bflo(gm.x) + w2a[0] * bflo(gn.x) + bba[0];
                    ga[1] = w0a[1] * bfhi(gl.x) + w1a[1] * bfhi(gm.x) + w2a[1] * bfhi(gn.x) + bba[1];
                    ga[2] = w0a[2] * bflo(gl.y) + w1a[2] * bflo(gm.y) + w2a[2] * bflo(gn.y) + bba[2];
                    ga[3] = w0a[3] * bfhi(gl.y) + w1a[3] * bfhi(gm.y) + w2a[3] * bfhi(gn.y) + bba[3];
                    gb[0] = w0b[0] * bflo(gl.z) + w1b[0] * bflo(gm.z) + w2b[0] * bflo(gn.z) + bbb[0];
                    gb[1] = w0b[1] * bfhi(gl.z) + w1b[1] * bfhi(gm.z) + w2b[1] * bfhi(gn.z) + bbb[1];
                    gb[2] = w0b[2] * bflo(gl.w) + w1b[2] * bflo(gm.w) + w2b[2] * bflo(gn.w) + bbb[2];
                    gb[3] = w0b[3] * bfhi(gl.w) + w1b[3] * bfhi(gm.w) + w2b[3] * bfhi(gn.w) + bbb[3];
                    const f32x4 a0 = acc[ai][bj][mh + m][0] * s, a1 = acc[ai][bj][mh + m][1] * s;
                    u32x4 w; w.x = pk2(gelu_t(ga[0]) * a0[0], gelu_t(ga[1]) * a0[1]); w.y = pk2(gelu_t(ga[2]) * a0[2], gelu_t(ga[3]) * a0[3]);
                    w.z = pk2(gelu_t(gb[0]) * a1[0], gelu_t(gb[1]) * a1[1]); w.w = pk2(gelu_t(gb[2]) * a1[2], gelu_t(gb[3]) * a1[3]);
                    *(u32x4*)(act + (size_t)row * FF + c) = w; } } }
    }
};

struct Params { const float* in[28]; float* out; unsigned char* ws; };
typedef LAS unsigned* PT;
__device__ __forceinline__ const float* pin(PT t0, int k) { unsigned ta = (unsigned)(size_t)t0; asm volatile("" : "+s"(ta)); const PT t = (PT)(size_t)ta;
    const unsigned lo = __builtin_amdgcn_readfirstlane(t[2 * k]), hi = __builtin_amdgcn_readfirstlane(t[2 * k + 1]); return (const float*)(__attribute__((address_space(1))) const float*)(((unsigned long long)hi << 32) | lo); }
__device__ __forceinline__ float* pout(PT t) { return (float*)pin(t, 28); }
__device__ __forceinline__ unsigned char* pws(PT t) { return (unsigned char*)pin(t, 29); }
enum { I_X = 0, I_P, I_N1G, I_WIN, I_DNCW, I_ALOG, I_DTB, I_DNG, I_LCW, I_LCB, I_LWA, I_LBA, I_LWX, I_LBX, I_LAM, I_LNG, I_WOUT, I_N2G, I_FWG, I_FWU, I_FCW, I_FCB, I_FWD, I_PNG, I_PWG, I_PBG, I_PWP, I_FING };

template <class RM>
__device__ __forceinline__ void tr_item(const float* W, int K, int N, bf16_t* WT, int ldt, const float* gk, const RM& rm, LAS float* scr, int item, int lane) {
    const int nblk = (N + 31) >> 5, kb = item / nblk, nb = item % nblk, k0 = 64 * kb, n0 = 32 * nb;
#pragma unroll
    for (int i = 0; i < 32; ++i) { const int kk = 2 * i + (lane >> 5), n = n0 + (lane & 31);
        float v = (n < N) ? W[(size_t)(k0 + kk) * N + n] : 0.f; if (gk) v *= gk[k0 + kk];
        scr[kk * 33 + (lane & 31)] = v; }
    LDS_FENCE();
    const int c = lane & 7;
#pragma unroll
    for (int j = 0; j < 4; ++j) { const int nl = (lane >> 3) + 8 * j, n = n0 + nl; const LAS float* s = scr + (8 * c) * 33 + nl;
        u32x4 o; o.x = pk2(s[0 * 33], s[1 * 33]); o.y = pk2(s[2 * 33], s[3 * 33]); o.z = pk2(s[4 * 33], s[5 * 33]); o.w = pk2(s[6 * 33], s[7 * 33]);
        const int dst = (n < N) ? rm(n) : -1;
        if (dst >= 0) *(u32x4*)(WT + (size_t)dst * ldt + k0 + 8 * c) = o; }
    LDS_FENCE();
}
struct RmId { __device__ __forceinline__ int operator()(int n) const { return n; } };
struct RmIn { __device__ __forceinline__ int operator()(int n) const {
    if (n < 1536) return n;
    if (n < 2048) return 2048 + (n - 1536);
    if (n < 2064) return 3072 + (n - 2048);
    if (n < 2576) return 1536 + (n - 2064);
    return 2560 + (n - 2576);
} };

__device__ __forceinline__ void prologue(PT pt, LAS unsigned char* lds, int gw, int NGW, int lane, int wave) {
    asm volatile("" : "+v"(lane));
    unsigned char* ws = pws(pt);
    for (int l = 0; l < NL; ++l) { u32x4* z = (u32x4*)((bf16_t*)(ws + WS_WIN) + ((size_t)l * 3328 + 3088) * 1024); const int n4 = 240 * 1024 / 8;
        for (int i = gw * 64 + lane; i < n4; i += NGW * 64) z[i] = (u32x4){0u, 0u, 0u, 0u}; }
    LAS float* scr = (LAS float*)(lds + wave * 16384);
    constexpr int I_IN = 16 * 97, I_OUT = 16 * 32, I_G = 16 * 88, I_D = 44 * 32, I_PG = 16 * 32, I_PP = 4 * 32, I_LA = 32;
    constexpr int PER_L = I_IN + I_OUT + 2 * I_G + I_D + I_PG + I_PP + 2 * I_LA;
    for (int it = gw; it < NL * PER_L; it += NGW) {
        const int l = it / PER_L; int r = it % PER_L;
        if (r < I_IN) { tr_item(pin(pt, I_WIN) + (size_t)l * DM * INC, DM, INC, (bf16_t*)(ws + WS_WIN) + (size_t)l * 3328 * 1024, 1024, pin(pt, I_N1G) + l * DM, RmIn(), scr, r, lane); continue; } r -= I_IN;
        if (r < I_OUT) { tr_item(pin(pt, I_WOUT) + (size_t)l * DM * DM, DM, DM, (bf16_t*)(ws + WS_WOUT) + (size_t)l * DM * DM, 1024, nullptr, RmId(), scr, r, lane); continue; } r -= I_OUT;
        if (r < I_G) { tr_item(pin(pt, I_FWG) + (size_t)l * DM * FF, DM, FF, (bf16_t*)(ws + WS_WG) + (size_t)l * FF * DM, 1024, pin(pt, I_N2G) + l * DM, RmId(), scr, r, lane); continue; } r -= I_G;
        if (r < I_G) { tr_item(pin(pt, I_FWU) + (size_t)l * DM * FF, DM, FF, (bf16_t*)(ws + WS_WU) + (size_t)l * FF * DM, 1024, pin(pt, I_N2G) + l * DM, RmId(), scr, r, lane); continue; } r -= I_G;
        if (r < I_D) { tr_item(pin(pt, I_FWD) + (size_t)l * FF * DM, FF, DM, (bf16_t*)(ws + WS_WD) + (size_t)l * DM * FF, FF, nullptr, RmId(), scr, r, lane); continue; } r -= I_D;
        if (r < I_PG) { tr_item(pin(pt, I_PWG) + (size_t)l * DM * DM, DM, DM, (bf16_t*)(ws + WS_WPG) + (size_t)l * DM * DM, 1024, pin(pt, I_PNG) + l * DM, RmId(), scr, r, lane); continue; } r -= I_PG;
        if (r < I_PP) { tr_item(pin(pt, I_PWP) + (size_t)l * PLE * DM, PLE, DM, (bf16_t*)(ws + WS_WP) + (size_t)l * DM * PLE, PLE, nullptr, RmId(), scr, r, lane); continue; } r -= I_PP;
        { const int gate = r / I_LA; r %= I_LA; const int mat = r >> 1, sub = r & 1;
          const float* src = pin(pt, gate ? I_LWX : I_LWA) + ((size_t)l * 16 + mat) * 4096;
          bf16_t* dst = (bf16_t*)(ws + WS_WAT) + (((size_t)l * 16 + mat) * 2 + gate) * 4096;
          tr_item(src, 64, 64, dst, 64, nullptr, RmId(), scr, sub, lane); }
    }
    const float* x = pin(pt, I_X); bf16_t* rb = (bf16_t*)(ws + WS_RB); float* ss0 = (float*)(ws + WS_SSP); bf16_t* rl = (bf16_t*)pout(pt) + (size_t)M_TOK * 1024;
    for (int m = gw; m < M_TOK; m += NGW) { const f32x4* xr = (const f32x4*)(x + (size_t)m * DM) + lane; u32x2* o = (u32x2*)(rb + (size_t)m * DM) + lane; u32x2* ol = (u32x2*)(rl + (size_t)m * DM) + lane; float s = 0.f;
#pragma unroll
        for (int j = 0; j < 4; ++j) { const f32x4 v = xr[64 * j]; s += (v[0] * v[0] + v[1] * v[1]) + (v[2] * v[2] + v[3] * v[3]); const u32x2 hw = pk4(v); o[64 * j] = hw;
            ol[64 * j] = pk4((f32x4){v[0] - bflo(hw.x), v[1] - bfhi(hw.x), v[2] - bflo(hw.y), v[3] - bfhi(hw.y)}); }
#pragma unroll
        for (int o2 = 1; o2 < 64; o2 <<= 1) s += __shfl_xor(s, o2);
        if (lane < 4) ss0[(size_t)m * 4 + lane] = lane == 0 ? s : 0.f; }
}

__device__ __forceinline__ void lru_block(PT pt, LAS unsigned char* lds, int bi, int layer, int tid) {
    asm volatile("" : "+v"(tid));
    const int lane = tid & 63, w = tid >> 6;
    unsigned char* ws = pws(pt);
    const int wi = bi * 8 + w;
    const int dq = wi & 3, n = (wi >> 2) & 7, dir = (wi >> 5) & 1, b = wi >> 6;
    const int fr = lane & 15, fq = lane >> 4;
    LAS unsigned char* XCB = lds + (w >> 2) * 8192;
    LAS unsigned char* SCN = lds + 16384 + w * 1024;
    const int ti = lane >> 2, cq = lane & 3;
    const int cch = 64 * n + 16 * dq + 4 * cq;
    f32x4 cw4[4];
#pragma unroll
    for (int tap = 0; tap < 4; ++tap) cw4[tap] = *(const f32x4*)(pin(pt, I_LCW) + ((size_t)layer * 4 + tap) * 512 + cch);
    const f32x4 cb4 = *(const f32x4*)(pin(pt, I_LCB) + (size_t)layer * 512 + cch);
    const bf16_t* wbase = (const bf16_t*)(ws + WS_WAT) + ((((size_t)layer * 2 + dir) * 8 + n) * 2) * 4096;
    bf16x8 Ba[2], Bx[2];
#pragma unroll
    for (int ks = 0; ks < 2; ++ks) { Ba[ks] = *(const bf16x8*)(wbase + (16 * dq + fr) * 64 + 32 * ks + 8 * fq); Bx[ks] = *(const bf16x8*)(wbase + 4096 + (16 * dq + fr) * 64 + 32 * ks + 8 * fq); }
    const int dch = 64 * n + 16 * dq + fr; const size_t pidx = ((size_t)layer * 2 + dir) * 512 + dch;
    const float ba = pin(pt, I_LBA)[pidx], bx = pin(pt, I_LBX)[pidx], sp8 = 8.0f * 1.4426950408889634f * softplus_f(-pin(pt, I_LAM)[pidx]);
    const bf16_t* plx = (const bf16_t*)(ws + WS_PLX) + (size_t)b * SEQ * 512 + cch;
    bf16_t* hout = (bf16_t*)pout(pt) + (size_t)dir * M_TOK * 512 + (size_t)b * SEQ * 512 + dch;
    u32x2 xr[2][4];
#define LRU_LOAD(scn) do { _Pragma("unroll") for (int s_ = 0; s_ < 2; ++s_) { const int tt_ = dir ? (SEQ - 1 - (32 * (scn) + 16 * s_ + ti)) : (32 * (scn) + 16 * s_ + ti); \
        _Pragma("unroll") for (int tap = 0; tap < 4; ++tap) { const int t2_ = tt_ + tap - 2; xr[s_][tap] = (u32x2){0u, 0u}; if (t2_ >= 0 && t2_ < SEQ) xr[s_][tap] = *(const u32x2*)(plx + (size_t)t2_ * 512); } } } while (0)
    LRU_LOAD(0);
    float hprev = 0.f;
    LBAR();
#pragma unroll 1
    for (int sc = 0; sc < 64; ++sc) {
        LAS unsigned char* XC = XCB + (sc & 1) * 4096;
#pragma unroll
        for (int s2 = 0; s2 < 2; ++s2) { f32x4 xa = cb4;
#pragma unroll
            for (int tap = 0; tap < 4; ++tap) { xa[0] += cw4[tap][0] * bflo(xr[s2][tap].x); xa[1] += cw4[tap][1] * bfhi(xr[s2][tap].x); xa[2] += cw4[tap][2] * bflo(xr[s2][tap].y); xa[3] += cw4[tap][3] * bfhi(xr[s2][tap].y); }
            *(LAS u32x2*)(XC + swz64(16 * s2 + ti, 16 * dq + 4 * cq)) = pk4(xa); }
        if (sc + 1 < 64) LRU_LOAD(sc + 1);
        LBAR();
        float Ac[2][4], Hc[2][4];
#pragma unroll
        for (int s2 = 0; s2 < 2; ++s2) {
            const bf16x8 A0 = *(const LAS bf16x8*)(XC + swz64(16 * s2 + fr, 8 * fq)), A1 = *(const LAS bf16x8*)(XC + swz64(16 * s2 + fr, 32 + 8 * fq));
            f32x4 ca = {0.f, 0.f, 0.f, 0.f}, cx = {0.f, 0.f, 0.f, 0.f};
            ca = MFMA16(A0, Ba[0], ca); ca = MFMA16(A1, Ba[1], ca); cx = MFMA16(A0, Bx[0], cx); cx = MFMA16(A1, Bx[1], cx);
#pragma unroll
            for (int jj = 0; jj < 4; ++jj) { const float xv = bf2f(*(const LAS unsigned short*)(XC + swz64(16 * s2 + 4 * fq + jj, 16 * dq + fr)));
                const float r = sigm(ca[jj] + ba), ig = sigm(cx[jj] + bx), a = __builtin_amdgcn_exp2f(-r * sp8);
                const float bt = __builtin_amdgcn_sqrtf(fmaxf(1.0f - a * a, 0.f)) * ig * xv;
                Hc[s2][jj] = jj ? (a * Hc[s2][jj - 1] + bt) : bt; Ac[s2][jj] = jj ? (a * Ac[s2][jj - 1]) : a; }
            *(LAS f32x2*)(SCN + s2 * 512 + (fq * 16 + fr) * 8) = (f32x2){Ac[s2][3], Hc[s2][3]}; }
#pragma unroll
        for (int s2 = 0; s2 < 2; ++s2) {
            const LAS unsigned char* T = SCN + s2 * 512;
            const f32x2 g0 = *(const LAS f32x2*)(T + (0 * 16 + fr) * 8), g1 = *(const LAS f32x2*)(T + (1 * 16 + fr) * 8), g2 = *(const LAS f32x2*)(T + (2 * 16 + fr) * 8), g3 = *(const LAS f32x2*)(T + (3 * 16 + fr) * 8);
            const float h1 = g0.x * hprev + g0.y, h2 = g1.x * h1 + g1.y, h3 = g2.x * h2 + g2.y, h4 = g3.x * h3 + g3.y;
            const float hin = fq == 0 ? hprev : (fq == 1 ? h1 : (fq == 2 ? h2 : h3));
            hprev = h4;
#pragma unroll
            for (int jj = 0; jj < 4; ++jj) { const float hv = Ac[s2][jj] * hin + Hc[s2][jj]; const int i = 16 * s2 + 4 * fq + jj; const int t2 = dir ? (SEQ - 1 - (32 * sc + i)) : (32 * sc + i);
                hout[(size_t)t2 * 512] = (bf16_t)(pk2(hv, 0.f) & 0xffffu); } }
    }
#undef LRU_LOAD
}

constexpr int DP_BUF0 = 0, DP_BUF1 = 49152, DP_KL = 49152, DP_QL = 49152 + 16384, DP_VL = 49152 + 32768, DP_VEC = 98304, DP_CWL = 99328;
__device__ __forceinline__ void dp_item(PT pt, LAS unsigned char* lds, int item, int layer, int tid, int lane, int w) {
    asm volatile("" : "+v"(tid)); lane = tid & 63; asm volatile("" : "+s"(w));
    unsigned char* ws = pws(pt);
    const int b = item >> 7, h = (item >> 5) & 3, n = item & 31;
    const size_t rowbase = (size_t)b * SEQ + 64 * n;
    LAS float* VEC = (LAS float*)(lds + DP_VEC);
    LBAR();
    f32x4 gpre = {0.f, 0.f, 0.f, 0.f};
    if (w == 0) { const float* gp = (const float*)(ws + WS_GATES) + (rowbase + lane) * 16 + h; gpre[0] = gp[0]; gpre[1] = gp[4]; gpre[2] = gp[8]; gpre[3] = gp[12]; }
    { const int i = tid >> 3, c = tid & 7; const int t = 64 * n + i; const size_t R = rowbase + i;
      const bf16_t* pq = (const bf16_t*)(ws + WS_PQKV);
      u32x4 xin[3][4][2];
#pragma unroll
      for (int mat = 0; mat < 3; ++mat)
#pragma unroll
          for (int tap = 0; tap < 4; ++tap) { const int t2 = t + tap - 2; xin[mat][tap][0] = (u32x4){0u, 0u, 0u, 0u}; xin[mat][tap][1] = (u32x4){0u, 0u, 0u, 0u};
              if (t2 >= 0 && t2 < SEQ) { const bf16_t* xp = pq + (R + tap - 2) * 1536 + mat * 512 + h * 128 + 16 * c; xin[mat][tap][0] = *(const u32x4*)xp; xin[mat][tap][1] = *(const u32x4*)(xp + 8); } }
#pragma unroll
      for (int mat = 0; mat < 3; ++mat) {
          f32x4 a[4] = {{0.f, 0.f, 0.f, 0.f}, {0.f, 0.f, 0.f, 0.f}, {0.f, 0.f, 0.f, 0.f}, {0.f, 0.f, 0.f, 0.f}};
#pragma unroll
          for (int tap = 0; tap < 4; ++tap) { const u32x4 x0 = xin[mat][tap][0], x1 = xin[mat][tap][1];
              const LAS float* wp = (const LAS float*)(lds + DP_CWL) + (mat * 4 + tap) * 128 + 16 * c; const f32x4 w0 = *(const LAS f32x4*)wp, w1 = *(const LAS f32x4*)(wp + 4), w2 = *(const LAS f32x4*)(wp + 8), w3 = *(const LAS f32x4*)(wp + 12);
              a[0][0] += w0[0] * bflo(x0.x); a[0][1] += w0[1] * bfhi(x0.x); a[0][2] += w0[2] * bflo(x0.y); a[0][3] += w0[3] * bfhi(x0.y);
              a[1][0] += w1[0] * bflo(x0.z); a[1][1] += w1[1] * bfhi(x0.z); a[1][2] += w1[2] * bflo(x0.w); a[1][3] += w1[3] * bfhi(x0.w);
              a[2][0] += w2[0] * bflo(x1.x); a[2][1] += w2[1] * bfhi(x1.x); a[2][2] += w2[2] * bflo(x1.y); a[2][3] += w2[3] * bfhi(x1.y);
              a[3][0] += w3[0] * bflo(x1.z); a[3][1] += w3[1] * bfhi(x1.z); a[3][2] += w3[2] * bflo(x1.w); a[3][3] += w3[3] * bfhi(x1.w); }
          float ssq = 0.f;
#pragma unroll
          for (int q = 0; q < 4; ++q)
#pragma unroll
              for (int e = 0; e < 4; ++e) { const float v = a[q][e]; const float sv = v * sigm(v); a[q][e] = sv; ssq += sv * sv; }
          float scale = 1.f;
          if (mat < 2) { ssq += __shfl_xor(ssq, 1); ssq += __shfl_xor(ssq, 2); ssq += __shfl_xor(ssq, 4); scale = rsqrtf(ssq + EPS); if (mat == 0) scale *= 0.08838834764831845f; }
          u32x4 o0, o1; o0.x = pk2(a[0][0] * scale, a[0][1] * scale); o0.y = pk2(a[0][2] * scale, a[0][3] * scale); o0.z = pk2(a[1][0] * scale, a[1][1] * scale); o0.w = pk2(a[1][2] * scale, a[1][3] * scale);
          o1.x = pk2(a[2][0] * scale, a[2][1] * scale); o1.y = pk2(a[2][2] * scale, a[2][3] * scale); o1.z = pk2(a[3][0] * scale, a[3][1] * scale); o1.w = pk2(a[3][2] * scale, a[3][3] * scale);
          const int lbase = (mat == 0) ? DP_QL : (mat == 1 ? DP_KL : DP_VL);
          *(LAS u32x4*)(lds + lbase + swz128(i, 16 * c)) = o0; *(LAS u32x4*)(lds + lbase + swz128(i, 16 * c + 8)) = o1;
          if (mat < 2) { bf16_t* gp = (bf16_t*)(ws + (mat == 0 ? WS_QH : WS_KH)) + R * 512 + h * 128 + 16 * c; *(u32x4*)gp = o0; *(u32x4*)(gp + 8) = o1; } }
    }
    if (w == 0) {
        const float bF = sigm(gpre[0]), bB = sigm(gpre[1]);
        float gF = -expf(pin(pt, I_ALOG)[layer * 8 + h]) * softplus_f(gpre[2] + pin(pt, I_DTB)[layer * 8 + h]);
        float gB = -expf(pin(pt, I_ALOG)[layer * 8 + 4 + h]) * softplus_f(gpre[3] + pin(pt, I_DTB)[layer * 8 + 4 + h]);
#pragma unroll
        for (int off = 1; off < 64; off <<= 1) { const float v = __shfl_up(gF, off); if (lane >= off) gF += v; const float u = __shfl_down(gB, off); if (lane + off < 64) gB += u; }
        const float glF = __shfl(gF, 63), glB = __shfl(gB, 0);
        VEC[lane] = bF; VEC[64 + lane] = gF; VEC[128 + lane] = bB; VEC[192 + lane] = gB;
        float* v0 = (float*)(ws + WS_VEC) + (size_t)item * 256; float* v1 = v0 + (size_t)4096 * 256;
        v0[lane] = bF; v0[64 + lane] = fexp(gF); v0[128 + lane] = fexp(glF - gF); if (lane == 0) v0[192] = fexp(glF);
        v1[lane] = bB; v1[64 + lane] = fexp(gB); v1[128 + lane] = fexp(glB - gB); if (lane == 0) v1[192] = fexp(glB);
    }
    LBAR();
    { const int e = tid >> 2, jq = tid & 3; unsigned vv[8];
#pragma unroll
      for (int p = 0; p < 8; ++p) { const unsigned lo = *(const LAS unsigned short*)(lds + DP_VL + swz128(16 * jq + 2 * p, e)), hi = *(const LAS unsigned short*)(lds + DP_VL + swz128(16 * jq + 2 * p + 1, e)); vv[p] = lo | (hi << 16); }
      bf16_t* gp = (bf16_t*)(ws + WS_VT) + (size_t)item * 8192 + e * 64 + 16 * jq;
      *(u32x4*)gp = (u32x4){vv[0], vv[1], vv[2], vv[3]}; *(u32x4*)(gp + 8) = (u32x4){vv[4], vv[5], vv[6], vv[7]}; }
    const int r32 = lane & 31, hi = lane >> 5;
    { const int kind = w >> 2, q = w & 3, ta = q >> 1, tb = q & 1;
      f32x16 acc; for (int r = 0; r < 16; ++r) acc[r] = 0.f;
      const int bbase = kind ? DP_QL : DP_KL;
#pragma unroll
      for (int ks = 0; ks < 8; ++ks) { const bf16x8 av = *(const LAS bf16x8*)(lds + DP_KL + swz128(32 * ta + r32, 16 * ks + 8 * hi)), bv = *(const LAS bf16x8*)(lds + bbase + swz128(32 * tb + r32, 16 * ks + 8 * hi)); acc = MFMA32(av, bv, acc); }
      const int gb = 32 * tb + r32;
#pragma unroll
      for (int dir = 0; dir < 2; ++dir) { const LAS float* bet = VEC + dir * 128; const LAS float* gc = VEC + dir * 128 + 64;
          const float gcl = gc[gb], betl = bet[gb];
#pragma unroll
          for (int g = 0; g < 4; ++g) { const int ga0 = 32 * ta + 8 * g + 4 * hi; const f32x4 gca = *(const LAS f32x4*)(gc + ga0), bea = *(const LAS f32x4*)(bet + ga0);
              if (kind == 0) { f32x4 xv, yv, pv;
#pragma unroll
                  for (int jj = 0; jj < 4; ++jj) { const int ga = ga0 + jj; const float kk = acc[4 * g + jj];
                      const bool mx = dir ? (gb < ga) : (gb > ga), my = dir ? (ga < gb) : (ga > gb);
                      const float ed = kk * fexp(-fabsf(gcl - gca[jj]));
                      xv[jj] = mx ? (-betl * ed) : 0.f; yv[jj] = my ? (-bea[jj] * ed) : 0.f; pv[jj] = (ga == gb) ? 1.f : 0.f; }
                  LAS unsigned char* bb = lds + DP_BUF0 + dir * 24576 + swz64(gb, ga0);
                  *(LAS u32x2*)bb = pk4(xv); *(LAS u32x2*)(bb + 8192) = pk4(yv); *(LAS u32x2*)(bb + 16384) = pk4(pv);
              } else { f32x4 av4;
#pragma unroll
                  for (int jj = 0; jj < 4; ++jj) { const int ga = ga0 + jj; const bool ma = dir ? (gb <= ga) : (gb >= ga); av4[jj] = ma ? (acc[4 * g + jj] * fexp(-fabsf(gcl - gca[jj]))) : 0.f; }
                  *(u32x2*)((bf16_t*)(ws + WS_AT) + ((size_t)dir * 4096 + item) * 4096 + gb * 64 + ga0) = pk4(av4); } } }
    }
    LBAR();
    { const int dir = w >> 2, q = w & 3, ti = q >> 1, tj = q & 1;
      f32x16 pacc; for (int r = 0; r < 16; ++r) pacc[r] = (32 * tj + crow(r, hi) == 32 * ti + r32) ? 1.f : 0.f;
#pragma unroll 1
      for (int rd = 0; rd < 6; ++rd) { LAS unsigned char* cur = lds + ((rd & 1) ? DP_BUF1 : DP_BUF0) + dir * 24576; LAS unsigned char* nxt = lds + ((rd & 1) ? DP_BUF0 : DP_BUF1) + dir * 24576;
          bf16x8 xf[4], yf[4], pf[4];
#pragma unroll
          for (int ks = 0; ks < 4; ++ks) { xf[ks] = *(const LAS bf16x8*)(cur + swz64(32 * ti + r32, 16 * ks + 8 * hi)); yf[ks] = *(const LAS bf16x8*)(cur + 8192 + swz64(32 * tj + r32, 16 * ks + 8 * hi)); pf[ks] = *(const LAS bf16x8*)(cur + 16384 + swz64(32 * ti + r32, 16 * ks + 8 * hi)); }
#pragma unroll
          for (int ks = 0; ks < 4; ++ks) pacc = MFMA32(yf[ks], pf[ks], pacc);
          if (rd < 5) { f32x16 xa, ya; for (int r = 0; r < 16; ++r) { xa[r] = 0.f; ya[r] = 0.f; }
#pragma unroll
              for (int ks = 0; ks < 4; ++ks) { xa = MFMA32(yf[ks], xf[ks], xa); ya = MFMA32(xf[ks], yf[ks], ya); }
#pragma unroll
              for (int g = 0; g < 4; ++g) { const int c0 = 8 * g + 4 * hi;
                  *(LAS u32x2*)(nxt + swz64(32 * ti + r32, 32 * tj + c0)) = pk4((f32x4){xa[4 * g], xa[4 * g + 1], xa[4 * g + 2], xa[4 * g + 3]});
                  *(LAS u32x2*)(nxt + 8192 + swz64(32 * tj + r32, 32 * ti + c0)) = pk4((f32x4){ya[4 * g], ya[4 * g + 1], ya[4 * g + 2], ya[4 * g + 3]});
                  *(LAS u32x2*)(nxt + 16384 + swz64(32 * ti + r32, 32 * tj + c0)) = pk4((f32x4){pacc[4 * g], pacc[4 * g + 1], pacc[4 * g + 2], pacc[4 * g + 3]}); }
              LBAR(); } }
      bf16_t* tg = (bf16_t*)(ws + WS_TM) + ((size_t)dir * 4096 + item) * 4096 + (32 * ti + r32) * 64 + 32 * tj + 4 * hi;
#pragma unroll
      for (int g = 0; g < 4; ++g) *(u32x2*)(tg + 8 * g) = pk4((f32x4){pacc[4 * g], pacc[4 * g + 1], pacc[4 * g + 2], pacc[4 * g + 3]});
    }
}

constexpr int DR_K = 0, DR_Q = 16384, DR_KT = 32768, DR_VT = 49152, DR_T = 65536, DR_A = 73728, DR_VEC = 81920, DR_PRIV = 83968;
__device__ __forceinline__ void dr_item(PT pt, LAS unsigned char* lds, int item, int tid, int lane, int w) {
    asm volatile("" : "+v"(tid)); lane = tid & 63; asm volatile("" : "+s"(w));
    unsigned char* ws = pws(pt);
    const int dir = item & 1, h = (item >> 1) & 3, b = item >> 3;
    const int fr = lane & 15, fq = lane >> 4, es = 16 * w;
    LAS unsigned char* ST = lds + DR_PRIV + w * 8192; LAS unsigned char* RV = ST + 4096; LAS unsigned char* VN2 = ST + 6144;
    const LAS float* VEC = (const LAS float*)(lds + DR_VEC);
    const bf16_t* kh = (const bf16_t*)(ws + WS_KH) + (size_t)b * SEQ * 512 + h * 128;
    const bf16_t* qh = (const bf16_t*)(ws + WS_QH) + (size_t)b * SEQ * 512 + h * 128;
    const int ibase = (b * 4 + h) * 32;
    const bf16_t* vt = (const bf16_t*)(ws + WS_VT) + (size_t)ibase * 8192;
    const bf16_t* tm = (const bf16_t*)(ws + WS_TM) + ((size_t)dir * 4096 + ibase) * 4096;
    const bf16_t* at = (const bf16_t*)(ws + WS_AT) + ((size_t)dir * 4096 + ibase) * 4096;
    const float* vecs = (const float*)(ws + WS_VEC) + ((size_t)dir * 4096 + ibase) * 256;
    bf16_t* og = (bf16_t*)(ws + (dir ? WS_OB : WS_OF)) + (size_t)b * SEQ * 512 + h * 128 + es + fr;
    u32x4 pk[2], pq[2], pv[2], ptm, pa; f32x4 pvec = {0.f, 0.f, 0.f, 0.f};
#define DR_LOAD(nn) do { _Pragma("unroll") for (int u_ = 0; u_ < 2; ++u_) { const int p_ = tid + 512 * u_; \
        pk[u_] = *(const u32x4*)(kh + (size_t)(64 * (nn) + (p_ >> 4)) * 512 + 8 * (p_ & 15)); pq[u_] = *(const u32x4*)(qh + (size_t)(64 * (nn) + (p_ >> 4)) * 512 + 8 * (p_ & 15)); \
        pv[u_] = *(const u32x4*)(vt + (size_t)(nn) * 8192 + p_ * 8); } \
        ptm = *(const u32x4*)(tm + (size_t)(nn) * 4096 + tid * 8); pa = *(const u32x4*)(at + (size_t)(nn) * 4096 + tid * 8); \
        if (tid < 64) pvec = *(const f32x4*)(vecs + (size_t)(nn) * 256 + 4 * tid); } while (0)
#define DR_STORE() do { _Pragma("unroll") for (int u_ = 0; u_ < 2; ++u_) { const int p_ = tid + 512 * u_; const int j_ = p_ >> 4, q_ = p_ & 15; \
        *(LAS u32x4*)(lds + DR_K + swz128(j_, 8 * q_)) = pk[u_]; *(LAS u32x4*)(lds + DR_Q + swz128(j_, 8 * q_)) = pq[u_]; \
        *(LAS unsigned short*)(lds + DR_KT + swz64(8 * q_ + 0, j_)) = (unsigned short)(pk[u_].x & 0xffffu); *(LAS unsigned short*)(lds + DR_KT + swz64(8 * q_ + 1, j_)) = (unsigned short)(pk[u_].x >> 16); \
        *(LAS unsigned short*)(lds + DR_KT + swz64(8 * q_ + 2, j_)) = (unsigned short)(pk[u_].y & 0xffffu); *(LAS unsigned short*)(lds + DR_KT + swz64(8 * q_ + 3, j_)) = (unsigned short)(pk[u_].y >> 16); \
        *(LAS unsigned short*)(lds + DR_KT + swz64(8 * q_ + 4, j_)) = (unsigned short)(pk[u_].z & 0xffffu); *(LAS unsigned short*)(lds + DR_KT + swz64(8 * q_ + 5, j_)) = (unsigned short)(pk[u_].z >> 16); \
        *(LAS unsigned short*)(lds + DR_KT + swz64(8 * q_ + 6, j_)) = (unsigned short)(pk[u_].w & 0xffffu); *(LAS unsigned short*)(lds + DR_KT + swz64(8 * q_ + 7, j_)) = (unsigned short)(pk[u_].w >> 16); \
        *(LAS u32x4*)(lds + DR_VT + swz64(p_ >> 3, 8 * (p_ & 7))) = pv[u_]; } \
        *(LAS u32x4*)(lds + DR_T + swz64(tid >> 3, 8 * (tid & 7))) = ptm; *(LAS u32x4*)(lds + DR_A + swz64(tid >> 3, 8 * (tid & 7))) = pa; \
        if (tid < 64) *(LAS f32x4*)(lds + DR_VEC + 16 * tid) = pvec; } while (0)
    LBAR();
    DR_LOAD(dir ? 31 : 0);
    DR_STORE();
#pragma unroll
    for (int q = 0; q < 4; ++q) *(LAS u32x4*)(ST + lane * 64 + q * 16) = (u32x4){0u, 0u, 0u, 0u};
    f32x4 Sacc[8];
#pragma unroll
    for (int d = 0; d < 8; ++d) Sacc[d] = (f32x4){0.f, 0.f, 0.f, 0.f};
    LBAR();
#pragma unroll 1
    for (int cc = 0; cc < 32; ++cc) { const int n = dir ? (31 - cc) : cc;
        if (cc + 1 < 32) DR_LOAD(dir ? (30 - cc) : (cc + 1));
        bf16x8 sb[4];
#pragma unroll
        for (int ks = 0; ks < 4; ++ks) sb[ks] = *(const LAS bf16x8*)(ST + swz128(fr, 32 * ks + 8 * fq));
        f32x4 oacc[4];
#pragma unroll
        for (int it = 0; it < 4; ++it) { f32x4 ka = {0.f, 0.f, 0.f, 0.f}, qa = {0.f, 0.f, 0.f, 0.f};
#pragma unroll
            for (int ks = 0; ks < 4; ++ks) { const bf16x8 a1 = *(const LAS bf16x8*)(lds + DR_K + swz128(16 * it + fr, 32 * ks + 8 * fq)), a2 = *(const LAS bf16x8*)(lds + DR_Q + swz128(16 * it + fr, 32 * ks + 8 * fq));
                ka = MFMA16(a1, sb[ks], ka); qa = MFMA16(a2, sb[ks], qa); }
            const int i0 = 16 * it + 4 * fq; const f32x4 be = *(const LAS f32x4*)(VEC + i0), eg = *(const LAS f32x4*)(VEC + 64 + i0);
            const u32x2 vv = *(const LAS u32x2*)(lds + DR_VT + swz64(es + fr, i0));
            f32x4 rh; rh[0] = be[0] * (bflo(vv.x) - eg[0] * ka[0]); rh[1] = be[1] * (bfhi(vv.x) - eg[1] * ka[1]); rh[2] = be[2] * (bflo(vv.y) - eg[2] * ka[2]); rh[3] = be[3] * (bfhi(vv.y) - eg[3] * ka[3]);
            *(LAS u32x2*)(RV + swz64(fr, i0)) = pk4(rh);
            oacc[it] = qa * eg; }
        bf16x8 rb2[2];
#pragma unroll
        for (int ks = 0; ks < 2; ++ks) rb2[ks] = *(const LAS bf16x8*)(RV + swz64(fr, 32 * ks + 8 * fq));
        f32x4 vn[4];
#pragma unroll
        for (int it = 0; it < 4; ++it) { vn[it] = (f32x4){0.f, 0.f, 0.f, 0.f};
#pragma unroll
            for (int ks = 0; ks < 2; ++ks) { const bf16x8 a1 = *(const LAS bf16x8*)(lds + DR_T + swz64(16 * it + fr, 32 * ks + 8 * fq)); vn[it] = MFMA16(a1, rb2[ks], vn[it]); } }
#pragma unroll
        for (int it = 0; it < 4; ++it) { const int i0 = 16 * it + 4 * fq; const f32x4 ed = *(const LAS f32x4*)(VEC + 128 + i0);
            *(LAS u32x2*)(RV + swz64(fr, i0)) = pk4(vn[it]); *(LAS u32x2*)(VN2 + swz64(fr, i0)) = pk4(vn[it] * ed); }
        bf16x8 vb[2], vb2[2];
#pragma unroll
        for (int ks = 0; ks < 2; ++ks) { vb[ks] = *(const LAS bf16x8*)(RV + swz64(fr, 32 * ks + 8 * fq)); vb2[ks] = *(const LAS bf16x8*)(VN2 + swz64(fr, 32 * ks + 8 * fq)); }
#pragma unroll
        for (int it = 0; it < 4; ++it)
#pragma unroll
            for (int ks = 0; ks < 2; ++ks) { const bf16x8 a1 = *(const LAS bf16x8*)(lds + DR_A + swz64(16 * it + fr, 32 * ks + 8 * fq)); oacc[it] = MFMA16(a1, vb[ks], oacc[it]); }
        const float cdec = VEC[192];
#pragma unroll
        for (int dt = 0; dt < 8; ++dt) { Sacc[dt] = Sacc[dt] * cdec;
#pragma unroll
            for (int ks = 0; ks < 2; ++ks) { const bf16x8 a1 = *(const LAS bf16x8*)(lds + DR_KT + swz64(16 * dt + fr, 32 * ks + 8 * fq)); Sacc[dt] = MFMA16(a1, vb2[ks], Sacc[dt]); }
            *(LAS u32x2*)(ST + swz128(fr, 16 * dt + 4 * fq)) = pk4(Sacc[dt]); }
#pragma unroll
        for (int it = 0; it < 4; ++it)
#pragma unroll
            for (int jj = 0; jj < 4; ++jj) og[(size_t)(64 * n + 16 * it + 4 * fq + jj) * 512] = (bf16_t)(pk2(oacc[it][jj], 0.f) & 0xffffu);
        LBAR();
        if (cc + 1 < 32) DR_STORE();
        LBAR();
    }
#undef DR_LOAD
#undef DR_STORE
}

__device__ __forceinline__ void m2_rows(PT pt, int layer, int gw, int NGW, int lane) {
    asm volatile("" : "+v"(lane));
    unsigned char* ws = pws(pt);
    const bf16_t* of = (const bf16_t*)(ws + WS_OF); const bf16_t* ob = (const bf16_t*)(ws + WS_OB); const bf16_t* pz = (const bf16_t*)(ws + WS_PZ);
    const bf16_t* hf = (const bf16_t*)pout(pt); const bf16_t* hb = hf + (size_t)M_TOK * 512; const bf16_t* plg = (const bf16_t*)(ws + WS_PLG);
    bf16_t* amix = (bf16_t*)(ws + WS_AMIX);
    const float* dng = pin(pt, I_DNG) + layer * 128 + 8 * (lane & 15); const float* lng = pin(pt, I_LNG) + layer * 512 + 8 * lane;
    const f32x4 dg0 = *(const f32x4*)dng, dg1 = *(const f32x4*)(dng + 4), lg0 = *(const f32x4*)lng, lg1 = *(const f32x4*)(lng + 4);
    for (int m0 = gw; m0 < M_TOK; m0 += 2 * NGW) {
        u32x4 av[2], bv[2], zv[2], cv[2], dv[2], gv[2];
#pragma unroll
        for (int r = 0; r < 2; ++r) { const int m = m0 + r * NGW; if (m < M_TOK) { const size_t o = (size_t)m * 512 + 8 * lane;
            av[r] = *(const u32x4*)(of + o); bv[r] = *(const u32x4*)(ob + o); zv[r] = *(const u32x4*)(pz + o); cv[r] = *(const u32x4*)(hf + o); dv[r] = *(const u32x4*)(hb + o); gv[r] = *(const u32x4*)(plg + o); } }
#pragma unroll
        for (int r = 0; r < 2; ++r) { const int m = m0 + r * NGW; if (m < M_TOK) {
        const u32x4 a = av[r], b2 = bv[r], z = zv[r], c = cv[r], d = dv[r], g = gv[r];
        float v[8], y[8];
        v[0] = bflo(a.x) + bflo(b2.x); v[1] = bfhi(a.x) + bfhi(b2.x); v[2] = bflo(a.y) + bflo(b2.y); v[3] = bfhi(a.y) + bfhi(b2.y);
        v[4] = bflo(a.z) + bflo(b2.z); v[5] = bfhi(a.z) + bfhi(b2.z); v[6] = bflo(a.w) + bflo(b2.w); v[7] = bfhi(a.w) + bfhi(b2.w);
        float s1 = 0.f;
#pragma unroll
        for (int e = 0; e < 8; ++e) s1 += v[e] * v[e];
        s1 += __shfl_xor(s1, 1); s1 += __shfl_xor(s1, 2); s1 += __shfl_xor(s1, 4); s1 += __shfl_xor(s1, 8);
        const float r1 = rsqrtf(s1 * (1.0f / 128.0f) + EPS);
        float zz[8] = {bflo(z.x), bfhi(z.x), bflo(z.y), bfhi(z.y), bflo(z.z), bfhi(z.z), bflo(z.w), bfhi(z.w)};
        float gg[8] = {bflo(g.x), bfhi(g.x), bflo(g.y), bfhi(g.y), bflo(g.z), bfhi(g.z), bflo(g.w), bfhi(g.w)};
        float hh[8] = {bflo(c.x) + bflo(d.x), bfhi(c.x) + bfhi(d.x), bflo(c.y) + bflo(d.y), bfhi(c.y) + bfhi(d.y), bflo(c.z) + bflo(d.z), bfhi(c.z) + bfhi(d.z), bflo(c.w) + bflo(d.w), bfhi(c.w) + bfhi(d.w)};
        float s2 = 0.f;
#pragma unroll
        for (int e = 0; e < 8; ++e) { const float dgv = e < 4 ? dg0[e & 3] : dg1[e & 3]; v[e] = v[e] * r1 * dgv * (zz[e] * sigm(zz[e])); y[e] = gelu_t(gg[e]) * hh[e]; s2 += y[e] * y[e]; }
#pragma unroll
        for (int o2 = 1; o2 < 64; o2 <<= 1) s2 += __shfl_xor(s2, o2);
        const float r2 = rsqrtf(s2 * (1.0f / 512.0f) + EPS);
#pragma unroll
        for (int e = 0; e < 8; ++e) { const float lgv = e < 4 ? lg0[e & 3] : lg1[e & 3]; y[e] = y[e] * r2 * lgv; }
        u32x4 w1, w2; w1.x = pk2(v[0], v[1]); w1.y = pk2(v[2], v[3]); w1.z = pk2(v[4], v[5]); w1.w = pk2(v[6], v[7]);
        w2.x = pk2(y[0], y[1]); w2.y = pk2(y[2], y[3]); w2.z = pk2(y[4], y[5]); w2.w = pk2(y[6], y[7]);
        *(u32x4*)(amix + (size_t)m * 1024 + 8 * lane) = w1; *(u32x4*)(amix + (size_t)m * 1024 + 512 + 8 * lane) = w2; } }
    }
}

#define XB_TMO      128
#define XB_XCNT(j)  (256  + 64 * (j))
#define XB_XSUB(j)  (1280 + 64 * (j))
#define XB_XGEN(j)  (2304 + 64 * (j))
#define XB_TOP      3328
#define XB_TOPGEN   3392
#define XCD_BAR_WORDS 3456
#define XB_SPIN_CAP (1u << 18)

__device__ __forceinline__ unsigned xb_ld(unsigned* p)              { return __hip_atomic_load(p, __ATOMIC_RELAXED, __HIP_MEMORY_SCOPE_AGENT); }
__device__ __forceinline__ unsigned xb_add(unsigned* p, unsigned v) { return __hip_atomic_fetch_add(p, v, __ATOMIC_RELAXED, __HIP_MEMORY_SCOPE_AGENT); }
__device__ __forceinline__ unsigned xb_xcc_id() { return (unsigned)__builtin_amdgcn_s_getreg((3 << 11) | 20) & 0xFu; }
#define XB_SPIN(cond, bar) do { unsigned _sp = 0; while (cond) { __builtin_amdgcn_s_sleep(1); \
    if ((++_sp & 255u) == 0u) { if (xb_ld(&(bar)[XB_TMO])) break; if (_sp > XB_SPIN_CAP) { atomicAdd(&(bar)[XB_TMO], 1u); break; } } } } while (0)

struct XcdBarrier {
    unsigned* bar; unsigned x;
    volatile LAS unsigned* st;
};

__device__ __forceinline__ XcdBarrier xcd_barrier_post(unsigned* bar, volatile LAS unsigned* st) {
    XcdBarrier b; b.bar = bar; b.x = xb_xcc_id(); b.st = st;
    if (threadIdx.x == 0) (void)xb_add(&bar[XB_XCNT(b.x)], 1u);
    return b;
}
__device__ __forceinline__ void xcd_barrier_complete(unsigned* bar, unsigned x, unsigned& nloc, unsigned& nx) {
    const unsigned G = gridDim.x * gridDim.y * gridDim.z;
    unsigned sum, cnt, mine, sp = 0u;
    for (;;) {
        sum = 0u; cnt = 0u; mine = 0u;
#pragma unroll
        for (unsigned j = 0; j < 16; ++j) { const unsigned c = xb_ld(&bar[XB_XCNT(j)]); sum += c; cnt += (c > 0u) ? 1u : 0u; mine = (j == x) ? c : mine; }
        if (sum == G) break;
        __builtin_amdgcn_s_sleep(1);
        if ((++sp & 255u) == 0u) { if (xb_ld(&bar[XB_TMO])) break; if (sp > XB_SPIN_CAP) { atomicAdd(&bar[XB_TMO], 1u); break; } }
    }
    nloc = mine > 0u ? mine : 1u; nx = cnt > 0u ? cnt : 1u;
}

__device__ __forceinline__ void xcd_barrier(const XcdBarrier& b) {
    asm volatile("s_waitcnt vmcnt(0)" ::: "memory");
    __syncthreads();
    if (threadIdx.x == 0) {
        unsigned* bar = b.bar;
        __builtin_amdgcn_s_waitcnt(0);
        unsigned nloc = b.st[0], nx = b.st[1];
        if (nloc == 0u) { xcd_barrier_complete(bar, b.x, nloc, nx); b.st[0] = nloc; b.st[1] = nx; }
        const unsigned old = xb_add(&bar[XB_XSUB(b.x)], 1u);
        const unsigned gen = old / nloc;
        if (old + 1u == (gen + 1u) * nloc) {
            __builtin_amdgcn_fence(__ATOMIC_RELEASE, "agent");
            asm volatile("s_waitcnt vmcnt(0)" ::: "memory");
            const unsigned og = xb_add(&bar[XB_TOP], 1u);
            const unsigned tg = og / nx;
            if (og + 1u == (tg + 1u) * nx) xb_add(&bar[XB_TOPGEN], 1u);
            else XB_SPIN(xb_ld(&bar[XB_TOPGEN]) == tg, bar);
            __builtin_amdgcn_fence(__ATOMIC_ACQUIRE, "agent");
            xb_add(&bar[XB_XGEN(b.x)], 1u);
            asm volatile("s_waitcnt vmcnt(0)" ::: "memory");
        } else {
            XB_SPIN(xb_ld(&bar[XB_XGEN(b.x)]) == gen, bar);
            __builtin_amdgcn_fence(__ATOMIC_ACQUIRE, "agent");
            asm volatile("s_waitcnt vmcnt(0)" ::: "memory");
        }
    }
    __syncthreads();
}

#ifndef PHMASK
#define PHMASK 0xFFFF
#endif
#ifndef DUPMASK
#define DUPMASK 0
#endif
#define PH(k) _Pragma("unroll 1") for (int rep_ = 0; rep_ < ((((PHMASK >> (k)) & 1) ? 1 : 0) + (((DUPMASK >> (k)) & 1) ? 1 : 0)); ++rep_)
#define GRID_BAR() do { XcdBarrier b_; b_.bar = (unsigned*)pws(pt); b_.x = xb_xcc_id(); b_.st = (volatile LAS unsigned*)(lds + LDS_BYTES - 512); xcd_barrier(b_); } while (0)
#ifndef TMASK
#define TMASK 0
#endif
#define TS_BEGIN(k) do { if (((TMASK >> (k)) & 1) && bx == 0 && tid == 0) { const unsigned long long t_ = __builtin_amdgcn_s_memrealtime(); *(volatile LAS unsigned*)(lds + LDS_BYTES - 128) = (unsigned)t_; } } while (0)
#define TS_END(k) do { if (((TMASK >> (k)) & 1) && bx == 0 && tid == 0) { const unsigned t_ = (unsigned)__builtin_amdgcn_s_memrealtime(); volatile LAS unsigned* a_ = (volatile LAS unsigned*)(lds + LDS_BYTES - 128); a_[1] += t_ - a_[0]; } } while (0)
#ifndef STAG
#define STAG 0
#endif
#define STAGGER(step_10ns) do { if (STAG) { const unsigned sg_ = ((unsigned)bx >> 3) & 1u; if (sg_) { const unsigned long long t0_ = __builtin_amdgcn_s_memrealtime(); \
        while (__builtin_amdgcn_s_memrealtime() - t0_ < (unsigned long long)(sg_ * (step_10ns))) __builtin_amdgcn_s_sleep(16); } __syncthreads(); } } while (0)
#define RB_ ((bf16_t*)(pws(pt) + WS_RB))
#define RLO_ ((bf16_t*)pout(pt) + (size_t)M_TOK * 1024)
#define RLOF_ ((bf16_t*)(pws(pt) + WS_RLO))
#define RBC_ ((bf16_t*)(pws(pt) + WS_BIG + 128 * MiB))
#define SS_(k) ((float*)(pws(pt) + WS_SSP) + (size_t)(k) * M_TOK * 4)
__global__ void __launch_bounds__(512, 2) fwd_kernel(Params P) {
    extern __shared__ __attribute__((aligned(16))) unsigned char lds_raw[];
    LAS unsigned char* lds = (LAS unsigned char*)lds_raw;
    cg::grid_group grid = cg::this_grid();
    const int tid = threadIdx.x, lane = tid & 63, wave = __builtin_amdgcn_readfirstlane(tid >> 6);
    const int G = gridDim.x, bx = blockIdx.x; const int gw = bx * 8 + wave, NGW = G * 8;
    PT pt = (PT)(lds + LDS_BYTES - 256);
    volatile LAS unsigned* xst = (volatile LAS unsigned*)(lds + LDS_BYTES - 512);
    if (tid == 0) { xst[0] = 0u; xst[1] = 0u; if (TMASK) { ((volatile LAS unsigned*)(lds + LDS_BYTES - 128))[1] = 0u; }
#pragma unroll
        for (int i = 0; i < 28; ++i) { const unsigned long long v = (unsigned long long)P.in[i]; pt[2 * i] = (unsigned)v; pt[2 * i + 1] = (unsigned)(v >> 32); }
        { const unsigned long long v = (unsigned long long)P.out; pt[56] = (unsigned)v; pt[57] = (unsigned)(v >> 32); }
        { const unsigned long long v = (unsigned long long)P.ws; pt[58] = (unsigned)v; pt[59] = (unsigned)(v >> 32); }
    }
    __syncthreads();
    (void)xcd_barrier_post((unsigned*)P.ws, xst);

    TS_BEGIN(0);
    PH(0) prologue(pt, lds, gw, NGW, lane, wave);
    __syncthreads();
    grid.sync(); TS_END(0);

#pragma unroll 1
    for (int layer = 0; layer < NL; ++layer) {
        TS_BEGIN(1); PH(1) { pg8::Gemm g{RB_, (const bf16_t*)(pws(pt) + WS_WIN) + (size_t)layer * 3328 * 1024, M_TOK, 3328, 1024}; pg8::StaticOrder S; S.init(M_TOK, 3328, G, bx);
          EpiStore E{SS_(3 * layer), {(bf16_t*)(pws(pt) + WS_PQKV), (bf16_t*)(pws(pt) + WS_PLX), (bf16_t*)(pws(pt) + WS_PZ), (bf16_t*)(pws(pt) + WS_PLG)}, {1536, 512, 512, 512}, {0, 6, 8, 10}, (float*)(pws(pt) + WS_GATES), 12};
          pg8::gemm_phase<EpiStore, pg8::StaticOrder, true, true>(lds, g, S, E);
          int tl = tid; asm volatile("" : "+v"(tl));
          const f32x4* ps = (const f32x4*)(pin(pt, I_P) + (size_t)layer * M_TOK * PLE); u32x2* pd = (u32x2*)(pws(pt) + WS_PB);
          for (size_t i = (size_t)bx * 512 + tl; i < (size_t)M_TOK * PLE / 4; i += (size_t)G * 512) pd[i] = pk4(ps[i]);
          }
        GRID_BAR(); TS_END(1);
        TS_BEGIN(2); PH(2) for (int bi = bx; bi < 256; bi += G) lru_block(pt, lds, bi, layer, tid);
        PH(3) { __syncthreads();
          { int tl = tid; asm volatile("" : "+v"(tl)); const int hh = (bx >> 5) & 3; const float* cwg = pin(pt, I_DNCW) + (size_t)layer * 4 * 1536;
            for (int e = tl; e < 1536; e += 512) { const int mat = e >> 9, tap = (e >> 7) & 3, ch = e & 127; ((LAS float*)(lds + DP_CWL))[e] = cwg[tap * 1536 + mat * 512 + hh * 128 + ch]; } }
          for (int it = bx; it < 4096; it += G) dp_item(pt, lds, it, layer, tid, lane, wave); }
        GRID_BAR(); TS_END(2);
        TS_BEGIN(4); PH(4) for (int it = bx; it < 256; it += G) dr_item(pt, lds, it, tid, lane, wave);
        GRID_BAR(); TS_END(4);
        TS_BEGIN(6); PH(6) m2_rows(pt, layer, gw, NGW, lane);
        GRID_BAR(); TS_END(6);
        TS_BEGIN(7); PH(7) { STAGGER(3700); pg8::Gemm g{(const bf16_t*)(pws(pt) + WS_AMIX), (const bf16_t*)(pws(pt) + WS_WOUT) + (size_t)layer * DM * DM, M_TOK, 1024, 1024}; pg8::StaticOrder S; S.init(M_TOK, 1024, G, bx);
          EpiResid<0> E{nullptr, RB_, RLO_, RLO_, SS_(3 * layer + 1), nullptr, nullptr, nullptr, nullptr, (LAS float*)(lds + 131072)};
          pg8::gemm_phase<EpiResid<0>, pg8::StaticOrder, true, true>(lds, g, S, E); }
        GRID_BAR(); TS_END(7);
        TS_BEGIN(8); PH(8) { pg8::Gemm g{RB_, (const bf16_t*)(pws(pt) + WS_WG) + (size_t)layer * FF * DM, M_TOK, FF, 1024}; pg8::StaticOrder S; S.init(M_TOK, FF, G, bx);
          EpiStore E{SS_(3 * layer + 1), {(bf16_t*)(pws(pt) + WS_G), nullptr, nullptr, nullptr}, {FF, 0, 0, 0}, {0, 99, 99, 99}, nullptr, 99};
          pg8::gemm_phase<EpiStore, pg8::StaticOrder, true, true>(lds, g, S, E); }
        GRID_BAR(); TS_END(8);
        TS_BEGIN(9); PH(9) { STAGGER(2700); pg8::Gemm g{RB_, (const bf16_t*)(pws(pt) + WS_WU) + (size_t)layer * FF * DM, M_TOK, FF, 1024}; pg8::StaticOrder S; S.init(M_TOK, FF, G, bx);
          EpiGlu E{SS_(3 * layer + 1), (const bf16_t*)(pws(pt) + WS_G), pin(pt, I_FCW) + (size_t)layer * 3 * FF, pin(pt, I_FCB) + (size_t)layer * FF, (bf16_t*)(pws(pt) + WS_ACT)};
          pg8::gemm_phase<EpiGlu, pg8::StaticOrder, true, true>(lds, g, S, E); }
        GRID_BAR(); TS_END(9);
        TS_BEGIN(10); PH(10) { STAGGER(4800); pg8::Gemm g{(const bf16_t*)(pws(pt) + WS_ACT), (const bf16_t*)(pws(pt) + WS_WD) + (size_t)layer * DM * FF, M_TOK, 1024, FF}; pg8::StaticOrder S; S.init(M_TOK, 1024, G, bx);
          EpiResid<0> E{nullptr, RB_, RLO_, RLO_, SS_(3 * layer + 2), nullptr, nullptr, nullptr, RBC_, (LAS float*)(lds + 131072)};
          pg8::gemm_phase<EpiResid<0>, pg8::StaticOrder, true, true>(lds, g, S, E); }
        __syncthreads();
        PH(11) { pg8::Gemm g{(const bf16_t*)(pws(pt) + WS_PB), (const bf16_t*)(pws(pt) + WS_WP) + (size_t)layer * DM * PLE, M_TOK, 1024, PLE}; pg8::StaticOrder S; S.init(M_TOK, 1024, G, bx);
          EpiStore E{nullptr, {(bf16_t*)(pws(pt) + WS_PP), nullptr, nullptr, nullptr}, {1024, 0, 0, 0}, {0, 99, 99, 99}, nullptr, 99};
          pg8::gemm_phase<EpiStore, pg8::StaticOrder, true, true>(lds, g, S, E); }
        GRID_BAR(); TS_END(10);
        TS_BEGIN(12); PH(12) { STAGGER(3000); pg8::Gemm g{RBC_, (const bf16_t*)(pws(pt) + WS_WPG) + (size_t)layer * DM * DM, M_TOK, 1024, 1024}; pg8::StaticOrder S; S.init(M_TOK, 1024, G, bx);
          EpiResid<1> E{nullptr, RB_, RLO_, layer == NL - 1 ? RLOF_ : RLO_, SS_(3 * layer + 3), SS_(3 * layer + 2), pin(pt, I_PBG) + (size_t)layer * DM, (const bf16_t*)(pws(pt) + WS_PP), nullptr, (LAS float*)(lds + 131072)};
          pg8::gemm_phase<EpiResid<1>, pg8::StaticOrder, true, true>(lds, g, S, E); }
        GRID_BAR(); TS_END(12);
    }
    TS_BEGIN(13);
    { const float* ssF = SS_(12); const f32x4* fg = (const f32x4*)pin(pt, I_FING) + lane; const bf16_t* hi_ = RB_; const bf16_t* lo_ = RLOF_; float* outp = pout(pt);
      for (int m = gw; m < M_TOK; m += NGW) { const float sc = rs_of(ssF, m); f32x4* xr = (f32x4*)(outp + (size_t)m * DM) + lane;
          const u32x2* hr = (const u32x2*)(hi_ + (size_t)m * DM) + lane; const u32x2* lr = (const u32x2*)(lo_ + (size_t)m * DM) + lane;
#pragma unroll
          for (int j = 0; j < 4; ++j) { const u32x2 h = hr[64 * j], l = lr[64 * j]; const f32x4 g = fg[64 * j];
              f32x4 v; v[0] = (bflo(h.x) + bflo(l.x)) * sc * g[0]; v[1] = (bfhi(h.x) + bfhi(l.x)) * sc * g[1]; v[2] = (bflo(h.y) + bflo(l.y)) * sc * g[2]; v[3] = (bfhi(h.y) + bfhi(l.y)) * sc * g[3];
              xr[64 * j] = v; } } }
    if (TMASK) { __syncthreads(); TS_END(13); if (bx == 0 && tid == 0) { const unsigned wait_ = ((volatile LAS unsigned*)(lds + LDS_BYTES - 128))[1]; const unsigned long long t0_ = __builtin_amdgcn_s_memrealtime(); while (__builtin_amdgcn_s_memrealtime() - t0_ < (unsigned long long)wait_) __builtin_amdgcn_s_sleep(8); } }
}

extern "C" void kernel_launch(void* const* d_in, const int* in_sizes, int n_in, void* d_out, int out_size, void* d_ws, size_t ws_size, hipStream_t stream) {
    static int grid = 0;
    if (grid == 0) {
        if (n_in != 28 || ws_size < WS_END) { fprintf(stderr, "kernel_launch: unexpected n_in %d or workspace %zu < %zu\n", n_in, ws_size, (size_t)WS_END); grid = -1; return; }
        int dev = 0, cus = 0, per_cu = 0;
        hipGetDevice(&dev); hipDeviceGetAttribute(&cus, hipDeviceAttributeMultiprocessorCount, dev);
        if (hipFuncSetAttribute((const void*)fwd_kernel, hipFuncAttributeMaxDynamicSharedMemorySize, LDS_BYTES) != hipSuccess) fprintf(stderr, "kernel_launch: hipFuncSetAttribute failed\n");
        if (hipOccupancyMaxActiveBlocksPerMultiprocessor(&per_cu, (const void*)fwd_kernel, 512, LDS_BYTES) != hipSuccess || per_cu < 1) { fprintf(stderr, "kernel_launch: occupancy query says %d\n", per_cu); per_cu = 1; }
        (void)hipGetLastError();
        grid = cus * per_cu; if (grid > 256) grid = 256;
    }
    if (grid < 0) return;
    if (hipMemsetAsync(d_ws, 0, 16384, stream) != hipSuccess) { fprintf(stderr, "kernel_launch: memset of the barrier words failed\n"); return; }
    Params p{};
    for (int i = 0; i < 28; ++i) p.in[i] = (const float*)d_in[i];
    p.out = (float*)d_out; p.ws = (unsigned char*)d_ws;
    void* args[] = {&p};
    hipError_t e = hipLaunchCooperativeKernel((const void*)fwd_kernel, dim3(grid), dim3(512), args, LDS_BYTES, stream);
    if (e != hipSuccess) fprintf(stderr, "cooperative launch failed: %s (grid %d)\n", hipGetErrorString(e), grid);
}
```

```cpp
#include <hip/hip_runtime.h>
#include <hip/hip_cooperative_groups.h>
#include <cstdio>
#include <cstdint>
namespace cg = cooperative_groups;

#define LAS __attribute__((address_space(3)))
typedef unsigned short bf16_t;
typedef short bf16x8 __attribute__((ext_vector_type(8)));
typedef short s16x4 __attribute__((ext_vector_type(4)));
typedef float f32x2 __attribute__((ext_vector_type(2)));
typedef float f32x4 __attribute__((ext_vector_type(4)));
typedef float f32x16 __attribute__((ext_vector_type(16)));
typedef unsigned u32x4 __attribute__((ext_vector_type(4)));
typedef unsigned u32x2 __attribute__((ext_vector_type(2)));
typedef __bf16 bfx2_t __attribute__((ext_vector_type(2)));

constexpr int M_TOK = 65536, DM = 1024, SEQ = 2048, NB = 32, NL = 4;
constexpr int FF = 2816, PLE = 256, INC = 3088;
constexpr float EPS = 1e-6f;

constexpr size_t MiB = 1u << 20;
constexpr size_t WS_SS = 0;
constexpr size_t WS_WIN = 4 * MiB;
constexpr size_t WS_WOUT = WS_WIN + 26 * MiB;
constexpr size_t WS_WG = WS_WOUT + 8 * MiB;
constexpr size_t WS_WU = WS_WG + 22 * MiB;
constexpr size_t WS_WD = WS_WU + 22 * MiB;
constexpr size_t WS_WPG = WS_WD + 22 * MiB;
constexpr size_t WS_WP = WS_WPG + 8 * MiB;
constexpr size_t WS_WAT = WS_WP + 2 * MiB;
constexpr size_t WS_GATES = WS_WAT + 1 * MiB;
constexpr size_t WS_VEC = WS_GATES + 4 * MiB;
constexpr size_t WS_PB = WS_VEC + 8 * MiB;
constexpr size_t WS_RB = WS_PB + 32 * MiB;
constexpr size_t WS_BIG = WS_RB + 128 * MiB;
constexpr size_t WS_PQKV = WS_BIG;
constexpr size_t WS_OF = WS_BIG, WS_OB = WS_BIG + 64 * MiB, WS_PZ = WS_BIG + 576 * MiB;
constexpr size_t WS_PLX = WS_BIG + 192 * MiB, WS_PLG = WS_BIG + 640 * MiB;
constexpr size_t WS_QH = WS_BIG + 256 * MiB, WS_KH = WS_BIG + 320 * MiB, WS_VT = WS_BIG + 384 * MiB;
constexpr size_t WS_TM = WS_BIG + 448 * MiB, WS_AT = WS_BIG + 512 * MiB;
constexpr size_t WS_RLO = WS_BIG + 576 * MiB;
constexpr size_t WS_AMIX = WS_BIG + 256 * MiB;
constexpr size_t WS_G = WS_BIG, WS_ACT = WS_BIG + 352 * MiB, WS_PP = WS_BIG;
constexpr size_t WS_SSP = WS_BIG + 704 * MiB;
constexpr size_t WS_END = WS_SSP + 13 * MiB;
constexpr int LDS_BYTES = 153600;

__device__ __forceinline__ unsigned pk2(float lo, float hi) { f32x2 v = {lo, hi}; bfx2_t b = __builtin_convertvector(v, bfx2_t); return __builtin_bit_cast(unsigned, b); }
__device__ __forceinline__ u32x2 pk4(f32x4 v) { u32x2 r; r.x = pk2(v[0], v[1]); r.y = pk2(v[2], v[3]); return r; }
__device__ __forceinline__ float bflo(unsigned w) { return __uint_as_float(w << 16); }
__device__ __forceinline__ float bfhi(unsigned w) { return __uint_as_float(w & 0xffff0000u); }
__device__ __forceinline__ float bf2f(unsigned short b) { return __uint_as_float((unsigned)b << 16); }
__device__ __forceinline__ float fexp(float x) { return __builtin_amdgcn_exp2f(x * 1.4426950408889634f); }
__device__ __forceinline__ float sigm(float x) { return __builtin_amdgcn_rcpf(1.0f + fexp(-x)); }
__device__ __forceinline__ float gelu_t(float x) { const float u = 1.5957691216057308f * (x + 0.044715f * x * x * x); return x * __builtin_amdgcn_rcpf(1.0f + fexp(-u)); }
__device__ __forceinline__ float softplus_f(float x) { return x > 20.f ? x : log1pf(expf(x)); }
__device__ __forceinline__ int swz128(int row, int col) { return row * 256 + ((((col >> 3) ^ (row & 15)) << 4) | ((col & 7) << 1)); }
__device__ __forceinline__ int swz64(int row, int col) { return row * 128 + ((((col >> 3) ^ (row & 7)) << 4) | ((col & 7) << 1)); }
__device__ __forceinline__ int crow(int r, int hi) { return (r & 3) + 8 * (r >> 2) + 4 * hi; }
#define MFMA16(a, b, c) __builtin_amdgcn_mfma_f32_16x16x32_bf16((a), (b), (c), 0, 0, 0)
#define MFMA32(a, b, c) __builtin_amdgcn_mfma_f32_32x32x16_bf16((a), (b), (c), 0, 0, 0)
typedef unsigned long long u64;
__device__ __forceinline__ float rs_of(const float* ss4, int row) { const f32x4 p = *(const f32x4*)(ss4 + (size_t)row * 4); return rsqrtf(((p[0] + p[1]) + (p[2] + p[3])) * (1.0f / 1024.0f) + EPS); }
#define LDS_FENCE() asm volatile("s_waitcnt lgkmcnt(0)" ::: "memory")

#define LBAR() do { asm volatile("s_waitcnt lgkmcnt(0)" ::: "memory"); __builtin_amdgcn_s_barrier(); asm volatile("" ::: "memory"); } while (0)

namespace pg8 {
#define PG8_LAS __attribute__((address_space(3)))
typedef unsigned short bf16_t;
typedef short bf16x8 __attribute__((ext_vector_type(8)));
typedef float f32x4 __attribute__((ext_vector_type(4)));
typedef unsigned u32x4 __attribute__((ext_vector_type(4)));
constexpr int BM = 256, BK = 64, HALF = 128, HTB = HALF * BK * 2  , STAGE_BYTES = 8 * HTB, NXCD = 8, WGM = 8;

__host__ __device__ __forceinline__ int lds_byte(int r, int c) { const int st = (r >> 4) * 2 + (c >> 5), rr = r & 15, cc = c & 31, ob = rr * 64 + cc * 2; return st * 1024 + (ob ^ (((ob >> 9) & 1) << 5)); }
__host__ __device__ __forceinline__ void stage_rc(int b, int& R, int& C) { const int st = b / 1024, sb = b % 1024, swz = sb ^ (((sb >> 9) & 1) << 5); R = (st >> 1) * 16 + swz / 64; C = (st & 1) * 32 + (swz % 64) / 2; }
__host__ __device__ __forceinline__ int perm32(int rho) { const int n = rho >> 4, i = rho & 15; return 8 * (i >> 2) + 4 * n + (i & 3); }

struct Unit { int pm, pn; };
struct Gemm { const bf16_t* A; const bf16_t* Bt; int M, N, K; };

struct StaticOrder {
    int nM, nN, nwg, G, c;
    __host__ __device__ void init(int M, int N, int G_, int c_) { nM = M / BM; nN = N / BM; nwg = nM * nN; G = G_; c = c_; }
    __host__ __device__ bool next(int i, Unit& u) const {
        const long L = (long)i * G + c; if (L >= nwg) return false;
        int wgid = (int)L; { const int q = nwg / NXCD, r = nwg % NXCD, xcd = wgid % NXCD, off = wgid / NXCD; wgid = (xcd < r ? xcd * (q + 1) : r * (q + 1) + (xcd - r) * q) + off; }
        const int nig = WGM * nN, gid = wgid / nig, fm = gid * WGM, gsz = (nM - fm) < WGM ? (nM - fm) : WGM;
        u.pm = fm + ((wgid % nig) % gsz); u.pn = (wgid % nig) / gsz; return true;
    }
    __device__ __forceinline__ void a_ready(const Unit&) const {}
    __device__ __forceinline__ void done(const Unit&) const {}
};

template <class Epi, class Sched, bool ALIGN_EPI = false, bool SP2 = false>
__device__ __forceinline__ void gemm_phase(PG8_LAS unsigned char* lds, const Gemm g, const Sched& S, const Epi& E) {
    int tid_ = threadIdx.x; asm volatile("" : "+v"(tid_));
    const int tid = tid_, wid = __builtin_amdgcn_readfirstlane(tid >> 6), lane = tid & 63, wr = wid >> 2, wc = wid & 3, fr = lane & 15, fq = lane >> 4;
    const int K = g.K, nt = K / BK;
    unsigned voffA[2], voffB[2];
#pragma unroll
    for (int i = 0; i < 2; ++i) { int R, C; stage_rc(tid * 16 + i * 8192, R, C); const int Rb = Epi::PERM ? ((R & ~31) + perm32(R & 31)) : R;
        voffA[i] = (unsigned)(R * K + C) * 2u; voffB[i] = (unsigned)(Rb * K + C) * 2u; }
    const size_t kstep = (size_t)(BK * 2);
    const size_t hstep = (size_t)HALF * K * 2;
    const size_t tstep = 2 * hstep;
    const unsigned ldsw = (unsigned)wid * 1024u;
    const int aoff = lds_byte(wr * 64 + fr, fq * 8), boff = lds_byte(wc * 32 + fr, fq * 8);
#define PG8_SA(b, h) (((b) * 2 + (h)) * HTB)
#define PG8_SB(b, h) ((4 + (b) * 2 + (h)) * HTB)
#define PG8_STAGE(bufoff, gbase, voff) do { _Pragma("unroll") for (int _i = 0; _i < 2; ++_i) \
        __builtin_amdgcn_global_load_lds((const unsigned*)((const char*)(gbase) + (voff)[_i]), (PG8_LAS unsigned*)(lds + (bufoff) + ldsw + _i * 8192), 16, 0, 0); } while (0)
#define PG8_LDA(dst, b, h) do { _Pragma("unroll") for (int m = 0; m < 4; ++m) _Pragma("unroll") for (int k = 0; k < 2; ++k) dst[m][k] = *(const PG8_LAS bf16x8*)(lds + PG8_SA(b, h) + aoff + m * 2048 + k * 1024); } while (0)
#define PG8_LDB(dst, b, h) do { _Pragma("unroll") for (int n = 0; n < 2; ++n) _Pragma("unroll") for (int k = 0; k < 2; ++k) dst[n][k] = *(const PG8_LAS bf16x8*)(lds + PG8_SB(b, h) + boff + n * 2048 + k * 1024); } while (0)
#define PG8_MMA(ai, bj, At, Bt) do { __builtin_amdgcn_s_setprio(1); _Pragma("unroll") for (int m = 0; m < 4; ++m) _Pragma("unroll") for (int n = 0; n < 2; ++n) _Pragma("unroll") for (int k = 0; k < 2; ++k) \
        acc[ai][bj][m][n] = __builtin_amdgcn_mfma_f32_16x16x32_bf16(Bt[n][k], At[m][k], acc[ai][bj][m][n], 0, 0, 0); __builtin_amdgcn_s_setprio(0); } while (0)
#define PG8_WAIT_V(n) asm volatile("s_waitcnt vmcnt(" #n ")" ::: "memory")
#define PG8_WAIT_L(n) asm volatile("s_waitcnt lgkmcnt(" #n ")" ::: "memory")
#define PG8_BAR __builtin_amdgcn_s_barrier()
#define PG8_SCHED __builtin_amdgcn_sched_barrier(0)
    Unit cur, nxt; int ui = 0;
    if (!S.next(0, cur)) return;
    f32x4 acc[2][2][4][2];
#pragma unroll
    for (int a = 0; a < 2; ++a)
#pragma unroll
        for (int b = 0; b < 2; ++b)
#pragma unroll
            for (int m = 0; m < 4; ++m)
#pragma unroll
                for (int n = 0; n < 2; ++n) acc[a][b][m][n] = (f32x4){0.f, 0.f, 0.f, 0.f};
    bf16x8 At[4][2], B0[2][2], B1[2][2];
    const char* cA = (const char*)g.A + (size_t)cur.pm * tstep; const char* cB = (const char*)g.Bt + (size_t)cur.pn * tstep;
    S.a_ready(cur);
    if constexpr (SP2) {
        PG8_STAGE(PG8_SB(0, 0), cB, voffB); PG8_STAGE(PG8_SB(0, 1), cB + hstep, voffB); PG8_STAGE(PG8_SA(0, 0), cA, voffA); PG8_STAGE(PG8_SA(0, 1), cA + hstep, voffA);
        if (wr == 1) PG8_BAR;
        PG8_WAIT_V(2); PG8_BAR;
        PG8_STAGE(PG8_SB(1, 0), cB + kstep, voffB); PG8_STAGE(PG8_SA(1, 0), cA + kstep, voffA); PG8_STAGE(PG8_SB(1, 1), cB + hstep + kstep, voffB);
        PG8_WAIT_V(6); PG8_BAR;
    } else {
        PG8_STAGE(PG8_SB(0, 0), cB, voffB); PG8_STAGE(PG8_SA(0, 0), cA, voffA); PG8_STAGE(PG8_SB(0, 1), cB + hstep, voffB); PG8_STAGE(PG8_SA(0, 1), cA + hstep, voffA);
        if (wr == 1) PG8_BAR;
        PG8_WAIT_V(4); PG8_BAR;
        PG8_STAGE(PG8_SB(1, 0), cB + kstep, voffB); PG8_STAGE(PG8_SA(1, 0), cA + kstep, voffA); PG8_STAGE(PG8_SB(1, 1), cB + hstep + kstep, voffB);
        PG8_WAIT_V(6); PG8_BAR;
    }
    for (;;) {
        const bool has_next = S.next(ui + 1, nxt);
        const char* nA = has_next ? (const char*)g.A + (size_t)nxt.pm * tstep : cA; const char* nB = has_next ? (const char*)g.Bt + (size_t)nxt.pn * tstep : cB;
        for (int t = 0; t < nt; t += 2) {
            const bool last = (t == nt - 2);
            const char* a1 = cA + (size_t)(t + 1) * kstep;
            const char* a2 = last ? nA : cA + (size_t)(t + 2) * kstep; const char* b2 = last ? nB : cB + (size_t)(t + 2) * kstep;
            const char* a3 = a2 + kstep; const char* b3 = b2 + kstep;
            if (last && has_next) S.a_ready(nxt);
            if constexpr (SP2) {
            PG8_LDB(B0, 0, 0); PG8_LDB(B1, 0, 1); PG8_SCHED; PG8_LDA(At, 0, 0); PG8_STAGE(PG8_SA(1, 1), a1 + hstep, voffA);
            PG8_WAIT_V(8); PG8_WAIT_L(0); PG8_BAR; PG8_MMA(0, 0, At, B0); PG8_MMA(0, 1, At, B1); PG8_BAR; PG8_SCHED;
            PG8_LDA(At, 0, 1); PG8_STAGE(PG8_SB(0, 0), b2, voffB); PG8_STAGE(PG8_SB(0, 1), b2 + hstep, voffB); PG8_STAGE(PG8_SA(0, 0), a2, voffA);
            PG8_WAIT_V(8); PG8_WAIT_L(0); PG8_BAR; PG8_MMA(1, 0, At, B0); PG8_MMA(1, 1, At, B1); PG8_BAR; PG8_SCHED;
            PG8_LDB(B0, 1, 0); PG8_LDB(B1, 1, 1); PG8_SCHED; PG8_LDA(At, 1, 0); PG8_STAGE(PG8_SA(0, 1), a2 + hstep, voffA);
            PG8_WAIT_V(8); PG8_WAIT_L(0); PG8_BAR; PG8_MMA(0, 0, At, B0); PG8_MMA(0, 1, At, B1); PG8_BAR; PG8_SCHED;
            PG8_LDA(At, 1, 1); PG8_STAGE(PG8_SB(1, 0), b3, voffB); PG8_STAGE(PG8_SB(1, 1), b3 + hstep, voffB); PG8_STAGE(PG8_SA(1, 0), a3, voffA);
            PG8_WAIT_V(8); PG8_WAIT_L(0); PG8_BAR; PG8_MMA(1, 0, At, B0); PG8_MMA(1, 1, At, B1); PG8_BAR; PG8_SCHED;
            } else {
            PG8_LDB(B0, 0, 0); PG8_SCHED; PG8_LDA(At, 0, 0); PG8_STAGE(PG8_SA(1, 1), a1 + hstep, voffA);
            PG8_WAIT_L(8); PG8_BAR; PG8_WAIT_L(0); PG8_MMA(0, 0, At, B0); PG8_BAR; PG8_SCHED;
            PG8_LDB(B1, 0, 1); PG8_STAGE(PG8_SB(0, 0), b2, voffB);
            PG8_BAR; PG8_WAIT_L(0); PG8_MMA(0, 1, At, B1); PG8_BAR;
            PG8_LDA(At, 0, 1); PG8_STAGE(PG8_SA(0, 0), a2, voffA);
            PG8_BAR; PG8_WAIT_L(0); PG8_MMA(1, 0, At, B0); PG8_BAR; PG8_SCHED;
            PG8_STAGE(PG8_SB(0, 1), b2 + hstep, voffB);
            PG8_WAIT_V(6); PG8_BAR; PG8_MMA(1, 1, At, B1); PG8_BAR;
            PG8_LDB(B0, 1, 0); PG8_SCHED; PG8_LDA(At, 1, 0); PG8_STAGE(PG8_SA(0, 1), a2 + hstep, voffA);
            PG8_WAIT_L(8); PG8_BAR; PG8_WAIT_L(0); PG8_MMA(0, 0, At, B0); PG8_BAR; PG8_SCHED;
            PG8_LDB(B1, 1, 1); PG8_STAGE(PG8_SB(1, 0), b3, voffB);
            PG8_BAR; PG8_WAIT_L(0); PG8_MMA(0, 1, At, B1); PG8_BAR;
            PG8_LDA(At, 1, 1); PG8_STAGE(PG8_SA(1, 0), a3, voffA);
            PG8_BAR; PG8_WAIT_L(0); PG8_MMA(1, 0, At, B0); PG8_BAR; PG8_SCHED;
            PG8_STAGE(PG8_SB(1, 1), b3 + hstep, voffB);
            PG8_WAIT_V(6); PG8_BAR; PG8_MMA(1, 1, At, B1); PG8_BAR;
            }
        }
        if constexpr (ALIGN_EPI) { if (wr == 0) PG8_BAR; }
        if constexpr (!Epi::AFTER_DRAIN) { E(acc, cur, wr, wc, fr, fq); S.done(cur); }
        if (!has_next) break;
#pragma unroll
        for (int a = 0; a < 2; ++a)
#pragma unroll
            for (int b = 0; b < 2; ++b)
#pragma unroll
                for (int m = 0; m < 4; ++m)
#pragma unroll
                    for (int n = 0; n < 2; ++n) acc[a][b][m][n] = (f32x4){0.f, 0.f, 0.f, 0.f};
        cur = nxt; cA = nA; cB = nB; ++ui;
        if constexpr (ALIGN_EPI) { if (wr == 1) PG8_BAR; }
    }
    PG8_WAIT_V(0);
    if constexpr (!ALIGN_EPI) { if (wr == 0) PG8_BAR; }
    PG8_BAR;
    if constexpr (Epi::AFTER_DRAIN) { E.fused(acc, cur, wr, wc, fr, fq, lds, wid, lane); S.done(cur); }
#undef PG8_SA
#undef PG8_SB
#undef PG8_STAGE
#undef PG8_LDA
#undef PG8_LDB
#undef PG8_MMA
#undef PG8_WAIT_V
#undef PG8_WAIT_L
#undef PG8_BAR
#undef PG8_SCHED
}
}

using pg8::Unit;
struct EpiStore {
    static constexpr bool PERM = true, AFTER_DRAIN = false;
    const float* ss; bf16_t* base[4]; int ld[4]; int ts[4]; float* gates; int t2;
    __device__ __forceinline__ void operator()(const f32x4 (&acc)[2][2][4][2], const Unit& u, int wr, int wc, int fr, int fq) const {
        const int row0 = u.pm * 256 + wr * 64 + fr; const int pn = u.pn;
        if (pn >= t2) {
            if (wc == 0 && fq < 2) {
#pragma unroll
                for (int ai = 0; ai < 2; ++ai)
#pragma unroll
                    for (int m = 0; m < 4; ++m) { const int row = row0 + ai * 128 + m * 16; const float s = ss ? rs_of(ss, row) : 1.f;
                        float* gp = gates + (size_t)row * 16 + 8 * fq; *(f32x4*)gp = acc[ai][0][m][0] * s; *(f32x4*)(gp + 4) = acc[ai][0][m][1] * s; }
            }
            return;
        }
        int k = 0; if (pn >= ts[1]) k = 1; if (pn >= ts[2]) k = 2; if (pn >= ts[3]) k = 3;
        bf16_t* bsel = base[0]; int ldsel = ld[0], t0 = ts[0];
        if (k == 1) { bsel = base[1]; ldsel = ld[1]; t0 = ts[1]; } else if (k == 2) { bsel = base[2]; ldsel = ld[2]; t0 = ts[2]; } else if (k == 3) { bsel = base[3]; ldsel = ld[3]; t0 = ts[3]; }
        const int col0 = (pn - t0) * 256 + wc * 32 + 8 * fq;
#pragma unroll
        for (int ai = 0; ai < 2; ++ai)
#pragma unroll
            for (int m = 0; m < 4; ++m) { const int row = row0 + ai * 128 + m * 16; const float s = ss ? rs_of(ss, row) : 1.f;
                bf16_t* rowp = bsel + (size_t)row * ldsel + col0;
#pragma unroll
                for (int bj = 0; bj < 2; ++bj) { const f32x4 v0 = acc[ai][bj][m][0] * s, v1 = acc[ai][bj][m][1] * s;
                    u32x4 w; w.x = pk2(v0[0], v0[1]); w.y = pk2(v0[2], v0[3]); w.z = pk2(v1[0], v1[1]); w.w = pk2(v1[2], v1[3]);
                    *(u32x4*)(rowp + bj * 128) = w; } }
    }
};

#ifndef RES_BM
#define RES_BM 4
#endif
#ifndef RES1_BM
#define RES1_BM 2
#endif
template <int MODE> struct EpiResid {
    static constexpr bool PERM = true, AFTER_DRAIN = false;
    const float* rin32; bf16_t* rb; const bf16_t* rlo; bf16_t* rlo_w; float* ss_out; const float* ss_in; const float* bias; const bf16_t* pp; bf16_t* rb2; LAS float* sl;
    __device__ __forceinline__ void ld_r(size_t off, f32x4& r0, f32x4& r1) const {
        if (rin32) { r0 = *(const f32x4*)(rin32 + off); r1 = *(const f32x4*)(rin32 + off + 4); }
        else { const u32x4 h = *(const u32x4*)(rb + off), l = *(const u32x4*)(rlo + off);
            r0[0] = bflo(h.x) + bflo(l.x); r0[1] = bfhi(h.x) + bfhi(l.x); r0[2] = bflo(h.y) + bflo(l.y); r0[3] = bfhi(h.y) + bfhi(l.y);
            r1[0] = bflo(h.z) + bflo(l.z); r1[1] = bfhi(h.z) + bfhi(l.z); r1[2] = bflo(h.w) + bflo(l.w); r1[3] = bfhi(h.w) + bfhi(l.w); }
    }
    __device__ __forceinline__ float st_r(size_t off, const f32x4& r0, const f32x4& r1) const {
        u32x4 w; w.x = pk2(r0[0], r0[1]); w.y = pk2(r0[2], r0[3]); w.z = pk2(r1[0], r1[1]); w.w = pk2(r1[2], r1[3]);
        u32x4 l; l.x = pk2(r0[0] - bflo(w.x), r0[1] - bfhi(w.x)); l.y = pk2(r0[2] - bflo(w.y), r0[3] - bfhi(w.y)); l.z = pk2(r1[0] - bflo(w.z), r1[1] - bfhi(w.z)); l.w = pk2(r1[2] - bflo(w.w), r1[3] - bfhi(w.w));
        *(u32x4*)(rb + off) = w; *(u32x4*)(rlo_w + off) = l; if (rb2) *(u32x4*)(rb2 + off) = w;
        return (r0[0] * r0[0] + r0[1] * r0[1]) + (r0[2] * r0[2] + r0[3] * r0[3]) + (r1[0] * r1[0] + r1[1] * r1[1]) + (r1[2] * r1[2] + r1[3] * r1[3]);
    }
    __device__ __forceinline__ void operator()(const f32x4 (&acc)[2][2][4][2], const Unit& u, int wr, int wc, int fr, int fq) const {
        run<false>(acc, u, wr, wc, fr, fq);
    }
    template <bool F32IN> __device__ __forceinline__ void run(const f32x4 (&acc)[2][2][4][2], const Unit& u, int wr, int wc, int fr, int fq) const {
        const int row0 = u.pm * 256 + wr * 64 + fr; const int col0 = u.pn * 256 + wc * 32 + 8 * fq;
        float sqa[2][4] = {{0.f, 0.f, 0.f, 0.f}, {0.f, 0.f, 0.f, 0.f}}; float sina[2][4]; f32x4 bia[2][2];
#pragma unroll
        for (int ai = 0; ai < 2; ++ai)
#pragma unroll
            for (int m = 0; m < 4; ++m) sina[ai][m] = (MODE == 1) ? rs_of(ss_in, row0 + ai * 128 + m * 16) : 1.f;
#pragma unroll
        for (int bj = 0; bj < 2; ++bj) { bia[bj][0] = (f32x4){0.f, 0.f, 0.f, 0.f}; bia[bj][1] = (f32x4){0.f, 0.f, 0.f, 0.f};
            if (MODE == 1) { bia[bj][0] = *(const f32x4*)(bias + col0 + bj * 128); bia[bj][1] = *(const f32x4*)(bias + col0 + bj * 128 + 4); } }
        constexpr int RPB = (MODE == 1) ? 1 : 2;
        constexpr int NBAT = 16 / RPB;
        u32x4 ph[2][RPB], pl[2][RPB], pw[2][RPB];
#define RES_AI(b_) ((b_) / (8 / RPB))
#define RES_BJ(b_) (((b_) / (4 / RPB)) & 1)
#define RES_MH(b_) (((b_) % (4 / RPB)) * RPB)
#define RES_OFF(b_, m_) ((size_t)(row0 + RES_AI(b_) * 128 + (RES_MH(b_) + (m_)) * 16) * 1024 + col0 + RES_BJ(b_) * 128)
#define RES_LOAD(b_, buf_) do { _Pragma("unroll") for (int m_ = 0; m_ < RPB; ++m_) { const size_t off_ = RES_OFF(b_, m_); ph[buf_][m_] = *(const u32x4*)(rb + off_); pl[buf_][m_] = *(const u32x4*)(rlo + off_); \
            if (MODE == 1) pw[buf_][m_] = *(const u32x4*)(pp + off_); } } while (0)
        __builtin_amdgcn_sched_barrier(0);
        RES_LOAD(0, 0);
        __builtin_amdgcn_sched_barrier(0);
#pragma unroll
        for (int b = 0; b < NBAT; ++b) { const int buf = b & 1; const int ai = RES_AI(b), bj = RES_BJ(b), mh = RES_MH(b);
            if (b + 1 < NBAT) { RES_LOAD(b + 1, buf ^ 1); }
            __builtin_amdgcn_sched_barrier(0);
            const f32x4 b0 = bia[bj][0], b1 = bia[bj][1];
#pragma unroll
            for (int m = 0; m < RPB; ++m) { const size_t off = RES_OFF(b, m); const float si = sina[ai][mh + m]; const u32x4 h = ph[buf][m], l = pl[buf][m];
                f32x4 p0, p1;
                p0[0] = bflo(h.x) + bflo(l.x); p0[1] = bfhi(h.x) + bfhi(l.x); p0[2] = bflo(h.y) + bflo(l.y); p0[3] = bfhi(h.y) + bfhi(l.y);
                p1[0] = bflo(h.z) + bflo(l.z); p1[1] = bfhi(h.z) + bfhi(l.z); p1[2] = bflo(h.w) + bflo(l.w); p1[3] = bfhi(h.w) + bfhi(l.w);
                f32x4 a0 = acc[ai][bj][mh + m][0], a1 = acc[ai][bj][mh + m][1];
                if (MODE == 1) { const u32x4 w = pw[buf][m];
                    a0[0] = sigm(a0[0] * si + b0[0]) * bflo(w.x); a0[1] = sigm(a0[1] * si + b0[1]) * bfhi(w.x);
                    a0[2] = sigm(a0[2] * si + b0[2]) * bflo(w.y); a0[3] = sigm(a0[3] * si + b0[3]) * bfhi(w.y);
                    a1[0] = sigm(a1[0] * si + b1[0]) * bflo(w.z); a1[1] = sigm(a1[1] * si + b1[1]) * bfhi(w.z);
                    a1[2] = sigm(a1[2] * si + b1[2]) * bflo(w.w); a1[3] = sigm(a1[3] * si + b1[3]) * bfhi(w.w); }
                const f32x4 r0 = p0 + a0, r1 = p1 + a1;
                sqa[ai][mh + m] += st_r(off, r0, r1); }
            __builtin_amdgcn_sched_barrier(0);
        }
#undef RES_AI
#undef RES_BJ
#undef RES_MH
#undef RES_LOAD
#undef RES_OFF
#pragma unroll
        for (int ai = 0; ai < 2; ++ai)
#pragma unroll
            for (int m = 0; m < 4; ++m) { float q = sqa[ai][m]; q += __shfl_xor(q, 16); q += __shfl_xor(q, 32);
                if (fq == 0) sl[(ai * 128 + wr * 64 + m * 16 + fr) * 4 + wc] = q; }
        asm volatile("s_waitcnt lgkmcnt(0)" ::: "memory"); __builtin_amdgcn_s_barrier(); asm volatile("" ::: "memory");
        if (fq == 0) {
#pragma unroll
            for (int ai = 0; ai < 2; ++ai) { const int r = ai * 128 + wr * 64 + wc * 16 + fr; const f32x4 p = *(const LAS f32x4*)(sl + r * 4);
                ss_out[(size_t)(u.pm * 256 + r) * 4 + u.pn] = (p[0] + p[1]) + (p[2] + p[3]); } }
    }
};

#ifndef GLU_BM
#define GLU_BM 2
#endif
struct EpiGlu {
    static constexpr bool PERM = true, AFTER_DRAIN = false;
    const float* ss; const bf16_t* G; const float* cw; const float* cb; bf16_t* act;
    __device__ __forceinline__ void operator()(const f32x4 (&acc)[2][2][4][2], const Unit& u, int wr, int wc, int fr, int fq) const {
        const int row0 = u.pm * 256 + wr * 64 + fr; const int col0 = u.pn * 256 + wc * 32 + 8 * fq;
#pragma unroll
        for (int bj = 0; bj < 2; ++bj) { const int c = col0 + bj * 128;
            const f32x4 w0a = *(const f32x4*)(cw + c), w0b = *(const f32x4*)(cw + c + 4), w1a = *(const f32x4*)(cw + FF + c), w1b = *(const f32x4*)(cw + FF + c + 4);
            const f32x4 w2a = *(const f32x4*)(cw + 2 * FF + c), w2b = *(const f32x4*)(cw + 2 * FF + c + 4), bba = *(const f32x4*)(cb + c), bbb = *(const f32x4*)(cb + c + 4);
#pragma unroll
            for (int ai = 0; ai < 2; ++ai)
#pragma unroll
            for (int mh = 0; mh < 4; mh += GLU_BM) {
                u32x4 gmv[GLU_BM], glv[GLU_BM], gnv[GLU_BM]; float sv[GLU_BM];
#pragma unroll
                for (int m = 0; m < GLU_BM; ++m) { const int row = row0 + ai * 128 + (mh + m) * 16; const int t = row & (SEQ - 1); const bf16_t* gp = G + (size_t)row * FF + c;
                    gmv[m] = *(const u32x4*)gp; glv[m] = (u32x4){0u, 0u, 0u, 0u}; gnv[m] = (u32x4){0u, 0u, 0u, 0u};
                    if (t > 0) glv[m] = *(const u32x4*)(gp - FF);
                    if (t < SEQ - 1) gnv[m] = *(const u32x4*)(gp + FF);
                    sv[m] = rs_of(ss, row); }
#pragma unroll
                for (int m = 0; m < GLU_BM; ++m) { const int row = row0 + ai * 128 + (mh + m) * 16; const float s = sv[m]; const u32x4 gm = gmv[m], gl = glv[m], gn = gnv[m];
                    f32x4 ga, gb;
                    ga[0] = w0a[0] * bflo(gl.x) + w1a[0] * bflo(gm.x) + w2a[0] * bflo(gn.x) + bba[0];
                    ga[1] = w0a[1] * bfhi(gl.x) + w1a[1] * bfhi(gm.x) + w2a[1] * bfhi(gn.x) + bba[1];
                    ga[2] = w0a[2] * bflo(gl.y) + w1a[2] * bflo(gm.y) + w2a[2] * bflo(gn.y) + bba[2];
                    ga[3] = w0a[3] * bfhi(gl.y) + w1a[3] * bfhi(gm.y) + w2a[3] * bfhi(gn.y) + bba[3];
                    gb[0] = w0b[0] * bflo(gl.z) + w1b[0] * bflo(gm.z) + w2b[0] * bflo(gn.z) + bbb[0];
                    gb[1] = w0b[1] * bfhi(gl.z) + w1b[1] * bfhi(gm.z) + w2b[1] * bfhi(gn.z) + bbb[1];
                    gb[2] = w0b[2] * bflo(gl.w) + w1b[2] * bflo(gm.w) + w2b[2] * bflo(gn.w) + bbb[2];
                    gb[3] = w0b[3] * bfhi(gl.w) + w1b[3] * bfhi(gm.w) + w2b[3] * bfhi(gn.w) + bbb[3];
                    const f32x4 a0 = acc[ai][bj][mh + m][0] * s, a1 = acc[ai][bj][mh + m][1] * s;
                    u32x4 w; w.x = pk2(gelu_t(ga[0]) * a0[0], gelu_t(ga[1]) * a0[1]); w.y = pk2(gelu_t(ga[2]) * a0[2], gelu_t(ga[3]) * a0[3]);
                    w.z = pk2(gelu_t(gb[0]) * a1[0], gelu_t(gb[1]) * a1[1]); w.w = pk2(gelu_t(gb[2]) * a1[2], gelu_t(gb[3]) * a1[3]);
                    *(u32x4*)(act + (size_t)row * FF + c) = w; } } }
    }
};

struct EpiGluF {
    static constexpr bool PERM = true, AFTER_DRAIN = false;
    const float* ss; const float* haloT; const float* haloB; const float* cw; const float* cb; bf16_t* act; LAS float* ex;
    __device__ __forceinline__ void operator()(const f32x4 (&acc)[2][2][4][2], const Unit& u, int wr, int wc, int fr, int fq) const {
        const int row0 = u.pm * 256 + wr * 64 + fr; const int chl = wc * 32 + 8 * fq; const int chg = u.pn * 128 + chl;
        float rsm[2][4];
#pragma unroll
        for (int ai = 0; ai < 2; ++ai)
#pragma unroll
            for (int m = 0; m < 4; ++m) rsm[ai][m] = rs_of(ss, row0 + ai * 128 + m * 16);
        if (fr == 0 || fr == 15) {
#pragma unroll
            for (int ai = 0; ai < 2; ++ai)
#pragma unroll
                for (int m = 0; m < 4; ++m) { const int rgi = ai * 8 + wr * 4 + m; LAS float* e = ex + (2 * rgi + (fr == 15 ? 1 : 0)) * 128 + chl;
                    *(LAS f32x4*)e = acc[ai][0][m][0] * rsm[ai][m]; *(LAS f32x4*)(e + 4) = acc[ai][0][m][1] * rsm[ai][m]; } }
        asm volatile("s_waitcnt lgkmcnt(0)" ::: "memory"); __builtin_amdgcn_s_barrier(); asm volatile("" ::: "memory");
#pragma unroll
        for (int ai = 0; ai < 2; ++ai)
#pragma unroll
            for (int m = 0; m < 4; ++m) { const int row = row0 + ai * 128 + m * 16; const int t = row & (SEQ - 1); const int rgi = ai * 8 + wr * 4 + m;
                int cq = chg; asm volatile("" : "+v"(cq));
                const f32x4 w0a = *(const f32x4*)(cw + cq), w0b = *(const f32x4*)(cw + cq + 4), w1a = *(const f32x4*)(cw + FF + cq), w1b = *(const f32x4*)(cw + FF + cq + 4);
                const f32x4 w2a = *(const f32x4*)(cw + 2 * FF + cq), w2b = *(const f32x4*)(cw + 2 * FF + cq + 4), bba = *(const f32x4*)(cb + cq), bbb = *(const f32x4*)(cb + cq + 4);
                const float sm = rsm[ai][m]; const float su = __shfl_up(sm, 1, 16), sd = __shfl_down(sm, 1, 16);
                f32x4 gm0 = acc[ai][0][m][0] * sm, gm1 = acc[ai][0][m][1] * sm, gu0, gu1, gd0, gd1;
#pragma unroll
                for (int j = 0; j < 4; ++j) { gu0[j] = __shfl_up(acc[ai][0][m][0][j], 1, 16) * su; gu1[j] = __shfl_up(acc[ai][0][m][1][j], 1, 16) * su;
                    gd0[j] = __shfl_down(acc[ai][0][m][0][j], 1, 16) * sd; gd1[j] = __shfl_down(acc[ai][0][m][1][j], 1, 16) * sd; }
                if (fr == 0) {
                    if (rgi > 0) { const LAS float* e = ex + (2 * (rgi - 1) + 1) * 128 + chl; gu0 = *(const LAS f32x4*)e; gu1 = *(const LAS f32x4*)(e + 4); }
                    else if (t != 0) { const float* h = haloT + (size_t)u.pm * FF + chg; gu0 = *(const f32x4*)h; gu1 = *(const f32x4*)(h + 4); }
                    else { gu0 = (f32x4){0.f, 0.f, 0.f, 0.f}; gu1 = gu0; } }
                if (fr == 15) {
                    if (rgi < 15) { const LAS float* e = ex + (2 * (rgi + 1)) * 128 + chl; gd0 = *(const LAS f32x4*)e; gd1 = *(const LAS f32x4*)(e + 4); }
                    else if (t != SEQ - 1) { const float* h = haloB + (size_t)u.pm * FF + chg; gd0 = *(const f32x4*)h; gd1 = *(const f32x4*)(h + 4); }
                    else { gd0 = (f32x4){0.f, 0.f, 0.f, 0.f}; gd1 = gd0; } }
                const f32x4 ga = w0a * gu0 + w1a * gm0 + w2a * gd0 + bba, gb = w0b * gu1 + w1b * gm1 + w2b * gd1 + bbb;
                const f32x4 a0 = acc[ai][1][m][0] * sm, a1 = acc[ai][1][m][1] * sm;
                u32x4 w; w.x = pk2(gelu_t(ga[0]) * a0[0], gelu_t(ga[1]) * a0[1]); w.y = pk2(gelu_t(ga[2]) * a0[2], gelu_t(ga[3]) * a0[3]);
                w.z = pk2(gelu_t(gb[0]) * a1[0], gelu_t(gb[1]) * a1[1]); w.w = pk2(gelu_t(gb[2]) * a1[2], gelu_t(gb[3]) * a1[3]);
                *(u32x4*)(act + (size_t)row * FF + chg) = w; }
    }
};

struct Params { const float* in[28]; float* out; unsigned char* ws; };
typedef LAS unsigned* PT;
__device__ __forceinline__ const float* pin(PT t0, int k) { unsigned ta = (unsigned)(size_t)t0; asm volatile("" : "+s"(ta)); const PT t = (PT)(size_t)ta;
    const unsigned lo = __builtin_amdgcn_readfirstlane(t[2 * k]), hi = __builtin_amdgcn_readfirstlane(t[2 * k + 1]); return (const float*)(__attribute__((address_space(1))) const float*)(((unsigned long long)hi << 32) | lo); }
__device__ __forceinline__ float* pout(PT t) { return (float*)pin(t, 28); }
__device__ __forceinline__ unsigned char* pws(PT t) { return (unsigned char*)pin(t, 29); }
enum { I_X = 0, I_P, I_N1G, I_WIN, I_DNCW, I_ALOG, I_DTB, I_DNG, I_LCW, I_LCB, I_LWA, I_LBA, I_LWX, I_LBX, I_LAM, I_LNG, I_WOUT, I_N2G, I_FWG, I_FWU, I_FCW, I_FCB, I_FWD, I_PNG, I_PWG, I_PBG, I_PWP, I_FING };

template <class RM>
__device__ __forceinline__ void tr_item(const float* W, int K, int N, bf16_t* WT, int ldt, const float* gk, const RM& rm, LAS float* scr, int item, int lane) {
    const int nblk = (N + 31) >> 5, kb = item / nblk, nb = item % nblk, k0 = 64 * kb, n0 = 32 * nb;
#pragma unroll 8
    for (int i = 0; i < 32; ++i) { const int kk = 2 * i + (lane >> 5), n = n0 + (lane & 31);
        float v = (n < N) ? W[(size_t)(k0 + kk) * N + n] : 0.f; if (gk) v *= gk[k0 + kk];
        scr[kk * 33 + (lane & 31)] = v; }
    LDS_FENCE();
    const int c = lane & 7;
#pragma unroll
    for (int j = 0; j < 4; ++j) { const int nl = (lane >> 3) + 8 * j, n = n0 + nl; const LAS float* s = scr + (8 * c) * 33 + nl;
        u32x4 o; o.x = pk2(s[0 * 33], s[1 * 33]); o.y = pk2(s[2 * 33], s[3 * 33]); o.z = pk2(s[4 * 33], s[5 * 33]); o.w = pk2(s[6 * 33], s[7 * 33]);
        const int dst = (n < N) ? rm(n) : -1;
        if (dst >= 0) *(u32x4*)(WT + (size_t)dst * ldt + k0 + 8 * c) = o; }
    LDS_FENCE();
}
struct RmId { __device__ __forceinline__ int operator()(int n) const { return n; } };
struct RmGU { int off; __device__ __forceinline__ int operator()(int n) const { return (n >> 7) * 256 + off + (n & 127); } };
struct RmIn { __device__ __forceinline__ int operator()(int n) const {
    if (n < 1536) return n;
    if (n < 2048) return 2048 + (n - 1536);
    if (n < 2064) return 3072 + (n - 2048);
    if (n < 2576) return 1536 + (n - 2064);
    return 2560 + (n - 2576);
} };

__device__ __forceinline__ void prologue(PT pt, LAS unsigned char* lds, int gw, int NGW, int lane, int wave) {
    asm volatile("" : "+v"(lane));
    unsigned char* ws = pws(pt);
    for (int l = 0; l < NL; ++l) { u32x4* z = (u32x4*)((bf16_t*)(ws + WS_WIN) + ((size_t)l * 3328 + 3088) * 1024); const int n4 = 240 * 1024 / 8;
        for (int i = gw * 64 + lane; i < n4; i += NGW * 64) z[i] = (u32x4){0u, 0u, 0u, 0u}; }
    LAS float* scr = (LAS float*)(lds + wave * 16384);
    constexpr int I_IN = 16 * 97, I_OUT = 16 * 32, I_G = 16 * 88, I_D = 44 * 32, I_PG = 16 * 32, I_PP = 4 * 32, I_LA = 32;
    constexpr int PER_L = I_IN + I_OUT + 2 * I_G + I_D + I_PG + I_PP + 2 * I_LA;
    for (int it = gw; it < NL * PER_L; it += NGW) {
        const int l = it / PER_L; int r = it % PER_L;
        if (r < I_IN) { tr_item(pin(pt, I_WIN) + (size_t)l * DM * INC, DM, INC, (bf16_t*)(ws + WS_WIN) + (size_t)l * 3328 * 1024, 1024, pin(pt, I_N1G) + l * DM, RmIn(), scr, r, lane); continue; } r -= I_IN;
        if (r < I_OUT) { tr_item(pin(pt, I_WOUT) + (size_t)l * DM * DM, DM, DM, (bf16_t*)(ws + WS_WOUT) + (size_t)l * DM * DM, 1024, nullptr, RmId(), scr, r, lane); continue; } r -= I_OUT;
        if (r < I_G) { tr_item(pin(pt, I_FWG) + (size_t)l * DM * FF, DM, FF, (bf16_t*)(ws + WS_WG) + (size_t)l * 5632 * 1024, 1024, pin(pt, I_N2G) + l * DM, RmGU{0}, scr, r, lane); continue; } r -= I_G;
        if (r < I_G) { tr_item(pin(pt, I_FWU) + (size_t)l * DM * FF, DM, FF, (bf16_t*)(ws + WS_WG) + (size_t)l * 5632 * 1024, 1024, pin(pt, I_N2G) + l * DM, RmGU{128}, scr, r, lane); continue; } r -= I_G;
        if (r < I_D) { tr_item(pin(pt, I_FWD) + (size_t)l * FF * DM, FF, DM, (bf16_t*)(ws + WS_WD) + (size_t)l * DM * FF, FF, nullptr, RmId(), scr, r, lane); continue; } r -= I_D;
        if (r < I_PG) { tr_item(pin(pt, I_PWG) + (size_t)l * DM * DM, DM, DM, (bf16_t*)(ws + WS_WPG) + (size_t)l * DM * DM, 1024, pin(pt, I_PNG) + l * DM, RmId(), scr, r, lane); continue; } r -= I_PG;
        if (r < I_PP) { tr_item(pin(pt, I_PWP) + (size_t)l * PLE * DM, PLE, DM, (bf16_t*)(ws + WS_WP) + (size_t)l * DM * PLE, PLE, nullptr, RmId(), scr, r, lane); continue; } r -= I_PP;
        { const int gate = r / I_LA; r %= I_LA; const int mat = r >> 1, sub = r & 1;
          const float* src = pin(pt, gate ? I_LWX : I_LWA) + ((size_t)l * 16 + mat) * 4096;
          bf16_t* dst = (bf16_t*)(ws + WS_WAT) + (((size_t)l * 16 + mat) * 2 + gate) * 4096;
          tr_item(src, 64, 64, dst, 64, nullptr, RmId(), scr, sub, lane); }
    }
    const float* x = pin(pt, I_X); bf16_t* rb = (bf16_t*)(ws + WS_RB); float* ss0 = (float*)(ws + WS_SSP); bf16_t* rl = (bf16_t*)pout(pt) + (size_t)M_TOK * 1024;
    for (int m = gw; m < M_TOK; m += NGW) { const f32x4* xr = (const f32x4*)(x + (size_t)m * DM) + lane; u32x2* o = (u32x2*)(rb + (size_t)m * DM) + lane; u32x2* ol = (u32x2*)(rl + (size_t)m * DM) + lane; float s = 0.f;
#pragma unroll
        for (int j = 0; j < 4; ++j) { const f32x4 v = xr[64 * j]; s += (v[0] * v[0] + v[1] * v[1]) + (v[2] * v[2] + v[3] * v[3]); const u32x2 hw = pk4(v); o[64 * j] = hw;
            ol[64 * j] = pk4((f32x4){v[0] - bflo(hw.x), v[1] - bfhi(hw.x), v[2] - bflo(hw.y), v[3] - bfhi(hw.y)}); }
#pragma unroll
        for (int o2 = 1; o2 < 64; o2 <<= 1) s += __shfl_xor(s, o2);
        if (lane < 4) ss0[(size_t)m * 4 + lane] = lane == 0 ? s : 0.f; }
}

__device__ __forceinline__ void lru_block(PT pt, LAS unsigned char* lds, int bi, int layer, int tid) {
    asm volatile("" : "+v"(tid));
    const int lane = tid & 63, w = tid >> 6;
    unsigned char* ws = pws(pt);
    const int wi = bi * 8 + w;
    const int dq = wi & 3, n = (wi >> 2) & 7, dir = (wi >> 5) & 1, b = wi >> 6;
    const int fr = lane & 15, fq = lane >> 4;
    LAS unsigned char* XCB = lds + (w >> 2) * 8192;
    LAS unsigned char* SCN = lds + 16384 + w * 1024;
    const int ti = lane >> 2, cq = lane & 3;
    const int cch = 64 * n + 16 * dq + 4 * cq;
    f32x4 cw4[4];
#pragma unroll
    for (int tap = 0; tap < 4; ++tap) cw4[tap] = *(const f32x4*)(pin(pt, I_LCW) + ((size_t)layer * 4 + tap) * 512 + cch);
    const f32x4 cb4 = *(const f32x4*)(pin(pt, I_LCB) + (size_t)layer * 512 + cch);
    const bf16_t* wbase = (const bf16_t*)(ws + WS_WAT) + ((((size_t)layer * 2 + dir) * 8 + n) * 2) * 4096;
    bf16x8 Ba[2], Bx[2];
#pragma unroll
    for (int ks = 0; ks < 2; ++ks) { Ba[ks] = *(const bf16x8*)(wbase + (16 * dq + fr) * 64 + 32 * ks + 8 * fq); Bx[ks] = *(const bf16x8*)(wbase + 4096 + (16 * dq + fr) * 64 + 32 * ks + 8 * fq); }
    const int dch = 64 * n + 16 * dq + fr; const size_t pidx = ((size_t)layer * 2 + dir) * 512 + dch;
    const float ba = pin(pt, I_LBA)[pidx], bx = pin(pt, I_LBX)[pidx], sp8 = 8.0f * 1.4426950408889634f * softplus_f(-pin(pt, I_LAM)[pidx]);
    const bf16_t* plx = (const bf16_t*)(ws + WS_PLX) + (size_t)b * SEQ * 512 + cch;
    bf16_t* hout = (bf16_t*)pout(pt) + (size_t)dir * M_TOK * 512 + (size_t)b * SEQ * 512 + dch;
    u32x2 xr[2][4];
#define LRU_LOAD(scn) do { _Pragma("unroll") for (int s_ = 0; s_ < 2; ++s_) { const int tt_ = dir ? (SEQ - 1 - (32 * (scn) + 16 * s_ + ti)) : (32 * (scn) + 16 * s_ + ti); \
        _Pragma("unroll") for (int tap = 0; tap < 4; ++tap) { const int t2_ = tt_ + tap - 2; xr[s_][tap] = (u32x2){0u, 0u}; if (t2_ >= 0 && t2_ < SEQ) xr[s_][tap] = *(const u32x2*)(plx + (size_t)t2_ * 512); } } } while (0)
    LRU_LOAD(0);
    float hprev = 0.f;
    LBAR();
#pragma unroll 1
    for (int sc = 0; sc < 64; ++sc) {
        LAS unsigned char* XC = XCB + (sc & 1) * 4096;
#pragma unroll
        for (int s2 = 0; s2 < 2; ++s2) { f32x4 xa = cb4;
#pragma unroll
            for (int tap = 0; tap < 4; ++tap) { xa[0] += cw4[tap][0] * bflo(xr[s2][tap].x); xa[1] += cw4[tap][1] * bfhi(xr[s2][tap].x); xa[2] += cw4[tap][2] * bflo(xr[s2][tap].y); xa[3] += cw4[tap][3] * bfhi(xr[s2][tap].y); }
            *(LAS u32x2*)(XC + swz64(16 * s2 + ti, 16 * dq + 4 * cq)) = pk4(xa); }
        if (sc + 1 < 64) LRU_LOAD(sc + 1);
        LBAR();
        float Ac[2][4], Hc[2][4];
#pragma unroll
        for (int s2 = 0; s2 < 2; ++s2) {
            const bf16x8 A0 = *(const LAS bf16x8*)(XC + swz64(16 * s2 + fr, 8 * fq)), A1 = *(const LAS bf16x8*)(XC + swz64(16 * s2 + fr, 32 + 8 * fq));
            f32x4 ca = {0.f, 0.f, 0.f, 0.f}, cx = {0.f, 0.f, 0.f, 0.f};
            ca = MFMA16(A0, Ba[0], ca); ca = MFMA16(A1, Ba[1], ca); cx = MFMA16(A0, Bx[0], cx); cx = MFMA16(A1, Bx[1], cx);
#pragma unroll
            for (int jj = 0; jj < 4; ++jj) { const float xv = bf2f(*(const LAS unsigned short*)(XC + swz64(16 * s2 + 4 * fq + jj, 16 * dq + fr)));
                const float r = sigm(ca[jj] + ba), ig = sigm(cx[jj] + bx), a = __builtin_amdgcn_exp2f(-r * sp8);
                const float bt = __builtin_amdgcn_sqrtf(fmaxf(1.0f - a * a, 0.f)) * ig * xv;
                Hc[s2][jj] = jj ? (a * Hc[s2][jj - 1] + bt) : bt; Ac[s2][jj] = jj ? (a * Ac[s2][jj - 1]) : a; }
            *(LAS f32x2*)(SCN + s2 * 512 + (fq * 16 + fr) * 8) = (f32x2){Ac[s2][3], Hc[s2][3]}; }
#pragma unroll
        for (int s2 = 0; s2 < 2; ++s2) {
            const LAS unsigned char* T = SCN + s2 * 512;
            const f32x2 g0 = *(const LAS f32x2*)(T + (0 * 16 + fr) * 8), g1 = *(const LAS f32x2*)(T + (1 * 16 + fr) * 8), g2 = *(const LAS f32x2*)(T + (2 * 16 + fr) * 8), g3 = *(const LAS f32x2*)(T + (3 * 16 + fr) * 8);
            const float h1 = g0.x * hprev + g0.y, h2 = g1.x * h1 + g1.y, h3 = g2.x * h2 + g2.y, h4 = g3.x * h3 + g3.y;
            const float hin = fq == 0 ? hprev : (fq == 1 ? h1 : (fq == 2 ? h2 : h3));
            hprev = h4;
#pragma unroll
            for (int jj = 0; jj < 4; ++jj) { const float hv = Ac[s2][jj] * hin + Hc[s2][jj]; const int i = 16 * s2 + 4 * fq + jj; const int t2 = dir ? (SEQ - 1 - (32 * sc + i)) : (32 * sc + i);
                hout[(size_t)t2 * 512] = (bf16_t)(pk2(hv, 0.f) & 0xffffu); } }
    }
#undef LRU_LOAD
}

constexpr int DP_BUF0 = 0, DP_BUF1 = 49152, DP_KL = 49152, DP_QL = 49152 + 16384, DP_VL = 49152 + 32768, DP_VEC = 98304, DP_CWL = 99328;
__device__ __forceinline__ void dp_item(PT pt, LAS unsigned char* lds, int item, int layer, int tid, int lane, int w) {
    asm volatile("" : "+v"(tid)); lane = tid & 63; asm volatile("" : "+s"(w));
    unsigned char* ws = pws(pt);
    const int b = item >> 7, h = (item >> 5) & 3, n = item & 31;
    const size_t rowbase = (size_t)b * SEQ + 64 * n;
    LAS float* VEC = (LAS float*)(lds + DP_VEC);
    LBAR();
    f32x4 gpre = {0.f, 0.f, 0.f, 0.f};
    if (w == 0) { const float* gp = (const float*)(ws + WS_GATES) + (rowbase + lane) * 16 + h; gpre[0] = gp[0]; gpre[1] = gp[4]; gpre[2] = gp[8]; gpre[3] = gp[12]; }
    { const int i = tid >> 3, c = tid & 7; const int t = 64 * n + i; const size_t R = rowbase + i;
      const bf16_t* pq = (const bf16_t*)(ws + WS_PQKV);
      u32x4 xin[3][4][2];
#pragma unroll
      for (int mat = 0; mat < 3; ++mat)
#pragma unroll
          for (int tap = 0; tap < 4; ++tap) { const int t2 = t + tap - 2; xin[mat][tap][0] = (u32x4){0u, 0u, 0u, 0u}; xin[mat][tap][1] = (u32x4){0u, 0u, 0u, 0u};
              if (t2 >= 0 && t2 < SEQ) { const bf16_t* xp = pq + (R + tap - 2) * 1536 + mat * 512 + h * 128 + 16 * c; xin[mat][tap][0] = *(const u32x4*)xp; xin[mat][tap][1] = *(const u32x4*)(xp + 8); } }
#pragma unroll
      for (int mat = 0; mat < 3; ++mat) {
          f32x4 a[4] = {{0.f, 0.f, 0.f, 0.f}, {0.f, 0.f, 0.f, 0.f}, {0.f, 0.f, 0.f, 0.f}, {0.f, 0.f, 0.f, 0.f}};
#pragma unroll
          for (int tap = 0; tap < 4; ++tap) { const u32x4 x0 = xin[mat][tap][0], x1 = xin[mat][tap][1];
              const LAS float* wp = (const LAS float*)(lds + DP_CWL) + (mat * 4 + tap) * 128 + 16 * c; const f32x4 w0 = *(const LAS f32x4*)wp, w1 = *(const LAS f32x4*)(wp + 4), w2 = *(const LAS f32x4*)(wp + 8), w3 = *(const LAS f32x4*)(wp + 12);
              a[0][0] += w0[0] * bflo(x0.x); a[0][1] += w0[1] * bfhi(x0.x); a[0][2] += w0[2] * bflo(x0.y); a[0][3] += w0[3] * bfhi(x0.y);
              a[1][0] += w1[0] * bflo(x0.z); a[1][1] += w1[1] * bfhi(x0.z); a[1][2] += w1[2] * bflo(x0.w); a[1][3] += w1[3] * bfhi(x0.w);
              a[2][0] += w2[0] * bflo(x1.x); a[2][1] += w2[1] * bfhi(x1.x); a[2][2] += w2[2] * bflo(x1.y); a[2][3] += w2[3] * bfhi(x1.y);
              a[3][0] += w3[0] * bflo(x1.z); a[3][1] += w3[1] * bfhi(x1.z); a[3][2] += w3[2] * bflo(x1.w); a[3][3] += w3[3] * bfhi(x1.w); }
          float ssq = 0.f;
#pragma unroll
          for (int q = 0; q < 4; ++q)
#pragma unroll
              for (int e = 0; e < 4; ++e) { const float v = a[q][e]; const float sv = v * sigm(v); a[q][e] = sv; ssq += sv * sv; }
          float scale = 1.f;
          if (mat < 2) { ssq += __shfl_xor(ssq, 1); ssq += __shfl_xor(ssq, 2); ssq += __shfl_xor(ssq, 4); scale = rsqrtf(ssq + EPS); if (mat == 0) scale *= 0.08838834764831845f; }
          u32x4 o0, o1; o0.x = pk2(a[0][0] * scale, a[0][1] * scale); o0.y = pk2(a[0][2] * scale, a[0][3] * scale); o0.z = pk2(a[1][0] * scale, a[1][1] * scale); o0.w = pk2(a[1][2] * scale, a[1][3] * scale);
          o1.x = pk2(a[2][0] * scale, a[2][1] * scale); o1.y = pk2(a[2][2] * scale, a[2][3] * scale); o1.z = pk2(a[3][0] * scale, a[3][1] * scale); o1.w = pk2(a[3][2] * scale, a[3][3] * scale);
          const int lbase = (mat == 0) ? DP_QL : (mat == 1 ? DP_KL : DP_VL);
          *(LAS u32x4*)(lds + lbase + swz128(i, 16 * c)) = o0; *(LAS u32x4*)(lds + lbase + swz128(i, 16 * c + 8)) = o1;
          if (mat < 2) { bf16_t* gp = (bf16_t*)(ws + (mat == 0 ? WS_QH : WS_KH)) + R * 512 + h * 128 + 16 * c; *(u32x4*)gp = o0; *(u32x4*)(gp + 8) = o1; } }
    }
    if (w == 0) {
        const float bF = sigm(gpre[0]), bB = sigm(gpre[1]);
        float gF = -expf(pin(pt, I_ALOG)[layer * 8 + h]) * softplus_f(gpre[2] + pin(pt, I_DTB)[layer * 8 + h]);
        float gB = -expf(pin(pt, I_ALOG)[layer * 8 + 4 + h]) * softplus_f(gpre[3] + pin(pt, I_DTB)[layer * 8 + 4 + h]);
#pragma unroll
        for (int off = 1; off < 64; off <<= 1) { const float v = __shfl_up(gF, off); if (lane >= off) gF += v; const float u = __shfl_down(gB, off); if (lane + off < 64) gB += u; }
        const float glF = __shfl(gF, 63), glB = __shfl(gB, 0);
        VEC[lane] = bF; VEC[64 + lane] = gF; VEC[128 + lane] = bB; VEC[192 + lane] = gB;
        float* v0 = (float*)(ws + WS_VEC) + (size_t)item * 256; float* v1 = v0 + (size_t)4096 * 256;
        v0[lane] = bF; v0[64 + lane] = fexp(gF); v0[128 + lane] = fexp(glF - gF); if (lane == 0) v0[192] = fexp(glF);
        v1[lane] = bB; v1[64 + lane] = fexp(gB); v1[128 + lane] = fexp(glB - gB); if (lane == 0) v1[192] = fexp(glB);
    }
    LBAR();
    { const int e = tid >> 2, jq = tid & 3; unsigned vv[8];
#pragma unroll
      for (int p = 0; p < 8; ++p) { const unsigned lo = *(const LAS unsigned short*)(lds + DP_VL + swz128(16 * jq + 2 * p, e)), hi = *(const LAS unsigned short*)(lds + DP_VL + swz128(16 * jq + 2 * p + 1, e)); vv[p] = lo | (hi << 16); }
      bf16_t* gp = (bf16_t*)(ws + WS_VT) + (size_t)item * 8192 + e * 64 + 16 * jq;
      *(u32x4*)gp = (u32x4){vv[0], vv[1], vv[2], vv[3]}; *(u32x4*)(gp + 8) = (u32x4){vv[4], vv[5], vv[6], vv[7]}; }
    const int r32 = lane & 31, hi = lane >> 5;
    { const int kind = w >> 2, q = w & 3, ta = q >> 1, tb = q & 1;
      f32x16 acc; for (int r = 0; r < 16; ++r) acc[r] = 0.f;
      const int bbase = kind ? DP_QL : DP_KL;
#pragma unroll
      for (int ks = 0; ks < 8; ++ks) { const bf16x8 av = *(const LAS bf16x8*)(lds + DP_KL + swz128(32 * ta + r32, 16 * ks + 8 * hi)), bv = *(const LAS bf16x8*)(lds + bbase + swz128(32 * tb + r32, 16 * ks + 8 * hi)); acc = MFMA32(av, bv, acc); }
      const int gb = 32 * tb + r32;
#pragma unroll
      for (int dir = 0; dir < 2; ++dir) { const LAS float* bet = VEC + dir * 128; const LAS float* gc = VEC + dir * 128 + 64;
          const float gcl = gc[gb], betl = bet[gb];
#pragma unroll
          for (int g = 0; g < 4; ++g) { const int ga0 = 32 * ta + 8 * g + 4 * hi; const f32x4 gca = *(const LAS f32x4*)(gc + ga0), bea = *(const LAS f32x4*)(bet + ga0);
              if (kind == 0) { f32x4 xv, yv, pv;
#pragma unroll
                  for (int jj = 0; jj < 4; ++jj) { const int ga = ga0 + jj; const float kk = acc[4 * g + jj];
                      const bool mx = dir ? (gb < ga) : (gb > ga), my = dir ? (ga < gb) : (ga > gb);
                      const float ed = kk * fexp(-fabsf(gcl - gca[jj]));
                      xv[jj] = mx ? (-betl * ed) : 0.f; yv[jj] = my ? (-bea[jj] * ed) : 0.f; pv[jj] = (ga == gb) ? 1.f : 0.f; }
                  LAS unsigned char* bb = lds + DP_BUF0 + dir * 24576 + swz64(gb, ga0);
                  *(LAS u32x2*)bb = pk4(xv); *(LAS u32x2*)(bb + 8192) = pk4(yv); *(LAS u32x2*)(bb + 16384) = pk4(pv);
              } else { f32x4 av4;
#pragma unroll
                  for (int jj = 0; jj < 4; ++jj) { const int ga = ga0 + jj; const bool ma = dir ? (gb <= ga) : (gb >= ga); av4[jj] = ma ? (acc[4 * g + jj] * fexp(-fabsf(gcl - gca[jj]))) : 0.f; }
                  *(u32x2*)((bf16_t*)(ws + WS_AT) + ((size_t)dir * 4096 + item) * 4096 + gb * 64 + ga0) = pk4(av4); } } }
    }
    LBAR();
    { const int dir = w >> 2, q = w & 3, ti = q >> 1, tj = q & 1;
      f32x16 pacc; for (int r = 0; r < 16; ++r) pacc[r] = (32 * tj + crow(r, hi) == 32 * ti + r32) ? 1.f : 0.f;
#pragma unroll 1
      for (int rd = 0; rd < 6; ++rd) { LAS unsigned char* cur = lds + ((rd & 1) ? DP_BUF1 : DP_BUF0) + dir * 24576; LAS unsigned char* nxt = lds + ((rd & 1) ? DP_BUF0 : DP_BUF1) + dir * 24576;
          bf16x8 xf[4], yf[4], pf[4];
#pragma unroll
          for (int ks = 0; ks < 4; ++ks) { xf[ks] = *(const LAS bf16x8*)(cur + swz64(32 * ti + r32, 16 * ks + 8 * hi)); yf[ks] = *(const LAS bf16x8*)(cur + 8192 + swz64(32 * tj + r32, 16 * ks + 8 * hi)); pf[ks] = *(const LAS bf16x8*)(cur + 16384 + swz64(32 * ti + r32, 16 * ks + 8 * hi)); }
#pragma unroll
          for (int ks = 0; ks < 4; ++ks) pacc = MFMA32(yf[ks], pf[ks], pacc);
          if (rd < 5) { f32x16 xa, ya; for (int r = 0; r < 16; ++r) { xa[r] = 0.f; ya[r] = 0.f; }
#pragma unroll
              for (int ks = 0; ks < 4; ++ks) { xa = MFMA32(yf[ks], xf[ks], xa); ya = MFMA32(xf[ks], yf[ks], ya); }
#pragma unroll
              for (int g = 0; g < 4; ++g) { const int c0 = 8 * g + 4 * hi;
                  *(LAS u32x2*)(nxt + swz64(32 * ti + r32, 32 * tj + c0)) = pk4((f32x4){xa[4 * g], xa[4 * g + 1], xa[4 * g + 2], xa[4 * g + 3]});
                  *(LAS u32x2*)(nxt + 8192 + swz64(32 * tj + r32, 32 * ti + c0)) = pk4((f32x4){ya[4 * g], ya[4 * g + 1], ya[4 * g + 2], ya[4 * g + 3]});
                  *(LAS u32x2*)(nxt + 16384 + swz64(32 * ti + r32, 32 * tj + c0)) = pk4((f32x4){pacc[4 * g], pacc[4 * g + 1], pacc[4 * g + 2], pacc[4 * g + 3]}); }
              LBAR(); } }
      bf16_t* tg = (bf16_t*)(ws + WS_TM) + ((size_t)dir * 4096 + item) * 4096 + (32 * ti + r32) * 64 + 32 * tj + 4 * hi;
#pragma unroll
      for (int g = 0; g < 4; ++g) *(u32x2*)(tg + 8 * g) = pk4((f32x4){pacc[4 * g], pacc[4 * g + 1], pacc[4 * g + 2], pacc[4 * g + 3]});
    }
}

constexpr int DR_K = 0, DR_Q = 16384, DR_KT = 32768, DR_VT = 49152, DR_T = 65536, DR_A = 73728, DR_VEC = 81920, DR_PRIV = 83968;
__device__ __forceinline__ void dr_item(PT pt, LAS unsigned char* lds, int item, int tid, int lane, int w) {
    asm volatile("" : "+v"(tid)); lane = tid & 63; asm volatile("" : "+s"(w));
    unsigned char* ws = pws(pt);
    const int dir = item & 1, h = (item >> 1) & 3, b = item >> 3;
    const int fr = lane & 15, fq = lane >> 4, es = 16 * w;
    LAS unsigned char* ST = lds + DR_PRIV + w * 8192; LAS unsigned char* RV = ST + 4096; LAS unsigned char* VN2 = ST + 6144;
    const LAS float* VEC = (const LAS float*)(lds + DR_VEC);
    const bf16_t* kh = (const bf16_t*)(ws + WS_KH) + (size_t)b * SEQ * 512 + h * 128;
    const bf16_t* qh = (const bf16_t*)(ws + WS_QH) + (size_t)b * SEQ * 512 + h * 128;
    const int ibase = (b * 4 + h) * 32;
    const bf16_t* vt = (const bf16_t*)(ws + WS_VT) + (size_t)ibase * 8192;
    const bf16_t* tm = (const bf16_t*)(ws + WS_TM) + ((size_t)dir * 4096 + ibase) * 4096;
    const bf16_t* at = (const bf16_t*)(ws + WS_AT) + ((size_t)dir * 4096 + ibase) * 4096;
    const float* vecs = (const float*)(ws + WS_VEC) + ((size_t)dir * 4096 + ibase) * 256;
    bf16_t* og = (bf16_t*)(ws + (dir ? WS_OB : WS_OF)) + (size_t)b * SEQ * 512 + h * 128 + es + fr;
    u32x4 pk[2], pq[2], pv[2], ptm, pa; f32x4 pvec = {0.f, 0.f, 0.f, 0.f};
#define DR_LOAD(nn) do { _Pragma("unroll") for (int u_ = 0; u_ < 2; ++u_) { const int p_ = tid + 512 * u_; \
        pk[u_] = *(const u32x4*)(kh + (size_t)(64 * (nn) + (p_ >> 4)) * 512 + 8 * (p_ & 15)); pq[u_] = *(const u32x4*)(qh + (size_t)(64 * (nn) + (p_ >> 4)) * 512 + 8 * (p_ & 15)); \
        pv[u_] = *(const u32x4*)(vt + (size_t)(nn) * 8192 + p_ * 8); } \
        ptm = *(const u32x4*)(tm + (size_t)(nn) * 4096 + tid * 8); pa = *(const u32x4*)(at + (size_t)(nn) * 4096 + tid * 8); \
        if (tid < 64) pvec = *(const f32x4*)(vecs + (size_t)(nn) * 256 + 4 * tid); } while (0)
#define DR_STORE() do { _Pragma("unroll") for (int u_ = 0; u_ < 2; ++u_) { const int p_ = tid + 512 * u_; const int j_ = p_ >> 4, q_ = p_ & 15; \
        *(LAS u32x4*)(lds + DR_K + swz128(j_, 8 * q_)) = pk[u_]; *(LAS u32x4*)(lds + DR_Q + swz128(j_, 8 * q_)) = pq[u_]; \
        *(LAS unsigned short*)(lds + DR_KT + swz64(8 * q_ + 0, j_)) = (unsigned short)(pk[u_].x & 0xffffu); *(LAS unsigned short*)(lds + DR_KT + swz64(8 * q_ + 1, j_)) = (unsigned short)(pk[u_].x >> 16); \
        *(LAS unsigned short*)(lds + DR_KT + swz64(8 * q_ + 2, j_)) = (unsigned short)(pk[u_].y & 0xffffu); *(LAS unsigned short*)(lds + DR_KT + swz64(8 * q_ + 3, j_)) = (unsigned short)(pk[u_].y >> 16); \
        *(LAS unsigned short*)(lds + DR_KT + swz64(8 * q_ + 4, j_)) = (unsigned short)(pk[u_].z & 0xffffu); *(LAS unsigned short*)(lds + DR_KT + swz64(8 * q_ + 5, j_)) = (unsigned short)(pk[u_].z >> 16); \
        *(LAS unsigned short*)(lds + DR_KT + swz64(8 * q_ + 6, j_)) = (unsigned short)(pk[u_].w & 0xffffu); *(LAS unsigned short*)(lds + DR_KT + swz64(8 * q_ + 7, j_)) = (unsigned short)(pk[u_].w >> 16); \
        *(LAS u32x4*)(lds + DR_VT + swz64(p_ >> 3, 8 * (p_ & 7))) = pv[u_]; } \
        *(LAS u32x4*)(lds + DR_T + swz64(tid >> 3, 8 * (tid & 7))) = ptm; *(LAS u32x4*)(lds + DR_A + swz64(tid >> 3, 8 * (tid & 7))) = pa; \
        if (tid < 64) *(LAS f32x4*)(lds + DR_VEC + 16 * tid) = pvec; } while (0)
    LBAR();
    DR_LOAD(dir ? 31 : 0);
    DR_STORE();
#pragma unroll
    for (int q = 0; q < 4; ++q) *(LAS u32x4*)(ST + lane * 64 + q * 16) = (u32x4){0u, 0u, 0u, 0u};
    f32x4 Sacc[8];
#pragma unroll
    for (int d = 0; d < 8; ++d) Sacc[d] = (f32x4){0.f, 0.f, 0.f, 0.f};
    LBAR();
#pragma unroll 1
    for (int cc = 0; cc < 32; ++cc) { const int n = dir ? (31 - cc) : cc;
        if (cc + 1 < 32) DR_LOAD(dir ? (30 - cc) : (cc + 1));
        bf16x8 sb[4];
#pragma unroll
        for (int ks = 0; ks < 4; ++ks) sb[ks] = *(const LAS bf16x8*)(ST + swz128(fr, 32 * ks + 8 * fq));
        f32x4 oacc[4];
#pragma unroll
        for (int it = 0; it < 4; ++it) { f32x4 ka = {0.f, 0.f, 0.f, 0.f}, qa = {0.f, 0.f, 0.f, 0.f};
#pragma unroll
            for (int ks = 0; ks < 4; ++ks) { const bf16x8 a1 = *(const LAS bf16x8*)(lds + DR_K + swz128(16 * it + fr, 32 * ks + 8 * fq)), a2 = *(const LAS bf16x8*)(lds + DR_Q + swz128(16 * it + fr, 32 * ks + 8 * fq));
                ka = MFMA16(a1, sb[ks], ka); qa = MFMA16(a2, sb[ks], qa); }
            const int i0 = 16 * it + 4 * fq; const f32x4 be = *(const LAS f32x4*)(VEC + i0), eg = *(const LAS f32x4*)(VEC + 64 + i0);
            const u32x2 vv = *(const LAS u32x2*)(lds + DR_VT + swz64(es + fr, i0));
            f32x4 rh; rh[0] = be[0] * (bflo(vv.x) - eg[0] * ka[0]); rh[1] = be[1] * (bfhi(vv.x) - eg[1] * ka[1]); rh[2] = be[2] * (bflo(vv.y) - eg[2] * ka[2]); rh[3] = be[3] * (bfhi(vv.y) - eg[3] * ka[3]);
            *(LAS u32x2*)(RV + swz64(fr, i0)) = pk4(rh);
            oacc[it] = qa * eg; }
        bf16x8 rb2[2];
#pragma unroll
        for (int ks = 0; ks < 2; ++ks) rb2[ks] = *(const LAS bf16x8*)(RV + swz64(fr, 32 * ks + 8 * fq));
        f32x4 vn[4];
#pragma unroll
        for (int it = 0; it < 4; ++it) { vn[it] = (f32x4){0.f, 0.f, 0.f, 0.f};
#pragma unroll
            for (int ks = 0; ks < 2; ++ks) { const bf16x8 a1 = *(const LAS bf16x8*)(lds + DR_T + swz64(16 * it + fr, 32 * ks + 8 * fq)); vn[it] = MFMA16(a1, rb2[ks], vn[it]); } }
#pragma unroll
        for (int it = 0; it < 4; ++it) { const int i0 = 16 * it + 4 * fq; const f32x4 ed = *(const LAS f32x4*)(VEC + 128 + i0);
            *(LAS u32x2*)(RV + swz64(fr, i0)) = pk4(vn[it]); *(LAS u32x2*)(VN2 + swz64(fr, i0)) = pk4(vn[it] * ed); }
        bf16x8 vb[2], vb2[2];
#pragma unroll
        for (int ks = 0; ks < 2; ++ks) { vb[ks] = *(const LAS bf16x8*)(RV + swz64(fr, 32 * ks + 8 * fq)); vb2[ks] = *(const LAS bf16x8*)(VN2 + swz64(fr, 32 * ks + 8 * fq)); }
#pragma unroll
        for (int it = 0; it < 4; ++it)
#pragma unroll
            for (int ks = 0; ks < 2; ++ks) { const bf16x8 a1 = *(const LAS bf16x8*)(lds + DR_A + swz64(16 * it + fr, 32 * ks + 8 * fq)); oacc[it] = MFMA16(a1, vb[ks], oacc[it]); }
        const float cdec = VEC[192];
#pragma unroll
        for (int dt = 0; dt < 8; ++dt) { Sacc[dt] = Sacc[dt] * cdec;
#pragma unroll
            for (int ks = 0; ks < 2; ++ks) { const bf16x8 a1 = *(const LAS bf16x8*)(lds + DR_KT + swz64(16 * dt + fr, 32 * ks + 8 * fq)); Sacc[dt] = MFMA16(a1, vb2[ks], Sacc[dt]); }
            *(LAS u32x2*)(ST + swz128(fr, 16 * dt + 4 * fq)) = pk4(Sacc[dt]); }
#pragma unroll
        for (int it = 0; it < 4; ++it)
#pragma unroll
            for (int jj = 0; jj < 4; ++jj) og[(size_t)(64 * n + 16 * it + 4 * fq + jj) * 512] = (bf16_t)(pk2(oacc[it][jj], 0.f) & 0xffffu);
        LBAR();
        if (cc + 1 < 32) DR_STORE();
        LBAR();
    }
#undef DR_LOAD
#undef DR_STORE
}

__device__ __forceinline__ void m2_rows(PT pt, int layer, int gw, int NGW, int lane) {
    asm volatile("" : "+v"(lane));
    unsigned char* ws = pws(pt);
    const bf16_t* of = (const bf16_t*)(ws + WS_OF); const bf16_t* ob = (const bf16_t*)(ws + WS_OB); const bf16_t* pz = (const bf16_t*)(ws + WS_PZ);
    const bf16_t* hf = (const bf16_t*)pout(pt); const bf16_t* hb = hf + (size_t)M_TOK * 512; const bf16_t* plg = (const bf16_t*)(ws + WS_PLG);
    bf16_t* amix = (bf16_t*)(ws + WS_AMIX);
    const float* dng = pin(pt, I_DNG) + layer * 128 + 8 * (lane & 15); const float* lng = pin(pt, I_LNG) + layer * 512 + 8 * lane;
    const f32x4 dg0 = *(const f32x4*)dng, dg1 = *(const f32x4*)(dng + 4), lg0 = *(const f32x4*)lng, lg1 = *(const f32x4*)(lng + 4);
    for (int m0 = gw; m0 < M_TOK; m0 += 2 * NGW) {
        u32x4 av[2], bv[2], zv[2], cv[2], dv[2], gv[2];
#pragma unroll
        for (int r = 0; r < 2; ++r) { const int m = m0 + r * NGW; if (m < M_TOK) { const size_t o = (size_t)m * 512 + 8 * lane;
            av[r] = *(const u32x4*)(of + o); bv[r] = *(const u32x4*)(ob + o); zv[r] = *(const u32x4*)(pz + o); cv[r] = *(const u32x4*)(hf + o); dv[r] = *(const u32x4*)(hb + o); gv[r] = *(const u32x4*)(plg + o); } }
#pragma unroll
        for (int r = 0; r < 2; ++r) { const int m = m0 + r * NGW; if (m < M_TOK) {
        const u32x4 a = av[r], b2 = bv[r], z = zv[r], c = cv[r], d = dv[r], g = gv[r];
        float v[8], y[8];
        v[0] = bflo(a.x) + bflo(b2.x); v[1] = bfhi(a.x) + bfhi(b2.x); v[2] = bflo(a.y) + bflo(b2.y); v[3] = bfhi(a.y) + bfhi(b2.y);
        v[4] = bflo(a.z) + bflo(b2.z); v[5] = bfhi(a.z) + bfhi(b2.z); v[6] = bflo(a.w) + bflo(b2.w); v[7] = bfhi(a.w) + bfhi(b2.w);
        float s1 = 0.f;
#pragma unroll
        for (int e = 0; e < 8; ++e) s1 += v[e] * v[e];
        s1 += __shfl_xor(s1, 1); s1 += __shfl_xor(s1, 2); s1 += __shfl_xor(s1, 4); s1 += __shfl_xor(s1, 8);
        const float r1 = rsqrtf(s1 * (1.0f / 128.0f) + EPS);
        float zz[8] = {bflo(z.x), bfhi(z.x), bflo(z.y), bfhi(z.y), bflo(z.z), bfhi(z.z), bflo(z.w), bfhi(z.w)};
        float gg[8] = {bflo(g.x), bfhi(g.x), bflo(g.y), bfhi(g.y), bflo(g.z), bfhi(g.z), bflo(g.w), bfhi(g.w)};
        float hh[8] = {bflo(c.x) + bflo(d.x), bfhi(c.x) + bfhi(d.x), bflo(c.y) + bflo(d.y), bfhi(c.y) + bfhi(d.y), bflo(c.z) + bflo(d.z), bfhi(c.z) + bfhi(d.z), bflo(c.w) + bflo(d.w), bfhi(c.w) + bfhi(d.w)};
        float s2 = 0.f;
#pragma unroll
        for (int e = 0; e < 8; ++e) { const float dgv = e < 4 ? dg0[e & 3] : dg1[e & 3]; v[e] = v[e] * r1 * dgv * (zz[e] * sigm(zz[e])); y[e] = gelu_t(gg[e]) * hh[e]; s2 += y[e] * y[e]; }
#pragma unroll
        for (int o2 = 1; o2 < 64; o2 <<= 1) s2 += __shfl_xor(s2, o2);
        const float r2 = rsqrtf(s2 * (1.0f / 512.0f) + EPS);
#pragma unroll
        for (int e = 0; e < 8; ++e) { const float lgv = e < 4 ? lg0[e & 3] : lg1[e & 3]; y[e] = y[e] * r2 * lgv; }
        u32x4 w1, w2; w1.x = pk2(v[0], v[1]); w1.y = pk2(v[2], v[3]); w1.z = pk2(v[4], v[5]); w1.w = pk2(v[6], v[7]);
        w2.x = pk2(y[0], y[1]); w2.y = pk2(y[2], y[3]); w2.z = pk2(y[4], y[5]); w2.w = pk2(y[6], y[7]);
        *(u32x4*)(amix + (size_t)m * 1024 + 8 * lane) = w1; *(u32x4*)(amix + (size_t)m * 1024 + 512 + 8 * lane) = w2; } }
    }
}

__device__ __forceinline__ void halo_pass(PT pt, int layer, int bx, int G, int wave, int lane) {
    asm volatile("" : "+v"(lane));
    unsigned char* ws = pws(pt);
    const bf16_t* rb = (const bf16_t*)(ws + WS_RB); const bf16_t* wf = (const bf16_t*)(ws + WS_WG) + (size_t)layer * 5632 * 1024;
    const float* ss = (const float*)(ws + WS_SSP) + (size_t)(3 * layer + 1) * M_TOK * 4;
    float* hT = (float*)(ws + WS_G); float* hB = hT + (size_t)256 * FF;
    const int fr = lane & 15, fq = lane >> 4;
    for (int L = wave * G + bx; L < 14 * 44; L += 8 * G) { const int rp = L / 44, cq = L % 44;
        const bf16_t* ap[2]; const bf16_t* bp[4];
#pragma unroll
        for (int r = 0; r < 2; ++r) { const int rho = 16 * (2 * rp + r) + fr, beta = rho >> 1, which = rho & 1; const int tt = (beta / 7) * 8 + (beta % 7) + 1; ap[r] = rb + (size_t)(256 * tt - 1 + which) * 1024 + 8 * fq; }
#pragma unroll
        for (int c = 0; c < 4; ++c) { const int ch = 64 * cq + 16 * c + fr; bp[c] = wf + (size_t)((ch >> 7) * 256 + (ch & 127)) * 1024 + 8 * fq; }
        f32x4 acc[2][4];
#pragma unroll
        for (int r = 0; r < 2; ++r)
#pragma unroll
            for (int c = 0; c < 4; ++c) acc[r][c] = (f32x4){0.f, 0.f, 0.f, 0.f};
#pragma unroll 1
        for (int kc = 0; kc < 8; ++kc) {
            bf16x8 av[2][4], bv[4][4];
#pragma unroll
            for (int k = 0; k < 4; ++k) {
#pragma unroll
                for (int r = 0; r < 2; ++r) av[r][k] = *(const bf16x8*)(ap[r] + 32 * (4 * kc + k));
#pragma unroll
                for (int c = 0; c < 4; ++c) bv[c][k] = *(const bf16x8*)(bp[c] + 32 * (4 * kc + k)); }
#pragma unroll
            for (int k = 0; k < 4; ++k)
#pragma unroll
                for (int r = 0; r < 2; ++r)
#pragma unroll
                    for (int c = 0; c < 4; ++c) acc[r][c] = MFMA16(av[r][k], bv[c][k], acc[r][c]); }
#pragma unroll
        for (int r = 0; r < 2; ++r)
#pragma unroll
            for (int j = 0; j < 4; ++j) { const int rho2 = 16 * (2 * rp + r) + 4 * fq + j, beta2 = rho2 >> 1, which2 = rho2 & 1; const int t2 = (beta2 / 7) * 8 + (beta2 % 7) + 1; const int row2 = 256 * t2 - 1 + which2;
                const float sc = rs_of(ss, row2); float* dst = which2 ? (hB + (size_t)(t2 - 1) * FF) : (hT + (size_t)t2 * FF);
#pragma unroll
                for (int c = 0; c < 4; ++c) dst[64 * cq + 16 * c + fr] = acc[r][c][j] * sc; }
    }
}

#define XB_TMO      128
#define XB_XCNT(j)  (256  + 64 * (j))
#define XB_XSUB(j)  (1280 + 64 * (j))
#define XB_XGEN(j)  (2304 + 64 * (j))
#define XB_TOP      3328
#define XB_TOPGEN   3392
#define XCD_BAR_WORDS 3456
#define XB_SPIN_CAP (1u << 18)

__device__ __forceinline__ unsigned xb_ld(unsigned* p)              { return __hip_atomic_load(p, __ATOMIC_RELAXED, __HIP_MEMORY_SCOPE_AGENT); }
__device__ __forceinline__ unsigned xb_add(unsigned* p, unsigned v) { return __hip_atomic_fetch_add(p, v, __ATOMIC_RELAXED, __HIP_MEMORY_SCOPE_AGENT); }
__device__ __forceinline__ unsigned xb_xcc_id() { return (unsigned)__builtin_amdgcn_s_getreg((3 << 11) | 20) & 0xFu; }
#define XB_SPIN(cond, bar) do { unsigned _sp = 0; while (cond) { __builtin_amdgcn_s_sleep(1); \
    if ((++_sp & 255u) == 0u) { if (xb_ld(&(bar)[XB_TMO])) break; if (_sp > XB_SPIN_CAP) { atomicAdd(&(bar)[XB_TMO], 1u); break; } } } } while (0)

struct XcdBarrier {
    unsigned* bar; unsigned x;
    volatile LAS unsigned* st;
};

__device__ __forceinline__ XcdBarrier xcd_barrier_post(unsigned* bar, volatile LAS unsigned* st) {
    XcdBarrier b; b.bar = bar; b.x = xb_xcc_id(); b.st = st;
    if (threadIdx.x == 0) (void)xb_add(&bar[XB_XCNT(b.x)], 1u);
    return b;
}
__device__ __forceinline__ void xcd_barrier_complete(unsigned* bar, unsigned x, unsigned& nloc, unsigned& nx) {
    const unsigned G = gridDim.x * gridDim.y * gridDim.z;
    unsigned sum, cnt, mine, sp = 0u;
    for (;;) {
        sum = 0u; cnt = 0u; mine = 0u;
#pragma unroll
        for (unsigned j = 0; j < 16; ++j) { const unsigned c = xb_ld(&bar[XB_XCNT(j)]); sum += c; cnt += (c > 0u) ? 1u : 0u; mine = (j == x) ? c : mine; }
        if (sum == G) break;
        __builtin_amdgcn_s_sleep(1);
        if ((++sp & 255u) == 0u) { if (xb_ld(&bar[XB_TMO])) break; if (sp > XB_SPIN_CAP) { atomicAdd(&bar[XB_TMO], 1u); break; } }
    }
    nloc = mine > 0u ? mine : 1u; nx = cnt > 0u ? cnt : 1u;
}

__device__ __forceinline__ void xcd_barrier(const XcdBarrier& b) {
    asm volatile("s_waitcnt vmcnt(0)" ::: "memory");
    __syncthreads();
    if (threadIdx.x == 0) {
        unsigned* bar = b.bar;
        __builtin_amdgcn_s_waitcnt(0);
        unsigned nloc = b.st[0], nx = b.st[1];
        if (nloc == 0u) { xcd_barrier_complete(bar, b.x, nloc, nx); b.st[0] = nloc; b.st[1] = nx; }
        const unsigned old = xb_add(&bar[XB_XSUB(b.x)], 1u);
        const unsigned gen = old / nloc;
        if (old + 1u == (gen + 1u) * nloc) {
            __builtin_amdgcn_fence(__ATOMIC_RELEASE, "agent");
            asm volatile("s_waitcnt vmcnt(0)" ::: "memory");
            const unsigned og = xb_add(&bar[XB_TOP], 1u);
            const unsigned tg = og / nx;
            if (og + 1u == (tg + 1u) * nx) xb_add(&bar[XB_TOPGEN], 1u);
            else XB_SPIN(xb_ld(&bar[XB_TOPGEN]) == tg, bar);
            __builtin_amdgcn_fence(__ATOMIC_ACQUIRE, "agent");
            xb_add(&bar[XB_XGEN(b.x)], 1u);
            asm volatile("s_waitcnt vmcnt(0)" ::: "memory");
        } else {
            XB_SPIN(xb_ld(&bar[XB_XGEN(b.x)]) == gen, bar);
            __builtin_amdgcn_fence(__ATOMIC_ACQUIRE, "agent");
            asm volatile("s_waitcnt vmcnt(0)" ::: "memory");
        }
    }
    __syncthreads();
}

#ifndef PHMASK
#define PHMASK 0xFFFF
#endif
#ifndef DUPMASK
#define DUPMASK 0
#endif
#define PH(k) _Pragma("unroll 1") for (int rep_ = 0; rep_ < ((((PHMASK >> (k)) & 1) ? 1 : 0) + (((DUPMASK >> (k)) & 1) ? 1 : 0)); ++rep_)
#define GRID_BAR() do { XcdBarrier b_; b_.bar = (unsigned*)pws(pt); b_.x = xb_xcc_id(); b_.st = (volatile LAS unsigned*)(lds + LDS_BYTES - 512); xcd_barrier(b_); } while (0)
#ifndef TMASK
#define TMASK 0
#endif
#define TS_BEGIN(k) do { if (((TMASK >> (k)) & 1) && bx == 0 && tid == 0) { const unsigned long long t_ = __builtin_amdgcn_s_memrealtime(); *(volatile LAS unsigned*)(lds + LDS_BYTES - 128) = (unsigned)t_; } } while (0)
#define TS_END(k) do { if (((TMASK >> (k)) & 1) && bx == 0 && tid == 0) { const unsigned t_ = (unsigned)__builtin_amdgcn_s_memrealtime(); volatile LAS unsigned* a_ = (volatile LAS unsigned*)(lds + LDS_BYTES - 128); a_[1] += t_ - a_[0]; } } while (0)
#ifndef STAG
#define STAG 0
#endif
#define STAGGER(step_10ns) do { if (STAG) { const unsigned sg_ = ((unsigned)bx >> 3) & 1u; if (sg_) { const unsigned long long t0_ = __builtin_amdgcn_s_memrealtime(); \
        while (__builtin_amdgcn_s_memrealtime() - t0_ < (unsigned long long)(sg_ * (step_10ns))) __builtin_amdgcn_s_sleep(16); } __syncthreads(); } } while (0)
#define RB_ ((bf16_t*)(pws(pt) + WS_RB))
#define RLO_ ((bf16_t*)pout(pt) + (size_t)M_TOK * 1024)
#define RLOF_ ((bf16_t*)(pws(pt) + WS_RLO))
#define RBC_ ((bf16_t*)(pws(pt) + WS_BIG + 128 * MiB))
#define SS_(k) ((float*)(pws(pt) + WS_SSP) + (size_t)(k) * M_TOK * 4)
__global__ void __launch_bounds__(512, 2) fwd_kernel(Params P) {
    extern __shared__ __attribute__((aligned(16))) unsigned char lds_raw[];
    LAS unsigned char* lds = (LAS unsigned char*)lds_raw;
    cg::grid_group grid = cg::this_grid();
    const int tid = threadIdx.x, lane = tid & 63, wave = __builtin_amdgcn_readfirstlane(tid >> 6);
    const int G = gridDim.x, bx = blockIdx.x; const int gw = bx * 8 + wave, NGW = G * 8;
    PT pt = (PT)(lds + LDS_BYTES - 256);
    volatile LAS unsigned* xst = (volatile LAS unsigned*)(lds + LDS_BYTES - 512);
    if (tid == 0) { xst[0] = 0u; xst[1] = 0u; if (TMASK) { ((volatile LAS unsigned*)(lds + LDS_BYTES - 128))[1] = 0u; }
#pragma unroll
        for (int i = 0; i < 28; ++i) { const unsigned long long v = (unsigned long long)P.in[i]; pt[2 * i] = (unsigned)v; pt[2 * i + 1] = (unsigned)(v >> 32); }
        { const unsigned long long v = (unsigned long long)P.out; pt[56] = (unsigned)v; pt[57] = (unsigned)(v >> 32); }
        { const unsigned long long v = (unsigned long long)P.ws; pt[58] = (unsigned)v; pt[59] = (unsigned)(v >> 32); }
    }
    __syncthreads();
    (void)xcd_barrier_post((unsigned*)P.ws, xst);

    TS_BEGIN(0);
    PH(0) prologue(pt, lds, gw, NGW, lane, wave);
    __syncthreads();
    grid.sync(); TS_END(0);

#pragma unroll 1
    for (int layer = 0; layer < NL; ++layer) {
        TS_BEGIN(1); PH(1) { pg8::Gemm g{RB_, (const bf16_t*)(pws(pt) + WS_WIN) + (size_t)layer * 3328 * 1024, M_TOK, 3328, 1024}; pg8::StaticOrder S; S.init(M_TOK, 3328, G, bx);
          EpiStore E{SS_(3 * layer), {(bf16_t*)(pws(pt) + WS_PQKV), (bf16_t*)(pws(pt) + WS_PLX), (bf16_t*)(pws(pt) + WS_PZ), (bf16_t*)(pws(pt) + WS_PLG)}, {1536, 512, 512, 512}, {0, 6, 8, 10}, (float*)(pws(pt) + WS_GATES), 12};
          pg8::gemm_phase<EpiStore, pg8::StaticOrder, true, true>(lds, g, S, E);
          int tl = tid; asm volatile("" : "+v"(tl));
          const f32x4* ps = (const f32x4*)(pin(pt, I_P) + (size_t)layer * M_TOK * PLE); u32x2* pd = (u32x2*)(pws(pt) + WS_PB);
          for (size_t i = (size_t)bx * 512 + tl; i < (size_t)M_TOK * PLE / 4; i += (size_t)G * 512) pd[i] = pk4(ps[i]);
          }
        GRID_BAR(); TS_END(1);
        TS_BEGIN(2); PH(2) for (int bi = bx; bi < 256; bi += G) lru_block(pt, lds, bi, layer, tid);
        PH(3) { __syncthreads();
          { int tl = tid; asm volatile("" : "+v"(tl)); const int hh = (bx >> 5) & 3; const float* cwg = pin(pt, I_DNCW) + (size_t)layer * 4 * 1536;
            for (int e = tl; e < 1536; e += 512) { const int mat = e >> 9, tap = (e >> 7) & 3, ch = e & 127; ((LAS float*)(lds + DP_CWL))[e] = cwg[tap * 1536 + mat * 512 + hh * 128 + ch]; } }
          for (int it = bx; it < 4096; it += G) dp_item(pt, lds, it, layer, tid, lane, wave); }
        GRID_BAR(); TS_END(2);
        TS_BEGIN(4); PH(4) for (int it = bx; it < 256; it += G) dr_item(pt, lds, it, tid, lane, wave);
        GRID_BAR(); TS_END(4);
        TS_BEGIN(6); PH(6) m2_rows(pt, layer, gw, NGW, lane);
        GRID_BAR(); TS_END(6);
        TS_BEGIN(7); PH(7) { STAGGER(3700); pg8::Gemm g{(const bf16_t*)(pws(pt) + WS_AMIX), (const bf16_t*)(pws(pt) + WS_WOUT) + (size_t)layer * DM * DM, M_TOK, 1024, 1024}; pg8::StaticOrder S; S.init(M_TOK, 1024, G, bx);
          EpiResid<0> E{nullptr, RB_, RLO_, RLO_, SS_(3 * layer + 1), nullptr, nullptr, nullptr, nullptr, (LAS float*)(lds + 131072)};
          pg8::gemm_phase<EpiResid<0>, pg8::StaticOrder, true, true>(lds, g, S, E); }
        GRID_BAR(); TS_END(7);
        TS_BEGIN(8); PH(8) halo_pass(pt, layer, bx, G, wave, lane);
        GRID_BAR(); TS_END(8);
        TS_BEGIN(9); PH(9) { pg8::Gemm g{RB_, (const bf16_t*)(pws(pt) + WS_WG) + (size_t)layer * 5632 * 1024, M_TOK, 5632, 1024}; pg8::StaticOrder S; S.init(M_TOK, 5632, G, bx);
          EpiGluF E{SS_(3 * layer + 1), (const float*)(pws(pt) + WS_G), (const float*)(pws(pt) + WS_G) + (size_t)256 * FF, pin(pt, I_FCW) + (size_t)layer * 3 * FF, pin(pt, I_FCB) + (size_t)layer * FF, (bf16_t*)(pws(pt) + WS_ACT), (LAS float*)(lds + 135168)};
          pg8::gemm_phase<EpiGluF, pg8::StaticOrder, true, true>(lds, g, S, E); }
        GRID_BAR(); TS_END(9);
        TS_BEGIN(10); PH(10) { STAGGER(4800); pg8::Gemm g{(const bf16_t*)(pws(pt) + WS_ACT), (const bf16_t*)(pws(pt) + WS_WD) + (size_t)layer * DM * FF, M_TOK, 1024, FF}; pg8::StaticOrder S; S.init(M_TOK, 1024, G, bx);
          EpiResid<0> E{nullptr, RB_, RLO_, RLO_, SS_(3 * layer + 2), nullptr, nullptr, nullptr, RBC_, (LAS float*)(lds + 131072)};
          pg8::gemm_phase<EpiResid<0>, pg8::StaticOrder, true, true>(lds, g, S, E); }
        __syncthreads();
        PH(11) { pg8::Gemm g{(const bf16_t*)(pws(pt) + WS_PB), (const bf16_t*)(pws(pt) + WS_WP) + (size_t)layer * DM * PLE, M_TOK, 1024, PLE}; pg8::StaticOrder S; S.init(M_TOK, 1024, G, bx);
          EpiStore E{nullptr, {(bf16_t*)(pws(pt) + WS_PP), nullptr, nullptr, nullptr}, {1024, 0, 0, 0}, {0, 99, 99, 99}, nullptr, 99};
          pg8::gemm_phase<EpiStore, pg8::StaticOrder, true, true>(lds, g, S, E); }
        GRID_BAR(); TS_END(10);
        TS_BEGIN(12); PH(12) { STAGGER(3000); pg8::Gemm g{RBC_, (const bf16_t*)(pws(pt) + WS_WPG) + (size_t)layer * DM * DM, M_TOK, 1024, 1024}; pg8::StaticOrder S; S.init(M_TOK, 1024, G, bx);
          EpiResid<1> E{nullptr, RB_, RLO_, layer == NL - 1 ? RLOF_ : RLO_, SS_(3 * layer + 3), SS_(3 * layer + 2), pin(pt, I_PBG) + (size_t)layer * DM, (const bf16_t*)(pws(pt) + WS_PP), nullptr, (LAS float*)(lds + 131072)};
          pg8::gemm_phase<EpiResid<1>, pg8::StaticOrder, true, true>(lds, g, S, E); }
        GRID_BAR(); TS_END(12);
    }
    TS_BEGIN(13);
    { int tlf = tid; asm volatile("" : "+v"(tlf)); const int lane = tlf & 63;
      const float* ssF = SS_(12); const f32x4* fg = (const f32x4*)pin(pt, I_FING) + lane; const bf16_t* hi_ = RB_; const bf16_t* lo_ = RLOF_; float* outp = pout(pt);
      for (int m = gw; m < M_TOK; m += NGW) { const float sc = rs_of(ssF, m); f32x4* xr = (f32x4*)(outp + (size_t)m * DM) + lane;
          const u32x2* hr = (const u32x2*)(hi_ + (size_t)m * DM) + lane; const u32x2* lr = (const u32x2*)(lo_ + (size_t)m * DM) + lane;
#pragma unroll
          for (int j = 0; j < 4; ++j) { const u32x2 h = hr[64 * j], l = lr[64 * j]; const f32x4 g = fg[64 * j];
              f32x4 v; v[0] = (bflo(h.x) + bflo(l.x)) * sc * g[0]; v[1] = (bfhi(h.x) + bfhi(l.x)) * sc * g[1]; v[2] = (bflo(h.y) + bflo(l.y)) * sc * g[2]; v[3] = (bfhi(h.y) + bfhi(l.y)) * sc * g[3];
              xr[64 * j] = v; } } }
    if (TMASK) { __syncthreads(); TS_END(13); if (bx == 0 && tid == 0) { const unsigned wait_ = ((volatile LAS unsigned*)(lds + LDS_BYTES - 128))[1]; const unsigned long long t0_ = __builtin_amdgcn_s_memrealtime(); while (__builtin_amdgcn_s_memrealtime() - t0_ < (unsigned long long)wait_) __builtin_amdgcn_s_sleep(8); } }
}

extern "C" void kernel_launch(void* const* d_in, const int* in_sizes, int n_in, void* d_out, int out_size, void* d_ws, size_t ws_size, hipStream_t stream) {
    static int grid = 0;
    if (grid == 0) {
        if (n_in != 28 || ws_size < WS_END) { fprintf(stderr, "kernel_launch: unexpected n_in %d or workspace %zu < %zu\n", n_in, ws_size, (size_t)WS_END); grid = -1; return; }
        int dev = 0, cus = 0, per_cu = 0;
        hipGetDevice(&dev); hipDeviceGetAttribute(&cus, hipDeviceAttributeMultiprocessorCount, dev);
        if (hipFuncSetAttribute((const void*)fwd_kernel, hipFuncAttributeMaxDynamicSharedMemorySize, LDS_BYTES) != hipSuccess) fprintf(stderr, "kernel_launch: hipFuncSetAttribute failed\n");
        if (hipOccupancyMaxActiveBlocksPerMultiprocessor(&per_cu, (const void*)fwd_kernel, 512, LDS_BYTES) != hipSuccess || per_cu < 1) { fprintf(stderr, "kernel_launch: occupancy query says %d\n", per_cu); per_cu = 1; }
        (void)hipGetLastError();
        grid = cus * per_cu; if (grid > 256) grid = 256;
    }
    if (grid < 0) return;
    if (hipMemsetAsync(d_ws, 0, 16384, stream) != hipSuccess) { fprintf(stderr, "kernel_launch: memset of the barrier words failed\n"); return; }
    Params p{};
    for (int i = 0; i < 28; ++i) p.in[i] = (const float*)d_in[i];
    p.out = (float*)d_out; p.ws = (unsigned char*)d_ws;
    void* args[] = {&p};
    hipError_t e = hipLaunchCooperativeKernel((const void*)fwd_kernel, dim3(grid), dim3(512), args, LDS_BYTES, stream);
    if (e != hipSuccess) fprintf(stderr, "cooperative launch failed: %s (grid %d)\n", hipGetErrorString(e), grid);
}
```

```cpp
#include <hip/hip_runtime.h>
#include <hip/hip_cooperative_groups.h>
#include <cstdio>
#include <cstdint>
namespace cg = cooperative_groups;

#define LAS __attribute__((address_space(3)))
typedef unsigned short bf16_t;
typedef short bf16x8 __attribute__((ext_vector_type(8)));
typedef short s16x4 __attribute__((ext_vector_type(4)));
typedef float f32x2 __attribute__((ext_vector_type(2)));
typedef float f32x4 __attribute__((ext_vector_type(4)));
typedef float f32x16 __attribute__((ext_vector_type(16)));
typedef unsigned u32x4 __attribute__((ext_vector_type(4)));
typedef unsigned u32x2 __attribute__((ext_vector_type(2)));
typedef __bf16 bfx2_t __attribute__((ext_vector_type(2)));

constexpr int M_TOK = 65536, DM = 1024, SEQ = 2048, NB = 32, NL = 4;
constexpr int FF = 2816, PLE = 256, INC = 3088;
constexpr float EPS = 1e-6f;

constexpr size_t MiB = 1u << 20;
constexpr size_t WS_SS = 0;
constexpr size_t WS_WIN = 4 * MiB;
constexpr size_t WS_WOUT = WS_WIN + 26 * MiB;
constexpr size_t WS_WG = WS_WOUT + 8 * MiB;
constexpr size_t WS_WU = WS_WG + 22 * MiB;
constexpr size_t WS_WD = WS_WU + 22 * MiB;
constexpr size_t WS_WPG = WS_WD + 22 * MiB;
constexpr size_t WS_WP = WS_WPG + 8 * MiB;
constexpr size_t WS_WAT = WS_WP + 2 * MiB;
constexpr size_t WS_GATES = WS_WAT + 1 * MiB;
constexpr size_t WS_VEC = WS_GATES + 4 * MiB;
constexpr size_t WS_PB = WS_VEC + 8 * MiB;
constexpr size_t WS_RB = WS_PB + 32 * MiB;
constexpr size_t WS_BIG = WS_RB + 128 * MiB;
constexpr size_t WS_PQKV = WS_BIG;
constexpr size_t WS_OF = WS_BIG, WS_OB = WS_BIG + 64 * MiB, WS_PZ = WS_BIG + 576 * MiB;
constexpr size_t WS_PLX = WS_BIG + 192 * MiB, WS_PLG = WS_BIG + 640 * MiB;
constexpr size_t WS_QH = WS_BIG + 256 * MiB, WS_KH = WS_BIG + 320 * MiB, WS_VT = WS_BIG + 384 * MiB;
constexpr size_t WS_TM = WS_BIG + 448 * MiB, WS_AT = WS_BIG + 512 * MiB;
constexpr size_t WS_RLO = WS_BIG + 576 * MiB;
constexpr size_t WS_AMIX = WS_BIG + 256 * MiB;
constexpr size_t WS_G = WS_BIG, WS_ACT = WS_BIG + 352 * MiB, WS_PP = WS_BIG;
constexpr size_t WS_SSP = WS_BIG + 704 * MiB;
constexpr size_t WS_END = WS_SSP + 13 * MiB;
constexpr int LDS_BYTES = 153600;

__device__ __forceinline__ unsigned pk2(float lo, float hi) { f32x2 v = {lo, hi}; bfx2_t b = __builtin_convertvector(v, bfx2_t); return __builtin_bit_cast(unsigned, b); }
__device__ __forceinline__ u32x2 pk4(f32x4 v) { u32x2 r; r.x = pk2(v[0], v[1]); r.y = pk2(v[2], v[3]); return r; }
__device__ __forceinline__ float bflo(unsigned w) { return __uint_as_float(w << 16); }
__device__ __forceinline__ float bfhi(unsigned w) { return __uint_as_float(w & 0xffff0000u); }
__device__ __forceinline__ float bf2f(unsigned short b) { return __uint_as_float((unsigned)b << 16); }
__device__ __forceinline__ float fexp(float x) { return __builtin_amdgcn_exp2f(x * 1.4426950408889634f); }
__device__ __forceinline__ float sigm(float x) { return __builtin_amdgcn_rcpf(1.0f + fexp(-x)); }
__device__ __forceinline__ float gelu_t(float x) { const float u = 1.5957691216057308f * (x + 0.044715f * x * x * x); return x * __builtin_amdgcn_rcpf(1.0f + fexp(-u)); }
__device__ __forceinline__ float softplus_f(float x) { return x > 20.f ? x : log1pf(expf(x)); }
__device__ __forceinline__ int swz128(int row, int col) { return row * 256 + ((((col >> 3) ^ (row & 15)) << 4) | ((col & 7) << 1)); }
__device__ __forceinline__ int swz64(int row, int col) { return row * 128 + ((((col >> 3) ^ (row & 7)) << 4) | ((col & 7) << 1)); }
__device__ __forceinline__ int crow(int r, int hi) { return (r & 3) + 8 * (r >> 2) + 4 * hi; }
#define MFMA16(a, b, c) __builtin_amdgcn_mfma_f32_16x16x32_bf16((a), (b), (c), 0, 0, 0)
#define MFMA32(a, b, c) __builtin_amdgcn_mfma_f32_32x32x16_bf16((a), (b), (c), 0, 0, 0)
typedef unsigned long long u64;
__device__ __forceinline__ float rs_of(const float* ss4, int row) { const f32x4 p = *(const f32x4*)(ss4 + (size_t)row * 4); return rsqrtf(((p[0] + p[1]) + (p[2] + p[3])) * (1.0f / 1024.0f) + EPS); }
#define LDS_FENCE() asm volatile("s_waitcnt lgkmcnt(0)" ::: "memory")

#define LBAR() do { asm volatile("s_waitcnt lgkmcnt(0)" ::: "memory"); __builtin_amdgcn_s_barrier(); asm volatile("" ::: "memory"); } while (0)

namespace pg8 {
#define PG8_LAS __attribute__((address_space(3)))
typedef unsigned short bf16_t;
typedef short bf16x8 __attribute__((ext_vector_type(8)));
typedef float f32x4 __attribute__((ext_vector_type(4)));
typedef unsigned u32x4 __attribute__((ext_vector_type(4)));
constexpr int BM = 256, BK = 64, HALF = 128, HTB = HALF * BK * 2  , STAGE_BYTES = 8 * HTB, NXCD = 8, WGM = 8;

__host__ __device__ __forceinline__ int lds_byte(int r, int c) { const int st = (r >> 4) * 2 + (c >> 5), rr = r & 15, cc = c & 31, ob = rr * 64 + cc * 2; return st * 1024 + (ob ^ (((ob >> 9) & 1) << 5)); }
__host__ __device__ __forceinline__ void stage_rc(int b, int& R, int& C) { const int st = b / 1024, sb = b % 1024, swz = sb ^ (((sb >> 9) & 1) << 5); R = (st >> 1) * 16 + swz / 64; C = (st & 1) * 32 + (swz % 64) / 2; }
__host__ __device__ __forceinline__ int perm32(int rho) { const int n = rho >> 4, i = rho & 15; return 8 * (i >> 2) + 4 * n + (i & 3); }

struct Unit { int pm, pn; };
struct Gemm { const bf16_t* A; const bf16_t* Bt; int M, N, K; };

struct StaticOrder {
    int nM, nN, nwg, G, c;
    __host__ __device__ void init(int M, int N, int G_, int c_) { nM = M / BM; nN = N / BM; nwg = nM * nN; G = G_; c = c_; }
    __host__ __device__ bool next(int i, Unit& u) const {
        const long L = (long)i * G + c; if (L >= nwg) return false;
        int wgid = (int)L; { const int q = nwg / NXCD, r = nwg % NXCD, xcd = wgid % NXCD, off = wgid / NXCD; wgid = (xcd < r ? xcd * (q + 1) : r * (q + 1) + (xcd - r) * q) + off; }
        const int nig = WGM * nN, gid = wgid / nig, fm = gid * WGM, gsz = (nM - fm) < WGM ? (nM - fm) : WGM;
        u.pm = fm + ((wgid % nig) % gsz); u.pn = (wgid % nig) / gsz; return true;
    }
    __device__ __forceinline__ void a_ready(const Unit&) const {}
    __device__ __forceinline__ void done(const Unit&) const {}
};

template <class Epi, class Sched, bool ALIGN_EPI = false, bool SP2 = false>
__device__ __forceinline__ void gemm_phase(PG8_LAS unsigned char* lds, const Gemm g, const Sched& S, const Epi& E) {
    int tid_ = threadIdx.x; asm volatile("" : "+v"(tid_));
    const int tid = tid_, wid = __builtin_amdgcn_readfirstlane(tid >> 6), lane = tid & 63, wr = wid >> 2, wc = wid & 3, fr = lane & 15, fq = lane >> 4;
    const int K = g.K, nt = K / BK;
    unsigned voffA[2], voffB[2];
#pragma unroll
    for (int i = 0; i < 2; ++i) { int R, C; stage_rc(tid * 16 + i * 8192, R, C); const int Rb = Epi::PERM ? ((R & ~31) + perm32(R & 31)) : R;
        voffA[i] = (unsigned)(R * K + C) * 2u; voffB[i] = (unsigned)(Rb * K + C) * 2u; }
    const size_t kstep = (size_t)(BK * 2);
    const size_t hstep = (size_t)HALF * K * 2;
    const size_t tstep = 2 * hstep;
    const unsigned ldsw = (unsigned)wid * 1024u;
    const int aoff = lds_byte(wr * 64 + fr, fq * 8), boff = lds_byte(wc * 32 + fr, fq * 8);
#define PG8_SA(b, h) (((b) * 2 + (h)) * HTB)
#define PG8_SB(b, h) ((4 + (b) * 2 + (h)) * HTB)
#define PG8_STAGE(bufoff, gbase, voff) do { _Pragma("unroll") for (int _i = 0; _i < 2; ++_i) \
        __builtin_amdgcn_global_load_lds((const unsigned*)((const char*)(gbase) + (voff)[_i]), (PG8_LAS unsigned*)(lds + (bufoff) + ldsw + _i * 8192), 16, 0, 0); } while (0)
#define PG8_LDA(dst, b, h) do { _Pragma("unroll") for (int m = 0; m < 4; ++m) _Pragma("unroll") for (int k = 0; k < 2; ++k) dst[m][k] = *(const PG8_LAS bf16x8*)(lds + PG8_SA(b, h) + aoff + m * 2048 + k * 1024); } while (0)
#define PG8_LDB(dst, b, h) do { _Pragma("unroll") for (int n = 0; n < 2; ++n) _Pragma("unroll") for (int k = 0; k < 2; ++k) dst[n][k] = *(const PG8_LAS bf16x8*)(lds + PG8_SB(b, h) + boff + n * 2048 + k * 1024); } while (0)
#define PG8_MMA(ai, bj, At, Bt) do { __builtin_amdgcn_s_setprio(1); _Pragma("unroll") for (int m = 0; m < 4; ++m) _Pragma("unroll") for (int n = 0; n < 2; ++n) _Pragma("unroll") for (int k = 0; k < 2; ++k) \
        acc[ai][bj][m][n] = __builtin_amdgcn_mfma_f32_16x16x32_bf16(Bt[n][k], At[m][k], acc[ai][bj][m][n], 0, 0, 0); __builtin_amdgcn_s_setprio(0); } while (0)
#define PG8_WAIT_V(n) asm volatile("s_waitcnt vmcnt(" #n ")" ::: "memory")
#define PG8_WAIT_L(n) asm volatile("s_waitcnt lgkmcnt(" #n ")" ::: "memory")
#define PG8_BAR __builtin_amdgcn_s_barrier()
#define PG8_SCHED __builtin_amdgcn_sched_barrier(0)
    Unit cur, nxt; int ui = 0;
    if (!S.next(0, cur)) return;
    f32x4 acc[2][2][4][2];
#pragma unroll
    for (int a = 0; a < 2; ++a)
#pragma unroll
        for (int b = 0; b < 2; ++b)
#pragma unroll
            for (int m = 0; m < 4; ++m)
#pragma unroll
                for (int n = 0; n < 2; ++n) acc[a][b][m][n] = (f32x4){0.f, 0.f, 0.f, 0.f};
    bf16x8 At[4][2], B0[2][2], B1[2][2];
    const char* cA = (const char*)g.A + (size_t)cur.pm * tstep; const char* cB = (const char*)g.Bt + (size_t)cur.pn * tstep;
    S.a_ready(cur);
    if constexpr (SP2) {
        PG8_STAGE(PG8_SB(0, 0), cB, voffB); PG8_STAGE(PG8_SB(0, 1), cB + hstep, voffB); PG8_STAGE(PG8_SA(0, 0), cA, voffA); PG8_STAGE(PG8_SA(0, 1), cA + hstep, voffA);
        if (wr == 1) PG8_BAR;
        PG8_WAIT_V(2); PG8_BAR;
        PG8_STAGE(PG8_SB(1, 0), cB + kstep, voffB); PG8_STAGE(PG8_SA(1, 0), cA + kstep, voffA); PG8_STAGE(PG8_SB(1, 1), cB + hstep + kstep, voffB);
        PG8_WAIT_V(6); PG8_BAR;
    } else {
        PG8_STAGE(PG8_SB(0, 0), cB, voffB); PG8_STAGE(PG8_SA(0, 0), cA, voffA); PG8_STAGE(PG8_SB(0, 1), cB + hstep, voffB); PG8_STAGE(PG8_SA(0, 1), cA + hstep, voffA);
        if (wr == 1) PG8_BAR;
        PG8_WAIT_V(4); PG8_BAR;
        PG8_STAGE(PG8_SB(1, 0), cB + kstep, voffB); PG8_STAGE(PG8_SA(1, 0), cA + kstep, voffA); PG8_STAGE(PG8_SB(1, 1), cB + hstep + kstep, voffB);
        PG8_WAIT_V(6); PG8_BAR;
    }
    for (;;) {
        const bool has_next = S.next(ui + 1, nxt);
        const char* nA = has_next ? (const char*)g.A + (size_t)nxt.pm * tstep : cA; const char* nB = has_next ? (const char*)g.Bt + (size_t)nxt.pn * tstep : cB;
        for (int t = 0; t < nt; t += 2) {
            const bool last = (t == nt - 2);
            const char* a1 = cA + (size_t)(t + 1) * kstep;
            const char* a2 = last ? nA : cA + (size_t)(t + 2) * kstep; const char* b2 = last ? nB : cB + (size_t)(t + 2) * kstep;
            const char* a3 = a2 + kstep; const char* b3 = b2 + kstep;
            if (last && has_next) S.a_ready(nxt);
            if constexpr (SP2) {
            PG8_LDB(B0, 0, 0); PG8_LDB(B1, 0, 1); PG8_SCHED; PG8_LDA(At, 0, 0); PG8_STAGE(PG8_SA(1, 1), a1 + hstep, voffA);
            PG8_WAIT_V(8); PG8_WAIT_L(0); PG8_BAR; PG8_MMA(0, 0, At, B0); PG8_MMA(0, 1, At, B1); PG8_BAR; PG8_SCHED;
            PG8_LDA(At, 0, 1); PG8_STAGE(PG8_SB(0, 0), b2, voffB); PG8_STAGE(PG8_SB(0, 1), b2 + hstep, voffB); PG8_STAGE(PG8_SA(0, 0), a2, voffA);
            PG8_WAIT_V(8); PG8_WAIT_L(0); PG8_BAR; PG8_MMA(1, 0, At, B0); PG8_MMA(1, 1, At, B1); PG8_BAR; PG8_SCHED;
            PG8_LDB(B0, 1, 0); PG8_LDB(B1, 1, 1); PG8_SCHED; PG8_LDA(At, 1, 0); PG8_STAGE(PG8_SA(0, 1), a2 + hstep, voffA);
            PG8_WAIT_V(8); PG8_WAIT_L(0); PG8_BAR; PG8_MMA(0, 0, At, B0); PG8_MMA(0, 1, At, B1); PG8_BAR; PG8_SCHED;
            PG8_LDA(At, 1, 1); PG8_STAGE(PG8_SB(1, 0), b3, voffB); PG8_STAGE(PG8_SB(1, 1), b3 + hstep, voffB); PG8_STAGE(PG8_SA(1, 0), a3, voffA);
            PG8_WAIT_V(8); PG8_WAIT_L(0); PG8_BAR; PG8_MMA(1, 0, At, B0); PG8_MMA(1, 1, At, B1); PG8_BAR; PG8_SCHED;
            } else {
            PG8_LDB(B0, 0, 0); PG8_SCHED; PG8_LDA(At, 0, 0); PG8_STAGE(PG8_SA(1, 1), a1 + hstep, voffA);
            PG8_WAIT_L(8); PG8_BAR; PG8_WAIT_L(0); PG8_MMA(0, 0, At, B0); PG8_BAR; PG8_SCHED;
            PG8_LDB(B1, 0, 1); PG8_STAGE(PG8_SB(0, 0), b2, voffB);
            PG8_BAR; PG8_WAIT_L(0); PG8_MMA(0, 1, At, B1); PG8_BAR;
            PG8_LDA(At, 0, 1); PG8_STAGE(PG8_SA(0, 0), a2, voffA);
            PG8_BAR; PG8_WAIT_L(0); PG8_MMA(1, 0, At, B0); PG8_BAR; PG8_SCHED;
            PG8_STAGE(PG8_SB(0, 1), b2 + hstep, voffB);
            PG8_WAIT_V(6); PG8_BAR; PG8_MMA(1, 1, At, B1); PG8_BAR;
            PG8_LDB(B0, 1, 0); PG8_SCHED; PG8_LDA(At, 1, 0); PG8_STAGE(PG8_SA(0, 1), a2 + hstep, voffA);
            PG8_WAIT_L(8); PG8_BAR; PG8_WAIT_L(0); PG8_MMA(0, 0, At, B0); PG8_BAR; PG8_SCHED;
            PG8_LDB(B1, 1, 1); PG8_STAGE(PG8_SB(1, 0), b3, voffB);
            PG8_BAR; PG8_WAIT_L(0); PG8_MMA(0, 1, At, B1); PG8_BAR;
            PG8_LDA(At, 1, 1); PG8_STAGE(PG8_SA(1, 0), a3, voffA);
            PG8_BAR; PG8_WAIT_L(0); PG8_MMA(1, 0, At, B0); PG8_BAR; PG8_SCHED;
            PG8_STAGE(PG8_SB(1, 1), b3 + hstep, voffB);
            PG8_WAIT_V(6); PG8_BAR; PG8_MMA(1, 1, At, B1); PG8_BAR;
            }
        }
        if constexpr (ALIGN_EPI) { if (wr == 0) PG8_BAR; }
        if constexpr (!Epi::AFTER_DRAIN) { E(acc, cur, wr, wc, fr, fq); S.done(cur); }
        if (!has_next) break;
#pragma unroll
        for (int a = 0; a < 2; ++a)
#pragma unroll
            for (int b = 0; b < 2; ++b)
#pragma unroll
                for (int m = 0; m < 4; ++m)
#pragma unroll
                    for (int n = 0; n < 2; ++n) acc[a][b][m][n] = (f32x4){0.f, 0.f, 0.f, 0.f};
        cur = nxt; cA = nA; cB = nB; ++ui;
        if constexpr (ALIGN_EPI) { if (wr == 1) PG8_BAR; }
    }
    PG8_WAIT_V(0);
    if constexpr (!ALIGN_EPI) { if (wr == 0) PG8_BAR; }
    PG8_BAR;
    if constexpr (Epi::AFTER_DRAIN) { E.fused(acc, cur, wr, wc, fr, fq, lds, wid, lane); S.done(cur); }
#undef PG8_SA
#undef PG8_SB
#undef PG8_STAGE
#undef PG8_LDA
#undef PG8_LDB
#undef PG8_MMA
#undef PG8_WAIT_V
#undef PG8_WAIT_L
#undef PG8_BAR
#undef PG8_SCHED
}
}

using pg8::Unit;
struct EpiStore {
    static constexpr bool PERM = true, AFTER_DRAIN = false;
    const float* ss; bf16_t* base[4]; int ld[4]; int ts[4]; float* gates; int t2;
    __device__ __forceinline__ void operator()(const f32x4 (&acc)[2][2][4][2], const Unit& u, int wr, int wc, int fr, int fq) const {
        const int row0 = u.pm * 256 + wr * 64 + fr; const int pn = u.pn;
        if (pn >= t2) {
            if (wc == 0 && fq < 2) {
#pragma unroll
                for (int ai = 0; ai < 2; ++ai)
#pragma unroll
                    for (int m = 0; m < 4; ++m) { const int row = row0 + ai * 128 + m * 16; const float s = ss ? rs_of(ss, row) : 1.f;
                        float* gp = gates + (size_t)row * 16 + 8 * fq; *(f32x4*)gp = acc[ai][0][m][0] * s; *(f32x4*)(gp + 4) = acc[ai][0][m][1] * s; }
            }
            return;
        }
        int k = 0; if (pn >= ts[1]) k = 1; if (pn >= ts[2]) k = 2; if (pn >= ts[3]) k = 3;
        bf16_t* bsel = base[0]; int ldsel = ld[0], t0 = ts[0];
        if (k == 1) { bsel = base[1]; ldsel = ld[1]; t0 = ts[1]; } else if (k == 2) { bsel = base[2]; ldsel = ld[2]; t0 = ts[2]; } else if (k == 3) { bsel = base[3]; ldsel = ld[3]; t0 = ts[3]; }
        const int col0 = (pn - t0) * 256 + wc * 32 + 8 * fq;
#pragma unroll
        for (int ai = 0; ai < 2; ++ai)
#pragma unroll
            for (int m = 0; m < 4; ++m) { const int row = row0 + ai * 128 + m * 16; const float s = ss ? rs_of(ss, row) : 1.f;
                bf16_t* rowp = bsel + (size_t)row * ldsel + col0;
#pragma unroll
                for (int bj = 0; bj < 2; ++bj) { const f32x4 v0 = acc[ai][bj][m][0] * s, v1 = acc[ai][bj][m][1] * s;
                    u32x4 w; w.x = pk2(v0[0], v0[1]); w.y = pk2(v0[2], v0[3]); w.z = pk2(v1[0], v1[1]); w.w = pk2(v1[2], v1[3]);
                    *(u32x4*)(rowp + bj * 128) = w; } }
    }
};

#ifndef RES_BM
#define RES_BM 4
#endif
#ifndef RES1_BM
#define RES1_BM 2
#endif
template <int MODE> struct EpiResid {
    static constexpr bool PERM = true, AFTER_DRAIN = false;
    const float* rin32; bf16_t* rb; const bf16_t* rlo; bf16_t* rlo_w; float* ss_out; const float* ss_in; const float* bias; const bf16_t* pp; bf16_t* rb2; LAS float* sl;
    __device__ __forceinline__ void ld_r(size_t off, f32x4& r0, f32x4& r1) const {
        if (rin32) { r0 = *(const f32x4*)(rin32 + off); r1 = *(const f32x4*)(rin32 + off + 4); }
        else { const u32x4 h = *(const u32x4*)(rb + off), l = *(const u32x4*)(rlo + off);
            r0[0] = bflo(h.x) + bflo(l.x); r0[1] = bfhi(h.x) + bfhi(l.x); r0[2] = bflo(h.y) + bflo(l.y); r0[3] = bfhi(h.y) + bfhi(l.y);
            r1[0] = bflo(h.z) + bflo(l.z); r1[1] = bfhi(h.z) + bfhi(l.z); r1[2] = bflo(h.w) + bflo(l.w); r1[3] = bfhi(h.w) + bfhi(l.w); }
    }
    __device__ __forceinline__ float st_r(size_t off, const f32x4& r0, const f32x4& r1) const {
        u32x4 w; w.x = pk2(r0[0], r0[1]); w.y = pk2(r0[2], r0[3]); w.z = pk2(r1[0], r1[1]); w.w = pk2(r1[2], r1[3]);
        u32x4 l; l.x = pk2(r0[0] - bflo(w.x), r0[1] - bfhi(w.x)); l.y = pk2(r0[2] - bflo(w.y), r0[3] - bfhi(w.y)); l.z = pk2(r1[0] - bflo(w.z), r1[1] - bfhi(w.z)); l.w = pk2(r1[2] - bflo(w.w), r1[3] - bfhi(w.w));
        *(u32x4*)(rb + off) = w; *(u32x4*)(rlo_w + off) = l; if (rb2) *(u32x4*)(rb2 + off) = w;
        return (r0[0] * r0[0] + r0[1] * r0[1]) + (r0[2] * r0[2] + r0[3] * r0[3]) + (r1[0] * r1[0] + r1[1] * r1[1]) + (r1[2] * r1[2] + r1[3] * r1[3]);
    }
    __device__ __forceinline__ void operator()(const f32x4 (&acc)[2][2][4][2], const Unit& u, int wr, int wc, int fr, int fq) const {
        run<false>(acc, u, wr, wc, fr, fq);
    }
    template <bool F32IN> __device__ __forceinline__ void run(const f32x4 (&acc)[2][2][4][2], const Unit& u, int wr, int wc, int fr, int fq) const {
        const int row0 = u.pm * 256 + wr * 64 + fr; const int col0 = u.pn * 256 + wc * 32 + 8 * fq;
        float sqa[2][4] = {{0.f, 0.f, 0.f, 0.f}, {0.f, 0.f, 0.f, 0.f}}; float sina[2][4]; f32x4 bia[2][2];
#pragma unroll
        for (int ai = 0; ai < 2; ++ai)
#pragma unroll
            for (int m = 0; m < 4; ++m) sina[ai][m] = (MODE == 1) ? rs_of(ss_in, row0 + ai * 128 + m * 16) : 1.f;
#pragma unroll
        for (int bj = 0; bj < 2; ++bj) { bia[bj][0] = (f32x4){0.f, 0.f, 0.f, 0.f}; bia[bj][1] = (f32x4){0.f, 0.f, 0.f, 0.f};
            if (MODE == 1) { bia[bj][0] = *(const f32x4*)(bias + col0 + bj * 128); bia[bj][1] = *(const f32x4*)(bias + col0 + bj * 128 + 4); } }
        constexpr int RPB = (MODE == 1) ? 1 : 2;
        constexpr int NBAT = 16 / RPB;
        u32x4 ph[2][RPB], pl[2][RPB], pw[2][RPB];
#define RES_AI(b_) ((b_) / (8 / RPB))
#define RES_BJ(b_) (((b_) / (4 / RPB)) & 1)
#define RES_MH(b_) (((b_) % (4 / RPB)) * RPB)
#define RES_OFF(b_, m_) ((size_t)(row0 + RES_AI(b_) * 128 + (RES_MH(b_) + (m_)) * 16) * 1024 + col0 + RES_BJ(b_) * 128)
#define RES_LOAD(b_, buf_) do { _Pragma("unroll") for (int m_ = 0; m_ < RPB; ++m_) { const size_t off_ = RES_OFF(b_, m_); ph[buf_][m_] = *(const u32x4*)(rb + off_); pl[buf_][m_] = *(const u32x4*)(rlo + off_); \
            if (MODE == 1) pw[buf_][m_] = *(const u32x4*)(pp + off_); } } while (0)
        __builtin_amdgcn_sched_barrier(0);
        RES_LOAD(0, 0);
        __builtin_amdgcn_sched_barrier(0);
#pragma unroll
        for (int b = 0; b < NBAT; ++b) { const int buf = b & 1; const int ai = RES_AI(b), bj = RES_BJ(b), mh = RES_MH(b);
            if (b + 1 < NBAT) { RES_LOAD(b + 1, buf ^ 1); }
            __builtin_amdgcn_sched_barrier(0);
            const f32x4 b0 = bia[bj][0], b1 = bia[bj][1];
#pragma unroll
            for (int m = 0; m < RPB; ++m) { const size_t off = RES_OFF(b, m); const float si = sina[ai][mh + m]; const u32x4 h = ph[buf][m], l = pl[buf][m];
                f32x4 p0, p1;
                p0[0] = bflo(h.x) + bflo(l.x); p0[1] = bfhi(h.x) + bfhi(l.x); p0[2] = bflo(h.y) + bflo(l.y); p0[3] = bfhi(h.y) + bfhi(l.y);
                p1[0] = bflo(h.z) + bflo(l.z); p1[1] = bfhi(h.z) + bfhi(l.z); p1[2] = bflo(h.w) + bflo(l.w); p1[3] = bfhi(h.w) + bfhi(l.w);
                f32x4 a0 = acc[ai][bj][mh + m][0], a1 = acc[ai][bj][mh + m][1];
                if (MODE == 1) { const u32x4 w = pw[buf][m];
                    a0[0] = sigm(a0[0] * si + b0[0]) * bflo(w.x); a0[1] = sigm(a0[1] * si + b0[1]) * bfhi(w.x);
                    a0[2] = sigm(a0[2] * si + b0[2]) * bflo(w.y); a0[3] = sigm(a0[3] * si + b0[3]) * bfhi(w.y);
                    a1[0] = sigm(a1[0] * si + b1[0]) * bflo(w.z); a1[1] = sigm(a1[1] * si + b1[1]) * bfhi(w.z);
                    a1[2] = sigm(a1[2] * si + b1[2]) * bflo(w.w); a1[3] = sigm(a1[3] * si + b1[3]) * bfhi(w.w); }
                const f32x4 r0 = p0 + a0, r1 = p1 + a1;
                sqa[ai][mh + m] += st_r(off, r0, r1); }
            __builtin_amdgcn_sched_barrier(0);
        }
#undef RES_AI
#undef RES_BJ
#undef RES_MH
#undef RES_LOAD
#undef RES_OFF
#pragma unroll
        for (int ai = 0; ai < 2; ++ai)
#pragma unroll
            for (int m = 0; m < 4; ++m) { float q = sqa[ai][m]; q += __shfl_xor(q, 16); q += __shfl_xor(q, 32);
                if (fq == 0) sl[(ai * 128 + wr * 64 + m * 16 + fr) * 4 + wc] = q; }
        asm volatile("s_waitcnt lgkmcnt(0)" ::: "memory"); __builtin_amdgcn_s_barrier(); asm volatile("" ::: "memory");
        if (fq == 0) {
#pragma unroll
            for (int ai = 0; ai < 2; ++ai) { const int r = ai * 128 + wr * 64 + wc * 16 + fr; const f32x4 p = *(const LAS f32x4*)(sl + r * 4);
                ss_out[(size_t)(u.pm * 256 + r) * 4 + u.pn] = (p[0] + p[1]) + (p[2] + p[3]); } }
    }
};

#ifndef GLU_BM
#define GLU_BM 2
#endif
struct EpiGlu {
    static constexpr bool PERM = true, AFTER_DRAIN = false;
    const float* ss; const bf16_t* G; const float* cw; const float* cb; bf16_t* act;
    __device__ __forceinline__ void operator()(const f32x4 (&acc)[2][2][4][2], const Unit& u, int wr, int wc, int fr, int fq) const {
        const int row0 = u.pm * 256 + wr * 64 + fr; const int col0 = u.pn * 256 + wc * 32 + 8 * fq;
#pragma unroll
        for (int bj = 0; bj < 2; ++bj) { const int c = col0 + bj * 128;
            const f32x4 w0a = *(const f32x4*)(cw + c), w0b = *(const f32x4*)(cw + c + 4), w1a = *(const f32x4*)(cw + FF + c), w1b = *(const f32x4*)(cw + FF + c + 4);
            const f32x4 w2a = *(const f32x4*)(cw + 2 * FF + c), w2b = *(const f32x4*)(cw + 2 * FF + c + 4), bba = *(const f32x4*)(cb + c), bbb = *(const f32x4*)(cb + c + 4);
#pragma unroll
            for (int ai = 0; ai < 2; ++ai)
#pragma unroll
            for (int mh = 0; mh < 4; mh += GLU_BM) {
                u32x4 gmv[GLU_BM], glv[GLU_BM], gnv[GLU_BM]; float sv[GLU_BM];
#pragma unroll
                for (int m = 0; m < GLU_BM; ++m) { const int row = row0 + ai * 128 + (mh + m) * 16; const int t = row & (SEQ - 1); const bf16_t* gp = G + (size_t)row * FF + c;
                    gmv[m] = *(const u32x4*)gp; glv[m] = (u32x4){0u, 0u, 0u, 0u}; gnv[m] = (u32x4){0u, 0u, 0u, 0u};
                    if (t > 0) glv[m] = *(const u32x4*)(gp - FF);
                    if (t < SEQ - 1) gnv[m] = *(const u32x4*)(gp + FF);
                    sv[m] = rs_of(ss, row); }
#pragma unroll
                for (int m = 0; m < GLU_BM; ++m) { const int row = row0 + ai * 128 + (mh + m) * 16; const float s = sv[m]; const u32x4 gm = gmv[m], gl = glv[m], gn = gnv[m];
                    f32x4 ga, gb;
                    ga[0] = w0a[0] * bflo(gl.x) + w1a[0] * bflo(gm.x) + w2a[0] * bflo(gn.x) + bba[0];
                    ga[1] = w0a[1] * bfhi(gl.x) + w1a[1] * bfhi(gm.x) + w2a[1] * bfhi(gn.x) + bba[1];
                    ga[2] = w0a[2] * bflo(gl.y) + w1a[2] * bflo(gm.y) + w2a[2] * bflo(gn.y) + bba[2];
                    ga[3] = w0a[3] * bfhi(gl.y) + w1a[3] * bfhi(gm.y) + w2a[3] * bfhi(gn.y) + bba[3];
                    gb[0] = w0b[0] * bflo(gl.z) + w1b[0] * bflo(gm.z) + w2b[0] * bflo(gn.z) + bbb[0];
                    gb[1] = w0b[1] * bfhi(gl.z) + w1b[1] * bfhi(gm.z) + w2b[1] * bfhi(gn.z) + bbb[1];
                    gb[2] = w0b[2] * bflo(gl.w) + w1b[2] * bflo(gm.w) + w2b[2] * bflo(gn.w) + bbb[2];
                    gb[3] = w0b[3] * bfhi(gl.w) + w1b[3] * bfhi(gm.w) + w2b[3] * bfhi(gn.w) + bbb[3];
                    const f32x4 a0 = acc[ai][bj][mh + m][0] * s, a1 = acc[ai][bj][mh + m][1] * s;
                    u32x4 w; w.x = pk2(gelu_t(ga[0]) * a0[0], gelu_t(ga[1]) * a0[1]); w.y = pk2(gelu_t(ga[2]) * a0[2], gelu_t(ga[3]) * a0[3]);
                    w.z = pk2(gelu_t(gb[0]) * a1[0], gelu_t(gb[1]) * a1[1]); w.w = pk2(gelu_t(gb[2]) * a1[2], gelu_t(gb[3]) * a1[3]);
                    *(u32x4*)(act + (size_t)row * FF + c) = w; } } }
    }
};

struct EpiGluF {
    static constexpr bool PERM = true, AFTER_DRAIN = false;
    const float* ss; float* sg; float* su; const float* cw; const float* cb; bf16_t* act; LAS float* ex;
    __device__ __forceinline__ void operator()(const f32x4 (&acc)[2][2][4][2], const Unit& u, int wr, int wc, int fr, int fq) const {
        const int row0 = u.pm * 256 + wr * 64 + fr; const int chl = wc * 32 + 8 * fq; const int chg = u.pn * 128 + chl;
        float rsm[2][4];
#pragma unroll
        for (int ai = 0; ai < 2; ++ai)
#pragma unroll
            for (int m = 0; m < 4; ++m) rsm[ai][m] = rs_of(ss, row0 + ai * 128 + m * 16);
        if (fr == 0 || fr == 15) {
#pragma unroll
            for (int ai = 0; ai < 2; ++ai)
#pragma unroll
                for (int m = 0; m < 4; ++m) { const int rgi = ai * 8 + wr * 4 + m; LAS float* e = ex + (2 * rgi + (fr == 15 ? 1 : 0)) * 128 + chl;
                    *(LAS f32x4*)e = acc[ai][0][m][0] * rsm[ai][m]; *(LAS f32x4*)(e + 4) = acc[ai][0][m][1] * rsm[ai][m]; } }
        asm volatile("s_waitcnt lgkmcnt(0)" ::: "memory"); __builtin_amdgcn_s_barrier(); asm volatile("" ::: "memory");
#pragma unroll
        for (int ai = 0; ai < 2; ++ai)
#pragma unroll
            for (int m = 0; m < 4; ++m) { const int row = row0 + ai * 128 + m * 16; const int rgi = ai * 8 + wr * 4 + m;
                int cq = chg; asm volatile("" : "+v"(cq));
                const f32x4 w0a = *(const f32x4*)(cw + cq), w0b = *(const f32x4*)(cw + cq + 4), w1a = *(const f32x4*)(cw + FF + cq), w1b = *(const f32x4*)(cw + FF + cq + 4);
                const f32x4 w2a = *(const f32x4*)(cw + 2 * FF + cq), w2b = *(const f32x4*)(cw + 2 * FF + cq + 4), bba = *(const f32x4*)(cb + cq), bbb = *(const f32x4*)(cb + cq + 4);
                const float sm = rsm[ai][m]; const float su = __shfl_up(sm, 1, 16), sd = __shfl_down(sm, 1, 16);
                f32x4 gm0 = acc[ai][0][m][0] * sm, gm1 = acc[ai][0][m][1] * sm, gu0, gu1, gd0, gd1;
#pragma unroll
                for (int j = 0; j < 4; ++j) { gu0[j] = __shfl_up(acc[ai][0][m][0][j], 1, 16) * su; gu1[j] = __shfl_up(acc[ai][0][m][1][j], 1, 16) * su;
                    gd0[j] = __shfl_down(acc[ai][0][m][0][j], 1, 16) * sd; gd1[j] = __shfl_down(acc[ai][0][m][1][j], 1, 16) * sd; }
                if (fr == 0) {
                    if (rgi > 0) { const LAS float* e = ex + (2 * (rgi - 1) + 1) * 128 + chl; gu0 = *(const LAS f32x4*)e; gu1 = *(const LAS f32x4*)(e + 4); } }
                if (fr == 15) {
                    if (rgi < 15) { const LAS float* e = ex + (2 * (rgi + 1)) * 128 + chl; gd0 = *(const LAS f32x4*)e; gd1 = *(const LAS f32x4*)(e + 4); } }
                const f32x4 ga = w0a * gu0 + w1a * gm0 + w2a * gd0 + bba, gb = w0b * gu1 + w1b * gm1 + w2b * gd1 + bbb;
                const f32x4 a0 = acc[ai][1][m][0] * sm, a1 = acc[ai][1][m][1] * sm;
                u32x4 w; w.x = pk2(gelu_t(ga[0]) * a0[0], gelu_t(ga[1]) * a0[1]); w.y = pk2(gelu_t(ga[2]) * a0[2], gelu_t(ga[3]) * a0[3]);
                w.z = pk2(gelu_t(gb[0]) * a1[0], gelu_t(gb[1]) * a1[1]); w.w = pk2(gelu_t(gb[2]) * a1[2], gelu_t(gb[3]) * a1[3]);
                const bool first = (rgi == 0 && fr == 0), last = (rgi == 15 && fr == 15);
                if (!(first || last)) *(u32x4*)(act + (size_t)row * FF + chg) = w;
                if (rgi == 0 && fr <= 1) { float* d = sg + ((size_t)u.pm * 4 + fr) * FF + chg; *(f32x4*)d = gm0; *(f32x4*)(d + 4) = gm1; }
                if (rgi == 15 && fr >= 14) { float* d = sg + ((size_t)u.pm * 4 + (fr - 12)) * FF + chg; *(f32x4*)d = gm0; *(f32x4*)(d + 4) = gm1; }
                if (first || last) { float* d = this->su + ((size_t)u.pm * 2 + (last ? 1 : 0)) * FF + chg; *(f32x4*)d = a0; *(f32x4*)(d + 4) = a1; } }
    }
};

struct Params { const float* in[28]; float* out; unsigned char* ws; };
typedef LAS unsigned* PT;
__device__ __forceinline__ const float* pin(PT t0, int k) { unsigned ta = (unsigned)(size_t)t0; asm volatile("" : "+s"(ta)); const PT t = (PT)(size_t)ta;
    const unsigned lo = __builtin_amdgcn_readfirstlane(t[2 * k]), hi = __builtin_amdgcn_readfirstlane(t[2 * k + 1]); return (const float*)(__attribute__((address_space(1))) const float*)(((unsigned long long)hi << 32) | lo); }
__device__ __forceinline__ float* pout(PT t) { return (float*)pin(t, 28); }
__device__ __forceinline__ unsigned char* pws(PT t) { return (unsigned char*)pin(t, 29); }
enum { I_X = 0, I_P, I_N1G, I_WIN, I_DNCW, I_ALOG, I_DTB, I_DNG, I_LCW, I_LCB, I_LWA, I_LBA, I_LWX, I_LBX, I_LAM, I_LNG, I_WOUT, I_N2G, I_FWG, I_FWU, I_FCW, I_FCB, I_FWD, I_PNG, I_PWG, I_PBG, I_PWP, I_FING };

template <class RM>
__device__ __forceinline__ void tr_item(const float* W, int K, int N, bf16_t* WT, int ldt, const float* gk, const RM& rm, LAS float* scr, int item, int lane) {
    const int nblk = (N + 31) >> 5, kb = item / nblk, nb = item % nblk, k0 = 64 * kb, n0 = 32 * nb;
#pragma unroll 8
    for (int i = 0; i < 32; ++i) { const int kk = 2 * i + (lane >> 5), n = n0 + (lane & 31);
        float v = (n < N) ? W[(size_t)(k0 + kk) * N + n] : 0.f; if (gk) v *= gk[k0 + kk];
        scr[kk * 33 + (lane & 31)] = v; }
    LDS_FENCE();
    const int c = lane & 7;
#pragma unroll
    for (int j = 0; j < 4; ++j) { const int nl = (lane >> 3) + 8 * j, n = n0 + nl; const LAS float* s = scr + (8 * c) * 33 + nl;
        u32x4 o; o.x = pk2(s[0 * 33], s[1 * 33]); o.y = pk2(s[2 * 33], s[3 * 33]); o.z = pk2(s[4 * 33], s[5 * 33]); o.w = pk2(s[6 * 33], s[7 * 33]);
        const int dst = (n < N) ? rm(n) : -1;
        if (dst >= 0) *(u32x4*)(WT + (size_t)dst * ldt + k0 + 8 * c) = o; }
    LDS_FENCE();
}
struct RmId { __device__ __forceinline__ int operator()(int n) const { return n; } };
struct RmGU { int off; __device__ __forceinline__ int operator()(int n) const { return (n >> 7) * 256 + off + (n & 127); } };
struct RmIn { __device__ __forceinline__ int operator()(int n) const {
    if (n < 1536) return n;
    if (n < 2048) return 2048 + (n - 1536);
    if (n < 2064) return 3072 + (n - 2048);
    if (n < 2576) return 1536 + (n - 2064);
    return 2560 + (n - 2576);
} };

__device__ __forceinline__ void prologue(PT pt, LAS unsigned char* lds, int gw, int NGW, int lane, int wave) {
    asm volatile("" : "+v"(lane));
    unsigned char* ws = pws(pt);
    for (int l = 0; l < NL; ++l) { u32x4* z = (u32x4*)((bf16_t*)(ws + WS_WIN) + ((size_t)l * 3328 + 3088) * 1024); const int n4 = 240 * 1024 / 8;
        for (int i = gw * 64 + lane; i < n4; i += NGW * 64) z[i] = (u32x4){0u, 0u, 0u, 0u}; }
    LAS float* scr = (LAS float*)(lds + wave * 16384);
    constexpr int I_IN = 16 * 97, I_OUT = 16 * 32, I_G = 16 * 88, I_D = 44 * 32, I_PG = 16 * 32, I_PP = 4 * 32, I_LA = 32;
    constexpr int PER_L = I_IN + I_OUT + 2 * I_G + I_D + I_PG + I_PP + 2 * I_LA;
    for (int it = gw; it < NL * PER_L; it += NGW) {
        const int l = it / PER_L; int r = it % PER_L;
        if (r < I_IN) { tr_item(pin(pt, I_WIN) + (size_t)l * DM * INC, DM, INC, (bf16_t*)(ws + WS_WIN) + (size_t)l * 3328 * 1024, 1024, pin(pt, I_N1G) + l * DM, RmIn(), scr, r, lane); continue; } r -= I_IN;
        if (r < I_OUT) { tr_item(pin(pt, I_WOUT) + (size_t)l * DM * DM, DM, DM, (bf16_t*)(ws + WS_WOUT) + (size_t)l * DM * DM, 1024, nullptr, RmId(), scr, r, lane); continue; } r -= I_OUT;
        if (r < I_G) { tr_item(pin(pt, I_FWG) + (size_t)l * DM * FF, DM, FF, (bf16_t*)(ws + WS_WG) + (size_t)l * 5632 * 1024, 1024, pin(pt, I_N2G) + l * DM, RmGU{0}, scr, r, lane); continue; } r -= I_G;
        if (r < I_G) { tr_item(pin(pt, I_FWU) + (size_t)l * DM * FF, DM, FF, (bf16_t*)(ws + WS_WG) + (size_t)l * 5632 * 1024, 1024, pin(pt, I_N2G) + l * DM, RmGU{128}, scr, r, lane); continue; } r -= I_G;
        if (r < I_D) { tr_item(pin(pt, I_FWD) + (size_t)l * FF * DM, FF, DM, (bf16_t*)(ws + WS_WD) + (size_t)l * DM * FF, FF, nullptr, RmId(), scr, r, lane); continue; } r -= I_D;
        if (r < I_PG) { tr_item(pin(pt, I_PWG) + (size_t)l * DM * DM, DM, DM, (bf16_t*)(ws + WS_WPG) + (size_t)l * DM * DM, 1024, pin(pt, I_PNG) + l * DM, RmId(), scr, r, lane); continue; } r -= I_PG;
        if (r < I_PP) { tr_item(pin(pt, I_PWP) + (size_t)l * PLE * DM, PLE, DM, (bf16_t*)(ws + WS_WP) + (size_t)l * DM * PLE, PLE, nullptr, RmId(), scr, r, lane); continue; } r -= I_PP;
        { const int gate = r / I_LA; r %= I_LA; const int mat = r >> 1, sub = r & 1;
          const float* src = pin(pt, gate ? I_LWX : I_LWA) + ((size_t)l * 16 + mat) * 4096;
          bf16_t* dst = (bf16_t*)(ws + WS_WAT) + (((size_t)l * 16 + mat) * 2 + gate) * 4096;
          tr_item(src, 64, 64, dst, 64, nullptr, RmId(), scr, sub, lane); }
    }
    const float* x = pin(pt, I_X); bf16_t* rb = (bf16_t*)(ws + WS_RB); float* ss0 = (float*)(ws + WS_SSP); bf16_t* rl = (bf16_t*)pout(pt) + (size_t)M_TOK * 1024;
    for (int m = gw; m < M_TOK; m += NGW) { const f32x4* xr = (const f32x4*)(x + (size_t)m * DM) + lane; u32x2* o = (u32x2*)(rb + (size_t)m * DM) + lane; u32x2* ol = (u32x2*)(rl + (size_t)m * DM) + lane; float s = 0.f;
#pragma unroll
        for (int j = 0; j < 4; ++j) { const f32x4 v = xr[64 * j]; s += (v[0] * v[0] + v[1] * v[1]) + (v[2] * v[2] + v[3] * v[3]); const u32x2 hw = pk4(v); o[64 * j] = hw;
            ol[64 * j] = pk4((f32x4){v[0] - bflo(hw.x), v[1] - bfhi(hw.x), v[2] - bflo(hw.y), v[3] - bfhi(hw.y)}); }
#pragma unroll
        for (int o2 = 1; o2 < 64; o2 <<= 1) s += __shfl_xor(s, o2);
        if (lane < 4) ss0[(size_t)m * 4 + lane] = lane == 0 ? s : 0.f; }
}

__device__ __forceinline__ void lru_block(PT pt, LAS unsigned char* lds, int bi, int layer, int tid) {
    asm volatile("" : "+v"(tid));
    const int lane = tid & 63, w = tid >> 6;
    unsigned char* ws = pws(pt);
    const int wi = bi * 8 + w;
    const int dq = wi & 3, n = (wi >> 2) & 7, dir = (wi >> 5) & 1, b = wi >> 6;
    const int fr = lane & 15, fq = lane >> 4;
    LAS unsigned char* XCB = lds + (w >> 2) * 8192;
    LAS unsigned char* SCN = lds + 16384 + w * 1024;
    const int ti = lane >> 2, cq = lane & 3;
    const int cch = 64 * n + 16 * dq + 4 * cq;
    f32x4 cw4[4];
#pragma unroll
    for (int tap = 0; tap < 4; ++tap) cw4[tap] = *(const f32x4*)(pin(pt, I_LCW) + ((size_t)layer * 4 + tap) * 512 + cch);
    const f32x4 cb4 = *(const f32x4*)(pin(pt, I_LCB) + (size_t)layer * 512 + cch);
    const bf16_t* wbase = (const bf16_t*)(ws + WS_WAT) + ((((size_t)layer * 2 + dir) * 8 + n) * 2) * 4096;
    bf16x8 Ba[2], Bx[2];
#pragma unroll
    for (int ks = 0; ks < 2; ++ks) { Ba[ks] = *(const bf16x8*)(wbase + (16 * dq + fr) * 64 + 32 * ks + 8 * fq); Bx[ks] = *(const bf16x8*)(wbase + 4096 + (16 * dq + fr) * 64 + 32 * ks + 8 * fq); }
    const int dch = 64 * n + 16 * dq + fr; const size_t pidx = ((size_t)layer * 2 + dir) * 512 + dch;
    const float ba = pin(pt, I_LBA)[pidx], bx = pin(pt, I_LBX)[pidx], sp8 = 8.0f * 1.4426950408889634f * softplus_f(-pin(pt, I_LAM)[pidx]);
    const bf16_t* plx = (const bf16_t*)(ws + WS_PLX) + (size_t)b * SEQ * 512 + cch;
    bf16_t* hout = (bf16_t*)pout(pt) + (size_t)dir * M_TOK * 512 + (size_t)b * SEQ * 512 + dch;
    u32x2 xr[2][4];
#define LRU_LOAD(scn) do { _Pragma("unroll") for (int s_ = 0; s_ < 2; ++s_) { const int tt_ = dir ? (SEQ - 1 - (32 * (scn) + 16 * s_ + ti)) : (32 * (scn) + 16 * s_ + ti); \
        _Pragma("unroll") for (int tap = 0; tap < 4; ++tap) { const int t2_ = tt_ + tap - 2; xr[s_][tap] = (u32x2){0u, 0u}; if (t2_ >= 0 && t2_ < SEQ) xr[s_][tap] = *(const u32x2*)(plx + (size_t)t2_ * 512); } } } while (0)
    LRU_LOAD(0);
    float hprev = 0.f;
    LBAR();
#pragma unroll 1
    for (int sc = 0; sc < 64; ++sc) {
        LAS unsigned char* XC = XCB + (sc & 1) * 4096;
#pragma unroll
        for (int s2 = 0; s2 < 2; ++s2) { f32x4 xa = cb4;
#pragma unroll
            for (int tap = 0; tap < 4; ++tap) { xa[0] += cw4[tap][0] * bflo(xr[s2][tap].x); xa[1] += cw4[tap][1] * bfhi(xr[s2][tap].x); xa[2] += cw4[tap][2] * bflo(xr[s2][tap].y); xa[3] += cw4[tap][3] * bfhi(xr[s2][tap].y); }
            *(LAS u32x2*)(XC + swz64(16 * s2 + ti, 16 * dq + 4 * cq)) = pk4(xa); }
        if (sc + 1 < 64) LRU_LOAD(sc + 1);
        LBAR();
        float Ac[2][4], Hc[2][4];
#pragma unroll
        for (int s2 = 0; s2 < 2; ++s2) {
            const bf16x8 A0 = *(const LAS bf16x8*)(XC + swz64(16 * s2 + fr, 8 * fq)), A1 = *(const LAS bf16x8*)(XC + swz64(16 * s2 + fr, 32 + 8 * fq));
            f32x4 ca = {0.f, 0.f, 0.f, 0.f}, cx = {0.f, 0.f, 0.f, 0.f};
            ca = MFMA16(A0, Ba[0], ca); ca = MFMA16(A1, Ba[1], ca); cx = MFMA16(A0, Bx[0], cx); cx = MFMA16(A1, Bx[1], cx);
#pragma unroll
            for (int jj = 0; jj < 4; ++jj) { const float xv = bf2f(*(const LAS unsigned short*)(XC + swz64(16 * s2 + 4 * fq + jj, 16 * dq + fr)));
                const float r = sigm(ca[jj] + ba), ig = sigm(cx[jj] + bx), a = __builtin_amdgcn_exp2f(-r * sp8);
                const float bt = __builtin_amdgcn_sqrtf(fmaxf(1.0f - a * a, 0.f)) * ig * xv;
                Hc[s2][jj] = jj ? (a * Hc[s2][jj - 1] + bt) : bt; Ac[s2][jj] = jj ? (a * Ac[s2][jj - 1]) : a; }
            *(LAS f32x2*)(SCN + s2 * 512 + (fq * 16 + fr) * 8) = (f32x2){Ac[s2][3], Hc[s2][3]}; }
#pragma unroll
        for (int s2 = 0; s2 < 2; ++s2) {
            const LAS unsigned char* T = SCN + s2 * 512;
            const f32x2 g0 = *(const LAS f32x2*)(T + (0 * 16 + fr) * 8), g1 = *(const LAS f32x2*)(T + (1 * 16 + fr) * 8), g2 = *(const LAS f32x2*)(T + (2 * 16 + fr) * 8), g3 = *(const LAS f32x2*)(T + (3 * 16 + fr) * 8);
            const float h1 = g0.x * hprev + g0.y, h2 = g1.x * h1 + g1.y, h3 = g2.x * h2 + g2.y, h4 = g3.x * h3 + g3.y;
            const float hin = fq == 0 ? hprev : (fq == 1 ? h1 : (fq == 2 ? h2 : h3));
            hprev = h4;
#pragma unroll
            for (int jj = 0; jj < 4; ++jj) { const float hv = Ac[s2][jj] * hin + Hc[s2][jj]; const int i = 16 * s2 + 4 * fq + jj; const int t2 = dir ? (SEQ - 1 - (32 * sc + i)) : (32 * sc + i);
                hout[(size_t)t2 * 512] = (bf16_t)(pk2(hv, 0.f) & 0xffffu); } }
    }
#undef LRU_LOAD
}

constexpr int DP_BUF0 = 0, DP_BUF1 = 49152, DP_KL = 49152, DP_QL = 49152 + 16384, DP_VL = 49152 + 32768, DP_VEC = 98304, DP_CWL = 99328;
__device__ __forceinline__ void dp_item(PT pt, LAS unsigned char* lds, int item, int layer, int tid, int lane, int w) {
    asm volatile("" : "+v"(tid)); lane = tid & 63; asm volatile("" : "+s"(w));
    unsigned char* ws = pws(pt);
    const int b = item >> 7, h = (item >> 5) & 3, n = item & 31;
    const size_t rowbase = (size_t)b * SEQ + 64 * n;
    LAS float* VEC = (LAS float*)(lds + DP_VEC);
    LBAR();
    f32x4 gpre = {0.f, 0.f, 0.f, 0.f};
    if (w == 0) { const float* gp = (const float*)(ws + WS_GATES) + (rowbase + lane) * 16 + h; gpre[0] = gp[0]; gpre[1] = gp[4]; gpre[2] = gp[8]; gpre[3] = gp[12]; }
    { const int i = tid >> 3, c = tid & 7; const int t = 64 * n + i; const size_t R = rowbase + i;
      const bf16_t* pq = (const bf16_t*)(ws + WS_PQKV);
      u32x4 xin[3][4][2];
#pragma unroll
      for (int mat = 0; mat < 3; ++mat)
#pragma unroll
          for (int tap = 0; tap < 4; ++tap) { const int t2 = t + tap - 2; xin[mat][tap][0] = (u32x4){0u, 0u, 0u, 0u}; xin[mat][tap][1] = (u32x4){0u, 0u, 0u, 0u};
              if (t2 >= 0 && t2 < SEQ) { const bf16_t* xp = pq + (R + tap - 2) * 1536 + mat * 512 + h * 128 + 16 * c; xin[mat][tap][0] = *(const u32x4*)xp; xin[mat][tap][1] = *(const u32x4*)(xp + 8); } }
#pragma unroll
      for (int mat = 0; mat < 3; ++mat) {
          f32x4 a[4] = {{0.f, 0.f, 0.f, 0.f}, {0.f, 0.f, 0.f, 0.f}, {0.f, 0.f, 0.f, 0.f}, {0.f, 0.f, 0.f, 0.f}};
#pragma unroll
          for (int tap = 0; tap < 4; ++tap) { const u32x4 x0 = xin[mat][tap][0], x1 = xin[mat][tap][1];
              const LAS float* wp = (const LAS float*)(lds + DP_CWL) + (mat * 4 + tap) * 128 + 16 * c; const f32x4 w0 = *(const LAS f32x4*)wp, w1 = *(const LAS f32x4*)(wp + 4), w2 = *(const LAS f32x4*)(wp + 8), w3 = *(const LAS f32x4*)(wp + 12);
              a[0][0] += w0[0] * bflo(x0.x); a[0][1] += w0[1] * bfhi(x0.x); a[0][2] += w0[2] * bflo(x0.y); a[0][3] += w0[3] * bfhi(x0.y);
              a[1][0] += w1[0] * bflo(x0.z); a[1][1] += w1[1] * bfhi(x0.z); a[1][2] += w1[2] * bflo(x0.w); a[1][3] += w1[3] * bfhi(x0.w);
              a[2][0] += w2[0] * bflo(x1.x); a[2][1] += w2[1] * bfhi(x1.x); a[2][2] += w2[2] * bflo(x1.y); a[2][3] += w2[3] * bfhi(x1.y);
              a[3][0] += w3[0] * bflo(x1.z); a[3][1] += w3[1] * bfhi(x1.z); a[3][2] += w3[2] * bflo(x1.w); a[3][3] += w3[3] * bfhi(x1.w); }
          float ssq = 0.f;
#pragma unroll
          for (int q = 0; q < 4; ++q)
#pragma unroll
              for (int e = 0; e < 4; ++e) { const float v = a[q][e]; const float sv = v * sigm(v); a[q][e] = sv; ssq += sv * sv; }
          float scale = 1.f;
          if (mat < 2) { ssq += __shfl_xor(ssq, 1); ssq += __shfl_xor(ssq, 2); ssq += __shfl_xor(ssq, 4); scale = rsqrtf(ssq + EPS); if (mat == 0) scale *= 0.08838834764831845f; }
          u32x4 o0, o1; o0.x = pk2(a[0][0] * scale, a[0][1] * scale); o0.y = pk2(a[0][2] * scale, a[0][3] * scale); o0.z = pk2(a[1][0] * scale, a[1][1] * scale); o0.w = pk2(a[1][2] * scale, a[1][3] * scale);
          o1.x = pk2(a[2][0] * scale, a[2][1] * scale); o1.y = pk2(a[2][2] * scale, a[2][3] * scale); o1.z = pk2(a[3][0] * scale, a[3][1] * scale); o1.w = pk2(a[3][2] * scale, a[3][3] * scale);
          const int lbase = (mat == 0) ? DP_QL : (mat == 1 ? DP_KL : DP_VL);
          *(LAS u32x4*)(lds + lbase + swz128(i, 16 * c)) = o0; *(LAS u32x4*)(lds + lbase + swz128(i, 16 * c + 8)) = o1;
          if (mat < 2) { bf16_t* gp = (bf16_t*)(ws + (mat == 0 ? WS_QH : WS_KH)) + R * 512 + h * 128 + 16 * c; *(u32x4*)gp = o0; *(u32x4*)(gp + 8) = o1; } }
    }
    if (w == 0) {
        const float bF = sigm(gpre[0]), bB = sigm(gpre[1]);
        float gF = -expf(pin(pt, I_ALOG)[layer * 8 + h]) * softplus_f(gpre[2] + pin(pt, I_DTB)[layer * 8 + h]);
        float gB = -expf(pin(pt, I_ALOG)[layer * 8 + 4 + h]) * softplus_f(gpre[3] + pin(pt, I_DTB)[layer * 8 + 4 + h]);
#pragma unroll
        for (int off = 1; off < 64; off <<= 1) { const float v = __shfl_up(gF, off); if (lane >= off) gF += v; const float u = __shfl_down(gB, off); if (lane + off < 64) gB += u; }
        const float glF = __shfl(gF, 63), glB = __shfl(gB, 0);
        VEC[lane] = bF; VEC[64 + lane] = gF; VEC[128 + lane] = bB; VEC[192 + lane] = gB;
        float* v0 = (float*)(ws + WS_VEC) + (size_t)item * 256; float* v1 = v0 + (size_t)4096 * 256;
        v0[lane] = bF; v0[64 + lane] = fexp(gF); v0[128 + lane] = fexp(glF - gF); if (lane == 0) v0[192] = fexp(glF);
        v1[lane] = bB; v1[64 + lane] = fexp(gB); v1[128 + lane] = fexp(glB - gB); if (lane == 0) v1[192] = fexp(glB);
    }
    LBAR();
    { const int e = tid >> 2, jq = tid & 3; unsigned vv[8];
#pragma unroll
      for (int p = 0; p < 8; ++p) { const unsigned lo = *(const LAS unsigned short*)(lds + DP_VL + swz128(16 * jq + 2 * p, e)), hi = *(const LAS unsigned short*)(lds + DP_VL + swz128(16 * jq + 2 * p + 1, e)); vv[p] = lo | (hi << 16); }
      bf16_t* gp = (bf16_t*)(ws + WS_VT) + (size_t)item * 8192 + e * 64 + 16 * jq;
      *(u32x4*)gp = (u32x4){vv[0], vv[1], vv[2], vv[3]}; *(u32x4*)(gp + 8) = (u32x4){vv[4], vv[5], vv[6], vv[7]}; }
    const int r32 = lane & 31, hi = lane >> 5;
    { const int kind = w >> 2, q = w & 3, ta = q >> 1, tb = q & 1;
      f32x16 acc; for (int r = 0; r < 16; ++r) acc[r] = 0.f;
      const int bbase = kind ? DP_QL : DP_KL;
#pragma unroll
      for (int ks = 0; ks < 8; ++ks) { const bf16x8 av = *(const LAS bf16x8*)(lds + DP_KL + swz128(32 * ta + r32, 16 * ks + 8 * hi)), bv = *(const LAS bf16x8*)(lds + bbase + swz128(32 * tb + r32, 16 * ks + 8 * hi)); acc = MFMA32(av, bv, acc); }
      const int gb = 32 * tb + r32;
#pragma unroll
      for (int dir = 0; dir < 2; ++dir) { const LAS float* bet = VEC + dir * 128; const LAS float* gc = VEC + dir * 128 + 64;
          const float gcl = gc[gb], betl = bet[gb];
#pragma unroll
          for (int g = 0; g < 4; ++g) { const int ga0 = 32 * ta + 8 * g + 4 * hi; const f32x4 gca = *(const LAS f32x4*)(gc + ga0), bea = *(const LAS f32x4*)(bet + ga0);
              if (kind == 0) { f32x4 xv, yv, pv;
#pragma unroll
                  for (int jj = 0; jj < 4; ++jj) { const int ga = ga0 + jj; const float kk = acc[4 * g + jj];
                      const bool mx = dir ? (gb < ga) : (gb > ga), my = dir ? (ga < gb) : (ga > gb);
                      const float ed = kk * fexp(-fabsf(gcl - gca[jj]));
                      xv[jj] = mx ? (-betl * ed) : 0.f; yv[jj] = my ? (-bea[jj] * ed) : 0.f; pv[jj] = (ga == gb) ? 1.f : 0.f; }
                  LAS unsigned char* bb = lds + DP_BUF0 + dir * 24576 + swz64(gb, ga0);
                  *(LAS u32x2*)bb = pk4(xv); *(LAS u32x2*)(bb + 8192) = pk4(yv); *(LAS u32x2*)(bb + 16384) = pk4(pv);
              } else { f32x4 av4;
#pragma unroll
                  for (int jj = 0; jj < 4; ++jj) { const int ga = ga0 + jj; const bool ma = dir ? (gb <= ga) : (gb >= ga); av4[jj] = ma ? (acc[4 * g + jj] * fexp(-fabsf(gcl - gca[jj]))) : 0.f; }
                  *(u32x2*)((bf16_t*)(ws + WS_AT) + ((size_t)dir * 4096 + item) * 4096 + gb * 64 + ga0) = pk4(av4); } } }
    }
    LBAR();
    { const int dir = w >> 2, q = w & 3, ti = q >> 1, tj = q & 1;
      f32x16 pacc; for (int r = 0; r < 16; ++r) pacc[r] = (32 * tj + crow(r, hi) == 32 * ti + r32) ? 1.f : 0.f;
#pragma unroll 1
      for (int rd = 0; rd < 6; ++rd) { LAS unsigned char* cur = lds + ((rd & 1) ? DP_BUF1 : DP_BUF0) + dir * 24576; LAS unsigned char* nxt = lds + ((rd & 1) ? DP_BUF0 : DP_BUF1) + dir * 24576;
          bf16x8 xf[4], yf[4], pf[4];
#pragma unroll
          for (int ks = 0; ks < 4; ++ks) { xf[ks] = *(const LAS bf16x8*)(cur + swz64(32 * ti + r32, 16 * ks + 8 * hi)); yf[ks] = *(const LAS bf16x8*)(cur + 8192 + swz64(32 * tj + r32, 16 * ks + 8 * hi)); pf[ks] = *(const LAS bf16x8*)(cur + 16384 + swz64(32 * ti + r32, 16 * ks + 8 * hi)); }
#pragma unroll
          for (int ks = 0; ks < 4; ++ks) pacc = MFMA32(yf[ks], pf[ks], pacc);
          if (rd < 5) { f32x16 xa, ya; for (int r = 0; r < 16; ++r) { xa[r] = 0.f; ya[r] = 0.f; }
#pragma unroll
              for (int ks = 0; ks < 4; ++ks) { xa = MFMA32(yf[ks], xf[ks], xa); ya = MFMA32(xf[ks], yf[ks], ya); }
#pragma unroll
              for (int g = 0; g < 4; ++g) { const int c0 = 8 * g + 4 * hi;
                  *(LAS u32x2*)(nxt + swz64(32 * ti + r32, 32 * tj + c0)) = pk4((f32x4){xa[4 * g], xa[4 * g + 1], xa[4 * g + 2], xa[4 * g + 3]});
                  *(LAS u32x2*)(nxt + 8192 + swz64(32 * tj + r32, 32 * ti + c0)) = pk4((f32x4){ya[4 * g], ya[4 * g + 1], ya[4 * g + 2], ya[4 * g + 3]});
                  *(LAS u32x2*)(nxt + 16384 + swz64(32 * ti + r32, 32 * tj + c0)) = pk4((f32x4){pacc[4 * g], pacc[4 * g + 1], pacc[4 * g + 2], pacc[4 * g + 3]}); }
              LBAR(); } }
      bf16_t* tg = (bf16_t*)(ws + WS_TM) + ((size_t)dir * 4096 + item) * 4096 + (32 * ti + r32) * 64 + 32 * tj + 4 * hi;
#pragma unroll
      for (int g = 0; g < 4; ++g) *(u32x2*)(tg + 8 * g) = pk4((f32x4){pacc[4 * g], pacc[4 * g + 1], pacc[4 * g + 2], pacc[4 * g + 3]});
    }
}

constexpr int DR_K = 0, DR_Q = 16384, DR_KT = 32768, DR_VT = 49152, DR_T = 65536, DR_A = 73728, DR_VEC = 81920, DR_PRIV = 83968;
__device__ __forceinline__ void dr_item(PT pt, LAS unsigned char* lds, int item, int tid, int lane, int w) {
    asm volatile("" : "+v"(tid)); lane = tid & 63; asm volatile("" : "+s"(w));
    unsigned char* ws = pws(pt);
    const int dir = item & 1, h = (item >> 1) & 3, b = item >> 3;
    const int fr = lane & 15, fq = lane >> 4, es = 16 * w;
    LAS unsigned char* ST = lds + DR_PRIV + w * 8192; LAS unsigned char* RV = ST + 4096; LAS unsigned char* VN2 = ST + 6144;
    const LAS float* VEC = (const LAS float*)(lds + DR_VEC);
    const bf16_t* kh = (const bf16_t*)(ws + WS_KH) + (size_t)b * SEQ * 512 + h * 128;
    const bf16_t* qh = (const bf16_t*)(ws + WS_QH) + (size_t)b * SEQ * 512 + h * 128;
    const int ibase = (b * 4 + h) * 32;
    const bf16_t* vt = (const bf16_t*)(ws + WS_VT) + (size_t)ibase * 8192;
    const bf16_t* tm = (const bf16_t*)(ws + WS_TM) + ((size_t)dir * 4096 + ibase) * 4096;
    const bf16_t* at = (const bf16_t*)(ws + WS_AT) + ((size_t)dir * 4096 + ibase) * 4096;
    const float* vecs = (const float*)(ws + WS_VEC) + ((size_t)dir * 4096 + ibase) * 256;
    bf16_t* og = (bf16_t*)(ws + (dir ? WS_OB : WS_OF)) + (size_t)b * SEQ * 512 + h * 128 + es + fr;
    u32x4 pk[2], pq[2], pv[2], ptm, pa; f32x4 pvec = {0.f, 0.f, 0.f, 0.f};
#define DR_LOAD(nn) do { _Pragma("unroll") for (int u_ = 0; u_ < 2; ++u_) { const int p_ = tid + 512 * u_; \
        pk[u_] = *(const u32x4*)(kh + (size_t)(64 * (nn) + (p_ >> 4)) * 512 + 8 * (p_ & 15)); pq[u_] = *(const u32x4*)(qh + (size_t)(64 * (nn) + (p_ >> 4)) * 512 + 8 * (p_ & 15)); \
        pv[u_] = *(const u32x4*)(vt + (size_t)(nn) * 8192 + p_ * 8); } \
        ptm = *(const u32x4*)(tm + (size_t)(nn) * 4096 + tid * 8); pa = *(const u32x4*)(at + (size_t)(nn) * 4096 + tid * 8); \
        if (tid < 64) pvec = *(const f32x4*)(vecs + (size_t)(nn) * 256 + 4 * tid); } while (0)
#define DR_STORE() do { _Pragma("unroll") for (int u_ = 0; u_ < 2; ++u_) { const int p_ = tid + 512 * u_; const int j_ = p_ >> 4, q_ = p_ & 15; \
        *(LAS u32x4*)(lds + DR_K + swz128(j_, 8 * q_)) = pk[u_]; *(LAS u32x4*)(lds + DR_Q + swz128(j_, 8 * q_)) = pq[u_]; \
        *(LAS unsigned short*)(lds + DR_KT + swz64(8 * q_ + 0, j_)) = (unsigned short)(pk[u_].x & 0xffffu); *(LAS unsigned short*)(lds + DR_KT + swz64(8 * q_ + 1, j_)) = (unsigned short)(pk[u_].x >> 16); \
        *(LAS unsigned short*)(lds + DR_KT + swz64(8 * q_ + 2, j_)) = (unsigned short)(pk[u_].y & 0xffffu); *(LAS unsigned short*)(lds + DR_KT + swz64(8 * q_ + 3, j_)) = (unsigned short)(pk[u_].y >> 16); \
        *(LAS unsigned short*)(lds + DR_KT + swz64(8 * q_ + 4, j_)) = (unsigned short)(pk[u_].z & 0xffffu); *(LAS unsigned short*)(lds + DR_KT + swz64(8 * q_ + 5, j_)) = (unsigned short)(pk[u_].z >> 16); \
        *(LAS unsigned short*)(lds + DR_KT + swz64(8 * q_ + 6, j_)) = (unsigned short)(pk[u_].w & 0xffffu); *(LAS unsigned short*)(lds + DR_KT + swz64(8 * q_ + 7, j_)) = (unsigned short)(pk[u_].w >> 16); \
        *(LAS u32x4*)(lds + DR_VT + swz64(p_ >> 3, 8 * (p_ & 7))) = pv[u_]; } \
        *(LAS u32x4*)(lds + DR_T + swz64(tid >> 3, 8 * (tid & 7))) = ptm; *(LAS u32x4*)(lds + DR_A + swz64(tid >> 3, 8 * (tid & 7))) = pa; \
        if (tid < 64) *(LAS f32x4*)(lds + DR_VEC + 16 * tid) = pvec; } while (0)
    LBAR();
    DR_LOAD(dir ? 31 : 0);
    DR_STORE();
#pragma unroll
    for (int q = 0; q < 4; ++q) *(LAS u32x4*)(ST + lane * 64 + q * 16) = (u32x4){0u, 0u, 0u, 0u};
    f32x4 Sacc[8];
#pragma unroll
    for (int d = 0; d < 8; ++d) Sacc[d] = (f32x4){0.f, 0.f, 0.f, 0.f};
    LBAR();
#pragma unroll 1
    for (int cc = 0; cc < 32; ++cc) { const int n = dir ? (31 - cc) : cc;
        if (cc + 1 < 32) DR_LOAD(dir ? (30 - cc) : (cc + 1));
        bf16x8 sb[4];
#pragma unroll
        for (int ks = 0; ks < 4; ++ks) sb[ks] = *(const LAS bf16x8*)(ST + swz128(fr, 32 * ks + 8 * fq));
        f32x4 oacc[4];
#pragma unroll
        for (int it = 0; it < 4; ++it) { f32x4 ka = {0.f, 0.f, 0.f, 0.f}, qa = {0.f, 0.f, 0.f, 0.f};
#pragma unroll
            for (int ks = 0; ks < 4; ++ks) { const bf16x8 a1 = *(const LAS bf16x8*)(lds + DR_K + swz128(16 * it + fr, 32 * ks + 8 * fq)), a2 = *(const LAS bf16x8*)(lds + DR_Q + swz128(16 * it + fr, 32 * ks + 8 * fq));
                ka = MFMA16(a1, sb[ks], ka); qa = MFMA16(a2, sb[ks], qa); }
            const int i0 = 16 * it + 4 * fq; const f32x4 be = *(const LAS f32x4*)(VEC + i0), eg = *(const LAS f32x4*)(VEC + 64 + i0);
            const u32x2 vv = *(const LAS u32x2*)(lds + DR_VT + swz64(es + fr, i0));
            f32x4 rh; rh[0] = be[0] * (bflo(vv.x) - eg[0] * ka[0]); rh[1] = be[1] * (bfhi(vv.x) - eg[1] * ka[1]); rh[2] = be[2] * (bflo(vv.y) - eg[2] * ka[2]); rh[3] = be[3] * (bfhi(vv.y) - eg[3] * ka[3]);
            *(LAS u32x2*)(RV + swz64(fr, i0)) = pk4(rh);
            oacc[it] = qa * eg; }
        bf16x8 rb2[2];
#pragma unroll
        for (int ks = 0; ks < 2; ++ks) rb2[ks] = *(const LAS bf16x8*)(RV + swz64(fr, 32 * ks + 8 * fq));
        f32x4 vn[4];
#pragma unroll
        for (int it = 0; it < 4; ++it) { vn[it] = (f32x4){0.f, 0.f, 0.f, 0.f};
#pragma unroll
            for (int ks = 0; ks < 2; ++ks) { const bf16x8 a1 = *(const LAS bf16x8*)(lds + DR_T + swz64(16 * it + fr, 32 * ks + 8 * fq)); vn[it] = MFMA16(a1, rb2[ks], vn[it]); } }
#pragma unroll
        for (int it = 0; it < 4; ++it) { const int i0 = 16 * it + 4 * fq; const f32x4 ed = *(const LAS f32x4*)(VEC + 128 + i0);
            *(LAS u32x2*)(RV + swz64(fr, i0)) = pk4(vn[it]); *(LAS u32x2*)(VN2 + swz64(fr, i0)) = pk4(vn[it] * ed); }
        bf16x8 vb[2], vb2[2];
#pragma unroll
        for (int ks = 0; ks < 2; ++ks) { vb[ks] = *(const LAS bf16x8*)(RV + swz64(fr, 32 * ks + 8 * fq)); vb2[ks] = *(const LAS bf16x8*)(VN2 + swz64(fr, 32 * ks + 8 * fq)); }
#pragma unroll
        for (int it = 0; it < 4; ++it)
#pragma unroll
            for (int ks = 0; ks < 2; ++ks) { const bf16x8 a1 = *(const LAS bf16x8*)(lds + DR_A + swz64(16 * it + fr, 32 * ks + 8 * fq)); oacc[it] = MFMA16(a1, vb[ks], oacc[it]); }
        const float cdec = VEC[192];
#pragma unroll
        for (int dt = 0; dt < 8; ++dt) { Sacc[dt] = Sacc[dt] * cdec;
#pragma unroll
            for (int ks = 0; ks < 2; ++ks) { const bf16x8 a1 = *(const LAS bf16x8*)(lds + DR_KT + swz64(16 * dt + fr, 32 * ks + 8 * fq)); Sacc[dt] = MFMA16(a1, vb2[ks], Sacc[dt]); }
            *(LAS u32x2*)(ST + swz128(fr, 16 * dt + 4 * fq)) = pk4(Sacc[dt]); }
#pragma unroll
        for (int it = 0; it < 4; ++it)
#pragma unroll
            for (int jj = 0; jj < 4; ++jj) og[(size_t)(64 * n + 16 * it + 4 * fq + jj) * 512] = (bf16_t)(pk2(oacc[it][jj], 0.f) & 0xffffu);
        LBAR();
        if (cc + 1 < 32) DR_STORE();
        LBAR();
    }
#undef DR_LOAD
#undef DR_STORE
}

__device__ __forceinline__ void m2_rows(PT pt, int layer, int gw, int NGW, int lane) {
    asm volatile("" : "+v"(lane));
    unsigned char* ws = pws(pt);
    const bf16_t* of = (const bf16_t*)(ws + WS_OF); const bf16_t* ob = (const bf16_t*)(ws + WS_OB); const bf16_t* pz = (const bf16_t*)(ws + WS_PZ);
    const bf16_t* hf = (const bf16_t*)pout(pt); const bf16_t* hb = hf + (size_t)M_TOK * 512; const bf16_t* plg = (const bf16_t*)(ws + WS_PLG);
    bf16_t* amix = (bf16_t*)(ws + WS_AMIX);
    const float* dng = pin(pt, I_DNG) + layer * 128 + 8 * (lane & 15); const float* lng = pin(pt, I_LNG) + layer * 512 + 8 * lane;
    const f32x4 dg0 = *(const f32x4*)dng, dg1 = *(const f32x4*)(dng + 4), lg0 = *(const f32x4*)lng, lg1 = *(const f32x4*)(lng + 4);
    for (int m0 = gw; m0 < M_TOK; m0 += 2 * NGW) {
        u32x4 av[2], bv[2], zv[2], cv[2], dv[2], gv[2];
#pragma unroll
        for (int r = 0; r < 2; ++r) { const int m = m0 + r * NGW; if (m < M_TOK) { const size_t o = (size_t)m * 512 + 8 * lane;
            av[r] = *(const u32x4*)(of + o); bv[r] = *(const u32x4*)(ob + o); zv[r] = *(const u32x4*)(pz + o); cv[r] = *(const u32x4*)(hf + o); dv[r] = *(const u32x4*)(hb + o); gv[r] = *(const u32x4*)(plg + o); } }
#pragma unroll
        for (int r = 0; r < 2; ++r) { const int m = m0 + r * NGW; if (m < M_TOK) {
        const u32x4 a = av[r], b2 = bv[r], z = zv[r], c = cv[r], d = dv[r], g = gv[r];
        float v[8], y[8];
        v[0] = bflo(a.x) + bflo(b2.x); v[1] = bfhi(a.x) + bfhi(b2.x); v[2] = bflo(a.y) + bflo(b2.y); v[3] = bfhi(a.y) + bfhi(b2.y);
        v[4] = bflo(a.z) + bflo(b2.z); v[5] = bfhi(a.z) + bfhi(b2.z); v[6] = bflo(a.w) + bflo(b2.w); v[7] = bfhi(a.w) + bfhi(b2.w);
        float s1 = 0.f;
#pragma unroll
        for (int e = 0; e < 8; ++e) s1 += v[e] * v[e];
        s1 += __shfl_xor(s1, 1); s1 += __shfl_xor(s1, 2); s1 += __shfl_xor(s1, 4); s1 += __shfl_xor(s1, 8);
        const float r1 = rsqrtf(s1 * (1.0f / 128.0f) + EPS);
        float zz[8] = {bflo(z.x), bfhi(z.x), bflo(z.y), bfhi(z.y), bflo(z.z), bfhi(z.z), bflo(z.w), bfhi(z.w)};
        float gg[8] = {bflo(g.x), bfhi(g.x), bflo(g.y), bfhi(g.y), bflo(g.z), bfhi(g.z), bflo(g.w), bfhi(g.w)};
        float hh[8] = {bflo(c.x) + bflo(d.x), bfhi(c.x) + bfhi(d.x), bflo(c.y) + bflo(d.y), bfhi(c.y) + bfhi(d.y), bflo(c.z) + bflo(d.z), bfhi(c.z) + bfhi(d.z), bflo(c.w) + bflo(d.w), bfhi(c.w) + bfhi(d.w)};
        float s2 = 0.f;
#pragma unroll
        for (int e = 0; e < 8; ++e) { const float dgv = e < 4 ? dg0[e & 3] : dg1[e & 3]; v[e] = v[e] * r1 * dgv * (zz[e] * sigm(zz[e])); y[e] = gelu_t(gg[e]) * hh[e]; s2 += y[e] * y[e]; }
#pragma unroll
        for (int o2 = 1; o2 < 64; o2 <<= 1) s2 += __shfl_xor(s2, o2);
        const float r2 = rsqrtf(s2 * (1.0f / 512.0f) + EPS);
#pragma unroll
        for (int e = 0; e < 8; ++e) { const float lgv = e < 4 ? lg0[e & 3] : lg1[e & 3]; y[e] = y[e] * r2 * lgv; }
        u32x4 w1, w2; w1.x = pk2(v[0], v[1]); w1.y = pk2(v[2], v[3]); w1.z = pk2(v[4], v[5]); w1.w = pk2(v[6], v[7]);
        w2.x = pk2(y[0], y[1]); w2.y = pk2(y[2], y[3]); w2.z = pk2(y[4], y[5]); w2.w = pk2(y[6], y[7]);
        *(u32x4*)(amix + (size_t)m * 1024 + 8 * lane) = w1; *(u32x4*)(amix + (size_t)m * 1024 + 512 + 8 * lane) = w2; } }
    }
}

__device__ __forceinline__ void glu_fixup(PT pt, int layer, int bx, int G, int tid) {
    asm volatile("" : "+v"(tid));
    unsigned char* ws = pws(pt);
    const float* sg = (const float*)(ws + WS_G); const float* su = sg + (size_t)256 * 4 * FF; bf16_t* act = (bf16_t*)(ws + WS_ACT);
    const float* cw = pin(pt, I_FCW) + (size_t)layer * 3 * FF; const float* cb = pin(pt, I_FCB) + (size_t)layer * FF;
    for (int e = bx * 512 + tid; e < 512 * (FF / 4); e += G * 512) { const int edge = e / (FF / 4), ch = (e % (FF / 4)) * 4; const int pm = edge >> 1, side = edge & 1;
        const int row = 256 * pm + (side ? 255 : 0); const int t = row & (SEQ - 1);
        const f32x4 gmid = *(const f32x4*)(sg + ((size_t)pm * 4 + (side ? 3 : 0)) * FF + ch);
        f32x4 gup = {0.f, 0.f, 0.f, 0.f}, gdn = {0.f, 0.f, 0.f, 0.f};
        if (side == 0) { gdn = *(const f32x4*)(sg + ((size_t)pm * 4 + 1) * FF + ch); if (t != 0) gup = *(const f32x4*)(sg + ((size_t)(pm - 1) * 4 + 3) * FF + ch); }
        else { gup = *(const f32x4*)(sg + ((size_t)pm * 4 + 2) * FF + ch); if (t != SEQ - 1) gdn = *(const f32x4*)(sg + ((size_t)(pm + 1) * 4 + 0) * FF + ch); }
        const f32x4 uu = *(const f32x4*)(su + ((size_t)pm * 2 + side) * FF + ch);
        const f32x4 w0 = *(const f32x4*)(cw + ch), w1 = *(const f32x4*)(cw + FF + ch), w2 = *(const f32x4*)(cw + 2 * FF + ch), bb = *(const f32x4*)(cb + ch);
        const f32x4 ga = w0 * gup + w1 * gmid + w2 * gdn + bb;
        u32x2 o; o.x = pk2(gelu_t(ga[0]) * uu[0], gelu_t(ga[1]) * uu[1]); o.y = pk2(gelu_t(ga[2]) * uu[2], gelu_t(ga[3]) * uu[3]);
        *(u32x2*)(act + (size_t)row * FF + ch) = o; }
}

#define XB_TMO      128
#define XB_XCNT(j)  (256  + 64 * (j))
#define XB_XSUB(j)  (1280 + 64 * (j))
#define XB_XGEN(j)  (2304 + 64 * (j))
#define XB_TOP      3328
#define XB_TOPGEN   3392
#define XCD_BAR_WORDS 3456
#define XB_SPIN_CAP (1u << 18)

__device__ __forceinline__ unsigned xb_ld(unsigned* p)              { return __hip_atomic_load(p, __ATOMIC_RELAXED, __HIP_MEMORY_SCOPE_AGENT); }
__device__ __forceinline__ unsigned xb_add(unsigned* p, unsigned v) { return __hip_atomic_fetch_add(p, v, __ATOMIC_RELAXED, __HIP_MEMORY_SCOPE_AGENT); }
__device__ __forceinline__ unsigned xb_xcc_id() { return (unsigned)__builtin_amdgcn_s_getreg((3 << 11) | 20) & 0xFu; }
#define XB_SPIN(cond, bar) do { unsigned _sp = 0; while (cond) { __builtin_amdgcn_s_sleep(1); \
    if ((++_sp & 255u) == 0u) { if (xb_ld(&(bar)[XB_TMO])) break; if (_sp > XB_SPIN_CAP) { atomicAdd(&(bar)[XB_TMO], 1u); break; } } } } while (0)

struct XcdBarrier {
    unsigned* bar; unsigned x;
    volatile LAS unsigned* st;
};

__device__ __forceinline__ XcdBarrier xcd_barrier_post(unsigned* bar, volatile LAS unsigned* st) {
    XcdBarrier b; b.bar = bar; b.x = xb_xcc_id(); b.st = st;
    if (threadIdx.x == 0) (void)xb_add(&bar[XB_XCNT(b.x)], 1u);
    return b;
}
__device__ __forceinline__ void xcd_barrier_complete(unsigned* bar, unsigned x, unsigned& nloc, unsigned& nx) {
    const unsigned G = gridDim.x * gridDim.y * gridDim.z;
    unsigned sum, cnt, mine, sp = 0u;
    for (;;) {
        sum = 0u; cnt = 0u; mine = 0u;
#pragma unroll
        for (unsigned j = 0; j < 16; ++j) { const unsigned c = xb_ld(&bar[XB_XCNT(j)]); sum += c; cnt += (c > 0u) ? 1u : 0u; mine = (j == x) ? c : mine; }
        if (sum == G) break;
        __builtin_amdgcn_s_sleep(1);
        if ((++sp & 255u) == 0u) { if (xb_ld(&bar[XB_TMO])) break; if (sp > XB_SPIN_CAP) { atomicAdd(&bar[XB_TMO], 1u); break; } }
    }
    nloc = mine > 0u ? mine : 1u; nx = cnt > 0u ? cnt : 1u;
}

__device__ __forceinline__ void xcd_barrier(const XcdBarrier& b) {
    asm volatile("s_waitcnt vmcnt(0)" ::: "memory");
    __syncthreads();
    if (threadIdx.x == 0) {
        unsigned* bar = b.bar;
        __builtin_amdgcn_s_waitcnt(0);
        unsigned nloc = b.st[0], nx = b.st[1];
        if (nloc == 0u) { xcd_barrier_complete(bar, b.x, nloc, nx); b.st[0] = nloc; b.st[1] = nx; }
        const unsigned old = xb_add(&bar[XB_XSUB(b.x)], 1u);
        const unsigned gen = old / nloc;
        if (old + 1u == (gen + 1u) * nloc) {
            __builtin_amdgcn_fence(__ATOMIC_RELEASE, "agent");
            asm volatile("s_waitcnt vmcnt(0)" ::: "memory");
            const unsigned og = xb_add(&bar[XB_TOP], 1u);
            const unsigned tg = og / nx;
            if (og + 1u == (tg + 1u) * nx) xb_add(&bar[XB_TOPGEN], 1u);
            else XB_SPIN(xb_ld(&bar[XB_TOPGEN]) == tg, bar);
            __builtin_amdgcn_fence(__ATOMIC_ACQUIRE, "agent");
            xb_add(&bar[XB_XGEN(b.x)], 1u);
            asm volatile("s_waitcnt vmcnt(0)" ::: "memory");
        } else {
            XB_SPIN(xb_ld(&bar[XB_XGEN(b.x)]) == gen, bar);
            __builtin_amdgcn_fence(__ATOMIC_ACQUIRE, "agent");
            asm volatile("s_waitcnt vmcnt(0)" ::: "memory");
        }
    }
    __syncthreads();
}

#ifndef PHMASK
#define PHMASK 0xFFFF
#endif
#ifndef DUPMASK
#define DUPMASK 0
#endif
#define PH(k) _Pragma("unroll 1") for (int rep_ = 0; rep_ < ((((PHMASK >> (k)) & 1) ? 1 : 0) + (((DUPMASK >> (k)) & 1) ? 1 : 0)); ++rep_)
#define GRID_BAR() do { XcdBarrier b_; b_.bar = (unsigned*)pws(pt); b_.x = xb_xcc_id(); b_.st = (volatile LAS unsigned*)(lds + LDS_BYTES - 512); xcd_barrier(b_); } while (0)
#ifndef TMASK
#define TMASK 0
#endif
#define TS_BEGIN(k) do { if (((TMASK >> (k)) & 1) && bx == 0 && tid == 0) { const unsigned long long t_ = __builtin_amdgcn_s_memrealtime(); *(volatile LAS unsigned*)(lds + LDS_BYTES - 128) = (unsigned)t_; } } while (0)
#define TS_END(k) do { if (((TMASK >> (k)) & 1) && bx == 0 && tid == 0) { const unsigned t_ = (unsigned)__builtin_amdgcn_s_memrealtime(); volatile LAS unsigned* a_ = (volatile LAS unsigned*)(lds + LDS_BYTES - 128); a_[1] += t_ - a_[0]; } } while (0)
#ifndef STAG
#define STAG 0
#endif
#define STAGGER(step_10ns) do { if (STAG) { const unsigned sg_ = ((unsigned)bx >> 3) & 1u; if (sg_) { const unsigned long long t0_ = __builtin_amdgcn_s_memrealtime(); \
        while (__builtin_amdgcn_s_memrealtime() - t0_ < (unsigned long long)(sg_ * (step_10ns))) __builtin_amdgcn_s_sleep(16); } __syncthreads(); } } while (0)
#define RB_ ((bf16_t*)(pws(pt) + WS_RB))
#define RLO_ ((bf16_t*)pout(pt) + (size_t)M_TOK * 1024)
#define RLOF_ ((bf16_t*)(pws(pt) + WS_RLO))
#define RBC_ ((bf16_t*)(pws(pt) + WS_BIG + 128 * MiB))
#define SS_(k) ((float*)(pws(pt) + WS_SSP) + (size_t)(k) * M_TOK * 4)
__global__ void __launch_bounds__(512, 2) fwd_kernel(Params P) {
    extern __shared__ __attribute__((aligned(16))) unsigned char lds_raw[];
    LAS unsigned char* lds = (LAS unsigned char*)lds_raw;
    cg::grid_group grid = cg::this_grid();
    const int tid = threadIdx.x, lane = tid & 63, wave = __builtin_amdgcn_readfirstlane(tid >> 6);
    const int G = gridDim.x, bx = blockIdx.x; const int gw = bx * 8 + wave, NGW = G * 8;
    PT pt = (PT)(lds + LDS_BYTES - 256);
    volatile LAS unsigned* xst = (volatile LAS unsigned*)(lds + LDS_BYTES - 512);
    if (tid == 0) { xst[0] = 0u; xst[1] = 0u; if (TMASK) { ((volatile LAS unsigned*)(lds + LDS_BYTES - 128))[1] = 0u; }
#pragma unroll
        for (int i = 0; i < 28; ++i) { const unsigned long long v = (unsigned long long)P.in[i]; pt[2 * i] = (unsigned)v; pt[2 * i + 1] = (unsigned)(v >> 32); }
        { const unsigned long long v = (unsigned long long)P.out; pt[56] = (unsigned)v; pt[57] = (unsigned)(v >> 32); }
        { const unsigned long long v = (unsigned long long)P.ws; pt[58] = (unsigned)v; pt[59] = (unsigned)(v >> 32); }
    }
    __syncthreads();
    (void)xcd_barrier_post((unsigned*)P.ws, xst);

    TS_BEGIN(0);
    PH(0) prologue(pt, lds, gw, NGW, lane, wave);
    __syncthreads();
    grid.sync(); TS_END(0);

#pragma unroll 1
    for (int layer = 0; layer < NL; ++layer) {
        TS_BEGIN(1); PH(1) { pg8::Gemm g{RB_, (const bf16_t*)(pws(pt) + WS_WIN) + (size_t)layer * 3328 * 1024, M_TOK, 3328, 1024}; pg8::StaticOrder S; S.init(M_TOK, 3328, G, bx);
          EpiStore E{SS_(3 * layer), {(bf16_t*)(pws(pt) + WS_PQKV), (bf16_t*)(pws(pt) + WS_PLX), (bf16_t*)(pws(pt) + WS_PZ), (bf16_t*)(pws(pt) + WS_PLG)}, {1536, 512, 512, 512}, {0, 6, 8, 10}, (float*)(pws(pt) + WS_GATES), 12};
          pg8::gemm_phase<EpiStore, pg8::StaticOrder, true, true>(lds, g, S, E);
          int tl = tid; asm volatile("" : "+v"(tl));
          const f32x4* ps = (const f32x4*)(pin(pt, I_P) + (size_t)layer * M_TOK * PLE); u32x2* pd = (u32x2*)(pws(pt) + WS_PB);
          for (size_t i = (size_t)bx * 512 + tl; i < (size_t)M_TOK * PLE / 4; i += (size_t)G * 512) pd[i] = pk4(ps[i]);
          }
        GRID_BAR(); TS_END(1);
        TS_BEGIN(2); PH(2) for (int bi = bx; bi < 256; bi += G) lru_block(pt, lds, bi, layer, tid);
        PH(3) { __syncthreads();
          { int tl = tid; asm volatile("" : "+v"(tl)); const int hh = (bx >> 5) & 3; const float* cwg = pin(pt, I_DNCW) + (size_t)layer * 4 * 1536;
            for (int e = tl; e < 1536; e += 512) { const int mat = e >> 9, tap = (e >> 7) & 3, ch = e & 127; ((LAS float*)(lds + DP_CWL))[e] = cwg[tap * 1536 + mat * 512 + hh * 128 + ch]; } }
          for (int it = bx; it < 4096; it += G) dp_item(pt, lds, it, layer, tid, lane, wave); }
        GRID_BAR(); TS_END(2);
        TS_BEGIN(4); PH(4) for (int it = bx; it < 256; it += G) dr_item(pt, lds, it, tid, lane, wave);
        GRID_BAR(); TS_END(4);
        TS_BEGIN(6); PH(6) m2_rows(pt, layer, gw, NGW, lane);
        GRID_BAR(); TS_END(6);
        TS_BEGIN(7); PH(7) { STAGGER(3700); pg8::Gemm g{(const bf16_t*)(pws(pt) + WS_AMIX), (const bf16_t*)(pws(pt) + WS_WOUT) + (size_t)layer * DM * DM, M_TOK, 1024, 1024}; pg8::StaticOrder S; S.init(M_TOK, 1024, G, bx);
          EpiResid<0> E{nullptr, RB_, RLO_, RLO_, SS_(3 * layer + 1), nullptr, nullptr, nullptr, nullptr, (LAS float*)(lds + 131072)};
          pg8::gemm_phase<EpiResid<0>, pg8::StaticOrder, true, true>(lds, g, S, E); }
        GRID_BAR(); TS_END(7);
        TS_BEGIN(9); PH(9) { pg8::Gemm g{RB_, (const bf16_t*)(pws(pt) + WS_WG) + (size_t)layer * 5632 * 1024, M_TOK, 5632, 1024}; pg8::StaticOrder S; S.init(M_TOK, 5632, G, bx);
          EpiGluF E{SS_(3 * layer + 1), (float*)(pws(pt) + WS_G), (float*)(pws(pt) + WS_G) + (size_t)256 * 4 * FF, pin(pt, I_FCW) + (size_t)layer * 3 * FF, pin(pt, I_FCB) + (size_t)layer * FF, (bf16_t*)(pws(pt) + WS_ACT), (LAS float*)(lds + 135168)};
          pg8::gemm_phase<EpiGluF, pg8::StaticOrder, true, true>(lds, g, S, E); }
        GRID_BAR(); TS_END(9);
        TS_BEGIN(8); PH(8) glu_fixup(pt, layer, bx, G, tid);
        GRID_BAR(); TS_END(8);
        TS_BEGIN(10); PH(10) { STAGGER(4800); pg8::Gemm g{(const bf16_t*)(pws(pt) + WS_ACT), (const bf16_t*)(pws(pt) + WS_WD) + (size_t)layer * DM * FF, M_TOK, 1024, FF}; pg8::StaticOrder S; S.init(M_TOK, 1024, G, bx);
          EpiResid<0> E{nullptr, RB_, RLO_, RLO_, SS_(3 * layer + 2), nullptr, nullptr, nullptr, RBC_, (LAS float*)(lds + 131072)};
          pg8::gemm_phase<EpiResid<0>, pg8::StaticOrder, true, true>(lds, g, S, E); }
        __syncthreads();
        PH(11) { pg8::Gemm g{(const bf16_t*)(pws(pt) + WS_PB), (const bf16_t*)(pws(pt) + WS_WP) + (size_t)layer * DM * PLE, M_TOK, 1024, PLE}; pg8::StaticOrder S; S.init(M_TOK, 1024, G, bx);
          EpiStore E{nullptr, {(bf16_t*)(pws(pt) + WS_PP), nullptr, nullptr, nullptr}, {1024, 0, 0, 0}, {0, 99, 99, 99}, nullptr, 99};
          pg8::gemm_phase<EpiStore, pg8::StaticOrder, true, true>(lds, g, S, E); }
        GRID_BAR(); TS_END(10);
        TS_BEGIN(12); PH(12) { STAGGER(3000); pg8::Gemm g{RBC_, (const bf16_t*)(pws(pt) + WS_WPG) + (size_t)layer * DM * DM, M_TOK, 1024, 1024}; pg8::StaticOrder S; S.init(M_TOK, 1024, G, bx);
          EpiResid<1> E{nullptr, RB_, RLO_, layer == NL - 1 ? RLOF_ : RLO_, SS_(3 * layer + 3), SS_(3 * layer + 2), pin(pt, I_PBG) + (size_t)layer * DM, (const bf16_t*)(pws(pt) + WS_PP), nullptr, (LAS float*)(lds + 131072)};
          pg8::gemm_phase<EpiResid<1>, pg8::StaticOrder, true, true>(lds, g, S, E); }
        GRID_BAR(); TS_END(12);
    }
    TS_BEGIN(13);
    { int tlf = tid; asm volatile("" : "+v"(tlf)); const int lane = tlf & 63;
      const float* ssF = SS_(12); const f32x4* fg = (const f32x4*)pin(pt, I_FING) + lane; const bf16_t* hi_ = RB_; const bf16_t* lo_ = RLOF_; float* outp = pout(pt);
      for (int m = gw; m < M_TOK; m += NGW) { const float sc = rs_of(ssF, m); f32x4* xr = (f32x4*)(outp + (size_t)m * DM) + lane;
          const u32x2* hr = (const u32x2*)(hi_ + (size_t)m * DM) + lane; const u32x2* lr = (const u32x2*)(lo_ + (size_t)m * DM) + lane;
#pragma unroll
          for (int j = 0; j < 4; ++j) { const u32x2 h = hr[64 * j], l = lr[64 * j]; const f32x4 g = fg[64 * j];
              f32x4 v; v[0] = (bflo(h.x) + bflo(l.x)) * sc * g[0]; v[1] = (bfhi(h.x) + bfhi(l.x)) * sc * g[1]; v[2] = (bflo(h.y) + bflo(l.y)) * sc * g[2]; v[3] = (bfhi(h.y) + bfhi(l.y)) * sc * g[3];
              xr[64 * j] = v; } } }
    if (TMASK) { __syncthreads(); TS_END(13); if (bx == 0 && tid == 0) { const unsigned wait_ = ((volatile LAS unsigned*)(lds + LDS_BYTES - 128))[1]; const unsigned long long t0_ = __builtin_amdgcn_s_memrealtime(); while (__builtin_amdgcn_s_memrealtime() - t0_ < (unsigned long long)wait_) __builtin_amdgcn_s_sleep(8); } }
}

extern "C" void kernel_launch(void* const* d_in, const int* in_sizes, int n_in, void* d_out, int out_size, void* d_ws, size_t ws_size, hipStream_t stream) {
    static int grid = 0;
    if (grid == 0) {
        if (n_in != 28 || ws_size < WS_END) { fprintf(stderr, "kernel_launch: unexpected n_in %d or workspace %zu < %zu\n", n_in, ws_size, (size_t)WS_END); grid = -1; return; }
        int dev = 0, cus = 0, per_cu = 0;
        hipGetDevice(&dev); hipDeviceGetAttribute(&cus, hipDeviceAttributeMultiprocessorCount, dev);
        if (hipFuncSetAttribute((const void*)fwd_kernel, hipFuncAttributeMaxDynamicSharedMemorySize, LDS_BYTES) != hipSuccess) fprintf(stderr, "kernel_launch: hipFuncSetAttribute failed\n");
        if (hipOccupancyMaxActiveBlocksPerMultiprocessor(&per_cu, (const void*)fwd_kernel, 512, LDS_BYTES) != hipSuccess || per_cu < 1) { fprintf(stderr, "kernel_launch: occupancy query says %d\n", per_cu); per_cu = 1; }
        (void)hipGetLastError();
        grid = cus * per_cu; if (grid > 256) grid = 256;
    }
    if (grid < 0) return;
    if (hipMemsetAsync(d_ws, 0, 16384, stream) != hipSuccess) { fprintf(stderr, "kernel_launch: memset of the barrier words failed\n"); return; }
    Params p{};
    for (int i = 0; i < 28; ++i) p.in[i] = (const float*)d_in[i];
    p.out = (float*)d_out; p.ws = (unsigned char*)d_ws;
    void* args[] = {&p};
    hipError_t e = hipLaunchCooperativeKernel((const void*)fwd_kernel, dim3(grid), dim3(512), args, LDS_BYTES, stream);
    if (e != hipSuccess) fprintf(stderr, "cooperative launch failed: %s (grid %d)\n", hipGetErrorString(e), grid);
}
```

```cpp
#include <hip/hip_runtime.h>
#include <hip/hip_cooperative_groups.h>
#include <cstdio>
#include <cstdint>
namespace cg = cooperative_groups;

#define LAS __attribute__((address_space(3)))
typedef unsigned short bf16_t;
typedef short bf16x8 __attribute__((ext_vector_type(8)));
typedef short s16x4 __attribute__((ext_vector_type(4)));
typedef float f32x2 __attribute__((ext_vector_type(2)));
typedef float f32x4 __attribute__((ext_vector_type(4)));
typedef float f32x16 __attribute__((ext_vector_type(16)));
typedef unsigned u32x4 __attribute__((ext_vector_type(4)));
typedef unsigned u32x2 __attribute__((ext_vector_type(2)));
typedef __bf16 bfx2_t __attribute__((ext_vector_type(2)));

constexpr int M_TOK = 65536, DM = 1024, SEQ = 2048, NB = 32, NL = 4;
constexpr int FF = 2816, PLE = 256, INC = 3088;
constexpr float EPS = 1e-6f;

constexpr size_t MiB = 1u << 20;
constexpr size_t WS_SS = 0;
constexpr size_t WS_WIN = 4 * MiB;
constexpr size_t WS_WOUT = WS_WIN + 26 * MiB;
constexpr size_t WS_WG = WS_WOUT + 8 * MiB;
constexpr size_t WS_WU = WS_WG + 22 * MiB;
constexpr size_t WS_WD = WS_WU + 22 * MiB;
constexpr size_t WS_WPG = WS_WD + 22 * MiB;
constexpr size_t WS_WP = WS_WPG + 8 * MiB;
constexpr size_t WS_WAT = WS_WP + 2 * MiB;
constexpr size_t WS_GATES = WS_WAT + 1 * MiB;
constexpr size_t WS_VEC = WS_GATES + 4 * MiB;
constexpr size_t WS_PB = WS_VEC + 8 * MiB;
constexpr size_t WS_RB = WS_PB + 32 * MiB;
constexpr size_t WS_BIG = WS_RB + 128 * MiB;
constexpr size_t WS_PQKV = WS_BIG;
constexpr size_t WS_OF = WS_BIG, WS_OB = WS_BIG + 64 * MiB, WS_PZ = WS_BIG + 576 * MiB;
constexpr size_t WS_PLX = WS_BIG + 192 * MiB, WS_PLG = WS_BIG + 640 * MiB;
constexpr size_t WS_QH = WS_BIG + 256 * MiB, WS_KH = WS_BIG + 320 * MiB, WS_VT = WS_BIG + 384 * MiB;
constexpr size_t WS_TM = WS_BIG + 448 * MiB, WS_AT = WS_BIG + 512 * MiB;
constexpr size_t WS_RLO = WS_BIG + 576 * MiB;
constexpr size_t WS_AMIX = WS_BIG + 256 * MiB;
constexpr size_t WS_G = WS_BIG, WS_ACT = WS_BIG + 352 * MiB, WS_PP = WS_BIG;
constexpr size_t WS_SSP = WS_BIG + 704 * MiB;
constexpr size_t WS_END = WS_SSP + 13 * MiB;
constexpr int LDS_BYTES = 153600;

__device__ __forceinline__ unsigned pk2(float lo, float hi) { f32x2 v = {lo, hi}; bfx2_t b = __builtin_convertvector(v, bfx2_t); return __builtin_bit_cast(unsigned, b); }
__device__ __forceinline__ u32x2 pk4(f32x4 v) { u32x2 r; r.x = pk2(v[0], v[1]); r.y = pk2(v[2], v[3]); return r; }
__device__ __forceinline__ float bflo(unsigned w) { return __uint_as_float(w << 16); }
__device__ __forceinline__ float bfhi(unsigned w) { return __uint_as_float(w & 0xffff0000u); }
__device__ __forceinline__ float bf2f(unsigned short b) { return __uint_as_float((unsigned)b << 16); }
__device__ __forceinline__ float fexp(float x) { return __builtin_amdgcn_exp2f(x * 1.4426950408889634f); }
__device__ __forceinline__ float sigm(float x) { return __builtin_amdgcn_rcpf(1.0f + fexp(-x)); }
__device__ __forceinline__ float gelu_t(float x) { const float u = 1.5957691216057308f * (x + 0.044715f * x * x * x); return x * __builtin_amdgcn_rcpf(1.0f + fexp(-u)); }
__device__ __forceinline__ float softplus_f(float x) { return x > 20.f ? x : log1pf(expf(x)); }
__device__ __forceinline__ int swz128(int row, int col) { return row * 256 + ((((col >> 3) ^ (row & 15)) << 4) | ((col & 7) << 1)); }
__device__ __forceinline__ int swz64(int row, int col) { return row * 128 + ((((col >> 3) ^ (row & 7)) << 4) | ((col & 7) << 1)); }
__device__ __forceinline__ int crow(int r, int hi) { return (r & 3) + 8 * (r >> 2) + 4 * hi; }
#define MFMA16(a, b, c) __builtin_amdgcn_mfma_f32_16x16x32_bf16((a), (b), (c), 0, 0, 0)
#define MFMA32(a, b, c) __builtin_amdgcn_mfma_f32_32x32x16_bf16((a), (b), (c), 0, 0, 0)
typedef unsigned long long u64;
__device__ __forceinline__ float rs_of(const float* ss4, int row) { const f32x4 p = *(const f32x4*)(ss4 + (size_t)row * 4); return rsqrtf(((p[0] + p[1]) + (p[2] + p[3])) * (1.0f / 1024.0f) + EPS); }
#define LDS_FENCE() asm volatile("s_waitcnt lgkmcnt(0)" ::: "memory")

#define LBAR() do { asm volatile("s_waitcnt lgkmcnt(0)" ::: "memory"); __builtin_amdgcn_s_barrier(); asm volatile("" ::: "memory"); } while (0)

namespace pg8 {
#define PG8_LAS __attribute__((address_space(3)))
typedef unsigned short bf16_t;
typedef short bf16x8 __attribute__((ext_vector_type(8)));
typedef float f32x4 __attribute__((ext_vector_type(4)));
typedef unsigned u32x4 __attribute__((ext_vector_type(4)));
constexpr int BM = 256, BK = 64, HALF = 128, HTB = HALF * BK * 2  , STAGE_BYTES = 8 * HTB, NXCD = 8, WGM = 8;

__host__ __device__ __forceinline__ int lds_byte(int r, int c) { const int st = (r >> 4) * 2 + (c >> 5), rr = r & 15, cc = c & 31, ob = rr * 64 + cc * 2; return st * 1024 + (ob ^ (((ob >> 9) & 1) << 5)); }
__host__ __device__ __forceinline__ void stage_rc(int b, int& R, int& C) { const int st = b / 1024, sb = b % 1024, swz = sb ^ (((sb >> 9) & 1) << 5); R = (st >> 1) * 16 + swz / 64; C = (st & 1) * 32 + (swz % 64) / 2; }
__host__ __device__ __forceinline__ int perm32(int rho) { const int n = rho >> 4, i = rho & 15; return 8 * (i >> 2) + 4 * n + (i & 3); }

struct Unit { int pm, pn; };
struct Gemm { const bf16_t* A; const bf16_t* Bt; int M, N, K; };

struct StaticOrder {
    int nM, nN, nwg, G, c;
    __host__ __device__ void init(int M, int N, int G_, int c_) { nM = M / BM; nN = N / BM; nwg = nM * nN; G = G_; c = c_; }
    __host__ __device__ bool next(int i, Unit& u) const {
        const long L = (long)i * G + c; if (L >= nwg) return false;
        int wgid = (int)L; { const int q = nwg / NXCD, r = nwg % NXCD, xcd = wgid % NXCD, off = wgid / NXCD; wgid = (xcd < r ? xcd * (q + 1) : r * (q + 1) + (xcd - r) * q) + off; }
        const int nig = WGM * nN, gid = wgid / nig, fm = gid * WGM, gsz = (nM - fm) < WGM ? (nM - fm) : WGM;
        u.pm = fm + ((wgid % nig) % gsz); u.pn = (wgid % nig) / gsz; return true;
    }
    __device__ __forceinline__ void a_ready(const Unit&) const {}
    __device__ __forceinline__ void done(const Unit&) const {}
};

template <class Epi, class Sched, bool ALIGN_EPI = false, bool SP2 = false>
__device__ __forceinline__ void gemm_phase(PG8_LAS unsigned char* lds, const Gemm g, const Sched& S, const Epi& E) {
    int tid_ = threadIdx.x; asm volatile("" : "+v"(tid_));
    const int tid = tid_, wid = __builtin_amdgcn_readfirstlane(tid >> 6), lane = tid & 63, wr = wid >> 2, wc = wid & 3, fr = lane & 15, fq = lane >> 4;
    const int K = g.K, nt = K / BK;
    unsigned voffA[2], voffB[2];
#pragma unroll
    for (int i = 0; i < 2; ++i) { int R, C; stage_rc(tid * 16 + i * 8192, R, C); const int Rb = Epi::PERM ? ((R & ~31) + perm32(R & 31)) : R;
        voffA[i] = (unsigned)(R * K + C) * 2u; voffB[i] = (unsigned)(Rb * K + C) * 2u; }
    const size_t kstep = (size_t)(BK * 2);
    const size_t hstep = (size_t)HALF * K * 2;
    const size_t tstep = 2 * hstep;
    const unsigned ldsw = (unsigned)wid * 1024u;
    const int aoff = lds_byte(wr * 64 + fr, fq * 8), boff = lds_byte(wc * 32 + fr, fq * 8);
#define PG8_SA(b, h) (((b) * 2 + (h)) * HTB)
#define PG8_SB(b, h) ((4 + (b) * 2 + (h)) * HTB)
#define PG8_STAGE(bufoff, gbase, voff) do { _Pragma("unroll") for (int _i = 0; _i < 2; ++_i) \
        __builtin_amdgcn_global_load_lds((const unsigned*)((const char*)(gbase) + (voff)[_i]), (PG8_LAS unsigned*)(lds + (bufoff) + ldsw + _i * 8192), 16, 0, 0); } while (0)
#define PG8_LDA(dst, b, h) do { _Pragma("unroll") for (int m = 0; m < 4; ++m) _Pragma("unroll") for (int k = 0; k < 2; ++k) dst[m][k] = *(const PG8_LAS bf16x8*)(lds + PG8_SA(b, h) + aoff + m * 2048 + k * 1024); } while (0)
#define PG8_LDB(dst, b, h) do { _Pragma("unroll") for (int n = 0; n < 2; ++n) _Pragma("unroll") for (int k = 0; k < 2; ++k) dst[n][k] = *(const PG8_LAS bf16x8*)(lds + PG8_SB(b, h) + boff + n * 2048 + k * 1024); } while (0)
#define PG8_MMA(ai, bj, At, Bt) do { __builtin_amdgcn_s_setprio(1); _Pragma("unroll") for (int m = 0; m < 4; ++m) _Pragma("unroll") for (int n = 0; n < 2; ++n) _Pragma("unroll") for (int k = 0; k < 2; ++k) \
        acc[ai][bj][m][n] = __builtin_amdgcn_mfma_f32_16x16x32_bf16(Bt[n][k], At[m][k], acc[ai][bj][m][n], 0, 0, 0); __builtin_amdgcn_s_setprio(0); } while (0)
#define PG8_WAIT_V(n) asm volatile("s_waitcnt vmcnt(" #n ")" ::: "memory")
#define PG8_WAIT_L(n) asm volatile("s_waitcnt lgkmcnt(" #n ")" ::: "memory")
#define PG8_BAR __builtin_amdgcn_s_barrier()
#define PG8_SCHED __builtin_amdgcn_sched_barrier(0)
    Unit cur, nxt; int ui = 0;
    if (!S.next(0, cur)) return;
    f32x4 acc[2][2][4][2];
#pragma unroll
    for (int a = 0; a < 2; ++a)
#pragma unroll
        for (int b = 0; b < 2; ++b)
#pragma unroll
            for (int m = 0; m < 4; ++m)
#pragma unroll
                for (int n = 0; n < 2; ++n) acc[a][b][m][n] = (f32x4){0.f, 0.f, 0.f, 0.f};
    bf16x8 At[4][2], B0[2][2], B1[2][2];
    const char* cA = (const char*)g.A + (size_t)cur.pm * tstep; const char* cB = (const char*)g.Bt + (size_t)cur.pn * tstep;
    S.a_ready(cur);
    if constexpr (SP2) {
        PG8_STAGE(PG8_SB(0, 0), cB, voffB); PG8_STAGE(PG8_SB(0, 1), cB + hstep, voffB); PG8_STAGE(PG8_SA(0, 0), cA, voffA); PG8_STAGE(PG8_SA(0, 1), cA + hstep, voffA);
        if (wr == 1) PG8_BAR;
        PG8_WAIT_V(2); PG8_BAR;
        PG8_STAGE(PG8_SB(1, 0), cB + kstep, voffB); PG8_STAGE(PG8_SA(1, 0), cA + kstep, voffA); PG8_STAGE(PG8_SB(1, 1), cB + hstep + kstep, voffB);
        PG8_WAIT_V(6); PG8_BAR;
    } else {
        PG8_STAGE(PG8_SB(0, 0), cB, voffB); PG8_STAGE(PG8_SA(0, 0), cA, voffA); PG8_STAGE(PG8_SB(0, 1), cB + hstep, voffB); PG8_STAGE(PG8_SA(0, 1), cA + hstep, voffA);
        if (wr == 1) PG8_BAR;
        PG8_WAIT_V(4); PG8_BAR;
        PG8_STAGE(PG8_SB(1, 0), cB + kstep, voffB); PG8_STAGE(PG8_SA(1, 0), cA + kstep, voffA); PG8_STAGE(PG8_SB(1, 1), cB + hstep + kstep, voffB);
        PG8_WAIT_V(6); PG8_BAR;
    }
    for (;;) {
        const bool has_next = S.next(ui + 1, nxt);
        const char* nA = has_next ? (const char*)g.A + (size_t)nxt.pm * tstep : cA; const char* nB = has_next ? (const char*)g.Bt + (size_t)nxt.pn * tstep : cB;
        for (int t = 0; t < nt; t += 2) {
            const bool last = (t == nt - 2);
            const char* a1 = cA + (size_t)(t + 1) * kstep;
            const char* a2 = last ? nA : cA + (size_t)(t + 2) * kstep; const char* b2 = last ? nB : cB + (size_t)(t + 2) * kstep;
            const char* a3 = a2 + kstep; const char* b3 = b2 + kstep;
            if (last && has_next) S.a_ready(nxt);
            if constexpr (SP2) {
            PG8_LDB(B0, 0, 0); PG8_LDB(B1, 0, 1); PG8_SCHED; PG8_LDA(At, 0, 0); PG8_STAGE(PG8_SA(1, 1), a1 + hstep, voffA);
            PG8_WAIT_V(8); PG8_WAIT_L(0); PG8_BAR; PG8_MMA(0, 0, At, B0); PG8_MMA(0, 1, At, B1); PG8_BAR; PG8_SCHED;
            PG8_LDA(At, 0, 1); PG8_STAGE(PG8_SB(0, 0), b2, voffB); PG8_STAGE(PG8_SB(0, 1), b2 + hstep, voffB); PG8_STAGE(PG8_SA(0, 0), a2, voffA);
            PG8_WAIT_V(8); PG8_WAIT_L(0); PG8_BAR; PG8_MMA(1, 0, At, B0); PG8_MMA(1, 1, At, B1); PG8_BAR; PG8_SCHED;
            PG8_LDB(B0, 1, 0); PG8_LDB(B1, 1, 1); PG8_SCHED; PG8_LDA(At, 1, 0); PG8_STAGE(PG8_SA(0, 1), a2 + hstep, voffA);
            PG8_WAIT_V(8); PG8_WAIT_L(0); PG8_BAR; PG8_MMA(0, 0, At, B0); PG8_MMA(0, 1, At, B1); PG8_BAR; PG8_SCHED;
            PG8_LDA(At, 1, 1); PG8_STAGE(PG8_SB(1, 0), b3, voffB); PG8_STAGE(PG8_SB(1, 1), b3 + hstep, voffB); PG8_STAGE(PG8_SA(1, 0), a3, voffA);
            PG8_WAIT_V(8); PG8_WAIT_L(0); PG8_BAR; PG8_MMA(1, 0, At, B0); PG8_MMA(1, 1, At, B1); PG8_BAR; PG8_SCHED;
            } else {
            PG8_LDB(B0, 0, 0); PG8_SCHED; PG8_LDA(At, 0, 0); PG8_STAGE(PG8_SA(1, 1), a1 + hstep, voffA);
            PG8_WAIT_L(8); PG8_BAR; PG8_WAIT_L(0); PG8_MMA(0, 0, At, B0); PG8_BAR; PG8_SCHED;
            PG8_LDB(B1, 0, 1); PG8_STAGE(PG8_SB(0, 0), b2, voffB);
            PG8_BAR; PG8_WAIT_L(0); PG8_MMA(0, 1, At, B1); PG8_BAR;
            PG8_LDA(At, 0, 1); PG8_STAGE(PG8_SA(0, 0), a2, voffA);
            PG8_BAR; PG8_WAIT_L(0); PG8_MMA(1, 0, At, B0); PG8_BAR; PG8_SCHED;
            PG8_STAGE(PG8_SB(0, 1), b2 + hstep, voffB);
            PG8_WAIT_V(6); PG8_BAR; PG8_MMA(1, 1, At, B1); PG8_BAR;
            PG8_LDB(B0, 1, 0); PG8_SCHED; PG8_LDA(At, 1, 0); PG8_STAGE(PG8_SA(0, 1), a2 + hstep, voffA);
            PG8_WAIT_L(8); PG8_BAR; PG8_WAIT_L(0); PG8_MMA(0, 0, At, B0); PG8_BAR; PG8_SCHED;
            PG8_LDB(B1, 1, 1); PG8_STAGE(PG8_SB(1, 0), b3, voffB);
            PG8_BAR; PG8_WAIT_L(0); PG8_MMA(0, 1, At, B1); PG8_BAR;
            PG8_LDA(At, 1, 1); PG8_STAGE(PG8_SA(1, 0), a3, voffA);
            PG8_BAR; PG8_WAIT_L(0); PG8_MMA(1, 0, At, B0); PG8_BAR; PG8_SCHED;
            PG8_STAGE(PG8_SB(1, 1), b3 + hstep, voffB);
            PG8_WAIT_V(6); PG8_BAR; PG8_MMA(1, 1, At, B1); PG8_BAR;
            }
        }
        if constexpr (ALIGN_EPI) { if (wr == 0) PG8_BAR; }
        if constexpr (!Epi::AFTER_DRAIN) { E(acc, cur, wr, wc, fr, fq); S.done(cur); }
        if (!has_next) break;
#pragma unroll
        for (int a = 0; a < 2; ++a)
#pragma unroll
            for (int b = 0; b < 2; ++b)
#pragma unroll
                for (int m = 0; m < 4; ++m)
#pragma unroll
                    for (int n = 0; n < 2; ++n) acc[a][b][m][n] = (f32x4){0.f, 0.f, 0.f, 0.f};
        cur = nxt; cA = nA; cB = nB; ++ui;
        if constexpr (ALIGN_EPI) { if (wr == 1) PG8_BAR; }
    }
    PG8_WAIT_V(0);
    if constexpr (!ALIGN_EPI) { if (wr == 0) PG8_BAR; }
    PG8_BAR;
    if constexpr (Epi::AFTER_DRAIN) { E.fused(acc, cur, wr, wc, fr, fq, lds, wid, lane); S.done(cur); }
#undef PG8_SA
#undef PG8_SB
#undef PG8_STAGE
#undef PG8_LDA
#undef PG8_LDB
#undef PG8_MMA
#undef PG8_WAIT_V
#undef PG8_WAIT_L
#undef PG8_BAR
#undef PG8_SCHED
}
}

using pg8::Unit;
struct EpiStore {
    static constexpr bool PERM = true, AFTER_DRAIN = false;
    const float* ss; bf16_t* base[4]; int ld[4]; int ts[4]; float* gates; int t2;
    __device__ __forceinline__ void operator()(const f32x4 (&acc)[2][2][4][2], const Unit& u, int wr, int wc, int fr, int fq) const {
        const int row0 = u.pm * 256 + wr * 64 + fr; const int pn = u.pn;
        if (pn >= t2) {
            if (wc == 0 && fq < 2) {
#pragma unroll
                for (int ai = 0; ai < 2; ++ai)
#pragma unroll
                    for (int m = 0; m < 4; ++m) { const int row = row0 + ai * 128 + m * 16; const float s = ss ? rs_of(ss, row) : 1.f;
                        float* gp = gates + (size_t)row * 16 + 8 * fq; *(f32x4*)gp = acc[ai][0][m][0] * s; *(f32x4*)(gp + 4) = acc[ai][0][m][1] * s; }
            }
            return;
        }
        int k = 0; if (pn >= ts[1]) k = 1; if (pn >= ts[2]) k = 2; if (pn >= ts[3]) k = 3;
        bf16_t* bsel = base[0]; int ldsel = ld[0], t0 = ts[0];
        if (k == 1) { bsel = base[1]; ldsel = ld[1]; t0 = ts[1]; } else if (k == 2) { bsel = base[2]; ldsel = ld[2]; t0 = ts[2]; } else if (k == 3) { bsel = base[3]; ldsel = ld[3]; t0 = ts[3]; }
        const int col0 = (pn - t0) * 256 + wc * 32 + 8 * fq;
#pragma unroll
        for (int ai = 0; ai < 2; ++ai)
#pragma unroll
            for (int m = 0; m < 4; ++m) { const int row = row0 + ai * 128 + m * 16; const float s = ss ? rs_of(ss, row) : 1.f;
                bf16_t* rowp = bsel + (size_t)row * ldsel + col0;
#pragma unroll
                for (int bj = 0; bj < 2; ++bj) { const f32x4 v0 = acc[ai][bj][m][0] * s, v1 = acc[ai][bj][m][1] * s;
                    u32x4 w; w.x = pk2(v0[0], v0[1]); w.y = pk2(v0[2], v0[3]); w.z = pk2(v1[0], v1[1]); w.w = pk2(v1[2], v1[3]);
                    *(u32x4*)(rowp + bj * 128) = w; } }
    }
};

#ifndef RES_BM
#define RES_BM 4
#endif
#ifndef RES1_BM
#define RES1_BM 2
#endif
template <int MODE> struct EpiResid {
    static constexpr bool PERM = true, AFTER_DRAIN = false;
    const float* rin32; bf16_t* rb; const bf16_t* rlo; bf16_t* rlo_w; float* ss_out; const float* ss_in; const float* bias; const bf16_t* pp; bf16_t* rb2; LAS float* sl;
    __device__ __forceinline__ void ld_r(size_t off, f32x4& r0, f32x4& r1) const {
        if (rin32) { r0 = *(const f32x4*)(rin32 + off); r1 = *(const f32x4*)(rin32 + off + 4); }
        else { const u32x4 h = *(const u32x4*)(rb + off), l = *(const u32x4*)(rlo + off);
            r0[0] = bflo(h.x) + bflo(l.x); r0[1] = bfhi(h.x) + bfhi(l.x); r0[2] = bflo(h.y) + bflo(l.y); r0[3] = bfhi(h.y) + bfhi(l.y);
            r1[0] = bflo(h.z) + bflo(l.z); r1[1] = bfhi(h.z) + bfhi(l.z); r1[2] = bflo(h.w) + bflo(l.w); r1[3] = bfhi(h.w) + bfhi(l.w); }
    }
    __device__ __forceinline__ float st_r(size_t off, const f32x4& r0, const f32x4& r1) const {
        u32x4 w; w.x = pk2(r0[0], r0[1]); w.y = pk2(r0[2], r0[3]); w.z = pk2(r1[0], r1[1]); w.w = pk2(r1[2], r1[3]);
        u32x4 l; l.x = pk2(r0[0] - bflo(w.x), r0[1] - bfhi(w.x)); l.y = pk2(r0[2] - bflo(w.y), r0[3] - bfhi(w.y)); l.z = pk2(r1[0] - bflo(w.z), r1[1] - bfhi(w.z)); l.w = pk2(r1[2] - bflo(w.w), r1[3] - bfhi(w.w));
        *(u32x4*)(rb + off) = w; *(u32x4*)(rlo_w + off) = l; if (rb2) *(u32x4*)(rb2 + off) = w;
        return (r0[0] * r0[0] + r0[1] * r0[1]) + (r0[2] * r0[2] + r0[3] * r0[3]) + (r1[0] * r1[0] + r1[1] * r1[1]) + (r1[2] * r1[2] + r1[3] * r1[3]);
    }
    __device__ __forceinline__ void operator()(const f32x4 (&acc)[2][2][4][2], const Unit& u, int wr, int wc, int fr, int fq) const {
        run<false>(acc, u, wr, wc, fr, fq);
    }
    template <bool F32IN> __device__ __forceinline__ void run(const f32x4 (&acc)[2][2][4][2], const Unit& u, int wr, int wc, int fr, int fq) const {
        const int row0 = u.pm * 256 + wr * 64 + fr; const int col0 = u.pn * 256 + wc * 32 + 8 * fq;
        float sqa[2][4] = {{0.f, 0.f, 0.f, 0.f}, {0.f, 0.f, 0.f, 0.f}}; float sina[2][4]; f32x4 bia[2][2];
#pragma unroll
        for (int ai = 0; ai < 2; ++ai)
#pragma unroll
            for (int m = 0; m < 4; ++m) sina[ai][m] = (MODE == 1) ? rs_of(ss_in, row0 + ai * 128 + m * 16) : 1.f;
#pragma unroll
        for (int bj = 0; bj < 2; ++bj) { bia[bj][0] = (f32x4){0.f, 0.f, 0.f, 0.f}; bia[bj][1] = (f32x4){0.f, 0.f, 0.f, 0.f};
            if (MODE == 1) { bia[bj][0] = *(const f32x4*)(bias + col0 + bj * 128); bia[bj][1] = *(const f32x4*)(bias + col0 + bj * 128 + 4); } }
        constexpr int RPB = (MODE == 1) ? 1 : 2;
        constexpr int NBAT = 16 / RPB;
        u32x4 ph[2][RPB], pl[2][RPB], pw[2][RPB];
#define RES_AI(b_) ((b_) / (8 / RPB))
#define RES_BJ(b_) (((b_) / (4 / RPB)) & 1)
#define RES_MH(b_) (((b_) % (4 / RPB)) * RPB)
#define RES_OFF(b_, m_) ((size_t)(row0 + RES_AI(b_) * 128 + (RES_MH(b_) + (m_)) * 16) * 1024 + col0 + RES_BJ(b_) * 128)
#define RES_LOAD(b_, buf_) do { _Pragma("unroll") for (int m_ = 0; m_ < RPB; ++m_) { const size_t off_ = RES_OFF(b_, m_); ph[buf_][m_] = *(const u32x4*)(rb + off_); pl[buf_][m_] = *(const u32x4*)(rlo + off_); \
            if (MODE == 1) pw[buf_][m_] = *(const u32x4*)(pp + off_); } } while (0)
        __builtin_amdgcn_sched_barrier(0);
        RES_LOAD(0, 0);
        __builtin_amdgcn_sched_barrier(0);
#pragma unroll
        for (int b = 0; b < NBAT; ++b) { const int buf = b & 1; const int ai = RES_AI(b), bj = RES_BJ(b), mh = RES_MH(b);
            if (b + 1 < NBAT) { RES_LOAD(b + 1, buf ^ 1); }
            __builtin_amdgcn_sched_barrier(0);
            const f32x4 b0 = bia[bj][0], b1 = bia[bj][1];
#pragma unroll
            for (int m = 0; m < RPB; ++m) { const size_t off = RES_OFF(b, m); const float si = sina[ai][mh + m]; const u32x4 h = ph[buf][m], l = pl[buf][m];
                f32x4 p0, p1;
                p0[0] = bflo(h.x) + bflo(l.x); p0[1] = bfhi(h.x) + bfhi(l.x); p0[2] = bflo(h.y) + bflo(l.y); p0[3] = bfhi(h.y) + bfhi(l.y);
                p1[0] = bflo(h.z) + bflo(l.z); p1[1] = bfhi(h.z) + bfhi(l.z); p1[2] = bflo(h.w) + bflo(l.w); p1[3] = bfhi(h.w) + bfhi(l.w);
                f32x4 a0 = acc[ai][bj][mh + m][0], a1 = acc[ai][bj][mh + m][1];
                if (MODE == 1) { const u32x4 w = pw[buf][m];
                    a0[0] = sigm(a0[0] * si + b0[0]) * bflo(w.x); a0[1] = sigm(a0[1] * si + b0[1]) * bfhi(w.x);
                    a0[2] = sigm(a0[2] * si + b0[2]) * bflo(w.y); a0[3] = sigm(a0[3] * si + b0[3]) * bfhi(w.y);
                    a1[0] = sigm(a1[0] * si + b1[0]) * bflo(w.z); a1[1] = sigm(a1[1] * si + b1[1]) * bfhi(w.z);
                    a1[2] = sigm(a1[2] * si + b1[2]) * bflo(w.w); a1[3] = sigm(a1[3] * si + b1[3]) * bfhi(w.w); }
                const f32x4 r0 = p0 + a0, r1 = p1 + a1;
                sqa[ai][mh + m] += st_r(off, r0, r1); }
            __builtin_amdgcn_sched_barrier(0);
        }
#undef RES_AI
#undef RES_BJ
#undef RES_MH
#undef RES_LOAD
#undef RES_OFF
#pragma unroll
        for (int ai = 0; ai < 2; ++ai)
#pragma unroll
            for (int m = 0; m < 4; ++m) { float q = sqa[ai][m]; q += __shfl_xor(q, 16); q += __shfl_xor(q, 32);
                if (fq == 0) sl[(ai * 128 + wr * 64 + m * 16 + fr) * 4 + wc] = q; }
        asm volatile("s_waitcnt lgkmcnt(0)" ::: "memory"); __builtin_amdgcn_s_barrier(); asm volatile("" ::: "memory");
        if (fq == 0) {
#pragma unroll
            for (int ai = 0; ai < 2; ++ai) { const int r = ai * 128 + wr * 64 + wc * 16 + fr; const f32x4 p = *(const LAS f32x4*)(sl + r * 4);
                ss_out[(size_t)(u.pm * 256 + r) * 4 + u.pn] = (p[0] + p[1]) + (p[2] + p[3]); } }
    }
};

#ifndef GLU_BM
#define GLU_BM 2
#endif
struct EpiGlu {
    static constexpr bool PERM = true, AFTER_DRAIN = false;
    const float* ss; const bf16_t* G; const float* cw; const float* cb; bf16_t* act;
    __device__ __forceinline__ void operator()(const f32x4 (&acc)[2][2][4][2], const Unit& u, int wr, int wc, int fr, int fq) const {
        const int row0 = u.pm * 256 + wr * 64 + fr; const int col0 = u.pn * 256 + wc * 32 + 8 * fq;
#pragma unroll
        for (int bj = 0; bj < 2; ++bj) { const int c = col0 + bj * 128;
            const f32x4 w0a = *(const f32x4*)(cw + c), w0b = *(const f32x4*)(cw + c + 4), w1a = *(const f32x4*)(cw + FF + c), w1b = *(const f32x4*)(cw + FF + c + 4);
            const f32x4 w2a = *(const f32x4*)(cw + 2 * FF + c), w2b = *(const f32x4*)(cw + 2 * FF + c + 4), bba = *(const f32x4*)(cb + c), bbb = *(const f32x4*)(cb + c + 4);
#pragma unroll
            for (int ai = 0; ai < 2; ++ai)
#pragma unroll
            for (int mh = 0; mh < 4; mh += GLU_BM) {
                u32x4 gmv[GLU_BM], glv[GLU_BM], gnv[GLU_BM]; float sv[GLU_BM];
#pragma unroll
                for (int m = 0; m < GLU_BM; ++m) { const int row = row0 + ai * 128 + (mh + m) * 16; const int t = row & (SEQ - 1); const bf16_t* gp = G + (size_t)row * FF + c;
                    gmv[m] = *(const u32x4*)gp; glv[m] = (u32x4){0u, 0u, 0u, 0u}; gnv[m] = (u32x4){0u, 0u, 0u, 0u};
                    if (t > 0) glv[m] = *(const u32x4*)(gp - FF);
                    if (t < SEQ - 1) gnv[m] = *(const u32x4*)(gp + FF);
                    sv[m] = rs_of(ss, row); }
#pragma unroll
                for (int m = 0; m < GLU_BM; ++m) { const int row = row0 + ai * 128 + (mh + m) * 16; const float s = sv[m]; const u32x4 gm = gmv[m], gl = glv[m], gn = gnv[m];
                    f32x4 ga, gb;
                    ga[0] = w0a[0] * bflo(gl.x) + w1a[0] * bflo(gm.x) + w2a[0] * bflo(gn.x) + bba[0];
                    ga[1] = w0a[1] * bfhi(gl.x) + w1a[1] * bfhi(gm.x) + w2a[1] * bfhi(gn.x) + bba[1];
                    ga[2] = w0a[2] * bflo(gl.y) + w1a[2] * bflo(gm.y) + w2a[2] * bflo(gn.y) + bba[2];
                    ga[3] = w0a[3] * bfhi(gl.y) + w1a[3] * bfhi(gm.y) + w2a[3] * bfhi(gn.y) + bba[3];
                    gb[0] = w0b[0] * bflo(gl.z) + w1b[0] * bflo(gm.z) + w2b[0] * bflo(gn.z) + bbb[0];
                    gb[1] = w0b[1] * bfhi(gl.z) + w1b[1] * bfhi(gm.z) + w2b[1] * bfhi(gn.z) + bbb[1];
                    gb[2] = w0b[2] * bflo(gl.w) + w1b[2] * bflo(gm.w) + w2b[2] * bflo(gn.w) + bbb[2];
                    gb[3] = w0b[3] * bfhi(gl.w) + w1b[3] * bfhi(gm.w) + w2b[3] * bfhi(gn.w) + bbb[3];
                    const f32x4 a0 = acc[ai][bj][mh + m][0] * s, a1 = acc[ai][bj][mh + m][1] * s;
                    u32x4 w; w.x = pk2(gelu_t(ga[0]) * a0[0], gelu_t(ga[1]) * a0[1]); w.y = pk2(gelu_t(ga[2]) * a0[2], gelu_t(ga[3]) * a0[3]);
                    w.z = pk2(gelu_t(gb[0]) * a1[0], gelu_t(gb[1]) * a1[1]); w.w = pk2(gelu_t(gb[2]) * a1[2], gelu_t(gb[3]) * a1[3]);
                    *(u32x4*)(act + (size_t)row * FF + c) = w; } } }
    }
};

__device__ __forceinline__ float dpp_up1(float x) { const int v = __builtin_bit_cast(int, x); return __builtin_bit_cast(float, __builtin_amdgcn_update_dpp(v, v, 0x111, 0xf, 0xf, false)); }
__device__ __forceinline__ float dpp_dn1(float x) { const int v = __builtin_bit_cast(int, x); return __builtin_bit_cast(float, __builtin_amdgcn_update_dpp(v, v, 0x101, 0xf, 0xf, false)); }
struct EpiGluF {
    static constexpr bool PERM = true, AFTER_DRAIN = false;
    const float* ss; float* sg; float* su; const float* cw; const float* cb; bf16_t* act; LAS float* ex;
    __device__ __forceinline__ void operator()(const f32x4 (&acc)[2][2][4][2], const Unit& u, int wr, int wc, int fr, int fq) const {
        const int row0 = u.pm * 256 + wr * 64 + fr; const int chl = wc * 32 + 8 * fq; const int chg = u.pn * 128 + chl;
        float rsm[2][4];
#pragma unroll
        for (int ai = 0; ai < 2; ++ai)
#pragma unroll
            for (int m = 0; m < 4; ++m) rsm[ai][m] = rs_of(ss, row0 + ai * 128 + m * 16);
        if (fr == 0 || fr == 15) {
#pragma unroll
            for (int ai = 0; ai < 2; ++ai)
#pragma unroll
                for (int m = 0; m < 4; ++m) { const int rgi = ai * 8 + wr * 4 + m; LAS float* e = ex + (2 * rgi + (fr == 15 ? 1 : 0)) * 128 + chl;
                    *(LAS f32x4*)e = acc[ai][0][m][0] * rsm[ai][m]; *(LAS f32x4*)(e + 4) = acc[ai][0][m][1] * rsm[ai][m]; } }
        asm volatile("s_waitcnt lgkmcnt(0)" ::: "memory"); __builtin_amdgcn_s_barrier(); asm volatile("" ::: "memory");
#pragma unroll
        for (int ai = 0; ai < 2; ++ai)
#pragma unroll
            for (int m = 0; m < 4; ++m) { const int row = row0 + ai * 128 + m * 16; const int rgi = ai * 8 + wr * 4 + m;
                int cq = chg; asm volatile("" : "+v"(cq));
                const f32x4 w0a = *(const f32x4*)(cw + cq), w0b = *(const f32x4*)(cw + cq + 4), w1a = *(const f32x4*)(cw + FF + cq), w1b = *(const f32x4*)(cw + FF + cq + 4);
                const f32x4 w2a = *(const f32x4*)(cw + 2 * FF + cq), w2b = *(const f32x4*)(cw + 2 * FF + cq + 4), bba = *(const f32x4*)(cb + cq), bbb = *(const f32x4*)(cb + cq + 4);
                const float sm = rsm[ai][m]; const float su = dpp_up1(sm), sd = dpp_dn1(sm);
                f32x4 gm0 = acc[ai][0][m][0] * sm, gm1 = acc[ai][0][m][1] * sm, gu0, gu1, gd0, gd1;
#pragma unroll
                for (int j = 0; j < 4; ++j) { gu0[j] = dpp_up1(acc[ai][0][m][0][j]) * su; gu1[j] = dpp_up1(acc[ai][0][m][1][j]) * su;
                    gd0[j] = dpp_dn1(acc[ai][0][m][0][j]) * sd; gd1[j] = dpp_dn1(acc[ai][0][m][1][j]) * sd; }
                if (fr == 0) {
                    if (rgi > 0) { const LAS float* e = ex + (2 * (rgi - 1) + 1) * 128 + chl; gu0 = *(const LAS f32x4*)e; gu1 = *(const LAS f32x4*)(e + 4); } }
                if (fr == 15) {
                    if (rgi < 15) { const LAS float* e = ex + (2 * (rgi + 1)) * 128 + chl; gd0 = *(const LAS f32x4*)e; gd1 = *(const LAS f32x4*)(e + 4); } }
                const f32x4 ga = w0a * gu0 + w1a * gm0 + w2a * gd0 + bba, gb = w0b * gu1 + w1b * gm1 + w2b * gd1 + bbb;
                const f32x4 a0 = acc[ai][1][m][0] * sm, a1 = acc[ai][1][m][1] * sm;
                u32x4 w; w.x = pk2(gelu_t(ga[0]) * a0[0], gelu_t(ga[1]) * a0[1]); w.y = pk2(gelu_t(ga[2]) * a0[2], gelu_t(ga[3]) * a0[3]);
                w.z = pk2(gelu_t(gb[0]) * a1[0], gelu_t(gb[1]) * a1[1]); w.w = pk2(gelu_t(gb[2]) * a1[2], gelu_t(gb[3]) * a1[3]);
                const bool first = (rgi == 0 && fr == 0), last = (rgi == 15 && fr == 15);
                if (!(first || last)) *(u32x4*)(act + (size_t)row * FF + chg) = w;
                if (rgi == 0 && fr <= 1) { float* d = sg + ((size_t)u.pm * 4 + fr) * FF + chg; *(f32x4*)d = gm0; *(f32x4*)(d + 4) = gm1; }
                if (rgi == 15 && fr >= 14) { float* d = sg + ((size_t)u.pm * 4 + (fr - 12)) * FF + chg; *(f32x4*)d = gm0; *(f32x4*)(d + 4) = gm1; }
                if (first || last) { float* d = this->su + ((size_t)u.pm * 2 + (last ? 1 : 0)) * FF + chg; *(f32x4*)d = a0; *(f32x4*)(d + 4) = a1; } }
    }
};

struct Params { const float* in[28]; float* out; unsigned char* ws; };
typedef LAS unsigned* PT;
__device__ __forceinline__ const float* pin(PT t0, int k) { unsigned ta = (unsigned)(size_t)t0; asm volatile("" : "+s"(ta)); const PT t = (PT)(size_t)ta;
    const unsigned lo = __builtin_amdgcn_readfirstlane(t[2 * k]), hi = __builtin_amdgcn_readfirstlane(t[2 * k + 1]); return (const float*)(__attribute__((address_space(1))) const float*)(((unsigned long long)hi << 32) | lo); }
__device__ __forceinline__ float* pout(PT t) { return (float*)pin(t, 28); }
__device__ __forceinline__ unsigned char* pws(PT t) { return (unsigned char*)pin(t, 29); }
enum { I_X = 0, I_P, I_N1G, I_WIN, I_DNCW, I_ALOG, I_DTB, I_DNG, I_LCW, I_LCB, I_LWA, I_LBA, I_LWX, I_LBX, I_LAM, I_LNG, I_WOUT, I_N2G, I_FWG, I_FWU, I_FCW, I_FCB, I_FWD, I_PNG, I_PWG, I_PBG, I_PWP, I_FING };

template <class RM>
__device__ __forceinline__ void tr_item(const float* W, int K, int N, bf16_t* WT, int ldt, const float* gk, const RM& rm, LAS float* scr, int item, int lane) {
    const int nblk = (N + 31) >> 5, kb = item / nblk, nb = item % nblk, k0 = 64 * kb, n0 = 32 * nb;
#pragma unroll 8
    for (int i = 0; i < 32; ++i) { const int kk = 2 * i + (lane >> 5), n = n0 + (lane & 31);
        float v = (n < N) ? W[(size_t)(k0 + kk) * N + n] : 0.f; if (gk) v *= gk[k0 + kk];
        scr[kk * 33 + (lane & 31)] = v; }
    LDS_FENCE();
    const int c = lane & 7;
#pragma unroll
    for (int j = 0; j < 4; ++j) { const int nl = (lane >> 3) + 8 * j, n = n0 + nl; const LAS float* s = scr + (8 * c) * 33 + nl;
        u32x4 o; o.x = pk2(s[0 * 33], s[1 * 33]); o.y = pk2(s[2 * 33], s[3 * 33]); o.z = pk2(s[4 * 33], s[5 * 33]); o.w = pk2(s[6 * 33], s[7 * 33]);
        const int dst = (n < N) ? rm(n) : -1;
        if (dst >= 0) *(u32x4*)(WT + (size_t)dst * ldt + k0 + 8 * c) = o; }
    LDS_FENCE();
}
struct RmId { __device__ __forceinline__ int operator()(int n) const { return n; } };
struct RmGU { int off; __device__ __forceinline__ int operator()(int n) const { return (n >> 7) * 256 + off + (n & 127); } };
struct RmIn { __device__ __forceinline__ int operator()(int n) const {
    if (n < 1536) return n;
    if (n < 2048) return 2048 + (n - 1536);
    if (n < 2064) return 3072 + (n - 2048);
    if (n < 2576) return 1536 + (n - 2064);
    return 2560 + (n - 2576);
} };

__device__ __forceinline__ void prologue(PT pt, LAS unsigned char* lds, int gw, int NGW, int lane, int wave) {
    asm volatile("" : "+v"(lane));
    unsigned char* ws = pws(pt);
    for (int l = 0; l < NL; ++l) { u32x4* z = (u32x4*)((bf16_t*)(ws + WS_WIN) + ((size_t)l * 3328 + 3088) * 1024); const int n4 = 240 * 1024 / 8;
        for (int i = gw * 64 + lane; i < n4; i += NGW * 64) z[i] = (u32x4){0u, 0u, 0u, 0u}; }
    LAS float* scr = (LAS float*)(lds + wave * 16384);
    constexpr int I_IN = 16 * 97, I_OUT = 16 * 32, I_G = 16 * 88, I_D = 44 * 32, I_PG = 16 * 32, I_PP = 4 * 32, I_LA = 32;
    constexpr int PER_L = I_IN + I_OUT + 2 * I_G + I_D + I_PG + I_PP + 2 * I_LA;
    for (int it = gw; it < NL * PER_L; it += NGW) {
        const int l = it / PER_L; int r = it % PER_L;
        if (r < I_IN) { tr_item(pin(pt, I_WIN) + (size_t)l * DM * INC, DM, INC, (bf16_t*)(ws + WS_WIN) + (size_t)l * 3328 * 1024, 1024, pin(pt, I_N1G) + l * DM, RmIn(), scr, r, lane); continue; } r -= I_IN;
        if (r < I_OUT) { tr_item(pin(pt, I_WOUT) + (size_t)l * DM * DM, DM, DM, (bf16_t*)(ws + WS_WOUT) + (size_t)l * DM * DM, 1024, nullptr, RmId(), scr, r, lane); continue; } r -= I_OUT;
        if (r < I_G) { tr_item(pin(pt, I_FWG) + (size_t)l * DM * FF, DM, FF, (bf16_t*)(ws + WS_WG) + (size_t)l * 5632 * 1024, 1024, pin(pt, I_N2G) + l * DM, RmGU{0}, scr, r, lane); continue; } r -= I_G;
        if (r < I_G) { tr_item(pin(pt, I_FWU) + (size_t)l * DM * FF, DM, FF, (bf16_t*)(ws + WS_WG) + (size_t)l * 5632 * 1024, 1024, pin(pt, I_N2G) + l * DM, RmGU{128}, scr, r, lane); continue; } r -= I_G;
        if (r < I_D) { tr_item(pin(pt, I_FWD) + (size_t)l * FF * DM, FF, DM, (bf16_t*)(ws + WS_WD) + (size_t)l * DM * FF, FF, nullptr, RmId(), scr, r, lane); continue; } r -= I_D;
        if (r < I_PG) { tr_item(pin(pt, I_PWG) + (size_t)l * DM * DM, DM, DM, (bf16_t*)(ws + WS_WPG) + (size_t)l * DM * DM, 1024, pin(pt, I_PNG) + l * DM, RmId(), scr, r, lane); continue; } r -= I_PG;
        if (r < I_PP) { tr_item(pin(pt, I_PWP) + (size_t)l * PLE * DM, PLE, DM, (bf16_t*)(ws + WS_WP) + (size_t)l * DM * PLE, PLE, nullptr, RmId(), scr, r, lane); continue; } r -= I_PP;
        { const int gate = r / I_LA; r %= I_LA; const int mat = r >> 1, sub = r & 1;
          const float* src = pin(pt, gate ? I_LWX : I_LWA) + ((size_t)l * 16 + mat) * 4096;
          bf16_t* dst = (bf16_t*)(ws + WS_WAT) + (((size_t)l * 16 + mat) * 2 + gate) * 4096;
          tr_item(src, 64, 64, dst, 64, nullptr, RmId(), scr, sub, lane); }
    }
    const float* x = pin(pt, I_X); bf16_t* rb = (bf16_t*)(ws + WS_RB); float* ss0 = (float*)(ws + WS_SSP); bf16_t* rl = (bf16_t*)pout(pt) + (size_t)M_TOK * 1024;
    for (int m = gw; m < M_TOK; m += NGW) { const f32x4* xr = (const f32x4*)(x + (size_t)m * DM) + lane; u32x2* o = (u32x2*)(rb + (size_t)m * DM) + lane; u32x2* ol = (u32x2*)(rl + (size_t)m * DM) + lane; float s = 0.f;
#pragma unroll
        for (int j = 0; j < 4; ++j) { const f32x4 v = xr[64 * j]; s += (v[0] * v[0] + v[1] * v[1]) + (v[2] * v[2] + v[3] * v[3]); const u32x2 hw = pk4(v); o[64 * j] = hw;
            ol[64 * j] = pk4((f32x4){v[0] - bflo(hw.x), v[1] - bfhi(hw.x), v[2] - bflo(hw.y), v[3] - bfhi(hw.y)}); }
#pragma unroll
        for (int o2 = 1; o2 < 64; o2 <<= 1) s += __shfl_xor(s, o2);
        if (lane < 4) ss0[(size_t)m * 4 + lane] = lane == 0 ? s : 0.f; }
}

__device__ __forceinline__ void lru_block(PT pt, LAS unsigned char* lds, int bi, int layer, int tid) {
    asm volatile("" : "+v"(tid));
    const int lane = tid & 63, w = tid >> 6;
    unsigned char* ws = pws(pt);
    const int wi = bi * 8 + w;
    const int dq = wi & 3, n = (wi >> 2) & 7, dir = (wi >> 5) & 1, b = wi >> 6;
    const int fr = lane & 15, fq = lane >> 4;
    LAS unsigned char* XCB = lds + (w >> 2) * 8192;
    LAS unsigned char* SCN = lds + 16384 + w * 1024;
    const int ti = lane >> 2, cq = lane & 3;
    const int cch = 64 * n + 16 * dq + 4 * cq;
    f32x4 cw4[4];
#pragma unroll
    for (int tap = 0; tap < 4; ++tap) cw4[tap] = *(const f32x4*)(pin(pt, I_LCW) + ((size_t)layer * 4 + tap) * 512 + cch);
    const f32x4 cb4 = *(const f32x4*)(pin(pt, I_LCB) + (size_t)layer * 512 + cch);
    const bf16_t* wbase = (const bf16_t*)(ws + WS_WAT) + ((((size_t)layer * 2 + dir) * 8 + n) * 2) * 4096;
    bf16x8 Ba[2], Bx[2];
#pragma unroll
    for (int ks = 0; ks < 2; ++ks) { Ba[ks] = *(const bf16x8*)(wbase + (16 * dq + fr) * 64 + 32 * ks + 8 * fq); Bx[ks] = *(const bf16x8*)(wbase + 4096 + (16 * dq + fr) * 64 + 32 * ks + 8 * fq); }
    const int dch = 64 * n + 16 * dq + fr; const size_t pidx = ((size_t)layer * 2 + dir) * 512 + dch;
    const float ba = pin(pt, I_LBA)[pidx], bx = pin(pt, I_LBX)[pidx], sp8 = 8.0f * 1.4426950408889634f * softplus_f(-pin(pt, I_LAM)[pidx]);
    const bf16_t* plx = (const bf16_t*)(ws + WS_PLX) + (size_t)b * SEQ * 512 + cch;
    bf16_t* hout = (bf16_t*)pout(pt) + (size_t)dir * M_TOK * 512 + (size_t)b * SEQ * 512 + dch;
    u32x2 xr[2][4];
#define LRU_LOAD(scn) do { _Pragma("unroll") for (int s_ = 0; s_ < 2; ++s_) { const int tt_ = dir ? (SEQ - 1 - (32 * (scn) + 16 * s_ + ti)) : (32 * (scn) + 16 * s_ + ti); \
        _Pragma("unroll") for (int tap = 0; tap < 4; ++tap) { const int t2_ = tt_ + tap - 2; xr[s_][tap] = (u32x2){0u, 0u}; if (t2_ >= 0 && t2_ < SEQ) xr[s_][tap] = *(const u32x2*)(plx + (size_t)t2_ * 512); } } } while (0)
    LRU_LOAD(0);
    float hprev = 0.f;
    LBAR();
#pragma unroll 1
    for (int sc = 0; sc < 64; ++sc) {
        LAS unsigned char* XC = XCB + (sc & 1) * 4096;
#pragma unroll
        for (int s2 = 0; s2 < 2; ++s2) { f32x4 xa = cb4;
#pragma unroll
            for (int tap = 0; tap < 4; ++tap) { xa[0] += cw4[tap][0] * bflo(xr[s2][tap].x); xa[1] += cw4[tap][1] * bfhi(xr[s2][tap].x); xa[2] += cw4[tap][2] * bflo(xr[s2][tap].y); xa[3] += cw4[tap][3] * bfhi(xr[s2][tap].y); }
            *(LAS u32x2*)(XC + swz64(16 * s2 + ti, 16 * dq + 4 * cq)) = pk4(xa); }
        if (sc + 1 < 64) LRU_LOAD(sc + 1);
        LBAR();
        float Ac[2][4], Hc[2][4];
#pragma unroll
        for (int s2 = 0; s2 < 2; ++s2) {
            const bf16x8 A0 = *(const LAS bf16x8*)(XC + swz64(16 * s2 + fr, 8 * fq)), A1 = *(const LAS bf16x8*)(XC + swz64(16 * s2 + fr, 32 + 8 * fq));
            f32x4 ca = {0.f, 0.f, 0.f, 0.f}, cx = {0.f, 0.f, 0.f, 0.f};
            ca = MFMA16(A0, Ba[0], ca); ca = MFMA16(A1, Ba[1], ca); cx = MFMA16(A0, Bx[0], cx); cx = MFMA16(A1, Bx[1], cx);
#pragma unroll
            for (int jj = 0; jj < 4; ++jj) { const float xv = bf2f(*(const LAS unsigned short*)(XC + swz64(16 * s2 + 4 * fq + jj, 16 * dq + fr)));
                const float r = sigm(ca[jj] + ba), ig = sigm(cx[jj] + bx), a = __builtin_amdgcn_exp2f(-r * sp8);
                const float bt = __builtin_amdgcn_sqrtf(fmaxf(1.0f - a * a, 0.f)) * ig * xv;
                Hc[s2][jj] = jj ? (a * Hc[s2][jj - 1] + bt) : bt; Ac[s2][jj] = jj ? (a * Ac[s2][jj - 1]) : a; }
            *(LAS f32x2*)(SCN + s2 * 512 + (fq * 16 + fr) * 8) = (f32x2){Ac[s2][3], Hc[s2][3]}; }
#pragma unroll
        for (int s2 = 0; s2 < 2; ++s2) {
            const LAS unsigned char* T = SCN + s2 * 512;
            const f32x2 g0 = *(const LAS f32x2*)(T + (0 * 16 + fr) * 8), g1 = *(const LAS f32x2*)(T + (1 * 16 + fr) * 8), g2 = *(const LAS f32x2*)(T + (2 * 16 + fr) * 8), g3 = *(const LAS f32x2*)(T + (3 * 16 + fr) * 8);
            const float h1 = g0.x * hprev + g0.y, h2 = g1.x * h1 + g1.y, h3 = g2.x * h2 + g2.y, h4 = g3.x * h3 + g3.y;
            const float hin = fq == 0 ? hprev : (fq == 1 ? h1 : (fq == 2 ? h2 : h3));
            hprev = h4;
#pragma unroll
            for (int jj = 0; jj < 4; ++jj) { const float hv = Ac[s2][jj] * hin + Hc[s2][jj]; const int i = 16 * s2 + 4 * fq + jj; const int t2 = dir ? (SEQ - 1 - (32 * sc + i)) : (32 * sc + i);
                hout[(size_t)t2 * 512] = (bf16_t)(pk2(hv, 0.f) & 0xffffu); } }
    }
#undef LRU_LOAD
}

constexpr int DP_BUF0 = 0, DP_BUF1 = 49152, DP_KL = 49152, DP_QL = 49152 + 16384, DP_VL = 49152 + 32768, DP_VEC = 98304, DP_CWL = 99328;
__device__ __forceinline__ void dp_item(PT pt, LAS unsigned char* lds, int item, int layer, int tid, int lane, int w) {
    asm volatile("" : "+v"(tid)); lane = tid & 63; asm volatile("" : "+s"(w));
    unsigned char* ws = pws(pt);
    const int b = item >> 7, h = (item >> 5) & 3, n = item & 31;
    const size_t rowbase = (size_t)b * SEQ + 64 * n;
    LAS float* VEC = (LAS float*)(lds + DP_VEC);
    LBAR();
    f32x4 gpre = {0.f, 0.f, 0.f, 0.f};
    if (w == 0) { const float* gp = (const float*)(ws + WS_GATES) + (rowbase + lane) * 16 + h; gpre[0] = gp[0]; gpre[1] = gp[4]; gpre[2] = gp[8]; gpre[3] = gp[12]; }
    { const int i = tid >> 3, c = tid & 7; const int t = 64 * n + i; const size_t R = rowbase + i;
      const bf16_t* pq = (const bf16_t*)(ws + WS_PQKV);
      u32x4 xin[3][4][2];
#pragma unroll
      for (int mat = 0; mat < 3; ++mat)
#pragma unroll
          for (int tap = 0; tap < 4; ++tap) { const int t2 = t + tap - 2; xin[mat][tap][0] = (u32x4){0u, 0u, 0u, 0u}; xin[mat][tap][1] = (u32x4){0u, 0u, 0u, 0u};
              if (t2 >= 0 && t2 < SEQ) { const bf16_t* xp = pq + (R + tap - 2) * 1536 + mat * 512 + h * 128 + 16 * c; xin[mat][tap][0] = *(const u32x4*)xp; xin[mat][tap][1] = *(const u32x4*)(xp + 8); } }
#pragma unroll
      for (int mat = 0; mat < 3; ++mat) {
          f32x4 a[4] = {{0.f, 0.f, 0.f, 0.f}, {0.f, 0.f, 0.f, 0.f}, {0.f, 0.f, 0.f, 0.f}, {0.f, 0.f, 0.f, 0.f}};
#pragma unroll
          for (int tap = 0; tap < 4; ++tap) { const u32x4 x0 = xin[mat][tap][0], x1 = xin[mat][tap][1];
              const LAS float* wp = (const LAS float*)(lds + DP_CWL) + (mat * 4 + tap) * 128 + 16 * c; const f32x4 w0 = *(const LAS f32x4*)wp, w1 = *(const LAS f32x4*)(wp + 4), w2 = *(const LAS f32x4*)(wp + 8), w3 = *(const LAS f32x4*)(wp + 12);
              a[0][0] += w0[0] * bflo(x0.x); a[0][1] += w0[1] * bfhi(x0.x); a[0][2] += w0[2] * bflo(x0.y); a[0][3] += w0[3] * bfhi(x0.y);
              a[1][0] += w1[0] * bflo(x0.z); a[1][1] += w1[1] * bfhi(x0.z); a[1][2] += w1[2] * bflo(x0.w); a[1][3] += w1[3] * bfhi(x0.w);
              a[2][0] += w2[0] * bflo(x1.x); a[2][1] += w2[1] * bfhi(x1.x); a[2][2] += w2[2] * bflo(x1.y); a[2][3] += w2[3] * bfhi(x1.y);
              a[3][0] += w3[0] * bflo(x1.z); a[3][1] += w3[1] * bfhi(x1.z); a[3][2] += w3[2] * bflo(x1.w); a[3][3] += w3[3] * bfhi(x1.w); }
          float ssq = 0.f;
#pragma unroll
          for (int q = 0; q < 4; ++q)
#pragma unroll
              for (int e = 0; e < 4; ++e) { const float v = a[q][e]; const float sv = v * sigm(v); a[q][e] = sv; ssq += sv * sv; }
          float scale = 1.f;
          if (mat < 2) { ssq += __shfl_xor(ssq, 1); ssq += __shfl_xor(ssq, 2); ssq += __shfl_xor(ssq, 4); scale = rsqrtf(ssq + EPS); if (mat == 0) scale *= 0.08838834764831845f; }
          u32x4 o0, o1; o0.x = pk2(a[0][0] * scale, a[0][1] * scale); o0.y = pk2(a[0][2] * scale, a[0][3] * scale); o0.z = pk2(a[1][0] * scale, a[1][1] * scale); o0.w = pk2(a[1][2] * scale, a[1][3] * scale);
          o1.x = pk2(a[2][0] * scale, a[2][1] * scale); o1.y = pk2(a[2][2] * scale, a[2][3] * scale); o1.z = pk2(a[3][0] * scale, a[3][1] * scale); o1.w = pk2(a[3][2] * scale, a[3][3] * scale);
          const int lbase = (mat == 0) ? DP_QL : (mat == 1 ? DP_KL : DP_VL);
          *(LAS u32x4*)(lds + lbase + swz128(i, 16 * c)) = o0; *(LAS u32x4*)(lds + lbase + swz128(i, 16 * c + 8)) = o1;
          if (mat < 2) { bf16_t* gp = (bf16_t*)(ws + (mat == 0 ? WS_QH : WS_KH)) + R * 512 + h * 128 + 16 * c; *(u32x4*)gp = o0; *(u32x4*)(gp + 8) = o1; } }
    }
    if (w == 0) {
        const float bF = sigm(gpre[0]), bB = sigm(gpre[1]);
        float gF = -expf(pin(pt, I_ALOG)[layer * 8 + h]) * softplus_f(gpre[2] + pin(pt, I_DTB)[layer * 8 + h]);
        float gB = -expf(pin(pt, I_ALOG)[layer * 8 + 4 + h]) * softplus_f(gpre[3] + pin(pt, I_DTB)[layer * 8 + 4 + h]);
#pragma unroll
        for (int off = 1; off < 64; off <<= 1) { const float v = __shfl_up(gF, off); if (lane >= off) gF += v; const float u = __shfl_down(gB, off); if (lane + off < 64) gB += u; }
        const float glF = __shfl(gF, 63), glB = __shfl(gB, 0);
        VEC[lane] = bF; VEC[64 + lane] = gF; VEC[128 + lane] = bB; VEC[192 + lane] = gB;
        float* v0 = (float*)(ws + WS_VEC) + (size_t)item * 256; float* v1 = v0 + (size_t)4096 * 256;
        v0[lane] = bF; v0[64 + lane] = fexp(gF); v0[128 + lane] = fexp(glF - gF); if (lane == 0) v0[192] = fexp(glF);
        v1[lane] = bB; v1[64 + lane] = fexp(gB); v1[128 + lane] = fexp(glB - gB); if (lane == 0) v1[192] = fexp(glB);
    }
    LBAR();
    { const int e = tid >> 2, jq = tid & 3; unsigned vv[8];
#pragma unroll
      for (int p = 0; p < 8; ++p) { const unsigned lo = *(const LAS unsigned short*)(lds + DP_VL + swz128(16 * jq + 2 * p, e)), hi = *(const LAS unsigned short*)(lds + DP_VL + swz128(16 * jq + 2 * p + 1, e)); vv[p] = lo | (hi << 16); }
      bf16_t* gp = (bf16_t*)(ws + WS_VT) + (size_t)item * 8192 + e * 64 + 16 * jq;
      *(u32x4*)gp = (u32x4){vv[0], vv[1], vv[2], vv[3]}; *(u32x4*)(gp + 8) = (u32x4){vv[4], vv[5], vv[6], vv[7]}; }
    const int r32 = lane & 31, hi = lane >> 5;
    { const int kind = w >> 2, q = w & 3, ta = q >> 1, tb = q & 1;
      f32x16 acc; for (int r = 0; r < 16; ++r) acc[r] = 0.f;
      const int bbase = kind ? DP_QL : DP_KL;
#pragma unroll
      for (int ks = 0; ks < 8; ++ks) { const bf16x8 av = *(const LAS bf16x8*)(lds + DP_KL + swz128(32 * ta + r32, 16 * ks + 8 * hi)), bv = *(const LAS bf16x8*)(lds + bbase + swz128(32 * tb + r32, 16 * ks + 8 * hi)); acc = MFMA32(av, bv, acc); }
      const int gb = 32 * tb + r32;
#pragma unroll
      for (int dir = 0; dir < 2; ++dir) { const LAS float* bet = VEC + dir * 128; const LAS float* gc = VEC + dir * 128 + 64;
          const float gcl = gc[gb], betl = bet[gb];
#pragma unroll
          for (int g = 0; g < 4; ++g) { const int ga0 = 32 * ta + 8 * g + 4 * hi; const f32x4 gca = *(const LAS f32x4*)(gc + ga0), bea = *(const LAS f32x4*)(bet + ga0);
              if (kind == 0) { f32x4 xv, yv, pv;
#pragma unroll
                  for (int jj = 0; jj < 4; ++jj) { const int ga = ga0 + jj; const float kk = acc[4 * g + jj];
                      const bool mx = dir ? (gb < ga) : (gb > ga), my = dir ? (ga < gb) : (ga > gb);
                      const float ed = kk * fexp(-fabsf(gcl - gca[jj]));
                      xv[jj] = mx ? (-betl * ed) : 0.f; yv[jj] = my ? (-bea[jj] * ed) : 0.f; pv[jj] = (ga == gb) ? 1.f : 0.f; }
                  LAS unsigned char* bb = lds + DP_BUF0 + dir * 24576 + swz64(gb, ga0);
                  *(LAS u32x2*)bb = pk4(xv); *(LAS u32x2*)(bb + 8192) = pk4(yv); *(LAS u32x2*)(bb + 16384) = pk4(pv);
              } else { f32x4 av4;
#pragma unroll
                  for (int jj = 0; jj < 4; ++jj) { const int ga = ga0 + jj; const bool ma = dir ? (gb <= ga) : (gb >= ga); av4[jj] = ma ? (acc[4 * g + jj] * fexp(-fabsf(gcl - gca[jj]))) : 0.f; }
                  *(u32x2*)((bf16_t*)(ws + WS_AT) + ((size_t)dir * 4096 + item) * 4096 + gb * 64 + ga0) = pk4(av4); } } }
    }
    LBAR();
    { const int dir = w >> 2, q = w & 3, ti = q >> 1, tj = q & 1;
      f32x16 pacc; for (int r = 0; r < 16; ++r) pacc[r] = (32 * tj + crow(r, hi) == 32 * ti + r32) ? 1.f : 0.f;
#pragma unroll 1
      for (int rd = 0; rd < 6; ++rd) { LAS unsigned char* cur = lds + ((rd & 1) ? DP_BUF1 : DP_BUF0) + dir * 24576; LAS unsigned char* nxt = lds + ((rd & 1) ? DP_BUF0 : DP_BUF1) + dir * 24576;
          bf16x8 xf[4], yf[4], pf[4];
#pragma unroll
          for (int ks = 0; ks < 4; ++ks) { xf[ks] = *(const LAS bf16x8*)(cur + swz64(32 * ti + r32, 16 * ks + 8 * hi)); yf[ks] = *(const LAS bf16x8*)(cur + 8192 + swz64(32 * tj + r32, 16 * ks + 8 * hi)); pf[ks] = *(const LAS bf16x8*)(cur + 16384 + swz64(32 * ti + r32, 16 * ks + 8 * hi)); }
#pragma unroll
          for (int ks = 0; ks < 4; ++ks) pacc = MFMA32(yf[ks], pf[ks], pacc);
          if (rd < 5) { f32x16 xa, ya; for (int r = 0; r < 16; ++r) { xa[r] = 0.f; ya[r] = 0.f; }
#pragma unroll
              for (int ks = 0; ks < 4; ++ks) { xa = MFMA32(yf[ks], xf[ks], xa); ya = MFMA32(xf[ks], yf[ks], ya); }
#pragma unroll
              for (int g = 0; g < 4; ++g) { const int c0 = 8 * g + 4 * hi;
                  *(LAS u32x2*)(nxt + swz64(32 * ti + r32, 32 * tj + c0)) = pk4((f32x4){xa[4 * g], xa[4 * g + 1], xa[4 * g + 2], xa[4 * g + 3]});
                  *(LAS u32x2*)(nxt + 8192 + swz64(32 * tj + r32, 32 * ti + c0)) = pk4((f32x4){ya[4 * g], ya[4 * g + 1], ya[4 * g + 2], ya[4 * g + 3]});
                  *(LAS u32x2*)(nxt + 16384 + swz64(32 * ti + r32, 32 * tj + c0)) = pk4((f32x4){pacc[4 * g], pacc[4 * g + 1], pacc[4 * g + 2], pacc[4 * g + 3]}); }
              LBAR(); } }
      bf16_t* tg = (bf16_t*)(ws + WS_TM) + ((size_t)dir * 4096 + item) * 4096 + (32 * ti + r32) * 64 + 32 * tj + 4 * hi;
#pragma unroll
      for (int g = 0; g < 4; ++g) *(u32x2*)(tg + 8 * g) = pk4((f32x4){pacc[4 * g], pacc[4 * g + 1], pacc[4 * g + 2], pacc[4 * g + 3]});
    }
}

constexpr int DR_K = 0, DR_Q = 16384, DR_KT = 32768, DR_VT = 49152, DR_T = 65536, DR_A = 73728, DR_VEC = 81920, DR_PRIV = 83968;
__device__ __forceinline__ void dr_item(PT pt, LAS unsigned char* lds, int item, int tid, int lane, int w) {
    asm volatile("" : "+v"(tid)); lane = tid & 63; asm volatile("" : "+s"(w));
    unsigned char* ws = pws(pt);
    const int dir = item & 1, h = (item >> 1) & 3, b = item >> 3;
    const int fr = lane & 15, fq = lane >> 4, es = 16 * w;
    LAS unsigned char* ST = lds + DR_PRIV + w * 8192; LAS unsigned char* RV = ST + 4096; LAS unsigned char* VN2 = ST + 6144;
    const LAS float* VEC = (const LAS float*)(lds + DR_VEC);
    const bf16_t* kh = (const bf16_t*)(ws + WS_KH) + (size_t)b * SEQ * 512 + h * 128;
    const bf16_t* qh = (const bf16_t*)(ws + WS_QH) + (size_t)b * SEQ * 512 + h * 128;
    const int ibase = (b * 4 + h) * 32;
    const bf16_t* vt = (const bf16_t*)(ws + WS_VT) + (size_t)ibase * 8192;
    const bf16_t* tm = (const bf16_t*)(ws + WS_TM) + ((size_t)dir * 4096 + ibase) * 4096;
    const bf16_t* at = (const bf16_t*)(ws + WS_AT) + ((size_t)dir * 4096 + ibase) * 4096;
    const float* vecs = (const float*)(ws + WS_VEC) + ((size_t)dir * 4096 + ibase) * 256;
    bf16_t* og = (bf16_t*)(ws + (dir ? WS_OB : WS_OF)) + (size_t)b * SEQ * 512 + h * 128 + es + fr;
    u32x4 pk[2], pq[2], pv[2], ptm, pa; f32x4 pvec = {0.f, 0.f, 0.f, 0.f};
#define DR_LOAD(nn) do { _Pragma("unroll") for (int u_ = 0; u_ < 2; ++u_) { const int p_ = tid + 512 * u_; \
        pk[u_] = *(const u32x4*)(kh + (size_t)(64 * (nn) + (p_ >> 4)) * 512 + 8 * (p_ & 15)); pq[u_] = *(const u32x4*)(qh + (size_t)(64 * (nn) + (p_ >> 4)) * 512 + 8 * (p_ & 15)); \
        pv[u_] = *(const u32x4*)(vt + (size_t)(nn) * 8192 + p_ * 8); } \
        ptm = *(const u32x4*)(tm + (size_t)(nn) * 4096 + tid * 8); pa = *(const u32x4*)(at + (size_t)(nn) * 4096 + tid * 8); \
        if (tid < 64) pvec = *(const f32x4*)(vecs + (size_t)(nn) * 256 + 4 * tid); } while (0)
#define DR_STORE() do { _Pragma("unroll") for (int u_ = 0; u_ < 2; ++u_) { const int p_ = tid + 512 * u_; const int j_ = p_ >> 4, q_ = p_ & 15; \
        *(LAS u32x4*)(lds + DR_K + swz128(j_, 8 * q_)) = pk[u_]; *(LAS u32x4*)(lds + DR_Q + swz128(j_, 8 * q_)) = pq[u_]; \
        *(LAS unsigned short*)(lds + DR_KT + swz64(8 * q_ + 0, j_)) = (unsigned short)(pk[u_].x & 0xffffu); *(LAS unsigned short*)(lds + DR_KT + swz64(8 * q_ + 1, j_)) = (unsigned short)(pk[u_].x >> 16); \
        *(LAS unsigned short*)(lds + DR_KT + swz64(8 * q_ + 2, j_)) = (unsigned short)(pk[u_].y & 0xffffu); *(LAS unsigned short*)(lds + DR_KT + swz64(8 * q_ + 3, j_)) = (unsigned short)(pk[u_].y >> 16); \
        *(LAS unsigned short*)(lds + DR_KT + swz64(8 * q_ + 4, j_)) = (unsigned short)(pk[u_].z & 0xffffu); *(LAS unsigned short*)(lds + DR_KT + swz64(8 * q_ + 5, j_)) = (unsigned short)(pk[u_].z >> 16); \
        *(LAS unsigned short*)(lds + DR_KT + swz64(8 * q_ + 6, j_)) = (unsigned short)(pk[u_].w & 0xffffu); *(LAS unsigned short*)(lds + DR_KT + swz64(8 * q_ + 7, j_)) = (unsigned short)(pk[u_].w >> 16); \
        *(LAS u32x4*)(lds + DR_VT + swz64(p_ >> 3, 8 * (p_ & 7))) = pv[u_]; } \
        *(LAS u32x4*)(lds + DR_T + swz64(tid >> 3, 8 * (tid & 7))) = ptm; *(LAS u32x4*)(lds + DR_A + swz64(tid >> 3, 8 * (tid & 7))) = pa; \
        if (tid < 64) *(LAS f32x4*)(lds + DR_VEC + 16 * tid) = pvec; } while (0)
    LBAR();
    DR_LOAD(dir ? 31 : 0);
    DR_STORE();
#pragma unroll
    for (int q = 0; q < 4; ++q) *(LAS u32x4*)(ST + lane * 64 + q * 16) = (u32x4){0u, 0u, 0u, 0u};
    f32x4 Sacc[8];
#pragma unroll
    for (int d = 0; d < 8; ++d) Sacc[d] = (f32x4){0.f, 0.f, 0.f, 0.f};
    LBAR();
#pragma unroll 1
    for (int cc = 0; cc < 32; ++cc) { const int n = dir ? (31 - cc) : cc;
        if (cc + 1 < 32) DR_LOAD(dir ? (30 - cc) : (cc + 1));
        bf16x8 sb[4];
#pragma unroll
        for (int ks = 0; ks < 4; ++ks) sb[ks] = *(const LAS bf16x8*)(ST + swz128(fr, 32 * ks + 8 * fq));
        f32x4 oacc[4];
#pragma unroll
        for (int it = 0; it < 4; ++it) { f32x4 ka = {0.f, 0.f, 0.f, 0.f}, qa = {0.f, 0.f, 0.f, 0.f};
#pragma unroll
            for (int ks = 0; ks < 4; ++ks) { const bf16x8 a1 = *(const LAS bf16x8*)(lds + DR_K + swz128(16 * it + fr, 32 * ks + 8 * fq)), a2 = *(const LAS bf16x8*)(lds + DR_Q + swz128(16 * it + fr, 32 * ks + 8 * fq));
                ka = MFMA16(a1, sb[ks], ka); qa = MFMA16(a2, sb[ks], qa); }
            const int i0 = 16 * it + 4 * fq; const f32x4 be = *(const LAS f32x4*)(VEC + i0), eg = *(const LAS f32x4*)(VEC + 64 + i0);
            const u32x2 vv = *(const LAS u32x2*)(lds + DR_VT + swz64(es + fr, i0));
            f32x4 rh; rh[0] = be[0] * (bflo(vv.x) - eg[0] * ka[0]); rh[1] = be[1] * (bfhi(vv.x) - eg[1] * ka[1]); rh[2] = be[2] * (bflo(vv.y) - eg[2] * ka[2]); rh[3] = be[3] * (bfhi(vv.y) - eg[3] * ka[3]);
            *(LAS u32x2*)(RV + swz64(fr, i0)) = pk4(rh);
            oacc[it] = qa * eg; }
        bf16x8 rb2[2];
#pragma unroll
        for (int ks = 0; ks < 2; ++ks) rb2[ks] = *(const LAS bf16x8*)(RV + swz64(fr, 32 * ks + 8 * fq));
        f32x4 vn[4];
#pragma unroll
        for (int it = 0; it < 4; ++it) { vn[it] = (f32x4){0.f, 0.f, 0.f, 0.f};
#pragma unroll
            for (int ks = 0; ks < 2; ++ks) { const bf16x8 a1 = *(const LAS bf16x8*)(lds + DR_T + swz64(16 * it + fr, 32 * ks + 8 * fq)); vn[it] = MFMA16(a1, rb2[ks], vn[it]); } }
#pragma unroll
        for (int it = 0; it < 4; ++it) { const int i0 = 16 * it + 4 * fq; const f32x4 ed = *(const LAS f32x4*)(VEC + 128 + i0);
            *(LAS u32x2*)(RV + swz64(fr, i0)) = pk4(vn[it]); *(LAS u32x2*)(VN2 + swz64(fr, i0)) = pk4(vn[it] * ed); }
        bf16x8 vb[2], vb2[2];
#pragma unroll
        for (int ks = 0; ks < 2; ++ks) { vb[ks] = *(const LAS bf16x8*)(RV + swz64(fr, 32 * ks + 8 * fq)); vb2[ks] = *(const LAS bf16x8*)(VN2 + swz64(fr, 32 * ks + 8 * fq)); }
#pragma unroll
        for (int it = 0; it < 4; ++it)
#pragma unroll
            for (int ks = 0; ks < 2; ++ks) { const bf16x8 a1 = *(const LAS bf16x8*)(lds + DR_A + swz64(16 * it + fr, 32 * ks + 8 * fq)); oacc[it] = MFMA16(a1, vb[ks], oacc[it]); }
        const float cdec = VEC[192];
#pragma unroll
        for (int dt = 0; dt < 8; ++dt) { Sacc[dt] = Sacc[dt] * cdec;
#pragma unroll
            for (int ks = 0; ks < 2; ++ks) { const bf16x8 a1 = *(const LAS bf16x8*)(lds + DR_KT + swz64(16 * dt + fr, 32 * ks + 8 * fq)); Sacc[dt] = MFMA16(a1, vb2[ks], Sacc[dt]); }
            *(LAS u32x2*)(ST + swz128(fr, 16 * dt + 4 * fq)) = pk4(Sacc[dt]); }
#pragma unroll
        for (int it = 0; it < 4; ++it)
#pragma unroll
            for (int jj = 0; jj < 4; ++jj) og[(size_t)(64 * n + 16 * it + 4 * fq + jj) * 512] = (bf16_t)(pk2(oacc[it][jj], 0.f) & 0xffffu);
        LBAR();
        if (cc + 1 < 32) DR_STORE();
        LBAR();
    }
#undef DR_LOAD
#undef DR_STORE
}

__device__ __forceinline__ void m2_rows(PT pt, int layer, int gw, int NGW, int lane) {
    asm volatile("" : "+v"(lane));
    unsigned char* ws = pws(pt);
    const bf16_t* of = (const bf16_t*)(ws + WS_OF); const bf16_t* ob = (const bf16_t*)(ws + WS_OB); const bf16_t* pz = (const bf16_t*)(ws + WS_PZ);
    const bf16_t* hf = (const bf16_t*)pout(pt); const bf16_t* hb = hf + (size_t)M_TOK * 512; const bf16_t* plg = (const bf16_t*)(ws + WS_PLG);
    bf16_t* amix = (bf16_t*)(ws + WS_AMIX);
    const float* dng = pin(pt, I_DNG) + layer * 128 + 8 * (lane & 15); const float* lng = pin(pt, I_LNG) + layer * 512 + 8 * lane;
    const f32x4 dg0 = *(const f32x4*)dng, dg1 = *(const f32x4*)(dng + 4), lg0 = *(const f32x4*)lng, lg1 = *(const f32x4*)(lng + 4);
    for (int m0 = gw; m0 < M_TOK; m0 += 2 * NGW) {
        u32x4 av[2], bv[2], zv[2], cv[2], dv[2], gv[2];
#pragma unroll
        for (int r = 0; r < 2; ++r) { const int m = m0 + r * NGW; if (m < M_TOK) { const size_t o = (size_t)m * 512 + 8 * lane;
            av[r] = *(const u32x4*)(of + o); bv[r] = *(const u32x4*)(ob + o); zv[r] = *(const u32x4*)(pz + o); cv[r] = *(const u32x4*)(hf + o); dv[r] = *(const u32x4*)(hb + o); gv[r] = *(const u32x4*)(plg + o); } }
#pragma unroll
        for (int r = 0; r < 2; ++r) { const int m = m0 + r * NGW; if (m < M_TOK) {
        const u32x4 a = av[r], b2 = bv[r], z = zv[r], c = cv[r], d = dv[r], g = gv[r];
        float v[8], y[8];
        v[0] = bflo(a.x) + bflo(b2.x); v[1] = bfhi(a.x) + bfhi(b2.x); v[2] = bflo(a.y) + bflo(b2.y); v[3] = bfhi(a.y) + bfhi(b2.y);
        v[4] = bflo(a.z) + bflo(b2.z); v[5] = bfhi(a.z) + bfhi(b2.z); v[6] = bflo(a.w) + bflo(b2.w); v[7] = bfhi(a.w) + bfhi(b2.w);
        float s1 = 0.f;
#pragma unroll
        for (int e = 0; e < 8; ++e) s1 += v[e] * v[e];
        s1 += __shfl_xor(s1, 1); s1 += __shfl_xor(s1, 2); s1 += __shfl_xor(s1, 4); s1 += __shfl_xor(s1, 8);
        const float r1 = rsqrtf(s1 * (1.0f / 128.0f) + EPS);
        float zz[8] = {bflo(z.x), bfhi(z.x), bflo(z.y), bfhi(z.y), bflo(z.z), bfhi(z.z), bflo(z.w), bfhi(z.w)};
        float gg[8] = {bflo(g.x), bfhi(g.x), bflo(g.y), bfhi(g.y), bflo(g.z), bfhi(g.z), bflo(g.w), bfhi(g.w)};
        float hh[8] = {bflo(c.x) + bflo(d.x), bfhi(c.x) + bfhi(d.x), bflo(c.y) + bflo(d.y), bfhi(c.y) + bfhi(d.y), bflo(c.z) + bflo(d.z), bfhi(c.z) + bfhi(d.z), bflo(c.w) + bflo(d.w), bfhi(c.w) + bfhi(d.w)};
        float s2 = 0.f;
#pragma unroll
        for (int e = 0; e < 8; ++e) { const float dgv = e < 4 ? dg0[e & 3] : dg1[e & 3]; v[e] = v[e] * r1 * dgv * (zz[e] * sigm(zz[e])); y[e] = gelu_t(gg[e]) * hh[e]; s2 += y[e] * y[e]; }
#pragma unroll
        for (int o2 = 1; o2 < 64; o2 <<= 1) s2 += __shfl_xor(s2, o2);
        const float r2 = rsqrtf(s2 * (1.0f / 512.0f) + EPS);
#pragma unroll
        for (int e = 0; e < 8; ++e) { const float lgv = e < 4 ? lg0[e & 3] : lg1[e & 3]; y[e] = y[e] * r2 * lgv; }
        u32x4 w1, w2; w1.x = pk2(v[0], v[1]); w1.y = pk2(v[2], v[3]); w1.z = pk2(v[4], v[5]); w1.w = pk2(v[6], v[7]);
        w2.x = pk2(y[0], y[1]); w2.y = pk2(y[2], y[3]); w2.z = pk2(y[4], y[5]); w2.w = pk2(y[6], y[7]);
        *(u32x4*)(amix + (size_t)m * 1024 + 8 * lane) = w1; *(u32x4*)(amix + (size_t)m * 1024 + 512 + 8 * lane) = w2; } }
    }
}

__device__ __forceinline__ void glu_fixup(PT pt, int layer, int bx, int G, int tid) {
    asm volatile("" : "+v"(tid));
    unsigned char* ws = pws(pt);
    const float* sg = (const float*)(ws + WS_G); const float* su = sg + (size_t)256 * 4 * FF; bf16_t* act = (bf16_t*)(ws + WS_ACT);
    const float* cw = pin(pt, I_FCW) + (size_t)layer * 3 * FF; const float* cb = pin(pt, I_FCB) + (size_t)layer * FF;
    for (int e = bx * 512 + tid; e < 512 * (FF / 4); e += G * 512) { const int edge = e / (FF / 4), ch = (e % (FF / 4)) * 4; const int pm = edge >> 1, side = edge & 1;
        const int row = 256 * pm + (side ? 255 : 0); const int t = row & (SEQ - 1);
        const f32x4 gmid = *(const f32x4*)(sg + ((size_t)pm * 4 + (side ? 3 : 0)) * FF + ch);
        f32x4 gup = {0.f, 0.f, 0.f, 0.f}, gdn = {0.f, 0.f, 0.f, 0.f};
        if (side == 0) { gdn = *(const f32x4*)(sg + ((size_t)pm * 4 + 1) * FF + ch); if (t != 0) gup = *(const f32x4*)(sg + ((size_t)(pm - 1) * 4 + 3) * FF + ch); }
        else { gup = *(const f32x4*)(sg + ((size_t)pm * 4 + 2) * FF + ch); if (t != SEQ - 1) gdn = *(const f32x4*)(sg + ((size_t)(pm + 1) * 4 + 0) * FF + ch); }
        const f32x4 uu = *(const f32x4*)(su + ((size_t)pm * 2 + side) * FF + ch);
        const f32x4 w0 = *(const f32x4*)(cw + ch), w1 = *(const f32x4*)(cw + FF + ch), w2 = *(const f32x4*)(cw + 2 * FF + ch), bb = *(const f32x4*)(cb + ch);
        const f32x4 ga = w0 * gup + w1 * gmid + w2 * gdn + bb;
        u32x2 o; o.x = pk2(gelu_t(ga[0]) * uu[0], gelu_t(ga[1]) * uu[1]); o.y = pk2(gelu_t(ga[2]) * uu[2], gelu_t(ga[3]) * uu[3]);
        *(u32x2*)(act + (size_t)row * FF + ch) = o; }
}

#define XB_TMO      128
#define XB_XCNT(j)  (256  + 64 * (j))
#define XB_XSUB(j)  (1280 + 64 * (j))
#define XB_XGEN(j)  (2304 + 64 * (j))
#define XB_TOP      3328
#define XB_TOPGEN   3392
#define XCD_BAR_WORDS 3456
#define XB_SPIN_CAP (1u << 18)

__device__ __forceinline__ unsigned xb_ld(unsigned* p)              { return __hip_atomic_load(p, __ATOMIC_RELAXED, __HIP_MEMORY_SCOPE_AGENT); }
__device__ __forceinline__ unsigned xb_add(unsigned* p, unsigned v) { return __hip_atomic_fetch_add(p, v, __ATOMIC_RELAXED, __HIP_MEMORY_SCOPE_AGENT); }
__device__ __forceinline__ unsigned xb_xcc_id() { return (unsigned)__builtin_amdgcn_s_getreg((3 << 11) | 20) & 0xFu; }
#define XB_SPIN(cond, bar) do { unsigned _sp = 0; while (cond) { __builtin_amdgcn_s_sleep(1); \
    if ((++_sp & 255u) == 0u) { if (xb_ld(&(bar)[XB_TMO])) break; if (_sp > XB_SPIN_CAP) { atomicAdd(&(bar)[XB_TMO], 1u); break; } } } } while (0)

struct XcdBarrier {
    unsigned* bar; unsigned x;
    volatile LAS unsigned* st;
};

__device__ __forceinline__ XcdBarrier xcd_barrier_post(unsigned* bar, volatile LAS unsigned* st) {
    XcdBarrier b; b.bar = bar; b.x = xb_xcc_id(); b.st = st;
    if (threadIdx.x == 0) (void)xb_add(&bar[XB_XCNT(b.x)], 1u);
    return b;
}
__device__ __forceinline__ void xcd_barrier_complete(unsigned* bar, unsigned x, unsigned& nloc, unsigned& nx) {
    const unsigned G = gridDim.x * gridDim.y * gridDim.z;
    unsigned sum, cnt, mine, sp = 0u;
    for (;;) {
        sum = 0u; cnt = 0u; mine = 0u;
#pragma unroll
        for (unsigned j = 0; j < 16; ++j) { const unsigned c = xb_ld(&bar[XB_XCNT(j)]); sum += c; cnt += (c > 0u) ? 1u : 0u; mine = (j == x) ? c : mine; }
        if (sum == G) break;
        __builtin_amdgcn_s_sleep(1);
        if ((++sp & 255u) == 0u) { if (xb_ld(&bar[XB_TMO])) break; if (sp > XB_SPIN_CAP) { atomicAdd(&bar[XB_TMO], 1u); break; } }
    }
    nloc = mine > 0u ? mine : 1u; nx = cnt > 0u ? cnt : 1u;
}

__device__ __forceinline__ void xcd_barrier(const XcdBarrier& b) {
    asm volatile("s_waitcnt vmcnt(0)" ::: "memory");
    __syncthreads();
    if (threadIdx.x == 0) {
        unsigned* bar = b.bar;
        __builtin_amdgcn_s_waitcnt(0);
        unsigned nloc = b.st[0], nx = b.st[1];
        if (nloc == 0u) { xcd_barrier_complete(bar, b.x, nloc, nx); b.st[0] = nloc; b.st[1] = nx; }
        const unsigned old = xb_add(&bar[XB_XSUB(b.x)], 1u);
        const unsigned gen = old / nloc;
        if (old + 1u == (gen + 1u) * nloc) {
            __builtin_amdgcn_fence(__ATOMIC_RELEASE, "agent");
            asm volatile("s_waitcnt vmcnt(0)" ::: "memory");
            const unsigned og = xb_add(&bar[XB_TOP], 1u);
            const unsigned tg = og / nx;
            if (og + 1u == (tg + 1u) * nx) xb_add(&bar[XB_TOPGEN], 1u);
            else XB_SPIN(xb_ld(&bar[XB_TOPGEN]) == tg, bar);
            __builtin_amdgcn_fence(__ATOMIC_ACQUIRE, "agent");
            xb_add(&bar[XB_XGEN(b.x)], 1u);
            asm volatile("s_waitcnt vmcnt(0)" ::: "memory");
        } else {
            XB_SPIN(xb_ld(&bar[XB_XGEN(b.x)]) == gen, bar);
            __builtin_amdgcn_fence(__ATOMIC_ACQUIRE, "agent");
            asm volatile("s_waitcnt vmcnt(0)" ::: "memory");
        }
    }
    __syncthreads();
}

#ifndef PHMASK
#define PHMASK 0xFFFF
#endif
#ifndef DUPMASK
#define DUPMASK 0
#endif
#define PH(k) _Pragma("unroll 1") for (int rep_ = 0; rep_ < ((((PHMASK >> (k)) & 1) ? 1 : 0) + (((DUPMASK >> (k)) & 1) ? 1 : 0)); ++rep_)
#define GRID_BAR() do { XcdBarrier b_; b_.bar = (unsigned*)pws(pt); b_.x = xb_xcc_id(); b_.st = (volatile LAS unsigned*)(lds + LDS_BYTES - 512); xcd_barrier(b_); } while (0)
#ifndef TMASK
#define TMASK 0
#endif
#define TS_BEGIN(k) do { if (((TMASK >> (k)) & 1) && bx == 0 && tid == 0) { const unsigned long long t_ = __builtin_amdgcn_s_memrealtime(); *(volatile LAS unsigned*)(lds + LDS_BYTES - 128) = (unsigned)t_; } } while (0)
#define TS_END(k) do { if (((TMASK >> (k)) & 1) && bx == 0 && tid == 0) { const unsigned t_ = (unsigned)__builtin_amdgcn_s_memrealtime(); volatile LAS unsigned* a_ = (volatile LAS unsigned*)(lds + LDS_BYTES - 128); a_[1] += t_ - a_[0]; } } while (0)
#ifndef STAG
#define STAG 0
#endif
#define STAGGER(step_10ns) do { if (STAG) { const unsigned sg_ = ((unsigned)bx >> 3) & 1u; if (sg_) { const unsigned long long t0_ = __builtin_amdgcn_s_memrealtime(); \
        while (__builtin_amdgcn_s_memrealtime() - t0_ < (unsigned long long)(sg_ * (step_10ns))) __builtin_amdgcn_s_sleep(16); } __syncthreads(); } } while (0)
#define RB_ ((bf16_t*)(pws(pt) + WS_RB))
#define RLO_ ((bf16_t*)pout(pt) + (size_t)M_TOK * 1024)
#define RLOF_ ((bf16_t*)(pws(pt) + WS_RLO))
#define RBC_ ((bf16_t*)(pws(pt) + WS_BIG + 128 * MiB))
#define SS_(k) ((float*)(pws(pt) + WS_SSP) + (size_t)(k) * M_TOK * 4)
__global__ void __launch_bounds__(512, 2) fwd_kernel(Params P) {
    extern __shared__ __attribute__((aligned(16))) unsigned char lds_raw[];
    LAS unsigned char* lds = (LAS unsigned char*)lds_raw;
    cg::grid_group grid = cg::this_grid();
    const int tid = threadIdx.x, lane = tid & 63, wave = __builtin_amdgcn_readfirstlane(tid >> 6);
    const int G = gridDim.x, bx = blockIdx.x; const int gw = bx * 8 + wave, NGW = G * 8;
    PT pt = (PT)(lds + LDS_BYTES - 256);
    volatile LAS unsigned* xst = (volatile LAS unsigned*)(lds + LDS_BYTES - 512);
    if (tid == 0) { xst[0] = 0u; xst[1] = 0u; if (TMASK) { ((volatile LAS unsigned*)(lds + LDS_BYTES - 128))[1] = 0u; }
#pragma unroll
        for (int i = 0; i < 28; ++i) { const unsigned long long v = (unsigned long long)P.in[i]; pt[2 * i] = (unsigned)v; pt[2 * i + 1] = (unsigned)(v >> 32); }
        { const unsigned long long v = (unsigned long long)P.out; pt[56] = (unsigned)v; pt[57] = (unsigned)(v >> 32); }
        { const unsigned long long v = (unsigned long long)P.ws; pt[58] = (unsigned)v; pt[59] = (unsigned)(v >> 32); }
    }
    __syncthreads();
    (void)xcd_barrier_post((unsigned*)P.ws, xst);

    TS_BEGIN(0);
    PH(0) prologue(pt, lds, gw, NGW, lane, wave);
    __syncthreads();
    grid.sync(); TS_END(0);

#pragma unroll 1
    for (int layer = 0; layer < NL; ++layer) {
        TS_BEGIN(1); PH(1) { pg8::Gemm g{RB_, (const bf16_t*)(pws(pt) + WS_WIN) + (size_t)layer * 3328 * 1024, M_TOK, 3328, 1024}; pg8::StaticOrder S; S.init(M_TOK, 3328, G, bx);
          EpiStore E{SS_(3 * layer), {(bf16_t*)(pws(pt) + WS_PQKV), (bf16_t*)(pws(pt) + WS_PLX), (bf16_t*)(pws(pt) + WS_PZ), (bf16_t*)(pws(pt) + WS_PLG)}, {1536, 512, 512, 512}, {0, 6, 8, 10}, (float*)(pws(pt) + WS_GATES), 12};
          pg8::gemm_phase<EpiStore, pg8::StaticOrder, true, true>(lds, g, S, E);
          int tl = tid; asm volatile("" : "+v"(tl));
          const f32x4* ps = (const f32x4*)(pin(pt, I_P) + (size_t)layer * M_TOK * PLE); u32x2* pd = (u32x2*)(pws(pt) + WS_PB);
          for (size_t i = (size_t)bx * 512 + tl; i < (size_t)M_TOK * PLE / 4; i += (size_t)G * 512) pd[i] = pk4(ps[i]);
          }
        GRID_BAR(); TS_END(1);
        TS_BEGIN(2); PH(2) for (int bi = bx; bi < 256; bi += G) lru_block(pt, lds, bi, layer, tid);
        PH(3) { __syncthreads();
          { int tl = tid; asm volatile("" : "+v"(tl)); const int hh = (bx >> 5) & 3; const float* cwg = pin(pt, I_DNCW) + (size_t)layer * 4 * 1536;
            for (int e = tl; e < 1536; e += 512) { const int mat = e >> 9, tap = (e >> 7) & 3, ch = e & 127; ((LAS float*)(lds + DP_CWL))[e] = cwg[tap * 1536 + mat * 512 + hh * 128 + ch]; } }
          for (int it = bx; it < 4096; it += G) dp_item(pt, lds, it, layer, tid, lane, wave); }
        GRID_BAR(); TS_END(2);
        TS_BEGIN(4); PH(4) for (int it = bx; it < 256; it += G) dr_item(pt, lds, it, tid, lane, wave);
        GRID_BAR(); TS_END(4);
        TS_BEGIN(6); PH(6) m2_rows(pt, layer, gw, NGW, lane);
        GRID_BAR(); TS_END(6);
        TS_BEGIN(7); PH(7) { STAGGER(3700); pg8::Gemm g{(const bf16_t*)(pws(pt) + WS_AMIX), (const bf16_t*)(pws(pt) + WS_WOUT) + (size_t)layer * DM * DM, M_TOK, 1024, 1024}; pg8::StaticOrder S; S.init(M_TOK, 1024, G, bx);
          EpiResid<0> E{nullptr, RB_, RLO_, RLO_, SS_(3 * layer + 1), nullptr, nullptr, nullptr, nullptr, (LAS float*)(lds + 131072)};
          pg8::gemm_phase<EpiResid<0>, pg8::StaticOrder, true, true>(lds, g, S, E); }
        GRID_BAR(); TS_END(7);
        TS_BEGIN(9); PH(9) { pg8::Gemm g{RB_, (const bf16_t*)(pws(pt) + WS_WG) + (size_t)layer * 5632 * 1024, M_TOK, 5632, 1024}; pg8::StaticOrder S; S.init(M_TOK, 5632, G, bx);
          EpiGluF E{SS_(3 * layer + 1), (float*)(pws(pt) + WS_G), (float*)(pws(pt) + WS_G) + (size_t)256 * 4 * FF, pin(pt, I_FCW) + (size_t)layer * 3 * FF, pin(pt, I_FCB) + (size_t)layer * FF, (bf16_t*)(pws(pt) + WS_ACT), (LAS float*)(lds + 135168)};
          pg8::gemm_phase<EpiGluF, pg8::StaticOrder, true, true>(lds, g, S, E); }
        GRID_BAR(); TS_END(9);
        TS_BEGIN(8); PH(8) glu_fixup(pt, layer, bx, G, tid);
        GRID_BAR(); TS_END(8);
        TS_BEGIN(10); PH(10) { STAGGER(4800); pg8::Gemm g{(const bf16_t*)(pws(pt) + WS_ACT), (const bf16_t*)(pws(pt) + WS_WD) + (size_t)layer * DM * FF, M_TOK, 1024, FF}; pg8::StaticOrder S; S.init(M_TOK, 1024, G, bx);
          EpiResid<0> E{nullptr, RB_, RLO_, RLO_, SS_(3 * layer + 2), nullptr, nullptr, nullptr, RBC_, (LAS float*)(lds + 131072)};
          pg8::gemm_phase<EpiResid<0>, pg8::StaticOrder, true, true>(lds, g, S, E); }
        __syncthreads();
        PH(11) { pg8::Gemm g{(const bf16_t*)(pws(pt) + WS_PB), (const bf16_t*)(pws(pt) + WS_WP) + (size_t)layer * DM * PLE, M_TOK, 1024, PLE}; pg8::StaticOrder S; S.init(M_TOK, 1024, G, bx);
          EpiStore E{nullptr, {(bf16_t*)(pws(pt) + WS_PP), nullptr, nullptr, nullptr}, {1024, 0, 0, 0}, {0, 99, 99, 99}, nullptr, 99};
          pg8::gemm_phase<EpiStore, pg8::StaticOrder, true, true>(lds, g, S, E); }
        GRID_BAR(); TS_END(10);
        TS_BEGIN(12); PH(12) { STAGGER(3000); pg8::Gemm g{RBC_, (const bf16_t*)(pws(pt) + WS_WPG) + (size_t)layer * DM * DM, M_TOK, 1024, 1024}; pg8::StaticOrder S; S.init(M_TOK, 1024, G, bx);
          EpiResid<1> E{nullptr, RB_, RLO_, layer == NL - 1 ? RLOF_ : RLO_, SS_(3 * layer + 3), SS_(3 * layer + 2), pin(pt, I_PBG) + (size_t)layer * DM, (const bf16_t*)(pws(pt) + WS_PP), nullptr, (LAS float*)(lds + 131072)};
          pg8::gemm_phase<EpiResid<1>, pg8::StaticOrder, true, true>(lds, g, S, E); }
        GRID_BAR(); TS_END(12);
    }
    TS_BEGIN(13);
    { int tlf = tid; asm volatile("" : "+v"(tlf)); const int lane = tlf & 63;
      const float* ssF = SS_(12); const f32x4* fg = (const f32x4*)pin(pt, I_FING) + lane; const bf16_t* hi_ = RB_; const bf16_t* lo_ = RLOF_; float* outp = pout(pt);
      for (int m = gw; m < M_TOK; m += NGW) { const float sc = rs_of(ssF, m); f32x4* xr = (f32x4*)(outp + (size_t)m * DM) + lane;
          const u32x2* hr = (const u32x2*)(hi_ + (size_t)m * DM) + lane; const u32x2* lr = (const u32x2*)(lo_ + (size_t)m * DM) + lane;
#pragma unroll
          for (int j = 0; j < 4; ++j) { const u32x2 h = hr[64 * j], l = lr[64 * j]; const f32x4 g = fg[64 * j];
              f32x4 v; v[0] = (bflo(h.x) + bflo(l.x)) * sc * g[0]; v[1] = (bfhi(h.x) + bfhi(l.x)) * sc * g[1]; v[2] = (bflo(h.y) + bflo(l.y)) * sc * g[2]; v[3] = (bfhi(h.y) + bfhi(l.y)) * sc * g[3];
              xr[64 * j] = v; } } }
    if (TMASK) { __syncthreads(); TS_END(13); if (bx == 0 && tid == 0) { const unsigned wait_ = ((volatile LAS unsigned*)(lds + LDS_BYTES - 128))[1]; const unsigned long long t0_ = __builtin_amdgcn_s_memrealtime(); while (__builtin_amdgcn_s_memrealtime() - t0_ < (unsigned long long)wait_) __builtin_amdgcn_s_sleep(8); } }
}

extern "C" void kernel_launch(void* const* d_in, const int* in_sizes, int n_in, void* d_out, int out_size, void* d_ws, size_t ws_size, hipStream_t stream) {
    static int grid = 0;
    if (grid == 0) {
        if (n_in != 28 || ws_size < WS_END) { fprintf(stderr, "kernel_launch: unexpected n_in %d or workspace %zu < %zu\n", n_in, ws_size, (size_t)WS_END); grid = -1; return; }
        int dev = 0, cus = 0, per_cu = 0;
        hipGetDevice(&dev); hipDeviceGetAttribute(&cus, hipDeviceAttributeMultiprocessorCount, dev);
        if (hipFuncSetAttribute((const void*)fwd_kernel, hipFuncAttributeMaxDynamicSharedMemorySize, LDS_BYTES) != hipSuccess) fprintf(stderr, "kernel_launch: hipFuncSetAttribute failed\n");
        if (hipOccupancyMaxActiveBlocksPerMultiprocessor(&per_cu, (const void*)fwd_kernel, 512, LDS_BYTES) != hipSuccess || per_cu < 1) { fprintf(stderr, "kernel_launch: occupancy query says %d\n", per_cu); per_cu = 1; }
        (void)hipGetLastError();
        grid = cus * per_cu; if (grid > 256) grid = 256;
    }
    if (grid < 0) return;
    if (hipMemsetAsync(d_ws, 0, 16384, stream) != hipSuccess) { fprintf(stderr, "kernel_launch: memset of the barrier words failed\n"); return; }
    Params p{};
    for (int i = 0; i < 28; ++i) p.in[i] = (const float*)d_in[i];
    p.out = (float*)d_out; p.ws = (unsigned char*)d_ws;
    void* args[] = {&p};
    hipError_t e = hipLaunchCooperativeKernel((const void*)fwd_kernel, dim3(grid), dim3(512), args, LDS_BYTES, stream);
    if (e != hipSuccess) fprintf(stderr, "cooperative launch failed: %s (grid %d)\n", hipGetErrorString(e), grid);
}
```

```cpp
#include <hip/hip_runtime.h>
#include <hip/hip_cooperative_groups.h>
#include <cstdio>
#include <cstdint>
namespace cg = cooperative_groups;

#define LAS __attribute__((address_space(3)))
typedef unsigned short bf16_t;
typedef short bf16x8 __attribute__((ext_vector_type(8)));
typedef short s16x4 __attribute__((ext_vector_type(4)));
typedef float f32x2 __attribute__((ext_vector_type(2)));
typedef float f32x4 __attribute__((ext_vector_type(4)));
typedef float f32x16 __attribute__((ext_vector_type(16)));
typedef unsigned u32x4 __attribute__((ext_vector_type(4)));
typedef unsigned u32x2 __attribute__((ext_vector_type(2)));
typedef __bf16 bfx2_t __attribute__((ext_vector_type(2)));

constexpr int M_TOK = 65536, DM = 1024, SEQ = 2048, NB = 32, NL = 4;
constexpr int FF = 2816, PLE = 256, INC = 3088;
constexpr float EPS = 1e-6f;

constexpr size_t MiB = 1u << 20;
constexpr size_t WS_SS = 0;
constexpr size_t WS_WIN = 4 * MiB;
constexpr size_t WS_WOUT = WS_WIN + 26 * MiB;
constexpr size_t WS_WG = WS_WOUT + 8 * MiB;
constexpr size_t WS_WU = WS_WG + 22 * MiB;
constexpr size_t WS_WD = WS_WU + 22 * MiB;
constexpr size_t WS_WPG = WS_WD + 22 * MiB;
constexpr size_t WS_WP = WS_WPG + 8 * MiB;
constexpr size_t WS_WAT = WS_WP + 2 * MiB;
constexpr size_t WS_GATES = WS_WAT + 1 * MiB;
constexpr size_t WS_VEC = WS_GATES + 4 * MiB;
constexpr size_t WS_PB = WS_VEC + 8 * MiB;
constexpr size_t WS_RB = WS_PB + 32 * MiB;
constexpr size_t WS_BIG = WS_RB + 128 * MiB;
constexpr size_t WS_PQKV = WS_BIG;
constexpr size_t WS_OF = WS_BIG, WS_OB = WS_BIG + 64 * MiB, WS_PZ = WS_BIG + 576 * MiB;
constexpr size_t WS_PLX = WS_BIG + 192 * MiB, WS_PLG = WS_BIG + 640 * MiB;
constexpr size_t WS_QH = WS_BIG + 256 * MiB, WS_KH = WS_BIG + 320 * MiB, WS_VT = WS_BIG + 384 * MiB;
constexpr size_t WS_TM = WS_BIG + 448 * MiB, WS_AT = WS_BIG + 512 * MiB;
constexpr size_t WS_RLO = WS_BIG + 576 * MiB;
constexpr size_t WS_AMIX = WS_BIG + 256 * MiB;
constexpr size_t WS_G = WS_BIG, WS_ACT = WS_BIG + 352 * MiB, WS_PP = WS_BIG;
constexpr size_t WS_SSP = WS_BIG + 704 * MiB;
constexpr size_t WS_END = WS_SSP + 13 * MiB;
constexpr int LDS_BYTES = 153600;

__device__ __forceinline__ unsigned pk2(float lo, float hi) { f32x2 v = {lo, hi}; bfx2_t b = __builtin_convertvector(v, bfx2_t); return __builtin_bit_cast(unsigned, b); }
__device__ __forceinline__ u32x2 pk4(f32x4 v) { u32x2 r; r.x = pk2(v[0], v[1]); r.y = pk2(v[2], v[3]); return r; }
__device__ __forceinline__ float bflo(unsigned w) { return __uint_as_float(w << 16); }
__device__ __forceinline__ float bfhi(unsigned w) { return __uint_as_float(w & 0xffff0000u); }
__device__ __forceinline__ float bf2f(unsigned short b) { return __uint_as_float((unsigned)b << 16); }
__device__ __forceinline__ float fexp(float x) { return __builtin_amdgcn_exp2f(x * 1.4426950408889634f); }
__device__ __forceinline__ float sigm(float x) { return __builtin_amdgcn_rcpf(1.0f + fexp(-x)); }
__device__ __forceinline__ float gelu_t(float x) { const float u = 1.5957691216057308f * (x + 0.044715f * x * x * x); return x * __builtin_amdgcn_rcpf(1.0f + fexp(-u)); }
__device__ __forceinline__ float softplus_f(float x) { return x > 20.f ? x : log1pf(expf(x)); }
__device__ __forceinline__ int swz128(int row, int col) { return row * 256 + ((((col >> 3) ^ (row & 15)) << 4) | ((col & 7) << 1)); }
__device__ __forceinline__ int swz64(int row, int col) { return row * 128 + ((((col >> 3) ^ (row & 7)) << 4) | ((col & 7) << 1)); }
__device__ __forceinline__ int crow(int r, int hi) { return (r & 3) + 8 * (r >> 2) + 4 * hi; }
#define MFMA16(a, b, c) __builtin_amdgcn_mfma_f32_16x16x32_bf16((a), (b), (c), 0, 0, 0)
#define MFMA32(a, b, c) __builtin_amdgcn_mfma_f32_32x32x16_bf16((a), (b), (c), 0, 0, 0)
typedef unsigned long long u64;
__device__ __forceinline__ float rs_of(const float* ss4, int row) { const f32x4 p = *(const f32x4*)(ss4 + (size_t)row * 4); return rsqrtf(((p[0] + p[1]) + (p[2] + p[3])) * (1.0f / 1024.0f) + EPS); }
#define LDS_FENCE() asm volatile("s_waitcnt lgkmcnt(0)" ::: "memory")

#define LBAR() do { asm volatile("s_waitcnt lgkmcnt(0)" ::: "memory"); __builtin_amdgcn_s_barrier(); asm volatile("" ::: "memory"); } while (0)

namespace pg8 {
#define PG8_LAS __attribute__((address_space(3)))
typedef unsigned short bf16_t;
typedef short bf16x8 __attribute__((ext_vector_type(8)));
typedef float f32x4 __attribute__((ext_vector_type(4)));
typedef unsigned u32x4 __attribute__((ext_vector_type(4)));
constexpr int BM = 256, BK = 64, HALF = 128, HTB = HALF * BK * 2  , STAGE_BYTES = 8 * HTB, NXCD = 8, WGM = 8;

__host__ __device__ __forceinline__ int lds_byte(int r, int c) { const int st = (r >> 4) * 2 + (c >> 5), rr = r & 15, cc = c & 31, ob = rr * 64 + cc * 2; return st * 1024 + (ob ^ (((ob >> 9) & 1) << 5)); }
__host__ __device__ __forceinline__ void stage_rc(int b, int& R, int& C) { const int st = b / 1024, sb = b % 1024, swz = sb ^ (((sb >> 9) & 1) << 5); R = (st >> 1) * 16 + swz / 64; C = (st & 1) * 32 + (swz % 64) / 2; }
__host__ __device__ __forceinline__ int perm32(int rho) { const int n = rho >> 4, i = rho & 15; return 8 * (i >> 2) + 4 * n + (i & 3); }

struct Unit { int pm, pn; };
struct Gemm { const bf16_t* A; const bf16_t* Bt; int M, N, K; };

struct StaticOrder {
    int nM, nN, nwg, G, c;
    __host__ __device__ void init(int M, int N, int G_, int c_) { nM = M / BM; nN = N / BM; nwg = nM * nN; G = G_; c = c_; }
    __host__ __device__ bool next(int i, Unit& u) const {
        const long L = (long)i * G + c; if (L >= nwg) return false;
        int wgid = (int)L; { const int q = nwg / NXCD, r = nwg % NXCD, xcd = wgid % NXCD, off = wgid / NXCD; wgid = (xcd < r ? xcd * (q + 1) : r * (q + 1) + (xcd - r) * q) + off; }
        const int nig = WGM * nN, gid = wgid / nig, fm = gid * WGM, gsz = (nM - fm) < WGM ? (nM - fm) : WGM;
        u.pm = fm + ((wgid % nig) % gsz); u.pn = (wgid % nig) / gsz; return true;
    }
    __device__ __forceinline__ void a_ready(const Unit&) const {}
    __device__ __forceinline__ void done(const Unit&) const {}
};

template <class Epi, class Sched, bool ALIGN_EPI = false, bool SP2 = false>
__device__ __forceinline__ void gemm_phase(PG8_LAS unsigned char* lds, const Gemm g, const Sched& S, const Epi& E) {
    int tid_ = threadIdx.x; asm volatile("" : "+v"(tid_));
    const int tid = tid_, wid = __builtin_amdgcn_readfirstlane(tid >> 6), lane = tid & 63, wr = wid >> 2, wc = wid & 3, fr = lane & 15, fq = lane >> 4;
    const int K = g.K, nt = K / BK;
    unsigned voffA[2], voffB[2];
#pragma unroll
    for (int i = 0; i < 2; ++i) { int R, C; stage_rc(tid * 16 + i * 8192, R, C); const int Rb = Epi::PERM ? ((R & ~31) + perm32(R & 31)) : R;
        voffA[i] = (unsigned)(R * K + C) * 2u; voffB[i] = (unsigned)(Rb * K + C) * 2u; }
    const size_t kstep = (size_t)(BK * 2);
    const size_t hstep = (size_t)HALF * K * 2;
    const size_t tstep = 2 * hstep;
    const unsigned ldsw = (unsigned)wid * 1024u;
    const int aoff = lds_byte(wr * 64 + fr, fq * 8), boff = lds_byte(wc * 32 + fr, fq * 8);
#define PG8_SA(b, h) (((b) * 2 + (h)) * HTB)
#define PG8_SB(b, h) ((4 + (b) * 2 + (h)) * HTB)
#define PG8_STAGE(bufoff, gbase, voff) do { _Pragma("unroll") for (int _i = 0; _i < 2; ++_i) \
        __builtin_amdgcn_global_load_lds((const unsigned*)((const char*)(gbase) + (voff)[_i]), (PG8_LAS unsigned*)(lds + (bufoff) + ldsw + _i * 8192), 16, 0, 0); } while (0)
#define PG8_LDA(dst, b, h) do { _Pragma("unroll") for (int m = 0; m < 4; ++m) _Pragma("unroll") for (int k = 0; k < 2; ++k) dst[m][k] = *(const PG8_LAS bf16x8*)(lds + PG8_SA(b, h) + aoff + m * 2048 + k * 1024); } while (0)
#define PG8_LDB(dst, b, h) do { _Pragma("unroll") for (int n = 0; n < 2; ++n) _Pragma("unroll") for (int k = 0; k < 2; ++k) dst[n][k] = *(const PG8_LAS bf16x8*)(lds + PG8_SB(b, h) + boff + n * 2048 + k * 1024); } while (0)
#define PG8_MMA(ai, bj, At, Bt) do { __builtin_amdgcn_s_setprio(1); _Pragma("unroll") for (int m = 0; m < 4; ++m) _Pragma("unroll") for (int n = 0; n < 2; ++n) _Pragma("unroll") for (int k = 0; k < 2; ++k) \
        acc[ai][bj][m][n] = __builtin_amdgcn_mfma_f32_16x16x32_bf16(Bt[n][k], At[m][k], acc[ai][bj][m][n], 0, 0, 0); __builtin_amdgcn_s_setprio(0); } while (0)
#define PG8_WAIT_V(n) asm volatile("s_waitcnt vmcnt(" #n ")" ::: "memory")
#define PG8_WAIT_L(n) asm volatile("s_waitcnt lgkmcnt(" #n ")" ::: "memory")
#define PG8_BAR __builtin_amdgcn_s_barrier()
#define PG8_SCHED __builtin_amdgcn_sched_barrier(0)
    Unit cur, nxt; int ui = 0;
    if (!S.next(0, cur)) return;
    f32x4 acc[2][2][4][2];
#pragma unroll
    for (int a = 0; a < 2; ++a)
#pragma unroll
        for (int b = 0; b < 2; ++b)
#pragma unroll
            for (int m = 0; m < 4; ++m)
#pragma unroll
                for (int n = 0; n < 2; ++n) acc[a][b][m][n] = (f32x4){0.f, 0.f, 0.f, 0.f};
    bf16x8 At[4][2], B0[2][2], B1[2][2];
    const char* cA = (const char*)g.A + (size_t)cur.pm * tstep; const char* cB = (const char*)g.Bt + (size_t)cur.pn * tstep;
    S.a_ready(cur);
    if constexpr (SP2) {
        PG8_STAGE(PG8_SB(0, 0), cB, voffB); PG8_STAGE(PG8_SB(0, 1), cB + hstep, voffB); PG8_STAGE(PG8_SA(0, 0), cA, voffA); PG8_STAGE(PG8_SA(0, 1), cA + hstep, voffA);
        if (wr == 1) PG8_BAR;
        PG8_WAIT_V(2); PG8_BAR;
        PG8_STAGE(PG8_SB(1, 0), cB + kstep, voffB); PG8_STAGE(PG8_SA(1, 0), cA + kstep, voffA); PG8_STAGE(PG8_SB(1, 1), cB + hstep + kstep, voffB);
        PG8_WAIT_V(6); PG8_BAR;
    } else {
        PG8_STAGE(PG8_SB(0, 0), cB, voffB); PG8_STAGE(PG8_SA(0, 0), cA, voffA); PG8_STAGE(PG8_SB(0, 1), cB + hstep, voffB); PG8_STAGE(PG8_SA(0, 1), cA + hstep, voffA);
        if (wr == 1) PG8_BAR;
        PG8_WAIT_V(4); PG8_BAR;
        PG8_STAGE(PG8_SB(1, 0), cB + kstep, voffB); PG8_STAGE(PG8_SA(1, 0), cA + kstep, voffA); PG8_STAGE(PG8_SB(1, 1), cB + hstep + kstep, voffB);
        PG8_WAIT_V(6); PG8_BAR;
    }
    for (;;) {
        const bool has_next = S.next(ui + 1, nxt);
        const char* nA = has_next ? (const char*)g.A + (size_t)nxt.pm * tstep : cA; const char* nB = has_next ? (const char*)g.Bt + (size_t)nxt.pn * tstep : cB;
        for (int t = 0; t < nt; t += 2) {
            const bool last = (t == nt - 2);
            const char* a1 = cA + (size_t)(t + 1) * kstep;
            const char* a2 = last ? nA : cA + (size_t)(t + 2) * kstep; const char* b2 = last ? nB : cB + (size_t)(t + 2) * kstep;
            const char* a3 = a2 + kstep; const char* b3 = b2 + kstep;
            if (last && has_next) S.a_ready(nxt);
            if constexpr (SP2) {
            PG8_LDB(B0, 0, 0); PG8_LDB(B1, 0, 1); PG8_SCHED; PG8_LDA(At, 0, 0); PG8_STAGE(PG8_SA(1, 1), a1 + hstep, voffA);
            PG8_WAIT_V(8); PG8_WAIT_L(0); PG8_BAR; PG8_MMA(0, 0, At, B0); PG8_MMA(0, 1, At, B1); PG8_BAR; PG8_SCHED;
            PG8_LDA(At, 0, 1); PG8_STAGE(PG8_SB(0, 0), b2, voffB); PG8_STAGE(PG8_SB(0, 1), b2 + hstep, voffB); PG8_STAGE(PG8_SA(0, 0), a2, voffA);
            PG8_WAIT_V(8); PG8_WAIT_L(0); PG8_BAR; PG8_MMA(1, 0, At, B0); PG8_MMA(1, 1, At, B1); PG8_BAR; PG8_SCHED;
            PG8_LDB(B0, 1, 0); PG8_LDB(B1, 1, 1); PG8_SCHED; PG8_LDA(At, 1, 0); PG8_STAGE(PG8_SA(0, 1), a2 + hstep, voffA);
            PG8_WAIT_V(8); PG8_WAIT_L(0); PG8_BAR; PG8_MMA(0, 0, At, B0); PG8_MMA(0, 1, At, B1); PG8_BAR; PG8_SCHED;
            PG8_LDA(At, 1, 1); PG8_STAGE(PG8_SB(1, 0), b3, voffB); PG8_STAGE(PG8_SB(1, 1), b3 + hstep, voffB); PG8_STAGE(PG8_SA(1, 0), a3, voffA);
            PG8_WAIT_V(8); PG8_WAIT_L(0); PG8_BAR; PG8_MMA(1, 0, At, B0); PG8_MMA(1, 1, At, B1); PG8_BAR; PG8_SCHED;
            } else {
            PG8_LDB(B0, 0, 0); PG8_SCHED; PG8_LDA(At, 0, 0); PG8_STAGE(PG8_SA(1, 1), a1 + hstep, voffA);
            PG8_WAIT_L(8); PG8_BAR; PG8_WAIT_L(0); PG8_MMA(0, 0, At, B0); PG8_BAR; PG8_SCHED;
            PG8_LDB(B1, 0, 1); PG8_STAGE(PG8_SB(0, 0), b2, voffB);
            PG8_BAR; PG8_WAIT_L(0); PG8_MMA(0, 1, At, B1); PG8_BAR;
            PG8_LDA(At, 0, 1); PG8_STAGE(PG8_SA(0, 0), a2, voffA);
            PG8_BAR; PG8_WAIT_L(0); PG8_MMA(1, 0, At, B0); PG8_BAR; PG8_SCHED;
            PG8_STAGE(PG8_SB(0, 1), b2 + hstep, voffB);
            PG8_WAIT_V(6); PG8_BAR; PG8_MMA(1, 1, At, B1); PG8_BAR;
            PG8_LDB(B0, 1, 0); PG8_SCHED; PG8_LDA(At, 1, 0); PG8_STAGE(PG8_SA(0, 1), a2 + hstep, voffA);
            PG8_WAIT_L(8); PG8_BAR; PG8_WAIT_L(0); PG8_MMA(0, 0, At, B0); PG8_BAR; PG8_SCHED;
            PG8_LDB(B1, 1, 1); PG8_STAGE(PG8_SB(1, 0), b3, voffB);
            PG8_BAR; PG8_WAIT_L(0); PG8_MMA(0, 1, At, B1); PG8_BAR;
            PG8_LDA(At, 1, 1); PG8_STAGE(PG8_SA(1, 0), a3, voffA);
            PG8_BAR; PG8_WAIT_L(0); PG8_MMA(1, 0, At, B0); PG8_BAR; PG8_SCHED;
            PG8_STAGE(PG8_SB(1, 1), b3 + hstep, voffB);
            PG8_WAIT_V(6); PG8_BAR; PG8_MMA(1, 1, At, B1); PG8_BAR;
            }
        }
        if constexpr (ALIGN_EPI) { if (wr == 0) PG8_BAR; }
        if constexpr (!Epi::AFTER_DRAIN) { E(acc, cur, wr, wc, fr, fq); S.done(cur); }
        if (!has_next) break;
#pragma unroll
        for (int a = 0; a < 2; ++a)
#pragma unroll
            for (int b = 0; b < 2; ++b)
#pragma unroll
                for (int m = 0; m < 4; ++m)
#pragma unroll
                    for (int n = 0; n < 2; ++n) acc[a][b][m][n] = (f32x4){0.f, 0.f, 0.f, 0.f};
        cur = nxt; cA = nA; cB = nB; ++ui;
        if constexpr (ALIGN_EPI) { if (wr == 1) PG8_BAR; }
    }
    PG8_WAIT_V(0);
    if constexpr (!ALIGN_EPI) { if (wr == 0) PG8_BAR; }
    PG8_BAR;
    if constexpr (Epi::AFTER_DRAIN) { E.fused(acc, cur, wr, wc, fr, fq, lds, wid, lane); S.done(cur); }
#undef PG8_SA
#undef PG8_SB
#undef PG8_STAGE
#undef PG8_LDA
#undef PG8_LDB
#undef PG8_MMA
#undef PG8_WAIT_V
#undef PG8_WAIT_L
#undef PG8_BAR
#undef PG8_SCHED
}
}

using pg8::Unit;
struct EpiStore {
    static constexpr bool PERM = true, AFTER_DRAIN = false;
    const float* ss; bf16_t* base[4]; int ld[4]; int ts[4]; float* gates; int t2;
    __device__ __forceinline__ void operator()(const f32x4 (&acc)[2][2][4][2], const Unit& u, int wr, int wc, int fr, int fq) const {
        const int row0 = u.pm * 256 + wr * 64 + fr; const int pn = u.pn;
        if (pn >= t2) {
            if (wc == 0 && fq < 2) {
#pragma unroll
                for (int ai = 0; ai < 2; ++ai)
#pragma unroll
                    for (int m = 0; m < 4; ++m) { const int row = row0 + ai * 128 + m * 16; const float s = ss ? rs_of(ss, row) : 1.f;
                        float* gp = gates + (size_t)row * 16 + 8 * fq; *(f32x4*)gp = acc[ai][0][m][0] * s; *(f32x4*)(gp + 4) = acc[ai][0][m][1] * s; }
            }
            return;
        }
        int k = 0; if (pn >= ts[1]) k = 1; if (pn >= ts[2]) k = 2; if (pn >= ts[3]) k = 3;
        bf16_t* bsel = base[0]; int ldsel = ld[0], t0 = ts[0];
        if (k == 1) { bsel = base[1]; ldsel = ld[1]; t0 = ts[1]; } else if (k == 2) { bsel = base[2]; ldsel = ld[2]; t0 = ts[2]; } else if (k == 3) { bsel = base[3]; ldsel = ld[3]; t0 = ts[3]; }
        const int col0 = (pn - t0) * 256 + wc * 32 + 8 * fq;
#pragma unroll
        for (int ai = 0; ai < 2; ++ai)
#pragma unroll
            for (int m = 0; m < 4; ++m) { const int row = row0 + ai * 128 + m * 16; const float s = ss ? rs_of(ss, row) : 1.f;
                bf16_t* rowp = bsel + (size_t)row * ldsel + col0;
#pragma unroll
                for (int bj = 0; bj < 2; ++bj) { const f32x4 v0 = acc[ai][bj][m][0] * s, v1 = acc[ai][bj][m][1] * s;
                    u32x4 w; w.x = pk2(v0[0], v0[1]); w.y = pk2(v0[2], v0[3]); w.z = pk2(v1[0], v1[1]); w.w = pk2(v1[2], v1[3]);
                    *(u32x4*)(rowp + bj * 128) = w; } }
    }
};

#ifndef RES_BM
#define RES_BM 4
#endif
#ifndef RES1_BM
#define RES1_BM 2
#endif
template <int MODE> struct EpiResid {
    static constexpr bool PERM = true, AFTER_DRAIN = false;
    const float* rin32; bf16_t* rb; const bf16_t* rlo; bf16_t* rlo_w; float* ss_out; const float* ss_in; const float* bias; const bf16_t* pp; bf16_t* rb2; LAS float* sl;
    __device__ __forceinline__ void ld_r(size_t off, f32x4& r0, f32x4& r1) const {
        if (rin32) { r0 = *(const f32x4*)(rin32 + off); r1 = *(const f32x4*)(rin32 + off + 4); }
        else { const u32x4 h = *(const u32x4*)(rb + off), l = *(const u32x4*)(rlo + off);
            r0[0] = bflo(h.x) + bflo(l.x); r0[1] = bfhi(h.x) + bfhi(l.x); r0[2] = bflo(h.y) + bflo(l.y); r0[3] = bfhi(h.y) + bfhi(l.y);
            r1[0] = bflo(h.z) + bflo(l.z); r1[1] = bfhi(h.z) + bfhi(l.z); r1[2] = bflo(h.w) + bflo(l.w); r1[3] = bfhi(h.w) + bfhi(l.w); }
    }
    __device__ __forceinline__ float st_r(size_t off, const f32x4& r0, const f32x4& r1) const {
        u32x4 w; w.x = pk2(r0[0], r0[1]); w.y = pk2(r0[2], r0[3]); w.z = pk2(r1[0], r1[1]); w.w = pk2(r1[2], r1[3]);
        u32x4 l; l.x = pk2(r0[0] - bflo(w.x), r0[1] - bfhi(w.x)); l.y = pk2(r0[2] - bflo(w.y), r0[3] - bfhi(w.y)); l.z = pk2(r1[0] - bflo(w.z), r1[1] - bfhi(w.z)); l.w = pk2(r1[2] - bflo(w.w), r1[3] - bfhi(w.w));
        *(u32x4*)(rb + off) = w; *(u32x4*)(rlo_w + off) = l; if (rb2) *(u32x4*)(rb2 + off) = w;
        return (r0[0] * r0[0] + r0[1] * r0[1]) + (r0[2] * r0[2] + r0[3] * r0[3]) + (r1[0] * r1[0] + r1[1] * r1[1]) + (r1[2] * r1[2] + r1[3] * r1[3]);
    }
    __device__ __forceinline__ void operator()(const f32x4 (&acc)[2][2][4][2], const Unit& u, int wr, int wc, int fr, int fq) const {
        run<false>(acc, u, wr, wc, fr, fq);
    }
    template <bool F32IN> __device__ __forceinline__ void run(const f32x4 (&acc)[2][2][4][2], const Unit& u, int wr, int wc, int fr, int fq) const {
        const int row0 = u.pm * 256 + wr * 64 + fr; const int col0 = u.pn * 256 + wc * 32 + 8 * fq;
        float sqa[2][4] = {{0.f, 0.f, 0.f, 0.f}, {0.f, 0.f, 0.f, 0.f}}; float sina[2][4]; f32x4 bia[2][2];
#pragma unroll
        for (int ai = 0; ai < 2; ++ai)
#pragma unroll
            for (int m = 0; m < 4; ++m) sina[ai][m] = (MODE == 1) ? rs_of(ss_in, row0 + ai * 128 + m * 16) : 1.f;
#pragma unroll
        for (int bj = 0; bj < 2; ++bj) { bia[bj][0] = (f32x4){0.f, 0.f, 0.f, 0.f}; bia[bj][1] = (f32x4){0.f, 0.f, 0.f, 0.f};
            if (MODE == 1) { bia[bj][0] = *(const f32x4*)(bias + col0 + bj * 128); bia[bj][1] = *(const f32x4*)(bias + col0 + bj * 128 + 4); } }
        constexpr int RPB = (MODE == 1) ? 1 : 2;
        constexpr int NBAT = 16 / RPB;
        u32x4 ph[2][RPB], pl[2][RPB], pw[2][RPB];
#define RES_AI(b_) ((b_) / (8 / RPB))
#define RES_BJ(b_) (((b_) / (4 / RPB)) & 1)
#define RES_MH(b_) (((b_) % (4 / RPB)) * RPB)
#define RES_OFF(b_, m_) ((size_t)(row0 + RES_AI(b_) * 128 + (RES_MH(b_) + (m_)) * 16) * 1024 + col0 + RES_BJ(b_) * 128)
#define RES_LOAD(b_, buf_) do { _Pragma("unroll") for (int m_ = 0; m_ < RPB; ++m_) { const size_t off_ = RES_OFF(b_, m_); ph[buf_][m_] = *(const u32x4*)(rb + off_); pl[buf_][m_] = *(const u32x4*)(rlo + off_); \
            if (MODE == 1) pw[buf_][m_] = *(const u32x4*)(pp + off_); } } while (0)
        __builtin_amdgcn_sched_barrier(0);
        RES_LOAD(0, 0);
        __builtin_amdgcn_sched_barrier(0);
#pragma unroll
        for (int b = 0; b < NBAT; ++b) { const int buf = b & 1; const int ai = RES_AI(b), bj = RES_BJ(b), mh = RES_MH(b);
            if (b + 1 < NBAT) { RES_LOAD(b + 1, buf ^ 1); }
            __builtin_amdgcn_sched_barrier(0);
            const f32x4 b0 = bia[bj][0], b1 = bia[bj][1];
#pragma unroll
            for (int m = 0; m < RPB; ++m) { const size_t off = RES_OFF(b, m); const float si = sina[ai][mh + m]; const u32x4 h = ph[buf][m], l = pl[buf][m];
                f32x4 p0, p1;
                p0[0] = bflo(h.x) + bflo(l.x); p0[1] = bfhi(h.x) + bfhi(l.x); p0[2] = bflo(h.y) + bflo(l.y); p0[3] = bfhi(h.y) + bfhi(l.y);
                p1[0] = bflo(h.z) + bflo(l.z); p1[1] = bfhi(h.z) + bfhi(l.z); p1[2] = bflo(h.w) + bflo(l.w); p1[3] = bfhi(h.w) + bfhi(l.w);
                f32x4 a0 = acc[ai][bj][mh + m][0], a1 = acc[ai][bj][mh + m][1];
                if (MODE == 1) { const u32x4 w = pw[buf][m];
                    a0[0] = sigm(a0[0] * si + b0[0]) * bflo(w.x); a0[1] = sigm(a0[1] * si + b0[1]) * bfhi(w.x);
                    a0[2] = sigm(a0[2] * si + b0[2]) * bflo(w.y); a0[3] = sigm(a0[3] * si + b0[3]) * bfhi(w.y);
                    a1[0] = sigm(a1[0] * si + b1[0]) * bflo(w.z); a1[1] = sigm(a1[1] * si + b1[1]) * bfhi(w.z);
                    a1[2] = sigm(a1[2] * si + b1[2]) * bflo(w.w); a1[3] = sigm(a1[3] * si + b1[3]) * bfhi(w.w); }
                const f32x4 r0 = p0 + a0, r1 = p1 + a1;
                sqa[ai][mh + m] += st_r(off, r0, r1); }
            __builtin_amdgcn_sched_barrier(0);
        }
#undef RES_AI
#undef RES_BJ
#undef RES_MH
#undef RES_LOAD
#undef RES_OFF
#pragma unroll
        for (int ai = 0; ai < 2; ++ai)
#pragma unroll
            for (int m = 0; m < 4; ++m) { float q = sqa[ai][m]; q += __shfl_xor(q, 16); q += __shfl_xor(q, 32);
                if (fq == 0) sl[(ai * 128 + wr * 64 + m * 16 + fr) * 4 + wc] = q; }
        asm volatile("s_waitcnt lgkmcnt(0)" ::: "memory"); __builtin_amdgcn_s_barrier(); asm volatile("" ::: "memory");
        if (fq == 0) {
#pragma unroll
            for (int ai = 0; ai < 2; ++ai) { const int r = ai * 128 + wr * 64 + wc * 16 + fr; const f32x4 p = *(const LAS f32x4*)(sl + r * 4);
                ss_out[(size_t)(u.pm * 256 + r) * 4 + u.pn] = (p[0] + p[1]) + (p[2] + p[3]); } }
    }
};

#ifndef GLU_BM
#define GLU_BM 2
#endif
struct EpiGlu {
    static constexpr bool PERM = true, AFTER_DRAIN = false;
    const float* ss; const bf16_t* G; const float* cw; const float* cb; bf16_t* act;
    __device__ __forceinline__ void operator()(const f32x4 (&acc)[2][2][4][2], const Unit& u, int wr, int wc, int fr, int fq) const {
        const int row0 = u.pm * 256 + wr * 64 + fr; const int col0 = u.pn * 256 + wc * 32 + 8 * fq;
#pragma unroll
        for (int bj = 0; bj < 2; ++bj) { const int c = col0 + bj * 128;
            const f32x4 w0a = *(const f32x4*)(cw + c), w0b = *(const f32x4*)(cw + c + 4), w1a = *(const f32x4*)(cw + FF + c), w1b = *(const f32x4*)(cw + FF + c + 4);
            const f32x4 w2a = *(const f32x4*)(cw + 2 * FF + c), w2b = *(const f32x4*)(cw + 2 * FF + c + 4), bba = *(const f32x4*)(cb + c), bbb = *(const f32x4*)(cb + c + 4);
#pragma unroll
            for (int ai = 0; ai < 2; ++ai)
#pragma unroll
            for (int mh = 0; mh < 4; mh += GLU_BM) {
                u32x4 gmv[GLU_BM], glv[GLU_BM], gnv[GLU_BM]; float sv[GLU_BM];
#pragma unroll
                for (int m = 0; m < GLU_BM; ++m) { const int row = row0 + ai * 128 + (mh + m) * 16; const int t = row & (SEQ - 1); const bf16_t* gp = G + (size_t)row * FF + c;
                    gmv[m] = *(const u32x4*)gp; glv[m] = (u32x4){0u, 0u, 0u, 0u}; gnv[m] = (u32x4){0u, 0u, 0u, 0u};
                    if (t > 0) glv[m] = *(const u32x4*)(gp - FF);
                    if (t < SEQ - 1) gnv[m] = *(const u32x4*)(gp + FF);
                    sv[m] = rs_of(ss, row); }
#pragma unroll
                for (int m = 0; m < GLU_BM; ++m) { const int row = row0 + ai * 128 + (mh + m) * 16; const float s = sv[m]; const u32x4 gm = gmv[m], gl = glv[m], gn = gnv[m];
                    f32x4 ga, gb;
                    ga[0] = w0a[0] * bflo(gl.x) + w1a[0] * bflo(gm.x) + w2a[0] * bflo(gn.x) + bba[0];
                    ga[1] = w0a[1] * bfhi(gl.x) + w1a[1] * bfhi(gm.x) + w2a[1] * bfhi(gn.x) + bba[1];
                    ga[2] = w0a[2] * bflo(gl.y) + w1a[2] * bflo(gm.y) + w2a[2] * bflo(gn.y) + bba[2];
                    ga[3] = w0a[3] * bfhi(gl.y) + w1a[3] * bfhi(gm.y) + w2a[3] * bfhi(gn.y) + bba[3];
                    gb[0] = w0b[0] * bflo(gl.z) + w1b[0] * bflo(gm.z) + w2b[0] * bflo(gn.z) + bbb[0];
                    gb[1] = w0b[1] * bfhi(gl.z) + w1b[1] * bfhi(gm.z) + w2b[1] * bfhi(gn.z) + bbb[1];
                    gb[2] = w0b[2] * bflo(gl.w) + w1b[2] * bflo(gm.w) + w2b[2] * bflo(gn.w) + bbb[2];
                    gb[3] = w0b[3] * bfhi(gl.w) + w1b[3] * bfhi(gm.w) + w2b[3] * bfhi(gn.w) + bbb[3];
                    const f32x4 a0 = acc[ai][bj][mh + m][0] * s, a1 = acc[ai][bj][mh + m][1] * s;
                    u32x4 w; w.x = pk2(gelu_t(ga[0]) * a0[0], gelu_t(ga[1]) * a0[1]); w.y = pk2(gelu_t(ga[2]) * a0[2], gelu_t(ga[3]) * a0[3]);
                    w.z = pk2(gelu_t(gb[0]) * a1[0], gelu_t(gb[1]) * a1[1]); w.w = pk2(gelu_t(gb[2]) * a1[2], gelu_t(gb[3]) * a1[3]);
                    *(u32x4*)(act + (size_t)row * FF + c) = w; } } }
    }
};

__device__ __forceinline__ float dpp_up1(float x) { const int v = __builtin_bit_cast(int, x); return __builtin_bit_cast(float, __builtin_amdgcn_update_dpp(v, v, 0x111, 0xf, 0xf, false)); }
__device__ __forceinline__ float dpp_dn1(float x) { const int v = __builtin_bit_cast(int, x); return __builtin_bit_cast(float, __builtin_amdgcn_update_dpp(v, v, 0x101, 0xf, 0xf, false)); }
struct EpiGluF {
    static constexpr bool PERM = true, AFTER_DRAIN = false;
    const float* ss; float* sg; float* su; const float* cw; const float* cb; bf16_t* act; LAS float* ex;
    __device__ __forceinline__ void operator()(const f32x4 (&acc)[2][2][4][2], const Unit& u, int wr, int wc, int fr, int fq) const {
        const int row0 = u.pm * 256 + wr * 64 + fr; const int chl = wc * 32 + 8 * fq; const int chg = u.pn * 128 + chl;
        float rsm[2][4];
#pragma unroll
        for (int ai = 0; ai < 2; ++ai)
#pragma unroll
            for (int m = 0; m < 4; ++m) rsm[ai][m] = rs_of(ss, row0 + ai * 128 + m * 16);
        if (fr == 0 || fr == 15) {
#pragma unroll
            for (int ai = 0; ai < 2; ++ai)
#pragma unroll
                for (int m = 0; m < 4; ++m) { const int rgi = ai * 8 + wr * 4 + m; LAS float* e = ex + (2 * rgi + (fr == 15 ? 1 : 0)) * 128 + chl;
                    *(LAS f32x4*)e = acc[ai][0][m][0] * rsm[ai][m]; *(LAS f32x4*)(e + 4) = acc[ai][0][m][1] * rsm[ai][m]; } }
        asm volatile("s_waitcnt lgkmcnt(0)" ::: "memory"); __builtin_amdgcn_s_barrier(); asm volatile("" ::: "memory");
        const f32x4 w0a = *(const f32x4*)(cw + chg), w0b = *(const f32x4*)(cw + chg + 4), w1a = *(const f32x4*)(cw + FF + chg), w1b = *(const f32x4*)(cw + FF + chg + 4);
        const f32x4 w2a = *(const f32x4*)(cw + 2 * FF + chg), w2b = *(const f32x4*)(cw + 2 * FF + chg + 4), bba = *(const f32x4*)(cb + chg), bbb = *(const f32x4*)(cb + chg + 4);
#pragma unroll
        for (int ai = 0; ai < 2; ++ai)
#pragma unroll
            for (int m = 0; m < 4; ++m) { const int row = row0 + ai * 128 + m * 16; const int rgi = ai * 8 + wr * 4 + m;

                const float sm = rsm[ai][m]; const float su = dpp_up1(sm), sd = dpp_dn1(sm);
                f32x4 gm0 = acc[ai][0][m][0] * sm, gm1 = acc[ai][0][m][1] * sm, gu0, gu1, gd0, gd1;
#pragma unroll
                for (int j = 0; j < 4; ++j) { gu0[j] = dpp_up1(acc[ai][0][m][0][j]) * su; gu1[j] = dpp_up1(acc[ai][0][m][1][j]) * su;
                    gd0[j] = dpp_dn1(acc[ai][0][m][0][j]) * sd; gd1[j] = dpp_dn1(acc[ai][0][m][1][j]) * sd; }
                if (fr == 0) {
                    if (rgi > 0) { const LAS float* e = ex + (2 * (rgi - 1) + 1) * 128 + chl; gu0 = *(const LAS f32x4*)e; gu1 = *(const LAS f32x4*)(e + 4); } }
                if (fr == 15) {
                    if (rgi < 15) { const LAS float* e = ex + (2 * (rgi + 1)) * 128 + chl; gd0 = *(const LAS f32x4*)e; gd1 = *(const LAS f32x4*)(e + 4); } }
                const f32x4 ga = w0a * gu0 + w1a * gm0 + w2a * gd0 + bba, gb = w0b * gu1 + w1b * gm1 + w2b * gd1 + bbb;
                const f32x4 a0 = acc[ai][1][m][0] * sm, a1 = acc[ai][1][m][1] * sm;
                u32x4 w; w.x = pk2(gelu_t(ga[0]) * a0[0], gelu_t(ga[1]) * a0[1]); w.y = pk2(gelu_t(ga[2]) * a0[2], gelu_t(ga[3]) * a0[3]);
                w.z = pk2(gelu_t(gb[0]) * a1[0], gelu_t(gb[1]) * a1[1]); w.w = pk2(gelu_t(gb[2]) * a1[2], gelu_t(gb[3]) * a1[3]);
                const bool first = (rgi == 0 && fr == 0), last = (rgi == 15 && fr == 15);
                if (!(first || last)) *(u32x4*)(act + (size_t)row * FF + chg) = w;
                if (rgi == 0 && fr <= 1) { float* d = sg + ((size_t)u.pm * 4 + fr) * FF + chg; *(f32x4*)d = gm0; *(f32x4*)(d + 4) = gm1; }
                if (rgi == 15 && fr >= 14) { float* d = sg + ((size_t)u.pm * 4 + (fr - 12)) * FF + chg; *(f32x4*)d = gm0; *(f32x4*)(d + 4) = gm1; }
                if (first || last) { float* d = this->su + ((size_t)u.pm * 2 + (last ? 1 : 0)) * FF + chg; *(f32x4*)d = a0; *(f32x4*)(d + 4) = a1; } }
    }
};

struct Params { const float* in[28]; float* out; unsigned char* ws; };
typedef LAS unsigned* PT;
__device__ __forceinline__ const float* pin(PT t0, int k) { unsigned ta = (unsigned)(size_t)t0; asm volatile("" : "+s"(ta)); const PT t = (PT)(size_t)ta;
    const unsigned lo = __builtin_amdgcn_readfirstlane(t[2 * k]), hi = __builtin_amdgcn_readfirstlane(t[2 * k + 1]); return (const float*)(__attribute__((address_space(1))) const float*)(((unsigned long long)hi << 32) | lo); }
__device__ __forceinline__ float* pout(PT t) { return (float*)pin(t, 28); }
__device__ __forceinline__ unsigned char* pws(PT t) { return (unsigned char*)pin(t, 29); }
enum { I_X = 0, I_P, I_N1G, I_WIN, I_DNCW, I_ALOG, I_DTB, I_DNG, I_LCW, I_LCB, I_LWA, I_LBA, I_LWX, I_LBX, I_LAM, I_LNG, I_WOUT, I_N2G, I_FWG, I_FWU, I_FCW, I_FCB, I_FWD, I_PNG, I_PWG, I_PBG, I_PWP, I_FING };

template <class RM>
__device__ __forceinline__ void tr_item(const float* W, int K, int N, bf16_t* WT, int ldt, const float* gk, const RM& rm, LAS float* scr, int item, int lane) {
    const int nblk = (N + 31) >> 5, kb = item / nblk, nb = item % nblk, k0 = 64 * kb, n0 = 32 * nb;
#pragma unroll 8
    for (int i = 0; i < 32; ++i) { const int kk = 2 * i + (lane >> 5), n = n0 + (lane & 31);
        float v = (n < N) ? W[(size_t)(k0 + kk) * N + n] : 0.f; if (gk) v *= gk[k0 + kk];
        scr[kk * 33 + (lane & 31)] = v; }
    LDS_FENCE();
    const int c = lane & 7;
#pragma unroll
    for (int j = 0; j < 4; ++j) { const int nl = (lane >> 3) + 8 * j, n = n0 + nl; const LAS float* s = scr + (8 * c) * 33 + nl;
        u32x4 o; o.x = pk2(s[0 * 33], s[1 * 33]); o.y = pk2(s[2 * 33], s[3 * 33]); o.z = pk2(s[4 * 33], s[5 * 33]); o.w = pk2(s[6 * 33], s[7 * 33]);
        const int dst = (n < N) ? rm(n) : -1;
        if (dst >= 0) *(u32x4*)(WT + (size_t)dst * ldt + k0 + 8 * c) = o; }
    LDS_FENCE();
}
struct RmId { __device__ __forceinline__ int operator()(int n) const { return n; } };
struct RmGU { int off; __device__ __forceinline__ int operator()(int n) const { return (n >> 7) * 256 + off + (n & 127); } };
struct RmIn { __device__ __forceinline__ int operator()(int n) const {
    if (n < 1536) return n;
    if (n < 2048) return 2048 + (n - 1536);
    if (n < 2064) return 3072 + (n - 2048);
    if (n < 2576) return 1536 + (n - 2064);
    return 2560 + (n - 2576);
} };

__device__ __forceinline__ void prologue(PT pt, LAS unsigned char* lds, int gw, int NGW, int lane, int wave) {
    asm volatile("" : "+v"(lane));
    unsigned char* ws = pws(pt);
    for (int l = 0; l < NL; ++l) { u32x4* z = (u32x4*)((bf16_t*)(ws + WS_WIN) + ((size_t)l * 3328 + 3088) * 1024); const int n4 = 240 * 1024 / 8;
        for (int i = gw * 64 + lane; i < n4; i += NGW * 64) z[i] = (u32x4){0u, 0u, 0u, 0u}; }
    LAS float* scr = (LAS float*)(lds + wave * 16384);
    constexpr int I_IN = 16 * 97, I_OUT = 16 * 32, I_G = 16 * 88, I_D = 44 * 32, I_PG = 16 * 32, I_PP = 4 * 32, I_LA = 32;
    constexpr int PER_L = I_IN + I_OUT + 2 * I_G + I_D + I_PG + I_PP + 2 * I_LA;
    for (int it = gw; it < NL * PER_L; it += NGW) {
        const int l = it / PER_L; int r = it % PER_L;
        if (r < I_IN) { tr_item(pin(pt, I_WIN) + (size_t)l * DM * INC, DM, INC, (bf16_t*)(ws + WS_WIN) + (size_t)l * 3328 * 1024, 1024, pin(pt, I_N1G) + l * DM, RmIn(), scr, r, lane); continue; } r -= I_IN;
        if (r < I_OUT) { tr_item(pin(pt, I_WOUT) + (size_t)l * DM * DM, DM, DM, (bf16_t*)(ws + WS_WOUT) + (size_t)l * DM * DM, 1024, nullptr, RmId(), scr, r, lane); continue; } r -= I_OUT;
        if (r < I_G) { tr_item(pin(pt, I_FWG) + (size_t)l * DM * FF, DM, FF, (bf16_t*)(ws + WS_WG) + (size_t)l * 5632 * 1024, 1024, pin(pt, I_N2G) + l * DM, RmGU{0}, scr, r, lane); continue; } r -= I_G;
        if (r < I_G) { tr_item(pin(pt, I_FWU) + (size_t)l * DM * FF, DM, FF, (bf16_t*)(ws + WS_WG) + (size_t)l * 5632 * 1024, 1024, pin(pt, I_N2G) + l * DM, RmGU{128}, scr, r, lane); continue; } r -= I_G;
        if (r < I_D) { tr_item(pin(pt, I_FWD) + (size_t)l * FF * DM, FF, DM, (bf16_t*)(ws + WS_WD) + (size_t)l * DM * FF, FF, nullptr, RmId(), scr, r, lane); continue; } r -= I_D;
        if (r < I_PG) { tr_item(pin(pt, I_PWG) + (size_t)l * DM * DM, DM, DM, (bf16_t*)(ws + WS_WPG) + (size_t)l * DM * DM, 1024, pin(pt, I_PNG) + l * DM, RmId(), scr, r, lane); continue; } r -= I_PG;
        if (r < I_PP) { tr_item(pin(pt, I_PWP) + (size_t)l * PLE * DM, PLE, DM, (bf16_t*)(ws + WS_WP) + (size_t)l * DM * PLE, PLE, nullptr, RmId(), scr, r, lane); continue; } r -= I_PP;
        { const int gate = r / I_LA; r %= I_LA; const int mat = r >> 1, sub = r & 1;
          const float* src = pin(pt, gate ? I_LWX : I_LWA) + ((size_t)l * 16 + mat) * 4096;
          bf16_t* dst = (bf16_t*)(ws + WS_WAT) + (((size_t)l * 16 + mat) * 2 + gate) * 4096;
          tr_item(src, 64, 64, dst, 64, nullptr, RmId(), scr, sub, lane); }
    }
    const float* x = pin(pt, I_X); bf16_t* rb = (bf16_t*)(ws + WS_RB); float* ss0 = (float*)(ws + WS_SSP); bf16_t* rl = (bf16_t*)pout(pt) + (size_t)M_TOK * 1024;
    for (int m = gw; m < M_TOK; m += NGW) { const f32x4* xr = (const f32x4*)(x + (size_t)m * DM) + lane; u32x2* o = (u32x2*)(rb + (size_t)m * DM) + lane; u32x2* ol = (u32x2*)(rl + (size_t)m * DM) + lane; float s = 0.f;
#pragma unroll
        for (int j = 0; j < 4; ++j) { const f32x4 v = xr[64 * j]; s += (v[0] * v[0] + v[1] * v[1]) + (v[2] * v[2] + v[3] * v[3]); const u32x2 hw = pk4(v); o[64 * j] = hw;
            ol[64 * j] = pk4((f32x4){v[0] - bflo(hw.x), v[1] - bfhi(hw.x), v[2] - bflo(hw.y), v[3] - bfhi(hw.y)}); }
#pragma unroll
        for (int o2 = 1; o2 < 64; o2 <<= 1) s += __shfl_xor(s, o2);
        if (lane < 4) ss0[(size_t)m * 4 + lane] = lane == 0 ? s : 0.f; }
}

__device__ __forceinline__ void lru_block(PT pt, LAS unsigned char* lds, int bi, int layer, int tid) {
    asm volatile("" : "+v"(tid));
    const int lane = tid & 63, w = tid >> 6;
    unsigned char* ws = pws(pt);
    const int wi = bi * 8 + w;
    const int dq = wi & 3, n = (wi >> 2) & 7, dir = (wi >> 5) & 1, b = wi >> 6;
    const int fr = lane & 15, fq = lane >> 4;
    LAS unsigned char* XCB = lds + (w >> 2) * 8192;
    LAS unsigned char* SCN = lds + 16384 + w * 1024;
    const int ti = lane >> 2, cq = lane & 3;
    const int cch = 64 * n + 16 * dq + 4 * cq;
    f32x4 cw4[4];
#pragma unroll
    for (int tap = 0; tap < 4; ++tap) cw4[tap] = *(const f32x4*)(pin(pt, I_LCW) + ((size_t)layer * 4 + tap) * 512 + cch);
    const f32x4 cb4 = *(const f32x4*)(pin(pt, I_LCB) + (size_t)layer * 512 + cch);
    const bf16_t* wbase = (const bf16_t*)(ws + WS_WAT) + ((((size_t)layer * 2 + dir) * 8 + n) * 2) * 4096;
    bf16x8 Ba[2], Bx[2];
#pragma unroll
    for (int ks = 0; ks < 2; ++ks) { Ba[ks] = *(const bf16x8*)(wbase + (16 * dq + fr) * 64 + 32 * ks + 8 * fq); Bx[ks] = *(const bf16x8*)(wbase + 4096 + (16 * dq + fr) * 64 + 32 * ks + 8 * fq); }
    const int dch = 64 * n + 16 * dq + fr; const size_t pidx = ((size_t)layer * 2 + dir) * 512 + dch;
    const float ba = pin(pt, I_LBA)[pidx], bx = pin(pt, I_LBX)[pidx], sp8 = 8.0f * 1.4426950408889634f * softplus_f(-pin(pt, I_LAM)[pidx]);
    const bf16_t* plx = (const bf16_t*)(ws + WS_PLX) + (size_t)b * SEQ * 512 + cch;
    bf16_t* hout = (bf16_t*)pout(pt) + (size_t)dir * M_TOK * 512 + (size_t)b * SEQ * 512 + dch;
    u32x2 xr[2][4];
#define LRU_LOAD(scn) do { _Pragma("unroll") for (int s_ = 0; s_ < 2; ++s_) { const int tt_ = dir ? (SEQ - 1 - (32 * (scn) + 16 * s_ + ti)) : (32 * (scn) + 16 * s_ + ti); \
        _Pragma("unroll") for (int tap = 0; tap < 4; ++tap) { const int t2_ = tt_ + tap - 2; xr[s_][tap] = (u32x2){0u, 0u}; if (t2_ >= 0 && t2_ < SEQ) xr[s_][tap] = *(const u32x2*)(plx + (size_t)t2_ * 512); } } } while (0)
    LRU_LOAD(0);
    float hprev = 0.f;
    LBAR();
#pragma unroll 1
    for (int sc = 0; sc < 64; ++sc) {
        LAS unsigned char* XC = XCB + (sc & 1) * 4096;
#pragma unroll
        for (int s2 = 0; s2 < 2; ++s2) { f32x4 xa = cb4;
#pragma unroll
            for (int tap = 0; tap < 4; ++tap) { xa[0] += cw4[tap][0] * bflo(xr[s2][tap].x); xa[1] += cw4[tap][1] * bfhi(xr[s2][tap].x); xa[2] += cw4[tap][2] * bflo(xr[s2][tap].y); xa[3] += cw4[tap][3] * bfhi(xr[s2][tap].y); }
            *(LAS u32x2*)(XC + swz64(16 * s2 + ti, 16 * dq + 4 * cq)) = pk4(xa); }
        if (sc + 1 < 64) LRU_LOAD(sc + 1);
        LBAR();
        float Ac[2][4], Hc[2][4];
#pragma unroll
        for (int s2 = 0; s2 < 2; ++s2) {
            const bf16x8 A0 = *(const LAS bf16x8*)(XC + swz64(16 * s2 + fr, 8 * fq)), A1 = *(const LAS bf16x8*)(XC + swz64(16 * s2 + fr, 32 + 8 * fq));
            f32x4 ca = {0.f, 0.f, 0.f, 0.f}, cx = {0.f, 0.f, 0.f, 0.f};
            ca = MFMA16(A0, Ba[0], ca); ca = MFMA16(A1, Ba[1], ca); cx = MFMA16(A0, Bx[0], cx); cx = MFMA16(A1, Bx[1], cx);
#pragma unroll
            for (int jj = 0; jj < 4; ++jj) { const float xv = bf2f(*(const LAS unsigned short*)(XC + swz64(16 * s2 + 4 * fq + jj, 16 * dq + fr)));
                const float r = sigm(ca[jj] + ba), ig = sigm(cx[jj] + bx), a = __builtin_amdgcn_exp2f(-r * sp8);
                const float bt = __builtin_amdgcn_sqrtf(fmaxf(1.0f - a * a, 0.f)) * ig * xv;
                Hc[s2][jj] = jj ? (a * Hc[s2][jj - 1] + bt) : bt; Ac[s2][jj] = jj ? (a * Ac[s2][jj - 1]) : a; }
            *(LAS f32x2*)(SCN + s2 * 512 + (fq * 16 + fr) * 8) = (f32x2){Ac[s2][3], Hc[s2][3]}; }
#pragma unroll
        for (int s2 = 0; s2 < 2; ++s2) {
            const LAS unsigned char* T = SCN + s2 * 512;
            const f32x2 g0 = *(const LAS f32x2*)(T + (0 * 16 + fr) * 8), g1 = *(const LAS f32x2*)(T + (1 * 16 + fr) * 8), g2 = *(const LAS f32x2*)(T + (2 * 16 + fr) * 8), g3 = *(const LAS f32x2*)(T + (3 * 16 + fr) * 8);
            const float h1 = g0.x * hprev + g0.y, h2 = g1.x * h1 + g1.y, h3 = g2.x * h2 + g2.y, h4 = g3.x * h3 + g3.y;
            const float hin = fq == 0 ? hprev : (fq == 1 ? h1 : (fq == 2 ? h2 : h3));
            hprev = h4;
#pragma unroll
            for (int jj = 0; jj < 4; ++jj) { const float hv = Ac[s2][jj] * hin + Hc[s2][jj]; const int i = 16 * s2 + 4 * fq + jj; const int t2 = dir ? (SEQ - 1 - (32 * sc + i)) : (32 * sc + i);
                hout[(size_t)t2 * 512] = (bf16_t)(pk2(hv, 0.f) & 0xffffu); } }
    }
#undef LRU_LOAD
}

constexpr int DP_BUF0 = 0, DP_BUF1 = 49152, DP_KL = 49152, DP_QL = 49152 + 16384, DP_VL = 49152 + 32768, DP_VEC = 98304, DP_CWL = 99328;
__device__ __forceinline__ void dp_item(PT pt, LAS unsigned char* lds, int item, int layer, int tid, int lane, int w) {
    asm volatile("" : "+v"(tid)); lane = tid & 63; asm volatile("" : "+s"(w));
    unsigned char* ws = pws(pt);
    const int b = item >> 7, h = (item >> 5) & 3, n = item & 31;
    const size_t rowbase = (size_t)b * SEQ + 64 * n;
    LAS float* VEC = (LAS float*)(lds + DP_VEC);
    LBAR();
    f32x4 gpre = {0.f, 0.f, 0.f, 0.f};
    if (w == 0) { const float* gp = (const float*)(ws + WS_GATES) + (rowbase + lane) * 16 + h; gpre[0] = gp[0]; gpre[1] = gp[4]; gpre[2] = gp[8]; gpre[3] = gp[12]; }
    { const int i = tid >> 3, c = tid & 7; const int t = 64 * n + i; const size_t R = rowbase + i;
      const bf16_t* pq = (const bf16_t*)(ws + WS_PQKV);
      u32x4 xin[3][4][2];
#pragma unroll
      for (int mat = 0; mat < 3; ++mat)
#pragma unroll
          for (int tap = 0; tap < 4; ++tap) { const int t2 = t + tap - 2; xin[mat][tap][0] = (u32x4){0u, 0u, 0u, 0u}; xin[mat][tap][1] = (u32x4){0u, 0u, 0u, 0u};
              if (t2 >= 0 && t2 < SEQ) { const bf16_t* xp = pq + (R + tap - 2) * 1536 + mat * 512 + h * 128 + 16 * c; xin[mat][tap][0] = *(const u32x4*)xp; xin[mat][tap][1] = *(const u32x4*)(xp + 8); } }
#pragma unroll
      for (int mat = 0; mat < 3; ++mat) {
          f32x4 a[4] = {{0.f, 0.f, 0.f, 0.f}, {0.f, 0.f, 0.f, 0.f}, {0.f, 0.f, 0.f, 0.f}, {0.f, 0.f, 0.f, 0.f}};
#pragma unroll
          for (int tap = 0; tap < 4; ++tap) { const u32x4 x0 = xin[mat][tap][0], x1 = xin[mat][tap][1];
              const LAS float* wp = (const LAS float*)(lds + DP_CWL) + (mat * 4 + tap) * 128 + 16 * c; const f32x4 w0 = *(const LAS f32x4*)wp, w1 = *(const LAS f32x4*)(wp + 4), w2 = *(const LAS f32x4*)(wp + 8), w3 = *(const LAS f32x4*)(wp + 12);
              a[0][0] += w0[0] * bflo(x0.x); a[0][1] += w0[1] * bfhi(x0.x); a[0][2] += w0[2] * bflo(x0.y); a[0][3] += w0[3] * bfhi(x0.y);
              a[1][0] += w1[0] * bflo(x0.z); a[1][1] += w1[1] * bfhi(x0.z); a[1][2] += w1[2] * bflo(x0.w); a[1][3] += w1[3] * bfhi(x0.w);
              a[2][0] += w2[0] * bflo(x1.x); a[2][1] += w2[1] * bfhi(x1.x); a[2][2] += w2[2] * bflo(x1.y); a[2][3] += w2[3] * bfhi(x1.y);
              a[3][0] += w3[0] * bflo(x1.z); a[3][1] += w3[1] * bfhi(x1.z); a[3][2] += w3[2] * bflo(x1.w); a[3][3] += w3[3] * bfhi(x1.w); }
          float ssq = 0.f;
#pragma unroll
          for (int q = 0; q < 4; ++q)
#pragma unroll
              for (int e = 0; e < 4; ++e) { const float v = a[q][e]; const float sv = v * sigm(v); a[q][e] = sv; ssq += sv * sv; }
          float scale = 1.f;
          if (mat < 2) { ssq += __shfl_xor(ssq, 1); ssq += __shfl_xor(ssq, 2); ssq += __shfl_xor(ssq, 4); scale = rsqrtf(ssq + EPS); if (mat == 0) scale *= 0.08838834764831845f; }
          u32x4 o0, o1; o0.x = pk2(a[0][0] * scale, a[0][1] * scale); o0.y = pk2(a[0][2] * scale, a[0][3] * scale); o0.z = pk2(a[1][0] * scale, a[1][1] * scale); o0.w = pk2(a[1][2] * scale, a[1][3] * scale);
          o1.x = pk2(a[2][0] * scale, a[2][1] * scale); o1.y = pk2(a[2][2] * scale, a[2][3] * scale); o1.z = pk2(a[3][0] * scale, a[3][1] * scale); o1.w = pk2(a[3][2] * scale, a[3][3] * scale);
          const int lbase = (mat == 0) ? DP_QL : (mat == 1 ? DP_KL : DP_VL);
          *(LAS u32x4*)(lds + lbase + swz128(i, 16 * c)) = o0; *(LAS u32x4*)(lds + lbase + swz128(i, 16 * c + 8)) = o1;
          if (mat < 2) { bf16_t* gp = (bf16_t*)(ws + (mat == 0 ? WS_QH : WS_KH)) + R * 512 + h * 128 + 16 * c; *(u32x4*)gp = o0; *(u32x4*)(gp + 8) = o1; } }
    }
    if (w == 0) {
        const float bF = sigm(gpre[0]), bB = sigm(gpre[1]);
        float gF = -expf(pin(pt, I_ALOG)[layer * 8 + h]) * softplus_f(gpre[2] + pin(pt, I_DTB)[layer * 8 + h]);
        float gB = -expf(pin(pt, I_ALOG)[layer * 8 + 4 + h]) * softplus_f(gpre[3] + pin(pt, I_DTB)[layer * 8 + 4 + h]);
#pragma unroll
        for (int off = 1; off < 64; off <<= 1) { const float v = __shfl_up(gF, off); if (lane >= off) gF += v; const float u = __shfl_down(gB, off); if (lane + off < 64) gB += u; }
        const float glF = __shfl(gF, 63), glB = __shfl(gB, 0);
        VEC[lane] = bF; VEC[64 + lane] = gF; VEC[128 + lane] = bB; VEC[192 + lane] = gB;
        float* v0 = (float*)(ws + WS_VEC) + (size_t)item * 256; float* v1 = v0 + (size_t)4096 * 256;
        v0[lane] = bF; v0[64 + lane] = fexp(gF); v0[128 + lane] = fexp(glF - gF); if (lane == 0) v0[192] = fexp(glF);
        v1[lane] = bB; v1[64 + lane] = fexp(gB); v1[128 + lane] = fexp(glB - gB); if (lane == 0) v1[192] = fexp(glB);
    }
    LBAR();
    { const int e = tid >> 2, jq = tid & 3; unsigned vv[8];
#pragma unroll
      for (int p = 0; p < 8; ++p) { const unsigned lo = *(const LAS unsigned short*)(lds + DP_VL + swz128(16 * jq + 2 * p, e)), hi = *(const LAS unsigned short*)(lds + DP_VL + swz128(16 * jq + 2 * p + 1, e)); vv[p] = lo | (hi << 16); }
      bf16_t* gp = (bf16_t*)(ws + WS_VT) + (size_t)item * 8192 + e * 64 + 16 * jq;
      *(u32x4*)gp = (u32x4){vv[0], vv[1], vv[2], vv[3]}; *(u32x4*)(gp + 8) = (u32x4){vv[4], vv[5], vv[6], vv[7]}; }
    const int r32 = lane & 31, hi = lane >> 5;
    { const int kind = w >> 2, q = w & 3, ta = q >> 1, tb = q & 1;
      f32x16 acc; for (int r = 0; r < 16; ++r) acc[r] = 0.f;
      const int bbase = kind ? DP_QL : DP_KL;
#pragma unroll
      for (int ks = 0; ks < 8; ++ks) { const bf16x8 av = *(const LAS bf16x8*)(lds + DP_KL + swz128(32 * ta + r32, 16 * ks + 8 * hi)), bv = *(const LAS bf16x8*)(lds + bbase + swz128(32 * tb + r32, 16 * ks + 8 * hi)); acc = MFMA32(av, bv, acc); }
      const int gb = 32 * tb + r32;
#pragma unroll
      for (int dir = 0; dir < 2; ++dir) { const LAS float* bet = VEC + dir * 128; const LAS float* gc = VEC + dir * 128 + 64;
          const float gcl = gc[gb], betl = bet[gb];
#pragma unroll
          for (int g = 0; g < 4; ++g) { const int ga0 = 32 * ta + 8 * g + 4 * hi; const f32x4 gca = *(const LAS f32x4*)(gc + ga0), bea = *(const LAS f32x4*)(bet + ga0);
              if (kind == 0) { f32x4 xv, yv, pv;
#pragma unroll
                  for (int jj = 0; jj < 4; ++jj) { const int ga = ga0 + jj; const float kk = acc[4 * g + jj];
                      const bool mx = dir ? (gb < ga) : (gb > ga), my = dir ? (ga < gb) : (ga > gb);
                      const float ed = kk * fexp(-fabsf(gcl - gca[jj]));
                      xv[jj] = mx ? (-betl * ed) : 0.f; yv[jj] = my ? (-bea[jj] * ed) : 0.f; pv[jj] = (ga == gb) ? 1.f : 0.f; }
                  LAS unsigned char* bb = lds + DP_BUF0 + dir * 24576 + swz64(gb, ga0);
                  *(LAS u32x2*)bb = pk4(xv); *(LAS u32x2*)(bb + 8192) = pk4(yv); *(LAS u32x2*)(bb + 16384) = pk4(pv);
              } else { f32x4 av4;
#pragma unroll
                  for (int jj = 0; jj < 4; ++jj) { const int ga = ga0 + jj; const bool ma = dir ? (gb <= ga) : (gb >= ga); av4[jj] = ma ? (acc[4 * g + jj] * fexp(-fabsf(gcl - gca[jj]))) : 0.f; }
                  *(u32x2*)((bf16_t*)(ws + WS_AT) + ((size_t)dir * 4096 + item) * 4096 + gb * 64 + ga0) = pk4(av4); } } }
    }
    LBAR();
    { const int dir = w >> 2, q = w & 3, ti = q >> 1, tj = q & 1;
      f32x16 pacc; for (int r = 0; r < 16; ++r) pacc[r] = (32 * tj + crow(r, hi) == 32 * ti + r32) ? 1.f : 0.f;
#pragma unroll 1
      for (int rd = 0; rd < 6; ++rd) { LAS unsigned char* cur = lds + ((rd & 1) ? DP_BUF1 : DP_BUF0) + dir * 24576; LAS unsigned char* nxt = lds + ((rd & 1) ? DP_BUF0 : DP_BUF1) + dir * 24576;
          bf16x8 xf[4], yf[4], pf[4];
#pragma unroll
          for (int ks = 0; ks < 4; ++ks) { xf[ks] = *(const LAS bf16x8*)(cur + swz64(32 * ti + r32, 16 * ks + 8 * hi)); yf[ks] = *(const LAS bf16x8*)(cur + 8192 + swz64(32 * tj + r32, 16 * ks + 8 * hi)); pf[ks] = *(const LAS bf16x8*)(cur + 16384 + swz64(32 * ti + r32, 16 * ks + 8 * hi)); }
#pragma unroll
          for (int ks = 0; ks < 4; ++ks) pacc = MFMA32(yf[ks], pf[ks], pacc);
          if (rd < 5) { f32x16 xa, ya; for (int r = 0; r < 16; ++r) { xa[r] = 0.f; ya[r] = 0.f; }
#pragma unroll
              for (int ks = 0; ks < 4; ++ks) { xa = MFMA32(yf[ks], xf[ks], xa); ya = MFMA32(xf[ks], yf[ks], ya); }
#pragma unroll
              for (int g = 0; g < 4; ++g) { const int c0 = 8 * g + 4 * hi;
                  *(LAS u32x2*)(nxt + swz64(32 * ti + r32, 32 * tj + c0)) = pk4((f32x4){xa[4 * g], xa[4 * g + 1], xa[4 * g + 2], xa[4 * g + 3]});
                  *(LAS u32x2*)(nxt + 8192 + swz64(32 * tj + r32, 32 * ti + c0)) = pk4((f32x4){ya[4 * g], ya[4 * g + 1], ya[4 * g + 2], ya[4 * g + 3]});
                  *(LAS u32x2*)(nxt + 16384 + swz64(32 * ti + r32, 32 * tj + c0)) = pk4((f32x4){pacc[4 * g], pacc[4 * g + 1], pacc[4 * g + 2], pacc[4 * g + 3]}); }
              LBAR(); } }
      bf16_t* tg = (bf16_t*)(ws + WS_TM) + ((size_t)dir * 4096 + item) * 4096 + (32 * ti + r32) * 64 + 32 * tj + 4 * hi;
#pragma unroll
      for (int g = 0; g < 4; ++g) *(u32x2*)(tg + 8 * g) = pk4((f32x4){pacc[4 * g], pacc[4 * g + 1], pacc[4 * g + 2], pacc[4 * g + 3]});
    }
}

constexpr int DR_K = 0, DR_Q = 16384, DR_KT = 32768, DR_VT = 49152, DR_T = 65536, DR_A = 73728, DR_VEC = 81920, DR_PRIV = 83968;
__device__ __forceinline__ void dr_item(PT pt, LAS unsigned char* lds, int item, int tid, int lane, int w) {
    asm volatile("" : "+v"(tid)); lane = tid & 63; asm volatile("" : "+s"(w));
    unsigned char* ws = pws(pt);
    const int dir = item & 1, h = (item >> 1) & 3, b = item >> 3;
    const int fr = lane & 15, fq = lane >> 4, es = 16 * w;
    LAS unsigned char* ST = lds + DR_PRIV + w * 8192; LAS unsigned char* RV = ST + 4096; LAS unsigned char* VN2 = ST + 6144;
    const LAS float* VEC = (const LAS float*)(lds + DR_VEC);
    const bf16_t* kh = (const bf16_t*)(ws + WS_KH) + (size_t)b * SEQ * 512 + h * 128;
    const bf16_t* qh = (const bf16_t*)(ws + WS_QH) + (size_t)b * SEQ * 512 + h * 128;
    const int ibase = (b * 4 + h) * 32;
    const bf16_t* vt = (const bf16_t*)(ws + WS_VT) + (size_t)ibase * 8192;
    const bf16_t* tm = (const bf16_t*)(ws + WS_TM) + ((size_t)dir * 4096 + ibase) * 4096;
    const bf16_t* at = (const bf16_t*)(ws + WS_AT) + ((size_t)dir * 4096 + ibase) * 4096;
    const float* vecs = (const float*)(ws + WS_VEC) + ((size_t)dir * 4096 + ibase) * 256;
    bf16_t* og = (bf16_t*)(ws + (dir ? WS_OB : WS_OF)) + (size_t)b * SEQ * 512 + h * 128 + es + fr;
    u32x4 pk[2], pq[2], pv[2], ptm, pa; f32x4 pvec = {0.f, 0.f, 0.f, 0.f};
#define DR_LOAD(nn) do { _Pragma("unroll") for (int u_ = 0; u_ < 2; ++u_) { const int p_ = tid + 512 * u_; \
        pk[u_] = *(const u32x4*)(kh + (size_t)(64 * (nn) + (p_ >> 4)) * 512 + 8 * (p_ & 15)); pq[u_] = *(const u32x4*)(qh + (size_t)(64 * (nn) + (p_ >> 4)) * 512 + 8 * (p_ & 15)); \
        pv[u_] = *(const u32x4*)(vt + (size_t)(nn) * 8192 + p_ * 8); } \
        ptm = *(const u32x4*)(tm + (size_t)(nn) * 4096 + tid * 8); pa = *(const u32x4*)(at + (size_t)(nn) * 4096 + tid * 8); \
        if (tid < 64) pvec = *(const f32x4*)(vecs + (size_t)(nn) * 256 + 4 * tid); } while (0)
#define DR_STORE() do { _Pragma("unroll") for (int u_ = 0; u_ < 2; ++u_) { const int p_ = tid + 512 * u_; const int j_ = p_ >> 4, q_ = p_ & 15; \
        *(LAS u32x4*)(lds + DR_K + swz128(j_, 8 * q_)) = pk[u_]; *(LAS u32x4*)(lds + DR_Q + swz128(j_, 8 * q_)) = pq[u_]; \
        *(LAS unsigned short*)(lds + DR_KT + swz64(8 * q_ + 0, j_)) = (unsigned short)(pk[u_].x & 0xffffu); *(LAS unsigned short*)(lds + DR_KT + swz64(8 * q_ + 1, j_)) = (unsigned short)(pk[u_].x >> 16); \
        *(LAS unsigned short*)(lds + DR_KT + swz64(8 * q_ + 2, j_)) = (unsigned short)(pk[u_].y & 0xffffu); *(LAS unsigned short*)(lds + DR_KT + swz64(8 * q_ + 3, j_)) = (unsigned short)(pk[u_].y >> 16); \
        *(LAS unsigned short*)(lds + DR_KT + swz64(8 * q_ + 4, j_)) = (unsigned short)(pk[u_].z & 0xffffu); *(LAS unsigned short*)(lds + DR_KT + swz64(8 * q_ + 5, j_)) = (unsigned short)(pk[u_].z >> 16); \
        *(LAS unsigned short*)(lds + DR_KT + swz64(8 * q_ + 6, j_)) = (unsigned short)(pk[u_].w & 0xffffu); *(LAS unsigned short*)(lds + DR_KT + swz64(8 * q_ + 7, j_)) = (unsigned short)(pk[u_].w >> 16); \
        *(LAS u32x4*)(lds + DR_VT + swz64(p_ >> 3, 8 * (p_ & 7))) = pv[u_]; } \
        *(LAS u32x4*)(lds + DR_T + swz64(tid >> 3, 8 * (tid & 7))) = ptm; *(LAS u32x4*)(lds + DR_A + swz64(tid >> 3, 8 * (tid & 7))) = pa; \
        if (tid < 64) *(LAS f32x4*)(lds + DR_VEC + 16 * tid) = pvec; } while (0)
    LBAR();
    DR_LOAD(dir ? 31 : 0);
    DR_STORE();
#pragma unroll
    for (int q = 0; q < 4; ++q) *(LAS u32x4*)(ST + lane * 64 + q * 16) = (u32x4){0u, 0u, 0u, 0u};
    f32x4 Sacc[8];
#pragma unroll
    for (int d = 0; d < 8; ++d) Sacc[d] = (f32x4){0.f, 0.f, 0.f, 0.f};
    LBAR();
#pragma unroll 1
    for (int cc = 0; cc < 32; ++cc) { const int n = dir ? (31 - cc) : cc;
        if (cc + 1 < 32) DR_LOAD(dir ? (30 - cc) : (cc + 1));
        bf16x8 sb[4];
#pragma unroll
        for (int ks = 0; ks < 4; ++ks) sb[ks] = *(const LAS bf16x8*)(ST + swz128(fr, 32 * ks + 8 * fq));
        f32x4 oacc[4];
#pragma unroll
        for (int it = 0; it < 4; ++it) { f32x4 ka = {0.f, 0.f, 0.f, 0.f}, qa = {0.f, 0.f, 0.f, 0.f};
#pragma unroll
            for (int ks = 0; ks < 4; ++ks) { const bf16x8 a1 = *(const LAS bf16x8*)(lds + DR_K + swz128(16 * it + fr, 32 * ks + 8 * fq)), a2 = *(const LAS bf16x8*)(lds + DR_Q + swz128(16 * it + fr, 32 * ks + 8 * fq));
                ka = MFMA16(a1, sb[ks], ka); qa = MFMA16(a2, sb[ks], qa); }
            const int i0 = 16 * it + 4 * fq; const f32x4 be = *(const LAS f32x4*)(VEC + i0), eg = *(const LAS f32x4*)(VEC + 64 + i0);
            const u32x2 vv = *(const LAS u32x2*)(lds + DR_VT + swz64(es + fr, i0));
            f32x4 rh; rh[0] = be[0] * (bflo(vv.x) - eg[0] * ka[0]); rh[1] = be[1] * (bfhi(vv.x) - eg[1] * ka[1]); rh[2] = be[2] * (bflo(vv.y) - eg[2] * ka[2]); rh[3] = be[3] * (bfhi(vv.y) - eg[3] * ka[3]);
            *(LAS u32x2*)(RV + swz64(fr, i0)) = pk4(rh);
            oacc[it] = qa * eg; }
        bf16x8 rb2[2];
#pragma unroll
        for (int ks = 0; ks < 2; ++ks) rb2[ks] = *(const LAS bf16x8*)(RV + swz64(fr, 32 * ks + 8 * fq));
        f32x4 vn[4];
#pragma unroll
        for (int it = 0; it < 4; ++it) { vn[it] = (f32x4){0.f, 0.f, 0.f, 0.f};
#pragma unroll
            for (int ks = 0; ks < 2; ++ks) { const bf16x8 a1 = *(const LAS bf16x8*)(lds + DR_T + swz64(16 * it + fr, 32 * ks + 8 * fq)); vn[it] = MFMA16(a1, rb2[ks], vn[it]); } }
#pragma unroll
        for (int it = 0; it < 4; ++it) { const int i0 = 16 * it + 4 * fq; const f32x4 ed = *(const LAS f32x4*)(VEC + 128 + i0);
            *(LAS u32x2*)(RV + swz64(fr, i0)) = pk4(vn[it]); *(LAS u32x2*)(VN2 + swz64(fr, i0)) = pk4(vn[it] * ed); }
        bf16x8 vb[2], vb2[2];
#pragma unroll
        for (int ks = 0; ks < 2; ++ks) { vb[ks] = *(const LAS bf16x8*)(RV + swz64(fr, 32 * ks + 8 * fq)); vb2[ks] = *(const LAS bf16x8*)(VN2 + swz64(fr, 32 * ks + 8 * fq)); }
#pragma unroll
        for (int it = 0; it < 4; ++it)
#pragma unroll
            for (int ks = 0; ks < 2; ++ks) { const bf16x8 a1 = *(const LAS bf16x8*)(lds + DR_A + swz64(16 * it + fr, 32 * ks + 8 * fq)); oacc[it] = MFMA16(a1, vb[ks], oacc[it]); }
        const float cdec = VEC[192];
#pragma unroll
        for (int dt = 0; dt < 8; ++dt) { Sacc[dt] = Sacc[dt] * cdec;
#pragma unroll
            for (int ks = 0; ks < 2; ++ks) { const bf16x8 a1 = *(const LAS bf16x8*)(lds + DR_KT + swz64(16 * dt + fr, 32 * ks + 8 * fq)); Sacc[dt] = MFMA16(a1, vb2[ks], Sacc[dt]); }
            *(LAS u32x2*)(ST + swz128(fr, 16 * dt + 4 * fq)) = pk4(Sacc[dt]); }
#pragma unroll
        for (int it = 0; it < 4; ++it)
#pragma unroll
            for (int jj = 0; jj < 4; ++jj) og[(size_t)(64 * n + 16 * it + 4 * fq + jj) * 512] = (bf16_t)(pk2(oacc[it][jj], 0.f) & 0xffffu);
        LBAR();
        if (cc + 1 < 32) DR_STORE();
        LBAR();
    }
#undef DR_LOAD
#undef DR_STORE
}

__device__ __forceinline__ void m2_rows(PT pt, int layer, int gw, int NGW, int lane) {
    asm volatile("" : "+v"(lane));
    unsigned char* ws = pws(pt);
    const bf16_t* of = (const bf16_t*)(ws + WS_OF); const bf16_t* ob = (const bf16_t*)(ws + WS_OB); const bf16_t* pz = (const bf16_t*)(ws + WS_PZ);
    const bf16_t* hf = (const bf16_t*)pout(pt); const bf16_t* hb = hf + (size_t)M_TOK * 512; const bf16_t* plg = (const bf16_t*)(ws + WS_PLG);
    bf16_t* amix = (bf16_t*)(ws + WS_AMIX);
    const float* dng = pin(pt, I_DNG) + layer * 128 + 8 * (lane & 15); const float* lng = pin(pt, I_LNG) + layer * 512 + 8 * lane;
    const f32x4 dg0 = *(const f32x4*)dng, dg1 = *(const f32x4*)(dng + 4), lg0 = *(const f32x4*)lng, lg1 = *(const f32x4*)(lng + 4);
    for (int m0 = gw; m0 < M_TOK; m0 += 2 * NGW) {
        u32x4 av[2], bv[2], zv[2], cv[2], dv[2], gv[2];
#pragma unroll
        for (int r = 0; r < 2; ++r) { const int m = m0 + r * NGW; if (m < M_TOK) { const size_t o = (size_t)m * 512 + 8 * lane;
            av[r] = *(const u32x4*)(of + o); bv[r] = *(const u32x4*)(ob + o); zv[r] = *(const u32x4*)(pz + o); cv[r] = *(const u32x4*)(hf + o); dv[r] = *(const u32x4*)(hb + o); gv[r] = *(const u32x4*)(plg + o); } }
#pragma unroll
        for (int r = 0; r < 2; ++r) { const int m = m0 + r * NGW; if (m < M_TOK) {
        const u32x4 a = av[r], b2 = bv[r], z = zv[r], c = cv[r], d = dv[r], g = gv[r];
        float v[8], y[8];
        v[0] = bflo(a.x) + bflo(b2.x); v[1] = bfhi(a.x) + bfhi(b2.x); v[2] = bflo(a.y) + bflo(b2.y); v[3] = bfhi(a.y) + bfhi(b2.y);
        v[4] = bflo(a.z) + bflo(b2.z); v[5] = bfhi(a.z) + bfhi(b2.z); v[6] = bflo(a.w) + bflo(b2.w); v[7] = bfhi(a.w) + bfhi(b2.w);
        float s1 = 0.f;
#pragma unroll
        for (int e = 0; e < 8; ++e) s1 += v[e] * v[e];
        s1 += __shfl_xor(s1, 1); s1 += __shfl_xor(s1, 2); s1 += __shfl_xor(s1, 4); s1 += __shfl_xor(s1, 8);
        const float r1 = rsqrtf(s1 * (1.0f / 128.0f) + EPS);
        float zz[8] = {bflo(z.x), bfhi(z.x), bflo(z.y), bfhi(z.y), bflo(z.z), bfhi(z.z), bflo(z.w), bfhi(z.w)};
        float gg[8] = {bflo(g.x), bfhi(g.x), bflo(g.y), bfhi(g.y), bflo(g.z), bfhi(g.z), bflo(g.w), bfhi(g.w)};
        float hh[8] = {bflo(c.x) + bflo(d.x), bfhi(c.x) + bfhi(d.x), bflo(c.y) + bflo(d.y), bfhi(c.y) + bfhi(d.y), bflo(c.z) + bflo(d.z), bfhi(c.z) + bfhi(d.z), bflo(c.w) + bflo(d.w), bfhi(c.w) + bfhi(d.w)};
        float s2 = 0.f;
#pragma unroll
        for (int e = 0; e < 8; ++e) { const float dgv = e < 4 ? dg0[e & 3] : dg1[e & 3]; v[e] = v[e] * r1 * dgv * (zz[e] * sigm(zz[e])); y[e] = gelu_t(gg[e]) * hh[e]; s2 += y[e] * y[e]; }
#pragma unroll
        for (int o2 = 1; o2 < 64; o2 <<= 1) s2 += __shfl_xor(s2, o2);
        const float r2 = rsqrtf(s2 * (1.0f / 512.0f) + EPS);
#pragma unroll
        for (int e = 0; e < 8; ++e) { const float lgv = e < 4 ? lg0[e & 3] : lg1[e & 3]; y[e] = y[e] * r2 * lgv; }
        u32x4 w1, w2; w1.x = pk2(v[0], v[1]); w1.y = pk2(v[2], v[3]); w1.z = pk2(v[4], v[5]); w1.w = pk2(v[6], v[7]);
        w2.x = pk2(y[0], y[1]); w2.y = pk2(y[2], y[3]); w2.z = pk2(y[4], y[5]); w2.w = pk2(y[6], y[7]);
        *(u32x4*)(amix + (size_t)m * 1024 + 8 * lane) = w1; *(u32x4*)(amix + (size_t)m * 1024 + 512 + 8 * lane) = w2; } }
    }
}

__device__ __forceinline__ void glu_fixup(PT pt, int layer, int bx, int G, int tid) {
    asm volatile("" : "+v"(tid));
    unsigned char* ws = pws(pt);
    const float* sg = (const float*)(ws + WS_G); const float* su = sg + (size_t)256 * 4 * FF; bf16_t* act = (bf16_t*)(ws + WS_ACT);
    const float* cw = pin(pt, I_FCW) + (size_t)layer * 3 * FF; const float* cb = pin(pt, I_FCB) + (size_t)layer * FF;
    for (int e = bx * 512 + tid; e < 512 * (FF / 4); e += G * 512) { const int edge = e / (FF / 4), ch = (e % (FF / 4)) * 4; const int pm = edge >> 1, side = edge & 1;
        const int row = 256 * pm + (side ? 255 : 0); const int t = row & (SEQ - 1);
        const f32x4 gmid = *(const f32x4*)(sg + ((size_t)pm * 4 + (side ? 3 : 0)) * FF + ch);
        f32x4 gup = {0.f, 0.f, 0.f, 0.f}, gdn = {0.f, 0.f, 0.f, 0.f};
        if (side == 0) { gdn = *(const f32x4*)(sg + ((size_t)pm * 4 + 1) * FF + ch); if (t != 0) gup = *(const f32x4*)(sg + ((size_t)(pm - 1) * 4 + 3) * FF + ch); }
        else { gup = *(const f32x4*)(sg + ((size_t)pm * 4 + 2) * FF + ch); if (t != SEQ - 1) gdn = *(const f32x4*)(sg + ((size_t)(pm + 1) * 4 + 0) * FF + ch); }
        const f32x4 uu = *(const f32x4*)(su + ((size_t)pm * 2 + side) * FF + ch);
        const f32x4 w0 = *(const f32x4*)(cw + ch), w1 = *(const f32x4*)(cw + FF + ch), w2 = *(const f32x4*)(cw + 2 * FF + ch), bb = *(const f32x4*)(cb + ch);
        const f32x4 ga = w0 * gup + w1 * gmid + w2 * gdn + bb;
        u32x2 o; o.x = pk2(gelu_t(ga[0]) * uu[0], gelu_t(ga[1]) * uu[1]); o.y = pk2(gelu_t(ga[2]) * uu[2], gelu_t(ga[3]) * uu[3]);
        *(u32x2*)(act + (size_t)row * FF + ch) = o; }
}

#define XB_TMO      128
#define XB_XCNT(j)  (256  + 64 * (j))
#define XB_XSUB(j)  (1280 + 64 * (j))
#define XB_XGEN(j)  (2304 + 64 * (j))
#define XB_TOP      3328
#define XB_TOPGEN   3392
#define XCD_BAR_WORDS 3456
#define XB_SPIN_CAP (1u << 18)

__device__ __forceinline__ unsigned xb_ld(unsigned* p)              { return __hip_atomic_load(p, __ATOMIC_RELAXED, __HIP_MEMORY_SCOPE_AGENT); }
__device__ __forceinline__ unsigned xb_add(unsigned* p, unsigned v) { return __hip_atomic_fetch_add(p, v, __ATOMIC_RELAXED, __HIP_MEMORY_SCOPE_AGENT); }
__device__ __forceinline__ unsigned xb_xcc_id() { return (unsigned)__builtin_amdgcn_s_getreg((3 << 11) | 20) & 0xFu; }
#define XB_SPIN(cond, bar) do { unsigned _sp = 0; while (cond) { __builtin_amdgcn_s_sleep(1); \
    if ((++_sp & 255u) == 0u) { if (xb_ld(&(bar)[XB_TMO])) break; if (_sp > XB_SPIN_CAP) { atomicAdd(&(bar)[XB_TMO], 1u); break; } } } } while (0)

struct XcdBarrier {
    unsigned* bar; unsigned x;
    volatile LAS unsigned* st;
};

__device__ __forceinline__ XcdBarrier xcd_barrier_post(unsigned* bar, volatile LAS unsigned* st) {
    XcdBarrier b; b.bar = bar; b.x = xb_xcc_id(); b.st = st;
    if (threadIdx.x == 0) (void)xb_add(&bar[XB_XCNT(b.x)], 1u);
    return b;
}
__device__ __forceinline__ void xcd_barrier_complete(unsigned* bar, unsigned x, unsigned& nloc, unsigned& nx) {
    const unsigned G = gridDim.x * gridDim.y * gridDim.z;
    unsigned sum, cnt, mine, sp = 0u;
    for (;;) {
        sum = 0u; cnt = 0u; mine = 0u;
#pragma unroll
        for (unsigned j = 0; j < 16; ++j) { const unsigned c = xb_ld(&bar[XB_XCNT(j)]); sum += c; cnt += (c > 0u) ? 1u : 0u; mine = (j == x) ? c : mine; }
        if (sum == G) break;
        __builtin_amdgcn_s_sleep(1);
        if ((++sp & 255u) == 0u) { if (xb_ld(&bar[XB_TMO])) break; if (sp > XB_SPIN_CAP) { atomicAdd(&bar[XB_TMO], 1u); break; } }
    }
    nloc = mine > 0u ? mine : 1u; nx = cnt > 0u ? cnt : 1u;
}

__device__ __forceinline__ void xcd_barrier(const XcdBarrier& b) {
    asm volatile("s_waitcnt vmcnt(0)" ::: "memory");
    __syncthreads();
    if (threadIdx.x == 0) {
        unsigned* bar = b.bar;
        __builtin_amdgcn_s_waitcnt(0);
        unsigned nloc = b.st[0], nx = b.st[1];
        if (nloc == 0u) { xcd_barrier_complete(bar, b.x, nloc, nx); b.st[0] = nloc; b.st[1] = nx; }
        const unsigned old = xb_add(&bar[XB_XSUB(b.x)], 1u);
        const unsigned gen = old / nloc;
        if (old + 1u == (gen + 1u) * nloc) {
            __builtin_amdgcn_fence(__ATOMIC_RELEASE, "agent");
            asm volatile("s_waitcnt vmcnt(0)" ::: "memory");
            const unsigned og = xb_add(&bar[XB_TOP], 1u);
            const unsigned tg = og / nx;
            if (og + 1u == (tg + 1u) * nx) xb_add(&bar[XB_TOPGEN], 1u);
            else XB_SPIN(xb_ld(&bar[XB_TOPGEN]) == tg, bar);
            __builtin_amdgcn_fence(__ATOMIC_ACQUIRE, "agent");
            xb_add(&bar[XB_XGEN(b.x)], 1u);
            asm volatile("s_waitcnt vmcnt(0)" ::: "memory");
        } else {
            XB_SPIN(xb_ld(&bar[XB_XGEN(b.x)]) == gen, bar);
            __builtin_amdgcn_fence(__ATOMIC_ACQUIRE, "agent");
            asm volatile("s_waitcnt vmcnt(0)" ::: "memory");
        }
    }
    __syncthreads();
}

#ifndef PHMASK
#define PHMASK 0xFFFF
#endif
#ifndef DUPMASK
#define DUPMASK 0
#endif
#define PH(k) _Pragma("unroll 1") for (int rep_ = 0; rep_ < ((((PHMASK >> (k)) & 1) ? 1 : 0) + (((DUPMASK >> (k)) & 1) ? 1 : 0)); ++rep_)
#define GRID_BAR() do { XcdBarrier b_; b_.bar = (unsigned*)pws(pt); b_.x = xb_xcc_id(); b_.st = (volatile LAS unsigned*)(lds + LDS_BYTES - 512); xcd_barrier(b_); } while (0)
#ifndef TMASK
#define TMASK 0
#endif
#define TS_BEGIN(k) do { if (((TMASK >> (k)) & 1) && bx == 0 && tid == 0) { const unsigned long long t_ = __builtin_amdgcn_s_memrealtime(); *(volatile LAS unsigned*)(lds + LDS_BYTES - 128) = (unsigned)t_; } } while (0)
#define TS_END(k) do { if (((TMASK >> (k)) & 1) && bx == 0 && tid == 0) { const unsigned t_ = (unsigned)__builtin_amdgcn_s_memrealtime(); volatile LAS unsigned* a_ = (volatile LAS unsigned*)(lds + LDS_BYTES - 128); a_[1] += t_ - a_[0]; } } while (0)
#ifndef STAG
#define STAG 0
#endif
#define STAGGER(step_10ns) do { if (STAG) { const unsigned sg_ = ((unsigned)bx >> 3) & 1u; if (sg_) { const unsigned long long t0_ = __builtin_amdgcn_s_memrealtime(); \
        while (__builtin_amdgcn_s_memrealtime() - t0_ < (unsigned long long)(sg_ * (step_10ns))) __builtin_amdgcn_s_sleep(16); } __syncthreads(); } } while (0)
#define RB_ ((bf16_t*)(pws(pt) + WS_RB))
#define RLO_ ((bf16_t*)pout(pt) + (size_t)M_TOK * 1024)
#define RLOF_ ((bf16_t*)(pws(pt) + WS_RLO))
#define RBC_ ((bf16_t*)(pws(pt) + WS_BIG + 128 * MiB))
#define SS_(k) ((float*)(pws(pt) + WS_SSP) + (size_t)(k) * M_TOK * 4)
__global__ void __launch_bounds__(512, 2) fwd_kernel(Params P) {
    extern __shared__ __attribute__((aligned(16))) unsigned char lds_raw[];
    LAS unsigned char* lds = (LAS unsigned char*)lds_raw;
    cg::grid_group grid = cg::this_grid();
    const int tid = threadIdx.x, lane = tid & 63, wave = __builtin_amdgcn_readfirstlane(tid >> 6);
    const int G = gridDim.x, bx = blockIdx.x; const int gw = bx * 8 + wave, NGW = G * 8;
    PT pt = (PT)(lds + LDS_BYTES - 256);
    volatile LAS unsigned* xst = (volatile LAS unsigned*)(lds + LDS_BYTES - 512);
    if (tid == 0) { xst[0] = 0u; xst[1] = 0u; if (TMASK) { ((volatile LAS unsigned*)(lds + LDS_BYTES - 128))[1] = 0u; }
#pragma unroll
        for (int i = 0; i < 28; ++i) { const unsigned long long v = (unsigned long long)P.in[i]; pt[2 * i] = (unsigned)v; pt[2 * i + 1] = (unsigned)(v >> 32); }
        { const unsigned long long v = (unsigned long long)P.out; pt[56] = (unsigned)v; pt[57] = (unsigned)(v >> 32); }
        { const unsigned long long v = (unsigned long long)P.ws; pt[58] = (unsigned)v; pt[59] = (unsigned)(v >> 32); }
    }
    __syncthreads();
    (void)xcd_barrier_post((unsigned*)P.ws, xst);

    TS_BEGIN(0);
    PH(0) prologue(pt, lds, gw, NGW, lane, wave);
    __syncthreads();
    grid.sync(); TS_END(0);

#pragma unroll 1
    for (int layer = 0; layer < NL; ++layer) {
        TS_BEGIN(1); PH(1) { pg8::Gemm g{RB_, (const bf16_t*)(pws(pt) + WS_WIN) + (size_t)layer * 3328 * 1024, M_TOK, 3328, 1024}; pg8::StaticOrder S; S.init(M_TOK, 3328, G, bx);
          EpiStore E{SS_(3 * layer), {(bf16_t*)(pws(pt) + WS_PQKV), (bf16_t*)(pws(pt) + WS_PLX), (bf16_t*)(pws(pt) + WS_PZ), (bf16_t*)(pws(pt) + WS_PLG)}, {1536, 512, 512, 512}, {0, 6, 8, 10}, (float*)(pws(pt) + WS_GATES), 12};
          pg8::gemm_phase<EpiStore, pg8::StaticOrder, true, true>(lds, g, S, E);
          int tl = tid; asm volatile("" : "+v"(tl));
          const f32x4* ps = (const f32x4*)(pin(pt, I_P) + (size_t)layer * M_TOK * PLE); u32x2* pd = (u32x2*)(pws(pt) + WS_PB);
          for (size_t i = (size_t)bx * 512 + tl; i < (size_t)M_TOK * PLE / 4; i += (size_t)G * 512) pd[i] = pk4(ps[i]);
          }
        GRID_BAR(); TS_END(1);
        TS_BEGIN(2); PH(2) for (int bi = bx; bi < 256; bi += G) lru_block(pt, lds, bi, layer, tid);
        PH(3) { __syncthreads();
          { int tl = tid; asm volatile("" : "+v"(tl)); const int hh = (bx >> 5) & 3; const float* cwg = pin(pt, I_DNCW) + (size_t)layer * 4 * 1536;
            for (int e = tl; e < 1536; e += 512) { const int mat = e >> 9, tap = (e >> 7) & 3, ch = e & 127; ((LAS float*)(lds + DP_CWL))[e] = cwg[tap * 1536 + mat * 512 + hh * 128 + ch]; } }
          for (int it = bx; it < 4096; it += G) dp_item(pt, lds, it, layer, tid, lane, wave); }
        GRID_BAR(); TS_END(2);
        TS_BEGIN(4); PH(4) for (int it = bx; it < 256; it += G) dr_item(pt, lds, it, tid, lane, wave);
        GRID_BAR(); TS_END(4);
        TS_BEGIN(6); PH(6) m2_rows(pt, layer, gw, NGW, lane);
        GRID_BAR(); TS_END(6);
        TS_BEGIN(7); PH(7) { STAGGER(3700); pg8::Gemm g{(const bf16_t*)(pws(pt) + WS_AMIX), (const bf16_t*)(pws(pt) + WS_WOUT) + (size_t)layer * DM * DM, M_TOK, 1024, 1024}; pg8::StaticOrder S; S.init(M_TOK, 1024, G, bx);
          EpiResid<0> E{nullptr, RB_, RLO_, RLO_, SS_(3 * layer + 1), nullptr, nullptr, nullptr, nullptr, (LAS float*)(lds + 131072)};
          pg8::gemm_phase<EpiResid<0>, pg8::StaticOrder, true, true>(lds, g, S, E); }
        GRID_BAR(); TS_END(7);
        TS_BEGIN(9); PH(9) { pg8::Gemm g{RB_, (const bf16_t*)(pws(pt) + WS_WG) + (size_t)layer * 5632 * 1024, M_TOK, 5632, 1024}; pg8::StaticOrder S; S.init(M_TOK, 5632, G, bx);
          EpiGluF E{SS_(3 * layer + 1), (float*)(pws(pt) + WS_G), (float*)(pws(pt) + WS_G) + (size_t)256 * 4 * FF, pin(pt, I_FCW) + (size_t)layer * 3 * FF, pin(pt, I_FCB) + (size_t)layer * FF, (bf16_t*)(pws(pt) + WS_ACT), (LAS float*)(lds + 135168)};
          pg8::gemm_phase<EpiGluF, pg8::StaticOrder, true, true>(lds, g, S, E); }
        GRID_BAR(); TS_END(9);
        TS_BEGIN(8); PH(8) glu_fixup(pt, layer, bx, G, tid);
        GRID_BAR(); TS_END(8);
        TS_BEGIN(10); PH(10) { STAGGER(4800); pg8::Gemm g{(const bf16_t*)(pws(pt) + WS_ACT), (const bf16_t*)(pws(pt) + WS_WD) + (size_t)layer * DM * FF, M_TOK, 1024, FF}; pg8::StaticOrder S; S.init(M_TOK, 1024, G, bx);
          EpiResid<0> E{nullptr, RB_, RLO_, RLO_, SS_(3 * layer + 2), nullptr, nullptr, nullptr, RBC_, (LAS float*)(lds + 131072)};
          pg8::gemm_phase<EpiResid<0>, pg8::StaticOrder, true, true>(lds, g, S, E); }
        __syncthreads();
        PH(11) { pg8::Gemm g{(const bf16_t*)(pws(pt) + WS_PB), (const bf16_t*)(pws(pt) + WS_WP) + (size_t)layer * DM * PLE, M_TOK, 1024, PLE}; pg8::StaticOrder S; S.init(M_TOK, 1024, G, bx);
          EpiStore E{nullptr, {(bf16_t*)(pws(pt) + WS_PP), nullptr, nullptr, nullptr}, {1024, 0, 0, 0}, {0, 99, 99, 99}, nullptr, 99};
          pg8::gemm_phase<EpiStore, pg8::StaticOrder, true, true>(lds, g, S, E); }
        GRID_BAR(); TS_END(10);
        TS_BEGIN(12); PH(12) { STAGGER(3000); pg8::Gemm g{RBC_, (const bf16_t*)(pws(pt) + WS_WPG) + (size_t)layer * DM * DM, M_TOK, 1024, 1024}; pg8::StaticOrder S; S.init(M_TOK, 1024, G, bx);
          EpiResid<1> E{nullptr, RB_, RLO_, layer == NL - 1 ? RLOF_ : RLO_, SS_(3 * layer + 3), SS_(3 * layer + 2), pin(pt, I_PBG) + (size_t)layer * DM, (const bf16_t*)(pws(pt) + WS_PP), nullptr, (LAS float*)(lds + 131072)};
          pg8::gemm_phase<EpiResid<1>, pg8::StaticOrder, true, true>(lds, g, S, E); }
        GRID_BAR(); TS_END(12);
    }
    TS_BEGIN(13);
    { int tlf = tid; asm volatile("" : "+v"(tlf)); const int lane = tlf & 63;
      const float* ssF = SS_(12); const f32x4* fg = (const f32x4*)pin(pt, I_FING) + lane; const bf16_t* hi_ = RB_; const bf16_t* lo_ = RLOF_; float* outp = pout(pt);
      for (int m = gw; m < M_TOK; m += NGW) { const float sc = rs_of(ssF, m); f32x4* xr = (f32x4*)(outp + (size_t)m * DM) + lane;
          const u32x2* hr = (const u32x2*)(hi_ + (size_t)m * DM) + lane; const u32x2* lr = (const u32x2*)(lo_ + (size_t)m * DM) + lane;
#pragma unroll
          for (int j = 0; j < 4; ++j) { const u32x2 h = hr[64 * j], l = lr[64 * j]; const f32x4 g = fg[64 * j];
              f32x4 v; v[0] = (bflo(h.x) + bflo(l.x)) * sc * g[0]; v[1] = (bfhi(h.x) + bfhi(l.x)) * sc * g[1]; v[2] = (bflo(h.y) + bflo(l.y)) * sc * g[2]; v[3] = (bfhi(h.y) + bfhi(l.y)) * sc * g[3];
              xr[64 * j] = v; } } }
    if (TMASK) { __syncthreads(); TS_END(13); if (bx == 0 && tid == 0) { const unsigned wait_ = ((volatile LAS unsigned*)(lds + LDS_BYTES - 128))[1]; const unsigned long long t0_ = __builtin_amdgcn_s_memrealtime(); while (__builtin_amdgcn_s_memrealtime() - t0_ < (unsigned long long)wait_) __builtin_amdgcn_s_sleep(8); } }
}

extern "C" void kernel_launch(void* const* d_in, const int* in_sizes, int n_in, void* d_out, int out_size, void* d_ws, size_t ws_size, hipStream_t stream) {
    static int grid = 0;
    if (grid == 0) {
        if (n_in != 28 || ws_size < WS_END) { fprintf(stderr, "kernel_launch: unexpected n_in %d or workspace %zu < %zu\n", n_in, ws_size, (size_t)WS_END); grid = -1; return; }
        int dev = 0, cus = 0, per_cu = 0;
        hipGetDevice(&dev); hipDeviceGetAttribute(&cus, hipDeviceAttributeMultiprocessorCount, dev);
        if (hipFuncSetAttribute((const void*)fwd_kernel, hipFuncAttributeMaxDynamicSharedMemorySize, LDS_BYTES) != hipSuccess) fprintf(stderr, "kernel_launch: hipFuncSetAttribute failed\n");
        if (hipOccupancyMaxActiveBlocksPerMultiprocessor(&per_cu, (const void*)fwd_kernel, 512, LDS_BYTES) != hipSuccess || per_cu < 1) { fprintf(stderr, "kernel_launch: occupancy query says %d\n", per_cu); per_cu = 1; }
        (void)hipGetLastError();
        grid = cus * per_cu; if (grid > 256) grid = 256;
    }
    if (grid < 0) return;
    if (hipMemsetAsync(d_ws, 0, 16384, stream) != hipSuccess) { fprintf(stderr, "kernel_launch: memset of the barrier words failed\n"); return; }
    Params p{};
    for (int i = 0; i < 28; ++i) p.in[i] = (const float*)d_in[i];
    p.out = (float*)d_out; p.ws = (unsigned char*)d_ws;
    void* args[] = {&p};
    hipError_t e = hipLaunchCooperativeKernel((const void*)fwd_kernel, dim3(grid), dim3(512), args, LDS_BYTES, stream);
    if (e != hipSuccess) fprintf(stderr, "cooperative launch failed: %s (grid %d)\n", hipGetErrorString(e), grid);
}
```

```cpp
#include <hip/hip_runtime.h>
#include <hip/hip_cooperative_groups.h>
#include <cstdio>
#include <cstdint>
namespace cg = cooperative_groups;

#define LAS __attribute__((address_space(3)))
typedef unsigned short bf16_t;
typedef short bf16x8 __attribute__((ext_vector_type(8)));
typedef short s16x4 __attribute__((ext_vector_type(4)));
typedef float f32x2 __attribute__((ext_vector_type(2)));
typedef float f32x4 __attribute__((ext_vector_type(4)));
typedef float f32x16 __attribute__((ext_vector_type(16)));
typedef unsigned u32x4 __attribute__((ext_vector_type(4)));
typedef unsigned u32x2 __attribute__((ext_vector_type(2)));
typedef __bf16 bfx2_t __attribute__((ext_vector_type(2)));

constexpr int M_TOK = 65536, DM = 1024, SEQ = 2048, NB = 32, NL = 4;
constexpr int FF = 2816, PLE = 256, INC = 3088;
constexpr float EPS = 1e-6f;

constexpr size_t MiB = 1u << 20;
constexpr size_t WS_SS = 0;
constexpr size_t WS_WIN = 4 * MiB;
constexpr size_t WS_WOUT = WS_WIN + 26 * MiB;
constexpr size_t WS_WG = WS_WOUT + 8 * MiB;
constexpr size_t WS_WU = WS_WG + 22 * MiB;
constexpr size_t WS_WD = WS_WU + 22 * MiB;
constexpr size_t WS_WPG = WS_WD + 22 * MiB;
constexpr size_t WS_WP = WS_WPG + 8 * MiB;
constexpr size_t WS_WAT = WS_WP + 2 * MiB;
constexpr size_t WS_GATES = WS_WAT + 1 * MiB;
constexpr size_t WS_VEC = WS_GATES + 4 * MiB;
constexpr size_t WS_PB = WS_VEC + 8 * MiB;
constexpr size_t WS_RB = WS_PB + 32 * MiB;
constexpr size_t WS_BIG = WS_RB + 128 * MiB;
constexpr size_t WS_PQKV = WS_BIG;
constexpr size_t WS_OF = WS_BIG, WS_OB = WS_BIG + 64 * MiB, WS_PZ = WS_BIG + 576 * MiB;
constexpr size_t WS_PLX = WS_BIG + 192 * MiB, WS_PLG = WS_BIG + 640 * MiB;
constexpr size_t WS_QH = WS_BIG + 256 * MiB, WS_KH = WS_BIG + 320 * MiB, WS_VT = WS_BIG + 384 * MiB;
constexpr size_t WS_TM = WS_BIG + 448 * MiB, WS_AT = WS_BIG + 512 * MiB;
constexpr size_t WS_RLO = WS_BIG + 576 * MiB;
constexpr size_t WS_AMIX = WS_BIG + 256 * MiB;
constexpr size_t WS_G = WS_BIG, WS_ACT = WS_BIG + 352 * MiB, WS_PP = WS_BIG;
constexpr size_t WS_SSP = WS_BIG + 704 * MiB;
constexpr size_t WS_END = WS_SSP + 13 * MiB;
constexpr int LDS_BYTES = 153600;

__device__ __forceinline__ unsigned pk2(float lo, float hi) { f32x2 v = {lo, hi}; bfx2_t b = __builtin_convertvector(v, bfx2_t); return __builtin_bit_cast(unsigned, b); }
__device__ __forceinline__ u32x2 pk4(f32x4 v) { u32x2 r; r.x = pk2(v[0], v[1]); r.y = pk2(v[2], v[3]); return r; }
__device__ __forceinline__ unsigned pk4_fp8(float a, float b, float c, float d) { int v = 0; v = __builtin_amdgcn_cvt_pk_fp8_f32(a * 1024.f, b * 1024.f, v, false); v = __builtin_amdgcn_cvt_pk_fp8_f32(c * 1024.f, d * 1024.f, v, true); return (unsigned)v; }
#define FP8_AT(w, i) (__builtin_amdgcn_cvt_f32_fp8((int)(w), (i)) * (1.0f / 1024.0f))
__device__ __forceinline__ float bflo(unsigned w) { return __uint_as_float(w << 16); }
__device__ __forceinline__ float bfhi(unsigned w) { return __uint_as_float(w & 0xffff0000u); }
__device__ __forceinline__ float bf2f(unsigned short b) { return __uint_as_float((unsigned)b << 16); }
__device__ __forceinline__ float fexp(float x) { return __builtin_amdgcn_exp2f(x * 1.4426950408889634f); }
__device__ __forceinline__ float sigm(float x) { return __builtin_amdgcn_rcpf(1.0f + fexp(-x)); }
__device__ __forceinline__ float gelu_t(float x) { const float u = 1.5957691216057308f * (x + 0.044715f * x * x * x); return x * __builtin_amdgcn_rcpf(1.0f + fexp(-u)); }
__device__ __forceinline__ float softplus_f(float x) { return x > 20.f ? x : log1pf(expf(x)); }
__device__ __forceinline__ int swz128(int row, int col) { return row * 256 + ((((col >> 3) ^ (row & 15)) << 4) | ((col & 7) << 1)); }
__device__ __forceinline__ int swz64(int row, int col) { return row * 128 + ((((col >> 3) ^ (row & 7)) << 4) | ((col & 7) << 1)); }
__device__ __forceinline__ int crow(int r, int hi) { return (r & 3) + 8 * (r >> 2) + 4 * hi; }
#define MFMA16(a, b, c) __builtin_amdgcn_mfma_f32_16x16x32_bf16((a), (b), (c), 0, 0, 0)
#define MFMA32(a, b, c) __builtin_amdgcn_mfma_f32_32x32x16_bf16((a), (b), (c), 0, 0, 0)
typedef unsigned long long u64;
__device__ __forceinline__ float rs_of(const float* ss4, int row) { const f32x4 p = *(const f32x4*)(ss4 + (size_t)row * 4); return rsqrtf(((p[0] + p[1]) + (p[2] + p[3])) * (1.0f / 1024.0f) + EPS); }
#define LDS_FENCE() asm volatile("s_waitcnt lgkmcnt(0)" ::: "memory")

#define LBAR() do { asm volatile("s_waitcnt lgkmcnt(0)" ::: "memory"); __builtin_amdgcn_s_barrier(); asm volatile("" ::: "memory"); } while (0)

namespace pg8 {
#define PG8_LAS __attribute__((address_space(3)))
typedef unsigned short bf16_t;
typedef short bf16x8 __attribute__((ext_vector_type(8)));
typedef float f32x4 __attribute__((ext_vector_type(4)));
typedef unsigned u32x4 __attribute__((ext_vector_type(4)));
constexpr int BM = 256, BK = 64, HALF = 128, HTB = HALF * BK * 2  , STAGE_BYTES = 8 * HTB, NXCD = 8, WGM = 8;

__host__ __device__ __forceinline__ int lds_byte(int r, int c) { const int st = (r >> 4) * 2 + (c >> 5), rr = r & 15, cc = c & 31, ob = rr * 64 + cc * 2; return st * 1024 + (ob ^ (((ob >> 9) & 1) << 5)); }
__host__ __device__ __forceinline__ void stage_rc(int b, int& R, int& C) { const int st = b / 1024, sb = b % 1024, swz = sb ^ (((sb >> 9) & 1) << 5); R = (st >> 1) * 16 + swz / 64; C = (st & 1) * 32 + (swz % 64) / 2; }
__host__ __device__ __forceinline__ int perm32(int rho) { const int n = rho >> 4, i = rho & 15; return 8 * (i >> 2) + 4 * n + (i & 3); }

struct Unit { int pm, pn; };
struct Gemm { const bf16_t* A; const bf16_t* Bt; int M, N, K; };

struct StaticOrder {
    int nM, nN, nwg, G, c;
    __host__ __device__ void init(int M, int N, int G_, int c_) { nM = M / BM; nN = N / BM; nwg = nM * nN; G = G_; c = c_; }
    __host__ __device__ bool next(int i, Unit& u) const {
        const long L = (long)i * G + c; if (L >= nwg) return false;
        int wgid = (int)L; { const int q = nwg / NXCD, r = nwg % NXCD, xcd = wgid % NXCD, off = wgid / NXCD; wgid = (xcd < r ? xcd * (q + 1) : r * (q + 1) + (xcd - r) * q) + off; }
        const int nig = WGM * nN, gid = wgid / nig, fm = gid * WGM, gsz = (nM - fm) < WGM ? (nM - fm) : WGM;
        u.pm = fm + ((wgid % nig) % gsz); u.pn = (wgid % nig) / gsz; return true;
    }
    __device__ __forceinline__ void a_ready(const Unit&) const {}
    __device__ __forceinline__ void done(const Unit&) const {}
};

template <class Epi, class Sched, bool ALIGN_EPI = false, bool SP2 = false>
__device__ __forceinline__ void gemm_phase(PG8_LAS unsigned char* lds, const Gemm g, const Sched& S, const Epi& E) {
    int tid_ = threadIdx.x; asm volatile("" : "+v"(tid_));
    const int tid = tid_, wid = __builtin_amdgcn_readfirstlane(tid >> 6), lane = tid & 63, wr = wid >> 2, wc = wid & 3, fr = lane & 15, fq = lane >> 4;
    const int K = g.K, nt = K / BK;
    unsigned voffA[2], voffB[2];
#pragma unroll
    for (int i = 0; i < 2; ++i) { int R, C; stage_rc(tid * 16 + i * 8192, R, C); const int Rb = Epi::PERM ? ((R & ~31) + perm32(R & 31)) : R;
        voffA[i] = (unsigned)(R * K + C) * 2u; voffB[i] = (unsigned)(Rb * K + C) * 2u; }
    const size_t kstep = (size_t)(BK * 2);
    const size_t hstep = (size_t)HALF * K * 2;
    const size_t tstep = 2 * hstep;
    const unsigned ldsw = (unsigned)wid * 1024u;
    const int aoff = lds_byte(wr * 64 + fr, fq * 8), boff = lds_byte(wc * 32 + fr, fq * 8);
#define PG8_SA(b, h) (((b) * 2 + (h)) * HTB)
#define PG8_SB(b, h) ((4 + (b) * 2 + (h)) * HTB)
#define PG8_STAGE(bufoff, gbase, voff) do { _Pragma("unroll") for (int _i = 0; _i < 2; ++_i) \
        __builtin_amdgcn_global_load_lds((const unsigned*)((const char*)(gbase) + (voff)[_i]), (PG8_LAS unsigned*)(lds + (bufoff) + ldsw + _i * 8192), 16, 0, 0); } while (0)
#define PG8_LDA(dst, b, h) do { _Pragma("unroll") for (int m = 0; m < 4; ++m) _Pragma("unroll") for (int k = 0; k < 2; ++k) dst[m][k] = *(const PG8_LAS bf16x8*)(lds + PG8_SA(b, h) + aoff + m * 2048 + k * 1024); } while (0)
#define PG8_LDB(dst, b, h) do { _Pragma("unroll") for (int n = 0; n < 2; ++n) _Pragma("unroll") for (int k = 0; k < 2; ++k) dst[n][k] = *(const PG8_LAS bf16x8*)(lds + PG8_SB(b, h) + boff + n * 2048 + k * 1024); } while (0)
#define PG8_MMA(ai, bj, At, Bt) do { __builtin_amdgcn_s_setprio(1); _Pragma("unroll") for (int m = 0; m < 4; ++m) _Pragma("unroll") for (int n = 0; n < 2; ++n) _Pragma("unroll") for (int k = 0; k < 2; ++k) \
        acc[ai][bj][m][n] = __builtin_amdgcn_mfma_f32_16x16x32_bf16(Bt[n][k], At[m][k], acc[ai][bj][m][n], 0, 0, 0); __builtin_amdgcn_s_setprio(0); } while (0)
#define PG8_WAIT_V(n) asm volatile("s_waitcnt vmcnt(" #n ")" ::: "memory")
#define PG8_WAIT_L(n) asm volatile("s_waitcnt lgkmcnt(" #n ")" ::: "memory")
#define PG8_BAR __builtin_amdgcn_s_barrier()
#define PG8_SCHED __builtin_amdgcn_sched_barrier(0)
    Unit cur, nxt; int ui = 0;
    if (!S.next(0, cur)) return;
    f32x4 acc[2][2][4][2];
#pragma unroll
    for (int a = 0; a < 2; ++a)
#pragma unroll
        for (int b = 0; b < 2; ++b)
#pragma unroll
            for (int m = 0; m < 4; ++m)
#pragma unroll
                for (int n = 0; n < 2; ++n) acc[a][b][m][n] = (f32x4){0.f, 0.f, 0.f, 0.f};
    bf16x8 At[4][2], B0[2][2], B1[2][2];
    const char* cA = (const char*)g.A + (size_t)cur.pm * tstep; const char* cB = (const char*)g.Bt + (size_t)cur.pn * tstep;
    S.a_ready(cur);
    if constexpr (SP2) {
        PG8_STAGE(PG8_SB(0, 0), cB, voffB); PG8_STAGE(PG8_SB(0, 1), cB + hstep, voffB); PG8_STAGE(PG8_SA(0, 0), cA, voffA); PG8_STAGE(PG8_SA(0, 1), cA + hstep, voffA);
        if (wr == 1) PG8_BAR;
        PG8_WAIT_V(2); PG8_BAR;
        PG8_STAGE(PG8_SB(1, 0), cB + kstep, voffB); PG8_STAGE(PG8_SA(1, 0), cA + kstep, voffA); PG8_STAGE(PG8_SB(1, 1), cB + hstep + kstep, voffB);
        PG8_WAIT_V(6); PG8_BAR;
    } else {
        PG8_STAGE(PG8_SB(0, 0), cB, voffB); PG8_STAGE(PG8_SA(0, 0), cA, voffA); PG8_STAGE(PG8_SB(0, 1), cB + hstep, voffB); PG8_STAGE(PG8_SA(0, 1), cA + hstep, voffA);
        if (wr == 1) PG8_BAR;
        PG8_WAIT_V(4); PG8_BAR;
        PG8_STAGE(PG8_SB(1, 0), cB + kstep, voffB); PG8_STAGE(PG8_SA(1, 0), cA + kstep, voffA); PG8_STAGE(PG8_SB(1, 1), cB + hstep + kstep, voffB);
        PG8_WAIT_V(6); PG8_BAR;
    }
    for (;;) {
        const bool has_next = S.next(ui + 1, nxt);
        const char* nA = has_next ? (const char*)g.A + (size_t)nxt.pm * tstep : cA; const char* nB = has_next ? (const char*)g.Bt + (size_t)nxt.pn * tstep : cB;
        for (int t = 0; t < nt; t += 2) {
            const bool last = (t == nt - 2);
            const char* a1 = cA + (size_t)(t + 1) * kstep;
            const char* a2 = last ? nA : cA + (size_t)(t + 2) * kstep; const char* b2 = last ? nB : cB + (size_t)(t + 2) * kstep;
            const char* a3 = a2 + kstep; const char* b3 = b2 + kstep;
            if (last && has_next) S.a_ready(nxt);
            if constexpr (SP2) {
            PG8_LDB(B0, 0, 0); PG8_LDB(B1, 0, 1); PG8_SCHED; PG8_LDA(At, 0, 0); PG8_STAGE(PG8_SA(1, 1), a1 + hstep, voffA);
            PG8_WAIT_V(8); PG8_WAIT_L(0); PG8_BAR; PG8_MMA(0, 0, At, B0); PG8_MMA(0, 1, At, B1); PG8_BAR; PG8_SCHED;
            PG8_LDA(At, 0, 1); PG8_STAGE(PG8_SB(0, 0), b2, voffB); PG8_STAGE(PG8_SB(0, 1), b2 + hstep, voffB); PG8_STAGE(PG8_SA(0, 0), a2, voffA);
            PG8_WAIT_V(8); PG8_WAIT_L(0); PG8_BAR; PG8_MMA(1, 0, At, B0); PG8_MMA(1, 1, At, B1); PG8_BAR; PG8_SCHED;
            PG8_LDB(B0, 1, 0); PG8_LDB(B1, 1, 1); PG8_SCHED; PG8_LDA(At, 1, 0); PG8_STAGE(PG8_SA(0, 1), a2 + hstep, voffA);
            PG8_WAIT_V(8); PG8_WAIT_L(0); PG8_BAR; PG8_MMA(0, 0, At, B0); PG8_MMA(0, 1, At, B1); PG8_BAR; PG8_SCHED;
            PG8_LDA(At, 1, 1); PG8_STAGE(PG8_SB(1, 0), b3, voffB); PG8_STAGE(PG8_SB(1, 1), b3 + hstep, voffB); PG8_STAGE(PG8_SA(1, 0), a3, voffA);
            PG8_WAIT_V(8); PG8_WAIT_L(0); PG8_BAR; PG8_MMA(1, 0, At, B0); PG8_MMA(1, 1, At, B1); PG8_BAR; PG8_SCHED;
            } else {
            PG8_LDB(B0, 0, 0); PG8_SCHED; PG8_LDA(At, 0, 0); PG8_STAGE(PG8_SA(1, 1), a1 + hstep, voffA);
            PG8_WAIT_L(8); PG8_BAR; PG8_WAIT_L(0); PG8_MMA(0, 0, At, B0); PG8_BAR; PG8_SCHED;
            PG8_LDB(B1, 0, 1); PG8_STAGE(PG8_SB(0, 0), b2, voffB);
            PG8_BAR; PG8_WAIT_L(0); PG8_MMA(0, 1, At, B1); PG8_BAR;
            PG8_LDA(At, 0, 1); PG8_STAGE(PG8_SA(0, 0), a2, voffA);
            PG8_BAR; PG8_WAIT_L(0); PG8_MMA(1, 0, At, B0); PG8_BAR; PG8_SCHED;
            PG8_STAGE(PG8_SB(0, 1), b2 + hstep, voffB);
            PG8_WAIT_V(6); PG8_BAR; PG8_MMA(1, 1, At, B1); PG8_BAR;
            PG8_LDB(B0, 1, 0); PG8_SCHED; PG8_LDA(At, 1, 0); PG8_STAGE(PG8_SA(0, 1), a2 + hstep, voffA);
            PG8_WAIT_L(8); PG8_BAR; PG8_WAIT_L(0); PG8_MMA(0, 0, At, B0); PG8_BAR; PG8_SCHED;
            PG8_LDB(B1, 1, 1); PG8_STAGE(PG8_SB(1, 0), b3, voffB);
            PG8_BAR; PG8_WAIT_L(0); PG8_MMA(0, 1, At, B1); PG8_BAR;
            PG8_LDA(At, 1, 1); PG8_STAGE(PG8_SA(1, 0), a3, voffA);
            PG8_BAR; PG8_WAIT_L(0); PG8_MMA(1, 0, At, B0); PG8_BAR; PG8_SCHED;
            PG8_STAGE(PG8_SB(1, 1), b3 + hstep, voffB);
            PG8_WAIT_V(6); PG8_BAR; PG8_MMA(1, 1, At, B1); PG8_BAR;
            }
        }
        if constexpr (ALIGN_EPI) { if (wr == 0) PG8_BAR; }
        if constexpr (!Epi::AFTER_DRAIN) { E(acc, cur, wr, wc, fr, fq); S.done(cur); }
        if (!has_next) break;
#pragma unroll
        for (int a = 0; a < 2; ++a)
#pragma unroll
            for (int b = 0; b < 2; ++b)
#pragma unroll
                for (int m = 0; m < 4; ++m)
#pragma unroll
                    for (int n = 0; n < 2; ++n) acc[a][b][m][n] = (f32x4){0.f, 0.f, 0.f, 0.f};
        cur = nxt; cA = nA; cB = nB; ++ui;
        if constexpr (ALIGN_EPI) { if (wr == 1) PG8_BAR; }
    }
    PG8_WAIT_V(0);
    if constexpr (!ALIGN_EPI) { if (wr == 0) PG8_BAR; }
    PG8_BAR;
    if constexpr (Epi::AFTER_DRAIN) { E.fused(acc, cur, wr, wc, fr, fq, lds, wid, lane); S.done(cur); }
#undef PG8_SA
#undef PG8_SB
#undef PG8_STAGE
#undef PG8_LDA
#undef PG8_LDB
#undef PG8_MMA
#undef PG8_WAIT_V
#undef PG8_WAIT_L
#undef PG8_BAR
#undef PG8_SCHED
}
}

using pg8::Unit;
struct EpiStore {
    static constexpr bool PERM = true, AFTER_DRAIN = false;
    const float* ss; bf16_t* base[4]; int ld[4]; int ts[4]; float* gates; int t2;
    __device__ __forceinline__ void operator()(const f32x4 (&acc)[2][2][4][2], const Unit& u, int wr, int wc, int fr, int fq) const {
        const int row0 = u.pm * 256 + wr * 64 + fr; const int pn = u.pn;
        if (pn >= t2) {
            if (wc == 0 && fq < 2) {
#pragma unroll
                for (int ai = 0; ai < 2; ++ai)
#pragma unroll
                    for (int m = 0; m < 4; ++m) { const int row = row0 + ai * 128 + m * 16; const float s = ss ? rs_of(ss, row) : 1.f;
                        float* gp = gates + (size_t)row * 16 + 8 * fq; *(f32x4*)gp = acc[ai][0][m][0] * s; *(f32x4*)(gp + 4) = acc[ai][0][m][1] * s; }
            }
            return;
        }
        int k = 0; if (pn >= ts[1]) k = 1; if (pn >= ts[2]) k = 2; if (pn >= ts[3]) k = 3;
        bf16_t* bsel = base[0]; int ldsel = ld[0], t0 = ts[0];
        if (k == 1) { bsel = base[1]; ldsel = ld[1]; t0 = ts[1]; } else if (k == 2) { bsel = base[2]; ldsel = ld[2]; t0 = ts[2]; } else if (k == 3) { bsel = base[3]; ldsel = ld[3]; t0 = ts[3]; }
        const int col0 = (pn - t0) * 256 + wc * 32 + 8 * fq;
#pragma unroll
        for (int ai = 0; ai < 2; ++ai)
#pragma unroll
            for (int m = 0; m < 4; ++m) { const int row = row0 + ai * 128 + m * 16; const float s = ss ? rs_of(ss, row) : 1.f;
                bf16_t* rowp = bsel + (size_t)row * ldsel + col0;
#pragma unroll
                for (int bj = 0; bj < 2; ++bj) { const f32x4 v0 = acc[ai][bj][m][0] * s, v1 = acc[ai][bj][m][1] * s;
                    u32x4 w; w.x = pk2(v0[0], v0[1]); w.y = pk2(v0[2], v0[3]); w.z = pk2(v1[0], v1[1]); w.w = pk2(v1[2], v1[3]);
                    *(u32x4*)(rowp + bj * 128) = w; } }
    }
};

#ifndef RES_BM
#define RES_BM 4
#endif
#ifndef RES1_BM
#define RES1_BM 2
#endif
template <int MODE> struct EpiResid {
    static constexpr bool PERM = true, AFTER_DRAIN = false;
    const float* rin32; bf16_t* rb; const unsigned char* rlo; unsigned char* rlo_w; float* ss_out; const float* ss_in; const float* bias; const bf16_t* pp; bf16_t* rb2; LAS float* sl;
    __device__ __forceinline__ void ld_r(size_t off, f32x4& r0, f32x4& r1) const {
        if (rin32) { r0 = *(const f32x4*)(rin32 + off); r1 = *(const f32x4*)(rin32 + off + 4); }
        else { const u32x4 h = *(const u32x4*)(rb + off); const u32x2 l = *(const u32x2*)(rlo + off);
            r0[0] = bflo(h.x) + FP8_AT(l.x, 0); r0[1] = bfhi(h.x) + FP8_AT(l.x, 1); r0[2] = bflo(h.y) + FP8_AT(l.x, 2); r0[3] = bfhi(h.y) + FP8_AT(l.x, 3);
            r1[0] = bflo(h.z) + FP8_AT(l.y, 0); r1[1] = bfhi(h.z) + FP8_AT(l.y, 1); r1[2] = bflo(h.w) + FP8_AT(l.y, 2); r1[3] = bfhi(h.w) + FP8_AT(l.y, 3); }
    }
    __device__ __forceinline__ float st_r(size_t off, const f32x4& r0, const f32x4& r1) const {
        u32x4 w; w.x = pk2(r0[0], r0[1]); w.y = pk2(r0[2], r0[3]); w.z = pk2(r1[0], r1[1]); w.w = pk2(r1[2], r1[3]);
        u32x2 l; l.x = pk4_fp8(r0[0] - bflo(w.x), r0[1] - bfhi(w.x), r0[2] - bflo(w.y), r0[3] - bfhi(w.y)); l.y = pk4_fp8(r1[0] - bflo(w.z), r1[1] - bfhi(w.z), r1[2] - bflo(w.w), r1[3] - bfhi(w.w));
        *(u32x4*)(rb + off) = w; *(u32x2*)(rlo_w + off) = l; if (rb2) *(u32x4*)(rb2 + off) = w;
        return (r0[0] * r0[0] + r0[1] * r0[1]) + (r0[2] * r0[2] + r0[3] * r0[3]) + (r1[0] * r1[0] + r1[1] * r1[1]) + (r1[2] * r1[2] + r1[3] * r1[3]);
    }
    __device__ __forceinline__ void operator()(const f32x4 (&acc)[2][2][4][2], const Unit& u, int wr, int wc, int fr, int fq) const {
        run<false>(acc, u, wr, wc, fr, fq);
    }
    template <bool F32IN> __device__ __forceinline__ void run(const f32x4 (&acc)[2][2][4][2], const Unit& u, int wr, int wc, int fr, int fq) const {
        const int row0 = u.pm * 256 + wr * 64 + fr; const int col0 = u.pn * 256 + wc * 32 + 8 * fq;
        float sqa[2][4] = {{0.f, 0.f, 0.f, 0.f}, {0.f, 0.f, 0.f, 0.f}}; float sina[2][4]; f32x4 bia[2][2];
#pragma unroll
        for (int ai = 0; ai < 2; ++ai)
#pragma unroll
            for (int m = 0; m < 4; ++m) sina[ai][m] = (MODE == 1) ? rs_of(ss_in, row0 + ai * 128 + m * 16) : 1.f;
#pragma unroll
        for (int bj = 0; bj < 2; ++bj) { bia[bj][0] = (f32x4){0.f, 0.f, 0.f, 0.f}; bia[bj][1] = (f32x4){0.f, 0.f, 0.f, 0.f};
            if (MODE == 1) { bia[bj][0] = *(const f32x4*)(bias + col0 + bj * 128); bia[bj][1] = *(const f32x4*)(bias + col0 + bj * 128 + 4); } }
        constexpr int RPB = (MODE == 1) ? 1 : 2;
        constexpr int NBAT = 16 / RPB;
        u32x4 ph[2][RPB], pw[2][RPB]; u32x2 pl[2][RPB];
#define RES_AI(b_) ((b_) / (8 / RPB))
#define RES_BJ(b_) (((b_) / (4 / RPB)) & 1)
#define RES_MH(b_) (((b_) % (4 / RPB)) * RPB)
#define RES_OFF(b_, m_) ((size_t)(row0 + RES_AI(b_) * 128 + (RES_MH(b_) + (m_)) * 16) * 1024 + col0 + RES_BJ(b_) * 128)
#define RES_LOAD(b_, buf_) do { _Pragma("unroll") for (int m_ = 0; m_ < RPB; ++m_) { const size_t off_ = RES_OFF(b_, m_); ph[buf_][m_] = *(const u32x4*)(rb + off_); pl[buf_][m_] = *(const u32x2*)(rlo + off_); \
            if (MODE == 1) pw[buf_][m_] = *(const u32x4*)(pp + off_); } } while (0)
        __builtin_amdgcn_sched_barrier(0);
        RES_LOAD(0, 0);
        __builtin_amdgcn_sched_barrier(0);
#pragma unroll
        for (int b = 0; b < NBAT; ++b) { const int buf = b & 1; const int ai = RES_AI(b), bj = RES_BJ(b), mh = RES_MH(b);
            if (b + 1 < NBAT) { RES_LOAD(b + 1, buf ^ 1); }
            __builtin_amdgcn_sched_barrier(0);
            const f32x4 b0 = bia[bj][0], b1 = bia[bj][1];
#pragma unroll
            for (int m = 0; m < RPB; ++m) { const size_t off = RES_OFF(b, m); const float si = sina[ai][mh + m]; const u32x4 h = ph[buf][m]; const u32x2 l = pl[buf][m];
                f32x4 p0, p1;
                p0[0] = bflo(h.x) + FP8_AT(l.x, 0); p0[1] = bfhi(h.x) + FP8_AT(l.x, 1); p0[2] = bflo(h.y) + FP8_AT(l.x, 2); p0[3] = bfhi(h.y) + FP8_AT(l.x, 3);
                p1[0] = bflo(h.z) + FP8_AT(l.y, 0); p1[1] = bfhi(h.z) + FP8_AT(l.y, 1); p1[2] = bflo(h.w) + FP8_AT(l.y, 2); p1[3] = bfhi(h.w) + FP8_AT(l.y, 3);
                f32x4 a0 = acc[ai][bj][mh + m][0], a1 = acc[ai][bj][mh + m][1];
                if (MODE == 1) { const u32x4 w = pw[buf][m];
                    a0[0] = sigm(a0[0] * si + b0[0]) * bflo(w.x); a0[1] = sigm(a0[1] * si + b0[1]) * bfhi(w.x);
                    a0[2] = sigm(a0[2] * si + b0[2]) * bflo(w.y); a0[3] = sigm(a0[3] * si + b0[3]) * bfhi(w.y);
                    a1[0] = sigm(a1[0] * si + b1[0]) * bflo(w.z); a1[1] = sigm(a1[1] * si + b1[1]) * bfhi(w.z);
                    a1[2] = sigm(a1[2] * si + b1[2]) * bflo(w.w); a1[3] = sigm(a1[3] * si + b1[3]) * bfhi(w.w); }
                const f32x4 r0 = p0 + a0, r1 = p1 + a1;
                sqa[ai][mh + m] += st_r(off, r0, r1); }
            __builtin_amdgcn_sched_barrier(0);
        }
#undef RES_AI
#undef RES_BJ
#undef RES_MH
#undef RES_LOAD
#undef RES_OFF
#pragma unroll
        for (int ai = 0; ai < 2; ++ai)
#pragma unroll
            for (int m = 0; m < 4; ++m) { float q = sqa[ai][m]; q += __shfl_xor(q, 16); q += __shfl_xor(q, 32);
                if (fq == 0) sl[(ai * 128 + wr * 64 + m * 16 + fr) * 4 + wc] = q; }
        asm volatile("s_waitcnt lgkmcnt(0)" ::: "memory"); __builtin_amdgcn_s_barrier(); asm volatile("" ::: "memory");
        if (fq == 0) {
#pragma unroll
            for (int ai = 0; ai < 2; ++ai) { const int r = ai * 128 + wr * 64 + wc * 16 + fr; const f32x4 p = *(const LAS f32x4*)(sl + r * 4);
                ss_out[(size_t)(u.pm * 256 + r) * 4 + u.pn] = (p[0] + p[1]) + (p[2] + p[3]); } }
    }
};

#ifndef GLU_BM
#define GLU_BM 2
#endif
struct EpiGlu {
    static constexpr bool PERM = true, AFTER_DRAIN = false;
    const float* ss; const bf16_t* G; const float* cw; const float* cb; bf16_t* act;
    __device__ __forceinline__ void operator()(const f32x4 (&acc)[2][2][4][2], const Unit& u, int wr, int wc, int fr, int fq) const {
        const int row0 = u.pm * 256 + wr * 64 + fr; const int col0 = u.pn * 256 + wc * 32 + 8 * fq;
#pragma unroll
        for (int bj = 0; bj < 2; ++bj) { const int c = col0 + bj * 128;
            const f32x4 w0a = *(const f32x4*)(cw + c), w0b = *(const f32x4*)(cw + c + 4), w1a = *(const f32x4*)(cw + FF + c), w1b = *(const f32x4*)(cw + FF + c + 4);
            const f32x4 w2a = *(const f32x4*)(cw + 2 * FF + c), w2b = *(const f32x4*)(cw + 2 * FF + c + 4), bba = *(const f32x4*)(cb + c), bbb = *(const f32x4*)(cb + c + 4);
#pragma unroll
            for (int ai = 0; ai < 2; ++ai)
#pragma unroll
            for (int mh = 0; mh < 4; mh += GLU_BM) {
                u32x4 gmv[GLU_BM], glv[GLU_BM], gnv[GLU_BM]; float sv[GLU_BM];
#pragma unroll
                for (int m = 0; m < GLU_BM; ++m) { const int row = row0 + ai * 128 + (mh + m) * 16; const int t = row & (SEQ - 1); const bf16_t* gp = G + (size_t)row * FF + c;
                    gmv[m] = *(const u32x4*)gp; glv[m] = (u32x4){0u, 0u, 0u, 0u}; gnv[m] = (u32x4){0u, 0u, 0u, 0u};
                    if (t > 0) glv[m] = *(const u32x4*)(gp - FF);
                    if (t < SEQ - 1) gnv[m] = *(const u32x4*)(gp + FF);
                    sv[m] = rs_of(ss, row); }
#pragma unroll
                for (int m = 0; m < GLU_BM; ++m) { const int row = row0 + ai * 128 + (mh + m) * 16; const float s = sv[m]; const u32x4 gm = gmv[m], gl = glv[m], gn = gnv[m];
                    f32x4 ga, gb;
                    ga[0] = w0a[0] * bflo(gl.x) + w1a[0] * bflo(gm.x) + w2a[0] * bflo(gn.x) + bba[0];
                    ga[1] = w0a[1] * bfhi(gl.x) + w1a[1] * bfhi(gm.x) + w2a[1] * bfhi(gn.x) + bba[1];
                    ga[2] = w0a[2] * bflo(gl.y) + w1a[2] * bflo(gm.y) + w2a[2] * bflo(gn.y) + bba[2];
                    ga[3] = w0a[3] * bfhi(gl.y) + w1a[3] * bfhi(gm.y) + w2a[3] * bfhi(gn.y) + bba[3];
                    gb[0] = w0b[0] * bflo(gl.z) + w1b[0] * bflo(gm.z) + w2b[0] * bflo(gn.z) + bbb[0];
                    gb[1] = w0b[1] * bfhi(gl.z) + w1b[1] * bfhi(gm.z) + w2b[1] * bfhi(gn.z) + bbb[1];
                    gb[2] = w0b[2] * bflo(gl.w) + w1b[2] * bflo(gm.w) + w2b[2] * bflo(gn.w) + bbb[2];
                    gb[3] = w0b[3] * bfhi(gl.w) + w1b[3] * bfhi(gm.w) + w2b[3] * bfhi(gn.w) + bbb[3];
                    const f32x4 a0 = acc[ai][bj][mh + m][0] * s, a1 = acc[ai][bj][mh + m][1] * s;
                    u32x4 w; w.x = pk2(gelu_t(ga[0]) * a0[0], gelu_t(ga[1]) * a0[1]); w.y = pk2(gelu_t(ga[2]) * a0[2], gelu_t(ga[3]) * a0[3]);
                    w.z = pk2(gelu_t(gb[0]) * a1[0], gelu_t(gb[1]) * a1[1]); w.w = pk2(gelu_t(gb[2]) * a1[2], gelu_t(gb[3]) * a1[3]);
                    *(u32x4*)(act + (size_t)row * FF + c) = w; } } }
    }
};

__device__ __forceinline__ float dpp_up1(float x) { const int v = __builtin_bit_cast(int, x); return __builtin_bit_cast(float, __builtin_amdgcn_update_dpp(v, v, 0x111, 0xf, 0xf, false)); }
__device__ __forceinline__ float dpp_dn1(float x) { const int v = __builtin_bit_cast(int, x); return __builtin_bit_cast(float, __builtin_amdgcn_update_dpp(v, v, 0x101, 0xf, 0xf, false)); }
struct EpiGluF {
    static constexpr bool PERM = true, AFTER_DRAIN = false;
    const float* ss; float* sg; float* su; const float* cw; const float* cb; bf16_t* act; LAS float* ex;
    __device__ __forceinline__ void operator()(const f32x4 (&acc)[2][2][4][2], const Unit& u, int wr, int wc, int fr, int fq) const {
        const int row0 = u.pm * 256 + wr * 64 + fr; const int chl = wc * 32 + 8 * fq; const int chg = u.pn * 128 + chl;
        float rsm[2][4];
#pragma unroll
        for (int ai = 0; ai < 2; ++ai)
#pragma unroll
            for (int m = 0; m < 4; ++m) rsm[ai][m] = rs_of(ss, row0 + ai * 128 + m * 16);
        if (fr == 0 || fr == 15) {
#pragma unroll
            for (int ai = 0; ai < 2; ++ai)
#pragma unroll
                for (int m = 0; m < 4; ++m) { const int rgi = ai * 8 + wr * 4 + m; LAS float* e = ex + (2 * rgi + (fr == 15 ? 1 : 0)) * 128 + chl;
                    *(LAS f32x4*)e = acc[ai][0][m][0] * rsm[ai][m]; *(LAS f32x4*)(e + 4) = acc[ai][0][m][1] * rsm[ai][m]; } }
        asm volatile("s_waitcnt lgkmcnt(0)" ::: "memory"); __builtin_amdgcn_s_barrier(); asm volatile("" ::: "memory");
        const f32x4 w0a = *(const f32x4*)(cw + chg), w0b = *(const f32x4*)(cw + chg + 4), w1a = *(const f32x4*)(cw + FF + chg), w1b = *(const f32x4*)(cw + FF + chg + 4);
        const f32x4 w2a = *(const f32x4*)(cw + 2 * FF + chg), w2b = *(const f32x4*)(cw + 2 * FF + chg + 4), bba = *(const f32x4*)(cb + chg), bbb = *(const f32x4*)(cb + chg + 4);
#pragma unroll
        for (int ai = 0; ai < 2; ++ai)
#pragma unroll
            for (int m = 0; m < 4; ++m) { const int row = row0 + ai * 128 + m * 16; const int rgi = ai * 8 + wr * 4 + m;

                const float sm = rsm[ai][m]; const float su = dpp_up1(sm), sd = dpp_dn1(sm);
                f32x4 gm0 = acc[ai][0][m][0] * sm, gm1 = acc[ai][0][m][1] * sm, gu0, gu1, gd0, gd1;
#pragma unroll
                for (int j = 0; j < 4; ++j) { gu0[j] = dpp_up1(acc[ai][0][m][0][j]) * su; gu1[j] = dpp_up1(acc[ai][0][m][1][j]) * su;
                    gd0[j] = dpp_dn1(acc[ai][0][m][0][j]) * sd; gd1[j] = dpp_dn1(acc[ai][0][m][1][j]) * sd; }
                if (fr == 0) {
                    if (rgi > 0) { const LAS float* e = ex + (2 * (rgi - 1) + 1) * 128 + chl; gu0 = *(const LAS f32x4*)e; gu1 = *(const LAS f32x4*)(e + 4); } }
                if (fr == 15) {
                    if (rgi < 15) { const LAS float* e = ex + (2 * (rgi + 1)) * 128 + chl; gd0 = *(const LAS f32x4*)e; gd1 = *(const LAS f32x4*)(e + 4); } }
                const f32x4 ga = w0a * gu0 + w1a * gm0 + w2a * gd0 + bba, gb = w0b * gu1 + w1b * gm1 + w2b * gd1 + bbb;
                const f32x4 a0 = acc[ai][1][m][0] * sm, a1 = acc[ai][1][m][1] * sm;
                u32x4 w; w.x = pk2(gelu_t(ga[0]) * a0[0], gelu_t(ga[1]) * a0[1]); w.y = pk2(gelu_t(ga[2]) * a0[2], gelu_t(ga[3]) * a0[3]);
                w.z = pk2(gelu_t(gb[0]) * a1[0], gelu_t(gb[1]) * a1[1]); w.w = pk2(gelu_t(gb[2]) * a1[2], gelu_t(gb[3]) * a1[3]);
                const bool first = (rgi == 0 && fr == 0), last = (rgi == 15 && fr == 15);
                if (!(first || last)) *(u32x4*)(act + (size_t)row * FF + chg) = w;
                if (rgi == 0 && fr <= 1) { float* d = sg + ((size_t)u.pm * 4 + fr) * FF + chg; *(f32x4*)d = gm0; *(f32x4*)(d + 4) = gm1; }
                if (rgi == 15 && fr >= 14) { float* d = sg + ((size_t)u.pm * 4 + (fr - 12)) * FF + chg; *(f32x4*)d = gm0; *(f32x4*)(d + 4) = gm1; }
                if (first || last) { float* d = this->su + ((size_t)u.pm * 2 + (last ? 1 : 0)) * FF + chg; *(f32x4*)d = a0; *(f32x4*)(d + 4) = a1; } }
    }
};

struct Params { const float* in[28]; float* out; unsigned char* ws; };
typedef LAS unsigned* PT;
__device__ __forceinline__ const float* pin(PT t0, int k) { unsigned ta = (unsigned)(size_t)t0; asm volatile("" : "+s"(ta)); const PT t = (PT)(size_t)ta;
    const unsigned lo = __builtin_amdgcn_readfirstlane(t[2 * k]), hi = __builtin_amdgcn_readfirstlane(t[2 * k + 1]); return (const float*)(__attribute__((address_space(1))) const float*)(((unsigned long long)hi << 32) | lo); }
__device__ __forceinline__ float* pout(PT t) { return (float*)pin(t, 28); }
__device__ __forceinline__ unsigned char* pws(PT t) { return (unsigned char*)pin(t, 29); }
enum { I_X = 0, I_P, I_N1G, I_WIN, I_DNCW, I_ALOG, I_DTB, I_DNG, I_LCW, I_LCB, I_LWA, I_LBA, I_LWX, I_LBX, I_LAM, I_LNG, I_WOUT, I_N2G, I_FWG, I_FWU, I_FCW, I_FCB, I_FWD, I_PNG, I_PWG, I_PBG, I_PWP, I_FING };

template <class RM>
__device__ __forceinline__ void tr_item(const float* W, int K, int N, bf16_t* WT, int ldt, const float* gk, const RM& rm, LAS float* scr, int item, int lane) {
    const int nblk = (N + 31) >> 5, kb = item / nblk, nb = item % nblk, k0 = 64 * kb, n0 = 32 * nb;
#pragma unroll 8
    for (int i = 0; i < 32; ++i) { const int kk = 2 * i + (lane >> 5), n = n0 + (lane & 31);
        float v = (n < N) ? W[(size_t)(k0 + kk) * N + n] : 0.f; if (gk) v *= gk[k0 + kk];
        scr[kk * 33 + (lane & 31)] = v; }
    LDS_FENCE();
    const int c = lane & 7;
#pragma unroll
    for (int j = 0; j < 4; ++j) { const int nl = (lane >> 3) + 8 * j, n = n0 + nl; const LAS float* s = scr + (8 * c) * 33 + nl;
        u32x4 o; o.x = pk2(s[0 * 33], s[1 * 33]); o.y = pk2(s[2 * 33], s[3 * 33]); o.z = pk2(s[4 * 33], s[5 * 33]); o.w = pk2(s[6 * 33], s[7 * 33]);
        const int dst = (n < N) ? rm(n) : -1;
        if (dst >= 0) *(u32x4*)(WT + (size_t)dst * ldt + k0 + 8 * c) = o; }
    LDS_FENCE();
}
struct RmId { __device__ __forceinline__ int operator()(int n) const { return n; } };
struct RmGU { int off; __device__ __forceinline__ int operator()(int n) const { return (n >> 7) * 256 + off + (n & 127); } };
struct RmIn { __device__ __forceinline__ int operator()(int n) const {
    if (n < 1536) return n;
    if (n < 2048) return 2048 + (n - 1536);
    if (n < 2064) return 3072 + (n - 2048);
    if (n < 2576) return 1536 + (n - 2064);
    return 2560 + (n - 2576);
} };

__device__ __forceinline__ void prologue(PT pt, LAS unsigned char* lds, int gw, int NGW, int lane, int wave) {
    asm volatile("" : "+v"(lane));
    unsigned char* ws = pws(pt);
    for (int l = 0; l < NL; ++l) { u32x4* z = (u32x4*)((bf16_t*)(ws + WS_WIN) + ((size_t)l * 3328 + 3088) * 1024); const int n4 = 240 * 1024 / 8;
        for (int i = gw * 64 + lane; i < n4; i += NGW * 64) z[i] = (u32x4){0u, 0u, 0u, 0u}; }
    LAS float* scr = (LAS float*)(lds + wave * 16384);
    constexpr int I_IN = 16 * 97, I_OUT = 16 * 32, I_G = 16 * 88, I_D = 44 * 32, I_PG = 16 * 32, I_PP = 4 * 32, I_LA = 32;
    constexpr int PER_L = I_IN + I_OUT + 2 * I_G + I_D + I_PG + I_PP + 2 * I_LA;
    for (int it = gw; it < NL * PER_L; it += NGW) {
        const int l = it / PER_L; int r = it % PER_L;
        if (r < I_IN) { tr_item(pin(pt, I_WIN) + (size_t)l * DM * INC, DM, INC, (bf16_t*)(ws + WS_WIN) + (size_t)l * 3328 * 1024, 1024, pin(pt, I_N1G) + l * DM, RmIn(), scr, r, lane); continue; } r -= I_IN;
        if (r < I_OUT) { tr_item(pin(pt, I_WOUT) + (size_t)l * DM * DM, DM, DM, (bf16_t*)(ws + WS_WOUT) + (size_t)l * DM * DM, 1024, nullptr, RmId(), scr, r, lane); continue; } r -= I_OUT;
        if (r < I_G) { tr_item(pin(pt, I_FWG) + (size_t)l * DM * FF, DM, FF, (bf16_t*)(ws + WS_WG) + (size_t)l * 5632 * 1024, 1024, pin(pt, I_N2G) + l * DM, RmGU{0}, scr, r, lane); continue; } r -= I_G;
        if (r < I_G) { tr_item(pin(pt, I_FWU) + (size_t)l * DM * FF, DM, FF, (bf16_t*)(ws + WS_WG) + (size_t)l * 5632 * 1024, 1024, pin(pt, I_N2G) + l * DM, RmGU{128}, scr, r, lane); continue; } r -= I_G;
        if (r < I_D) { tr_item(pin(pt, I_FWD) + (size_t)l * FF * DM, FF, DM, (bf16_t*)(ws + WS_WD) + (size_t)l * DM * FF, FF, nullptr, RmId(), scr, r, lane); continue; } r -= I_D;
        if (r < I_PG) { tr_item(pin(pt, I_PWG) + (size_t)l * DM * DM, DM, DM, (bf16_t*)(ws + WS_WPG) + (size_t)l * DM * DM, 1024, pin(pt, I_PNG) + l * DM, RmId(), scr, r, lane); continue; } r -= I_PG;
        if (r < I_PP) { tr_item(pin(pt, I_PWP) + (size_t)l * PLE * DM, PLE, DM, (bf16_t*)(ws + WS_WP) + (size_t)l * DM * PLE, PLE, nullptr, RmId(), scr, r, lane); continue; } r -= I_PP;
        { const int gate = r / I_LA; r %= I_LA; const int mat = r >> 1, sub = r & 1;
          const float* src = pin(pt, gate ? I_LWX : I_LWA) + ((size_t)l * 16 + mat) * 4096;
          bf16_t* dst = (bf16_t*)(ws + WS_WAT) + (((size_t)l * 16 + mat) * 2 + gate) * 4096;
          tr_item(src, 64, 64, dst, 64, nullptr, RmId(), scr, sub, lane); }
    }
    const float* x = pin(pt, I_X); bf16_t* rb = (bf16_t*)(ws + WS_RB); float* ss0 = (float*)(ws + WS_SSP); unsigned char* rl = (unsigned char*)pout(pt) + (size_t)128 * MiB;
    for (int m = gw; m < M_TOK; m += NGW) { const f32x4* xr = (const f32x4*)(x + (size_t)m * DM) + lane; u32x2* o = (u32x2*)(rb + (size_t)m * DM) + lane; unsigned* ol = (unsigned*)(rl + (size_t)m * DM) + lane; float s = 0.f;
#pragma unroll
        for (int j = 0; j < 4; ++j) { const f32x4 v = xr[64 * j]; s += (v[0] * v[0] + v[1] * v[1]) + (v[2] * v[2] + v[3] * v[3]); const u32x2 hw = pk4(v); o[64 * j] = hw;
            ol[64 * j] = pk4_fp8(v[0] - bflo(hw.x), v[1] - bfhi(hw.x), v[2] - bflo(hw.y), v[3] - bfhi(hw.y)); }
#pragma unroll
        for (int o2 = 1; o2 < 64; o2 <<= 1) s += __shfl_xor(s, o2);
        if (lane < 4) ss0[(size_t)m * 4 + lane] = lane == 0 ? s : 0.f; }
}

__device__ __forceinline__ void lru_block(PT pt, LAS unsigned char* lds, int bi, int layer, int tid) {
    asm volatile("" : "+v"(tid));
    const int lane = tid & 63, w = tid >> 6;
    unsigned char* ws = pws(pt);
    const int wi = bi * 8 + w;
    const int dq = wi & 3, n = (wi >> 2) & 7, dir = (wi >> 5) & 1, b = wi >> 6;
    const int fr = lane & 15, fq = lane >> 4;
    LAS unsigned char* XCB = lds + (w >> 2) * 8192;
    LAS unsigned char* SCN = lds + 16384 + w * 1024;
    const int ti = lane >> 2, cq = lane & 3;
    const int cch = 64 * n + 16 * dq + 4 * cq;
    f32x4 cw4[4];
#pragma unroll
    for (int tap = 0; tap < 4; ++tap) cw4[tap] = *(const f32x4*)(pin(pt, I_LCW) + ((size_t)layer * 4 + tap) * 512 + cch);
    const f32x4 cb4 = *(const f32x4*)(pin(pt, I_LCB) + (size_t)layer * 512 + cch);
    const bf16_t* wbase = (const bf16_t*)(ws + WS_WAT) + ((((size_t)layer * 2 + dir) * 8 + n) * 2) * 4096;
    bf16x8 Ba[2], Bx[2];
#pragma unroll
    for (int ks = 0; ks < 2; ++ks) { Ba[ks] = *(const bf16x8*)(wbase + (16 * dq + fr) * 64 + 32 * ks + 8 * fq); Bx[ks] = *(const bf16x8*)(wbase + 4096 + (16 * dq + fr) * 64 + 32 * ks + 8 * fq); }
    const int dch = 64 * n + 16 * dq + fr; const size_t pidx = ((size_t)layer * 2 + dir) * 512 + dch;
    const float ba = pin(pt, I_LBA)[pidx], bx = pin(pt, I_LBX)[pidx], sp8 = 8.0f * 1.4426950408889634f * softplus_f(-pin(pt, I_LAM)[pidx]);
    const bf16_t* plx = (const bf16_t*)(ws + WS_PLX) + (size_t)b * SEQ * 512 + cch;
    bf16_t* hout = (bf16_t*)pout(pt) + (size_t)dir * M_TOK * 512 + (size_t)b * SEQ * 512 + dch;
    u32x2 xr[2][4];
#define LRU_LOAD(scn) do { _Pragma("unroll") for (int s_ = 0; s_ < 2; ++s_) { const int tt_ = dir ? (SEQ - 1 - (32 * (scn) + 16 * s_ + ti)) : (32 * (scn) + 16 * s_ + ti); \
        _Pragma("unroll") for (int tap = 0; tap < 4; ++tap) { const int t2_ = tt_ + tap - 2; xr[s_][tap] = (u32x2){0u, 0u}; if (t2_ >= 0 && t2_ < SEQ) xr[s_][tap] = *(const u32x2*)(plx + (size_t)t2_ * 512); } } } while (0)
    LRU_LOAD(0);
    float hprev = 0.f;
    LBAR();
#pragma unroll 1
    for (int sc = 0; sc < 64; ++sc) {
        LAS unsigned char* XC = XCB + (sc & 1) * 4096;
#pragma unroll
        for (int s2 = 0; s2 < 2; ++s2) { f32x4 xa = cb4;
#pragma unroll
            for (int tap = 0; tap < 4; ++tap) { xa[0] += cw4[tap][0] * bflo(xr[s2][tap].x); xa[1] += cw4[tap][1] * bfhi(xr[s2][tap].x); xa[2] += cw4[tap][2] * bflo(xr[s2][tap].y); xa[3] += cw4[tap][3] * bfhi(xr[s2][tap].y); }
            *(LAS u32x2*)(XC + swz64(16 * s2 + ti, 16 * dq + 4 * cq)) = pk4(xa); }
        if (sc + 1 < 64) LRU_LOAD(sc + 1);
        LBAR();
        float Ac[2][4], Hc[2][4];
#pragma unroll
        for (int s2 = 0; s2 < 2; ++s2) {
            const bf16x8 A0 = *(const LAS bf16x8*)(XC + swz64(16 * s2 + fr, 8 * fq)), A1 = *(const LAS bf16x8*)(XC + swz64(16 * s2 + fr, 32 + 8 * fq));
            f32x4 ca = {0.f, 0.f, 0.f, 0.f}, cx = {0.f, 0.f, 0.f, 0.f};
            ca = MFMA16(A0, Ba[0], ca); ca = MFMA16(A1, Ba[1], ca); cx = MFMA16(A0, Bx[0], cx); cx = MFMA16(A1, Bx[1], cx);
#pragma unroll
            for (int jj = 0; jj < 4; ++jj) { const float xv = bf2f(*(const LAS unsigned short*)(XC + swz64(16 * s2 + 4 * fq + jj, 16 * dq + fr)));
                const float r = sigm(ca[jj] + ba), ig = sigm(cx[jj] + bx), a = __builtin_amdgcn_exp2f(-r * sp8);
                const float bt = __builtin_amdgcn_sqrtf(fmaxf(1.0f - a * a, 0.f)) * ig * xv;
                Hc[s2][jj] = jj ? (a * Hc[s2][jj - 1] + bt) : bt; Ac[s2][jj] = jj ? (a * Ac[s2][jj - 1]) : a; }
            *(LAS f32x2*)(SCN + s2 * 512 + (fq * 16 + fr) * 8) = (f32x2){Ac[s2][3], Hc[s2][3]}; }
#pragma unroll
        for (int s2 = 0; s2 < 2; ++s2) {
            const LAS unsigned char* T = SCN + s2 * 512;
            const f32x2 g0 = *(const LAS f32x2*)(T + (0 * 16 + fr) * 8), g1 = *(const LAS f32x2*)(T + (1 * 16 + fr) * 8), g2 = *(const LAS f32x2*)(T + (2 * 16 + fr) * 8), g3 = *(const LAS f32x2*)(T + (3 * 16 + fr) * 8);
            const float h1 = g0.x * hprev + g0.y, h2 = g1.x * h1 + g1.y, h3 = g2.x * h2 + g2.y, h4 = g3.x * h3 + g3.y;
            const float hin = fq == 0 ? hprev : (fq == 1 ? h1 : (fq == 2 ? h2 : h3));
            hprev = h4;
#pragma unroll
            for (int jj = 0; jj < 4; ++jj) { const float hv = Ac[s2][jj] * hin + Hc[s2][jj]; const int i = 16 * s2 + 4 * fq + jj; const int t2 = dir ? (SEQ - 1 - (32 * sc + i)) : (32 * sc + i);
                hout[(size_t)t2 * 512] = (bf16_t)(pk2(hv, 0.f) & 0xffffu); } }
    }
#undef LRU_LOAD
}

constexpr int DP_BUF0 = 0, DP_BUF1 = 49152, DP_KL = 49152, DP_QL = 49152 + 16384, DP_VL = 49152 + 32768, DP_VEC = 98304, DP_CWL = 99328;
__device__ __forceinline__ void dp_item(PT pt, LAS unsigned char* lds, int item, int layer, int tid, int lane, int w) {
    asm volatile("" : "+v"(tid)); lane = tid & 63; asm volatile("" : "+s"(w));
    unsigned char* ws = pws(pt);
    const int b = item >> 7, h = (item >> 5) & 3, n = item & 31;
    const size_t rowbase = (size_t)b * SEQ + 64 * n;
    LAS float* VEC = (LAS float*)(lds + DP_VEC);
    LBAR();
    f32x4 gpre = {0.f, 0.f, 0.f, 0.f};
    if (w == 0) { const float* gp = (const float*)(ws + WS_GATES) + (rowbase + lane) * 16 + h; gpre[0] = gp[0]; gpre[1] = gp[4]; gpre[2] = gp[8]; gpre[3] = gp[12]; }
    { const int i = tid >> 3, c = tid & 7; const int t = 64 * n + i; const size_t R = rowbase + i;
      const bf16_t* pq = (const bf16_t*)(ws + WS_PQKV);
      u32x4 xin[3][4][2];
#pragma unroll
      for (int mat = 0; mat < 3; ++mat)
#pragma unroll
          for (int tap = 0; tap < 4; ++tap) { const int t2 = t + tap - 2; xin[mat][tap][0] = (u32x4){0u, 0u, 0u, 0u}; xin[mat][tap][1] = (u32x4){0u, 0u, 0u, 0u};
              if (t2 >= 0 && t2 < SEQ) { const bf16_t* xp = pq + (R + tap - 2) * 1536 + mat * 512 + h * 128 + 16 * c; xin[mat][tap][0] = *(const u32x4*)xp; xin[mat][tap][1] = *(const u32x4*)(xp + 8); } }
#pragma unroll
      for (int mat = 0; mat < 3; ++mat) {
          f32x4 a[4] = {{0.f, 0.f, 0.f, 0.f}, {0.f, 0.f, 0.f, 0.f}, {0.f, 0.f, 0.f, 0.f}, {0.f, 0.f, 0.f, 0.f}};
#pragma unroll
          for (int tap = 0; tap < 4; ++tap) { const u32x4 x0 = xin[mat][tap][0], x1 = xin[mat][tap][1];
              const LAS float* wp = (const LAS float*)(lds + DP_CWL) + (mat * 4 + tap) * 128 + 16 * c; const f32x4 w0 = *(const LAS f32x4*)wp, w1 = *(const LAS f32x4*)(wp + 4), w2 = *(const LAS f32x4*)(wp + 8), w3 = *(const LAS f32x4*)(wp + 12);
              a[0][0] += w0[0] * bflo(x0.x); a[0][1] += w0[1] * bfhi(x0.x); a[0][2] += w0[2] * bflo(x0.y); a[0][3] += w0[3] * bfhi(x0.y);
              a[1][0] += w1[0] * bflo(x0.z); a[1][1] += w1[1] * bfhi(x0.z); a[1][2] += w1[2] * bflo(x0.w); a[1][3] += w1[3] * bfhi(x0.w);
              a[2][0] += w2[0] * bflo(x1.x); a[2][1] += w2[1] * bfhi(x1.x); a[2][2] += w2[2] * bflo(x1.y); a[2][3] += w2[3] * bfhi(x1.y);
              a[3][0] += w3[0] * bflo(x1.z); a[3][1] += w3[1] * bfhi(x1.z); a[3][2] += w3[2] * bflo(x1.w); a[3][3] += w3[3] * bfhi(x1.w); }
          float ssq = 0.f;
#pragma unroll
          for (int q = 0; q < 4; ++q)
#pragma unroll
              for (int e = 0; e < 4; ++e) { const float v = a[q][e]; const float sv = v * sigm(v); a[q][e] = sv; ssq += sv * sv; }
          float scale = 1.f;
          if (mat < 2) { ssq += __shfl_xor(ssq, 1); ssq += __shfl_xor(ssq, 2); ssq += __shfl_xor(ssq, 4); scale = rsqrtf(ssq + EPS); if (mat == 0) scale *= 0.08838834764831845f; }
          u32x4 o0, o1; o0.x = pk2(a[0][0] * scale, a[0][1] * scale); o0.y = pk2(a[0][2] * scale, a[0][3] * scale); o0.z = pk2(a[1][0] * scale, a[1][1] * scale); o0.w = pk2(a[1][2] * scale, a[1][3] * scale);
          o1.x = pk2(a[2][0] * scale, a[2][1] * scale); o1.y = pk2(a[2][2] * scale, a[2][3] * scale); o1.z = pk2(a[3][0] * scale, a[3][1] * scale); o1.w = pk2(a[3][2] * scale, a[3][3] * scale);
          const int lbase = (mat == 0) ? DP_QL : (mat == 1 ? DP_KL : DP_VL);
          *(LAS u32x4*)(lds + lbase + swz128(i, 16 * c)) = o0; *(LAS u32x4*)(lds + lbase + swz128(i, 16 * c + 8)) = o1;
          if (mat < 2) { bf16_t* gp = (bf16_t*)(ws + (mat == 0 ? WS_QH : WS_KH)) + R * 512 + h * 128 + 16 * c; *(u32x4*)gp = o0; *(u32x4*)(gp + 8) = o1; } }
    }
    if (w == 0) {
        const float bF = sigm(gpre[0]), bB = sigm(gpre[1]);
        float gF = -expf(pin(pt, I_ALOG)[layer * 8 + h]) * softplus_f(gpre[2] + pin(pt, I_DTB)[layer * 8 + h]);
        float gB = -expf(pin(pt, I_ALOG)[layer * 8 + 4 + h]) * softplus_f(gpre[3] + pin(pt, I_DTB)[layer * 8 + 4 + h]);
#pragma unroll
        for (int off = 1; off < 64; off <<= 1) { const float v = __shfl_up(gF, off); if (lane >= off) gF += v; const float u = __shfl_down(gB, off); if (lane + off < 64) gB += u; }
        const float glF = __shfl(gF, 63), glB = __shfl(gB, 0);
        VEC[lane] = bF; VEC[64 + lane] = gF; VEC[128 + lane] = bB; VEC[192 + lane] = gB;
        float* v0 = (float*)(ws + WS_VEC) + (size_t)item * 256; float* v1 = v0 + (size_t)4096 * 256;
        v0[lane] = bF; v0[64 + lane] = fexp(gF); v0[128 + lane] = fexp(glF - gF); if (lane == 0) v0[192] = fexp(glF);
        v1[lane] = bB; v1[64 + lane] = fexp(gB); v1[128 + lane] = fexp(glB - gB); if (lane == 0) v1[192] = fexp(glB);
    }
    LBAR();
    { const int e = tid >> 2, jq = tid & 3; unsigned vv[8];
#pragma unroll
      for (int p = 0; p < 8; ++p) { const unsigned lo = *(const LAS unsigned short*)(lds + DP_VL + swz128(16 * jq + 2 * p, e)), hi = *(const LAS unsigned short*)(lds + DP_VL + swz128(16 * jq + 2 * p + 1, e)); vv[p] = lo | (hi << 16); }
      bf16_t* gp = (bf16_t*)(ws + WS_VT) + (size_t)item * 8192 + e * 64 + 16 * jq;
      *(u32x4*)gp = (u32x4){vv[0], vv[1], vv[2], vv[3]}; *(u32x4*)(gp + 8) = (u32x4){vv[4], vv[5], vv[6], vv[7]}; }
    const int r32 = lane & 31, hi = lane >> 5;
    { const int kind = w >> 2, q = w & 3, ta = q >> 1, tb = q & 1;
      f32x16 acc; for (int r = 0; r < 16; ++r) acc[r] = 0.f;
      const int bbase = kind ? DP_QL : DP_KL;
#pragma unroll
      for (int ks = 0; ks < 8; ++ks) { const bf16x8 av = *(const LAS bf16x8*)(lds + DP_KL + swz128(32 * ta + r32, 16 * ks + 8 * hi)), bv = *(const LAS bf16x8*)(lds + bbase + swz128(32 * tb + r32, 16 * ks + 8 * hi)); acc = MFMA32(av, bv, acc); }
      const int gb = 32 * tb + r32;
#pragma unroll
      for (int dir = 0; dir < 2; ++dir) { const LAS float* bet = VEC + dir * 128; const LAS float* gc = VEC + dir * 128 + 64;
          const float gcl = gc[gb], betl = bet[gb];
#pragma unroll
          for (int g = 0; g < 4; ++g) { const int ga0 = 32 * ta + 8 * g + 4 * hi; const f32x4 gca = *(const LAS f32x4*)(gc + ga0), bea = *(const LAS f32x4*)(bet + ga0);
              if (kind == 0) { f32x4 xv, yv, pv;
#pragma unroll
                  for (int jj = 0; jj < 4; ++jj) { const int ga = ga0 + jj; const float kk = acc[4 * g + jj];
                      const bool mx = dir ? (gb < ga) : (gb > ga), my = dir ? (ga < gb) : (ga > gb);
                      const float ed = kk * fexp(-fabsf(gcl - gca[jj]));
                      xv[jj] = mx ? (-betl * ed) : 0.f; yv[jj] = my ? (-bea[jj] * ed) : 0.f; pv[jj] = (ga == gb) ? 1.f : 0.f; }
                  LAS unsigned char* bb = lds + DP_BUF0 + dir * 24576 + swz64(gb, ga0);
                  *(LAS u32x2*)bb = pk4(xv); *(LAS u32x2*)(bb + 8192) = pk4(yv); *(LAS u32x2*)(bb + 16384) = pk4(pv);
              } else { f32x4 av4;
#pragma unroll
                  for (int jj = 0; jj < 4; ++jj) { const int ga = ga0 + jj; const bool ma = dir ? (gb <= ga) : (gb >= ga); av4[jj] = ma ? (acc[4 * g + jj] * fexp(-fabsf(gcl - gca[jj]))) : 0.f; }
                  *(u32x2*)((bf16_t*)(ws + WS_AT) + ((size_t)dir * 4096 + item) * 4096 + gb * 64 + ga0) = pk4(av4); } } }
    }
    LBAR();
    { const int dir = w >> 2, q = w & 3, ti = q >> 1, tj = q & 1;
      f32x16 pacc; for (int r = 0; r < 16; ++r) pacc[r] = (32 * tj + crow(r, hi) == 32 * ti + r32) ? 1.f : 0.f;
#pragma unroll 1
      for (int rd = 0; rd < 6; ++rd) { LAS unsigned char* cur = lds + ((rd & 1) ? DP_BUF1 : DP_BUF0) + dir * 24576; LAS unsigned char* nxt = lds + ((rd & 1) ? DP_BUF0 : DP_BUF1) + dir * 24576;
          bf16x8 xf[4], yf[4], pf[4];
#pragma unroll
          for (int ks = 0; ks < 4; ++ks) { xf[ks] = *(const LAS bf16x8*)(cur + swz64(32 * ti + r32, 16 * ks + 8 * hi)); yf[ks] = *(const LAS bf16x8*)(cur + 8192 + swz64(32 * tj + r32, 16 * ks + 8 * hi)); pf[ks] = *(const LAS bf16x8*)(cur + 16384 + swz64(32 * ti + r32, 16 * ks + 8 * hi)); }
#pragma unroll
          for (int ks = 0; ks < 4; ++ks) pacc = MFMA32(yf[ks], pf[ks], pacc);
          if (rd < 5) { f32x16 xa, ya; for (int r = 0; r < 16; ++r) { xa[r] = 0.f; ya[r] = 0.f; }
#pragma unroll
              for (int ks = 0; ks < 4; ++ks) { xa = MFMA32(yf[ks], xf[ks], xa); ya = MFMA32(xf[ks], yf[ks], ya); }
#pragma unroll
              for (int g = 0; g < 4; ++g) { const int c0 = 8 * g + 4 * hi;
                  *(LAS u32x2*)(nxt + swz64(32 * ti + r32, 32 * tj + c0)) = pk4((f32x4){xa[4 * g], xa[4 * g + 1], xa[4 * g + 2], xa[4 * g + 3]});
                  *(LAS u32x2*)(nxt + 8192 + swz64(32 * tj + r32, 32 * ti + c0)) = pk4((f32x4){ya[4 * g], ya[4 * g + 1], ya[4 * g + 2], ya[4 * g + 3]});
                  *(LAS u32x2*)(nxt + 16384 + swz64(32 * ti + r32, 32 * tj + c0)) = pk4((f32x4){pacc[4 * g], pacc[4 * g + 1], pacc[4 * g + 2], pacc[4 * g + 3]}); }
              LBAR(); } }
      bf16_t* tg = (bf16_t*)(ws + WS_TM) + ((size_t)dir * 4096 + item) * 4096 + (32 * ti + r32) * 64 + 32 * tj + 4 * hi;
#pragma unroll
      for (int g = 0; g < 4; ++g) *(u32x2*)(tg + 8 * g) = pk4((f32x4){pacc[4 * g], pacc[4 * g + 1], pacc[4 * g + 2], pacc[4 * g + 3]});
    }
}

constexpr int DR_K = 0, DR_Q = 16384, DR_KT = 32768, DR_VT = 49152, DR_T = 65536, DR_A = 73728, DR_VEC = 81920, DR_PRIV = 83968;
__device__ __forceinline__ void dr_item(PT pt, LAS unsigned char* lds, int item, int tid, int lane, int w) {
    asm volatile("" : "+v"(tid)); lane = tid & 63; asm volatile("" : "+s"(w));
    unsigned char* ws = pws(pt);
    const int dir = item & 1, h = (item >> 1) & 3, b = item >> 3;
    const int fr = lane & 15, fq = lane >> 4, es = 16 * w;
    LAS unsigned char* ST = lds + DR_PRIV + w * 8192; LAS unsigned char* RV = ST + 4096; LAS unsigned char* VN2 = ST + 6144;
    const LAS float* VEC = (const LAS float*)(lds + DR_VEC);
    const bf16_t* kh = (const bf16_t*)(ws + WS_KH) + (size_t)b * SEQ * 512 + h * 128;
    const bf16_t* qh = (const bf16_t*)(ws + WS_QH) + (size_t)b * SEQ * 512 + h * 128;
    const int ibase = (b * 4 + h) * 32;
    const bf16_t* vt = (const bf16_t*)(ws + WS_VT) + (size_t)ibase * 8192;
    const bf16_t* tm = (const bf16_t*)(ws + WS_TM) + ((size_t)dir * 4096 + ibase) * 4096;
    const bf16_t* at = (const bf16_t*)(ws + WS_AT) + ((size_t)dir * 4096 + ibase) * 4096;
    const float* vecs = (const float*)(ws + WS_VEC) + ((size_t)dir * 4096 + ibase) * 256;
    bf16_t* og = (bf16_t*)(ws + (dir ? WS_OB : WS_OF)) + (size_t)b * SEQ * 512 + h * 128 + es + fr;
    u32x4 pk[2], pq[2], pv[2], ptm, pa; f32x4 pvec = {0.f, 0.f, 0.f, 0.f};
#define DR_LOAD(nn) do { _Pragma("unroll") for (int u_ = 0; u_ < 2; ++u_) { const int p_ = tid + 512 * u_; \
        pk[u_] = *(const u32x4*)(kh + (size_t)(64 * (nn) + (p_ >> 4)) * 512 + 8 * (p_ & 15)); pq[u_] = *(const u32x4*)(qh + (size_t)(64 * (nn) + (p_ >> 4)) * 512 + 8 * (p_ & 15)); \
        pv[u_] = *(const u32x4*)(vt + (size_t)(nn) * 8192 + p_ * 8); } \
        ptm = *(const u32x4*)(tm + (size_t)(nn) * 4096 + tid * 8); pa = *(const u32x4*)(at + (size_t)(nn) * 4096 + tid * 8); \
        if (tid < 64) pvec = *(const f32x4*)(vecs + (size_t)(nn) * 256 + 4 * tid); } while (0)
#define DR_STORE() do { _Pragma("unroll") for (int u_ = 0; u_ < 2; ++u_) { const int p_ = tid + 512 * u_; const int j_ = p_ >> 4, q_ = p_ & 15; \
        *(LAS u32x4*)(lds + DR_K + swz128(j_, 8 * q_)) = pk[u_]; *(LAS u32x4*)(lds + DR_Q + swz128(j_, 8 * q_)) = pq[u_]; \
        *(LAS unsigned short*)(lds + DR_KT + swz64(8 * q_ + 0, j_)) = (unsigned short)(pk[u_].x & 0xffffu); *(LAS unsigned short*)(lds + DR_KT + swz64(8 * q_ + 1, j_)) = (unsigned short)(pk[u_].x >> 16); \
        *(LAS unsigned short*)(lds + DR_KT + swz64(8 * q_ + 2, j_)) = (unsigned short)(pk[u_].y & 0xffffu); *(LAS unsigned short*)(lds + DR_KT + swz64(8 * q_ + 3, j_)) = (unsigned short)(pk[u_].y >> 16); \
        *(LAS unsigned short*)(lds + DR_KT + swz64(8 * q_ + 4, j_)) = (unsigned short)(pk[u_].z & 0xffffu); *(LAS unsigned short*)(lds + DR_KT + swz64(8 * q_ + 5, j_)) = (unsigned short)(pk[u_].z >> 16); \
        *(LAS unsigned short*)(lds + DR_KT + swz64(8 * q_ + 6, j_)) = (unsigned short)(pk[u_].w & 0xffffu); *(LAS unsigned short*)(lds + DR_KT + swz64(8 * q_ + 7, j_)) = (unsigned short)(pk[u_].w >> 16); \
        *(LAS u32x4*)(lds + DR_VT + swz64(p_ >> 3, 8 * (p_ & 7))) = pv[u_]; } \
        *(LAS u32x4*)(lds + DR_T + swz64(tid >> 3, 8 * (tid & 7))) = ptm; *(LAS u32x4*)(lds + DR_A + swz64(tid >> 3, 8 * (tid & 7))) = pa; \
        if (tid < 64) *(LAS f32x4*)(lds + DR_VEC + 16 * tid) = pvec; } while (0)
    LBAR();
    DR_LOAD(dir ? 31 : 0);
    DR_STORE();
#pragma unroll
    for (int q = 0; q < 4; ++q) *(LAS u32x4*)(ST + lane * 64 + q * 16) = (u32x4){0u, 0u, 0u, 0u};
    f32x4 Sacc[8];
#pragma unroll
    for (int d = 0; d < 8; ++d) Sacc[d] = (f32x4){0.f, 0.f, 0.f, 0.f};
    LBAR();
#pragma unroll 1
    for (int cc = 0; cc < 32; ++cc) { const int n = dir ? (31 - cc) : cc;
        if (cc + 1 < 32) DR_LOAD(dir ? (30 - cc) : (cc + 1));
        bf16x8 sb[4];
#pragma unroll
        for (int ks = 0; ks < 4; ++ks) sb[ks] = *(const LAS bf16x8*)(ST + swz128(fr, 32 * ks + 8 * fq));
        f32x4 oacc[4];
#pragma unroll
        for (int it = 0; it < 4; ++it) { f32x4 ka = {0.f, 0.f, 0.f, 0.f}, qa = {0.f, 0.f, 0.f, 0.f};
#pragma unroll
            for (int ks = 0; ks < 4; ++ks) { const bf16x8 a1 = *(const LAS bf16x8*)(lds + DR_K + swz128(16 * it + fr, 32 * ks + 8 * fq)), a2 = *(const LAS bf16x8*)(lds + DR_Q + swz128(16 * it + fr, 32 * ks + 8 * fq));
                ka = MFMA16(a1, sb[ks], ka); qa = MFMA16(a2, sb[ks], qa); }
            const int i0 = 16 * it + 4 * fq; const f32x4 be = *(const LAS f32x4*)(VEC + i0), eg = *(const LAS f32x4*)(VEC + 64 + i0);
            const u32x2 vv = *(const LAS u32x2*)(lds + DR_VT + swz64(es + fr, i0));
            f32x4 rh; rh[0] = be[0] * (bflo(vv.x) - eg[0] * ka[0]); rh[1] = be[1] * (bfhi(vv.x) - eg[1] * ka[1]); rh[2] = be[2] * (bflo(vv.y) - eg[2] * ka[2]); rh[3] = be[3] * (bfhi(vv.y) - eg[3] * ka[3]);
            *(LAS u32x2*)(RV + swz64(fr, i0)) = pk4(rh);
            oacc[it] = qa * eg; }
        bf16x8 rb2[2];
#pragma unroll
        for (int ks = 0; ks < 2; ++ks) rb2[ks] = *(const LAS bf16x8*)(RV + swz64(fr, 32 * ks + 8 * fq));
        f32x4 vn[4];
#pragma unroll
        for (int it = 0; it < 4; ++it) { vn[it] = (f32x4){0.f, 0.f, 0.f, 0.f};
#pragma unroll
            for (int ks = 0; ks < 2; ++ks) { const bf16x8 a1 = *(const LAS bf16x8*)(lds + DR_T + swz64(16 * it + fr, 32 * ks + 8 * fq)); vn[it] = MFMA16(a1, rb2[ks], vn[it]); } }
#pragma unroll
        for (int it = 0; it < 4; ++it) { const int i0 = 16 * it + 4 * fq; const f32x4 ed = *(const LAS f32x4*)(VEC + 128 + i0);
            *(LAS u32x2*)(RV + swz64(fr, i0)) = pk4(vn[it]); *(LAS u32x2*)(VN2 + swz64(fr, i0)) = pk4(vn[it] * ed); }
        bf16x8 vb[2], vb2[2];
#pragma unroll
        for (int ks = 0; ks < 2; ++ks) { vb[ks] = *(const LAS bf16x8*)(RV + swz64(fr, 32 * ks + 8 * fq)); vb2[ks] = *(const LAS bf16x8*)(VN2 + swz64(fr, 32 * ks + 8 * fq)); }
#pragma unroll
        for (int it = 0; it < 4; ++it)
#pragma unroll
            for (int ks = 0; ks < 2; ++ks) { const bf16x8 a1 = *(const LAS bf16x8*)(lds + DR_A + swz64(16 * it + fr, 32 * ks + 8 * fq)); oacc[it] = MFMA16(a1, vb[ks], oacc[it]); }
        const float cdec = VEC[192];
#pragma unroll
        for (int dt = 0; dt < 8; ++dt) { Sacc[dt] = Sacc[dt] * cdec;
#pragma unroll
            for (int ks = 0; ks < 2; ++ks) { const bf16x8 a1 = *(const LAS bf16x8*)(lds + DR_KT + swz64(16 * dt + fr, 32 * ks + 8 * fq)); Sacc[dt] = MFMA16(a1, vb2[ks], Sacc[dt]); }
            *(LAS u32x2*)(ST + swz128(fr, 16 * dt + 4 * fq)) = pk4(Sacc[dt]); }
#pragma unroll
        for (int it = 0; it < 4; ++it)
#pragma unroll
            for (int jj = 0; jj < 4; ++jj) og[(size_t)(64 * n + 16 * it + 4 * fq + jj) * 512] = (bf16_t)(pk2(oacc[it][jj], 0.f) & 0xffffu);
        LBAR();
        if (cc + 1 < 32) DR_STORE();
        LBAR();
    }
#undef DR_LOAD
#undef DR_STORE
}

__device__ __forceinline__ void m2_rows(PT pt, int layer, int gw, int NGW, int lane) {
    asm volatile("" : "+v"(lane));
    unsigned char* ws = pws(pt);
    const bf16_t* of = (const bf16_t*)(ws + WS_OF); const bf16_t* ob = (const bf16_t*)(ws + WS_OB); const bf16_t* pz = (const bf16_t*)(ws + WS_PZ);
    const bf16_t* hf = (const bf16_t*)pout(pt); const bf16_t* hb = hf + (size_t)M_TOK * 512; const bf16_t* plg = (const bf16_t*)(ws + WS_PLG);
    bf16_t* amix = (bf16_t*)(ws + WS_AMIX);
    const float* dng = pin(pt, I_DNG) + layer * 128 + 8 * (lane & 15); const float* lng = pin(pt, I_LNG) + layer * 512 + 8 * lane;
    const f32x4 dg0 = *(const f32x4*)dng, dg1 = *(const f32x4*)(dng + 4), lg0 = *(const f32x4*)lng, lg1 = *(const f32x4*)(lng + 4);
    for (int m0 = gw; m0 < M_TOK; m0 += 2 * NGW) {
        u32x4 av[2], bv[2], zv[2], cv[2], dv[2], gv[2];
#pragma unroll
        for (int r = 0; r < 2; ++r) { const int m = m0 + r * NGW; if (m < M_TOK) { const size_t o = (size_t)m * 512 + 8 * lane;
            av[r] = *(const u32x4*)(of + o); bv[r] = *(const u32x4*)(ob + o); zv[r] = *(const u32x4*)(pz + o); cv[r] = *(const u32x4*)(hf + o); dv[r] = *(const u32x4*)(hb + o); gv[r] = *(const u32x4*)(plg + o); } }
#pragma unroll
        for (int r = 0; r < 2; ++r) { const int m = m0 + r * NGW; if (m < M_TOK) {
        const u32x4 a = av[r], b2 = bv[r], z = zv[r], c = cv[r], d = dv[r], g = gv[r];
        float v[8], y[8];
        v[0] = bflo(a.x) + bflo(b2.x); v[1] = bfhi(a.x) + bfhi(b2.x); v[2] = bflo(a.y) + bflo(b2.y); v[3] = bfhi(a.y) + bfhi(b2.y);
        v[4] = bflo(a.z) + bflo(b2.z); v[5] = bfhi(a.z) + bfhi(b2.z); v[6] = bflo(a.w) + bflo(b2.w); v[7] = bfhi(a.w) + bfhi(b2.w);
        float s1 = 0.f;
#pragma unroll
        for (int e = 0; e < 8; ++e) s1 += v[e] * v[e];
        s1 += __shfl_xor(s1, 1); s1 += __shfl_xor(s1, 2); s1 += __shfl_xor(s1, 4); s1 += __shfl_xor(s1, 8);
        const float r1 = rsqrtf(s1 * (1.0f / 128.0f) + EPS);
        float zz[8] = {bflo(z.x), bfhi(z.x), bflo(z.y), bfhi(z.y), bflo(z.z), bfhi(z.z), bflo(z.w), bfhi(z.w)};
        float gg[8] = {bflo(g.x), bfhi(g.x), bflo(g.y), bfhi(g.y), bflo(g.z), bfhi(g.z), bflo(g.w), bfhi(g.w)};
        float hh[8] = {bflo(c.x) + bflo(d.x), bfhi(c.x) + bfhi(d.x), bflo(c.y) + bflo(d.y), bfhi(c.y) + bfhi(d.y), bflo(c.z) + bflo(d.z), bfhi(c.z) + bfhi(d.z), bflo(c.w) + bflo(d.w), bfhi(c.w) + bfhi(d.w)};
        float s2 = 0.f;
#pragma unroll
        for (int e = 0; e < 8; ++e) { const float dgv = e < 4 ? dg0[e & 3] : dg1[e & 3]; v[e] = v[e] * r1 * dgv * (zz[e] * sigm(zz[e])); y[e] = gelu_t(gg[e]) * hh[e]; s2 += y[e] * y[e]; }
#pragma unroll
        for (int o2 = 1; o2 < 64; o2 <<= 1) s2 += __shfl_xor(s2, o2);
        const float r2 = rsqrtf(s2 * (1.0f / 512.0f) + EPS);
#pragma unroll
        for (int e = 0; e < 8; ++e) { const float lgv = e < 4 ? lg0[e & 3] : lg1[e & 3]; y[e] = y[e] * r2 * lgv; }
        u32x4 w1, w2; w1.x = pk2(v[0], v[1]); w1.y = pk2(v[2], v[3]); w1.z = pk2(v[4], v[5]); w1.w = pk2(v[6], v[7]);
        w2.x = pk2(y[0], y[1]); w2.y = pk2(y[2], y[3]); w2.z = pk2(y[4], y[5]); w2.w = pk2(y[6], y[7]);
        *(u32x4*)(amix + (size_t)m * 1024 + 8 * lane) = w1; *(u32x4*)(amix + (size_t)m * 1024 + 512 + 8 * lane) = w2; } }
    }
}

__device__ __forceinline__ void glu_fixup(PT pt, int layer, int bx, int G, int tid) {
    asm volatile("" : "+v"(tid));
    unsigned char* ws = pws(pt);
    const float* sg = (const float*)(ws + WS_G); const float* su = sg + (size_t)256 * 4 * FF; bf16_t* act = (bf16_t*)(ws + WS_ACT);
    const float* cw = pin(pt, I_FCW) + (size_t)layer * 3 * FF; const float* cb = pin(pt, I_FCB) + (size_t)layer * FF;
    for (int e = bx * 512 + tid; e < 512 * (FF / 4); e += G * 512) { const int edge = e / (FF / 4), ch = (e % (FF / 4)) * 4; const int pm = edge >> 1, side = edge & 1;
        const int row = 256 * pm + (side ? 255 : 0); const int t = row & (SEQ - 1);
        const f32x4 gmid = *(const f32x4*)(sg + ((size_t)pm * 4 + (side ? 3 : 0)) * FF + ch);
        f32x4 gup = {0.f, 0.f, 0.f, 0.f}, gdn = {0.f, 0.f, 0.f, 0.f};
        if (side == 0) { gdn = *(const f32x4*)(sg + ((size_t)pm * 4 + 1) * FF + ch); if (t != 0) gup = *(const f32x4*)(sg + ((size_t)(pm - 1) * 4 + 3) * FF + ch); }
        else { gup = *(const f32x4*)(sg + ((size_t)pm * 4 + 2) * FF + ch); if (t != SEQ - 1) gdn = *(const f32x4*)(sg + ((size_t)(pm + 1) * 4 + 0) * FF + ch); }
        const f32x4 uu = *(const f32x4*)(su + ((size_t)pm * 2 + side) * FF + ch);
        const f32x4 w0 = *(const f32x4*)(cw + ch), w1 = *(const f32x4*)(cw + FF + ch), w2 = *(const f32x4*)(cw + 2 * FF + ch), bb = *(const f32x4*)(cb + ch);
        const f32x4 ga = w0 * gup + w1 * gmid + w2 * gdn + bb;
        u32x2 o; o.x = pk2(gelu_t(ga[0]) * uu[0], gelu_t(ga[1]) * uu[1]); o.y = pk2(gelu_t(ga[2]) * uu[2], gelu_t(ga[3]) * uu[3]);
        *(u32x2*)(act + (size_t)row * FF + ch) = o; }
}

#define XB_TMO      128
#define XB_XCNT(j)  (256  + 64 * (j))
#define XB_XSUB(j)  (1280 + 64 * (j))
#define XB_XGEN(j)  (2304 + 64 * (j))
#define XB_TOP      3328
#define XB_TOPGEN   3392
#define XCD_BAR_WORDS 3456
#define XB_SPIN_CAP (1u << 18)

__device__ __forceinline__ unsigned xb_ld(unsigned* p)              { return __hip_atomic_load(p, __ATOMIC_RELAXED, __HIP_MEMORY_SCOPE_AGENT); }
__device__ __forceinline__ unsigned xb_add(unsigned* p, unsigned v) { return __hip_atomic_fetch_add(p, v, __ATOMIC_RELAXED, __HIP_MEMORY_SCOPE_AGENT); }
__device__ __forceinline__ unsigned xb_xcc_id() { return (unsigned)__builtin_amdgcn_s_getreg((3 << 11) | 20) & 0xFu; }
#define XB_SPIN(cond, bar) do { unsigned _sp = 0; while (cond) { __builtin_amdgcn_s_sleep(1); \
    if ((++_sp & 255u) == 0u) { if (xb_ld(&(bar)[XB_TMO])) break; if (_sp > XB_SPIN_CAP) { atomicAdd(&(bar)[XB_TMO], 1u); break; } } } } while (0)

struct XcdBarrier {
    unsigned* bar; unsigned x;
    volatile LAS unsigned* st;
};

__device__ __forceinline__ XcdBarrier xcd_barrier_post(unsigned* bar, volatile LAS unsigned* st) {
    XcdBarrier b; b.bar = bar; b.x = xb_xcc_id(); b.st = st;
    if (threadIdx.x == 0) (void)xb_add(&bar[XB_XCNT(b.x)], 1u);
    return b;
}
__device__ __forceinline__ void xcd_barrier_complete(unsigned* bar, unsigned x, unsigned& nloc, unsigned& nx) {
    const unsigned G = gridDim.x * gridDim.y * gridDim.z;
    unsigned sum, cnt, mine, sp = 0u;
    for (;;) {
        sum = 0u; cnt = 0u; mine = 0u;
#pragma unroll
        for (unsigned j = 0; j < 16; ++j) { const unsigned c = xb_ld(&bar[XB_XCNT(j)]); sum += c; cnt += (c > 0u) ? 1u : 0u; mine = (j == x) ? c : mine; }
        if (sum == G) break;
        __builtin_amdgcn_s_sleep(1);
        if ((++sp & 255u) == 0u) { if (xb_ld(&bar[XB_TMO])) break; if (sp > XB_SPIN_CAP) { atomicAdd(&bar[XB_TMO], 1u); break; } }
    }
    nloc = mine > 0u ? mine : 1u; nx = cnt > 0u ? cnt : 1u;
}

__device__ __forceinline__ void xcd_barrier(const XcdBarrier& b) {
    asm volatile("s_waitcnt vmcnt(0)" ::: "memory");
    __syncthreads();
    if (threadIdx.x == 0) {
        unsigned* bar = b.bar;
        __builtin_amdgcn_s_waitcnt(0);
        unsigned nloc = b.st[0], nx = b.st[1];
        if (nloc == 0u) { xcd_barrier_complete(bar, b.x, nloc, nx); b.st[0] = nloc; b.st[1] = nx; }
        const unsigned old = xb_add(&bar[XB_XSUB(b.x)], 1u);
        const unsigned gen = old / nloc;
        if (old + 1u == (gen + 1u) * nloc) {
            __builtin_amdgcn_fence(__ATOMIC_RELEASE, "agent");
            asm volatile("s_waitcnt vmcnt(0)" ::: "memory");
            const unsigned og = xb_add(&bar[XB_TOP], 1u);
            const unsigned tg = og / nx;
            if (og + 1u == (tg + 1u) * nx) xb_add(&bar[XB_TOPGEN], 1u);
            else XB_SPIN(xb_ld(&bar[XB_TOPGEN]) == tg, bar);
            __builtin_amdgcn_fence(__ATOMIC_ACQUIRE, "agent");
            xb_add(&bar[XB_XGEN(b.x)], 1u);
            asm volatile("s_waitcnt vmcnt(0)" ::: "memory");
        } else {
            XB_SPIN(xb_ld(&bar[XB_XGEN(b.x)]) == gen, bar);
            __builtin_amdgcn_fence(__ATOMIC_ACQUIRE, "agent");
            asm volatile("s_waitcnt vmcnt(0)" ::: "memory");
        }
    }
    __syncthreads();
}

#ifndef PHMASK
#define PHMASK 0xFFFF
#endif
#ifndef DUPMASK
#define DUPMASK 0
#endif
#define PH(k) _Pragma("unroll 1") for (int rep_ = 0; rep_ < ((((PHMASK >> (k)) & 1) ? 1 : 0) + (((DUPMASK >> (k)) & 1) ? 1 : 0)); ++rep_)
#define GRID_BAR() do { XcdBarrier b_; b_.bar = (unsigned*)pws(pt); b_.x = xb_xcc_id(); b_.st = (volatile LAS unsigned*)(lds + LDS_BYTES - 512); xcd_barrier(b_); } while (0)
#ifndef TMASK
#define TMASK 0
#endif
#define TS_BEGIN(k) do { if (((TMASK >> (k)) & 1) && bx == 0 && tid == 0) { const unsigned long long t_ = __builtin_amdgcn_s_memrealtime(); *(volatile LAS unsigned*)(lds + LDS_BYTES - 128) = (unsigned)t_; } } while (0)
#define TS_END(k) do { if (((TMASK >> (k)) & 1) && bx == 0 && tid == 0) { const unsigned t_ = (unsigned)__builtin_amdgcn_s_memrealtime(); volatile LAS unsigned* a_ = (volatile LAS unsigned*)(lds + LDS_BYTES - 128); a_[1] += t_ - a_[0]; } } while (0)
#ifndef STAG
#define STAG 0
#endif
#define STAGGER(step_10ns) do { if (STAG) { const unsigned sg_ = ((unsigned)bx >> 3) & 1u; if (sg_) { const unsigned long long t0_ = __builtin_amdgcn_s_memrealtime(); \
        while (__builtin_amdgcn_s_memrealtime() - t0_ < (unsigned long long)(sg_ * (step_10ns))) __builtin_amdgcn_s_sleep(16); } __syncthreads(); } } while (0)
#define RB_ ((bf16_t*)(pws(pt) + WS_RB))
#define RLO_ ((unsigned char*)pout(pt) + (size_t)128 * MiB)
#define RLOF_ ((unsigned char*)(pws(pt) + WS_RLO))
#define RBC_ ((bf16_t*)(pws(pt) + WS_BIG + 128 * MiB))
#define SS_(k) ((float*)(pws(pt) + WS_SSP) + (size_t)(k) * M_TOK * 4)
__global__ void __launch_bounds__(512, 2) fwd_kernel(Params P) {
    extern __shared__ __attribute__((aligned(16))) unsigned char lds_raw[];
    LAS unsigned char* lds = (LAS unsigned char*)lds_raw;
    cg::grid_group grid = cg::this_grid();
    const int tid = threadIdx.x, lane = tid & 63, wave = __builtin_amdgcn_readfirstlane(tid >> 6);
    const int G = gridDim.x, bx = blockIdx.x; const int gw = bx * 8 + wave, NGW = G * 8;
    PT pt = (PT)(lds + LDS_BYTES - 256);
    volatile LAS unsigned* xst = (volatile LAS unsigned*)(lds + LDS_BYTES - 512);
    if (tid == 0) { xst[0] = 0u; xst[1] = 0u; if (TMASK) { ((volatile LAS unsigned*)(lds + LDS_BYTES - 128))[1] = 0u; }
#pragma unroll
        for (int i = 0; i < 28; ++i) { const unsigned long long v = (unsigned long long)P.in[i]; pt[2 * i] = (unsigned)v; pt[2 * i + 1] = (unsigned)(v >> 32); }
        { const unsigned long long v = (unsigned long long)P.out; pt[56] = (unsigned)v; pt[57] = (unsigned)(v >> 32); }
        { const unsigned long long v = (unsigned long long)P.ws; pt[58] = (unsigned)v; pt[59] = (unsigned)(v >> 32); }
    }
    __syncthreads();
    (void)xcd_barrier_post((unsigned*)P.ws, xst);

    TS_BEGIN(0);
    PH(0) prologue(pt, lds, gw, NGW, lane, wave);
    __syncthreads();
    grid.sync(); TS_END(0);

#pragma unroll 1
    for (int layer = 0; layer < NL; ++layer) {
        TS_BEGIN(1); PH(1) { pg8::Gemm g{RB_, (const bf16_t*)(pws(pt) + WS_WIN) + (size_t)layer * 3328 * 1024, M_TOK, 3328, 1024}; pg8::StaticOrder S; S.init(M_TOK, 3328, G, bx);
          EpiStore E{SS_(3 * layer), {(bf16_t*)(pws(pt) + WS_PQKV), (bf16_t*)(pws(pt) + WS_PLX), (bf16_t*)(pws(pt) + WS_PZ), (bf16_t*)(pws(pt) + WS_PLG)}, {1536, 512, 512, 512}, {0, 6, 8, 10}, (float*)(pws(pt) + WS_GATES), 12};
          pg8::gemm_phase<EpiStore, pg8::StaticOrder, true, true>(lds, g, S, E);
          int tl = tid; asm volatile("" : "+v"(tl));
          const f32x4* ps = (const f32x4*)(pin(pt, I_P) + (size_t)layer * M_TOK * PLE); u32x2* pd = (u32x2*)(pws(pt) + WS_PB);
          for (size_t i = (size_t)bx * 512 + tl; i < (size_t)M_TOK * PLE / 4; i += (size_t)G * 512) pd[i] = pk4(ps[i]);
          }
        GRID_BAR(); TS_END(1);
        TS_BEGIN(2); PH(2) for (int bi = bx; bi < 256; bi += G) lru_block(pt, lds, bi, layer, tid);
        PH(3) { __syncthreads();
          { int tl = tid; asm volatile("" : "+v"(tl)); const int hh = (bx >> 5) & 3; const float* cwg = pin(pt, I_DNCW) + (size_t)layer * 4 * 1536;
            for (int e = tl; e < 1536; e += 512) { const int mat = e >> 9, tap = (e >> 7) & 3, ch = e & 127; ((LAS float*)(lds + DP_CWL))[e] = cwg[tap * 1536 + mat * 512 + hh * 128 + ch]; } }
          for (int it = bx; it < 4096; it += G) dp_item(pt, lds, it, layer, tid, lane, wave); }
        GRID_BAR(); TS_END(2);
        TS_BEGIN(4); PH(4) for (int it = bx; it < 256; it += G) dr_item(pt, lds, it, tid, lane, wave);
        GRID_BAR(); TS_END(4);
        TS_BEGIN(6); PH(6) m2_rows(pt, layer, gw, NGW, lane);
        GRID_BAR(); TS_END(6);
        TS_BEGIN(7); PH(7) { STAGGER(3700); pg8::Gemm g{(const bf16_t*)(pws(pt) + WS_AMIX), (const bf16_t*)(pws(pt) + WS_WOUT) + (size_t)layer * DM * DM, M_TOK, 1024, 1024}; pg8::StaticOrder S; S.init(M_TOK, 1024, G, bx);
          EpiResid<0> E{nullptr, RB_, RLO_, RLO_, SS_(3 * layer + 1), nullptr, nullptr, nullptr, nullptr, (LAS float*)(lds + 131072)};
          pg8::gemm_phase<EpiResid<0>, pg8::StaticOrder, true, true>(lds, g, S, E); }
        GRID_BAR(); TS_END(7);
        TS_BEGIN(9); PH(9) { pg8::Gemm g{RB_, (const bf16_t*)(pws(pt) + WS_WG) + (size_t)layer * 5632 * 1024, M_TOK, 5632, 1024}; pg8::StaticOrder S; S.init(M_TOK, 5632, G, bx);
          EpiGluF E{SS_(3 * layer + 1), (float*)(pws(pt) + WS_G), (float*)(pws(pt) + WS_G) + (size_t)256 * 4 * FF, pin(pt, I_FCW) + (size_t)layer * 3 * FF, pin(pt, I_FCB) + (size_t)layer * FF, (bf16_t*)(pws(pt) + WS_ACT), (LAS float*)(lds + 135168)};
          pg8::gemm_phase<EpiGluF, pg8::StaticOrder, true, true>(lds, g, S, E); }
        GRID_BAR(); TS_END(9);
        TS_BEGIN(8); PH(8) glu_fixup(pt, layer, bx, G, tid);
        GRID_BAR(); TS_END(8);
        TS_BEGIN(10); PH(10) { STAGGER(4800); pg8::Gemm g{(const bf16_t*)(pws(pt) + WS_ACT), (const bf16_t*)(pws(pt) + WS_WD) + (size_t)layer * DM * FF, M_TOK, 1024, FF}; pg8::StaticOrder S; S.init(M_TOK, 1024, G, bx);
          EpiResid<0> E{nullptr, RB_, RLO_, RLO_, SS_(3 * layer + 2), nullptr, nullptr, nullptr, RBC_, (LAS float*)(lds + 131072)};
          pg8::gemm_phase<EpiResid<0>, pg8::StaticOrder, true, true>(lds, g, S, E); }
        __syncthreads();
        PH(11) { pg8::Gemm g{(const bf16_t*)(pws(pt) + WS_PB), (const bf16_t*)(pws(pt) + WS_WP) + (size_t)layer * DM * PLE, M_TOK, 1024, PLE}; pg8::StaticOrder S; S.init(M_TOK, 1024, G, bx);
          EpiStore E{nullptr, {(bf16_t*)(pws(pt) + WS_PP), nullptr, nullptr, nullptr}, {1024, 0, 0, 0}, {0, 99, 99, 99}, nullptr, 99};
          pg8::gemm_phase<EpiStore, pg8::StaticOrder, true, true>(lds, g, S, E); }
        GRID_BAR(); TS_END(10);
        TS_BEGIN(12); PH(12) { STAGGER(3000); pg8::Gemm g{RBC_, (const bf16_t*)(pws(pt) + WS_WPG) + (size_t)layer * DM * DM, M_TOK, 1024, 1024}; pg8::StaticOrder S; S.init(M_TOK, 1024, G, bx);
          EpiResid<1> E{nullptr, RB_, RLO_, layer == NL - 1 ? RLOF_ : RLO_, SS_(3 * layer + 3), SS_(3 * layer + 2), pin(pt, I_PBG) + (size_t)layer * DM, (const bf16_t*)(pws(pt) + WS_PP), nullptr, (LAS float*)(lds + 131072)};
          pg8::gemm_phase<EpiResid<1>, pg8::StaticOrder, true, true>(lds, g, S, E); }
        GRID_BAR(); TS_END(12);
    }
    TS_BEGIN(13);
    { int tlf = tid; asm volatile("" : "+v"(tlf)); const int lane = tlf & 63;
      const float* ssF = SS_(12); const f32x4* fg = (const f32x4*)pin(pt, I_FING) + lane; const bf16_t* hi_ = RB_; const unsigned char* lo_ = RLOF_; float* outp = pout(pt);
      for (int m = gw; m < M_TOK; m += NGW) { const float sc = rs_of(ssF, m); f32x4* xr = (f32x4*)(outp + (size_t)m * DM) + lane;
          const u32x2* hr = (const u32x2*)(hi_ + (size_t)m * DM) + lane; const unsigned* lr = (const unsigned*)(lo_ + (size_t)m * DM) + lane;
#pragma unroll
          for (int j = 0; j < 4; ++j) { const u32x2 h = hr[64 * j]; const unsigned l = lr[64 * j]; const f32x4 g = fg[64 * j];
              f32x4 v; v[0] = (bflo(h.x) + FP8_AT(l, 0)) * sc * g[0]; v[1] = (bfhi(h.x) + FP8_AT(l, 1)) * sc * g[1]; v[2] = (bflo(h.y) + FP8_AT(l, 2)) * sc * g[2]; v[3] = (bfhi(h.y) + FP8_AT(l, 3)) * sc * g[3];
              xr[64 * j] = v; } } }
    if (TMASK) { __syncthreads(); TS_END(13); if (bx == 0 && tid == 0) { const unsigned wait_ = ((volatile LAS unsigned*)(lds + LDS_BYTES - 128))[1]; const unsigned long long t0_ = __builtin_amdgcn_s_memrealtime(); while (__builtin_amdgcn_s_memrealtime() - t0_ < (unsigned long long)wait_) __builtin_amdgcn_s_sleep(8); } }
}

extern "C" void kernel_launch(void* const* d_in, const int* in_sizes, int n_in, void* d_out, int out_size, void* d_ws, size_t ws_size, hipStream_t stream) {
    static int grid = 0;
    if (grid == 0) {
        if (n_in != 28 || ws_size < WS_END) { fprintf(stderr, "kernel_launch: unexpected n_in %d or workspace %zu < %zu\n", n_in, ws_size, (size_t)WS_END); grid = -1; return; }
        int dev = 0, cus = 0, per_cu = 0;
        hipGetDevice(&dev); hipDeviceGetAttribute(&cus, hipDeviceAttributeMultiprocessorCount, dev);
        if (hipFuncSetAttribute((const void*)fwd_kernel, hipFuncAttributeMaxDynamicSharedMemorySize, LDS_BYTES) != hipSuccess) fprintf(stderr, "kernel_launch: hipFuncSetAttribute failed\n");
        if (hipOccupancyMaxActiveBlocksPerMultiprocessor(&per_cu, (const void*)fwd_kernel, 512, LDS_BYTES) != hipSuccess || per_cu < 1) { fprintf(stderr, "kernel_launch: occupancy query says %d\n", per_cu); per_cu = 1; }
        (void)hipGetLastError();
        grid = cus * per_cu; if (grid > 256) grid = 256;
    }
    if (grid < 0) return;
    if (hipMemsetAsync(d_ws, 0, 16384, stream) != hipSuccess) { fprintf(stderr, "kernel_launch: memset of the barrier words failed\n"); return; }
    Params p{};
    for (int i = 0; i < 28; ++i) p.in[i] = (const float*)d_in[i];
    p.out = (float*)d_out; p.ws = (unsigned char*)d_ws;
    void* args[] = {&p};
    hipError_t e = hipLaunchCooperativeKernel((const void*)fwd_kernel, dim3(grid), dim3(512), args, LDS_BYTES, stream);
    if (e != hipSuccess) fprintf(stderr, "cooperative launch failed: %s (grid %d)\n", hipGetErrorString(e), grid);
}
```

```cpp
#include <hip/hip_runtime.h>
#include <hip/hip_cooperative_groups.h>
#include <cstdio>
#include <cstdint>
namespace cg = cooperative_groups;

#define LAS __attribute__((address_space(3)))
typedef unsigned short bf16_t;
typedef short bf16x8 __attribute__((ext_vector_type(8)));
typedef short s16x4 __attribute__((ext_vector_type(4)));
typedef float f32x2 __attribute__((ext_vector_type(2)));
typedef float f32x4 __attribute__((ext_vector_type(4)));
typedef float f32x16 __attribute__((ext_vector_type(16)));
typedef unsigned u32x4 __attribute__((ext_vector_type(4)));
typedef unsigned u32x2 __attribute__((ext_vector_type(2)));
typedef __bf16 bfx2_t __attribute__((ext_vector_type(2)));

constexpr int M_TOK = 65536, DM = 1024, SEQ = 2048, NB = 32, NL = 4;
constexpr int FF = 2816, PLE = 256, INC = 3088;
constexpr float EPS = 1e-6f;

constexpr size_t MiB = 1u << 20;
constexpr size_t WS_SS = 0;
constexpr size_t WS_WIN = 4 * MiB;
constexpr size_t WS_WOUT = WS_WIN + 26 * MiB;
constexpr size_t WS_WG = WS_WOUT + 8 * MiB;
constexpr size_t WS_WU = WS_WG + 22 * MiB;
constexpr size_t WS_WD = WS_WU + 22 * MiB;
constexpr size_t WS_WPG = WS_WD + 22 * MiB;
constexpr size_t WS_WP = WS_WPG + 8 * MiB;
constexpr size_t WS_WAT = WS_WP + 2 * MiB;
constexpr size_t WS_GATES = WS_WAT + 1 * MiB;
constexpr size_t WS_VEC = WS_GATES + 4 * MiB;
constexpr size_t WS_PB = WS_VEC + 8 * MiB;
constexpr size_t WS_RB = WS_PB + 32 * MiB;
constexpr size_t WS_BIG = WS_RB + 128 * MiB;
constexpr size_t WS_PQKV = WS_BIG;
constexpr size_t WS_OF = WS_BIG, WS_OB = WS_BIG + 64 * MiB, WS_PZ = WS_BIG + 576 * MiB;
constexpr size_t WS_PLX = WS_BIG + 192 * MiB, WS_PLG = WS_BIG + 640 * MiB;
constexpr size_t WS_QH = WS_BIG + 256 * MiB, WS_KH = WS_BIG + 320 * MiB, WS_VT = WS_BIG + 384 * MiB;
constexpr size_t WS_TM = WS_BIG + 448 * MiB, WS_AT = WS_BIG + 512 * MiB;
constexpr size_t WS_RLO = WS_BIG + 576 * MiB;
constexpr size_t WS_AMIX = WS_BIG + 256 * MiB;
constexpr size_t WS_G = WS_BIG, WS_ACT = WS_BIG + 352 * MiB, WS_PP = WS_BIG;
constexpr size_t WS_SSP = WS_BIG + 704 * MiB;
constexpr size_t WS_END = WS_SSP + 13 * MiB;
constexpr int LDS_BYTES = 153600;

__device__ __forceinline__ unsigned pk2(float lo, float hi) { f32x2 v = {lo, hi}; bfx2_t b = __builtin_convertvector(v, bfx2_t); return __builtin_bit_cast(unsigned, b); }
__device__ __forceinline__ u32x2 pk4(f32x4 v) { u32x2 r; r.x = pk2(v[0], v[1]); r.y = pk2(v[2], v[3]); return r; }
__device__ __forceinline__ unsigned pk4_fp8(float a, float b, float c, float d) { int v = 0; v = __builtin_amdgcn_cvt_pk_fp8_f32(a * 1024.f, b * 1024.f, v, false); v = __builtin_amdgcn_cvt_pk_fp8_f32(c * 1024.f, d * 1024.f, v, true); return (unsigned)v; }
#define FP8_AT(w, i) (__builtin_amdgcn_cvt_f32_fp8((int)(w), (i)) * (1.0f / 1024.0f))
__device__ __forceinline__ float bflo(unsigned w) { return __uint_as_float(w << 16); }
__device__ __forceinline__ float bfhi(unsigned w) { return __uint_as_float(w & 0xffff0000u); }
__device__ __forceinline__ float bf2f(unsigned short b) { return __uint_as_float((unsigned)b << 16); }
__device__ __forceinline__ float fexp(float x) { return __builtin_amdgcn_exp2f(x * 1.4426950408889634f); }
__device__ __forceinline__ float sigm(float x) { return __builtin_amdgcn_rcpf(1.0f + fexp(-x)); }
__device__ __forceinline__ float gelu_t(float x) { const float u = 1.5957691216057308f * (x + 0.044715f * x * x * x); return x * __builtin_amdgcn_rcpf(1.0f + fexp(-u)); }
__device__ __forceinline__ float softplus_f(float x) { return x > 20.f ? x : log1pf(expf(x)); }
__device__ __forceinline__ int swz128(int row, int col) { return row * 256 + ((((col >> 3) ^ (row & 15)) << 4) | ((col & 7) << 1)); }
__device__ __forceinline__ int swz64(int row, int col) { return row * 128 + ((((col >> 3) ^ (row & 7)) << 4) | ((col & 7) << 1)); }
__device__ __forceinline__ int crow(int r, int hi) { return (r & 3) + 8 * (r >> 2) + 4 * hi; }
#define MFMA16(a, b, c) __builtin_amdgcn_mfma_f32_16x16x32_bf16((a), (b), (c), 0, 0, 0)
#define MFMA32(a, b, c) __builtin_amdgcn_mfma_f32_32x32x16_bf16((a), (b), (c), 0, 0, 0)
typedef unsigned long long u64;
__device__ __forceinline__ float rs_of(const float* ss4, int row) { const f32x4 p = *(const f32x4*)(ss4 + (size_t)row * 4); return rsqrtf(((p[0] + p[1]) + (p[2] + p[3])) * (1.0f / 1024.0f) + EPS); }
#define LDS_FENCE() asm volatile("s_waitcnt lgkmcnt(0)" ::: "memory")

#define LBAR() do { asm volatile("s_waitcnt lgkmcnt(0)" ::: "memory"); __builtin_amdgcn_s_barrier(); asm volatile("" ::: "memory"); } while (0)

namespace pg8 {
#define PG8_LAS __attribute__((address_space(3)))
typedef unsigned short bf16_t;
typedef short bf16x8 __attribute__((ext_vector_type(8)));
typedef float f32x4 __attribute__((ext_vector_type(4)));
typedef unsigned u32x4 __attribute__((ext_vector_type(4)));
constexpr int BM = 256, BK = 64, HALF = 128, HTB = HALF * BK * 2  , STAGE_BYTES = 8 * HTB, NXCD = 8, WGM = 8;

__host__ __device__ __forceinline__ int lds_byte(int r, int c) { const int st = (r >> 4) * 2 + (c >> 5), rr = r & 15, cc = c & 31, ob = rr * 64 + cc * 2; return st * 1024 + (ob ^ (((ob >> 9) & 1) << 5)); }
__host__ __device__ __forceinline__ void stage_rc(int b, int& R, int& C) { const int st = b / 1024, sb = b % 1024, swz = sb ^ (((sb >> 9) & 1) << 5); R = (st >> 1) * 16 + swz / 64; C = (st & 1) * 32 + (swz % 64) / 2; }
__host__ __device__ __forceinline__ int perm32(int rho) { const int n = rho >> 4, i = rho & 15; return 8 * (i >> 2) + 4 * n + (i & 3); }

struct Unit { int pm, pn; };
struct Gemm { const bf16_t* A; const bf16_t* Bt; int M, N, K; };

struct StaticOrder {
    int nM, nN, nwg, G, c;
    __host__ __device__ void init(int M, int N, int G_, int c_) { nM = M / BM; nN = N / BM; nwg = nM * nN; G = G_; c = c_; }
    __host__ __device__ bool next(int i, Unit& u) const {
        const long L = (long)i * G + c; if (L >= nwg) return false;
        int wgid = (int)L; { const int q = nwg / NXCD, r = nwg % NXCD, xcd = wgid % NXCD, off = wgid / NXCD; wgid = (xcd < r ? xcd * (q + 1) : r * (q + 1) + (xcd - r) * q) + off; }
        const int nig = WGM * nN, gid = wgid / nig, fm = gid * WGM, gsz = (nM - fm) < WGM ? (nM - fm) : WGM;
        u.pm = fm + ((wgid % nig) % gsz); u.pn = (wgid % nig) / gsz; return true;
    }
    __device__ __forceinline__ void a_ready(const Unit&) const {}
    __device__ __forceinline__ void done(const Unit&) const {}
};

template <class Epi, class Sched, bool ALIGN_EPI = false, bool SP2 = false>
__device__ __forceinline__ void gemm_phase(PG8_LAS unsigned char* lds, const Gemm g, const Sched& S, const Epi& E) {
    int tid_ = threadIdx.x; asm volatile("" : "+v"(tid_));
    const int tid = tid_, wid = __builtin_amdgcn_readfirstlane(tid >> 6), lane = tid & 63, wr = wid >> 2, wc = wid & 3, fr = lane & 15, fq = lane >> 4;
    const int K = g.K, nt = K / BK;
    unsigned voffA[2], voffB[2];
#pragma unroll
    for (int i = 0; i < 2; ++i) { int R, C; stage_rc(tid * 16 + i * 8192, R, C); const int Rb = Epi::PERM ? ((R & ~31) + perm32(R & 31)) : R;
        voffA[i] = (unsigned)(R * K + C) * 2u; voffB[i] = (unsigned)(Rb * K + C) * 2u; }
    const size_t kstep = (size_t)(BK * 2);
    const size_t hstep = (size_t)HALF * K * 2;
    const size_t tstep = 2 * hstep;
    const unsigned ldsw = (unsigned)wid * 1024u;
    const int aoff = lds_byte(wr * 64 + fr, fq * 8), boff = lds_byte(wc * 32 + fr, fq * 8);
#define PG8_SA(b, h) (((b) * 2 + (h)) * HTB)
#define PG8_SB(b, h) ((4 + (b) * 2 + (h)) * HTB)
#define PG8_STAGE(bufoff, gbase, voff) do { _Pragma("unroll") for (int _i = 0; _i < 2; ++_i) \
        __builtin_amdgcn_global_load_lds((const unsigned*)((const char*)(gbase) + (voff)[_i]), (PG8_LAS unsigned*)(lds + (bufoff) + ldsw + _i * 8192), 16, 0, 0); } while (0)
#define PG8_LDA(dst, b, h) do { _Pragma("unroll") for (int m = 0; m < 4; ++m) _Pragma("unroll") for (int k = 0; k < 2; ++k) dst[m][k] = *(const PG8_LAS bf16x8*)(lds + PG8_SA(b, h) + aoff + m * 2048 + k * 1024); } while (0)
#define PG8_LDB(dst, b, h) do { _Pragma("unroll") for (int n = 0; n < 2; ++n) _Pragma("unroll") for (int k = 0; k < 2; ++k) dst[n][k] = *(const PG8_LAS bf16x8*)(lds + PG8_SB(b, h) + boff + n * 2048 + k * 1024); } while (0)
#define PG8_MMA(ai, bj, At, Bt) do { __builtin_amdgcn_s_setprio(1); _Pragma("unroll") for (int m = 0; m < 4; ++m) _Pragma("unroll") for (int n = 0; n < 2; ++n) _Pragma("unroll") for (int k = 0; k < 2; ++k) \
        acc[ai][bj][m][n] = __builtin_amdgcn_mfma_f32_16x16x32_bf16(Bt[n][k], At[m][k], acc[ai][bj][m][n], 0, 0, 0); __builtin_amdgcn_s_setprio(0); } while (0)
#define PG8_WAIT_V(n) asm volatile("s_waitcnt vmcnt(" #n ")" ::: "memory")
#define PG8_WAIT_L(n) asm volatile("s_waitcnt lgkmcnt(" #n ")" ::: "memory")
#define PG8_BAR __builtin_amdgcn_s_barrier()
#define PG8_SCHED __builtin_amdgcn_sched_barrier(0)
    Unit cur, nxt; int ui = 0;
    if (!S.next(0, cur)) return;
    f32x4 acc[2][2][4][2];
#pragma unroll
    for (int a = 0; a < 2; ++a)
#pragma unroll
        for (int b = 0; b < 2; ++b)
#pragma unroll
            for (int m = 0; m < 4; ++m)
#pragma unroll
                for (int n = 0; n < 2; ++n) acc[a][b][m][n] = (f32x4){0.f, 0.f, 0.f, 0.f};
    bf16x8 At[4][2], B0[2][2], B1[2][2];
    const char* cA = (const char*)g.A + (size_t)cur.pm * tstep; const char* cB = (const char*)g.Bt + (size_t)cur.pn * tstep;
    S.a_ready(cur);
    if constexpr (SP2) {
        PG8_STAGE(PG8_SB(0, 0), cB, voffB); PG8_STAGE(PG8_SB(0, 1), cB + hstep, voffB); PG8_STAGE(PG8_SA(0, 0), cA, voffA); PG8_STAGE(PG8_SA(0, 1), cA + hstep, voffA);
        if (wr == 1) PG8_BAR;
        PG8_WAIT_V(2); PG8_BAR;
        PG8_STAGE(PG8_SB(1, 0), cB + kstep, voffB); PG8_STAGE(PG8_SA(1, 0), cA + kstep, voffA); PG8_STAGE(PG8_SB(1, 1), cB + hstep + kstep, voffB);
        PG8_WAIT_V(6); PG8_BAR;
    } else {
        PG8_STAGE(PG8_SB(0, 0), cB, voffB); PG8_STAGE(PG8_SA(0, 0), cA, voffA); PG8_STAGE(PG8_SB(0, 1), cB + hstep, voffB); PG8_STAGE(PG8_SA(0, 1), cA + hstep, voffA);
        if (wr == 1) PG8_BAR;
        PG8_WAIT_V(4); PG8_BAR;
        PG8_STAGE(PG8_SB(1, 0), cB + kstep, voffB); PG8_STAGE(PG8_SA(1, 0), cA + kstep, voffA); PG8_STAGE(PG8_SB(1, 1), cB + hstep + kstep, voffB);
        PG8_WAIT_V(6); PG8_BAR;
    }
    for (;;) {
        const bool has_next = S.next(ui + 1, nxt);
        const char* nA = has_next ? (const char*)g.A + (size_t)nxt.pm * tstep : cA; const char* nB = has_next ? (const char*)g.Bt + (size_t)nxt.pn * tstep : cB;
        for (int t = 0; t < nt; t += 2) {
            const bool last = (t == nt - 2);
            const char* a1 = cA + (size_t)(t + 1) * kstep;
            const char* a2 = last ? nA : cA + (size_t)(t + 2) * kstep; const char* b2 = last ? nB : cB + (size_t)(t + 2) * kstep;
            const char* a3 = a2 + kstep; const char* b3 = b2 + kstep;
            if (last && has_next) S.a_ready(nxt);
            if constexpr (SP2) {
            PG8_LDB(B0, 0, 0); PG8_LDB(B1, 0, 1); PG8_SCHED; PG8_LDA(At, 0, 0); PG8_STAGE(PG8_SA(1, 1), a1 + hstep, voffA);
            PG8_WAIT_V(8); PG8_WAIT_L(0); PG8_BAR; PG8_MMA(0, 0, At, B0); PG8_MMA(0, 1, At, B1); PG8_BAR; PG8_SCHED;
            PG8_LDA(At, 0, 1); PG8_STAGE(PG8_SB(0, 0), b2, voffB); PG8_STAGE(PG8_SB(0, 1), b2 + hstep, voffB); PG8_STAGE(PG8_SA(0, 0), a2, voffA);
            PG8_WAIT_V(8); PG8_WAIT_L(0); PG8_BAR; PG8_MMA(1, 0, At, B0); PG8_MMA(1, 1, At, B1); PG8_BAR; PG8_SCHED;
            PG8_LDB(B0, 1, 0); PG8_LDB(B1, 1, 1); PG8_SCHED; PG8_LDA(At, 1, 0); PG8_STAGE(PG8_SA(0, 1), a2 + hstep, voffA);
            PG8_WAIT_V(8); PG8_WAIT_L(0); PG8_BAR; PG8_MMA(0, 0, At, B0); PG8_MMA(0, 1, At, B1); PG8_BAR; PG8_SCHED;
            PG8_LDA(At, 1, 1); PG8_STAGE(PG8_SB(1, 0), b3, voffB); PG8_STAGE(PG8_SB(1, 1), b3 + hstep, voffB); PG8_STAGE(PG8_SA(1, 0), a3, voffA);
            PG8_WAIT_V(8); PG8_WAIT_L(0); PG8_BAR; PG8_MMA(1, 0, At, B0); PG8_MMA(1, 1, At, B1); PG8_BAR; PG8_SCHED;
            } else {
            PG8_LDB(B0, 0, 0); PG8_SCHED; PG8_LDA(At, 0, 0); PG8_STAGE(PG8_SA(1, 1), a1 + hstep, voffA);
            PG8_WAIT_L(8); PG8_BAR; PG8_WAIT_L(0); PG8_MMA(0, 0, At, B0); PG8_BAR; PG8_SCHED;
            PG8_LDB(B1, 0, 1); PG8_STAGE(PG8_SB(0, 0), b2, voffB);
            PG8_BAR; PG8_WAIT_L(0); PG8_MMA(0, 1, At, B1); PG8_BAR;
            PG8_LDA(At, 0, 1); PG8_STAGE(PG8_SA(0, 0), a2, voffA);
            PG8_BAR; PG8_WAIT_L(0); PG8_MMA(1, 0, At, B0); PG8_BAR; PG8_SCHED;
            PG8_STAGE(PG8_SB(0, 1), b2 + hstep, voffB);
            PG8_WAIT_V(6); PG8_BAR; PG8_MMA(1, 1, At, B1); PG8_BAR;
            PG8_LDB(B0, 1, 0); PG8_SCHED; PG8_LDA(At, 1, 0); PG8_STAGE(PG8_SA(0, 1), a2 + hstep, voffA);
            PG8_WAIT_L(8); PG8_BAR; PG8_WAIT_L(0); PG8_MMA(0, 0, At, B0); PG8_BAR; PG8_SCHED;
            PG8_LDB(B1, 1, 1); PG8_STAGE(PG8_SB(1, 0), b3, voffB);
            PG8_BAR; PG8_WAIT_L(0); PG8_MMA(0, 1, At, B1); PG8_BAR;
            PG8_LDA(At, 1, 1); PG8_STAGE(PG8_SA(1, 0), a3, voffA);
            PG8_BAR; PG8_WAIT_L(0); PG8_MMA(1, 0, At, B0); PG8_BAR; PG8_SCHED;
            PG8_STAGE(PG8_SB(1, 1), b3 + hstep, voffB);
            PG8_WAIT_V(6); PG8_BAR; PG8_MMA(1, 1, At, B1); PG8_BAR;
            }
        }
        if constexpr (ALIGN_EPI) { if (wr == 0) PG8_BAR; }
        if constexpr (!Epi::AFTER_DRAIN) { E(acc, cur, wr, wc, fr, fq); S.done(cur); }
        if (!has_next) break;
#pragma unroll
        for (int a = 0; a < 2; ++a)
#pragma unroll
            for (int b = 0; b < 2; ++b)
#pragma unroll
                for (int m = 0; m < 4; ++m)
#pragma unroll
                    for (int n = 0; n < 2; ++n) acc[a][b][m][n] = (f32x4){0.f, 0.f, 0.f, 0.f};
        cur = nxt; cA = nA; cB = nB; ++ui;
        if constexpr (ALIGN_EPI) { if (wr == 1) PG8_BAR; }
    }
    PG8_WAIT_V(0);
    if constexpr (!ALIGN_EPI) { if (wr == 0) PG8_BAR; }
    PG8_BAR;
    if constexpr (Epi::AFTER_DRAIN) { E.fused(acc, cur, wr, wc, fr, fq, lds, wid, lane); S.done(cur); }
#undef PG8_SA
#undef PG8_SB
#undef PG8_STAGE
#undef PG8_LDA
#undef PG8_LDB
#undef PG8_MMA
#undef PG8_WAIT_V
#undef PG8_WAIT_L
#undef PG8_BAR
#undef PG8_SCHED
}
}

using pg8::Unit;
struct EpiStore {
    static constexpr bool PERM = true, AFTER_DRAIN = false;
    const float* ss; bf16_t* base[4]; int ld[4]; int ts[4]; float* gates; int t2;
    __device__ __forceinline__ void operator()(const f32x4 (&acc)[2][2][4][2], const Unit& u, int wr, int wc, int fr, int fq) const {
        const int row0 = u.pm * 256 + wr * 64 + fr; const int pn = u.pn;
        if (pn >= t2) {
            if (wc == 0 && fq < 2) {
#pragma unroll
                for (int ai = 0; ai < 2; ++ai)
#pragma unroll
                    for (int m = 0; m < 4; ++m) { const int row = row0 + ai * 128 + m * 16; const float s = ss ? rs_of(ss, row) : 1.f;
                        float* gp = gates + (size_t)row * 16 + 8 * fq; *(f32x4*)gp = acc[ai][0][m][0] * s; *(f32x4*)(gp + 4) = acc[ai][0][m][1] * s; }
            }
            return;
        }
        int k = 0; if (pn >= ts[1]) k = 1; if (pn >= ts[2]) k = 2; if (pn >= ts[3]) k = 3;
        bf16_t* bsel = base[0]; int ldsel = ld[0], t0 = ts[0];
        if (k == 1) { bsel = base[1]; ldsel = ld[1]; t0 = ts[1]; } else if (k == 2) { bsel = base[2]; ldsel = ld[2]; t0 = ts[2]; } else if (k == 3) { bsel = base[3]; ldsel = ld[3]; t0 = ts[3]; }
        const int col0 = (pn - t0) * 256 + wc * 32 + 8 * fq;
#pragma unroll
        for (int ai = 0; ai < 2; ++ai)
#pragma unroll
            for (int m = 0; m < 4; ++m) { const int row = row0 + ai * 128 + m * 16; const float s = ss ? rs_of(ss, row) : 1.f;
                bf16_t* rowp = bsel + (size_t)row * ldsel + col0;
#pragma unroll
                for (int bj = 0; bj < 2; ++bj) { const f32x4 v0 = acc[ai][bj][m][0] * s, v1 = acc[ai][bj][m][1] * s;
                    u32x4 w; w.x = pk2(v0[0], v0[1]); w.y = pk2(v0[2], v0[3]); w.z = pk2(v1[0], v1[1]); w.w = pk2(v1[2], v1[3]);
                    *(u32x4*)(rowp + bj * 128) = w; } }
    }
};

#ifndef RES_BM
#define RES_BM 4
#endif
#ifndef RES1_BM
#define RES1_BM 2
#endif
template <int MODE> struct EpiResid {
    static constexpr bool PERM = true, AFTER_DRAIN = false;
    const float* rin32; const bf16_t* rbr; bf16_t* rb; const unsigned char* rlo; unsigned char* rlo_w; float* ss_out; const float* ss_in; const float* bias; const bf16_t* pp; bf16_t* rb2; LAS float* sl;
    __device__ __forceinline__ void ld_r(size_t off, f32x4& r0, f32x4& r1) const {
        if (rin32) { r0 = *(const f32x4*)(rin32 + off); r1 = *(const f32x4*)(rin32 + off + 4); }
        else { const u32x4 h = *(const u32x4*)(rbr + off); const u32x2 l = *(const u32x2*)(rlo + off);
            r0[0] = bflo(h.x) + FP8_AT(l.x, 0); r0[1] = bfhi(h.x) + FP8_AT(l.x, 1); r0[2] = bflo(h.y) + FP8_AT(l.x, 2); r0[3] = bfhi(h.y) + FP8_AT(l.x, 3);
            r1[0] = bflo(h.z) + FP8_AT(l.y, 0); r1[1] = bfhi(h.z) + FP8_AT(l.y, 1); r1[2] = bflo(h.w) + FP8_AT(l.y, 2); r1[3] = bfhi(h.w) + FP8_AT(l.y, 3); }
    }
    __device__ __forceinline__ float st_r(size_t off, const f32x4& r0, const f32x4& r1) const {
        u32x4 w; w.x = pk2(r0[0], r0[1]); w.y = pk2(r0[2], r0[3]); w.z = pk2(r1[0], r1[1]); w.w = pk2(r1[2], r1[3]);
        u32x2 l; l.x = pk4_fp8(r0[0] - bflo(w.x), r0[1] - bfhi(w.x), r0[2] - bflo(w.y), r0[3] - bfhi(w.y)); l.y = pk4_fp8(r1[0] - bflo(w.z), r1[1] - bfhi(w.z), r1[2] - bflo(w.w), r1[3] - bfhi(w.w));
        *(u32x4*)(rb + off) = w; *(u32x2*)(rlo_w + off) = l; if (rb2) *(u32x4*)(rb2 + off) = w;
        return (r0[0] * r0[0] + r0[1] * r0[1]) + (r0[2] * r0[2] + r0[3] * r0[3]) + (r1[0] * r1[0] + r1[1] * r1[1]) + (r1[2] * r1[2] + r1[3] * r1[3]);
    }
    __device__ __forceinline__ void operator()(const f32x4 (&acc)[2][2][4][2], const Unit& u, int wr, int wc, int fr, int fq) const {
        run<false>(acc, u, wr, wc, fr, fq);
    }
    template <bool F32IN> __device__ __forceinline__ void run(const f32x4 (&acc)[2][2][4][2], const Unit& u, int wr, int wc, int fr, int fq) const {
        const int row0 = u.pm * 256 + wr * 64 + fr; const int col0 = u.pn * 256 + wc * 32 + 8 * fq;
        float sqa[2][4] = {{0.f, 0.f, 0.f, 0.f}, {0.f, 0.f, 0.f, 0.f}}; float sina[2][4]; f32x4 bia[2][2];
#pragma unroll
        for (int ai = 0; ai < 2; ++ai)
#pragma unroll
            for (int m = 0; m < 4; ++m) sina[ai][m] = (MODE == 1) ? rs_of(ss_in, row0 + ai * 128 + m * 16) : 1.f;
#pragma unroll
        for (int bj = 0; bj < 2; ++bj) { bia[bj][0] = (f32x4){0.f, 0.f, 0.f, 0.f}; bia[bj][1] = (f32x4){0.f, 0.f, 0.f, 0.f};
            if (MODE == 1) { bia[bj][0] = *(const f32x4*)(bias + col0 + bj * 128); bia[bj][1] = *(const f32x4*)(bias + col0 + bj * 128 + 4); } }
        constexpr int RPB = (MODE == 1) ? 1 : 2;
        constexpr int NBAT = 16 / RPB;
        u32x4 ph[2][RPB], pw[2][RPB]; u32x2 pl[2][RPB];
#define RES_AI(b_) ((b_) / (8 / RPB))
#define RES_BJ(b_) (((b_) / (4 / RPB)) & 1)
#define RES_MH(b_) (((b_) % (4 / RPB)) * RPB)
#define RES_OFF(b_, m_) ((size_t)(row0 + RES_AI(b_) * 128 + (RES_MH(b_) + (m_)) * 16) * 1024 + col0 + RES_BJ(b_) * 128)
#define RES_LOAD(b_, buf_) do { _Pragma("unroll") for (int m_ = 0; m_ < RPB; ++m_) { const size_t off_ = RES_OFF(b_, m_); ph[buf_][m_] = *(const u32x4*)(rbr + off_); pl[buf_][m_] = *(const u32x2*)(rlo + off_); \
            if (MODE == 1) pw[buf_][m_] = *(const u32x4*)(pp + off_); } } while (0)
        __builtin_amdgcn_sched_barrier(0);
        RES_LOAD(0, 0);
        __builtin_amdgcn_sched_barrier(0);
#pragma unroll
        for (int b = 0; b < NBAT; ++b) { const int buf = b & 1; const int ai = RES_AI(b), bj = RES_BJ(b), mh = RES_MH(b);
            if (b + 1 < NBAT) { RES_LOAD(b + 1, buf ^ 1); }
            __builtin_amdgcn_sched_barrier(0);
            const f32x4 b0 = bia[bj][0], b1 = bia[bj][1];
#pragma unroll
            for (int m = 0; m < RPB; ++m) { const size_t off = RES_OFF(b, m); const float si = sina[ai][mh + m]; const u32x4 h = ph[buf][m]; const u32x2 l = pl[buf][m];
                f32x4 p0, p1;
                p0[0] = bflo(h.x) + FP8_AT(l.x, 0); p0[1] = bfhi(h.x) + FP8_AT(l.x, 1); p0[2] = bflo(h.y) + FP8_AT(l.x, 2); p0[3] = bfhi(h.y) + FP8_AT(l.x, 3);
                p1[0] = bflo(h.z) + FP8_AT(l.y, 0); p1[1] = bfhi(h.z) + FP8_AT(l.y, 1); p1[2] = bflo(h.w) + FP8_AT(l.y, 2); p1[3] = bfhi(h.w) + FP8_AT(l.y, 3);
                f32x4 a0 = acc[ai][bj][mh + m][0], a1 = acc[ai][bj][mh + m][1];
                if (MODE == 1) { const u32x4 w = pw[buf][m];
                    a0[0] = sigm(a0[0] * si + b0[0]) * bflo(w.x); a0[1] = sigm(a0[1] * si + b0[1]) * bfhi(w.x);
                    a0[2] = sigm(a0[2] * si + b0[2]) * bflo(w.y); a0[3] = sigm(a0[3] * si + b0[3]) * bfhi(w.y);
                    a1[0] = sigm(a1[0] * si + b1[0]) * bflo(w.z); a1[1] = sigm(a1[1] * si + b1[1]) * bfhi(w.z);
                    a1[2] = sigm(a1[2] * si + b1[2]) * bflo(w.w); a1[3] = sigm(a1[3] * si + b1[3]) * bfhi(w.w); }
                const f32x4 r0 = p0 + a0, r1 = p1 + a1;
                sqa[ai][mh + m] += st_r(off, r0, r1); }
            __builtin_amdgcn_sched_barrier(0);
        }
#undef RES_AI
#undef RES_BJ
#undef RES_MH
#undef RES_LOAD
#undef RES_OFF
#pragma unroll
        for (int ai = 0; ai < 2; ++ai)
#pragma unroll
            for (int m = 0; m < 4; ++m) { float q = sqa[ai][m]; q += __shfl_xor(q, 16); q += __shfl_xor(q, 32);
                if (fq == 0) sl[(ai * 128 + wr * 64 + m * 16 + fr) * 4 + wc] = q; }
        asm volatile("s_waitcnt lgkmcnt(0)" ::: "memory"); __builtin_amdgcn_s_barrier(); asm volatile("" ::: "memory");
        if (fq == 0) {
#pragma unroll
            for (int ai = 0; ai < 2; ++ai) { const int r = ai * 128 + wr * 64 + wc * 16 + fr; const f32x4 p = *(const LAS f32x4*)(sl + r * 4);
                ss_out[(size_t)(u.pm * 256 + r) * 4 + u.pn] = (p[0] + p[1]) + (p[2] + p[3]); } }
    }
};

#ifndef GLU_BM
#define GLU_BM 2
#endif
struct EpiGlu {
    static constexpr bool PERM = true, AFTER_DRAIN = false;
    const float* ss; const bf16_t* G; const float* cw; const float* cb; bf16_t* act;
    __device__ __forceinline__ void operator()(const f32x4 (&acc)[2][2][4][2], const Unit& u, int wr, int wc, int fr, int fq) const {
        const int row0 = u.pm * 256 + wr * 64 + fr; const int col0 = u.pn * 256 + wc * 32 + 8 * fq;
#pragma unroll
        for (int bj = 0; bj < 2; ++bj) { const int c = col0 + bj * 128;
            const f32x4 w0a = *(const f32x4*)(cw + c), w0b = *(const f32x4*)(cw + c + 4), w1a = *(const f32x4*)(cw + FF + c), w1b = *(const f32x4*)(cw + FF + c + 4);
            const f32x4 w2a = *(const f32x4*)(cw + 2 * FF + c), w2b = *(const f32x4*)(cw + 2 * FF + c + 4), bba = *(const f32x4*)(cb + c), bbb = *(const f32x4*)(cb + c + 4);
#pragma unroll
            for (int ai = 0; ai < 2; ++ai)
#pragma unroll
            for (int mh = 0; mh < 4; mh += GLU_BM) {
                u32x4 gmv[GLU_BM], glv[GLU_BM], gnv[GLU_BM]; float sv[GLU_BM];
#pragma unroll
                for (int m = 0; m < GLU_BM; ++m) { const int row = row0 + ai * 128 + (mh + m) * 16; const int t = row & (SEQ - 1); const bf16_t* gp = G + (size_t)row * FF + c;
                    gmv[m] = *(const u32x4*)gp; glv[m] = (u32x4){0u, 0u, 0u, 0u}; gnv[m] = (u32x4){0u, 0u, 0u, 0u};
                    if (t > 0) glv[m] = *(const u32x4*)(gp - FF);
                    if (t < SEQ - 1) gnv[m] = *(const u32x4*)(gp + FF);
                    sv[m] = rs_of(ss, row); }
#pragma unroll
                for (int m = 0; m < GLU_BM; ++m) { const int row = row0 + ai * 128 + (mh + m) * 16; const float s = sv[m]; const u32x4 gm = gmv[m], gl = glv[m], gn = gnv[m];
                    f32x4 ga, gb;
                    ga[0] = w0a[0] * bflo(gl.x) + w1a[0] * bflo(gm.x) + w2a[0] * bflo(gn.x) + bba[0];
                    ga[1] = w0a[1] * bfhi(gl.x) + w1a[1] * bfhi(gm.x) + w2a[1] * bfhi(gn.x) + bba[1];
                    ga[2] = w0a[2] * bflo(gl.y) + w1a[2] * bflo(gm.y) + w2a[2] * bflo(gn.y) + bba[2];
                    ga[3] = w0a[3] * bfhi(gl.y) + w1a[3] * bfhi(gm.y) + w2a[3] * bfhi(gn.y) + bba[3];
                    gb[0] = w0b[0] * bflo(gl.z) + w1b[0] * bflo(gm.z) + w2b[0] * bflo(gn.z) + bbb[0];
                    gb[1] = w0b[1] * bfhi(gl.z) + w1b[1] * bfhi(gm.z) + w2b[1] * bfhi(gn.z) + bbb[1];
                    gb[2] = w0b[2] * bflo(gl.w) + w1b[2] * bflo(gm.w) + w2b[2] * bflo(gn.w) + bbb[2];
                    gb[3] = w0b[3] * bfhi(gl.w) + w1b[3] * bfhi(gm.w) + w2b[3] * bfhi(gn.w) + bbb[3];
                    const f32x4 a0 = acc[ai][bj][mh + m][0] * s, a1 = acc[ai][bj][mh + m][1] * s;
                    u32x4 w; w.x = pk2(gelu_t(ga[0]) * a0[0], gelu_t(ga[1]) * a0[1]); w.y = pk2(gelu_t(ga[2]) * a0[2], gelu_t(ga[3]) * a0[3]);
                    w.z = pk2(gelu_t(gb[0]) * a1[0], gelu_t(gb[1]) * a1[1]); w.w = pk2(gelu_t(gb[2]) * a1[2], gelu_t(gb[3]) * a1[3]);
                    *(u32x4*)(act + (size_t)row * FF + c) = w; } } }
    }
};

__device__ __forceinline__ float dpp_up1(float x) { const int v = __builtin_bit_cast(int, x); return __builtin_bit_cast(float, __builtin_amdgcn_update_dpp(v, v, 0x111, 0xf, 0xf, false)); }
__device__ __forceinline__ float dpp_dn1(float x) { const int v = __builtin_bit_cast(int, x); return __builtin_bit_cast(float, __builtin_amdgcn_update_dpp(v, v, 0x101, 0xf, 0xf, false)); }
struct EpiGluF {
    static constexpr bool PERM = true, AFTER_DRAIN = false;
    const float* ss; float* sg; float* su; const float* cw; const float* cb; bf16_t* act; LAS float* ex;
    __device__ __forceinline__ void operator()(const f32x4 (&acc)[2][2][4][2], const Unit& u, int wr, int wc, int fr, int fq) const {
        const int row0 = u.pm * 256 + wr * 64 + fr; const int chl = wc * 32 + 8 * fq; const int chg = u.pn * 128 + chl;
        float rsm[2][4];
#pragma unroll
        for (int ai = 0; ai < 2; ++ai)
#pragma unroll
            for (int m = 0; m < 4; ++m) rsm[ai][m] = rs_of(ss, row0 + ai * 128 + m * 16);
        if (fr == 0 || fr == 15) {
#pragma unroll
            for (int ai = 0; ai < 2; ++ai)
#pragma unroll
                for (int m = 0; m < 4; ++m) { const int rgi = ai * 8 + wr * 4 + m; LAS float* e = ex + (2 * rgi + (fr == 15 ? 1 : 0)) * 128 + chl;
                    *(LAS f32x4*)e = acc[ai][0][m][0] * rsm[ai][m]; *(LAS f32x4*)(e + 4) = acc[ai][0][m][1] * rsm[ai][m]; } }
        asm volatile("s_waitcnt lgkmcnt(0)" ::: "memory"); __builtin_amdgcn_s_barrier(); asm volatile("" ::: "memory");
        const f32x4 w0a = *(const f32x4*)(cw + chg), w0b = *(const f32x4*)(cw + chg + 4), w1a = *(const f32x4*)(cw + FF + chg), w1b = *(const f32x4*)(cw + FF + chg + 4);
        const f32x4 w2a = *(const f32x4*)(cw + 2 * FF + chg), w2b = *(const f32x4*)(cw + 2 * FF + chg + 4), bba = *(const f32x4*)(cb + chg), bbb = *(const f32x4*)(cb + chg + 4);
#pragma unroll
        for (int ai = 0; ai < 2; ++ai)
#pragma unroll
            for (int m = 0; m < 4; ++m) { const int row = row0 + ai * 128 + m * 16; const int rgi = ai * 8 + wr * 4 + m;

                const float sm = rsm[ai][m]; const float su = dpp_up1(sm), sd = dpp_dn1(sm);
                f32x4 gm0 = acc[ai][0][m][0] * sm, gm1 = acc[ai][0][m][1] * sm, gu0, gu1, gd0, gd1;
#pragma unroll
                for (int j = 0; j < 4; ++j) { gu0[j] = dpp_up1(acc[ai][0][m][0][j]) * su; gu1[j] = dpp_up1(acc[ai][0][m][1][j]) * su;
                    gd0[j] = dpp_dn1(acc[ai][0][m][0][j]) * sd; gd1[j] = dpp_dn1(acc[ai][0][m][1][j]) * sd; }
                if (fr == 0) {
                    if (rgi > 0) { const LAS float* e = ex + (2 * (rgi - 1) + 1) * 128 + chl; gu0 = *(const LAS f32x4*)e; gu1 = *(const LAS f32x4*)(e + 4); } }
                if (fr == 15) {
                    if (rgi < 15) { const LAS float* e = ex + (2 * (rgi + 1)) * 128 + chl; gd0 = *(const LAS f32x4*)e; gd1 = *(const LAS f32x4*)(e + 4); } }
                const f32x4 ga = w0a * gu0 + w1a * gm0 + w2a * gd0 + bba, gb = w0b * gu1 + w1b * gm1 + w2b * gd1 + bbb;
                const f32x4 a0 = acc[ai][1][m][0] * sm, a1 = acc[ai][1][m][1] * sm;
                u32x4 w; w.x = pk2(gelu_t(ga[0]) * a0[0], gelu_t(ga[1]) * a0[1]); w.y = pk2(gelu_t(ga[2]) * a0[2], gelu_t(ga[3]) * a0[3]);
                w.z = pk2(gelu_t(gb[0]) * a1[0], gelu_t(gb[1]) * a1[1]); w.w = pk2(gelu_t(gb[2]) * a1[2], gelu_t(gb[3]) * a1[3]);
                const bool first = (rgi == 0 && fr == 0), last = (rgi == 15 && fr == 15);
                if (!(first || last)) *(u32x4*)(act + (size_t)row * FF + chg) = w;
                if (rgi == 0 && fr <= 1) { float* d = sg + ((size_t)u.pm * 4 + fr) * FF + chg; *(f32x4*)d = gm0; *(f32x4*)(d + 4) = gm1; }
                if (rgi == 15 && fr >= 14) { float* d = sg + ((size_t)u.pm * 4 + (fr - 12)) * FF + chg; *(f32x4*)d = gm0; *(f32x4*)(d + 4) = gm1; }
                if (first || last) { float* d = this->su + ((size_t)u.pm * 2 + (last ? 1 : 0)) * FF + chg; *(f32x4*)d = a0; *(f32x4*)(d + 4) = a1; } }
    }
};

struct Params { const float* in[28]; float* out; unsigned char* ws; };
typedef LAS unsigned* PT;
__device__ __forceinline__ const float* pin(PT t0, int k) { unsigned ta = (unsigned)(size_t)t0; asm volatile("" : "+s"(ta)); const PT t = (PT)(size_t)ta;
    const unsigned lo = __builtin_amdgcn_readfirstlane(t[2 * k]), hi = __builtin_amdgcn_readfirstlane(t[2 * k + 1]); return (const float*)(__attribute__((address_space(1))) const float*)(((unsigned long long)hi << 32) | lo); }
__device__ __forceinline__ float* pout(PT t) { return (float*)pin(t, 28); }
__device__ __forceinline__ unsigned char* pws(PT t) { return (unsigned char*)pin(t, 29); }
enum { I_X = 0, I_P, I_N1G, I_WIN, I_DNCW, I_ALOG, I_DTB, I_DNG, I_LCW, I_LCB, I_LWA, I_LBA, I_LWX, I_LBX, I_LAM, I_LNG, I_WOUT, I_N2G, I_FWG, I_FWU, I_FCW, I_FCB, I_FWD, I_PNG, I_PWG, I_PBG, I_PWP, I_FING };

template <class RM>
__device__ __forceinline__ void tr_item(const float* W, int K, int N, bf16_t* WT, int ldt, const float* gk, const RM& rm, LAS float* scr, int item, int lane) {
    const int nblk = (N + 31) >> 5, kb = item / nblk, nb = item % nblk, k0 = 64 * kb, n0 = 32 * nb;
#pragma unroll 8
    for (int i = 0; i < 32; ++i) { const int kk = 2 * i + (lane >> 5), n = n0 + (lane & 31);
        float v = (n < N) ? W[(size_t)(k0 + kk) * N + n] : 0.f; if (gk) v *= gk[k0 + kk];
        scr[kk * 33 + (lane & 31)] = v; }
    LDS_FENCE();
    const int c = lane & 7;
#pragma unroll
    for (int j = 0; j < 4; ++j) { const int nl = (lane >> 3) + 8 * j, n = n0 + nl; const LAS float* s = scr + (8 * c) * 33 + nl;
        u32x4 o; o.x = pk2(s[0 * 33], s[1 * 33]); o.y = pk2(s[2 * 33], s[3 * 33]); o.z = pk2(s[4 * 33], s[5 * 33]); o.w = pk2(s[6 * 33], s[7 * 33]);
        const int dst = (n < N) ? rm(n) : -1;
        if (dst >= 0) *(u32x4*)(WT + (size_t)dst * ldt + k0 + 8 * c) = o; }
    LDS_FENCE();
}
struct RmId { __device__ __forceinline__ int operator()(int n) const { return n; } };
struct RmGU { int off; __device__ __forceinline__ int operator()(int n) const { return (n >> 7) * 256 + off + (n & 127); } };
struct RmIn { __device__ __forceinline__ int operator()(int n) const {
    if (n < 1536) return n;
    if (n < 2048) return 2048 + (n - 1536);
    if (n < 2064) return 3072 + (n - 2048);
    if (n < 2576) return 1536 + (n - 2064);
    return 2560 + (n - 2576);
} };

__device__ __forceinline__ void prologue(PT pt, LAS unsigned char* lds, int gw, int NGW, int lane, int wave) {
    asm volatile("" : "+v"(lane));
    unsigned char* ws = pws(pt);
    for (int l = 0; l < NL; ++l) { u32x4* z = (u32x4*)((bf16_t*)(ws + WS_WIN) + ((size_t)l * 3328 + 3088) * 1024); const int n4 = 240 * 1024 / 8;
        for (int i = gw * 64 + lane; i < n4; i += NGW * 64) z[i] = (u32x4){0u, 0u, 0u, 0u}; }
    LAS float* scr = (LAS float*)(lds + wave * 16384);
    constexpr int I_IN = 16 * 97, I_OUT = 16 * 32, I_G = 16 * 88, I_D = 44 * 32, I_PG = 16 * 32, I_PP = 4 * 32, I_LA = 32;
    constexpr int PER_L = I_IN + I_OUT + 2 * I_G + I_D + I_PG + I_PP + 2 * I_LA;
    for (int it = gw; it < NL * PER_L; it += NGW) {
        const int l = it / PER_L; int r = it % PER_L;
        if (r < I_IN) { tr_item(pin(pt, I_WIN) + (size_t)l * DM * INC, DM, INC, (bf16_t*)(ws + WS_WIN) + (size_t)l * 3328 * 1024, 1024, pin(pt, I_N1G) + l * DM, RmIn(), scr, r, lane); continue; } r -= I_IN;
        if (r < I_OUT) { tr_item(pin(pt, I_WOUT) + (size_t)l * DM * DM, DM, DM, (bf16_t*)(ws + WS_WOUT) + (size_t)l * DM * DM, 1024, nullptr, RmId(), scr, r, lane); continue; } r -= I_OUT;
        if (r < I_G) { tr_item(pin(pt, I_FWG) + (size_t)l * DM * FF, DM, FF, (bf16_t*)(ws + WS_WG) + (size_t)l * 5632 * 1024, 1024, pin(pt, I_N2G) + l * DM, RmGU{0}, scr, r, lane); continue; } r -= I_G;
        if (r < I_G) { tr_item(pin(pt, I_FWU) + (size_t)l * DM * FF, DM, FF, (bf16_t*)(ws + WS_WG) + (size_t)l * 5632 * 1024, 1024, pin(pt, I_N2G) + l * DM, RmGU{128}, scr, r, lane); continue; } r -= I_G;
        if (r < I_D) { tr_item(pin(pt, I_FWD) + (size_t)l * FF * DM, FF, DM, (bf16_t*)(ws + WS_WD) + (size_t)l * DM * FF, FF, nullptr, RmId(), scr, r, lane); continue; } r -= I_D;
        if (r < I_PG) { tr_item(pin(pt, I_PWG) + (size_t)l * DM * DM, DM, DM, (bf16_t*)(ws + WS_WPG) + (size_t)l * DM * DM, 1024, pin(pt, I_PNG) + l * DM, RmId(), scr, r, lane); continue; } r -= I_PG;
        if (r < I_PP) { tr_item(pin(pt, I_PWP) + (size_t)l * PLE * DM, PLE, DM, (bf16_t*)(ws + WS_WP) + (size_t)l * DM * PLE, PLE, nullptr, RmId(), scr, r, lane); continue; } r -= I_PP;
        { const int gate = r / I_LA; r %= I_LA; const int mat = r >> 1, sub = r & 1;
          const float* src = pin(pt, gate ? I_LWX : I_LWA) + ((size_t)l * 16 + mat) * 4096;
          bf16_t* dst = (bf16_t*)(ws + WS_WAT) + (((size_t)l * 16 + mat) * 2 + gate) * 4096;
          tr_item(src, 64, 64, dst, 64, nullptr, RmId(), scr, sub, lane); }
    }
    const float* x = pin(pt, I_X); bf16_t* rb = (bf16_t*)(ws + WS_RB); float* ss0 = (float*)(ws + WS_SSP); unsigned char* rl = (unsigned char*)pout(pt) + (size_t)128 * MiB;
    for (int m = gw; m < M_TOK; m += NGW) { const f32x4* xr = (const f32x4*)(x + (size_t)m * DM) + lane; u32x2* o = (u32x2*)(rb + (size_t)m * DM) + lane; unsigned* ol = (unsigned*)(rl + (size_t)m * DM) + lane; float s = 0.f;
#pragma unroll
        for (int j = 0; j < 4; ++j) { const f32x4 v = xr[64 * j]; s += (v[0] * v[0] + v[1] * v[1]) + (v[2] * v[2] + v[3] * v[3]); const u32x2 hw = pk4(v); o[64 * j] = hw;
            ol[64 * j] = pk4_fp8(v[0] - bflo(hw.x), v[1] - bfhi(hw.x), v[2] - bflo(hw.y), v[3] - bfhi(hw.y)); }
#pragma unroll
        for (int o2 = 1; o2 < 64; o2 <<= 1) s += __shfl_xor(s, o2);
        if (lane < 4) ss0[(size_t)m * 4 + lane] = lane == 0 ? s : 0.f; }
}

__device__ __forceinline__ void lru_block(PT pt, LAS unsigned char* lds, int bi, int layer, int tid) {
    asm volatile("" : "+v"(tid));
    const int lane = tid & 63, w = tid >> 6;
    unsigned char* ws = pws(pt);
    const int wi = bi * 8 + w;
    const int dq = wi & 3, n = (wi >> 2) & 7, dir = (wi >> 5) & 1, b = wi >> 6;
    const int fr = lane & 15, fq = lane >> 4;
    LAS unsigned char* XCB = lds + (w >> 2) * 8192;
    LAS unsigned char* SCN = lds + 16384 + w * 1024;
    const int ti = lane >> 2, cq = lane & 3;
    const int cch = 64 * n + 16 * dq + 4 * cq;
    f32x4 cw4[4];
#pragma unroll
    for (int tap = 0; tap < 4; ++tap) cw4[tap] = *(const f32x4*)(pin(pt, I_LCW) + ((size_t)layer * 4 + tap) * 512 + cch);
    const f32x4 cb4 = *(const f32x4*)(pin(pt, I_LCB) + (size_t)layer * 512 + cch);
    const bf16_t* wbase = (const bf16_t*)(ws + WS_WAT) + ((((size_t)layer * 2 + dir) * 8 + n) * 2) * 4096;
    bf16x8 Ba[2], Bx[2];
#pragma unroll
    for (int ks = 0; ks < 2; ++ks) { Ba[ks] = *(const bf16x8*)(wbase + (16 * dq + fr) * 64 + 32 * ks + 8 * fq); Bx[ks] = *(const bf16x8*)(wbase + 4096 + (16 * dq + fr) * 64 + 32 * ks + 8 * fq); }
    const int dch = 64 * n + 16 * dq + fr; const size_t pidx = ((size_t)layer * 2 + dir) * 512 + dch;
    const float ba = pin(pt, I_LBA)[pidx], bx = pin(pt, I_LBX)[pidx], sp8 = 8.0f * 1.4426950408889634f * softplus_f(-pin(pt, I_LAM)[pidx]);
    const bf16_t* plx = (const bf16_t*)(ws + WS_PLX) + (size_t)b * SEQ * 512 + cch;
    bf16_t* hout = (bf16_t*)pout(pt) + (size_t)dir * M_TOK * 512 + (size_t)b * SEQ * 512 + dch;
    u32x2 xr[2][4];
#define LRU_LOAD(scn) do { _Pragma("unroll") for (int s_ = 0; s_ < 2; ++s_) { const int tt_ = dir ? (SEQ - 1 - (32 * (scn) + 16 * s_ + ti)) : (32 * (scn) + 16 * s_ + ti); \
        _Pragma("unroll") for (int tap = 0; tap < 4; ++tap) { const int t2_ = tt_ + tap - 2; xr[s_][tap] = (u32x2){0u, 0u}; if (t2_ >= 0 && t2_ < SEQ) xr[s_][tap] = *(const u32x2*)(plx + (size_t)t2_ * 512); } } } while (0)
    LRU_LOAD(0);
    float hprev = 0.f;
    LBAR();
#pragma unroll 1
    for (int sc = 0; sc < 64; ++sc) {
        LAS unsigned char* XC = XCB + (sc & 1) * 4096;
#pragma unroll
        for (int s2 = 0; s2 < 2; ++s2) { f32x4 xa = cb4;
#pragma unroll
            for (int tap = 0; tap < 4; ++tap) { xa[0] += cw4[tap][0] * bflo(xr[s2][tap].x); xa[1] += cw4[tap][1] * bfhi(xr[s2][tap].x); xa[2] += cw4[tap][2] * bflo(xr[s2][tap].y); xa[3] += cw4[tap][3] * bfhi(xr[s2][tap].y); }
            *(LAS u32x2*)(XC + swz64(16 * s2 + ti, 16 * dq + 4 * cq)) = pk4(xa); }
        if (sc + 1 < 64) LRU_LOAD(sc + 1);
        LBAR();
        float Ac[2][4], Hc[2][4];
#pragma unroll
        for (int s2 = 0; s2 < 2; ++s2) {
            const bf16x8 A0 = *(const LAS bf16x8*)(XC + swz64(16 * s2 + fr, 8 * fq)), A1 = *(const LAS bf16x8*)(XC + swz64(16 * s2 + fr, 32 + 8 * fq));
            f32x4 ca = {0.f, 0.f, 0.f, 0.f}, cx = {0.f, 0.f, 0.f, 0.f};
            ca = MFMA16(A0, Ba[0], ca); ca = MFMA16(A1, Ba[1], ca); cx = MFMA16(A0, Bx[0], cx); cx = MFMA16(A1, Bx[1], cx);
#pragma unroll
            for (int jj = 0; jj < 4; ++jj) { const float xv = bf2f(*(const LAS unsigned short*)(XC + swz64(16 * s2 + 4 * fq + jj, 16 * dq + fr)));
                const float r = sigm(ca[jj] + ba), ig = sigm(cx[jj] + bx), a = __builtin_amdgcn_exp2f(-r * sp8);
                const float bt = __builtin_amdgcn_sqrtf(fmaxf(1.0f - a * a, 0.f)) * ig * xv;
                Hc[s2][jj] = jj ? (a * Hc[s2][jj - 1] + bt) : bt; Ac[s2][jj] = jj ? (a * Ac[s2][jj - 1]) : a; }
            *(LAS f32x2*)(SCN + s2 * 512 + (fq * 16 + fr) * 8) = (f32x2){Ac[s2][3], Hc[s2][3]}; }
#pragma unroll
        for (int s2 = 0; s2 < 2; ++s2) {
            const LAS unsigned char* T = SCN + s2 * 512;
            const f32x2 g0 = *(const LAS f32x2*)(T + (0 * 16 + fr) * 8), g1 = *(const LAS f32x2*)(T + (1 * 16 + fr) * 8), g2 = *(const LAS f32x2*)(T + (2 * 16 + fr) * 8), g3 = *(const LAS f32x2*)(T + (3 * 16 + fr) * 8);
            const float h1 = g0.x * hprev + g0.y, h2 = g1.x * h1 + g1.y, h3 = g2.x * h2 + g2.y, h4 = g3.x * h3 + g3.y;
            const float hin = fq == 0 ? hprev : (fq == 1 ? h1 : (fq == 2 ? h2 : h3));
            hprev = h4;
#pragma unroll
            for (int jj = 0; jj < 4; ++jj) { const float hv = Ac[s2][jj] * hin + Hc[s2][jj]; const int i = 16 * s2 + 4 * fq + jj; const int t2 = dir ? (SEQ - 1 - (32 * sc + i)) : (32 * sc + i);
                hout[(size_t)t2 * 512] = (bf16_t)(pk2(hv, 0.f) & 0xffffu); } }
    }
#undef LRU_LOAD
}

constexpr int DP_BUF0 = 0, DP_BUF1 = 49152, DP_KL = 49152, DP_QL = 49152 + 16384, DP_VL = 49152 + 32768, DP_VEC = 98304, DP_CWL = 99328;
__device__ __forceinline__ void dp_item(PT pt, LAS unsigned char* lds, int item, int layer, int tid, int lane, int w) {
    asm volatile("" : "+v"(tid)); lane = tid & 63; asm volatile("" : "+s"(w));
    unsigned char* ws = pws(pt);
    const int b = item >> 7, h = (item >> 5) & 3, n = item & 31;
    const size_t rowbase = (size_t)b * SEQ + 64 * n;
    LAS float* VEC = (LAS float*)(lds + DP_VEC);
    LBAR();
    f32x4 gpre = {0.f, 0.f, 0.f, 0.f};
    if (w == 0) { const float* gp = (const float*)(ws + WS_GATES) + (rowbase + lane) * 16 + h; gpre[0] = gp[0]; gpre[1] = gp[4]; gpre[2] = gp[8]; gpre[3] = gp[12]; }
    { const int i = tid >> 3, c = tid & 7; const int t = 64 * n + i; const size_t R = rowbase + i;
      const bf16_t* pq = (const bf16_t*)(ws + WS_PQKV);
      u32x4 xin[3][4][2];
#pragma unroll
      for (int mat = 0; mat < 3; ++mat)
#pragma unroll
          for (int tap = 0; tap < 4; ++tap) { const int t2 = t + tap - 2; xin[mat][tap][0] = (u32x4){0u, 0u, 0u, 0u}; xin[mat][tap][1] = (u32x4){0u, 0u, 0u, 0u};
              if (t2 >= 0 && t2 < SEQ) { const bf16_t* xp = pq + (R + tap - 2) * 1536 + mat * 512 + h * 128 + 16 * c; xin[mat][tap][0] = *(const u32x4*)xp; xin[mat][tap][1] = *(const u32x4*)(xp + 8); } }
#pragma unroll
      for (int mat = 0; mat < 3; ++mat) {
          f32x4 a[4] = {{0.f, 0.f, 0.f, 0.f}, {0.f, 0.f, 0.f, 0.f}, {0.f, 0.f, 0.f, 0.f}, {0.f, 0.f, 0.f, 0.f}};
#pragma unroll
          for (int tap = 0; tap < 4; ++tap) { const u32x4 x0 = xin[mat][tap][0], x1 = xin[mat][tap][1];
              const LAS float* wp = (const LAS float*)(lds + DP_CWL) + (mat * 4 + tap) * 128 + 16 * c; const f32x4 w0 = *(const LAS f32x4*)wp, w1 = *(const LAS f32x4*)(wp + 4), w2 = *(const LAS f32x4*)(wp + 8), w3 = *(const LAS f32x4*)(wp + 12);
              a[0][0] += w0[0] * bflo(x0.x); a[0][1] += w0[1] * bfhi(x0.x); a[0][2] += w0[2] * bflo(x0.y); a[0][3] += w0[3] * bfhi(x0.y);
              a[1][0] += w1[0] * bflo(x0.z); a[1][1] += w1[1] * bfhi(x0.z); a[1][2] += w1[2] * bflo(x0.w); a[1][3] += w1[3] * bfhi(x0.w);
              a[2][0] += w2[0] * bflo(x1.x); a[2][1] += w2[1] * bfhi(x1.x); a[2][2] += w2[2] * bflo(x1.y); a[2][3] += w2[3] * bfhi(x1.y);
              a[3][0] += w3[0] * bflo(x1.z); a[3][1] += w3[1] * bfhi(x1.z); a[3][2] += w3[2] * bflo(x1.w); a[3][3] += w3[3] * bfhi(x1.w); }
          float ssq = 0.f;
#pragma unroll
          for (int q = 0; q < 4; ++q)
#pragma unroll
              for (int e = 0; e < 4; ++e) { const float v = a[q][e]; const float sv = v * sigm(v); a[q][e] = sv; ssq += sv * sv; }
          float scale = 1.f;
          if (mat < 2) { ssq += __shfl_xor(ssq, 1); ssq += __shfl_xor(ssq, 2); ssq += __shfl_xor(ssq, 4); scale = rsqrtf(ssq + EPS); if (mat == 0) scale *= 0.08838834764831845f; }
          u32x4 o0, o1; o0.x = pk2(a[0][0] * scale, a[0][1] * scale); o0.y = pk2(a[0][2] * scale, a[0][3] * scale); o0.z = pk2(a[1][0] * scale, a[1][1] * scale); o0.w = pk2(a[1][2] * scale, a[1][3] * scale);
          o1.x = pk2(a[2][0] * scale, a[2][1] * scale); o1.y = pk2(a[2][2] * scale, a[2][3] * scale); o1.z = pk2(a[3][0] * scale, a[3][1] * scale); o1.w = pk2(a[3][2] * scale, a[3][3] * scale);
          const int lbase = (mat == 0) ? DP_QL : (mat == 1 ? DP_KL : DP_VL);
          *(LAS u32x4*)(lds + lbase + swz128(i, 16 * c)) = o0; *(LAS u32x4*)(lds + lbase + swz128(i, 16 * c + 8)) = o1;
          if (mat < 2) { bf16_t* gp = (bf16_t*)(ws + (mat == 0 ? WS_QH : WS_KH)) + R * 512 + h * 128 + 16 * c; *(u32x4*)gp = o0; *(u32x4*)(gp + 8) = o1; } }
    }
    if (w == 0) {
        const float bF = sigm(gpre[0]), bB = sigm(gpre[1]);
        float gF = -expf(pin(pt, I_ALOG)[layer * 8 + h]) * softplus_f(gpre[2] + pin(pt, I_DTB)[layer * 8 + h]);
        float gB = -expf(pin(pt, I_ALOG)[layer * 8 + 4 + h]) * softplus_f(gpre[3] + pin(pt, I_DTB)[layer * 8 + 4 + h]);
#pragma unroll
        for (int off = 1; off < 64; off <<= 1) { const float v = __shfl_up(gF, off); if (lane >= off) gF += v; const float u = __shfl_down(gB, off); if (lane + off < 64) gB += u; }
        const float glF = __shfl(gF, 63), glB = __shfl(gB, 0);
        VEC[lane] = bF; VEC[64 + lane] = gF; VEC[128 + lane] = bB; VEC[192 + lane] = gB;
        float* v0 = (float*)(ws + WS_VEC) + (size_t)item * 256; float* v1 = v0 + (size_t)4096 * 256;
        v0[lane] = bF; v0[64 + lane] = fexp(gF); v0[128 + lane] = fexp(glF - gF); if (lane == 0) v0[192] = fexp(glF);
        v1[lane] = bB; v1[64 + lane] = fexp(gB); v1[128 + lane] = fexp(glB - gB); if (lane == 0) v1[192] = fexp(glB);
    }
    LBAR();
    { const int e = tid >> 2, jq = tid & 3; unsigned vv[8];
#pragma unroll
      for (int p = 0; p < 8; ++p) { const unsigned lo = *(const LAS unsigned short*)(lds + DP_VL + swz128(16 * jq + 2 * p, e)), hi = *(const LAS unsigned short*)(lds + DP_VL + swz128(16 * jq + 2 * p + 1, e)); vv[p] = lo | (hi << 16); }
      bf16_t* gp = (bf16_t*)(ws + WS_VT) + (size_t)item * 8192 + e * 64 + 16 * jq;
      *(u32x4*)gp = (u32x4){vv[0], vv[1], vv[2], vv[3]}; *(u32x4*)(gp + 8) = (u32x4){vv[4], vv[5], vv[6], vv[7]}; }
    const int r32 = lane & 31, hi = lane >> 5;
    { const int kind = w >> 2, q = w & 3, ta = q >> 1, tb = q & 1;
      f32x16 acc; for (int r = 0; r < 16; ++r) acc[r] = 0.f;
      const int bbase = kind ? DP_QL : DP_KL;
#pragma unroll
      for (int ks = 0; ks < 8; ++ks) { const bf16x8 av = *(const LAS bf16x8*)(lds + DP_KL + swz128(32 * ta + r32, 16 * ks + 8 * hi)), bv = *(const LAS bf16x8*)(lds + bbase + swz128(32 * tb + r32, 16 * ks + 8 * hi)); acc = MFMA32(av, bv, acc); }
      const int gb = 32 * tb + r32;
#pragma unroll
      for (int dir = 0; dir < 2; ++dir) { const LAS float* bet = VEC + dir * 128; const LAS float* gc = VEC + dir * 128 + 64;
          const float gcl = gc[gb], betl = bet[gb];
#pragma unroll
          for (int g = 0; g < 4; ++g) { const int ga0 = 32 * ta + 8 * g + 4 * hi; const f32x4 gca = *(const LAS f32x4*)(gc + ga0), bea = *(const LAS f32x4*)(bet + ga0);
              if (kind == 0) { f32x4 xv, yv, pv;
#pragma unroll
                  for (int jj = 0; jj < 4; ++jj) { const int ga = ga0 + jj; const float kk = acc[4 * g + jj];
                      const bool mx = dir ? (gb < ga) : (gb > ga), my = dir ? (ga < gb) : (ga > gb);
                      const float ed = kk * fexp(-fabsf(gcl - gca[jj]));
                      xv[jj] = mx ? (-betl * ed) : 0.f; yv[jj] = my ? (-bea[jj] * ed) : 0.f; pv[jj] = (ga == gb) ? 1.f : 0.f; }
                  LAS unsigned char* bb = lds + DP_BUF0 + dir * 24576 + swz64(gb, ga0);
                  *(LAS u32x2*)bb = pk4(xv); *(LAS u32x2*)(bb + 8192) = pk4(yv); *(LAS u32x2*)(bb + 16384) = pk4(pv);
              } else { f32x4 av4;
#pragma unroll
                  for (int jj = 0; jj < 4; ++jj) { const int ga = ga0 + jj; const bool ma = dir ? (gb <= ga) : (gb >= ga); av4[jj] = ma ? (acc[4 * g + jj] * fexp(-fabsf(gcl - gca[jj]))) : 0.f; }
                  *(u32x2*)((bf16_t*)(ws + WS_AT) + ((size_t)dir * 4096 + item) * 4096 + gb * 64 + ga0) = pk4(av4); } } }
    }
    LBAR();
    { const int dir = w >> 2, q = w & 3, ti = q >> 1, tj = q & 1;
      f32x16 pacc; for (int r = 0; r < 16; ++r) pacc[r] = (32 * tj + crow(r, hi) == 32 * ti + r32) ? 1.f : 0.f;
#pragma unroll 1
      for (int rd = 0; rd < 6; ++rd) { LAS unsigned char* cur = lds + ((rd & 1) ? DP_BUF1 : DP_BUF0) + dir * 24576; LAS unsigned char* nxt = lds + ((rd & 1) ? DP_BUF0 : DP_BUF1) + dir * 24576;
          bf16x8 xf[4], yf[4], pf[4];
#pragma unroll
          for (int ks = 0; ks < 4; ++ks) { xf[ks] = *(const LAS bf16x8*)(cur + swz64(32 * ti + r32, 16 * ks + 8 * hi)); yf[ks] = *(const LAS bf16x8*)(cur + 8192 + swz64(32 * tj + r32, 16 * ks + 8 * hi)); pf[ks] = *(const LAS bf16x8*)(cur + 16384 + swz64(32 * ti + r32, 16 * ks + 8 * hi)); }
#pragma unroll
          for (int ks = 0; ks < 4; ++ks) pacc = MFMA32(yf[ks], pf[ks], pacc);
          if (rd < 5) { f32x16 xa, ya; for (int r = 0; r < 16; ++r) { xa[r] = 0.f; ya[r] = 0.f; }
#pragma unroll
              for (int ks = 0; ks < 4; ++ks) { xa = MFMA32(yf[ks], xf[ks], xa); ya = MFMA32(xf[ks], yf[ks], ya); }
#pragma unroll
              for (int g = 0; g < 4; ++g) { const int c0 = 8 * g + 4 * hi;
                  *(LAS u32x2*)(nxt + swz64(32 * ti + r32, 32 * tj + c0)) = pk4((f32x4){xa[4 * g], xa[4 * g + 1], xa[4 * g + 2], xa[4 * g + 3]});
                  *(LAS u32x2*)(nxt + 8192 + swz64(32 * tj + r32, 32 * ti + c0)) = pk4((f32x4){ya[4 * g], ya[4 * g + 1], ya[4 * g + 2], ya[4 * g + 3]});
                  *(LAS u32x2*)(nxt + 16384 + swz64(32 * ti + r32, 32 * tj + c0)) = pk4((f32x4){pacc[4 * g], pacc[4 * g + 1], pacc[4 * g + 2], pacc[4 * g + 3]}); }
              LBAR(); } }
      bf16_t* tg = (bf16_t*)(ws + WS_TM) + ((size_t)dir * 4096 + item) * 4096 + (32 * ti + r32) * 64 + 32 * tj + 4 * hi;
#pragma unroll
      for (int g = 0; g < 4; ++g) *(u32x2*)(tg + 8 * g) = pk4((f32x4){pacc[4 * g], pacc[4 * g + 1], pacc[4 * g + 2], pacc[4 * g + 3]});
    }
}

constexpr int DR_K = 0, DR_Q = 16384, DR_KT = 32768, DR_VT = 49152, DR_T = 65536, DR_A = 73728, DR_VEC = 81920, DR_PRIV = 83968;
__device__ __forceinline__ void dr_item(PT pt, LAS unsigned char* lds, int item, int tid, int lane, int w) {
    asm volatile("" : "+v"(tid)); lane = tid & 63; asm volatile("" : "+s"(w));
    unsigned char* ws = pws(pt);
    const int dir = item & 1, h = (item >> 1) & 3, b = item >> 3;
    const int fr = lane & 15, fq = lane >> 4, es = 16 * w;
    LAS unsigned char* ST = lds + DR_PRIV + w * 8192; LAS unsigned char* RV = ST + 4096; LAS unsigned char* VN2 = ST + 6144;
    const LAS float* VEC = (const LAS float*)(lds + DR_VEC);
    const bf16_t* kh = (const bf16_t*)(ws + WS_KH) + (size_t)b * SEQ * 512 + h * 128;
    const bf16_t* qh = (const bf16_t*)(ws + WS_QH) + (size_t)b * SEQ * 512 + h * 128;
    const int ibase = (b * 4 + h) * 32;
    const bf16_t* vt = (const bf16_t*)(ws + WS_VT) + (size_t)ibase * 8192;
    const bf16_t* tm = (const bf16_t*)(ws + WS_TM) + ((size_t)dir * 4096 + ibase) * 4096;
    const bf16_t* at = (const bf16_t*)(ws + WS_AT) + ((size_t)dir * 4096 + ibase) * 4096;
    const float* vecs = (const float*)(ws + WS_VEC) + ((size_t)dir * 4096 + ibase) * 256;
    bf16_t* og = (bf16_t*)(ws + (dir ? WS_OB : WS_OF)) + (size_t)b * SEQ * 512 + h * 128 + es + fr;
    u32x4 pk[2], pq[2], pv[2], ptm, pa; f32x4 pvec = {0.f, 0.f, 0.f, 0.f};
#define DR_LOAD(nn) do { _Pragma("unroll") for (int u_ = 0; u_ < 2; ++u_) { const int p_ = tid + 512 * u_; \
        pk[u_] = *(const u32x4*)(kh + (size_t)(64 * (nn) + (p_ >> 4)) * 512 + 8 * (p_ & 15)); pq[u_] = *(const u32x4*)(qh + (size_t)(64 * (nn) + (p_ >> 4)) * 512 + 8 * (p_ & 15)); \
        pv[u_] = *(const u32x4*)(vt + (size_t)(nn) * 8192 + p_ * 8); } \
        ptm = *(const u32x4*)(tm + (size_t)(nn) * 4096 + tid * 8); pa = *(const u32x4*)(at + (size_t)(nn) * 4096 + tid * 8); \
        if (tid < 64) pvec = *(const f32x4*)(vecs + (size_t)(nn) * 256 + 4 * tid); } while (0)
#define DR_STORE() do { _Pragma("unroll") for (int u_ = 0; u_ < 2; ++u_) { const int p_ = tid + 512 * u_; const int j_ = p_ >> 4, q_ = p_ & 15; \
        *(LAS u32x4*)(lds + DR_K + swz128(j_, 8 * q_)) = pk[u_]; *(LAS u32x4*)(lds + DR_Q + swz128(j_, 8 * q_)) = pq[u_]; \
        *(LAS unsigned short*)(lds + DR_KT + swz64(8 * q_ + 0, j_)) = (unsigned short)(pk[u_].x & 0xffffu); *(LAS unsigned short*)(lds + DR_KT + swz64(8 * q_ + 1, j_)) = (unsigned short)(pk[u_].x >> 16); \
        *(LAS unsigned short*)(lds + DR_KT + swz64(8 * q_ + 2, j_)) = (unsigned short)(pk[u_].y & 0xffffu); *(LAS unsigned short*)(lds + DR_KT + swz64(8 * q_ + 3, j_)) = (unsigned short)(pk[u_].y >> 16); \
        *(LAS unsigned short*)(lds + DR_KT + swz64(8 * q_ + 4, j_)) = (unsigned short)(pk[u_].z & 0xffffu); *(LAS unsigned short*)(lds + DR_KT + swz64(8 * q_ + 5, j_)) = (unsigned short)(pk[u_].z >> 16); \
        *(LAS unsigned short*)(lds + DR_KT + swz64(8 * q_ + 6, j_)) = (unsigned short)(pk[u_].w & 0xffffu); *(LAS unsigned short*)(lds + DR_KT + swz64(8 * q_ + 7, j_)) = (unsigned short)(pk[u_].w >> 16); \
        *(LAS u32x4*)(lds + DR_VT + swz64(p_ >> 3, 8 * (p_ & 7))) = pv[u_]; } \
        *(LAS u32x4*)(lds + DR_T + swz64(tid >> 3, 8 * (tid & 7))) = ptm; *(LAS u32x4*)(lds + DR_A + swz64(tid >> 3, 8 * (tid & 7))) = pa; \
        if (tid < 64) *(LAS f32x4*)(lds + DR_VEC + 16 * tid) = pvec; } while (0)
    LBAR();
    DR_LOAD(dir ? 31 : 0);
    DR_STORE();
#pragma unroll
    for (int q = 0; q < 4; ++q) *(LAS u32x4*)(ST + lane * 64 + q * 16) = (u32x4){0u, 0u, 0u, 0u};
    f32x4 Sacc[8];
#pragma unroll
    for (int d = 0; d < 8; ++d) Sacc[d] = (f32x4){0.f, 0.f, 0.f, 0.f};
    LBAR();
#pragma unroll 1
    for (int cc = 0; cc < 32; ++cc) { const int n = dir ? (31 - cc) : cc;
        if (cc + 1 < 32) DR_LOAD(dir ? (30 - cc) : (cc + 1));
        bf16x8 sb[4];
#pragma unroll
        for (int ks = 0; ks < 4; ++ks) sb[ks] = *(const LAS bf16x8*)(ST + swz128(fr, 32 * ks + 8 * fq));
        f32x4 oacc[4];
#pragma unroll
        for (int it = 0; it < 4; ++it) { f32x4 ka = {0.f, 0.f, 0.f, 0.f}, qa = {0.f, 0.f, 0.f, 0.f};
#pragma unroll
            for (int ks = 0; ks < 4; ++ks) { const bf16x8 a1 = *(const LAS bf16x8*)(lds + DR_K + swz128(16 * it + fr, 32 * ks + 8 * fq)), a2 = *(const LAS bf16x8*)(lds + DR_Q + swz128(16 * it + fr, 32 * ks + 8 * fq));
                ka = MFMA16(a1, sb[ks], ka); qa = MFMA16(a2, sb[ks], qa); }
            const int i0 = 16 * it + 4 * fq; const f32x4 be = *(const LAS f32x4*)(VEC + i0), eg = *(const LAS f32x4*)(VEC + 64 + i0);
            const u32x2 vv = *(const LAS u32x2*)(lds + DR_VT + swz64(es + fr, i0));
            f32x4 rh; rh[0] = be[0] * (bflo(vv.x) - eg[0] * ka[0]); rh[1] = be[1] * (bfhi(vv.x) - eg[1] * ka[1]); rh[2] = be[2] * (bflo(vv.y) - eg[2] * ka[2]); rh[3] = be[3] * (bfhi(vv.y) - eg[3] * ka[3]);
            *(LAS u32x2*)(RV + swz64(fr, i0)) = pk4(rh);
            oacc[it] = qa * eg; }
        bf16x8 rb2[2];
#pragma unroll
        for (int ks = 0; ks < 2; ++ks) rb2[ks] = *(const LAS bf16x8*)(RV + swz64(fr, 32 * ks + 8 * fq));
        f32x4 vn[4];
#pragma unroll
        for (int it = 0; it < 4; ++it) { vn[it] = (f32x4){0.f, 0.f, 0.f, 0.f};
#pragma unroll
            for (int ks = 0; ks < 2; ++ks) { const bf16x8 a1 = *(const LAS bf16x8*)(lds + DR_T + swz64(16 * it + fr, 32 * ks + 8 * fq)); vn[it] = MFMA16(a1, rb2[ks], vn[it]); } }
#pragma unroll
        for (int it = 0; it < 4; ++it) { const int i0 = 16 * it + 4 * fq; const f32x4 ed = *(const LAS f32x4*)(VEC + 128 + i0);
            *(LAS u32x2*)(RV + swz64(fr, i0)) = pk4(vn[it]); *(LAS u32x2*)(VN2 + swz64(fr, i0)) = pk4(vn[it] * ed); }
        bf16x8 vb[2], vb2[2];
#pragma unroll
        for (int ks = 0; ks < 2; ++ks) { vb[ks] = *(const LAS bf16x8*)(RV + swz64(fr, 32 * ks + 8 * fq)); vb2[ks] = *(const LAS bf16x8*)(VN2 + swz64(fr, 32 * ks + 8 * fq)); }
#pragma unroll
        for (int it = 0; it < 4; ++it)
#pragma unroll
            for (int ks = 0; ks < 2; ++ks) { const bf16x8 a1 = *(const LAS bf16x8*)(lds + DR_A + swz64(16 * it + fr, 32 * ks + 8 * fq)); oacc[it] = MFMA16(a1, vb[ks], oacc[it]); }
        const float cdec = VEC[192];
#pragma unroll
        for (int dt = 0; dt < 8; ++dt) { Sacc[dt] = Sacc[dt] * cdec;
#pragma unroll
            for (int ks = 0; ks < 2; ++ks) { const bf16x8 a1 = *(const LAS bf16x8*)(lds + DR_KT + swz64(16 * dt + fr, 32 * ks + 8 * fq)); Sacc[dt] = MFMA16(a1, vb2[ks], Sacc[dt]); }
            *(LAS u32x2*)(ST + swz128(fr, 16 * dt + 4 * fq)) = pk4(Sacc[dt]); }
#pragma unroll
        for (int it = 0; it < 4; ++it)
#pragma unroll
            for (int jj = 0; jj < 4; ++jj) og[(size_t)(64 * n + 16 * it + 4 * fq + jj) * 512] = (bf16_t)(pk2(oacc[it][jj], 0.f) & 0xffffu);
        LBAR();
        if (cc + 1 < 32) DR_STORE();
        LBAR();
    }
#undef DR_LOAD
#undef DR_STORE
}

__device__ __forceinline__ void m2_rows(PT pt, int layer, int gw, int NGW, int lane) {
    asm volatile("" : "+v"(lane));
    unsigned char* ws = pws(pt);
    const bf16_t* of = (const bf16_t*)(ws + WS_OF); const bf16_t* ob = (const bf16_t*)(ws + WS_OB); const bf16_t* pz = (const bf16_t*)(ws + WS_PZ);
    const bf16_t* hf = (const bf16_t*)pout(pt); const bf16_t* hb = hf + (size_t)M_TOK * 512; const bf16_t* plg = (const bf16_t*)(ws + WS_PLG);
    bf16_t* amix = (bf16_t*)(ws + WS_AMIX);
    const float* dng = pin(pt, I_DNG) + layer * 128 + 8 * (lane & 15); const float* lng = pin(pt, I_LNG) + layer * 512 + 8 * lane;
    const f32x4 dg0 = *(const f32x4*)dng, dg1 = *(const f32x4*)(dng + 4), lg0 = *(const f32x4*)lng, lg1 = *(const f32x4*)(lng + 4);
    for (int m0 = gw; m0 < M_TOK; m0 += 2 * NGW) {
        u32x4 av[2], bv[2], zv[2], cv[2], dv[2], gv[2];
#pragma unroll
        for (int r = 0; r < 2; ++r) { const int m = m0 + r * NGW; if (m < M_TOK) { const size_t o = (size_t)m * 512 + 8 * lane;
            av[r] = *(const u32x4*)(of + o); bv[r] = *(const u32x4*)(ob + o); zv[r] = *(const u32x4*)(pz + o); cv[r] = *(const u32x4*)(hf + o); dv[r] = *(const u32x4*)(hb + o); gv[r] = *(const u32x4*)(plg + o); } }
#pragma unroll
        for (int r = 0; r < 2; ++r) { const int m = m0 + r * NGW; if (m < M_TOK) {
        const u32x4 a = av[r], b2 = bv[r], z = zv[r], c = cv[r], d = dv[r], g = gv[r];
        float v[8], y[8];
        v[0] = bflo(a.x) + bflo(b2.x); v[1] = bfhi(a.x) + bfhi(b2.x); v[2] = bflo(a.y) + bflo(b2.y); v[3] = bfhi(a.y) + bfhi(b2.y);
        v[4] = bflo(a.z) + bflo(b2.z); v[5] = bfhi(a.z) + bfhi(b2.z); v[6] = bflo(a.w) + bflo(b2.w); v[7] = bfhi(a.w) + bfhi(b2.w);
        float s1 = 0.f;
#pragma unroll
        for (int e = 0; e < 8; ++e) s1 += v[e] * v[e];
        s1 += __shfl_xor(s1, 1); s1 += __shfl_xor(s1, 2); s1 += __shfl_xor(s1, 4); s1 += __shfl_xor(s1, 8);
        const float r1 = rsqrtf(s1 * (1.0f / 128.0f) + EPS);
        float zz[8] = {bflo(z.x), bfhi(z.x), bflo(z.y), bfhi(z.y), bflo(z.z), bfhi(z.z), bflo(z.w), bfhi(z.w)};
        float gg[8] = {bflo(g.x), bfhi(g.x), bflo(g.y), bfhi(g.y), bflo(g.z), bfhi(g.z), bflo(g.w), bfhi(g.w)};
        float hh[8] = {bflo(c.x) + bflo(d.x), bfhi(c.x) + bfhi(d.x), bflo(c.y) + bflo(d.y), bfhi(c.y) + bfhi(d.y), bflo(c.z) + bflo(d.z), bfhi(c.z) + bfhi(d.z), bflo(c.w) + bflo(d.w), bfhi(c.w) + bfhi(d.w)};
        float s2 = 0.f;
#pragma unroll
        for (int e = 0; e < 8; ++e) { const float dgv = e < 4 ? dg0[e & 3] : dg1[e & 3]; v[e] = v[e] * r1 * dgv * (zz[e] * sigm(zz[e])); y[e] = gelu_t(gg[e]) * hh[e]; s2 += y[e] * y[e]; }
#pragma unroll
        for (int o2 = 1; o2 < 64; o2 <<= 1) s2 += __shfl_xor(s2, o2);
        const float r2 = rsqrtf(s2 * (1.0f / 512.0f) + EPS);
#pragma unroll
        for (int e = 0; e < 8; ++e) { const float lgv = e < 4 ? lg0[e & 3] : lg1[e & 3]; y[e] = y[e] * r2 * lgv; }
        u32x4 w1, w2; w1.x = pk2(v[0], v[1]); w1.y = pk2(v[2], v[3]); w1.z = pk2(v[4], v[5]); w1.w = pk2(v[6], v[7]);
        w2.x = pk2(y[0], y[1]); w2.y = pk2(y[2], y[3]); w2.z = pk2(y[4], y[5]); w2.w = pk2(y[6], y[7]);
        *(u32x4*)(amix + (size_t)m * 1024 + 8 * lane) = w1; *(u32x4*)(amix + (size_t)m * 1024 + 512 + 8 * lane) = w2; } }
    }
}

__device__ __forceinline__ void glu_fixup(PT pt, int layer, int bx, int G, int tid) {
    asm volatile("" : "+v"(tid));
    unsigned char* ws = pws(pt);
    const float* sg = (const float*)(ws + WS_G); const float* su = sg + (size_t)256 * 4 * FF; bf16_t* act = (bf16_t*)(ws + WS_ACT);
    const float* cw = pin(pt, I_FCW) + (size_t)layer * 3 * FF; const float* cb = pin(pt, I_FCB) + (size_t)layer * FF;
    for (int e = bx * 512 + tid; e < 512 * (FF / 4); e += G * 512) { const int edge = e / (FF / 4), ch = (e % (FF / 4)) * 4; const int pm = edge >> 1, side = edge & 1;
        const int row = 256 * pm + (side ? 255 : 0); const int t = row & (SEQ - 1);
        const f32x4 gmid = *(const f32x4*)(sg + ((size_t)pm * 4 + (side ? 3 : 0)) * FF + ch);
        f32x4 gup = {0.f, 0.f, 0.f, 0.f}, gdn = {0.f, 0.f, 0.f, 0.f};
        if (side == 0) { gdn = *(const f32x4*)(sg + ((size_t)pm * 4 + 1) * FF + ch); if (t != 0) gup = *(const f32x4*)(sg + ((size_t)(pm - 1) * 4 + 3) * FF + ch); }
        else { gup = *(const f32x4*)(sg + ((size_t)pm * 4 + 2) * FF + ch); if (t != SEQ - 1) gdn = *(const f32x4*)(sg + ((size_t)(pm + 1) * 4 + 0) * FF + ch); }
        const f32x4 uu = *(const f32x4*)(su + ((size_t)pm * 2 + side) * FF + ch);
        const f32x4 w0 = *(const f32x4*)(cw + ch), w1 = *(const f32x4*)(cw + FF + ch), w2 = *(const f32x4*)(cw + 2 * FF + ch), bb = *(const f32x4*)(cb + ch);
        const f32x4 ga = w0 * gup + w1 * gmid + w2 * gdn + bb;
        u32x2 o; o.x = pk2(gelu_t(ga[0]) * uu[0], gelu_t(ga[1]) * uu[1]); o.y = pk2(gelu_t(ga[2]) * uu[2], gelu_t(ga[3]) * uu[3]);
        *(u32x2*)(act + (size_t)row * FF + ch) = o; }
}

#define XB_TMO      128
#define XB_XCNT(j)  (256  + 64 * (j))
#define XB_XSUB(j)  (1280 + 64 * (j))
#define XB_XGEN(j)  (2304 + 64 * (j))
#define XB_TOP      3328
#define XB_TOPGEN   3392
#define XCD_BAR_WORDS 3456
#define XB_SPIN_CAP (1u << 18)

__device__ __forceinline__ unsigned xb_ld(unsigned* p)              { return __hip_atomic_load(p, __ATOMIC_RELAXED, __HIP_MEMORY_SCOPE_AGENT); }
__device__ __forceinline__ unsigned xb_add(unsigned* p, unsigned v) { return __hip_atomic_fetch_add(p, v, __ATOMIC_RELAXED, __HIP_MEMORY_SCOPE_AGENT); }
__device__ __forceinline__ unsigned xb_xcc_id() { return (unsigned)__builtin_amdgcn_s_getreg((3 << 11) | 20) & 0xFu; }
#define XB_SPIN(cond, bar) do { unsigned _sp = 0; while (cond) { __builtin_amdgcn_s_sleep(1); \
    if ((++_sp & 255u) == 0u) { if (xb_ld(&(bar)[XB_TMO])) break; if (_sp > XB_SPIN_CAP) { atomicAdd(&(bar)[XB_TMO], 1u); break; } } } } while (0)

struct XcdBarrier {
    unsigned* bar; unsigned x;
    volatile LAS unsigned* st;
};

__device__ __forceinline__ XcdBarrier xcd_barrier_post(unsigned* bar, volatile LAS unsigned* st) {
    XcdBarrier b; b.bar = bar; b.x = xb_xcc_id(); b.st = st;
    if (threadIdx.x == 0) (void)xb_add(&bar[XB_XCNT(b.x)], 1u);
    return b;
}
__device__ __forceinline__ void xcd_barrier_complete(unsigned* bar, unsigned x, unsigned& nloc, unsigned& nx) {
    const unsigned G = gridDim.x * gridDim.y * gridDim.z;
    unsigned sum, cnt, mine, sp = 0u;
    for (;;) {
        sum = 0u; cnt = 0u; mine = 0u;
#pragma unroll
        for (unsigned j = 0; j < 16; ++j) { const unsigned c = xb_ld(&bar[XB_XCNT(j)]); sum += c; cnt += (c > 0u) ? 1u : 0u; mine = (j == x) ? c : mine; }
        if (sum == G) break;
        __builtin_amdgcn_s_sleep(1);
        if ((++sp & 255u) == 0u) { if (xb_ld(&bar[XB_TMO])) break; if (sp > XB_SPIN_CAP) { atomicAdd(&bar[XB_TMO], 1u); break; } }
    }
    nloc = mine > 0u ? mine : 1u; nx = cnt > 0u ? cnt : 1u;
}

__device__ __forceinline__ void xcd_barrier(const XcdBarrier& b) {
    asm volatile("s_waitcnt vmcnt(0)" ::: "memory");
    __syncthreads();
    if (threadIdx.x == 0) {
        unsigned* bar = b.bar;
        __builtin_amdgcn_s_waitcnt(0);
        unsigned nloc = b.st[0], nx = b.st[1];
        if (nloc == 0u) { xcd_barrier_complete(bar, b.x, nloc, nx); b.st[0] = nloc; b.st[1] = nx; }
        const unsigned old = xb_add(&bar[XB_XSUB(b.x)], 1u);
        const unsigned gen = old / nloc;
        if (old + 1u == (gen + 1u) * nloc) {
            __builtin_amdgcn_fence(__ATOMIC_RELEASE, "agent");
            asm volatile("s_waitcnt vmcnt(0)" ::: "memory");
            const unsigned og = xb_add(&bar[XB_TOP], 1u);
            const unsigned tg = og / nx;
            if (og + 1u == (tg + 1u) * nx) xb_add(&bar[XB_TOPGEN], 1u);
            else XB_SPIN(xb_ld(&bar[XB_TOPGEN]) == tg, bar);
            __builtin_amdgcn_fence(__ATOMIC_ACQUIRE, "agent");
            xb_add(&bar[XB_XGEN(b.x)], 1u);
            asm volatile("s_waitcnt vmcnt(0)" ::: "memory");
        } else {
            XB_SPIN(xb_ld(&bar[XB_XGEN(b.x)]) == gen, bar);
            __builtin_amdgcn_fence(__ATOMIC_ACQUIRE, "agent");
            asm volatile("s_waitcnt vmcnt(0)" ::: "memory");
        }
    }
    __syncthreads();
}

#ifndef PHMASK
#define PHMASK 0xFFFF
#endif
#ifndef DUPMASK
#define DUPMASK 0
#endif
#define PH(k) _Pragma("unroll 1") for (int rep_ = 0; rep_ < ((((PHMASK >> (k)) & 1) ? 1 : 0) + (((DUPMASK >> (k)) & 1) ? 1 : 0)); ++rep_)
#define GRID_BAR() do { XcdBarrier b_; b_.bar = (unsigned*)pws(pt); b_.x = xb_xcc_id(); b_.st = (volatile LAS unsigned*)(lds + LDS_BYTES - 512); xcd_barrier(b_); } while (0)
#ifndef TMASK
#define TMASK 0
#endif
#define TS_BEGIN(k) do { if (((TMASK >> (k)) & 1) && bx == 0 && tid == 0) { const unsigned long long t_ = __builtin_amdgcn_s_memrealtime(); *(volatile LAS unsigned*)(lds + LDS_BYTES - 128) = (unsigned)t_; } } while (0)
#define TS_END(k) do { if (((TMASK >> (k)) & 1) && bx == 0 && tid == 0) { const unsigned t_ = (unsigned)__builtin_amdgcn_s_memrealtime(); volatile LAS unsigned* a_ = (volatile LAS unsigned*)(lds + LDS_BYTES - 128); a_[1] += t_ - a_[0]; } } while (0)
#ifndef STAG
#define STAG 0
#endif
#define STAGGER(step_10ns) do { if (STAG) { const unsigned sg_ = ((unsigned)bx >> 3) & 1u; if (sg_) { const unsigned long long t0_ = __builtin_amdgcn_s_memrealtime(); \
        while (__builtin_amdgcn_s_memrealtime() - t0_ < (unsigned long long)(sg_ * (step_10ns))) __builtin_amdgcn_s_sleep(16); } __syncthreads(); } } while (0)
#define RB_ ((bf16_t*)(pws(pt) + WS_RB))
#define RLO_ ((unsigned char*)pout(pt) + (size_t)128 * MiB)
#define RLOF_ ((unsigned char*)(pws(pt) + WS_RLO))
#define RBC_ ((bf16_t*)(pws(pt) + WS_BIG + 128 * MiB))
#define SS_(k) ((float*)(pws(pt) + WS_SSP) + (size_t)(k) * M_TOK * 4)
__global__ void __launch_bounds__(512, 2) fwd_kernel(Params P) {
    extern __shared__ __attribute__((aligned(16))) unsigned char lds_raw[];
    LAS unsigned char* lds = (LAS unsigned char*)lds_raw;
    cg::grid_group grid = cg::this_grid();
    const int tid = threadIdx.x, lane = tid & 63, wave = __builtin_amdgcn_readfirstlane(tid >> 6);
    const int G = gridDim.x, bx = blockIdx.x; const int gw = bx * 8 + wave, NGW = G * 8;
    PT pt = (PT)(lds + LDS_BYTES - 256);
    volatile LAS unsigned* xst = (volatile LAS unsigned*)(lds + LDS_BYTES - 512);
    if (tid == 0) { xst[0] = 0u; xst[1] = 0u; if (TMASK) { ((volatile LAS unsigned*)(lds + LDS_BYTES - 128))[1] = 0u; }
#pragma unroll
        for (int i = 0; i < 28; ++i) { const unsigned long long v = (unsigned long long)P.in[i]; pt[2 * i] = (unsigned)v; pt[2 * i + 1] = (unsigned)(v >> 32); }
        { const unsigned long long v = (unsigned long long)P.out; pt[56] = (unsigned)v; pt[57] = (unsigned)(v >> 32); }
        { const unsigned long long v = (unsigned long long)P.ws; pt[58] = (unsigned)v; pt[59] = (unsigned)(v >> 32); }
    }
    __syncthreads();
    (void)xcd_barrier_post((unsigned*)P.ws, xst);

    TS_BEGIN(0);
    PH(0) prologue(pt, lds, gw, NGW, lane, wave);
    __syncthreads();
    grid.sync(); TS_END(0);

#pragma unroll 1
    for (int layer = 0; layer < NL; ++layer) {
        TS_BEGIN(1); PH(1) { pg8::Gemm g{RB_, (const bf16_t*)(pws(pt) + WS_WIN) + (size_t)layer * 3328 * 1024, M_TOK, 3328, 1024}; pg8::StaticOrder S; S.init(M_TOK, 3328, G, bx);
          EpiStore E{SS_(3 * layer), {(bf16_t*)(pws(pt) + WS_PQKV), (bf16_t*)(pws(pt) + WS_PLX), (bf16_t*)(pws(pt) + WS_PZ), (bf16_t*)(pws(pt) + WS_PLG)}, {1536, 512, 512, 512}, {0, 6, 8, 10}, (float*)(pws(pt) + WS_GATES), 12};
          pg8::gemm_phase<EpiStore, pg8::StaticOrder, true, true>(lds, g, S, E);
          int tl = tid; asm volatile("" : "+v"(tl));
          const f32x4* ps = (const f32x4*)(pin(pt, I_P) + (size_t)layer * M_TOK * PLE); u32x2* pd = (u32x2*)(pws(pt) + WS_PB);
          for (size_t i = (size_t)bx * 512 + tl; i < (size_t)M_TOK * PLE / 4; i += (size_t)G * 512) pd[i] = pk4(ps[i]);
          }
        GRID_BAR(); TS_END(1);
        TS_BEGIN(2); PH(2) for (int bi = bx; bi < 256; bi += G) lru_block(pt, lds, bi, layer, tid);
        PH(3) { __syncthreads();
          { int tl = tid; asm volatile("" : "+v"(tl)); const int hh = (bx >> 5) & 3; const float* cwg = pin(pt, I_DNCW) + (size_t)layer * 4 * 1536;
            for (int e = tl; e < 1536; e += 512) { const int mat = e >> 9, tap = (e >> 7) & 3, ch = e & 127; ((LAS float*)(lds + DP_CWL))[e] = cwg[tap * 1536 + mat * 512 + hh * 128 + ch]; } }
          for (int it = bx; it < 4096; it += G) dp_item(pt, lds, it, layer, tid, lane, wave); }
        GRID_BAR(); TS_END(2);
        TS_BEGIN(4); PH(4) for (int it = bx; it < 256; it += G) dr_item(pt, lds, it, tid, lane, wave);
        GRID_BAR(); TS_END(4);
        TS_BEGIN(6); PH(6) m2_rows(pt, layer, gw, NGW, lane);
        GRID_BAR(); TS_END(6);
        TS_BEGIN(7); PH(7) { STAGGER(3700); pg8::Gemm g{(const bf16_t*)(pws(pt) + WS_AMIX), (const bf16_t*)(pws(pt) + WS_WOUT) + (size_t)layer * DM * DM, M_TOK, 1024, 1024}; pg8::StaticOrder S; S.init(M_TOK, 1024, G, bx);
          EpiResid<0> E{nullptr, RB_, RB_, RLO_, RLO_, SS_(3 * layer + 1), nullptr, nullptr, nullptr, nullptr, (LAS float*)(lds + 131072)};
          pg8::gemm_phase<EpiResid<0>, pg8::StaticOrder, true, true>(lds, g, S, E); }
        GRID_BAR(); TS_END(7);
        TS_BEGIN(9); PH(9) { pg8::Gemm g{RB_, (const bf16_t*)(pws(pt) + WS_WG) + (size_t)layer * 5632 * 1024, M_TOK, 5632, 1024}; pg8::StaticOrder S; S.init(M_TOK, 5632, G, bx);
          EpiGluF E{SS_(3 * layer + 1), (float*)(pws(pt) + WS_G), (float*)(pws(pt) + WS_G) + (size_t)256 * 4 * FF, pin(pt, I_FCW) + (size_t)layer * 3 * FF, pin(pt, I_FCB) + (size_t)layer * FF, (bf16_t*)(pws(pt) + WS_ACT), (LAS float*)(lds + 135168)};
          pg8::gemm_phase<EpiGluF, pg8::StaticOrder, true, true>(lds, g, S, E); }
        GRID_BAR(); TS_END(9);
        TS_BEGIN(8); PH(8) glu_fixup(pt, layer, bx, G, tid);
        GRID_BAR(); TS_END(8);
        TS_BEGIN(10); PH(10) { STAGGER(4800); pg8::Gemm g{(const bf16_t*)(pws(pt) + WS_ACT), (const bf16_t*)(pws(pt) + WS_WD) + (size_t)layer * DM * FF, M_TOK, 1024, FF}; pg8::StaticOrder S; S.init(M_TOK, 1024, G, bx);
          EpiResid<0> E{nullptr, RB_, RBC_, RLO_, RLO_, SS_(3 * layer + 2), nullptr, nullptr, nullptr, nullptr, (LAS float*)(lds + 131072)};
          pg8::gemm_phase<EpiResid<0>, pg8::StaticOrder, true, true>(lds, g, S, E); }
        __syncthreads();
        PH(11) { pg8::Gemm g{(const bf16_t*)(pws(pt) + WS_PB), (const bf16_t*)(pws(pt) + WS_WP) + (size_t)layer * DM * PLE, M_TOK, 1024, PLE}; pg8::StaticOrder S; S.init(M_TOK, 1024, G, bx);
          EpiStore E{nullptr, {(bf16_t*)(pws(pt) + WS_PP), nullptr, nullptr, nullptr}, {1024, 0, 0, 0}, {0, 99, 99, 99}, nullptr, 99};
          pg8::gemm_phase<EpiStore, pg8::StaticOrder, true, true>(lds, g, S, E); }
        GRID_BAR(); TS_END(10);
        TS_BEGIN(12); PH(12) { STAGGER(3000); pg8::Gemm g{RBC_, (const bf16_t*)(pws(pt) + WS_WPG) + (size_t)layer * DM * DM, M_TOK, 1024, 1024}; pg8::StaticOrder S; S.init(M_TOK, 1024, G, bx);
          EpiResid<1> E{nullptr, RBC_, RB_, RLO_, layer == NL - 1 ? RLOF_ : RLO_, SS_(3 * layer + 3), SS_(3 * layer + 2), pin(pt, I_PBG) + (size_t)layer * DM, (const bf16_t*)(pws(pt) + WS_PP), nullptr, (LAS float*)(lds + 131072)};
          pg8::gemm_phase<EpiResid<1>, pg8::StaticOrder, true, true>(lds, g, S, E); }
        GRID_BAR(); TS_END(12);
    }
    TS_BEGIN(13);
    { int tlf = tid; asm volatile("" : "+v"(tlf)); const int lane = tlf & 63;
      const float* ssF = SS_(12); const f32x4* fg = (const f32x4*)pin(pt, I_FING) + lane; const bf16_t* hi_ = RB_; const unsigned char* lo_ = RLOF_; float* outp = pout(pt);
      for (int m = gw; m < M_TOK; m += NGW) { const float sc = rs_of(ssF, m); f32x4* xr = (f32x4*)(outp + (size_t)m * DM) + lane;
          const u32x2* hr = (const u32x2*)(hi_ + (size_t)m * DM) + lane; const unsigned* lr = (const unsigned*)(lo_ + (size_t)m * DM) + lane;
#pragma unroll
          for (int j = 0; j < 4; ++j) { const u32x2 h = hr[64 * j]; const unsigned l = lr[64 * j]; const f32x4 g = fg[64 * j];
              f32x4 v; v[0] = (bflo(h.x) + FP8_AT(l, 0)) * sc * g[0]; v[1] = (bfhi(h.x) + FP8_AT(l, 1)) * sc * g[1]; v[2] = (bflo(h.y) + FP8_AT(l, 2)) * sc * g[2]; v[3] = (bfhi(h.y) + FP8_AT(l, 3)) * sc * g[3];
              xr[64 * j] = v; } } }
    if (TMASK) { __syncthreads(); TS_END(13); if (bx == 0 && tid == 0) { const unsigned wait_ = ((volatile LAS unsigned*)(lds + LDS_BYTES - 128))[1]; const unsigned long long t0_ = __builtin_amdgcn_s_memrealtime(); while (__builtin_amdgcn_s_memrealtime() - t0_ < (unsigned long long)wait_) __builtin_amdgcn_s_sleep(8); } }
}

extern "C" void kernel_launch(void* const* d_in, const int* in_sizes, int n_in, void* d_out, int out_size, void* d_ws, size_t ws_size, hipStream_t stream) {
    static int grid = 0;
    if (grid == 0) {
        if (n_in != 28 || ws_size < WS_END) { fprintf(stderr, "kernel_launch: unexpected n_in %d or workspace %zu < %zu\n", n_in, ws_size, (size_t)WS_END); grid = -1; return; }
        int dev = 0, cus = 0, per_cu = 0;
        hipGetDevice(&dev); hipDeviceGetAttribute(&cus, hipDeviceAttributeMultiprocessorCount, dev);
        if (hipFuncSetAttribute((const void*)fwd_kernel, hipFuncAttributeMaxDynamicSharedMemorySize, LDS_BYTES) != hipSuccess) fprintf(stderr, "kernel_launch: hipFuncSetAttribute failed\n");
        if (hipOccupancyMaxActiveBlocksPerMultiprocessor(&per_cu, (const void*)fwd_kernel, 512, LDS_BYTES) != hipSuccess || per_cu < 1) { fprintf(stderr, "kernel_launch: occupancy query says %d\n", per_cu); per_cu = 1; }
        (void)hipGetLastError();
        grid = cus * per_cu; if (grid > 256) grid = 256;
    }
    if (grid < 0) return;
    if (hipMemsetAsync(d_ws, 0, 16384, stream) != hipSuccess) { fprintf(stderr, "kernel_launch: memset of the barrier words failed\n"); return; }
    Params p{};
    for (int i = 0; i < 28; ++i) p.in[i] = (const float*)d_in[i];
    p.out = (float*)d_out; p.ws = (unsigned char*)d_ws;
    void* args[] = {&p};
    hipError_t e = hipLaunchCooperativeKernel((const void*)fwd_kernel, dim3(grid), dim3(512), args, LDS_BYTES, stream);
    if (e != hipSuccess) fprintf(stderr, "cooperative launch failed: %s (grid %d)\n", hipGetErrorString(e), grid);
}
```

```cpp
#include <hip/hip_runtime.h>
#include <hip/hip_cooperative_groups.h>
#include <cstdio>
#include <cstdint>
namespace cg = cooperative_groups;

#define LAS __attribute__((address_space(3)))
typedef unsigned short bf16_t;
typedef short bf16x8 __attribute__((ext_vector_type(8)));
typedef short s16x4 __attribute__((ext_vector_type(4)));
typedef float f32x2 __attribute__((ext_vector_type(2)));
typedef float f32x4 __attribute__((ext_vector_type(4)));
typedef float f32x16 __attribute__((ext_vector_type(16)));
typedef unsigned u32x4 __attribute__((ext_vector_type(4)));
typedef unsigned u32x2 __attribute__((ext_vector_type(2)));
typedef __bf16 bfx2_t __attribute__((ext_vector_type(2)));

constexpr int M_TOK = 65536, DM = 1024, SEQ = 2048, NB = 32, NL = 4;
constexpr int FF = 2816, PLE = 256, INC = 3088;
constexpr float EPS = 1e-6f;

constexpr size_t MiB = 1u << 20;
constexpr size_t WS_SS = 0;
constexpr size_t WS_WIN = 4 * MiB;
constexpr size_t WS_WOUT = WS_WIN + 26 * MiB;
constexpr size_t WS_WG = WS_WOUT + 8 * MiB;
constexpr size_t WS_WU = WS_WG + 22 * MiB;
constexpr size_t WS_WD = WS_WU + 22 * MiB;
constexpr size_t WS_WPG = WS_WD + 22 * MiB;
constexpr size_t WS_WP = WS_WPG + 8 * MiB;
constexpr size_t WS_WAT = WS_WP + 2 * MiB;
constexpr size_t WS_GATES = WS_WAT + 1 * MiB;
constexpr size_t WS_VEC = WS_GATES + 4 * MiB;
constexpr size_t WS_PB = WS_VEC + 8 * MiB;
constexpr size_t WS_RB = WS_PB + 32 * MiB;
constexpr size_t WS_BIG = WS_RB + 128 * MiB;
constexpr size_t WS_PQKV = WS_BIG;
constexpr size_t WS_OF = WS_BIG, WS_OB = WS_BIG + 64 * MiB, WS_PZ = WS_BIG + 576 * MiB;
constexpr size_t WS_PLX = WS_BIG + 192 * MiB, WS_PLG = WS_BIG + 640 * MiB;
constexpr size_t WS_QH = WS_BIG + 256 * MiB, WS_KH = WS_BIG + 320 * MiB, WS_VT = WS_BIG + 384 * MiB;
constexpr size_t WS_TM = WS_BIG + 448 * MiB, WS_AT = WS_BIG + 512 * MiB;
constexpr size_t WS_RLO = WS_BIG + 576 * MiB;
constexpr size_t WS_AMIX = WS_BIG + 256 * MiB;
constexpr size_t WS_G = WS_BIG, WS_ACT = WS_BIG + 352 * MiB, WS_PP = WS_BIG;
constexpr size_t WS_SSP = WS_BIG + 704 * MiB;
constexpr size_t WS_END = WS_SSP + 13 * MiB;
constexpr int LDS_BYTES = 153600;

__device__ __forceinline__ unsigned pk2(float lo, float hi) { f32x2 v = {lo, hi}; bfx2_t b = __builtin_convertvector(v, bfx2_t); return __builtin_bit_cast(unsigned, b); }
__device__ __forceinline__ u32x2 pk4(f32x4 v) { u32x2 r; r.x = pk2(v[0], v[1]); r.y = pk2(v[2], v[3]); return r; }
__device__ __forceinline__ unsigned pk4_fp8(float a, float b, float c, float d) { int v = 0; v = __builtin_amdgcn_cvt_pk_fp8_f32(a * 1024.f, b * 1024.f, v, false); v = __builtin_amdgcn_cvt_pk_fp8_f32(c * 1024.f, d * 1024.f, v, true); return (unsigned)v; }
#define FP8_AT(w, i) (__builtin_amdgcn_cvt_f32_fp8((int)(w), (i)) * (1.0f / 1024.0f))
__device__ __forceinline__ float bflo(unsigned w) { return __uint_as_float(w << 16); }
__device__ __forceinline__ float bfhi(unsigned w) { return __uint_as_float(w & 0xffff0000u); }
__device__ __forceinline__ float bf2f(unsigned short b) { return __uint_as_float((unsigned)b << 16); }
__device__ __forceinline__ float fexp(float x) { return __builtin_amdgcn_exp2f(x * 1.4426950408889634f); }
__device__ __forceinline__ float sigm(float x) { return __builtin_amdgcn_rcpf(1.0f + fexp(-x)); }
__device__ __forceinline__ float gelu_t(float x) { const float u = 1.5957691216057308f * (x + 0.044715f * x * x * x); return x * __builtin_amdgcn_rcpf(1.0f + fexp(-u)); }
__device__ __forceinline__ float softplus_f(float x) { return x > 20.f ? x : log1pf(expf(x)); }
__device__ __forceinline__ int swz128(int row, int col) { return row * 256 + ((((col >> 3) ^ (row & 15)) << 4) | ((col & 7) << 1)); }
__device__ __forceinline__ int swz64(int row, int col) { return row * 128 + ((((col >> 3) ^ (row & 7)) << 4) | ((col & 7) << 1)); }
__device__ __forceinline__ int crow(int r, int hi) { return (r & 3) + 8 * (r >> 2) + 4 * hi; }
#define MFMA16(a, b, c) __builtin_amdgcn_mfma_f32_16x16x32_bf16((a), (b), (c), 0, 0, 0)
#define MFMA32(a, b, c) __builtin_amdgcn_mfma_f32_32x32x16_bf16((a), (b), (c), 0, 0, 0)
typedef unsigned long long u64;
__device__ __forceinline__ float rs_of(const float* ss4, int row) { const f32x4 p = *(const f32x4*)(ss4 + (size_t)row * 4); return rsqrtf(((p[0] + p[1]) + (p[2] + p[3])) * (1.0f / 1024.0f) + EPS); }
#define LDS_FENCE() asm volatile("s_waitcnt lgkmcnt(0)" ::: "memory")

#define LBAR() do { asm volatile("s_waitcnt lgkmcnt(0)" ::: "memory"); __builtin_amdgcn_s_barrier(); asm volatile("" ::: "memory"); } while (0)

namespace pg8 {
#define PG8_LAS __attribute__((address_space(3)))
typedef unsigned short bf16_t;
typedef short bf16x8 __attribute__((ext_vector_type(8)));
typedef float f32x4 __attribute__((ext_vector_type(4)));
typedef unsigned u32x4 __attribute__((ext_vector_type(4)));
constexpr int BM = 256, BK = 64, HALF = 128, HTB = HALF * BK * 2  , STAGE_BYTES = 8 * HTB, NXCD = 8, WGM = 8;

__host__ __device__ __forceinline__ int lds_byte(int r, int c) { const int st = (r >> 4) * 2 + (c >> 5), rr = r & 15, cc = c & 31, ob = rr * 64 + cc * 2; return st * 1024 + (ob ^ (((ob >> 9) & 1) << 5)); }
__host__ __device__ __forceinline__ void stage_rc(int b, int& R, int& C) { const int st = b / 1024, sb = b % 1024, swz = sb ^ (((sb >> 9) & 1) << 5); R = (st >> 1) * 16 + swz / 64; C = (st & 1) * 32 + (swz % 64) / 2; }
__host__ __device__ __forceinline__ int perm32(int rho) { const int n = rho >> 4, i = rho & 15; return 8 * (i >> 2) + 4 * n + (i & 3); }

struct Unit { int pm, pn; };
struct Gemm { const bf16_t* A; const bf16_t* Bt; int M, N, K; };

struct StaticOrder {
    int nM, nN, nwg, G, c;
    __host__ __device__ void init(int M, int N, int G_, int c_) { nM = M / BM; nN = N / BM; nwg = nM * nN; G = G_; c = c_; }
    __host__ __device__ bool next(int i, Unit& u) const {
        const long L = (long)i * G + c; if (L >= nwg) return false;
        int wgid = (int)L; { const int q = nwg / NXCD, r = nwg % NXCD, xcd = wgid % NXCD, off = wgid / NXCD; wgid = (xcd < r ? xcd * (q + 1) : r * (q + 1) + (xcd - r) * q) + off; }
        const int nig = WGM * nN, gid = wgid / nig, fm = gid * WGM, gsz = (nM - fm) < WGM ? (nM - fm) : WGM;
        u.pm = fm + ((wgid % nig) % gsz); u.pn = (wgid % nig) / gsz; return true;
    }
    __device__ __forceinline__ void a_ready(const Unit&) const {}
    __device__ __forceinline__ void done(const Unit&) const {}
};

template <class Epi, class Sched, bool ALIGN_EPI = false, bool SP2 = false>
__device__ __forceinline__ void gemm_phase(PG8_LAS unsigned char* lds, const Gemm g, const Sched& S, const Epi& E) {
    int tid_ = threadIdx.x; asm volatile("" : "+v"(tid_));
    const int tid = tid_, wid = __builtin_amdgcn_readfirstlane(tid >> 6), lane = tid & 63, wr = wid >> 2, wc = wid & 3, fr = lane & 15, fq = lane >> 4;
    const int K = g.K, nt = K / BK;
    unsigned voffA[2], voffB[2];
#pragma unroll
    for (int i = 0; i < 2; ++i) { int R, C; stage_rc(tid * 16 + i * 8192, R, C); const int Rb = Epi::PERM ? ((R & ~31) + perm32(R & 31)) : R;
        voffA[i] = (unsigned)(R * K + C) * 2u; voffB[i] = (unsigned)(Rb * K + C) * 2u; }
    const size_t kstep = (size_t)(BK * 2);
    const size_t hstep = (size_t)HALF * K * 2;
    const size_t tstep = 2 * hstep;
    const unsigned ldsw = (unsigned)wid * 1024u;
    const int aoff = lds_byte(wr * 64 + fr, fq * 8), boff = lds_byte(wc * 32 + fr, fq * 8);
#define PG8_SA(b, h) (((b) * 2 + (h)) * HTB)
#define PG8_SB(b, h) ((4 + (b) * 2 + (h)) * HTB)
#define PG8_STAGE(bufoff, gbase, voff) do { _Pragma("unroll") for (int _i = 0; _i < 2; ++_i) \
        __builtin_amdgcn_global_load_lds((const unsigned*)((const char*)(gbase) + (voff)[_i]), (PG8_LAS unsigned*)(lds + (bufoff) + ldsw + _i * 8192), 16, 0, 0); } while (0)
#define PG8_LDA(dst, b, h) do { _Pragma("unroll") for (int m = 0; m < 4; ++m) _Pragma("unroll") for (int k = 0; k < 2; ++k) dst[m][k] = *(const PG8_LAS bf16x8*)(lds + PG8_SA(b, h) + aoff + m * 2048 + k * 1024); } while (0)
#define PG8_LDB(dst, b, h) do { _Pragma("unroll") for (int n = 0; n < 2; ++n) _Pragma("unroll") for (int k = 0; k < 2; ++k) dst[n][k] = *(const PG8_LAS bf16x8*)(lds + PG8_SB(b, h) + boff + n * 2048 + k * 1024); } while (0)
#define PG8_MMA(ai, bj, At, Bt) do { __builtin_amdgcn_s_setprio(1); _Pragma("unroll") for (int m = 0; m < 4; ++m) _Pragma("unroll") for (int n = 0; n < 2; ++n) _Pragma("unroll") for (int k = 0; k < 2; ++k) \
        acc[ai][bj][m][n] = __builtin_amdgcn_mfma_f32_16x16x32_bf16(Bt[n][k], At[m][k], acc[ai][bj][m][n], 0, 0, 0); __builtin_amdgcn_s_setprio(0); } while (0)
#define PG8_WAIT_V(n) asm volatile("s_waitcnt vmcnt(" #n ")" ::: "memory")
#define PG8_WAIT_L(n) asm volatile("s_waitcnt lgkmcnt(" #n ")" ::: "memory")
#define PG8_BAR __builtin_amdgcn_s_barrier()
#define PG8_SCHED __builtin_amdgcn_sched_barrier(0)
    Unit cur, nxt; int ui = 0;
    if (!S.next(0, cur)) return;
    f32x4 acc[2][2][4][2];
#pragma unroll
    for (int a = 0; a < 2; ++a)
#pragma unroll
        for (int b = 0; b < 2; ++b)
#pragma unroll
            for (int m = 0; m < 4; ++m)
#pragma unroll
                for (int n = 0; n < 2; ++n) acc[a][b][m][n] = (f32x4){0.f, 0.f, 0.f, 0.f};
    bf16x8 At[4][2], B0[2][2], B1[2][2];
    const char* cA = (const char*)g.A + (size_t)cur.pm * tstep; const char* cB = (const char*)g.Bt + (size_t)cur.pn * tstep;
    S.a_ready(cur);
    if constexpr (SP2) {
        PG8_STAGE(PG8_SB(0, 0), cB, voffB); PG8_STAGE(PG8_SB(0, 1), cB + hstep, voffB); PG8_STAGE(PG8_SA(0, 0), cA, voffA); PG8_STAGE(PG8_SA(0, 1), cA + hstep, voffA);
        if (wr == 1) PG8_BAR;
        PG8_WAIT_V(2); PG8_BAR;
        PG8_STAGE(PG8_SB(1, 0), cB + kstep, voffB); PG8_STAGE(PG8_SA(1, 0), cA + kstep, voffA); PG8_STAGE(PG8_SB(1, 1), cB + hstep + kstep, voffB);
        PG8_WAIT_V(6); PG8_BAR;
    } else {
        PG8_STAGE(PG8_SB(0, 0), cB, voffB); PG8_STAGE(PG8_SA(0, 0), cA, voffA); PG8_STAGE(PG8_SB(0, 1), cB + hstep, voffB); PG8_STAGE(PG8_SA(0, 1), cA + hstep, voffA);
        if (wr == 1) PG8_BAR;
        PG8_WAIT_V(4); PG8_BAR;
        PG8_STAGE(PG8_SB(1, 0), cB + kstep, voffB); PG8_STAGE(PG8_SA(1, 0), cA + kstep, voffA); PG8_STAGE(PG8_SB(1, 1), cB + hstep + kstep, voffB);
        PG8_WAIT_V(6); PG8_BAR;
    }
    for (;;) {
        const bool has_next = S.next(ui + 1, nxt);
        const char* nA = has_next ? (const char*)g.A + (size_t)nxt.pm * tstep : cA; const char* nB = has_next ? (const char*)g.Bt + (size_t)nxt.pn * tstep : cB;
        for (int t = 0; t < nt; t += 2) {
            const bool last = (t == nt - 2);
            const char* a1 = cA + (size_t)(t + 1) * kstep;
            const char* a2 = last ? nA : cA + (size_t)(t + 2) * kstep; const char* b2 = last ? nB : cB + (size_t)(t + 2) * kstep;
            const char* a3 = a2 + kstep; const char* b3 = b2 + kstep;
            if (last && has_next) S.a_ready(nxt);
            if constexpr (SP2) {
            PG8_LDB(B0, 0, 0); PG8_LDB(B1, 0, 1); PG8_SCHED; PG8_LDA(At, 0, 0); PG8_STAGE(PG8_SA(1, 1), a1 + hstep, voffA);
            PG8_WAIT_V(8); PG8_WAIT_L(0); PG8_BAR; PG8_MMA(0, 0, At, B0); PG8_MMA(0, 1, At, B1); PG8_BAR; PG8_SCHED;
            PG8_LDA(At, 0, 1); PG8_STAGE(PG8_SB(0, 0), b2, voffB); PG8_STAGE(PG8_SB(0, 1), b2 + hstep, voffB); PG8_STAGE(PG8_SA(0, 0), a2, voffA);
            PG8_WAIT_V(8); PG8_WAIT_L(0); PG8_BAR; PG8_MMA(1, 0, At, B0); PG8_MMA(1, 1, At, B1); PG8_BAR; PG8_SCHED;
            PG8_LDB(B0, 1, 0); PG8_LDB(B1, 1, 1); PG8_SCHED; PG8_LDA(At, 1, 0); PG8_STAGE(PG8_SA(0, 1), a2 + hstep, voffA);
            PG8_WAIT_V(8); PG8_WAIT_L(0); PG8_BAR; PG8_MMA(0, 0, At, B0); PG8_MMA(0, 1, At, B1); PG8_BAR; PG8_SCHED;
            PG8_LDA(At, 1, 1); PG8_STAGE(PG8_SB(1, 0), b3, voffB); PG8_STAGE(PG8_SB(1, 1), b3 + hstep, voffB); PG8_STAGE(PG8_SA(1, 0), a3, voffA);
            PG8_WAIT_V(8); PG8_WAIT_L(0); PG8_BAR; PG8_MMA(1, 0, At, B0); PG8_MMA(1, 1, At, B1); PG8_BAR; PG8_SCHED;
            } else {
            PG8_LDB(B0, 0, 0); PG8_SCHED; PG8_LDA(At, 0, 0); PG8_STAGE(PG8_SA(1, 1), a1 + hstep, voffA);
            PG8_WAIT_L(8); PG8_BAR; PG8_WAIT_L(0); PG8_MMA(0, 0, At, B0); PG8_BAR; PG8_SCHED;
            PG8_LDB(B1, 0, 1); PG8_STAGE(PG8_SB(0, 0), b2, voffB);
            PG8_BAR; PG8_WAIT_L(0); PG8_MMA(0, 1, At, B1); PG8_BAR;
            PG8_LDA(At, 0, 1); PG8_STAGE(PG8_SA(0, 0), a2, voffA);
            PG8_BAR; PG8_WAIT_L(0); PG8_MMA(1, 0, At, B0); PG8_BAR; PG8_SCHED;
            PG8_STAGE(PG8_SB(0, 1), b2 + hstep, voffB);
            PG8_WAIT_V(6); PG8_BAR; PG8_MMA(1, 1, At, B1); PG8_BAR;
            PG8_LDB(B0, 1, 0); PG8_SCHED; PG8_LDA(At, 1, 0); PG8_STAGE(PG8_SA(0, 1), a2 + hstep, voffA);
            PG8_WAIT_L(8); PG8_BAR; PG8_WAIT_L(0); PG8_MMA(0, 0, At, B0); PG8_BAR; PG8_SCHED;
            PG8_LDB(B1, 1, 1); PG8_STAGE(PG8_SB(1, 0), b3, voffB);
            PG8_BAR; PG8_WAIT_L(0); PG8_MMA(0, 1, At, B1); PG8_BAR;
            PG8_LDA(At, 1, 1); PG8_STAGE(PG8_SA(1, 0), a3, voffA);
            PG8_BAR; PG8_WAIT_L(0); PG8_MMA(1, 0, At, B0); PG8_BAR; PG8_SCHED;
            PG8_STAGE(PG8_SB(1, 1), b3 + hstep, voffB);
            PG8_WAIT_V(6); PG8_BAR; PG8_MMA(1, 1, At, B1); PG8_BAR;
            }
        }
        if constexpr (ALIGN_EPI) { if (wr == 0) PG8_BAR; }
        if constexpr (!Epi::AFTER_DRAIN) { E(acc, cur, wr, wc, fr, fq); S.done(cur); }
        if (!has_next) break;
#pragma unroll
        for (int a = 0; a < 2; ++a)
#pragma unroll
            for (int b = 0; b < 2; ++b)
#pragma unroll
                for (int m = 0; m < 4; ++m)
#pragma unroll
                    for (int n = 0; n < 2; ++n) acc[a][b][m][n] = (f32x4){0.f, 0.f, 0.f, 0.f};
        cur = nxt; cA = nA; cB = nB; ++ui;
        if constexpr (ALIGN_EPI) { if (wr == 1) PG8_BAR; }
    }
    PG8_WAIT_V(0);
    if constexpr (!ALIGN_EPI) { if (wr == 0) PG8_BAR; }
    PG8_BAR;
    if constexpr (Epi::AFTER_DRAIN) { E.fused(acc, cur, wr, wc, fr, fq, lds, wid, lane); S.done(cur); }
#undef PG8_SA
#undef PG8_SB
#undef PG8_STAGE
#undef PG8_LDA
#undef PG8_LDB
#undef PG8_MMA
#undef PG8_WAIT_V
#undef PG8_WAIT_L
#undef PG8_BAR
#undef PG8_SCHED
}
}

using pg8::Unit;
struct EpiStore {
    static constexpr bool PERM = true, AFTER_DRAIN = false;
    const float* ss; bf16_t* base[4]; int ld[4]; int ts[4]; float* gates; int t2;
    __device__ __forceinline__ void operator()(const f32x4 (&acc)[2][2][4][2], const Unit& u, int wr, int wc, int fr, int fq) const {
        const int row0 = u.pm * 256 + wr * 64 + fr; const int pn = u.pn;
        if (pn >= t2) {
            if (wc == 0 && fq < 2) {
#pragma unroll
                for (int ai = 0; ai < 2; ++ai)
#pragma unroll
                    for (int m = 0; m < 4; ++m) { const int row = row0 + ai * 128 + m * 16; const float s = ss ? rs_of(ss, row) : 1.f;
                        float* gp = gates + (size_t)row * 16 + 8 * fq; *(f32x4*)gp = acc[ai][0][m][0] * s; *(f32x4*)(gp + 4) = acc[ai][0][m][1] * s; }
            }
            return;
        }
        int k = 0; if (pn >= ts[1]) k = 1; if (pn >= ts[2]) k = 2; if (pn >= ts[3]) k = 3;
        bf16_t* bsel = base[0]; int ldsel = ld[0], t0 = ts[0];
        if (k == 1) { bsel = base[1]; ldsel = ld[1]; t0 = ts[1]; } else if (k == 2) { bsel = base[2]; ldsel = ld[2]; t0 = ts[2]; } else if (k == 3) { bsel = base[3]; ldsel = ld[3]; t0 = ts[3]; }
        const int col0 = (pn - t0) * 256 + wc * 32 + 8 * fq;
#pragma unroll
        for (int ai = 0; ai < 2; ++ai)
#pragma unroll
            for (int m = 0; m < 4; ++m) { const int row = row0 + ai * 128 + m * 16; const float s = ss ? rs_of(ss, row) : 1.f;
                bf16_t* rowp = bsel + (size_t)row * ldsel + col0;
#pragma unroll
                for (int bj = 0; bj < 2; ++bj) { const f32x4 v0 = acc[ai][bj][m][0] * s, v1 = acc[ai][bj][m][1] * s;
                    u32x4 w; w.x = pk2(v0[0], v0[1]); w.y = pk2(v0[2], v0[3]); w.z = pk2(v1[0], v1[1]); w.w = pk2(v1[2], v1[3]);
                    *(u32x4*)(rowp + bj * 128) = w; } }
    }
};

#ifndef RES_BM
#define RES_BM 4
#endif
#ifndef RES1_BM
#define RES1_BM 2
#endif
template <int MODE> struct EpiResid {
    static constexpr bool PERM = true, AFTER_DRAIN = false;
    const float* rin32; const bf16_t* rbr; bf16_t* rb; const unsigned char* rlo; unsigned char* rlo_w; float* ss_out; const float* ss_in; const float* bias; const bf16_t* pp; bf16_t* rb2; LAS float* sl;
    __device__ __forceinline__ void ld_r(size_t off, f32x4& r0, f32x4& r1) const {
        if (rin32) { r0 = *(const f32x4*)(rin32 + off); r1 = *(const f32x4*)(rin32 + off + 4); }
        else { const u32x4 h = *(const u32x4*)(rbr + off); const u32x2 l = *(const u32x2*)(rlo + off);
            r0[0] = bflo(h.x) + FP8_AT(l.x, 0); r0[1] = bfhi(h.x) + FP8_AT(l.x, 1); r0[2] = bflo(h.y) + FP8_AT(l.x, 2); r0[3] = bfhi(h.y) + FP8_AT(l.x, 3);
            r1[0] = bflo(h.z) + FP8_AT(l.y, 0); r1[1] = bfhi(h.z) + FP8_AT(l.y, 1); r1[2] = bflo(h.w) + FP8_AT(l.y, 2); r1[3] = bfhi(h.w) + FP8_AT(l.y, 3); }
    }
    __device__ __forceinline__ float st_r(size_t off, const f32x4& r0, const f32x4& r1) const {
        u32x4 w; w.x = pk2(r0[0], r0[1]); w.y = pk2(r0[2], r0[3]); w.z = pk2(r1[0], r1[1]); w.w = pk2(r1[2], r1[3]);
        u32x2 l; l.x = pk4_fp8(r0[0] - bflo(w.x), r0[1] - bfhi(w.x), r0[2] - bflo(w.y), r0[3] - bfhi(w.y)); l.y = pk4_fp8(r1[0] - bflo(w.z), r1[1] - bfhi(w.z), r1[2] - bflo(w.w), r1[3] - bfhi(w.w));
        *(u32x4*)(rb + off) = w; *(u32x2*)(rlo_w + off) = l; if (rb2) *(u32x4*)(rb2 + off) = w;
        return (r0[0] * r0[0] + r0[1] * r0[1]) + (r0[2] * r0[2] + r0[3] * r0[3]) + (r1[0] * r1[0] + r1[1] * r1[1]) + (r1[2] * r1[2] + r1[3] * r1[3]);
    }
    __device__ __forceinline__ void operator()(const f32x4 (&acc)[2][2][4][2], const Unit& u, int wr, int wc, int fr, int fq) const {
        run<false>(acc, u, wr, wc, fr, fq);
    }
    template <bool F32IN> __device__ __forceinline__ void run(const f32x4 (&acc)[2][2][4][2], const Unit& u, int wr, int wc, int fr, int fq) const {
        const int row0 = u.pm * 256 + wr * 64 + fr; const int col0 = u.pn * 256 + wc * 32 + 8 * fq;
        float sqa[2][4] = {{0.f, 0.f, 0.f, 0.f}, {0.f, 0.f, 0.f, 0.f}}; float sina[2][4]; f32x4 bia[2][2];
#pragma unroll
        for (int ai = 0; ai < 2; ++ai)
#pragma unroll
            for (int m = 0; m < 4; ++m) sina[ai][m] = (MODE == 1) ? rs_of(ss_in, row0 + ai * 128 + m * 16) : 1.f;
#pragma unroll
        for (int bj = 0; bj < 2; ++bj) { bia[bj][0] = (f32x4){0.f, 0.f, 0.f, 0.f}; bia[bj][1] = (f32x4){0.f, 0.f, 0.f, 0.f};
            if (MODE == 1) { bia[bj][0] = *(const f32x4*)(bias + col0 + bj * 128); bia[bj][1] = *(const f32x4*)(bias + col0 + bj * 128 + 4); } }
        constexpr int RPB = (MODE == 1) ? 1 : 2;
        constexpr int NBAT = 16 / RPB;
        u32x4 ph[2][RPB], pw[2][RPB]; u32x2 pl[2][RPB];
#define RES_AI(b_) ((b_) / (8 / RPB))
#define RES_BJ(b_) (((b_) / (4 / RPB)) & 1)
#define RES_MH(b_) (((b_) % (4 / RPB)) * RPB)
#define RES_OFF(b_, m_) ((size_t)(row0 + RES_AI(b_) * 128 + (RES_MH(b_) + (m_)) * 16) * 1024 + col0 + RES_BJ(b_) * 128)
#define RES_LOAD(b_, buf_) do { _Pragma("unroll") for (int m_ = 0; m_ < RPB; ++m_) { const size_t off_ = RES_OFF(b_, m_); ph[buf_][m_] = *(const u32x4*)(rbr + off_); pl[buf_][m_] = *(const u32x2*)(rlo + off_); \
            if (MODE == 1) pw[buf_][m_] = *(const u32x4*)(pp + off_); } } while (0)
        __builtin_amdgcn_sched_barrier(0);
        RES_LOAD(0, 0);
        __builtin_amdgcn_sched_barrier(0);
#pragma unroll
        for (int b = 0; b < NBAT; ++b) { const int buf = b & 1; const int ai = RES_AI(b), bj = RES_BJ(b), mh = RES_MH(b);
            if (b + 1 < NBAT) { RES_LOAD(b + 1, buf ^ 1); }
            __builtin_amdgcn_sched_barrier(0);
            const f32x4 b0 = bia[bj][0], b1 = bia[bj][1];
#pragma unroll
            for (int m = 0; m < RPB; ++m) { const size_t off = RES_OFF(b, m); const float si = sina[ai][mh + m]; const u32x4 h = ph[buf][m]; const u32x2 l = pl[buf][m];
                f32x4 p0, p1;
                p0[0] = bflo(h.x) + FP8_AT(l.x, 0); p0[1] = bfhi(h.x) + FP8_AT(l.x, 1); p0[2] = bflo(h.y) + FP8_AT(l.x, 2); p0[3] = bfhi(h.y) + FP8_AT(l.x, 3);
                p1[0] = bflo(h.z) + FP8_AT(l.y, 0); p1[1] = bfhi(h.z) + FP8_AT(l.y, 1); p1[2] = bflo(h.w) + FP8_AT(l.y, 2); p1[3] = bfhi(h.w) + FP8_AT(l.y, 3);
                f32x4 a0 = acc[ai][bj][mh + m][0], a1 = acc[ai][bj][mh + m][1];
                if (MODE == 1) { const u32x4 w = pw[buf][m];
                    a0[0] = sigm(a0[0] * si + b0[0]) * bflo(w.x); a0[1] = sigm(a0[1] * si + b0[1]) * bfhi(w.x);
                    a0[2] = sigm(a0[2] * si + b0[2]) * bflo(w.y); a0[3] = sigm(a0[3] * si + b0[3]) * bfhi(w.y);
                    a1[0] = sigm(a1[0] * si + b1[0]) * bflo(w.z); a1[1] = sigm(a1[1] * si + b1[1]) * bfhi(w.z);
                    a1[2] = sigm(a1[2] * si + b1[2]) * bflo(w.w); a1[3] = sigm(a1[3] * si + b1[3]) * bfhi(w.w); }
                const f32x4 r0 = p0 + a0, r1 = p1 + a1;
                sqa[ai][mh + m] += st_r(off, r0, r1); }
            __builtin_amdgcn_sched_barrier(0);
        }
#undef RES_AI
#undef RES_BJ
#undef RES_MH
#undef RES_LOAD
#undef RES_OFF
#pragma unroll
        for (int ai = 0; ai < 2; ++ai)
#pragma unroll
            for (int m = 0; m < 4; ++m) { float q = sqa[ai][m]; q += __shfl_xor(q, 16); q += __shfl_xor(q, 32);
                if (fq == 0) sl[(ai * 128 + wr * 64 + m * 16 + fr) * 4 + wc] = q; }
        asm volatile("s_waitcnt lgkmcnt(0)" ::: "memory"); __builtin_amdgcn_s_barrier(); asm volatile("" ::: "memory");
        if (fq == 0) {
#pragma unroll
            for (int ai = 0; ai < 2; ++ai) { const int r = ai * 128 + wr * 64 + wc * 16 + fr; const f32x4 p = *(const LAS f32x4*)(sl + r * 4);
                ss_out[(size_t)(u.pm * 256 + r) * 4 + u.pn] = (p[0] + p[1]) + (p[2] + p[3]); } }
    }
};

#ifndef GLU_BM
#define GLU_BM 2
#endif
struct EpiGlu {
    static constexpr bool PERM = true, AFTER_DRAIN = false;
    const float* ss; const bf16_t* G; const float* cw; const float* cb; bf16_t* act;
    __device__ __forceinline__ void operator()(const f32x4 (&acc)[2][2][4][2], const Unit& u, int wr, int wc, int fr, int fq) const {
        const int row0 = u.pm * 256 + wr * 64 + fr; const int col0 = u.pn * 256 + wc * 32 + 8 * fq;
#pragma unroll
        for (int bj = 0; bj < 2; ++bj) { const int c = col0 + bj * 128;
            const f32x4 w0a = *(const f32x4*)(cw + c), w0b = *(const f32x4*)(cw + c + 4), w1a = *(const f32x4*)(cw + FF + c), w1b = *(const f32x4*)(cw + FF + c + 4);
            const f32x4 w2a = *(const f32x4*)(cw + 2 * FF + c), w2b = *(const f32x4*)(cw + 2 * FF + c + 4), bba = *(const f32x4*)(cb + c), bbb = *(const f32x4*)(cb + c + 4);
#pragma unroll
            for (int ai = 0; ai < 2; ++ai)
#pragma unroll
            for (int mh = 0; mh < 4; mh += GLU_BM) {
                u32x4 gmv[GLU_BM], glv[GLU_BM], gnv[GLU_BM]; float sv[GLU_BM];
#pragma unroll
                for (int m = 0; m < GLU_BM; ++m) { const int row = row0 + ai * 128 + (mh + m) * 16; const int t = row & (SEQ - 1); const bf16_t* gp = G + (size_t)row * FF + c;
                    gmv[m] = *(const u32x4*)gp; glv[m] = (u32x4){0u, 0u, 0u, 0u}; gnv[m] = (u32x4){0u, 0u, 0u, 0u};
                    if (t > 0) glv[m] = *(const u32x4*)(gp - FF);
                    if (t < SEQ - 1) gnv[m] = *(const u32x4*)(gp + FF);
                    sv[m] = rs_of(ss, row); }
#pragma unroll
                for (int m = 0; m < GLU_BM; ++m) { const int row = row0 + ai * 128 + (mh + m) * 16; const float s = sv[m]; const u32x4 gm = gmv[m], gl = glv[m], gn = gnv[m];
                    f32x4 ga, gb;
                    ga[0] = w0a[0] * bflo(gl.x) + w1a[0] * bflo(gm.x) + w2a[0] * bflo(gn.x) + bba[0];
                    ga[1] = w0a[1] * bfhi(gl.x) + w1a[1] * bfhi(gm.x) + w2a[1] * bfhi(gn.x) + bba[1];
                    ga[2] = w0a[2] * bflo(gl.y) + w1a[2] * bflo(gm.y) + w2a[2] * bflo(gn.y) + bba[2];
                    ga[3] = w0a[3] * bfhi(gl.y) + w1a[3] * bfhi(gm.y) + w2a[3] * bfhi(gn.y) + bba[3];
                    gb[0] = w0b[0] * bflo(gl.z) + w1b[0] * bflo(gm.z) + w2b[0] * bflo(gn.z) + bbb[0];
                    gb[1] = w0b[1] * bfhi(gl.z) + w1b[1] * bfhi(gm.z) + w2b[1] * bfhi(gn.z) + bbb[1];
                    gb[2] = w0b[2] * bflo(gl.w) + w1b[2] * bflo(gm.w) + w2b[2] * bflo(gn.w) + bbb[2];
                    gb[3] = w0b[3] * bfhi(gl.w) + w1b[3] * bfhi(gm.w) + w2b[3] * bfhi(gn.w) + bbb[3];
                    const f32x4 a0 = acc[ai][bj][mh + m][0] * s, a1 = acc[ai][bj][mh + m][1] * s;
                    u32x4 w; w.x = pk2(gelu_t(ga[0]) * a0[0], gelu_t(ga[1]) * a0[1]); w.y = pk2(gelu_t(ga[2]) * a0[2], gelu_t(ga[3]) * a0[3]);
                    w.z = pk2(gelu_t(gb[0]) * a1[0], gelu_t(gb[1]) * a1[1]); w.w = pk2(gelu_t(gb[2]) * a1[2], gelu_t(gb[3]) * a1[3]);
                    *(u32x4*)(act + (size_t)row * FF + c) = w; } } }
    }
};

__device__ __forceinline__ float dpp_up1(float x) { const int v = __builtin_bit_cast(int, x); return __builtin_bit_cast(float, __builtin_amdgcn_update_dpp(v, v, 0x111, 0xf, 0xf, false)); }
__device__ __forceinline__ float dpp_dn1(float x) { const int v = __builtin_bit_cast(int, x); return __builtin_bit_cast(float, __builtin_amdgcn_update_dpp(v, v, 0x101, 0xf, 0xf, false)); }
struct EpiGluF {
    static constexpr bool PERM = true, AFTER_DRAIN = false;
    const float* ss; float* sg; float* su; const float* cw; const float* cb; bf16_t* act; LAS float* ex;
    __device__ __forceinline__ void operator()(const f32x4 (&acc)[2][2][4][2], const Unit& u, int wr, int wc, int fr, int fq) const {
        const int row0 = u.pm * 256 + wr * 64 + fr; const int chl = wc * 32 + 8 * fq; const int chg = u.pn * 128 + chl;
        float rsm[2][4];
#pragma unroll
        for (int ai = 0; ai < 2; ++ai)
#pragma unroll
            for (int m = 0; m < 4; ++m) rsm[ai][m] = rs_of(ss, row0 + ai * 128 + m * 16);
        if (fr == 0 || fr == 15) {
#pragma unroll
            for (int ai = 0; ai < 2; ++ai)
#pragma unroll
                for (int m = 0; m < 4; ++m) { const int rgi = ai * 8 + wr * 4 + m; LAS float* e = ex + (2 * rgi + (fr == 15 ? 1 : 0)) * 128 + chl;
                    *(LAS f32x4*)e = acc[ai][0][m][0] * rsm[ai][m]; *(LAS f32x4*)(e + 4) = acc[ai][0][m][1] * rsm[ai][m]; } }
        asm volatile("s_waitcnt lgkmcnt(0)" ::: "memory"); __builtin_amdgcn_s_barrier(); asm volatile("" ::: "memory");
        const f32x4 w0a = *(const f32x4*)(cw + chg), w0b = *(const f32x4*)(cw + chg + 4), w1a = *(const f32x4*)(cw + FF + chg), w1b = *(const f32x4*)(cw + FF + chg + 4);
        const f32x4 w2a = *(const f32x4*)(cw + 2 * FF + chg), w2b = *(const f32x4*)(cw + 2 * FF + chg + 4), bba = *(const f32x4*)(cb + chg), bbb = *(const f32x4*)(cb + chg + 4);
#pragma unroll
        for (int ai = 0; ai < 2; ++ai)
#pragma unroll
            for (int m = 0; m < 4; ++m) { const int row = row0 + ai * 128 + m * 16; const int rgi = ai * 8 + wr * 4 + m;

                const float sm = rsm[ai][m]; const float su = dpp_up1(sm), sd = dpp_dn1(sm);
                f32x4 gm0 = acc[ai][0][m][0] * sm, gm1 = acc[ai][0][m][1] * sm, gu0, gu1, gd0, gd1;
#pragma unroll
                for (int j = 0; j < 4; ++j) { gu0[j] = dpp_up1(acc[ai][0][m][0][j]) * su; gu1[j] = dpp_up1(acc[ai][0][m][1][j]) * su;
                    gd0[j] = dpp_dn1(acc[ai][0][m][0][j]) * sd; gd1[j] = dpp_dn1(acc[ai][0][m][1][j]) * sd; }
                if (fr == 0) {
                    if (rgi > 0) { const LAS float* e = ex + (2 * (rgi - 1) + 1) * 128 + chl; gu0 = *(const LAS f32x4*)e; gu1 = *(const LAS f32x4*)(e + 4); } }
                if (fr == 15) {
                    if (rgi < 15) { const LAS float* e = ex + (2 * (rgi + 1)) * 128 + chl; gd0 = *(const LAS f32x4*)e; gd1 = *(const LAS f32x4*)(e + 4); } }
                const f32x4 ga = w0a * gu0 + w1a * gm0 + w2a * gd0 + bba, gb = w0b * gu1 + w1b * gm1 + w2b * gd1 + bbb;
                const f32x4 a0 = acc[ai][1][m][0] * sm, a1 = acc[ai][1][m][1] * sm;
                u32x4 w; w.x = pk2(gelu_t(ga[0]) * a0[0], gelu_t(ga[1]) * a0[1]); w.y = pk2(gelu_t(ga[2]) * a0[2], gelu_t(ga[3]) * a0[3]);
                w.z = pk2(gelu_t(gb[0]) * a1[0], gelu_t(gb[1]) * a1[1]); w.w = pk2(gelu_t(gb[2]) * a1[2], gelu_t(gb[3]) * a1[3]);
                const bool first = (rgi == 0 && fr == 0), last = (rgi == 15 && fr == 15);
                if (!(first || last)) *(u32x4*)(act + (size_t)row * FF + chg) = w;
                if (rgi == 0 && fr <= 1) { float* d = sg + ((size_t)u.pm * 4 + fr) * FF + chg; *(f32x4*)d = gm0; *(f32x4*)(d + 4) = gm1; }
                if (rgi == 15 && fr >= 14) { float* d = sg + ((size_t)u.pm * 4 + (fr - 12)) * FF + chg; *(f32x4*)d = gm0; *(f32x4*)(d + 4) = gm1; }
                if (first || last) { float* d = this->su + ((size_t)u.pm * 2 + (last ? 1 : 0)) * FF + chg; *(f32x4*)d = a0; *(f32x4*)(d + 4) = a1; } }
    }
};

struct Params { const float* in[28]; float* out; unsigned char* ws; };
typedef LAS unsigned* PT;
__device__ __forceinline__ const float* pin(PT t0, int k) { unsigned ta = (unsigned)(size_t)t0; asm volatile("" : "+s"(ta)); const PT t = (PT)(size_t)ta;
    const unsigned lo = __builtin_amdgcn_readfirstlane(t[2 * k]), hi = __builtin_amdgcn_readfirstlane(t[2 * k + 1]); return (const float*)(__attribute__((address_space(1))) const float*)(((unsigned long long)hi << 32) | lo); }
__device__ __forceinline__ float* pout(PT t) { return (float*)pin(t, 28); }
__device__ __forceinline__ unsigned char* pws(PT t) { return (unsigned char*)pin(t, 29); }
enum { I_X = 0, I_P, I_N1G, I_WIN, I_DNCW, I_ALOG, I_DTB, I_DNG, I_LCW, I_LCB, I_LWA, I_LBA, I_LWX, I_LBX, I_LAM, I_LNG, I_WOUT, I_N2G, I_FWG, I_FWU, I_FCW, I_FCB, I_FWD, I_PNG, I_PWG, I_PBG, I_PWP, I_FING };

template <class RM>
__device__ __forceinline__ void tr_item(const float* W, int K, int N, bf16_t* WT, int ldt, const float* gk, const RM& rm, LAS float* scr, int item, int lane) {
    const int nblk = (N + 31) >> 5, kb = item / nblk, nb = item % nblk, k0 = 64 * kb, n0 = 32 * nb;
#pragma unroll 8
    for (int i = 0; i < 32; ++i) { const int kk = 2 * i + (lane >> 5), n = n0 + (lane & 31);
        float v = (n < N) ? W[(size_t)(k0 + kk) * N + n] : 0.f; if (gk) v *= gk[k0 + kk];
        scr[kk * 33 + (lane & 31)] = v; }
    LDS_FENCE();
    const int c = lane & 7;
#pragma unroll
    for (int j = 0; j < 4; ++j) { const int nl = (lane >> 3) + 8 * j, n = n0 + nl; const LAS float* s = scr + (8 * c) * 33 + nl;
        u32x4 o; o.x = pk2(s[0 * 33], s[1 * 33]); o.y = pk2(s[2 * 33], s[3 * 33]); o.z = pk2(s[4 * 33], s[5 * 33]); o.w = pk2(s[6 * 33], s[7 * 33]);
        const int dst = (n < N) ? rm(n) : -1;
        if (dst >= 0) *(u32x4*)(WT + (size_t)dst * ldt + k0 + 8 * c) = o; }
    LDS_FENCE();
}
struct RmId { __device__ __forceinline__ int operator()(int n) const { return n; } };
struct RmGU { int off; __device__ __forceinline__ int operator()(int n) const { return (n >> 7) * 256 + off + (n & 127); } };
struct RmIn { __device__ __forceinline__ int operator()(int n) const {
    if (n < 1536) return n;
    if (n < 2048) return 2048 + (n - 1536);
    if (n < 2064) return 3072 + (n - 2048);
    if (n < 2576) return 1536 + (n - 2064);
    return 2560 + (n - 2576);
} };

__device__ __forceinline__ void prologue(PT pt, LAS unsigned char* lds, int gw, int NGW, int lane, int wave) {
    asm volatile("" : "+v"(lane));
    unsigned char* ws = pws(pt);
    for (int l = 0; l < NL; ++l) { u32x4* z = (u32x4*)((bf16_t*)(ws + WS_WIN) + ((size_t)l * 3328 + 3088) * 1024); const int n4 = 240 * 1024 / 8;
        for (int i = gw * 64 + lane; i < n4; i += NGW * 64) z[i] = (u32x4){0u, 0u, 0u, 0u}; }
    LAS float* scr = (LAS float*)(lds + wave * 16384);
    constexpr int I_IN = 16 * 97, I_OUT = 16 * 32, I_G = 16 * 88, I_D = 44 * 32, I_PG = 16 * 32, I_PP = 4 * 32, I_LA = 32;
    constexpr int PER_L = I_IN + I_OUT + 2 * I_G + I_D + I_PG + I_PP + 2 * I_LA;
    for (int it = gw; it < NL * PER_L; it += NGW) {
        const int l = it / PER_L; int r = it % PER_L;
        if (r < I_IN) { tr_item(pin(pt, I_WIN) + (size_t)l * DM * INC, DM, INC, (bf16_t*)(ws + WS_WIN) + (size_t)l * 3328 * 1024, 1024, pin(pt, I_N1G) + l * DM, RmIn(), scr, r, lane); continue; } r -= I_IN;
        if (r < I_OUT) { tr_item(pin(pt, I_WOUT) + (size_t)l * DM * DM, DM, DM, (bf16_t*)(ws + WS_WOUT) + (size_t)l * DM * DM, 1024, nullptr, RmId(), scr, r, lane); continue; } r -= I_OUT;
        if (r < I_G) { tr_item(pin(pt, I_FWG) + (size_t)l * DM * FF, DM, FF, (bf16_t*)(ws + WS_WG) + (size_t)l * 5632 * 1024, 1024, pin(pt, I_N2G) + l * DM, RmGU{0}, scr, r, lane); continue; } r -= I_G;
        if (r < I_G) { tr_item(pin(pt, I_FWU) + (size_t)l * DM * FF, DM, FF, (bf16_t*)(ws + WS_WG) + (size_t)l * 5632 * 1024, 1024, pin(pt, I_N2G) + l * DM, RmGU{128}, scr, r, lane); continue; } r -= I_G;
        if (r < I_D) { tr_item(pin(pt, I_FWD) + (size_t)l * FF * DM, FF, DM, (bf16_t*)(ws + WS_WD) + (size_t)l * DM * FF, FF, nullptr, RmId(), scr, r, lane); continue; } r -= I_D;
        if (r < I_PG) { tr_item(pin(pt, I_PWG) + (size_t)l * DM * DM, DM, DM, (bf16_t*)(ws + WS_WPG) + (size_t)l * DM * DM, 1024, pin(pt, I_PNG) + l * DM, RmId(), scr, r, lane); continue; } r -= I_PG;
        if (r < I_PP) { tr_item(pin(pt, I_PWP) + (size_t)l * PLE * DM, PLE, DM, (bf16_t*)(ws + WS_WP) + (size_t)l * DM * PLE, PLE, nullptr, RmId(), scr, r, lane); continue; } r -= I_PP;
        { const int gate = r / I_LA; r %= I_LA; const int mat = r >> 1, sub = r & 1;
          const float* src = pin(pt, gate ? I_LWX : I_LWA) + ((size_t)l * 16 + mat) * 4096;
          bf16_t* dst = (bf16_t*)(ws + WS_WAT) + (((size_t)l * 16 + mat) * 2 + gate) * 4096;
          tr_item(src, 64, 64, dst, 64, nullptr, RmId(), scr, sub, lane); }
    }
    const float* x = pin(pt, I_X); bf16_t* rb = (bf16_t*)(ws + WS_RB); float* ss0 = (float*)(ws + WS_SSP); unsigned char* rl = (unsigned char*)pout(pt) + (size_t)128 * MiB;
    for (int m = gw; m < M_TOK; m += NGW) { const f32x4* xr = (const f32x4*)(x + (size_t)m * DM) + lane; u32x2* o = (u32x2*)(rb + (size_t)m * DM) + lane; unsigned* ol = (unsigned*)(rl + (size_t)m * DM) + lane; float s = 0.f;
#pragma unroll
        for (int j = 0; j < 4; ++j) { const f32x4 v = xr[64 * j]; s += (v[0] * v[0] + v[1] * v[1]) + (v[2] * v[2] + v[3] * v[3]); const u32x2 hw = pk4(v); o[64 * j] = hw;
            ol[64 * j] = pk4_fp8(v[0] - bflo(hw.x), v[1] - bfhi(hw.x), v[2] - bflo(hw.y), v[3] - bfhi(hw.y)); }
#pragma unroll
        for (int o2 = 1; o2 < 64; o2 <<= 1) s += __shfl_xor(s, o2);
        if (lane < 4) ss0[(size_t)m * 4 + lane] = lane == 0 ? s : 0.f; }
}

__device__ __forceinline__ void lru_block(PT pt, LAS unsigned char* lds, int bi, int layer, int tid) {
    asm volatile("" : "+v"(tid));
    const int lane = tid & 63, w = tid >> 6;
    unsigned char* ws = pws(pt);
    const int wi = bi * 8 + w;
    const int dq = wi & 3, n = (wi >> 2) & 7, dir = (wi >> 5) & 1, b = wi >> 6;
    const int fr = lane & 15, fq = lane >> 4;
    LAS unsigned char* XCB = lds + (w >> 2) * 8192;
    LAS unsigned char* SCN = lds + 16384 + w * 1024;
    const int ti = lane >> 2, cq = lane & 3;
    const int cch = 64 * n + 16 * dq + 4 * cq;
    f32x4 cw4[4];
#pragma unroll
    for (int tap = 0; tap < 4; ++tap) cw4[tap] = *(const f32x4*)(pin(pt, I_LCW) + ((size_t)layer * 4 + tap) * 512 + cch);
    const f32x4 cb4 = *(const f32x4*)(pin(pt, I_LCB) + (size_t)layer * 512 + cch);
    const bf16_t* wbase = (const bf16_t*)(ws + WS_WAT) + ((((size_t)layer * 2 + dir) * 8 + n) * 2) * 4096;
    bf16x8 Ba[2], Bx[2];
#pragma unroll
    for (int ks = 0; ks < 2; ++ks) { Ba[ks] = *(const bf16x8*)(wbase + (16 * dq + fr) * 64 + 32 * ks + 8 * fq); Bx[ks] = *(const bf16x8*)(wbase + 4096 + (16 * dq + fr) * 64 + 32 * ks + 8 * fq); }
    const int dch = 64 * n + 16 * dq + fr; const size_t pidx = ((size_t)layer * 2 + dir) * 512 + dch;
    const float ba = pin(pt, I_LBA)[pidx], bx = pin(pt, I_LBX)[pidx], sp8 = 8.0f * 1.4426950408889634f * softplus_f(-pin(pt, I_LAM)[pidx]);
    const bf16_t* plx = (const bf16_t*)(ws + WS_PLX) + (size_t)b * SEQ * 512 + cch;
    bf16_t* hout = (bf16_t*)pout(pt) + (size_t)dir * M_TOK * 512 + (size_t)b * SEQ * 512 + dch;
    u32x2 xr[2][4];
#define LRU_LOAD(scn) do { _Pragma("unroll") for (int s_ = 0; s_ < 2; ++s_) { const int tt_ = dir ? (SEQ - 1 - (32 * (scn) + 16 * s_ + ti)) : (32 * (scn) + 16 * s_ + ti); \
        _Pragma("unroll") for (int tap = 0; tap < 4; ++tap) { const int t2_ = tt_ + tap - 2; xr[s_][tap] = (u32x2){0u, 0u}; if (t2_ >= 0 && t2_ < SEQ) xr[s_][tap] = *(const u32x2*)(plx + (size_t)t2_ * 512); } } } while (0)
    LRU_LOAD(0);
    float hprev = 0.f;
    LBAR();
#pragma unroll 1
    for (int sc = 0; sc < 64; ++sc) {
        LAS unsigned char* XC = XCB + (sc & 1) * 4096;
#pragma unroll
        for (int s2 = 0; s2 < 2; ++s2) { f32x4 xa = cb4;
#pragma unroll
            for (int tap = 0; tap < 4; ++tap) { xa[0] += cw4[tap][0] * bflo(xr[s2][tap].x); xa[1] += cw4[tap][1] * bfhi(xr[s2][tap].x); xa[2] += cw4[tap][2] * bflo(xr[s2][tap].y); xa[3] += cw4[tap][3] * bfhi(xr[s2][tap].y); }
            *(LAS u32x2*)(XC + swz64(16 * s2 + ti, 16 * dq + 4 * cq)) = pk4(xa); }
        if (sc + 1 < 64) LRU_LOAD(sc + 1);
        LBAR();
        float Ac[2][4], Hc[2][4];
#pragma unroll
        for (int s2 = 0; s2 < 2; ++s2) {
            const bf16x8 A0 = *(const LAS bf16x8*)(XC + swz64(16 * s2 + fr, 8 * fq)), A1 = *(const LAS bf16x8*)(XC + swz64(16 * s2 + fr, 32 + 8 * fq));
            f32x4 ca = {0.f, 0.f, 0.f, 0.f}, cx = {0.f, 0.f, 0.f, 0.f};
            ca = MFMA16(A0, Ba[0], ca); ca = MFMA16(A1, Ba[1], ca); cx = MFMA16(A0, Bx[0], cx); cx = MFMA16(A1, Bx[1], cx);
#pragma unroll
            for (int jj = 0; jj < 4; ++jj) { const float xv = bf2f(*(const LAS unsigned short*)(XC + swz64(16 * s2 + 4 * fq + jj, 16 * dq + fr)));
                const float r = sigm(ca[jj] + ba), ig = sigm(cx[jj] + bx), a = __builtin_amdgcn_exp2f(-r * sp8);
                const float bt = __builtin_amdgcn_sqrtf(fmaxf(1.0f - a * a, 0.f)) * ig * xv;
                Hc[s2][jj] = jj ? (a * Hc[s2][jj - 1] + bt) : bt; Ac[s2][jj] = jj ? (a * Ac[s2][jj - 1]) : a; }
            *(LAS f32x2*)(SCN + s2 * 512 + (fq * 16 + fr) * 8) = (f32x2){Ac[s2][3], Hc[s2][3]}; }
#pragma unroll
        for (int s2 = 0; s2 < 2; ++s2) {
            const LAS unsigned char* T = SCN + s2 * 512;
            const f32x2 g0 = *(const LAS f32x2*)(T + (0 * 16 + fr) * 8), g1 = *(const LAS f32x2*)(T + (1 * 16 + fr) * 8), g2 = *(const LAS f32x2*)(T + (2 * 16 + fr) * 8), g3 = *(const LAS f32x2*)(T + (3 * 16 + fr) * 8);
            const float h1 = g0.x * hprev + g0.y, h2 = g1.x * h1 + g1.y, h3 = g2.x * h2 + g2.y, h4 = g3.x * h3 + g3.y;
            const float hin = fq == 0 ? hprev : (fq == 1 ? h1 : (fq == 2 ? h2 : h3));
            hprev = h4;
#pragma unroll
            for (int jj = 0; jj < 4; ++jj) { const float hv = Ac[s2][jj] * hin + Hc[s2][jj]; const int i = 16 * s2 + 4 * fq + jj; const int t2 = dir ? (SEQ - 1 - (32 * sc + i)) : (32 * sc + i);
                hout[(size_t)t2 * 512] = (bf16_t)(pk2(hv, 0.f) & 0xffffu); } }
    }
#undef LRU_LOAD
}

constexpr int DP_BUF0 = 0, DP_BUF1 = 49152, DP_KL = 49152, DP_QL = 49152 + 16384, DP_VL = 49152 + 32768, DP_VEC = 98304, DP_CWL = 99328;
__device__ __forceinline__ void dp_item(PT pt, LAS unsigned char* lds, int item, int layer, int tid, int lane, int w) {
    asm volatile("" : "+v"(tid)); lane = tid & 63; asm volatile("" : "+s"(w));
    unsigned char* ws = pws(pt);
    const int b = item >> 7, h = (item >> 5) & 3, n = item & 31;
    const size_t rowbase = (size_t)b * SEQ + 64 * n;
    LAS float* VEC = (LAS float*)(lds + DP_VEC);
    LBAR();
    f32x4 gpre = {0.f, 0.f, 0.f, 0.f};
    if (w == 0) { const float* gp = (const float*)(ws + WS_GATES) + (rowbase + lane) * 16 + h; gpre[0] = gp[0]; gpre[1] = gp[4]; gpre[2] = gp[8]; gpre[3] = gp[12]; }
    { const int i = tid >> 3, c = tid & 7; const int t = 64 * n + i; const size_t R = rowbase + i;
      const bf16_t* pq = (const bf16_t*)(ws + WS_PQKV);
      u32x4 xin[3][4][2];
#pragma unroll
      for (int mat = 0; mat < 3; ++mat)
#pragma unroll
          for (int tap = 0; tap < 4; ++tap) { const int t2 = t + tap - 2; xin[mat][tap][0] = (u32x4){0u, 0u, 0u, 0u}; xin[mat][tap][1] = (u32x4){0u, 0u, 0u, 0u};
              if (t2 >= 0 && t2 < SEQ) { const bf16_t* xp = pq + (R + tap - 2) * 1536 + mat * 512 + h * 128 + 16 * c; xin[mat][tap][0] = *(const u32x4*)xp; xin[mat][tap][1] = *(const u32x4*)(xp + 8); } }
#pragma unroll
      for (int mat = 0; mat < 3; ++mat) {
          f32x4 a[4] = {{0.f, 0.f, 0.f, 0.f}, {0.f, 0.f, 0.f, 0.f}, {0.f, 0.f, 0.f, 0.f}, {0.f, 0.f, 0.f, 0.f}};
#pragma unroll
          for (int tap = 0; tap < 4; ++tap) { const u32x4 x0 = xin[mat][tap][0], x1 = xin[mat][tap][1];
              const LAS float* wp = (const LAS float*)(lds + DP_CWL) + (mat * 4 + tap) * 128 + 16 * c; const f32x4 w0 = *(const LAS f32x4*)wp, w1 = *(const LAS f32x4*)(wp + 4), w2 = *(const LAS f32x4*)(wp + 8), w3 = *(const LAS f32x4*)(wp + 12);
              a[0][0] += w0[0] * bflo(x0.x); a[0][1] += w0[1] * bfhi(x0.x); a[0][2] += w0[2] * bflo(x0.y); a[0][3] += w0[3] * bfhi(x0.y);
              a[1][0] += w1[0] * bflo(x0.z); a[1][1] += w1[1] * bfhi(x0.z); a[1][2] += w1[2] * bflo(x0.w); a[1][3] += w1[3] * bfhi(x0.w);
              a[2][0] += w2[0] * bflo(x1.x); a[2][1] += w2[1] * bfhi(x1.x); a[2][2] += w2[2] * bflo(x1.y); a[2][3] += w2[3] * bfhi(x1.y);
              a[3][0] += w3[0] * bflo(x1.z); a[3][1] += w3[1] * bfhi(x1.z); a[3][2] += w3[2] * bflo(x1.w); a[3][3] += w3[3] * bfhi(x1.w); }
          float ssq = 0.f;
#pragma unroll
          for (int q = 0; q < 4; ++q)
#pragma unroll
              for (int e = 0; e < 4; ++e) { const float v = a[q][e]; const float sv = v * sigm(v); a[q][e] = sv; ssq += sv * sv; }
          float scale = 1.f;
          if (mat < 2) { ssq += __shfl_xor(ssq, 1); ssq += __shfl_xor(ssq, 2); ssq += __shfl_xor(ssq, 4); scale = rsqrtf(ssq + EPS); if (mat == 0) scale *= 0.08838834764831845f; }
          u32x4 o0, o1; o0.x = pk2(a[0][0] * scale, a[0][1] * scale); o0.y = pk2(a[0][2] * scale, a[0][3] * scale); o0.z = pk2(a[1][0] * scale, a[1][1] * scale); o0.w = pk2(a[1][2] * scale, a[1][3] * scale);
          o1.x = pk2(a[2][0] * scale, a[2][1] * scale); o1.y = pk2(a[2][2] * scale, a[2][3] * scale); o1.z = pk2(a[3][0] * scale, a[3][1] * scale); o1.w = pk2(a[3][2] * scale, a[3][3] * scale);
          const int lbase = (mat == 0) ? DP_QL : (mat == 1 ? DP_KL : DP_VL);
          *(LAS u32x4*)(lds + lbase + swz128(i, 16 * c)) = o0; *(LAS u32x4*)(lds + lbase + swz128(i, 16 * c + 8)) = o1;
          if (mat < 2) { bf16_t* gp = (bf16_t*)(ws + (mat == 0 ? WS_QH : WS_KH)) + R * 512 + h * 128 + 16 * c; *(u32x4*)gp = o0; *(u32x4*)(gp + 8) = o1; } }
    }
    if (w == 0) {
        const float bF = sigm(gpre[0]), bB = sigm(gpre[1]);
        float gF = -expf(pin(pt, I_ALOG)[layer * 8 + h]) * softplus_f(gpre[2] + pin(pt, I_DTB)[layer * 8 + h]);
        float gB = -expf(pin(pt, I_ALOG)[layer * 8 + 4 + h]) * softplus_f(gpre[3] + pin(pt, I_DTB)[layer * 8 + 4 + h]);
#pragma unroll
        for (int off = 1; off < 64; off <<= 1) { const float v = __shfl_up(gF, off); if (lane >= off) gF += v; const float u = __shfl_down(gB, off); if (lane + off < 64) gB += u; }
        const float glF = __shfl(gF, 63), glB = __shfl(gB, 0);
        VEC[lane] = bF; VEC[64 + lane] = gF; VEC[128 + lane] = bB; VEC[192 + lane] = gB;
        float* v0 = (float*)(ws + WS_VEC) + (size_t)item * 256; float* v1 = v0 + (size_t)4096 * 256;
        v0[lane] = bF; v0[64 + lane] = fexp(gF); v0[128 + lane] = fexp(glF - gF); if (lane == 0) v0[192] = fexp(glF);
        v1[lane] = bB; v1[64 + lane] = fexp(gB); v1[128 + lane] = fexp(glB - gB); if (lane == 0) v1[192] = fexp(glB);
    }
    LBAR();
    { const int e = tid >> 2, jq = tid & 3; unsigned vv[8];
#pragma unroll
      for (int p = 0; p < 8; ++p) { const unsigned lo = *(const LAS unsigned short*)(lds + DP_VL + swz128(16 * jq + 2 * p, e)), hi = *(const LAS unsigned short*)(lds + DP_VL + swz128(16 * jq + 2 * p + 1, e)); vv[p] = lo | (hi << 16); }
      bf16_t* gp = (bf16_t*)(ws + WS_VT) + (size_t)item * 8192 + e * 64 + 16 * jq;
      *(u32x4*)gp = (u32x4){vv[0], vv[1], vv[2], vv[3]}; *(u32x4*)(gp + 8) = (u32x4){vv[4], vv[5], vv[6], vv[7]}; }
    const int r32 = lane & 31, hi = lane >> 5;
    { const int kind = w >> 2, q = w & 3, ta = q >> 1, tb = q & 1;
      f32x16 acc; for (int r = 0; r < 16; ++r) acc[r] = 0.f;
      const int bbase = kind ? DP_QL : DP_KL;
#pragma unroll
      for (int ks = 0; ks < 8; ++ks) { const bf16x8 av = *(const LAS bf16x8*)(lds + DP_KL + swz128(32 * ta + r32, 16 * ks + 8 * hi)), bv = *(const LAS bf16x8*)(lds + bbase + swz128(32 * tb + r32, 16 * ks + 8 * hi)); acc = MFMA32(av, bv, acc); }
      const int gb = 32 * tb + r32;
#pragma unroll
      for (int dir = 0; dir < 2; ++dir) { const LAS float* bet = VEC + dir * 128; const LAS float* gc = VEC + dir * 128 + 64;
          const float gcl = gc[gb], betl = bet[gb];
#pragma unroll
          for (int g = 0; g < 4; ++g) { const int ga0 = 32 * ta + 8 * g + 4 * hi; const f32x4 gca = *(const LAS f32x4*)(gc + ga0), bea = *(const LAS f32x4*)(bet + ga0);
              if (kind == 0) { f32x4 xv, yv, pv;
#pragma unroll
                  for (int jj = 0; jj < 4; ++jj) { const int ga = ga0 + jj; const float kk = acc[4 * g + jj];
                      const bool mx = dir ? (gb < ga) : (gb > ga), my = dir ? (ga < gb) : (ga > gb);
                      const float ed = kk * fexp(-fabsf(gcl - gca[jj]));
                      xv[jj] = mx ? (-betl * ed) : 0.f; yv[jj] = my ? (-bea[jj] * ed) : 0.f; pv[jj] = (ga == gb) ? 1.f : 0.f; }
                  LAS unsigned char* bb = lds + DP_BUF0 + dir * 24576 + swz64(gb, ga0);
                  *(LAS u32x2*)bb = pk4(xv); *(LAS u32x2*)(bb + 8192) = pk4(yv); *(LAS u32x2*)(bb + 16384) = pk4(pv);
              } else { f32x4 av4;
#pragma unroll
                  for (int jj = 0; jj < 4; ++jj) { const int ga = ga0 + jj; const bool ma = dir ? (gb <= ga) : (gb >= ga); av4[jj] = ma ? (acc[4 * g + jj] * fexp(-fabsf(gcl - gca[jj]))) : 0.f; }
                  if (!(dir ? ((ga0 | 7) < gb) : ((ga0 & ~7) > gb)))
                      *(u32x2*)((bf16_t*)(ws + WS_AT) + ((size_t)dir * 4096 + item) * 4096 + gb * 64 + ga0) = pk4(av4); } } }
    }
    LBAR();
    { const int dir = w >> 2, q = w & 3, ti = q >> 1, tj = q & 1;
      f32x16 pacc; for (int r = 0; r < 16; ++r) pacc[r] = (32 * tj + crow(r, hi) == 32 * ti + r32) ? 1.f : 0.f;
#pragma unroll 1
      for (int rd = 0; rd < 6; ++rd) { LAS unsigned char* cur = lds + ((rd & 1) ? DP_BUF1 : DP_BUF0) + dir * 24576; LAS unsigned char* nxt = lds + ((rd & 1) ? DP_BUF0 : DP_BUF1) + dir * 24576;
          bf16x8 xf[4], yf[4], pf[4];
#pragma unroll
          for (int ks = 0; ks < 4; ++ks) { xf[ks] = *(const LAS bf16x8*)(cur + swz64(32 * ti + r32, 16 * ks + 8 * hi)); yf[ks] = *(const LAS bf16x8*)(cur + 8192 + swz64(32 * tj + r32, 16 * ks + 8 * hi)); pf[ks] = *(const LAS bf16x8*)(cur + 16384 + swz64(32 * ti + r32, 16 * ks + 8 * hi)); }
#pragma unroll
          for (int ks = 0; ks < 4; ++ks) pacc = MFMA32(yf[ks], pf[ks], pacc);
          if (rd < 5) { f32x16 xa, ya; for (int r = 0; r < 16; ++r) { xa[r] = 0.f; ya[r] = 0.f; }
#pragma unroll
              for (int ks = 0; ks < 4; ++ks) { xa = MFMA32(yf[ks], xf[ks], xa); ya = MFMA32(xf[ks], yf[ks], ya); }
#pragma unroll
              for (int g = 0; g < 4; ++g) { const int c0 = 8 * g + 4 * hi;
                  *(LAS u32x2*)(nxt + swz64(32 * ti + r32, 32 * tj + c0)) = pk4((f32x4){xa[4 * g], xa[4 * g + 1], xa[4 * g + 2], xa[4 * g + 3]});
                  *(LAS u32x2*)(nxt + 8192 + swz64(32 * tj + r32, 32 * ti + c0)) = pk4((f32x4){ya[4 * g], ya[4 * g + 1], ya[4 * g + 2], ya[4 * g + 3]});
                  *(LAS u32x2*)(nxt + 16384 + swz64(32 * ti + r32, 32 * tj + c0)) = pk4((f32x4){pacc[4 * g], pacc[4 * g + 1], pacc[4 * g + 2], pacc[4 * g + 3]}); }
              LBAR(); } }
      bf16_t* tg = (bf16_t*)(ws + WS_TM) + ((size_t)dir * 4096 + item) * 4096 + (32 * ti + r32) * 64 + 32 * tj + 4 * hi;
#pragma unroll
      for (int g = 0; g < 4; ++g) { const int trow = 32 * ti + r32, tc0 = 32 * tj + 8 * g + 4 * hi;
          if (!(dir ? ((tc0 | 7) < trow) : ((tc0 & ~7) > trow))) *(u32x2*)(tg + 8 * g) = pk4((f32x4){pacc[4 * g], pacc[4 * g + 1], pacc[4 * g + 2], pacc[4 * g + 3]}); }
    }
}

constexpr int DR_K = 0, DR_Q = 16384, DR_KT = 32768, DR_VT = 49152, DR_T = 65536, DR_A = 73728, DR_VEC = 81920, DR_PRIV = 83968;
__device__ __forceinline__ void dr_item(PT pt, LAS unsigned char* lds, int item, int tid, int lane, int w) {
    asm volatile("" : "+v"(tid)); lane = tid & 63; asm volatile("" : "+s"(w));
    unsigned char* ws = pws(pt);
    const int dir = item & 1, h = (item >> 1) & 3, b = item >> 3;
    const int fr = lane & 15, fq = lane >> 4, es = 16 * w;
    LAS unsigned char* ST = lds + DR_PRIV + w * 8192; LAS unsigned char* RV = ST + 4096; LAS unsigned char* VN2 = ST + 6144;
    const LAS float* VEC = (const LAS float*)(lds + DR_VEC);
    const bf16_t* kh = (const bf16_t*)(ws + WS_KH) + (size_t)b * SEQ * 512 + h * 128;
    const bf16_t* qh = (const bf16_t*)(ws + WS_QH) + (size_t)b * SEQ * 512 + h * 128;
    const int ibase = (b * 4 + h) * 32;
    const bf16_t* vt = (const bf16_t*)(ws + WS_VT) + (size_t)ibase * 8192;
    const bf16_t* tm = (const bf16_t*)(ws + WS_TM) + ((size_t)dir * 4096 + ibase) * 4096;
    const bf16_t* at = (const bf16_t*)(ws + WS_AT) + ((size_t)dir * 4096 + ibase) * 4096;
    const float* vecs = (const float*)(ws + WS_VEC) + ((size_t)dir * 4096 + ibase) * 256;
    bf16_t* og = (bf16_t*)(ws + (dir ? WS_OB : WS_OF)) + (size_t)b * SEQ * 512 + h * 128 + es + fr;
    u32x4 pk[2], pq[2], pv[2], ptm, pa; f32x4 pvec = {0.f, 0.f, 0.f, 0.f};
#define DR_LOAD(nn) do { _Pragma("unroll") for (int u_ = 0; u_ < 2; ++u_) { const int p_ = tid + 512 * u_; \
        pk[u_] = *(const u32x4*)(kh + (size_t)(64 * (nn) + (p_ >> 4)) * 512 + 8 * (p_ & 15)); pq[u_] = *(const u32x4*)(qh + (size_t)(64 * (nn) + (p_ >> 4)) * 512 + 8 * (p_ & 15)); \
        pv[u_] = *(const u32x4*)(vt + (size_t)(nn) * 8192 + p_ * 8); } \
        ptm = (u32x4){0u, 0u, 0u, 0u}; pa = ptm; if (!(dir ? (8 * (tid & 7) + 7 < (tid >> 3)) : (8 * (tid & 7) > (tid >> 3)))) { ptm = *(const u32x4*)(tm + (size_t)(nn) * 4096 + tid * 8); pa = *(const u32x4*)(at + (size_t)(nn) * 4096 + tid * 8); } \
        if (tid < 64) pvec = *(const f32x4*)(vecs + (size_t)(nn) * 256 + 4 * tid); } while (0)
#define DR_STORE() do { _Pragma("unroll") for (int u_ = 0; u_ < 2; ++u_) { const int p_ = tid + 512 * u_; const int j_ = p_ >> 4, q_ = p_ & 15; \
        *(LAS u32x4*)(lds + DR_K + swz128(j_, 8 * q_)) = pk[u_]; *(LAS u32x4*)(lds + DR_Q + swz128(j_, 8 * q_)) = pq[u_]; \
        *(LAS unsigned short*)(lds + DR_KT + swz64(8 * q_ + 0, j_)) = (unsigned short)(pk[u_].x & 0xffffu); *(LAS unsigned short*)(lds + DR_KT + swz64(8 * q_ + 1, j_)) = (unsigned short)(pk[u_].x >> 16); \
        *(LAS unsigned short*)(lds + DR_KT + swz64(8 * q_ + 2, j_)) = (unsigned short)(pk[u_].y & 0xffffu); *(LAS unsigned short*)(lds + DR_KT + swz64(8 * q_ + 3, j_)) = (unsigned short)(pk[u_].y >> 16); \
        *(LAS unsigned short*)(lds + DR_KT + swz64(8 * q_ + 4, j_)) = (unsigned short)(pk[u_].z & 0xffffu); *(LAS unsigned short*)(lds + DR_KT + swz64(8 * q_ + 5, j_)) = (unsigned short)(pk[u_].z >> 16); \
        *(LAS unsigned short*)(lds + DR_KT + swz64(8 * q_ + 6, j_)) = (unsigned short)(pk[u_].w & 0xffffu); *(LAS unsigned short*)(lds + DR_KT + swz64(8 * q_ + 7, j_)) = (unsigned short)(pk[u_].w >> 16); \
        *(LAS u32x4*)(lds + DR_VT + swz64(p_ >> 3, 8 * (p_ & 7))) = pv[u_]; } \
        *(LAS u32x4*)(lds + DR_T + swz64(tid >> 3, 8 * (tid & 7))) = ptm; *(LAS u32x4*)(lds + DR_A + swz64(tid >> 3, 8 * (tid & 7))) = pa; \
        if (tid < 64) *(LAS f32x4*)(lds + DR_VEC + 16 * tid) = pvec; } while (0)
    LBAR();
    DR_LOAD(dir ? 31 : 0);
    DR_STORE();
#pragma unroll
    for (int q = 0; q < 4; ++q) *(LAS u32x4*)(ST + lane * 64 + q * 16) = (u32x4){0u, 0u, 0u, 0u};
    f32x4 Sacc[8];
#pragma unroll
    for (int d = 0; d < 8; ++d) Sacc[d] = (f32x4){0.f, 0.f, 0.f, 0.f};
    LBAR();
#pragma unroll 1
    for (int cc = 0; cc < 32; ++cc) { const int n = dir ? (31 - cc) : cc;
        if (cc + 1 < 32) DR_LOAD(dir ? (30 - cc) : (cc + 1));
        bf16x8 sb[4];
#pragma unroll
        for (int ks = 0; ks < 4; ++ks) sb[ks] = *(const LAS bf16x8*)(ST + swz128(fr, 32 * ks + 8 * fq));
        f32x4 oacc[4];
#pragma unroll
        for (int it = 0; it < 4; ++it) { f32x4 ka = {0.f, 0.f, 0.f, 0.f}, qa = {0.f, 0.f, 0.f, 0.f};
#pragma unroll
            for (int ks = 0; ks < 4; ++ks) { const bf16x8 a1 = *(const LAS bf16x8*)(lds + DR_K + swz128(16 * it + fr, 32 * ks + 8 * fq)), a2 = *(const LAS bf16x8*)(lds + DR_Q + swz128(16 * it + fr, 32 * ks + 8 * fq));
                ka = MFMA16(a1, sb[ks], ka); qa = MFMA16(a2, sb[ks], qa); }
            const int i0 = 16 * it + 4 * fq; const f32x4 be = *(const LAS f32x4*)(VEC + i0), eg = *(const LAS f32x4*)(VEC + 64 + i0);
            const u32x2 vv = *(const LAS u32x2*)(lds + DR_VT + swz64(es + fr, i0));
            f32x4 rh; rh[0] = be[0] * (bflo(vv.x) - eg[0] * ka[0]); rh[1] = be[1] * (bfhi(vv.x) - eg[1] * ka[1]); rh[2] = be[2] * (bflo(vv.y) - eg[2] * ka[2]); rh[3] = be[3] * (bfhi(vv.y) - eg[3] * ka[3]);
            *(LAS u32x2*)(RV + swz64(fr, i0)) = pk4(rh);
            oacc[it] = qa * eg; }
        bf16x8 rb2[2];
#pragma unroll
        for (int ks = 0; ks < 2; ++ks) rb2[ks] = *(const LAS bf16x8*)(RV + swz64(fr, 32 * ks + 8 * fq));
        f32x4 vn[4];
#pragma unroll
        for (int it = 0; it < 4; ++it) { vn[it] = (f32x4){0.f, 0.f, 0.f, 0.f};
#pragma unroll
            for (int ks = 0; ks < 2; ++ks) { const bf16x8 a1 = *(const LAS bf16x8*)(lds + DR_T + swz64(16 * it + fr, 32 * ks + 8 * fq)); vn[it] = MFMA16(a1, rb2[ks], vn[it]); } }
#pragma unroll
        for (int it = 0; it < 4; ++it) { const int i0 = 16 * it + 4 * fq; const f32x4 ed = *(const LAS f32x4*)(VEC + 128 + i0);
            *(LAS u32x2*)(RV + swz64(fr, i0)) = pk4(vn[it]); *(LAS u32x2*)(VN2 + swz64(fr, i0)) = pk4(vn[it] * ed); }
        bf16x8 vb[2], vb2[2];
#pragma unroll
        for (int ks = 0; ks < 2; ++ks) { vb[ks] = *(const LAS bf16x8*)(RV + swz64(fr, 32 * ks + 8 * fq)); vb2[ks] = *(const LAS bf16x8*)(VN2 + swz64(fr, 32 * ks + 8 * fq)); }
#pragma unroll
        for (int it = 0; it < 4; ++it)
#pragma unroll
            for (int ks = 0; ks < 2; ++ks) { const bf16x8 a1 = *(const LAS bf16x8*)(lds + DR_A + swz64(16 * it + fr, 32 * ks + 8 * fq)); oacc[it] = MFMA16(a1, vb[ks], oacc[it]); }
        const float cdec = VEC[192];
#pragma unroll
        for (int dt = 0; dt < 8; ++dt) { Sacc[dt] = Sacc[dt] * cdec;
#pragma unroll
            for (int ks = 0; ks < 2; ++ks) { const bf16x8 a1 = *(const LAS bf16x8*)(lds + DR_KT + swz64(16 * dt + fr, 32 * ks + 8 * fq)); Sacc[dt] = MFMA16(a1, vb2[ks], Sacc[dt]); }
            *(LAS u32x2*)(ST + swz128(fr, 16 * dt + 4 * fq)) = pk4(Sacc[dt]); }
#pragma unroll
        for (int it = 0; it < 4; ++it)
#pragma unroll
            for (int jj = 0; jj < 4; ++jj) og[(size_t)(64 * n + 16 * it + 4 * fq + jj) * 512] = (bf16_t)(pk2(oacc[it][jj], 0.f) & 0xffffu);
        LBAR();
        if (cc + 1 < 32) DR_STORE();
        LBAR();
    }
#undef DR_LOAD
#undef DR_STORE
}

__device__ __forceinline__ void m2_rows(PT pt, int layer, int gw, int NGW, int lane) {
    asm volatile("" : "+v"(lane));
    unsigned char* ws = pws(pt);
    const bf16_t* of = (const bf16_t*)(ws + WS_OF); const bf16_t* ob = (const bf16_t*)(ws + WS_OB); const bf16_t* pz = (const bf16_t*)(ws + WS_PZ);
    const bf16_t* hf = (const bf16_t*)pout(pt); const bf16_t* hb = hf + (size_t)M_TOK * 512; const bf16_t* plg = (const bf16_t*)(ws + WS_PLG);
    bf16_t* amix = (bf16_t*)(ws + WS_AMIX);
    const float* dng = pin(pt, I_DNG) + layer * 128 + 8 * (lane & 15); const float* lng = pin(pt, I_LNG) + layer * 512 + 8 * lane;
    const f32x4 dg0 = *(const f32x4*)dng, dg1 = *(const f32x4*)(dng + 4), lg0 = *(const f32x4*)lng, lg1 = *(const f32x4*)(lng + 4);
    for (int m0 = gw; m0 < M_TOK; m0 += 2 * NGW) {
        u32x4 av[2], bv[2], zv[2], cv[2], dv[2], gv[2];
#pragma unroll
        for (int r = 0; r < 2; ++r) { const int m = m0 + r * NGW; if (m < M_TOK) { const size_t o = (size_t)m * 512 + 8 * lane;
            av[r] = *(const u32x4*)(of + o); bv[r] = *(const u32x4*)(ob + o); zv[r] = *(const u32x4*)(pz + o); cv[r] = *(const u32x4*)(hf + o); dv[r] = *(const u32x4*)(hb + o); gv[r] = *(const u32x4*)(plg + o); } }
#pragma unroll
        for (int r = 0; r < 2; ++r) { const int m = m0 + r * NGW; if (m < M_TOK) {
        const u32x4 a = av[r], b2 = bv[r], z = zv[r], c = cv[r], d = dv[r], g = gv[r];
        float v[8], y[8];
        v[0] = bflo(a.x) + bflo(b2.x); v[1] = bfhi(a.x) + bfhi(b2.x); v[2] = bflo(a.y) + bflo(b2.y); v[3] = bfhi(a.y) + bfhi(b2.y);
        v[4] = bflo(a.z) + bflo(b2.z); v[5] = bfhi(a.z) + bfhi(b2.z); v[6] = bflo(a.w) + bflo(b2.w); v[7] = bfhi(a.w) + bfhi(b2.w);
        float s1 = 0.f;
#pragma unroll
        for (int e = 0; e < 8; ++e) s1 += v[e] * v[e];
        s1 += __shfl_xor(s1, 1); s1 += __shfl_xor(s1, 2); s1 += __shfl_xor(s1, 4); s1 += __shfl_xor(s1, 8);
        const float r1 = rsqrtf(s1 * (1.0f / 128.0f) + EPS);
        float zz[8] = {bflo(z.x), bfhi(z.x), bflo(z.y), bfhi(z.y), bflo(z.z), bfhi(z.z), bflo(z.w), bfhi(z.w)};
        float gg[8] = {bflo(g.x), bfhi(g.x), bflo(g.y), bfhi(g.y), bflo(g.z), bfhi(g.z), bflo(g.w), bfhi(g.w)};
        float hh[8] = {bflo(c.x) + bflo(d.x), bfhi(c.x) + bfhi(d.x), bflo(c.y) + bflo(d.y), bfhi(c.y) + bfhi(d.y), bflo(c.z) + bflo(d.z), bfhi(c.z) + bfhi(d.z), bflo(c.w) + bflo(d.w), bfhi(c.w) + bfhi(d.w)};
        float s2 = 0.f;
#pragma unroll
        for (int e = 0; e < 8; ++e) { const float dgv = e < 4 ? dg0[e & 3] : dg1[e & 3]; v[e] = v[e] * r1 * dgv * (zz[e] * sigm(zz[e])); y[e] = gelu_t(gg[e]) * hh[e]; s2 += y[e] * y[e]; }
#pragma unroll
        for (int o2 = 1; o2 < 64; o2 <<= 1) s2 += __shfl_xor(s2, o2);
        const float r2 = rsqrtf(s2 * (1.0f / 512.0f) + EPS);
#pragma unroll
        for (int e = 0; e < 8; ++e) { const float lgv = e < 4 ? lg0[e & 3] : lg1[e & 3]; y[e] = y[e] * r2 * lgv; }
        u32x4 w1, w2; w1.x = pk2(v[0], v[1]); w1.y = pk2(v[2], v[3]); w1.z = pk2(v[4], v[5]); w1.w = pk2(v[6], v[7]);
        w2.x = pk2(y[0], y[1]); w2.y = pk2(y[2], y[3]); w2.z = pk2(y[4], y[5]); w2.w = pk2(y[6], y[7]);
        *(u32x4*)(amix + (size_t)m * 1024 + 8 * lane) = w1; *(u32x4*)(amix + (size_t)m * 1024 + 512 + 8 * lane) = w2; } }
    }
}

__device__ __forceinline__ void glu_fixup(PT pt, int layer, int bx, int G, int tid) {
    asm volatile("" : "+v"(tid));
    unsigned char* ws = pws(pt);
    const float* sg = (const float*)(ws + WS_G); const float* su = sg + (size_t)256 * 4 * FF; bf16_t* act = (bf16_t*)(ws + WS_ACT);
    const float* cw = pin(pt, I_FCW) + (size_t)layer * 3 * FF; const float* cb = pin(pt, I_FCB) + (size_t)layer * FF;
    for (int e = bx * 512 + tid; e < 512 * (FF / 4); e += G * 512) { const int edge = e / (FF / 4), ch = (e % (FF / 4)) * 4; const int pm = edge >> 1, side = edge & 1;
        const int row = 256 * pm + (side ? 255 : 0); const int t = row & (SEQ - 1);
        const f32x4 gmid = *(const f32x4*)(sg + ((size_t)pm * 4 + (side ? 3 : 0)) * FF + ch);
        f32x4 gup = {0.f, 0.f, 0.f, 0.f}, gdn = {0.f, 0.f, 0.f, 0.f};
        if (side == 0) { gdn = *(const f32x4*)(sg + ((size_t)pm * 4 + 1) * FF + ch); if (t != 0) gup = *(const f32x4*)(sg + ((size_t)(pm - 1) * 4 + 3) * FF + ch); }
        else { gup = *(const f32x4*)(sg + ((size_t)pm * 4 + 2) * FF + ch); if (t != SEQ - 1) gdn = *(const f32x4*)(sg + ((size_t)(pm + 1) * 4 + 0) * FF + ch); }
        const f32x4 uu = *(const f32x4*)(su + ((size_t)pm * 2 + side) * FF + ch);
        const f32x4 w0 = *(const f32x4*)(cw + ch), w1 = *(const f32x4*)(cw + FF + ch), w2 = *(const f32x4*)(cw + 2 * FF + ch), bb = *(const f32x4*)(cb + ch);
        const f32x4 ga = w0 * gup + w1 * gmid + w2 * gdn + bb;
        u32x2 o; o.x = pk2(gelu_t(ga[0]) * uu[0], gelu_t(ga[1]) * uu[1]); o.y = pk2(gelu_t(ga[2]) * uu[2], gelu_t(ga[3]) * uu[3]);
        *(u32x2*)(act + (size_t)row * FF + ch) = o; }
}

#define XB_TMO      128
#define XB_XCNT(j)  (256  + 64 * (j))
#define XB_XSUB(j)  (1280 + 64 * (j))
#define XB_XGEN(j)  (2304 + 64 * (j))
#define XB_TOP      3328
#define XB_TOPGEN   3392
#define XCD_BAR_WORDS 3456
#define XB_SPIN_CAP (1u << 18)

__device__ __forceinline__ unsigned xb_ld(unsigned* p)              { return __hip_atomic_load(p, __ATOMIC_RELAXED, __HIP_MEMORY_SCOPE_AGENT); }
__device__ __forceinline__ unsigned xb_add(unsigned* p, unsigned v) { return __hip_atomic_fetch_add(p, v, __ATOMIC_RELAXED, __HIP_MEMORY_SCOPE_AGENT); }
__device__ __forceinline__ unsigned xb_xcc_id() { return (unsigned)__builtin_amdgcn_s_getreg((3 << 11) | 20) & 0xFu; }
#define XB_SPIN(cond, bar) do { unsigned _sp = 0; while (cond) { __builtin_amdgcn_s_sleep(1); \
    if ((++_sp & 255u) == 0u) { if (xb_ld(&(bar)[XB_TMO])) break; if (_sp > XB_SPIN_CAP) { atomicAdd(&(bar)[XB_TMO], 1u); break; } } } } while (0)

struct XcdBarrier {
    unsigned* bar; unsigned x;
    volatile LAS unsigned* st;
};

__device__ __forceinline__ XcdBarrier xcd_barrier_post(unsigned* bar, volatile LAS unsigned* st) {
    XcdBarrier b; b.bar = bar; b.x = xb_xcc_id(); b.st = st;
    if (threadIdx.x == 0) (void)xb_add(&bar[XB_XCNT(b.x)], 1u);
    return b;
}
__device__ __forceinline__ void xcd_barrier_complete(unsigned* bar, unsigned x, unsigned& nloc, unsigned& nx) {
    const unsigned G = gridDim.x * gridDim.y * gridDim.z;
    unsigned sum, cnt, mine, sp = 0u;
    for (;;) {
        sum = 0u; cnt = 0u; mine = 0u;
#pragma unroll
        for (unsigned j = 0; j < 16; ++j) { const unsigned c = xb_ld(&bar[XB_XCNT(j)]); sum += c; cnt += (c > 0u) ? 1u : 0u; mine = (j == x) ? c : mine; }
        if (sum == G) break;
        __builtin_amdgcn_s_sleep(1);
        if ((++sp & 255u) == 0u) { if (xb_ld(&bar[XB_TMO])) break; if (sp > XB_SPIN_CAP) { atomicAdd(&bar[XB_TMO], 1u); break; } }
    }
    nloc = mine > 0u ? mine : 1u; nx = cnt > 0u ? cnt : 1u;
}

__device__ __forceinline__ void xcd_barrier(const XcdBarrier& b) {
    asm volatile("s_waitcnt vmcnt(0)" ::: "memory");
    __syncthreads();
    if (threadIdx.x == 0) {
        unsigned* bar = b.bar;
        __builtin_amdgcn_s_waitcnt(0);
        unsigned nloc = b.st[0], nx = b.st[1];
        if (nloc == 0u) { xcd_barrier_complete(bar, b.x, nloc, nx); b.st[0] = nloc; b.st[1] = nx; }
        const unsigned old = xb_add(&bar[XB_XSUB(b.x)], 1u);
        const unsigned gen = old / nloc;
        if (old + 1u == (gen + 1u) * nloc) {
            __builtin_amdgcn_fence(__ATOMIC_RELEASE, "agent");
            asm volatile("s_waitcnt vmcnt(0)" ::: "memory");
            const unsigned og = xb_add(&bar[XB_TOP], 1u);
            const unsigned tg = og / nx;
            if (og + 1u == (tg + 1u) * nx) xb_add(&bar[XB_TOPGEN], 1u);
            else XB_SPIN(xb_ld(&bar[XB_TOPGEN]) == tg, bar);
            __builtin_amdgcn_fence(__ATOMIC_ACQUIRE, "agent");
            xb_add(&bar[XB_XGEN(b.x)], 1u);
            asm volatile("s_waitcnt vmcnt(0)" ::: "memory");
        } else {
            XB_SPIN(xb_ld(&bar[XB_XGEN(b.x)]) == gen, bar);
            __builtin_amdgcn_fence(__ATOMIC_ACQUIRE, "agent");
            asm volatile("s_waitcnt vmcnt(0)" ::: "memory");
        }
    }
    __syncthreads();
}

#ifndef PHMASK
#define PHMASK 0xFFFF
#endif
#ifndef DUPMASK
#define DUPMASK 0
#endif
#define PH(k) _Pragma("unroll 1") for (int rep_ = 0; rep_ < ((((PHMASK >> (k)) & 1) ? 1 : 0) + (((DUPMASK >> (k)) & 1) ? 1 : 0)); ++rep_)
#define GRID_BAR() do { XcdBarrier b_; b_.bar = (unsigned*)pws(pt); b_.x = xb_xcc_id(); b_.st = (volatile LAS unsigned*)(lds + LDS_BYTES - 512); xcd_barrier(b_); } while (0)
#ifndef TMASK
#define TMASK 0
#endif
#define TS_BEGIN(k) do { if (((TMASK >> (k)) & 1) && bx == 0 && tid == 0) { const unsigned long long t_ = __builtin_amdgcn_s_memrealtime(); *(volatile LAS unsigned*)(lds + LDS_BYTES - 128) = (unsigned)t_; } } while (0)
#define TS_END(k) do { if (((TMASK >> (k)) & 1) && bx == 0 && tid == 0) { const unsigned t_ = (unsigned)__builtin_amdgcn_s_memrealtime(); volatile LAS unsigned* a_ = (volatile LAS unsigned*)(lds + LDS_BYTES - 128); a_[1] += t_ - a_[0]; } } while (0)
#ifndef STAG
#define STAG 0
#endif
#define STAGGER(step_10ns) do { if (STAG) { const unsigned sg_ = ((unsigned)bx >> 3) & 1u; if (sg_) { const unsigned long long t0_ = __builtin_amdgcn_s_memrealtime(); \
        while (__builtin_amdgcn_s_memrealtime() - t0_ < (unsigned long long)(sg_ * (step_10ns))) __builtin_amdgcn_s_sleep(16); } __syncthreads(); } } while (0)
#define RB_ ((bf16_t*)(pws(pt) + WS_RB))
#define RLO_ ((unsigned char*)pout(pt) + (size_t)128 * MiB)
#define RLOF_ ((unsigned char*)(pws(pt) + WS_RLO))
#define RBC_ ((bf16_t*)(pws(pt) + WS_BIG + 128 * MiB))
#define SS_(k) ((float*)(pws(pt) + WS_SSP) + (size_t)(k) * M_TOK * 4)
__global__ void __launch_bounds__(512, 2) fwd_kernel(Params P) {
    extern __shared__ __attribute__((aligned(16))) unsigned char lds_raw[];
    LAS unsigned char* lds = (LAS unsigned char*)lds_raw;
    cg::grid_group grid = cg::this_grid();
    const int tid = threadIdx.x, lane = tid & 63, wave = __builtin_amdgcn_readfirstlane(tid >> 6);
    const int G = gridDim.x, bx = blockIdx.x; const int gw = bx * 8 + wave, NGW = G * 8;
    PT pt = (PT)(lds + LDS_BYTES - 256);
    volatile LAS unsigned* xst = (volatile LAS unsigned*)(lds + LDS_BYTES - 512);
    if (tid == 0) { xst[0] = 0u; xst[1] = 0u; if (TMASK) { ((volatile LAS unsigned*)(lds + LDS_BYTES - 128))[1] = 0u; }
#pragma unroll
        for (int i = 0; i < 28; ++i) { const unsigned long long v = (unsigned long long)P.in[i]; pt[2 * i] = (unsigned)v; pt[2 * i + 1] = (unsigned)(v >> 32); }
        { const unsigned long long v = (unsigned long long)P.out; pt[56] = (unsigned)v; pt[57] = (unsigned)(v >> 32); }
        { const unsigned long long v = (unsigned long long)P.ws; pt[58] = (unsigned)v; pt[59] = (unsigned)(v >> 32); }
    }
    __syncthreads();
    (void)xcd_barrier_post((unsigned*)P.ws, xst);

    TS_BEGIN(0);
    PH(0) prologue(pt, lds, gw, NGW, lane, wave);
    __syncthreads();
    grid.sync(); TS_END(0);

#pragma unroll 1
    for (int layer = 0; layer < NL; ++layer) {
        TS_BEGIN(1); PH(1) { pg8::Gemm g{RB_, (const bf16_t*)(pws(pt) + WS_WIN) + (size_t)layer * 3328 * 1024, M_TOK, 3328, 1024}; pg8::StaticOrder S; S.init(M_TOK, 3328, G, bx);
          EpiStore E{SS_(3 * layer), {(bf16_t*)(pws(pt) + WS_PQKV), (bf16_t*)(pws(pt) + WS_PLX), (bf16_t*)(pws(pt) + WS_PZ), (bf16_t*)(pws(pt) + WS_PLG)}, {1536, 512, 512, 512}, {0, 6, 8, 10}, (float*)(pws(pt) + WS_GATES), 12};
          pg8::gemm_phase<EpiStore, pg8::StaticOrder, true, true>(lds, g, S, E);
          int tl = tid; asm volatile("" : "+v"(tl));
          const f32x4* ps = (const f32x4*)(pin(pt, I_P) + (size_t)layer * M_TOK * PLE); u32x2* pd = (u32x2*)(pws(pt) + WS_PB);
          for (size_t i = (size_t)bx * 512 + tl; i < (size_t)M_TOK * PLE / 4; i += (size_t)G * 512) pd[i] = pk4(ps[i]);
          }
        GRID_BAR(); TS_END(1);
        TS_BEGIN(2); PH(2) for (int bi = bx; bi < 256; bi += G) lru_block(pt, lds, bi, layer, tid);
        PH(3) { __syncthreads();
          { int tl = tid; asm volatile("" : "+v"(tl)); const int hh = (bx >> 5) & 3; const float* cwg = pin(pt, I_DNCW) + (size_t)layer * 4 * 1536;
            for (int e = tl; e < 1536; e += 512) { const int mat = e >> 9, tap = (e >> 7) & 3, ch = e & 127; ((LAS float*)(lds + DP_CWL))[e] = cwg[tap * 1536 + mat * 512 + hh * 128 + ch]; } }
          for (int it = bx; it < 4096; it += G) dp_item(pt, lds, it, layer, tid, lane, wave); }
        GRID_BAR(); TS_END(2);
        TS_BEGIN(4); PH(4) for (int it = bx; it < 256; it += G) dr_item(pt, lds, it, tid, lane, wave);
        GRID_BAR(); TS_END(4);
        TS_BEGIN(6); PH(6) m2_rows(pt, layer, gw, NGW, lane);
        GRID_BAR(); TS_END(6);
        TS_BEGIN(7); PH(7) { STAGGER(3700); pg8::Gemm g{(const bf16_t*)(pws(pt) + WS_AMIX), (const bf16_t*)(pws(pt) + WS_WOUT) + (size_t)layer * DM * DM, M_TOK, 1024, 1024}; pg8::StaticOrder S; S.init(M_TOK, 1024, G, bx);
          EpiResid<0> E{nullptr, RB_, RB_, RLO_, RLO_, SS_(3 * layer + 1), nullptr, nullptr, nullptr, nullptr, (LAS float*)(lds + 131072)};
          pg8::gemm_phase<EpiResid<0>, pg8::StaticOrder, true, true>(lds, g, S, E); }
        GRID_BAR(); TS_END(7);
        TS_BEGIN(9); PH(9) { pg8::Gemm g{RB_, (const bf16_t*)(pws(pt) + WS_WG) + (size_t)layer * 5632 * 1024, M_TOK, 5632, 1024}; pg8::StaticOrder S; S.init(M_TOK, 5632, G, bx);
          EpiGluF E{SS_(3 * layer + 1), (float*)(pws(pt) + WS_G), (float*)(pws(pt) + WS_G) + (size_t)256 * 4 * FF, pin(pt, I_FCW) + (size_t)layer * 3 * FF, pin(pt, I_FCB) + (size_t)layer * FF, (bf16_t*)(pws(pt) + WS_ACT), (LAS float*)(lds + 135168)};
          pg8::gemm_phase<EpiGluF, pg8::StaticOrder, true, true>(lds, g, S, E); }
        GRID_BAR(); TS_END(9);
        TS_BEGIN(8); PH(8) glu_fixup(pt, layer, bx, G, tid);
        GRID_BAR(); TS_END(8);
        TS_BEGIN(10); PH(10) { STAGGER(4800); pg8::Gemm g{(const bf16_t*)(pws(pt) + WS_ACT), (const bf16_t*)(pws(pt) + WS_WD) + (size_t)layer * DM * FF, M_TOK, 1024, FF}; pg8::StaticOrder S; S.init(M_TOK, 1024, G, bx);
          EpiResid<0> E{nullptr, RB_, RBC_, RLO_, RLO_, SS_(3 * layer + 2), nullptr, nullptr, nullptr, nullptr, (LAS float*)(lds + 131072)};
          pg8::gemm_phase<EpiResid<0>, pg8::StaticOrder, true, true>(lds, g, S, E); }
        __syncthreads();
        PH(11) { pg8::Gemm g{(const bf16_t*)(pws(pt) + WS_PB), (const bf16_t*)(pws(pt) + WS_WP) + (size_t)layer * DM * PLE, M_TOK, 1024, PLE}; pg8::StaticOrder S; S.init(M_TOK, 1024, G, bx);
          EpiStore E{nullptr, {(bf16_t*)(pws(pt) + WS_PP), nullptr, nullptr, nullptr}, {1024, 0, 0, 0}, {0, 99, 99, 99}, nullptr, 99};
          pg8::gemm_phase<EpiStore, pg8::StaticOrder, true, true>(lds, g, S, E); }
        GRID_BAR(); TS_END(10);
        TS_BEGIN(12); PH(12) { STAGGER(3000); pg8::Gemm g{RBC_, (const bf16_t*)(pws(pt) + WS_WPG) + (size_t)layer * DM * DM, M_TOK, 1024, 1024}; pg8::StaticOrder S; S.init(M_TOK, 1024, G, bx);
          EpiResid<1> E{nullptr, RBC_, RB_, RLO_, layer == NL - 1 ? RLOF_ : RLO_, SS_(3 * layer + 3), SS_(3 * layer + 2), pin(pt, I_PBG) + (size_t)layer * DM, (const bf16_t*)(pws(pt) + WS_PP), nullptr, (LAS float*)(lds + 131072)};
          pg8::gemm_phase<EpiResid<1>, pg8::StaticOrder, true, true>(lds, g, S, E); }
        GRID_BAR(); TS_END(12);
    }
    TS_BEGIN(13);
    { int tlf = tid; asm volatile("" : "+v"(tlf)); const int lane = tlf & 63;
      const float* ssF = SS_(12); const f32x4* fg = (const f32x4*)pin(pt, I_FING) + lane; const bf16_t* hi_ = RB_; const unsigned char* lo_ = RLOF_; float* outp = pout(pt);
      for (int m = gw; m < M_TOK; m += NGW) { const float sc = rs_of(ssF, m); f32x4* xr = (f32x4*)(outp + (size_t)m * DM) + lane;
          const u32x2* hr = (const u32x2*)(hi_ + (size_t)m * DM) + lane; const unsigned* lr = (const unsigned*)(lo_ + (size_t)m * DM) + lane;
#pragma unroll
          for (int j = 0; j < 4; ++j) { const u32x2 h = hr[64 * j]; const unsigned l = lr[64 * j]; const f32x4 g = fg[64 * j];
              f32x4 v; v[0] = (bflo(h.x) + FP8_AT(l, 0)) * sc * g[0]; v[1] = (bfhi(h.x) + FP8_AT(l, 1)) * sc * g[1]; v[2] = (bflo(h.y) + FP8_AT(l, 2)) * sc * g[2]; v[3] = (bfhi(h.y) + FP8_AT(l, 3)) * sc * g[3];
              xr[64 * j] = v; } } }
    if (TMASK) { __syncthreads(); TS_END(13); if (bx == 0 && tid == 0) { const unsigned wait_ = ((volatile LAS unsigned*)(lds + LDS_BYTES - 128))[1]; const unsigned long long t0_ = __builtin_amdgcn_s_memrealtime(); while (__builtin_amdgcn_s_memrealtime() - t0_ < (unsigned long long)wait_) __builtin_amdgcn_s_sleep(8); } }
}

extern "C" void kernel_launch(void* const* d_in, const int* in_sizes, int n_in, void* d_out, int out_size, void* d_ws, size_t ws_size, hipStream_t stream) {
    static int grid = 0;
    if (grid == 0) {
        if (n_in != 28 || ws_size < WS_END) { fprintf(stderr, "kernel_launch: unexpected n_in %d or workspace %zu < %zu\n", n_in, ws_size, (size_t)WS_END); grid = -1; return; }
        int dev = 0, cus = 0, per_cu = 0;
        hipGetDevice(&dev); hipDeviceGetAttribute(&cus, hipDeviceAttributeMultiprocessorCount, dev);
        if (hipFuncSetAttribute((const void*)fwd_kernel, hipFuncAttributeMaxDynamicSharedMemorySize, LDS_BYTES) != hipSuccess) fprintf(stderr, "kernel_launch: hipFuncSetAttribute failed\n");
        if (hipOccupancyMaxActiveBlocksPerMultiprocessor(&per_cu, (const void*)fwd_kernel, 512, LDS_BYTES) != hipSuccess || per_cu < 1) { fprintf(stderr, "kernel_launch: occupancy query says %d\n", per_cu); per_cu = 1; }
        (void)hipGetLastError();
        grid = cus * per_cu; if (grid > 256) grid = 256;
    }
    if (grid < 0) return;
    if (hipMemsetAsync(d_ws, 0, 16384, stream) != hipSuccess) { fprintf(stderr, "kernel_launch: memset of the barrier words failed\n"); return; }
    Params p{};
    for (int i = 0; i < 28; ++i) p.in[i] = (const float*)d_in[i];
    p.out = (float*)d_out; p.ws = (unsigned char*)d_ws;
    void* args[] = {&p};
    hipError_t e = hipLaunchCooperativeKernel((const void*)fwd_kernel, dim3(grid), dim3(512), args, LDS_BYTES, stream);
    if (e != hipSuccess) fprintf(stderr, "cooperative launch failed: %s (grid %d)\n", hipGetErrorString(e), grid);
}
```
